# Optimizing an MI355X kernel written in HIP

```python
import math
import jax, jax.numpy as jnp
from jax import lax
import numpy as np

D_MODEL = 4096
BATCH = 2
SEQ = 4096
DEPTH = 2

MEM_LEN = 256
N_BRANCH = 4
BRANCH_WIDTH = D_MODEL // 4
POOL_WINDOWS = (2, 4, 8, 16)
POOL_GROUP = BRANCH_WIDTH // 4
GLA_HEADS = 4
GLA_DK = BRANCH_WIDTH // 2
GLA_DV = BRANCH_WIDTH
GLA_HEAD_DK = GLA_DK // GLA_HEADS
GLA_HEAD_DV = GLA_DV // GLA_HEADS
GLA_RANK = 16
GLA_TAU = 16.0
GLA_CHUNK = 64
SWA_HEAD_DIM = 64
SWA_Q_HEADS = BRANCH_WIDTH // SWA_HEAD_DIM
SWA_KV_HEADS = SWA_Q_HEADS // 8
SWA_GROUP = SWA_Q_HEADS // SWA_KV_HEADS
SWA_KV_WIDTH = SWA_KV_HEADS * SWA_HEAD_DIM
WINDOW = 128
SWA_BLOCK = 128
ROPE_THETA = 500000.0
ROPE_DIM = SWA_HEAD_DIM // 4
XA_HEADS = 4
XA_HEAD_DIM = BRANCH_WIDTH // XA_HEADS
LN_EPS = 1e-5
DEEPNORM_ALPHA = (2 * DEPTH) ** 0.25
DEEPNORM_BETA = (8 * DEPTH) ** -0.25

IN_SPLITS = (
    BRANCH_WIDTH, BRANCH_WIDTH,
    GLA_DK, GLA_DK, GLA_DV, GLA_DV, GLA_RANK,
    BRANCH_WIDTH, SWA_KV_WIDTH, SWA_KV_WIDTH, BRANCH_WIDTH,
    BRANCH_WIDTH, BRANCH_WIDTH,
    N_BRANCH * D_MODEL,
)
D_IN = sum(IN_SPLITS)

kernel_name = "hybrid_pool_gla_swa_mem_deepnorm"


def _split_points():
    return [int(v) for v in np.cumsum(IN_SPLITS)[:-1]]


def layer_norm(x, g, b):
    xf = x.astype(jnp.float32)
    mu = jnp.mean(xf, axis=-1, keepdims=True)
    var = jnp.mean(jnp.square(xf - mu), axis=-1, keepdims=True)
    y = (xf - mu) * lax.rsqrt(var + LN_EPS) * g.astype(jnp.float32) + b.astype(jnp.float32)
    return y.astype(x.dtype)


def rope_partial(x, positions):
    half = ROPE_DIM // 2
    inv_freq = ROPE_THETA ** (-jnp.arange(0, ROPE_DIM, 2, dtype=jnp.float32) / ROPE_DIM)
    ang = positions.astype(jnp.float32)[:, :, None] * inv_freq
    cos = jnp.cos(ang)[:, :, None, :]
    sin = jnp.sin(ang)[:, :, None, :]
    xf = x.astype(jnp.float32)
    x1, x2, rest = xf[..., :half], xf[..., half:ROPE_DIM], xf[..., ROPE_DIM:]
    out = jnp.concatenate([x1 * cos - x2 * sin, x2 * cos + x1 * sin, rest], axis=-1)
    return out.astype(x.dtype)


def pool_mixer(u, w_pool, pool_scale):
    S = u.shape[1]
    t = jnp.arange(S)
    outs = []
    for gi, w in enumerate(POOL_WINDOWS):
        ug = u[..., gi * POOL_GROUP:(gi + 1) * POOL_GROUP].astype(jnp.float32)
        c = jnp.cumsum(ug, axis=1)
        c_lag = jnp.pad(c, ((0, 0), (w, 0), (0, 0)))[:, :S]
        cnt = jnp.minimum(t + 1, w).astype(jnp.float32)[None, :, None]
        pooled = (c - c_lag) / cnt - ug
        outs.append(jnp.einsum('bsc,cd->bsd', pooled.astype(u.dtype), w_pool[gi]))
    return jnp.concatenate(outs, axis=-1) * pool_scale


def gla_mixer(q, k, v, lr, w_gla_up, b_gla, gla_norm):
    B, S, _ = q.shape
    C = GLA_CHUNK
    n = S // C
    log_a = jax.nn.log_sigmoid((lr @ w_gla_up + b_gla).astype(jnp.float32)) / GLA_TAU

    def to_chunks(a, hd):
        return a.astype(jnp.float32).reshape(B, n, C, GLA_HEADS, hd).transpose(1, 0, 3, 2, 4)

    qc = to_chunks(q, GLA_HEAD_DK) * (GLA_HEAD_DK ** -0.5)
    kc = to_chunks(k, GLA_HEAD_DK)
    vc = to_chunks(v, GLA_HEAD_DV)
    gc = to_chunks(log_a, GLA_HEAD_DK)
    tri = jnp.tril(jnp.ones((C, C), dtype=bool))

    def step(state, inp):
        qb, kb, vb, gb = inp
        b = jnp.cumsum(gb, axis=2)
        o_inter = jnp.einsum('bhcd,bhde->bhce', qb * jnp.exp(b), state)
        diff = b[:, :, :, None, :] - b[:, :, None, :, :]
        diff = jnp.where(tri[None, None, :, :, None], diff, -jnp.inf)
        attn = jnp.sum(qb[:, :, :, None, :] * kb[:, :, None, :, :] * jnp.exp(diff), axis=-1)
        o_intra = jnp.einsum('bhij,bhje->bhie', attn, vb)
        b_last = b[:, :, -1:, :]
        k_dec = kb * jnp.exp(b_last - b)
        state = jnp.exp(b_last[:, :, 0, :])[..., None] * state + jnp.einsum('bhcd,bhce->bhde', k_dec, vb)
        return state, o_inter + o_intra

    state0 = jnp.zeros((B, GLA_HEADS, GLA_HEAD_DK, GLA_HEAD_DV), jnp.float32)
    _, o = lax.scan(step, state0, (qc, kc, vc, gc))
    o = o.transpose(1, 0, 3, 2, 4).reshape(B, S, GLA_HEADS, GLA_HEAD_DV)
    o = o * lax.rsqrt(jnp.mean(jnp.square(o), axis=-1, keepdims=True) + LN_EPS)
    o = o.reshape(B, S, GLA_DV) * gla_norm.astype(jnp.float32)
    return o.astype(q.dtype)


def swa_mixer(q, k, v, positions, sinks):
    B, S, _ = q.shape
    nb = S // SWA_BLOCK
    q = rope_partial(q.reshape(B, S, SWA_Q_HEADS, SWA_HEAD_DIM), positions) * (SWA_HEAD_DIM ** -0.5)
    k = rope_partial(k.reshape(B, S, SWA_KV_HEADS, SWA_HEAD_DIM), positions)
    v = v.reshape(B, S, SWA_KV_HEADS, SWA_HEAD_DIM)
    qb = q.reshape(B, nb, SWA_BLOCK, SWA_KV_HEADS, SWA_GROUP, SWA_HEAD_DIM)

    def band(a):
        ap = jnp.pad(a, ((0, 0), (SWA_BLOCK, 0), (0, 0), (0, 0)))
        ap = ap.reshape(B, nb + 1, SWA_BLOCK, SWA_KV_HEADS, SWA_HEAD_DIM)
        return jnp.concatenate([ap[:, :-1], ap[:, 1:]], axis=2)

    kb, vb = band(k), band(v)
    s = jnp.einsum('bnqkgd,bnskd->bnkgqs', qb, kb).astype(jnp.float32)
    qi = jnp.arange(SWA_BLOCK)
    sj = jnp.arange(2 * SWA_BLOCK)
    blk = jnp.arange(nb)
    diff = qi[:, None] + SWA_BLOCK - sj[None, :]
    key_abs = blk[:, None] * SWA_BLOCK - SWA_BLOCK + sj[None, :]
    valid = ((diff >= 0) & (diff < WINDOW))[None, :, :] & (key_abs >= 0)[:, None, :]
    s = jnp.where(valid[None, :, None, None, :, :], s, -jnp.inf)
    sink = sinks.astype(jnp.float32).reshape(SWA_KV_HEADS, SWA_GROUP)[None, None, :, :, None, None]
    sink = jnp.broadcast_to(sink, s.shape[:-1] + (1,))
    p = jax.nn.softmax(jnp.concatenate([s, sink], axis=-1), axis=-1)[..., :-1]
    o = jnp.einsum('bnkgqs,bnskd->bnqkgd', p.astype(vb.dtype), vb)
    return o.reshape(B, S, BRANCH_WIDTH)


def mem_attn(q, mem, w_mem_kv):
    B, S, _ = q.shape
    M = mem.shape[1]
    mkv = mem @ w_mem_kv
    mk = mkv[..., :BRANCH_WIDTH].reshape(B, M, XA_HEADS, XA_HEAD_DIM)
    mv = mkv[..., BRANCH_WIDTH:].reshape(B, M, XA_HEADS, XA_HEAD_DIM)
    qh = q.reshape(B, S, XA_HEADS, XA_HEAD_DIM)
    s = jnp.einsum('bshd,bmhd->bhsm', qh, mk).astype(jnp.float32) * (XA_HEAD_DIM ** -0.5)
    p = jax.nn.softmax(s, axis=-1)
    o = jnp.einsum('bhsm,bmhd->bshd', p.astype(mv.dtype), mv)
    return o.reshape(B, S, BRANCH_WIDTH)


def hybrid_layer(x, mem, positions, w_in, w_pool, pool_scale, w_gla_up, b_gla, gla_norm,
                 sinks, w_mem_kv, w_branch, w_out, ln_g, ln_b):
    h = x @ w_in
    (pool_u, pool_g, gq, gk, gv, gg, glr, sq, sk, sv, sg, xq, xg, mg) = jnp.split(h, _split_points(), axis=-1)
    o_pool = pool_mixer(pool_u, w_pool, pool_scale) * jax.nn.silu(pool_g)
    o_gla = gla_mixer(gq, gk, gv, glr, w_gla_up, b_gla, gla_norm) * jax.nn.silu(gg)
    o_swa = swa_mixer(sq, sk, sv, positions, sinks) * jax.nn.silu(sg)
    o_mem = mem_attn(xq, mem, w_mem_kv) * jax.nn.silu(xg)
    branches = (o_pool, o_gla, o_swa, o_mem)
    y = None
    for bi in range(N_BRANCH):
        gate = jax.nn.sigmoid(mg[..., bi * D_MODEL:(bi + 1) * D_MODEL])
        term = gate * (branches[bi] @ w_branch[bi])
        y = term if y is None else y + term
    out = y @ w_out
    return layer_norm(DEEPNORM_ALPHA * x + out, ln_g, ln_b)


def setup_inputs(seed: int = 0) -> dict:
    key = jax.random.key(seed)
    ks = jax.random.split(key, 16)
    f32 = jnp.float32
    x = jax.random.normal(ks[0], (BATCH, SEQ, D_MODEL), f32)
    mem = jax.random.normal(ks[1], (BATCH, MEM_LEN, D_MODEL), f32)
    offset = jax.random.randint(ks[2], (BATCH, 1), 0, 1024, dtype=jnp.int32)
    positions = (offset + jnp.arange(SEQ, dtype=jnp.int32)[None, :]).astype(jnp.int32)
    w_in = jax.random.normal(ks[3], (DEPTH, D_MODEL, D_IN), f32) * D_MODEL ** -0.5
    w_pool = jax.random.normal(ks[4], (DEPTH, len(POOL_WINDOWS), POOL_GROUP, POOL_GROUP), f32) * POOL_GROUP ** -0.5
    pool_scale = 1.0 + 0.02 * jax.random.normal(ks[5], (DEPTH, BRANCH_WIDTH), f32)
    w_gla_up = jax.random.normal(ks[6], (DEPTH, GLA_RANK, GLA_DK), f32) * GLA_RANK ** -0.5
    b_gla = 0.01 * jax.random.normal(ks[7], (DEPTH, GLA_DK), f32)
    gla_norm = 1.0 + 0.02 * jax.random.normal(ks[8], (DEPTH, GLA_DV), f32)
    sinks = 0.5 * jax.random.normal(ks[9], (DEPTH, SWA_Q_HEADS), f32)
    w_mem_kv = jax.random.normal(ks[10], (DEPTH, D_MODEL, 2 * BRANCH_WIDTH), f32) * D_MODEL ** -0.5
    w_branch = jax.random.normal(ks[11], (DEPTH, N_BRANCH, BRANCH_WIDTH, D_MODEL), f32) * (BRANCH_WIDTH ** -0.5 * DEEPNORM_BETA)
    w_out = jax.random.normal(ks[12], (DEPTH, D_MODEL, D_MODEL), f32) * (D_MODEL ** -0.5 * DEEPNORM_BETA)
    ln_g = 1.0 + 0.02 * jax.random.normal(ks[13], (DEPTH, D_MODEL), f32)
    ln_b = 0.02 * jax.random.normal(ks[14], (DEPTH, D_MODEL), f32)
    return {"x": x, "mem": mem, "positions": positions, "w_in": w_in, "w_pool": w_pool,
            "pool_scale": pool_scale, "w_gla_up": w_gla_up, "b_gla": b_gla, "gla_norm": gla_norm,
            "sinks": sinks, "w_mem_kv": w_mem_kv, "w_branch": w_branch, "w_out": w_out,
            "ln_g": ln_g, "ln_b": ln_b}


def reference(x, mem, positions, w_in, w_pool, pool_scale, w_gla_up, b_gla, gla_norm,
              sinks, w_mem_kv, w_branch, w_out, ln_g, ln_b):
    for l in range(DEPTH):
        x = hybrid_layer(x, mem, positions, w_in[l], w_pool[l], pool_scale[l], w_gla_up[l],
                         b_gla[l], gla_norm[l], sinks[l], w_mem_kv[l], w_branch[l], w_out[l],
                         ln_g[l], ln_b[l])
    return x
```

```cpp
#include <hip/hip_runtime.h>
#include <cstdio>
#include <cstdint>

#ifndef MK_PER_PHASE
#define MK_PER_PHASE 0
#endif

#define DI __device__ __forceinline__
#define LAS __attribute__((address_space(3)))
#define GAS __attribute__((address_space(1)))
typedef unsigned short bf16;
typedef short bf16x8 __attribute__((ext_vector_type(8)));
typedef short s16x4 __attribute__((ext_vector_type(4)));
typedef short v4i16_t __attribute__((ext_vector_type(4)));
typedef float f32x4 __attribute__((ext_vector_type(4)));
typedef float f32x2 __attribute__((ext_vector_type(2)));
typedef unsigned u32x4 __attribute__((ext_vector_type(4)));
typedef unsigned u32x2 __attribute__((ext_vector_type(2)));

constexpr int BATCH = 2, SEQ = 4096, DM = 4096, MTOK = BATCH * SEQ, DEPTH = 2;
constexpr int D_IN = 25872, NH = 26112;
constexpr int BW = 1024;
constexpr int MEMLEN = 256;
constexpr int C_PU = 0, C_PG = 1024, C_GQ = 2048, C_GK = 2560, C_GV = 3072, C_GG = 4096, C_SQ = 5120, C_SK = 6144, C_SV = 6272, C_SG = 6400, C_XQ = 7424, C_XG = 8448, C_MG = 9472, C_LR = 25856;
constexpr float LN_EPS = 1e-5f;
constexpr float DN_ALPHA = 1.41421356237309515f;

constexpr size_t MiB = 1u << 20;
constexpr size_t WS_CTL = 0, CTL_ZERO_BYTES = 1 * MiB;
constexpr size_t WS_ROPE = 1 * MiB;
constexpr size_t WS_WPOOLT = 2 * MiB;
constexpr size_t WS_MEMB = 4 * MiB;
constexpr size_t WS_MK = 8 * MiB;
constexpr size_t WS_MVT = 10 * MiB;
constexpr size_t WS_DEC = 12 * MiB;
constexpr size_t WS_WMKVT = 16 * MiB;
constexpr size_t WS_WBRT = 48 * MiB;
constexpr size_t WS_WOUTT = 112 * MiB;
constexpr size_t WS_XB = 176 * MiB;
constexpr size_t WS_OB = 240 * MiB;
constexpr size_t WS_YB = 304 * MiB;
constexpr size_t WS_GU = 368 * MiB;
constexpr size_t WS_GS = 432 * MiB;
constexpr size_t WS_GB = 464 * MiB;
constexpr size_t WS_WINT = 512 * MiB;
constexpr size_t WS_H = 928 * MiB;
constexpr size_t WS_Z = 1336 * MiB;
constexpr size_t WS_END = 1464 * MiB;
constexpr int CW_BAR = 4096;

constexpr int RING_BYTES = 131072;
constexpr int THIN_BYTES = 141312;
constexpr int LDSCTL_OFF = THIN_BYTES, MISC_OFF = LDSCTL_OFF + 320;
constexpr int LDS_BYTES = 147456;
constexpr int NWAVES = 8, NTHR = 512;

DI float bf2f(unsigned v) { return __builtin_bit_cast(float, v << 16); }
DI unsigned f2bf(float f) { unsigned u = __builtin_bit_cast(unsigned, f); return (u + 0x7fffu + ((u >> 16) & 1u)) >> 16; }
DI unsigned pk2(float lo, float hi) { return f2bf(lo) | (f2bf(hi) << 16); }
DI unsigned cvt_pk_bf16(float lo, float hi) { unsigned r; asm volatile("v_cvt_pk_bf16_f32 %0, %1, %2" : "=v"(r) : "v"(lo), "v"(hi)); return r; }
DI float fast_sigmoid(float v) { return __builtin_amdgcn_rcpf(1.0f + __builtin_amdgcn_exp2f(-1.44269504089f * v)); }
DI void unpack8(const u32x4 w, float (&f)[8]) {
    f[0] = bf2f(w.x & 0xffffu); f[1] = bf2f(w.x >> 16); f[2] = bf2f(w.y & 0xffffu); f[3] = bf2f(w.y >> 16);
    f[4] = bf2f(w.z & 0xffffu); f[5] = bf2f(w.z >> 16); f[6] = bf2f(w.w & 0xffffu); f[7] = bf2f(w.w >> 16);
}
DI u32x4 pack8(const float (&f)[8]) { u32x4 w; w.x = pk2(f[0], f[1]); w.y = pk2(f[2], f[3]); w.z = pk2(f[4], f[5]); w.w = pk2(f[6], f[7]); return w; }
DI f32x4 mma16(bf16x8 a, bf16x8 b, f32x4 c) { return __builtin_amdgcn_mfma_f32_16x16x32_bf16(a, b, c, 0, 0, 0); }
DI bf16x8 frag_lds(const LAS bf16* img, int ld, int idx0, int k0, int lane) { return *(const LAS bf16x8*)(img + (idx0 + (lane & 15)) * ld + k0 + 8 * (lane >> 4)); }
DI bf16x8 frag_glb(const bf16* img, size_t ld, int idx0, int k0, int lane) { return *(const bf16x8*)(img + (size_t)(idx0 + (lane & 15)) * ld + k0 + 8 * (lane >> 4)); }
DI s16x4 tr4(const LAS bf16* p) { return __builtin_bit_cast(s16x4, __builtin_amdgcn_ds_read_tr16_b64_v4i16((LAS v4i16_t*)p)); }
DI bf16x8 frag_tr(const LAS bf16* img, int ld, int k0, int idx0, int lane) {
    const int g = lane >> 4, q = (lane >> 2) & 3, p = lane & 3;
    const LAS bf16* a0 = img + (k0 + 8 * g + q) * ld + idx0 + 4 * p;
    const s16x4 lo = tr4(a0), hi = tr4(a0 + 4 * ld);
    return __builtin_shufflevector(lo, hi, 0, 1, 2, 3, 4, 5, 6, 7);
}
DI float wave_sum(float v) {
#pragma unroll
    for (int o = 1; o < 64; o <<= 1) v += __shfl_xor(v, o);
    return v;
}
#define LDS_WAIT() asm volatile("s_waitcnt lgkmcnt(0)" ::: "memory")
#define VM_WAIT() asm volatile("s_waitcnt vmcnt(0)" ::: "memory")

namespace pg8 {
constexpr int BM = 256, BK = 64, HALF = 128, HTB = HALF * BK * 2, STAGE_BYTES = 8 * HTB, NXCD = 8, WGM = 8;
__host__ __device__ __forceinline__ int lds_byte(int r, int c) { const int st = (r >> 4) * 2 + (c >> 5), rr = r & 15, cc = c & 31, ob = rr * 64 + cc * 2; return st * 1024 + (ob ^ (((ob >> 9) & 1) << 5)); }
__host__ __device__ __forceinline__ void stage_rc(int b, int& R, int& C) { const int st = b / 1024, sb = b % 1024, swz = sb ^ (((sb >> 9) & 1) << 5); R = (st >> 1) * 16 + swz / 64; C = (st & 1) * 32 + (swz % 64) / 2; }
__host__ __device__ __forceinline__ int perm32(int rho) { const int n = rho >> 4, i = rho & 15; return 8 * (i >> 2) + 4 * n + (i & 3); }

struct Unit { int pm, pn, gi; };

DI void static_tile(int L, int nM, int nN, int& pm, int& pn) {
    const int nwg = nM * nN; int wgid = L;
    { const int q = nwg / NXCD, r = nwg % NXCD, xcd = wgid % NXCD, off = wgid / NXCD; wgid = (xcd < r ? xcd * (q + 1) : r * (q + 1) + (xcd - r) * q) + off; }
    const int nig = WGM * nN, gid = wgid / nig, fm = gid * WGM, gsz = (nM - fm) < WGM ? (nM - fm) : WGM;
    pm = fm + ((wgid % nig) % gsz); pn = (wgid % nig) / gsz;
}
struct SchedStatic {
    int nM, nN, G, c; const char* A; const char* B; size_t astep, bstep;
    DI bool next(int i, Unit& u) const { const long L = (long)i * G + c; if (L >= (long)nM * nN) return false; static_tile((int)L, nM, nN, u.pm, u.pn); u.gi = 0; return true; }
    DI const char* abase(const Unit& u) const { return A + (size_t)u.pm * astep; }
    DI const char* bbase(const Unit& u) const { return B + (size_t)u.pn * bstep; }
};

template <class Epi, class Sched, int NB, bool ALIGN_EPI>
DI void gemm_phase(LAS unsigned char* lds, const int K, const Sched& S, const Epi& E) {
    const int tid = threadIdx.x, wid = __builtin_amdgcn_readfirstlane(tid >> 6), lane = tid & 63, wr = wid >> 2, wc = wid & 3, fr = lane & 15, fq = lane >> 4;
    const int nt = K / BK;
    unsigned voffA[2], voffB[2];
#pragma unroll
    for (int i = 0; i < 2; ++i) { int R, C; stage_rc(tid * 16 + i * 8192, R, C); const int Rb = Epi::PERM ? ((R & ~31) + perm32(R & 31)) : R;
        voffA[i] = (unsigned)(R * K + C) * 2u; voffB[i] = (unsigned)(Rb * K + C) * 2u; }
    const size_t kstep = (size_t)(BK * 2);
    const size_t hstep = (size_t)HALF * K * 2;
    const unsigned ldsw = (unsigned)wid * 1024u;
    const int aoff = lds_byte(wr * 64 + fr, fq * 8), boff = lds_byte(wc * 32 + fr, fq * 8);
#define PG8_SA(b, h) (((b) * 2 + (h)) * HTB)
#define PG8_SB(b, h) ((4 + (b) * 2 + (h)) * HTB)
#define PG8_STAGE(bufoff, gbase, voff) do { _Pragma("unroll") for (int _i = 0; _i < 2; ++_i) \
        __builtin_amdgcn_global_load_lds((const unsigned*)((const char*)(gbase) + (voff)[_i]), (LAS unsigned*)(lds + (bufoff) + ldsw + _i * 8192), 16, 0, 0); } while (0)
#define PG8_LDA(dst, b, h) do { _Pragma("unroll") for (int m = 0; m < 4; ++m) _Pragma("unroll") for (int k = 0; k < 2; ++k) dst[m][k] = *(const LAS bf16x8*)(lds + PG8_SA(b, h) + aoff + m * 2048 + k * 1024); } while (0)
#define PG8_LDB(dst, b, h) do { _Pragma("unroll") for (int n = 0; n < 2; ++n) _Pragma("unroll") for (int k = 0; k < 2; ++k) dst[n][k] = *(const LAS bf16x8*)(lds + PG8_SB(b, h) + boff + n * 2048 + k * 1024); } while (0)
#define PG8_MMA(ai, bj, At, Bt) do { __builtin_amdgcn_s_setprio(1); _Pragma("unroll") for (int m = 0; m < 4; ++m) _Pragma("unroll") for (int n = 0; n < 2; ++n) _Pragma("unroll") for (int k = 0; k < 2; ++k) \
        acc[ai][bj][m][n] = __builtin_amdgcn_mfma_f32_16x16x32_bf16(Bt[n][k], At[m][k], acc[ai][bj][m][n], 0, 0, 0); __builtin_amdgcn_s_setprio(0); } while (0)
#define PG8_WAIT_V(n) asm volatile("s_waitcnt vmcnt(" #n ")" ::: "memory")
#define PG8_WAIT_L(n) asm volatile("s_waitcnt lgkmcnt(" #n ")" ::: "memory")
#define PG8_BAR __builtin_amdgcn_s_barrier()
#define PG8_SCHED __builtin_amdgcn_sched_barrier(0)
#define PG8_WAIT_MAIN() do { if constexpr (NB == 2) PG8_WAIT_V(8); else PG8_WAIT_V(6); } while (0)
    Unit cur, nxt; int ui = 0;
    if (!S.next(0, cur)) return;
    f32x4 acc[2][NB][4][2];
    f32x4 yac[2][4][2];
#pragma unroll
    for (int a = 0; a < 2; ++a)
#pragma unroll
        for (int m = 0; m < 4; ++m)
#pragma unroll
            for (int n = 0; n < 2; ++n) { yac[a][m][n] = (f32x4){0.f, 0.f, 0.f, 0.f};
#pragma unroll
                for (int b = 0; b < NB; ++b) acc[a][b][m][n] = (f32x4){0.f, 0.f, 0.f, 0.f}; }
    bf16x8 At[4][2], B0[2][2], B1[2][2];
    const char* cA = S.abase(cur); const char* cB = S.bbase(cur);
    if constexpr (NB == 2) {
        PG8_STAGE(PG8_SB(0, 0), cB, voffB); PG8_STAGE(PG8_SB(0, 1), cB + hstep, voffB); PG8_STAGE(PG8_SA(0, 0), cA, voffA); PG8_STAGE(PG8_SA(0, 1), cA + hstep, voffA);
        if (wr == 1) PG8_BAR;
        PG8_WAIT_V(2); PG8_BAR;
        PG8_STAGE(PG8_SB(1, 0), cB + kstep, voffB); PG8_STAGE(PG8_SA(1, 0), cA + kstep, voffA); PG8_STAGE(PG8_SB(1, 1), cB + hstep + kstep, voffB);
        PG8_WAIT_V(6); PG8_BAR;
    } else {
        PG8_STAGE(PG8_SB(0, 0), cB, voffB); PG8_STAGE(PG8_SA(0, 0), cA, voffA); PG8_STAGE(PG8_SA(0, 1), cA + hstep, voffA);
        if (wr == 1) PG8_BAR;
        PG8_WAIT_V(2); PG8_BAR;
        PG8_STAGE(PG8_SB(1, 0), cB + kstep, voffB); PG8_STAGE(PG8_SA(1, 0), cA + kstep, voffA);
        PG8_WAIT_V(4); PG8_BAR;
    }
    for (;;) {
        const bool has_next = S.next(ui + 1, nxt);
        const char* nA = has_next ? S.abase(nxt) : cA; const char* nB = has_next ? S.bbase(nxt) : cB;
        for (int t = 0; t < nt; t += 2) {
            if constexpr (Epi::GATED) { if (t != 0 && (t & 15) == 0) { E.flush(acc, yac, cur, (t >> 4) - 1, wr, wc, fr, fq);
#pragma unroll
                for (int a = 0; a < 2; ++a)
#pragma unroll
                    for (int m = 0; m < 4; ++m)
#pragma unroll
                        for (int n = 0; n < 2; ++n) acc[a][0][m][n] = (f32x4){0.f, 0.f, 0.f, 0.f}; } }
            const bool last = (t == nt - 2);
            const char* a1 = cA + (size_t)(t + 1) * kstep;
            const char* a2 = last ? nA : cA + (size_t)(t + 2) * kstep; const char* b2 = last ? nB : cB + (size_t)(t + 2) * kstep;
            const char* a3 = a2 + kstep; const char* b3 = b2 + kstep;
            if constexpr (NB == 2) {
            PG8_LDB(B0, 0, 0); PG8_LDB(B1, 0, 1); PG8_SCHED; PG8_LDA(At, 0, 0); PG8_STAGE(PG8_SA(1, 1), a1 + hstep, voffA);
            PG8_WAIT_V(8); PG8_WAIT_L(0); PG8_BAR; PG8_MMA(0, 0, At, B0); PG8_MMA(0, 1, At, B1); PG8_BAR; PG8_SCHED;
            PG8_LDA(At, 0, 1); PG8_STAGE(PG8_SB(0, 0), b2, voffB); PG8_STAGE(PG8_SB(0, 1), b2 + hstep, voffB); PG8_STAGE(PG8_SA(0, 0), a2, voffA);
            PG8_WAIT_V(8); PG8_WAIT_L(0); PG8_BAR; PG8_MMA(1, 0, At, B0); PG8_MMA(1, 1, At, B1); PG8_BAR; PG8_SCHED;
            PG8_LDB(B0, 1, 0); PG8_LDB(B1, 1, 1); PG8_SCHED; PG8_LDA(At, 1, 0); PG8_STAGE(PG8_SA(0, 1), a2 + hstep, voffA);
            PG8_WAIT_V(8); PG8_WAIT_L(0); PG8_BAR; PG8_MMA(0, 0, At, B0); PG8_MMA(0, 1, At, B1); PG8_BAR; PG8_SCHED;
            PG8_LDA(At, 1, 1); PG8_STAGE(PG8_SB(1, 0), b3, voffB); PG8_STAGE(PG8_SB(1, 1), b3 + hstep, voffB); PG8_STAGE(PG8_SA(1, 0), a3, voffA);
            PG8_WAIT_V(8); PG8_WAIT_L(0); PG8_BAR; PG8_MMA(1, 0, At, B0); PG8_MMA(1, 1, At, B1); PG8_BAR; PG8_SCHED;
            } else {
            PG8_LDB(B0, 0, 0); PG8_SCHED; PG8_LDA(At, 0, 0); PG8_STAGE(PG8_SA(1, 1), a1 + hstep, voffA);
            PG8_WAIT_V(6); PG8_WAIT_L(0); PG8_BAR; PG8_MMA(0, 0, At, B0); PG8_BAR; PG8_SCHED;
            PG8_LDA(At, 0, 1); PG8_STAGE(PG8_SB(0, 0), b2, voffB); PG8_STAGE(PG8_SA(0, 0), a2, voffA);
            PG8_WAIT_V(6); PG8_WAIT_L(0); PG8_BAR; PG8_MMA(1, 0, At, B0); PG8_BAR; PG8_SCHED;
            PG8_LDB(B0, 1, 0); PG8_SCHED; PG8_LDA(At, 1, 0); PG8_STAGE(PG8_SA(0, 1), a2 + hstep, voffA);
            PG8_WAIT_V(6); PG8_WAIT_L(0); PG8_BAR; PG8_MMA(0, 0, At, B0); PG8_BAR; PG8_SCHED;
            PG8_LDA(At, 1, 1); PG8_STAGE(PG8_SB(1, 0), b3, voffB); PG8_STAGE(PG8_SA(1, 0), a3, voffA);
            PG8_WAIT_V(6); PG8_WAIT_L(0); PG8_BAR; PG8_MMA(1, 0, At, B0); PG8_BAR; PG8_SCHED;
            }
        }
        if constexpr (ALIGN_EPI) { if (wr == 0) PG8_BAR; }
        if constexpr (Epi::GATED) { E.finish(acc, yac, cur, wr, wc, fr, fq);
#pragma unroll
            for (int a = 0; a < 2; ++a)
#pragma unroll
                for (int m = 0; m < 4; ++m)
#pragma unroll
                    for (int n = 0; n < 2; ++n) yac[a][m][n] = (f32x4){0.f, 0.f, 0.f, 0.f};
        } else { E(acc, cur, wr, wc, fr, fq); }
        if (!has_next) break;
#pragma unroll
        for (int a = 0; a < 2; ++a)
#pragma unroll
            for (int b = 0; b < NB; ++b)
#pragma unroll
                for (int m = 0; m < 4; ++m)
#pragma unroll
                    for (int n = 0; n < 2; ++n) acc[a][b][m][n] = (f32x4){0.f, 0.f, 0.f, 0.f};
        cur = nxt; cA = nA; cB = nB; ++ui;
        if constexpr (ALIGN_EPI) { if (wr == 1) PG8_BAR; }
    }
    PG8_WAIT_V(0);
    if constexpr (!ALIGN_EPI) { if (wr == 0) PG8_BAR; }
    PG8_BAR;
#undef PG8_SA
#undef PG8_SB
#undef PG8_STAGE
#undef PG8_LDA
#undef PG8_LDB
#undef PG8_MMA
#undef PG8_WAIT_V
#undef PG8_WAIT_L
#undef PG8_BAR
#undef PG8_SCHED
#undef PG8_WAIT_MAIN
}
}

#define XB_TMO      128
#define XB_XCNT(j)  (256  + 64 * (j))
#define XB_XSUB(j)  (1280 + 64 * (j))
#define XB_XGEN(j)  (2304 + 64 * (j))
#define XB_TOP      3328
#define XB_TOPGEN   3392
#define XCD_BAR_WORDS 3456
#define XB_SPIN_CAP (1u << 18)
DI unsigned xb_ld(unsigned* p)              { return __hip_atomic_load(p, __ATOMIC_RELAXED, __HIP_MEMORY_SCOPE_AGENT); }
DI unsigned xb_add(unsigned* p, unsigned v) { return __hip_atomic_fetch_add(p, v, __ATOMIC_RELAXED, __HIP_MEMORY_SCOPE_AGENT); }
DI unsigned xb_xcc_id() { return (unsigned)__builtin_amdgcn_s_getreg((3 << 11) | 20) & 0xFu; }
#define XB_SPIN(cond, bar) do { unsigned _sp = 0; while (cond) { __builtin_amdgcn_s_sleep(1); \
    if ((++_sp & 255u) == 0u) { if (xb_ld(&(bar)[XB_TMO])) break; if (_sp > XB_SPIN_CAP) { atomicAdd(&(bar)[XB_TMO], 1u); break; } } } } while (0)
struct XcdBarrier { unsigned* bar; unsigned x; volatile LAS unsigned* st; };
DI XcdBarrier xcd_barrier_post(unsigned* bar, volatile LAS unsigned* st) {
    XcdBarrier b; b.bar = bar; b.x = xb_xcc_id(); b.st = st;
    if (threadIdx.x == 0) (void)xb_add(&bar[XB_XCNT(b.x)], 1u);
    return b;
}
DI void xcd_barrier_complete(unsigned* bar, unsigned x, unsigned& nloc, unsigned& nx) {
    const unsigned G = gridDim.x * gridDim.y * gridDim.z;
    unsigned sum, cnt, mine, sp = 0u;
    for (;;) {
        sum = 0u; cnt = 0u; mine = 0u;
#pragma unroll
        for (unsigned j = 0; j < 16; ++j) { const unsigned c = xb_ld(&bar[XB_XCNT(j)]); sum += c; cnt += (c > 0u) ? 1u : 0u; mine = (j == x) ? c : mine; }
        if (sum == G) break;
        __builtin_amdgcn_s_sleep(1);
        if ((++sp & 255u) == 0u) { if (xb_ld(&bar[XB_TMO])) break; if (sp > XB_SPIN_CAP) { atomicAdd(&bar[XB_TMO], 1u); break; } }
    }
    nloc = mine > 0u ? mine : 1u; nx = cnt > 0u ? cnt : 1u;
}
DI void xcd_barrier(const XcdBarrier& b) {
    asm volatile("s_waitcnt vmcnt(0)" ::: "memory");
    __syncthreads();
    if (threadIdx.x == 0) {
        unsigned* bar = b.bar;
        __builtin_amdgcn_s_waitcnt(0);
        unsigned nloc = b.st[0], nx = b.st[1];
        if (nloc == 0u) { xcd_barrier_complete(bar, b.x, nloc, nx); b.st[0] = nloc; b.st[1] = nx; }
        const unsigned old = xb_add(&bar[XB_XSUB(b.x)], 1u);
        const unsigned gen = old / nloc;
        if (old + 1u == (gen + 1u) * nloc) {
            __builtin_amdgcn_fence(__ATOMIC_RELEASE, "agent");
            asm volatile("s_waitcnt vmcnt(0)" ::: "memory");
            const unsigned og = xb_add(&bar[XB_TOP], 1u);
            const unsigned tg = og / nx;
            if (og + 1u == (tg + 1u) * nx) xb_add(&bar[XB_TOPGEN], 1u);
            else XB_SPIN(xb_ld(&bar[XB_TOPGEN]) == tg, bar);
            __builtin_amdgcn_fence(__ATOMIC_ACQUIRE, "agent");
            xb_add(&bar[XB_XGEN(b.x)], 1u);
            asm volatile("s_waitcnt vmcnt(0)" ::: "memory");
        } else {
            XB_SPIN(xb_ld(&bar[XB_XGEN(b.x)]) == gen, bar);
            __builtin_amdgcn_fence(__ATOMIC_ACQUIRE, "agent");
            asm volatile("s_waitcnt vmcnt(0)" ::: "memory");
        }
    }
    __syncthreads();
}

struct Frame {
    LAS unsigned char* lds;
    int tid, lane, wave, G, wg;
    float* out; unsigned char* ws;
};
template <class T> DI T* wsp(const Frame& F, size_t off) { return (T*)(F.ws + off); }

struct EpiH {
    static constexpr bool PERM = true, GATED = false;
    bf16* H; bf16* MK; bf16* MVT;
    DI void operator()(const f32x4 (&acc)[2][2][4][2], const pg8::Unit& u, int wr, int wc, int fr, int fq) const {
        bf16* base = H; size_t ldc = NH; int act = 0;
        if (u.gi == 0) { const int pn = u.pn; act = ((pn >= 4 && pn < 8) || (pn >= 16 && pn < 20) || (pn >= 25 && pn < 29) || (pn >= 33 && pn < 37)) ? 1 : ((pn >= 37 && pn < 101) ? 2 : 0); }
        else { const int lx = (u.gi - 1) >> 1, w = (u.gi - 1) & 1; if (w == 0) { base = MK + (size_t)lx * 512 * 1024; ldc = 1024; } else { base = MVT + (size_t)lx * 1024 * 512; ldc = 512; } }
        const int row0 = u.pm * 256 + wr * 64 + fr, col0 = u.pn * 256 + wc * 32 + 8 * fq;
#pragma unroll
        for (int ai = 0; ai < 2; ++ai)
#pragma unroll
            for (int m = 0; m < 4; ++m) { bf16* rowp = base + (size_t)(row0 + ai * 128 + m * 16) * ldc + col0;
#pragma unroll
                for (int bj = 0; bj < 2; ++bj) { f32x4 v0 = acc[ai][bj][m][0], v1 = acc[ai][bj][m][1];
                    if (act != 0) {
#pragma unroll
                        for (int j = 0; j < 4; ++j) { const float s0 = fast_sigmoid(v0[j]), s1 = fast_sigmoid(v1[j]); v0[j] = (act == 1) ? v0[j] * s0 : s0; v1[j] = (act == 1) ? v1[j] * s1 : s1; } }
                    u32x4 w; w.x = cvt_pk_bf16(v0[0], v0[1]); w.y = cvt_pk_bf16(v0[2], v0[3]); w.z = cvt_pk_bf16(v1[0], v1[1]); w.w = cvt_pk_bf16(v1[2], v1[3]);
                    *(u32x4*)(rowp + bj * 128) = w; } }
    }
};
struct EpiRes {
    static constexpr bool PERM = false, GATED = false;
    const float* __restrict__ res; float* __restrict__ out;
    DI void operator()(const f32x4 (&acc)[2][2][4][2], const pg8::Unit& u, int wr, int wc, int fr, int fq) const {
        const int row0 = u.pm * 256 + wr * 64 + fr, col0 = u.pn * 256 + wc * 32 + 4 * fq;
#pragma unroll
        for (int ai = 0; ai < 2; ++ai)
#pragma unroll
            for (int m = 0; m < 4; ++m) { const size_t ro = (size_t)(row0 + ai * 128 + m * 16) * DM + col0;
#pragma unroll
                for (int bj = 0; bj < 2; ++bj)
#pragma unroll
                    for (int n = 0; n < 2; ++n) { const size_t o = ro + bj * 128 + n * 16; const f32x4 r = *(const f32x4*)(res + o); *(f32x4*)(out + o) = r * DN_ALPHA + acc[ai][bj][m][n]; } }
    }
};
struct EpiGate {
    static constexpr bool PERM = true, GATED = true;
    const bf16* H; bf16* Y;
    DI void flush(const f32x4 (&acc)[2][1][4][2], f32x4 (&y)[2][4][2], const pg8::Unit& u, int bi, int wr, int wc, int fr, int fq) const {
        const int row0 = u.pm * 256 + wr * 64 + fr, col0 = u.pn * 128 + wc * 32 + 8 * fq;
#pragma unroll
        for (int ai = 0; ai < 2; ++ai)
#pragma unroll
            for (int m = 0; m < 4; ++m) { const u32x4 gw = *(const u32x4*)(H + (size_t)(row0 + ai * 128 + m * 16) * NH + C_MG + bi * DM + col0);
                float g[8]; unpack8(gw, g);
#pragma unroll
                for (int j = 0; j < 4; ++j) { y[ai][m][0][j] += g[j] * acc[ai][0][m][0][j]; y[ai][m][1][j] += g[4 + j] * acc[ai][0][m][1][j]; }
                if (m == 1 || m == 3) __builtin_amdgcn_sched_barrier(0); }
    }
    DI void finish(const f32x4 (&acc)[2][1][4][2], f32x4 (&y)[2][4][2], const pg8::Unit& u, int wr, int wc, int fr, int fq) const {
        flush(acc, y, u, 3, wr, wc, fr, fq);
        const int row0 = u.pm * 256 + wr * 64 + fr, col0 = u.pn * 128 + wc * 32 + 8 * fq;
#pragma unroll
        for (int ai = 0; ai < 2; ++ai)
#pragma unroll
            for (int m = 0; m < 4; ++m) { const f32x4 v0 = y[ai][m][0], v1 = y[ai][m][1];
                u32x4 w; w.x = cvt_pk_bf16(v0[0], v0[1]); w.y = cvt_pk_bf16(v0[2], v0[3]); w.z = cvt_pk_bf16(v1[0], v1[1]); w.w = cvt_pk_bf16(v1[2], v1[3]);
                *(u32x4*)(Y + (size_t)(row0 + ai * 128 + m * 16) * DM + col0) = w; }
    }
};
struct SchedInProj {
    int G, c, n_extra; const char *XB, *WT, *MEMB, *WKV;
    static constexpr int NM = 32, NN = 102, NU = NM * NN;
    static constexpr size_t TSTEP = (size_t)256 * 4096 * 2;
    DI bool next(int i, pg8::Unit& u) const {
        const long L = (long)i * G + c;
        if (L < NU) { pg8::static_tile((int)L, NM, NN, u.pm, u.pn); u.gi = 0; return true; }
        const int e = (int)(L - NU); if (e >= n_extra) return false;
        const int lx = e >> 4, r = e & 15;
        if (r < 8) { u.pm = r >> 2; u.pn = r & 3; u.gi = 1 + 2 * lx; } else { u.pm = (r - 8) >> 1; u.pn = (r - 8) & 1; u.gi = 2 + 2 * lx; }
        return true;
    }
    DI const char* abase(const pg8::Unit& u) const {
        if (u.gi == 0) return XB + (size_t)u.pm * TSTEP;
        const int lx = (u.gi - 1) >> 1, w = (u.gi - 1) & 1;
        return w == 0 ? MEMB + (size_t)u.pm * TSTEP : WKV + (size_t)lx * 2048 * 4096 * 2 + (size_t)(1024 + u.pm * 256) * 4096 * 2;
    }
    DI const char* bbase(const pg8::Unit& u) const {
        if (u.gi == 0) return WT + (size_t)u.pn * TSTEP;
        const int lx = (u.gi - 1) >> 1, w = (u.gi - 1) & 1;
        return w == 0 ? WKV + (size_t)lx * 2048 * 4096 * 2 + (size_t)u.pn * TSTEP : MEMB + (size_t)u.pn * TSTEP;
    }
};

DI int win_src_col(int n) { return n < 5120 ? n : (n < C_LR ? n + 16 : (n < C_LR + 16 ? n - C_LR + 5120 : -1)); }
template <bool WIN> DI void transpose_item(const float* W, size_t ldw, bf16* WT, size_t ldt, int k0, int n0, int kd0, LAS float* scr, int lane) {
    const int nn = lane & 31; int sc = n0 + nn; if (WIN) sc = win_src_col(sc);
    const float* src = W + (size_t)(k0 + (lane >> 5)) * ldw + (sc < 0 ? 0 : sc);
    float v[32];
#pragma unroll
    for (int i = 0; i < 32; ++i) v[i] = src[(size_t)(2 * i) * ldw];
#pragma unroll
    for (int i = 0; i < 32; ++i) scr[(2 * i + (lane >> 5)) * 33 + nn] = (sc < 0) ? 0.f : v[i];
    LDS_WAIT();
    const int c = lane & 7;
#pragma unroll
    for (int j = 0; j < 4; ++j) { const int n = (lane >> 3) + 8 * j; const LAS float* s = scr + (8 * c) * 33 + n;
        u32x4 o; o.x = pk2(s[0 * 33], s[1 * 33]); o.y = pk2(s[2 * 33], s[3 * 33]); o.z = pk2(s[4 * 33], s[5 * 33]); o.w = pk2(s[6 * 33], s[7 * 33]);
        *(u32x4*)(WT + (size_t)(n0 + n) * ldt + kd0 + 8 * c) = o; }
    LDS_WAIT();
}
DI void prologue(const Frame& F, const float* x, const float* mem, const int* pos, const float* w_in, const float* w_pool, const float* w_mem_kv, const float* w_branch, const float* w_out) {
    LAS float* scr = (LAS float*)(F.lds + F.wave * 16384);
    const int gw = F.wg * NWAVES + F.wave, NGW = F.G * NWAVES, lane = F.lane;
    constexpr int I_IN = 64 * (NH / 32), I_KV = 64 * 64, I_BR = 16 * 128, I_OUT = 64 * 128, I_PL = 4 * 8;
    constexpr int NITEMS = 2 * I_IN + 2 * I_KV + 8 * I_BR + 2 * I_OUT + 8 * I_PL;
    for (int it = gw; it < NITEMS; it += NGW) {
        int r = it;
        if (r < 2 * I_IN) { const int l = r / I_IN; r -= l * I_IN; const int nb = r >> 6, kb = r & 63;
            transpose_item<true>(w_in + (size_t)l * 4096 * D_IN, D_IN, wsp<bf16>(F, WS_WINT) + (size_t)l * NH * 4096, 4096, kb * 64, nb * 32, kb * 64, scr, lane); continue; }
        r -= 2 * I_IN;
        if (r < 2 * I_KV) { const int l = r / I_KV; r -= l * I_KV; const int nb = r >> 6, kb = r & 63;
            transpose_item<false>(w_mem_kv + (size_t)l * 4096 * 2048, 2048, wsp<bf16>(F, WS_WMKVT) + (size_t)l * 2048 * 4096, 4096, kb * 64, nb * 32, kb * 64, scr, lane); continue; }
        r -= 2 * I_KV;
        if (r < 8 * I_BR) { const int lb = r / I_BR; r -= lb * I_BR; const int l = lb >> 2, bi = lb & 3; const int nb = r >> 4, kb = r & 15;
            transpose_item<false>(w_branch + (size_t)lb * 1024 * 4096, 4096, wsp<bf16>(F, WS_WBRT) + (size_t)l * 4096 * 4096, 4096, kb * 64, nb * 32, bi * 1024 + kb * 64, scr, lane); continue; }
        r -= 8 * I_BR;
        if (r < 2 * I_OUT) { const int l = r / I_OUT; r -= l * I_OUT; const int nb = r >> 6, kb = r & 63;
            transpose_item<false>(w_out + (size_t)l * 4096 * 4096, 4096, wsp<bf16>(F, WS_WOUTT) + (size_t)l * 4096 * 4096, 4096, kb * 64, nb * 32, kb * 64, scr, lane); continue; }
        r -= 2 * I_OUT;
        { const int lg = r / I_PL; r -= lg * I_PL; const int nb = r >> 2, kb = r & 3;
            transpose_item<false>(w_pool + (size_t)lg * 256 * 256, 256, wsp<bf16>(F, WS_WPOOLT) + (size_t)lg * 256 * 256, 256, kb * 64, nb * 32, kb * 64, scr, lane); }
    }
    const size_t gt = (size_t)F.wg * NTHR + F.tid, GT = (size_t)F.G * NTHR;
    { const f32x4* xs = (const f32x4*)x; u32x4* xd = wsp<u32x4>(F, WS_XB);
      for (size_t i = gt; i < (size_t)MTOK * DM / 8; i += GT) { const f32x4 a = xs[2 * i], b = xs[2 * i + 1]; u32x4 o; o.x = pk2(a.x, a.y); o.y = pk2(a.z, a.w); o.z = pk2(b.x, b.y); o.w = pk2(b.z, b.w); xd[i] = o; }
      const f32x4* ms = (const f32x4*)mem; u32x4* md = wsp<u32x4>(F, WS_MEMB);
      for (size_t i = gt; i < (size_t)BATCH * MEMLEN * DM / 8; i += GT) { const f32x4 a = ms[2 * i], b = ms[2 * i + 1]; u32x4 o; o.x = pk2(a.x, a.y); o.y = pk2(a.z, a.w); o.z = pk2(b.x, b.y); o.w = pk2(b.z, b.w); md[i] = o; } }
    { f32x2* rt = wsp<f32x2>(F, WS_ROPE);
      for (size_t i = gt; i < (size_t)MTOK * 8; i += GT) { const int t = (int)(i >> 3), fi = (int)(i & 7);
          const float inv = (float)pow(500000.0, -(double)fi / 8.0); const float ang = (float)pos[t] * inv;
          rt[i] = (f32x2){cosf(ang), sinf(ang)}; } }
}

DI float logsigmoid_f(float z) { return fminf(z, 0.f) - log1pf(expf(-fabsf(z))); }

DI void gla_a_unit(const Frame& F, int l, int unit, const float* w_gla_up, const float* b_gla) {
    const int bh = unit >> 6, c = unit & 63, b = bh >> 2, h = bh & 3, t0 = b * SEQ + c * 64, tid = F.tid, lane = F.lane, wave = F.wave;
    const bf16* H = wsp<bf16>(F, WS_H);
    LAS float* lrs = (LAS float*)(F.lds);
    LAS float* bcs = (LAS float*)(F.lds + 4096);
    LAS float* seg = (LAS float*)(F.lds + 36864);
    LAS bf16* kds = (LAS bf16*)(F.lds + 40960);
    LAS bf16* vs = (LAS bf16*)(F.lds + 59392);
    constexpr int LDK = 136, LDV = 264;
    __syncthreads();
    if (tid < 128) { const int j = tid >> 1, hf = tid & 1; const u32x4 w = *(const u32x4*)(H + (size_t)(t0 + j) * NH + C_LR + 8 * hf); float f[8]; unpack8(w, f);
#pragma unroll
        for (int i = 0; i < 8; ++i) lrs[j * 16 + 8 * hf + i] = f[i]; }
    for (int p = tid; p < 64 * 32; p += NTHR) { const int j = p >> 5, ch = p & 31; *(LAS u32x4*)(vs + j * LDV + 8 * ch) = *(const u32x4*)(H + (size_t)(t0 + j) * NH + C_GV + h * 256 + 8 * ch); }
    __syncthreads();
    const int d = tid & 127, sg = tid >> 7;
    { float w[16];
#pragma unroll
      for (int r = 0; r < 16; ++r) w[r] = w_gla_up[(size_t)l * 16 * 512 + r * 512 + h * 128 + d];
      const float bg = b_gla[l * 512 + h * 128 + d]; float run = 0.f;
      for (int jj = 0; jj < 16; ++jj) { const int j = sg * 16 + jj; float z = bg;
#pragma unroll
          for (int r = 0; r < 16; ++r) z += lrs[j * 16 + r] * w[r];
          run += logsigmoid_f(z) * (1.0f / 16.0f); bcs[j * 128 + d] = run; }
      seg[sg * 128 + d] = run; }
    __syncthreads();
    { float pre = 0.f;
      for (int s = 0; s < sg; ++s) pre += seg[s * 128 + d];
      float* GB = wsp<float>(F, WS_GB);
      for (int jj = 0; jj < 16; ++jj) { const int j = sg * 16 + jj; const float v = bcs[j * 128 + d] + pre; bcs[j * 128 + d] = v; GB[(size_t)(t0 + j) * 512 + h * 128 + d] = v; }
      if (sg == 3) wsp<float>(F, WS_DEC)[(size_t)unit * 128 + d] = expf(bcs[63 * 128 + d]); }
    __syncthreads();
    for (int p = tid; p < 64 * 16; p += NTHR) { const int j = p >> 4, ch = p & 15; const u32x4 w = *(const u32x4*)(H + (size_t)(t0 + j) * NH + C_GK + h * 128 + 8 * ch); float f[8]; unpack8(w, f);
#pragma unroll
        for (int i = 0; i < 8; ++i) f[i] *= expf(bcs[63 * 128 + 8 * ch + i] - bcs[j * 128 + 8 * ch + i]);
        *(LAS u32x4*)(kds + j * LDK + 8 * ch) = pack8(f); }
    __syncthreads();
    f32x4 acc[2][8];
#pragma unroll
    for (int a = 0; a < 2; ++a)
#pragma unroll
        for (int n = 0; n < 8; ++n) acc[a][n] = (f32x4){0.f, 0.f, 0.f, 0.f};
#pragma unroll
    for (int ks = 0; ks < 2; ++ks) {
        bf16x8 af[2];
#pragma unroll
        for (int a = 0; a < 2; ++a) af[a] = frag_tr(vs, LDV, 32 * ks, 32 * wave + 16 * a, lane);
#pragma unroll
        for (int n = 0; n < 8; ++n) { const bf16x8 bfr = frag_tr(kds, LDK, 32 * ks, 16 * n, lane);
#pragma unroll
            for (int a = 0; a < 2; ++a) acc[a][n] = mma16(af[a], bfr, acc[a][n]); }
    }
    float* U = wsp<float>(F, WS_GU) + (size_t)unit * 256 * 128;
#pragma unroll
    for (int a = 0; a < 2; ++a)
#pragma unroll
        for (int n = 0; n < 8; ++n)
#pragma unroll
            for (int r = 0; r < 4; ++r) U[(size_t)(32 * wave + 16 * a + 4 * (lane >> 4) + r) * 128 + 16 * n + (lane & 15)] = acc[a][n][r];
}

DI void gla_scan(const Frame& F) {
    const float* U = wsp<float>(F, WS_GU); const float* DEC = wsp<float>(F, WS_DEC); unsigned* S = wsp<unsigned>(F, WS_GS);
    const int gt = F.wg * NTHR + F.tid, GT = F.G * NTHR;
    for (int it = gt; it < 8 * 256 * 64; it += GT) {
        const int bh = it >> 14, r = it & 16383, e = r >> 6, dp = r & 63;
        float s0 = 0.f, s1 = 0.f;
#pragma unroll 8
        for (int c = 0; c < 64; ++c) { const size_t un = (size_t)bh * 64 + c; const size_t o = (un * 256 + e) * 128 + 2 * dp;
            const f32x2 u = *(const f32x2*)(U + o); const f32x2 dc = *(const f32x2*)(DEC + un * 128 + 2 * dp);
            S[o >> 1] = pk2(s0, s1); s0 = dc.x * s0 + u.x; s1 = dc.y * s1 + u.y; }
    }
}

DI void gla_c_unit(const Frame& F, int l, int unit, const float* gla_norm) {
    const int bh = unit >> 6, c = unit & 63, b = bh >> 2, h = bh & 3, t0 = b * SEQ + c * 64, tid = F.tid, lane = F.lane, wave = F.wave;
    const bf16* H = wsp<bf16>(F, WS_H);
    LAS bf16* qs = (LAS bf16*)(F.lds);
    LAS bf16* ks = (LAS bf16*)(F.lds + 17408);
    LAS bf16* vs = (LAS bf16*)(F.lds + 34816);
    LAS bf16* ps = (LAS bf16*)(F.lds + 68608);
    LAS float* red = (LAS float*)(F.lds + 77824);
    constexpr int LDK = 136, LDV = 264, LDP = 72;
    __syncthreads();
    const float* GB = wsp<float>(F, WS_GB);
    for (int p = tid; p < 64 * 16; p += NTHR) { const int j = p >> 4, ch = p & 15;
        const u32x4 qw = *(const u32x4*)(H + (size_t)(t0 + j) * NH + C_GQ + h * 128 + 8 * ch); const u32x4 kw = *(const u32x4*)(H + (size_t)(t0 + j) * NH + C_GK + h * 128 + 8 * ch);
        const f32x4 b0 = *(const f32x4*)(GB + (size_t)(t0 + j) * 512 + h * 128 + 8 * ch), b1 = *(const f32x4*)(GB + (size_t)(t0 + j) * 512 + h * 128 + 8 * ch + 4);
        float q[8], k[8]; unpack8(qw, q); unpack8(kw, k); const float bb[8] = {b0.x, b0.y, b0.z, b0.w, b1.x, b1.y, b1.z, b1.w};
#pragma unroll
        for (int i = 0; i < 8; ++i) { const float eb = expf(bb[i]); q[i] *= eb * 0.08838834764831845f; k[i] *= expf(-bb[i]); }
        *(LAS u32x4*)(qs + j * LDK + 8 * ch) = pack8(q); *(LAS u32x4*)(ks + j * LDK + 8 * ch) = pack8(k); }
    for (int p = tid; p < 64 * 32; p += NTHR) { const int j = p >> 5, ch = p & 31; *(LAS u32x4*)(vs + j * LDV + 8 * ch) = *(const u32x4*)(H + (size_t)(t0 + j) * NH + C_GV + h * 256 + 8 * ch); }
    __syncthreads();
    { const int it = wave >> 1; f32x4 sa[2] = {(f32x4){0.f, 0.f, 0.f, 0.f}, (f32x4){0.f, 0.f, 0.f, 0.f}};
#pragma unroll
      for (int kk = 0; kk < 4; ++kk) { const bf16x8 qa = frag_lds(qs, LDK, 16 * it, 32 * kk, lane);
#pragma unroll
          for (int jj = 0; jj < 2; ++jj) sa[jj] = mma16(qa, frag_lds(ks, LDK, 16 * (2 * (wave & 1) + jj), 32 * kk, lane), sa[jj]); }
#pragma unroll
      for (int jj = 0; jj < 2; ++jj)
#pragma unroll
          for (int r = 0; r < 4; ++r) { const int i = 16 * it + 4 * (lane >> 4) + r, j = 16 * (2 * (wave & 1) + jj) + (lane & 15);
              ps[i * LDP + j] = (bf16)f2bf(j <= i ? sa[jj][r] : 0.f); } }
    __syncthreads();
    f32x4 acc[2][4];
#pragma unroll
    for (int a = 0; a < 2; ++a)
#pragma unroll
        for (int n = 0; n < 4; ++n) acc[a][n] = (f32x4){0.f, 0.f, 0.f, 0.f};
    const bf16* St = wsp<bf16>(F, WS_GS) + (size_t)unit * 256 * 128;
#pragma unroll
    for (int kk = 0; kk < 4; ++kk) { bf16x8 af[2];
#pragma unroll
        for (int a = 0; a < 2; ++a) af[a] = frag_glb(St, 128, 32 * wave + 16 * a, 32 * kk, lane);
#pragma unroll
        for (int n = 0; n < 4; ++n) { const bf16x8 bq = frag_lds(qs, LDK, 16 * n, 32 * kk, lane);
#pragma unroll
            for (int a = 0; a < 2; ++a) acc[a][n] = mma16(af[a], bq, acc[a][n]); } }
#pragma unroll
    for (int kk = 0; kk < 2; ++kk) { bf16x8 af[2];
#pragma unroll
        for (int a = 0; a < 2; ++a) af[a] = frag_tr(vs, LDV, 32 * kk, 32 * wave + 16 * a, lane);
#pragma unroll
        for (int n = 0; n < 4; ++n) { const bf16x8 bp = frag_lds(ps, LDP, 16 * n, 32 * kk, lane);
#pragma unroll
            for (int a = 0; a < 2; ++a) acc[a][n] = mma16(af[a], bp, acc[a][n]); } }
#pragma unroll
    for (int n = 0; n < 4; ++n) { float s = 0.f;
#pragma unroll
        for (int a = 0; a < 2; ++a)
#pragma unroll
            for (int r = 0; r < 4; ++r) s += acc[a][n][r] * acc[a][n][r];
        s += __shfl_xor(s, 16); s += __shfl_xor(s, 32);
        if (lane < 16) red[wave * 64 + 16 * n + lane] = s; }
    __syncthreads();
    bf16* OB = wsp<bf16>(F, WS_OB);
#pragma unroll
    for (int n = 0; n < 4; ++n) { const int i = 16 * n + (lane & 15); float tot = 0.f;
#pragma unroll
        for (int w = 0; w < 8; ++w) tot += red[w * 64 + i];
        const float rs = 1.0f / sqrtf(tot * (1.0f / 256.0f) + LN_EPS);
#pragma unroll
        for (int a = 0; a < 2; ++a) { const int e = 32 * wave + 16 * a + 4 * (lane >> 4);
            const f32x4 gn = *(const f32x4*)(gla_norm + l * 1024 + h * 256 + e);
            const u32x2 gw = *(const u32x2*)(H + (size_t)(t0 + i) * NH + C_GG + h * 256 + e);
            const float g0 = bf2f(gw.x & 0xffffu), g1 = bf2f(gw.x >> 16), g2 = bf2f(gw.y & 0xffffu), g3 = bf2f(gw.y >> 16);
            u32x2 o; o.x = pk2(acc[a][n][0] * rs * gn.x * g0, acc[a][n][1] * rs * gn.y * g1); o.y = pk2(acc[a][n][2] * rs * gn.z * g2, acc[a][n][3] * rs * gn.w * g3);
            *(u32x2*)(OB + (size_t)(t0 + i) * DM + 1024 + h * 256 + e) = o; } }
}

DI void pool_unit(const Frame& F, int l, int unit, const float* pool_scale) {
    const int gi = unit & 3, tt = unit >> 2, t0 = tt * 64, tid = F.tid, lane = F.lane, wave = F.wave, w = 2 << gi;
    const bf16* H = wsp<bf16>(F, WS_H);
    LAS bf16* pl = (LAS bf16*)(F.lds);
    constexpr int LDP = 264;
    __syncthreads();
    for (int p = tid; p < 64 * 32; p += NTHR) { const int j = p >> 5, ch = p & 31, t = t0 + j, ts = t & (SEQ - 1);
        const int cnt = (ts + 1 < w) ? ts + 1 : w; float a[8];
#pragma unroll
        for (int i = 0; i < 8; ++i) a[i] = 0.f;
        float u0[8];
        for (int s = 0; s < cnt; ++s) { const u32x4 x = *(const u32x4*)(H + (size_t)(t - s) * NH + C_PU + gi * 256 + 8 * ch); float f[8]; unpack8(x, f);
#pragma unroll
            for (int i = 0; i < 8; ++i) { a[i] += f[i]; if (s == 0) u0[i] = f[i]; } }
        const float ic = 1.0f / (float)cnt;
#pragma unroll
        for (int i = 0; i < 8; ++i) a[i] = a[i] * ic - u0[i];
        *(LAS u32x4*)(pl + j * LDP + 8 * ch) = pack8(a); }
    __syncthreads();
    const bf16* WP = wsp<bf16>(F, WS_WPOOLT) + (size_t)(l * 4 + gi) * 256 * 256;
    f32x4 acc[2][4];
#pragma unroll
    for (int a = 0; a < 2; ++a)
#pragma unroll
        for (int n = 0; n < 4; ++n) acc[a][n] = (f32x4){0.f, 0.f, 0.f, 0.f};
#pragma unroll 2
    for (int kk = 0; kk < 8; ++kk) { bf16x8 af[2];
#pragma unroll
        for (int a = 0; a < 2; ++a) af[a] = frag_glb(WP, 256, 32 * wave + 16 * a, 32 * kk, lane);
#pragma unroll
        for (int n = 0; n < 4; ++n) { const bf16x8 bp = frag_lds(pl, LDP, 16 * n, 32 * kk, lane);
#pragma unroll
            for (int a = 0; a < 2; ++a) acc[a][n] = mma16(af[a], bp, acc[a][n]); } }
    bf16* OB = wsp<bf16>(F, WS_OB);
#pragma unroll
    for (int n = 0; n < 4; ++n) { const int t = t0 + 16 * n + (lane & 15);
#pragma unroll
        for (int a = 0; a < 2; ++a) { const int dd = gi * 256 + 32 * wave + 16 * a + 4 * (lane >> 4);
            const f32x4 sc = *(const f32x4*)(pool_scale + l * 1024 + dd);
            const u32x2 gw = *(const u32x2*)(H + (size_t)t * NH + C_PG + dd);
            const float g0 = bf2f(gw.x & 0xffffu), g1 = bf2f(gw.x >> 16), g2 = bf2f(gw.y & 0xffffu), g3 = bf2f(gw.y >> 16);
            u32x2 o; o.x = pk2(acc[a][n][0] * sc.x * g0, acc[a][n][1] * sc.y * g1); o.y = pk2(acc[a][n][2] * sc.z * g2, acc[a][n][3] * sc.w * g3);
            *(u32x2*)(OB + (size_t)t * DM + dd) = o; } }
}

DI void swa_unit(const Frame& F, int l, int unit, const float* sinks) {
    const int n = unit & 31, hq = (unit >> 5) & 15, b = unit >> 9, kvh = hq >> 3, tid = F.tid, lane = F.lane, wave = F.wave;
    const int tq0 = b * SEQ + n * 128, tk0 = tq0 - 128;
    const bf16* H = wsp<bf16>(F, WS_H); const f32x2* RT = wsp<f32x2>(F, WS_ROPE);
    constexpr int LD = 72, LDPW = 168;
    LAS bf16* qs = (LAS bf16*)(F.lds);
    LAS bf16* ks = (LAS bf16*)(F.lds + 18432);
    LAS bf16* vs = (LAS bf16*)(F.lds + 57600);
    LAS bf16* pw = (LAS bf16*)(F.lds + 96768) + wave * 16 * LDPW;
    __syncthreads();
    for (int p = tid; p < 128 * 4; p += NTHR) { const int i = p >> 2, ch = p & 3; const bf16* src = H + (size_t)(tq0 + i) * NH + C_SQ + hq * 64 + 16 * ch;
        float f[16]; { float a[8], c[8]; unpack8(*(const u32x4*)src, a); unpack8(*(const u32x4*)(src + 8), c);
#pragma unroll
            for (int j = 0; j < 8; ++j) { f[j] = a[j]; f[8 + j] = c[j]; } }
        if (ch == 0) {
#pragma unroll
            for (int j = 0; j < 8; ++j) { const f32x2 cs = RT[(size_t)(tq0 + i) * 8 + j]; const float x1 = f[j], x2 = f[8 + j]; f[j] = x1 * cs.x - x2 * cs.y; f[8 + j] = x2 * cs.x + x1 * cs.y; } }
        float o0[8], o1[8];
#pragma unroll
        for (int j = 0; j < 8; ++j) { o0[j] = f[j] * 0.125f; o1[j] = f[8 + j] * 0.125f; }
        *(LAS u32x4*)(qs + i * LD + 16 * ch) = pack8(o0); *(LAS u32x4*)(qs + i * LD + 16 * ch + 8) = pack8(o1); }
    for (int p = tid; p < 272 * 4; p += NTHR) { const int j = p >> 2, ch = p & 3; const bool ok = (j < 256) && (n > 0 || j >= 128);
        u32x4 k0 = (u32x4){0u, 0u, 0u, 0u}, k1 = k0, v0 = k0, v1 = k0;
        if (ok) { const bf16* ksrc = H + (size_t)(tk0 + j) * NH + C_SK + kvh * 64 + 16 * ch; const bf16* vsrc = H + (size_t)(tk0 + j) * NH + C_SV + kvh * 64 + 16 * ch;
            k0 = *(const u32x4*)ksrc; k1 = *(const u32x4*)(ksrc + 8); v0 = *(const u32x4*)vsrc; v1 = *(const u32x4*)(vsrc + 8);
            if (ch == 0) { float a[8], c[8]; unpack8(k0, a); unpack8(k1, c);
#pragma unroll
                for (int jj = 0; jj < 8; ++jj) { const f32x2 cs = RT[(size_t)(tk0 + j) * 8 + jj]; const float x1 = a[jj], x2 = c[jj]; a[jj] = x1 * cs.x - x2 * cs.y; c[jj] = x2 * cs.x + x1 * cs.y; }
                k0 = pack8(a); k1 = pack8(c); } }
        *(LAS u32x4*)(ks + j * LD + 16 * ch) = k0; *(LAS u32x4*)(ks + j * LD + 16 * ch + 8) = k1;
        *(LAS u32x4*)(vs + j * LD + 16 * ch) = v0; *(LAS u32x4*)(vs + j * LD + 16 * ch + 8) = v1; }
    __syncthreads();
    const int qi = 16 * wave + (lane & 15);
    bf16x8 qf[2];
#pragma unroll
    for (int s = 0; s < 2; ++s) qf[s] = frag_lds(qs, LD, 16 * wave, 32 * s, lane);
    f32x4 sc[10];
#pragma unroll
    for (int jt = 0; jt < 10; ++jt) { sc[jt] = (f32x4){0.f, 0.f, 0.f, 0.f};
#pragma unroll
        for (int s = 0; s < 2; ++s) sc[jt] = mma16(frag_lds(ks, LD, 16 * (wave + jt), 32 * s, lane), qf[s], sc[jt]); }
    const float sink = sinks[l * 16 + hq];
    float mx = sink;
#pragma unroll
    for (int jt = 0; jt < 10; ++jt)
#pragma unroll
        for (int r = 0; r < 4; ++r) { const int kj = 16 * (wave + jt) + 4 * (lane >> 4) + r; const bool ok = (kj > qi) && (kj <= qi + 128) && (n > 0 || kj >= 128);
            sc[jt][r] = ok ? sc[jt][r] : -INFINITY; mx = fmaxf(mx, sc[jt][r]); }
    mx = fmaxf(mx, __shfl_xor(mx, 16)); mx = fmaxf(mx, __shfl_xor(mx, 32));
    float sum = 0.f;
#pragma unroll
    for (int jt = 0; jt < 10; ++jt)
#pragma unroll
        for (int r = 0; r < 4; ++r) { const float p = expf(sc[jt][r] - mx); sc[jt][r] = p; sum += p; }
    sum += __shfl_xor(sum, 16); sum += __shfl_xor(sum, 32);
    const float inv = 1.0f / (sum + expf(sink - mx));
#pragma unroll
    for (int jt = 0; jt < 10; ++jt) { u32x2 o; o.x = pk2(sc[jt][0] * inv, sc[jt][1] * inv); o.y = pk2(sc[jt][2] * inv, sc[jt][3] * inv);
        *(LAS u32x2*)(pw + (lane & 15) * LDPW + 16 * jt + 4 * (lane >> 4)) = o; }
    LDS_WAIT();
    f32x4 oa[4];
#pragma unroll
    for (int dt = 0; dt < 4; ++dt) oa[dt] = (f32x4){0.f, 0.f, 0.f, 0.f};
#pragma unroll
    for (int s = 0; s < 5; ++s) { const bf16x8 pf = frag_lds(pw, LDPW, 0, 32 * s, lane);
#pragma unroll
        for (int dt = 0; dt < 4; ++dt) oa[dt] = mma16(frag_tr(vs, LD, 16 * wave + 32 * s, 16 * dt, lane), pf, oa[dt]); }
    bf16* OB = wsp<bf16>(F, WS_OB);
    { const int t = tq0 + qi;
#pragma unroll
      for (int dt = 0; dt < 4; ++dt) { const int dd = hq * 64 + 16 * dt + 4 * (lane >> 4);
          const u32x2 gw = *(const u32x2*)(H + (size_t)t * NH + C_SG + dd);
          const float g0 = bf2f(gw.x & 0xffffu), g1 = bf2f(gw.x >> 16), g2 = bf2f(gw.y & 0xffffu), g3 = bf2f(gw.y >> 16);
          u32x2 o; o.x = pk2(oa[dt][0] * g0, oa[dt][1] * g1); o.y = pk2(oa[dt][2] * g2, oa[dt][3] * g3);
          *(u32x2*)(OB + (size_t)t * DM + 2048 + dd) = o; } }
}

DI void mem_unit(const Frame& F, int l, int unit) {
    const int n = unit & 31, hx = (unit >> 5) & 3, b = unit >> 7, lane = F.lane, wave = F.wave;
    const int tq0 = b * SEQ + n * 128 + 16 * wave;
    const bf16* H = wsp<bf16>(F, WS_H);
    const bf16* MK = wsp<bf16>(F, WS_MK) + (size_t)l * 512 * 1024 + (size_t)b * 256 * 1024 + hx * 256;
    const bf16* MVT = wsp<bf16>(F, WS_MVT) + (size_t)l * 1024 * 512 + (size_t)hx * 256 * 512 + b * 256;
    constexpr int LDPW = 264;
    LAS bf16* pw = (LAS bf16*)(F.lds) + wave * 16 * LDPW;
    __syncthreads();
    bf16x8 qf[8];
#pragma unroll
    for (int s = 0; s < 8; ++s) qf[s] = frag_glb(H + C_XQ + hx * 256, NH, tq0, 32 * s, lane);
    f32x4 sc[16];
#pragma unroll
    for (int jt = 0; jt < 16; ++jt) { sc[jt] = (f32x4){0.f, 0.f, 0.f, 0.f};
#pragma unroll
        for (int s = 0; s < 8; ++s) sc[jt] = mma16(frag_glb(MK, 1024, 16 * jt, 32 * s, lane), qf[s], sc[jt]); }
    float mx = -INFINITY;
#pragma unroll
    for (int jt = 0; jt < 16; ++jt)
#pragma unroll
        for (int r = 0; r < 4; ++r) { sc[jt][r] *= 0.0625f; mx = fmaxf(mx, sc[jt][r]); }
    mx = fmaxf(mx, __shfl_xor(mx, 16)); mx = fmaxf(mx, __shfl_xor(mx, 32));
    float sum = 0.f;
#pragma unroll
    for (int jt = 0; jt < 16; ++jt)
#pragma unroll
        for (int r = 0; r < 4; ++r) { const float p = expf(sc[jt][r] - mx); sc[jt][r] = p; sum += p; }
    sum += __shfl_xor(sum, 16); sum += __shfl_xor(sum, 32);
    const float inv = 1.0f / sum;
#pragma unroll
    for (int jt = 0; jt < 16; ++jt) { u32x2 o; o.x = pk2(sc[jt][0] * inv, sc[jt][1] * inv); o.y = pk2(sc[jt][2] * inv, sc[jt][3] * inv);
        *(LAS u32x2*)(pw + (lane & 15) * LDPW + 16 * jt + 4 * (lane >> 4)) = o; }
    LDS_WAIT();
    bf16x8 pf[8];
#pragma unroll
    for (int s = 0; s < 8; ++s) pf[s] = frag_lds(pw, LDPW, 0, 32 * s, lane);
    bf16* OB = wsp<bf16>(F, WS_OB); const int t = tq0 + (lane & 15);
#pragma unroll 4
    for (int dt = 0; dt < 16; ++dt) { f32x4 oa = (f32x4){0.f, 0.f, 0.f, 0.f};
#pragma unroll
        for (int s = 0; s < 8; ++s) oa = mma16(frag_glb(MVT, 512, 16 * dt, 32 * s, lane), pf[s], oa);
        const int dd = hx * 256 + 16 * dt + 4 * (lane >> 4);
        const u32x2 gw = *(const u32x2*)(H + (size_t)t * NH + C_XG + dd);
        const float g0 = bf2f(gw.x & 0xffffu), g1 = bf2f(gw.x >> 16), g2 = bf2f(gw.y & 0xffffu), g3 = bf2f(gw.y >> 16);
        u32x2 o; o.x = pk2(oa[0] * g0, oa[1] * g1); o.y = pk2(oa[2] * g2, oa[3] * g3);
        *(u32x2*)(OB + (size_t)t * DM + 3072 + dd) = o; }
}

DI void ln_phase(const Frame& F, int l, const float* ln_g, const float* ln_b) {
    const int gw = F.wg * NWAVES + F.wave, NGW = F.G * NWAVES, lane = F.lane;
    const float* g = ln_g + l * DM; const float* bb = ln_b + l * DM;
    for (int m = gw; m < MTOK; m += NGW) {
        f32x4* row = (f32x4*)(F.out + (size_t)m * DM) + lane; const f32x4* zrow = (const f32x4*)(wsp<float>(F, WS_Z) + (size_t)m * DM) + lane;
        f32x4 v[16]; float s = 0.f;
#pragma unroll
        for (int j = 0; j < 16; ++j) { v[j] = zrow[64 * j]; s += (v[j].x + v[j].y) + (v[j].z + v[j].w); }
        const float mean = wave_sum(s) * (1.f / DM); float s2 = 0.f;
#pragma unroll
        for (int j = 0; j < 16; ++j) { v[j] = v[j] - mean; s2 += (v[j].x * v[j].x + v[j].y * v[j].y) + (v[j].z * v[j].z + v[j].w * v[j].w); }
        const float rstd = 1.f / sqrtf(wave_sum(s2) * (1.f / DM) + LN_EPS);
        u32x2* xb = (u32x2*)(wsp<bf16>(F, WS_XB) + (size_t)m * DM) + lane;
#pragma unroll
        for (int j = 0; j < 16; ++j) { const f32x4 gg = *((const f32x4*)g + lane + 64 * j), be = *((const f32x4*)bb + lane + 64 * j);
            const f32x4 o = v[j] * rstd * gg + be; row[64 * j] = o;
            if (l + 1 < DEPTH) { u32x2 w; w.x = pk2(o.x, o.y); w.y = pk2(o.z, o.w); xb[64 * j] = w; } }
    }
}

struct Args { const void* in[15]; float* out; unsigned char* ws; int ph_lo, ph_hi; };
constexpr int PH_PER_LAYER = 7, N_PHASES = 1 + PH_PER_LAYER * DEPTH;
#define IN(k) (lo <= (k) && (k) < hi)
#ifndef PH_MASK
#define PH_MASK 0xffff
#endif
#define PHM(b) ((PH_MASK >> (b)) & 1)
#define SEAM(k) do { if (IN(k) && IN((k) + 1)) xcd_barrier(bar); } while (0)
template <int l> DI void layer_body(const Frame& F, const Args& args, const int lo, const int hi, const XcdBarrier& bar) {
        const int p0 = 1 + PH_PER_LAYER * l;
        if (PHM(1) && IN(p0)) {
            SchedInProj S; S.G = F.G; S.c = F.wg; S.n_extra = (l == 0) ? 32 : 0; S.XB = (const char*)(F.ws + WS_XB); S.WT = (const char*)(F.ws + WS_WINT) + (size_t)l * NH * 4096 * 2;
            S.MEMB = (const char*)(F.ws + WS_MEMB); S.WKV = (const char*)(F.ws + WS_WMKVT);
            EpiH E{wsp<bf16>(F, WS_H), wsp<bf16>(F, WS_MK), wsp<bf16>(F, WS_MVT)};
            pg8::gemm_phase<EpiH, SchedInProj, 2, true>(F.lds, 4096, S, E);
        }
        SEAM(p0);
        if (PHM(2) && IN(p0 + 1)) { for (int u = F.wg; u < 512; u += F.G) gla_a_unit(F, l, u, (const float*)args.in[6], (const float*)args.in[7]); }
        SEAM(p0 + 1);
        if (PHM(3) && IN(p0 + 2)) { gla_scan(F); }
        SEAM(p0 + 2);
        if (PHM(4) && IN(p0 + 3)) {
            for (int u = F.wg; u < 512; u += F.G) gla_c_unit(F, l, u, (const float*)args.in[8]);
            for (int u = F.wg; u < 512; u += F.G) pool_unit(F, l, u, (const float*)args.in[5]);
            for (int u = F.wg; u < 1024; u += F.G) swa_unit(F, l, u, (const float*)args.in[9]);
            for (int u = F.wg; u < 256; u += F.G) mem_unit(F, l, u);
            __syncthreads();
        }
        SEAM(p0 + 3);
        if (PHM(5) && IN(p0 + 4)) {
            pg8::SchedStatic S; S.nM = 32; S.nN = 32; S.G = F.G; S.c = F.wg; S.A = (const char*)(F.ws + WS_OB); S.B = (const char*)(F.ws + WS_WBRT) + (size_t)l * 4096 * 4096 * 2;
            S.astep = (size_t)256 * 4096 * 2; S.bstep = (size_t)128 * 4096 * 2;
            EpiGate E{wsp<bf16>(F, WS_H), wsp<bf16>(F, WS_YB)};
            pg8::gemm_phase<EpiGate, pg8::SchedStatic, 1, false>(F.lds, 4096, S, E);
        }
        SEAM(p0 + 4);
        if (PHM(6) && IN(p0 + 5)) {
            pg8::SchedStatic S; S.nM = 32; S.nN = 16; S.G = F.G; S.c = F.wg; S.A = (const char*)(F.ws + WS_YB); S.B = (const char*)(F.ws + WS_WOUTT) + (size_t)l * 4096 * 4096 * 2;
            S.astep = (size_t)256 * 4096 * 2; S.bstep = (size_t)256 * 4096 * 2;
            EpiRes E{l == 0 ? (const float*)args.in[0] : (const float*)F.out, wsp<float>(F, WS_Z)};
            pg8::gemm_phase<EpiRes, pg8::SchedStatic, 2, true>(F.lds, 4096, S, E);
        }
        SEAM(p0 + 5);
        if (PHM(7) && IN(p0 + 6)) { ln_phase(F, l, (const float*)args.in[13], (const float*)args.in[14]); }
        SEAM(p0 + 6);
}


__global__ void __launch_bounds__(NTHR, 2) mk_fwd(Args args) {
    extern __shared__ __attribute__((aligned(16))) unsigned char lds_raw[];
    Frame F;
    F.lds = (LAS unsigned char*)lds_raw;
    F.tid = threadIdx.x; F.lane = F.tid & 63; F.wave = __builtin_amdgcn_readfirstlane(F.tid >> 6); F.G = gridDim.x; F.wg = blockIdx.x;
    F.out = args.out; F.ws = args.ws;
    volatile LAS unsigned* MISC = (volatile LAS unsigned*)(F.lds + MISC_OFF);
    for (int u = F.tid; u < (LDS_BYTES - LDSCTL_OFF) / 4; u += NTHR) ((LAS unsigned*)(F.lds + LDSCTL_OFF))[u] = 0u;
    __syncthreads();
    unsigned* barw = (unsigned*)(F.ws + WS_CTL) + CW_BAR;
    XcdBarrier bar; bar.bar = barw; bar.x = 0; bar.st = nullptr;
    const int lo = args.ph_lo, hi = args.ph_hi;
    if (hi - lo > 1) bar = xcd_barrier_post(barw, MISC + 8);

    if (PHM(0) && IN(0)) { prologue(F, (const float*)args.in[0], (const float*)args.in[1], (const int*)args.in[2], (const float*)args.in[3], (const float*)args.in[4], (const float*)args.in[10], (const float*)args.in[11], (const float*)args.in[12]); }
    SEAM(0);
    layer_body<0>(F, args, lo, hi, bar);
    layer_body<1>(F, args, lo, hi, bar);
#undef IN
#undef SEAM
}

extern "C" void kernel_launch(void* const* d_in, const int* in_sizes, int n_in, void* d_out, int out_size, void* d_ws, size_t ws_size, hipStream_t stream) {
    static int grid = 0;
    if (grid == 0) {
        if (n_in != 15 || out_size != MTOK * DM || ws_size < WS_END) { fprintf(stderr, "kernel_launch: unexpected sizes (n_in %d, out %d, ws %zu); nothing launched\n", n_in, out_size, ws_size); grid = -1; return; }
        int dev = 0, cus = 0, per_cu = 0;
        if (hipGetDevice(&dev) != hipSuccess || hipDeviceGetAttribute(&cus, hipDeviceAttributeMultiprocessorCount, dev) != hipSuccess) { grid = -1; return; }
        if (hipFuncSetAttribute((const void*)mk_fwd, hipFuncAttributeMaxDynamicSharedMemorySize, LDS_BYTES) != hipSuccess) { fprintf(stderr, "kernel_launch: hipFuncSetAttribute failed\n"); grid = -1; return; }
        if (hipOccupancyMaxActiveBlocksPerMultiprocessor(&per_cu, (const void*)mk_fwd, NTHR, LDS_BYTES) != hipSuccess || per_cu < 1) fprintf(stderr, "kernel_launch: occupancy query says %d\n", per_cu);
        (void)hipGetLastError();
        grid = cus;
    }
    if (grid < 0) return;
    (void)hipMemsetAsync((char*)d_ws + WS_CTL, 0, CTL_ZERO_BYTES, stream);
    Args a{};
    for (int i = 0; i < 15; ++i) a.in[i] = d_in[i];
    a.out = (float*)d_out; a.ws = (unsigned char*)d_ws;
#if MK_PER_PHASE
    for (int p = 0; p < N_PHASES; ++p) { a.ph_lo = p; a.ph_hi = p + 1; hipLaunchKernelGGL(mk_fwd, dim3(grid), dim3(NTHR), LDS_BYTES, stream, a); }
#else
    a.ph_lo = 0; a.ph_hi = N_PHASES;
    hipLaunchKernelGGL(mk_fwd, dim3(grid), dim3(NTHR), LDS_BYTES, stream, a);
#endif
}
```

```cpp
#include <hip/hip_runtime.h>
#include <cstdio>
#include <cstdint>

#ifndef F8ASM1
#define F8ASM1 0
#endif
#ifndef F8NB
#define F8NB 1
#endif
#ifndef MK_PER_PHASE
#define MK_PER_PHASE 0
#endif

#define DI __device__ __forceinline__
#define LAS __attribute__((address_space(3)))
#define GAS __attribute__((address_space(1)))
typedef unsigned short bf16;
typedef short bf16x8 __attribute__((ext_vector_type(8)));
typedef short s16x4 __attribute__((ext_vector_type(4)));
typedef short v4i16_t __attribute__((ext_vector_type(4)));
typedef float f32x4 __attribute__((ext_vector_type(4)));
typedef float f32x2 __attribute__((ext_vector_type(2)));
typedef unsigned u32x4 __attribute__((ext_vector_type(4)));
typedef unsigned u32x2 __attribute__((ext_vector_type(2)));

constexpr int BATCH = 2, SEQ = 4096, DM = 4096, MTOK = BATCH * SEQ, DEPTH = 2;
constexpr int D_IN = 25872, NH = 26112;
constexpr int BW = 1024;
constexpr int MEMLEN = 256;
constexpr int C_PU = 0, C_PG = 1024, C_GQ = 2048, C_GK = 2560, C_GV = 3072, C_GG = 4096, C_SQ = 5120, C_SK = 6144, C_SV = 6272, C_SG = 6400, C_XQ = 7424, C_XG = 8448, C_MG = 9472, C_LR = 25856;
constexpr float LN_EPS = 1e-5f;
constexpr float DN_ALPHA = 1.41421356237309515f;

constexpr size_t MiB = 1u << 20;
constexpr size_t WS_CTL = 0, CTL_ZERO_BYTES = 1 * MiB;
constexpr size_t WS_ROPE = 1 * MiB;
constexpr size_t WS_WPOOLT = 2 * MiB;
constexpr size_t WS_MEMB = 4 * MiB;
constexpr size_t WS_MK = 8 * MiB;
constexpr size_t WS_MVT = 10 * MiB;
constexpr size_t WS_DEC = 12 * MiB;
constexpr size_t WS_WMKVT = 16 * MiB;
constexpr size_t WS_WBRT = 48 * MiB;
constexpr size_t WS_WOUTT = 112 * MiB;
constexpr size_t WS_XB = 176 * MiB;
constexpr size_t WS_OB = 240 * MiB;
constexpr size_t WS_YB = 304 * MiB;
constexpr size_t WS_GU = 368 * MiB;
constexpr size_t WS_GS = 432 * MiB;
constexpr size_t WS_GB = 464 * MiB;
constexpr size_t WS_WINT = 512 * MiB;
constexpr size_t WS_H = 928 * MiB;
constexpr size_t WS_Z = 1336 * MiB;
constexpr size_t WS_X8 = 1464 * MiB;
constexpr size_t WS_W8 = 1496 * MiB;
constexpr size_t WS_END = 1624 * MiB;
constexpr float X8_SCALE = 16.0f, W8_SCALE = 2048.0f, MG_DESCALE = 1.0f / (16.0f * 2048.0f);
constexpr int CW_BAR = 4096;

constexpr int RING_BYTES = 131072;
constexpr int THIN_BYTES = 141312;
constexpr int LDSCTL_OFF = THIN_BYTES, MISC_OFF = LDSCTL_OFF + 320;
constexpr int LDS_BYTES = 147456;
constexpr int NWAVES = 8, NTHR = 512;

DI float bf2f(unsigned v) { return __builtin_bit_cast(float, v << 16); }
DI unsigned f2bf(float f) { unsigned u = __builtin_bit_cast(unsigned, f); return (u + 0x7fffu + ((u >> 16) & 1u)) >> 16; }
DI unsigned pk2(float lo, float hi) { return f2bf(lo) | (f2bf(hi) << 16); }
DI unsigned cvt_pk_bf16(float lo, float hi) { unsigned r; asm volatile("v_cvt_pk_bf16_f32 %0, %1, %2" : "=v"(r) : "v"(lo), "v"(hi)); return r; }
DI float fast_sigmoid(float v) { return __builtin_amdgcn_rcpf(1.0f + __builtin_amdgcn_exp2f(-1.44269504089f * v)); }
DI void unpack8(const u32x4 w, float (&f)[8]) {
    f[0] = bf2f(w.x & 0xffffu); f[1] = bf2f(w.x >> 16); f[2] = bf2f(w.y & 0xffffu); f[3] = bf2f(w.y >> 16);
    f[4] = bf2f(w.z & 0xffffu); f[5] = bf2f(w.z >> 16); f[6] = bf2f(w.w & 0xffffu); f[7] = bf2f(w.w >> 16);
}
DI u32x4 pack8(const float (&f)[8]) { u32x4 w; w.x = pk2(f[0], f[1]); w.y = pk2(f[2], f[3]); w.z = pk2(f[4], f[5]); w.w = pk2(f[6], f[7]); return w; }
DI float clamp448(float v) { return fminf(fmaxf(v, -448.0f), 448.0f); }
DI unsigned pk4_fp8(float a, float b, float c, float d) {
    int w = 0; w = __builtin_amdgcn_cvt_pk_fp8_f32(clamp448(a), clamp448(b), w, false); w = __builtin_amdgcn_cvt_pk_fp8_f32(clamp448(c), clamp448(d), w, true); return (unsigned)w; }
typedef int v8i32 __attribute__((ext_vector_type(8)));
DI f32x4 mma16(bf16x8 a, bf16x8 b, f32x4 c) { return __builtin_amdgcn_mfma_f32_16x16x32_bf16(a, b, c, 0, 0, 0); }
DI bf16x8 frag_lds(const LAS bf16* img, int ld, int idx0, int k0, int lane) { return *(const LAS bf16x8*)(img + (idx0 + (lane & 15)) * ld + k0 + 8 * (lane >> 4)); }
DI bf16x8 frag_glb(const bf16* img, size_t ld, int idx0, int k0, int lane) { return *(const bf16x8*)(img + (size_t)(idx0 + (lane & 15)) * ld + k0 + 8 * (lane >> 4)); }
DI s16x4 tr4(const LAS bf16* p) { return __builtin_bit_cast(s16x4, __builtin_amdgcn_ds_read_tr16_b64_v4i16((LAS v4i16_t*)p)); }
DI bf16x8 frag_tr(const LAS bf16* img, int ld, int k0, int idx0, int lane) {
    const int g = lane >> 4, q = (lane >> 2) & 3, p = lane & 3;
    const LAS bf16* a0 = img + (k0 + 8 * g + q) * ld + idx0 + 4 * p;
    const s16x4 lo = tr4(a0), hi = tr4(a0 + 4 * ld);
    return __builtin_shufflevector(lo, hi, 0, 1, 2, 3, 4, 5, 6, 7);
}
DI float wave_sum(float v) {
#pragma unroll
    for (int o = 1; o < 64; o <<= 1) v += __shfl_xor(v, o);
    return v;
}
#define LDS_WAIT() asm volatile("s_waitcnt lgkmcnt(0)" ::: "memory")
#define VM_WAIT() asm volatile("s_waitcnt vmcnt(0)" ::: "memory")

namespace pg8 {
constexpr int BM = 256, BK = 64, HALF = 128, HTB = HALF * BK * 2, STAGE_BYTES = 8 * HTB, NXCD = 8, WGM = 8;
__host__ __device__ __forceinline__ int lds_byte(int r, int c) { const int st = (r >> 4) * 2 + (c >> 5), rr = r & 15, cc = c & 31, ob = rr * 64 + cc * 2; return st * 1024 + (ob ^ (((ob >> 9) & 1) << 5)); }
__host__ __device__ __forceinline__ void stage_rc(int b, int& R, int& C) { const int st = b / 1024, sb = b % 1024, swz = sb ^ (((sb >> 9) & 1) << 5); R = (st >> 1) * 16 + swz / 64; C = (st & 1) * 32 + (swz % 64) / 2; }
__host__ __device__ __forceinline__ int perm32(int rho) { const int n = rho >> 4, i = rho & 15; return 8 * (i >> 2) + 4 * n + (i & 3); }

struct Unit { int pm, pn, gi; };

DI void static_tile(int L, int nM, int nN, int& pm, int& pn) {
    const int nwg = nM * nN; int wgid = L;
    { const int q = nwg / NXCD, r = nwg % NXCD, xcd = wgid % NXCD, off = wgid / NXCD; wgid = (xcd < r ? xcd * (q + 1) : r * (q + 1) + (xcd - r) * q) + off; }
    const int nig = WGM * nN, gid = wgid / nig, fm = gid * WGM, gsz = (nM - fm) < WGM ? (nM - fm) : WGM;
    pm = fm + ((wgid % nig) % gsz); pn = (wgid % nig) / gsz;
}
struct SchedStatic {
    int nM, nN, G, c; const char* A; const char* B; size_t astep, bstep;
    DI bool next(int i, Unit& u) const { const long L = (long)i * G + c; if (L >= (long)nM * nN) return false; static_tile((int)L, nM, nN, u.pm, u.pn); u.gi = 0; return true; }
    DI const char* abase(const Unit& u) const { return A + (size_t)u.pm * astep; }
    DI const char* bbase(const Unit& u) const { return B + (size_t)u.pn * bstep; }
};

template <class Epi, class Sched, int NB, bool ALIGN_EPI, bool F8 = false>
DI void gemm_phase(LAS unsigned char* lds, const int K, const Sched& S, const Epi& E) {
    const int tid = threadIdx.x, wid = __builtin_amdgcn_readfirstlane(tid >> 6), lane = tid & 63, wr = wid >> 2, wc = wid & 3, fr = lane & 15, fq = lane >> 4;
    const int nt = K / BK;
    unsigned voffA[2], voffB[2];
#pragma unroll
    for (int i = 0; i < 2; ++i) { int R, C; stage_rc(tid * 16 + i * 8192, R, C); const int Rb = Epi::PERM ? ((R & ~31) + perm32(R & 31)) : R;
        voffA[i] = (unsigned)(R * K + C) * 2u; voffB[i] = (unsigned)(Rb * K + C) * 2u; }
    const size_t kstep = (size_t)(BK * 2);
    const size_t hstep = (size_t)HALF * K * 2;
    const unsigned ldsw = (unsigned)wid * 1024u;
    const int aoff = lds_byte(wr * 64 + fr, F8 ? fq * 16 : fq * 8), boff = lds_byte(wc * 32 + fr, F8 ? fq * 16 : fq * 8);
    constexpr int KOFF = F8 ? 16 : 1024;
    const unsigned one_scale = 0x7f7f7f7fu;
#define PG8_SA(b, h) (((b) * 2 + (h)) * HTB)
#define PG8_SB(b, h) ((4 + (b) * 2 + (h)) * HTB)
#define PG8_STAGE(bufoff, gbase, voff) do { _Pragma("unroll") for (int _i = 0; _i < 2; ++_i) \
        __builtin_amdgcn_global_load_lds((const unsigned*)((const char*)(gbase) + (voff)[_i]), (LAS unsigned*)(lds + (bufoff) + ldsw + _i * 8192), 16, 0, 0); } while (0)
#define PG8_LDA(dst, b, h) do { _Pragma("unroll") for (int m = 0; m < 4; ++m) _Pragma("unroll") for (int k = 0; k < 2; ++k) dst[m][k] = *(const LAS bf16x8*)(lds + PG8_SA(b, h) + aoff + m * 2048 + k * KOFF); } while (0)
#define PG8_LDB(dst, b, h) do { _Pragma("unroll") for (int n = 0; n < 2; ++n) _Pragma("unroll") for (int k = 0; k < 2; ++k) dst[n][k] = *(const LAS bf16x8*)(lds + PG8_SB(b, h) + boff + n * 2048 + k * KOFF); } while (0)
#define PG8_CAT(x) __builtin_bit_cast(v8i32, __builtin_shufflevector((x)[0], (x)[1], 0, 1, 2, 3, 4, 5, 6, 7, 8, 9, 10, 11, 12, 13, 14, 15))
#define PG8_MMA(ai, bj, At, Bt) do { __builtin_amdgcn_s_setprio(1); _Pragma("unroll") for (int m = 0; m < 4; ++m) _Pragma("unroll") for (int n = 0; n < 2; ++n) { \
        if constexpr (F8 && NB == 1 && !F8ASM1) acc[ai][bj][m][n] = __builtin_amdgcn_mfma_scale_f32_16x16x128_f8f6f4(PG8_CAT(Bt[n]), PG8_CAT(At[m]), acc[ai][bj][m][n], 0, 0, 0, 0x7f7f7f7f, 0, 0x7f7f7f7f); \
        else if constexpr (F8) { asm volatile("v_mfma_scale_f32_16x16x128_f8f6f4 %0, %1, %2, %0, %3, %3 op_sel_hi:[0,0,0]" : "+v"(acc[ai][bj][m][n]) : "v"(PG8_CAT(Bt[n])), "v"(PG8_CAT(At[m])), "v"(one_scale)); } \
        else { _Pragma("unroll") for (int k = 0; k < 2; ++k) acc[ai][bj][m][n] = __builtin_amdgcn_mfma_f32_16x16x32_bf16(Bt[n][k], At[m][k], acc[ai][bj][m][n], 0, 0, 0); } } \
        __builtin_amdgcn_s_setprio(0); } while (0)
#define PG8_WAIT_V(n) asm volatile("s_waitcnt vmcnt(" #n ")" ::: "memory")
#define PG8_WAIT_L(n) asm volatile("s_waitcnt lgkmcnt(" #n ")" ::: "memory")
#define PG8_BAR __builtin_amdgcn_s_barrier()
#define PG8_SCHED __builtin_amdgcn_sched_barrier(0)
#define PG8_WAIT_MAIN() do { if constexpr (NB == 2) PG8_WAIT_V(8); else PG8_WAIT_V(6); } while (0)
    Unit cur, nxt; int ui = 0;
    if (!S.next(0, cur)) return;
    f32x4 acc[2][NB][4][2];
    f32x4 yac[2][4][2];
#pragma unroll
    for (int a = 0; a < 2; ++a)
#pragma unroll
        for (int m = 0; m < 4; ++m)
#pragma unroll
            for (int n = 0; n < 2; ++n) { yac[a][m][n] = (f32x4){0.f, 0.f, 0.f, 0.f};
#pragma unroll
                for (int b = 0; b < NB; ++b) acc[a][b][m][n] = (f32x4){0.f, 0.f, 0.f, 0.f}; }
    bf16x8 At[4][2], B0[2][2], B1[2][2];
    const char* cA = S.abase(cur); const char* cB = S.bbase(cur);
    if constexpr (NB == 2) {
        PG8_STAGE(PG8_SB(0, 0), cB, voffB); PG8_STAGE(PG8_SB(0, 1), cB + hstep, voffB); PG8_STAGE(PG8_SA(0, 0), cA, voffA); PG8_STAGE(PG8_SA(0, 1), cA + hstep, voffA);
        if (wr == 1) PG8_BAR;
        PG8_WAIT_V(2); PG8_BAR;
        PG8_STAGE(PG8_SB(1, 0), cB + kstep, voffB); PG8_STAGE(PG8_SA(1, 0), cA + kstep, voffA); PG8_STAGE(PG8_SB(1, 1), cB + hstep + kstep, voffB);
        PG8_WAIT_V(6); PG8_BAR;
    } else {
        PG8_STAGE(PG8_SB(0, 0), cB, voffB); PG8_STAGE(PG8_SA(0, 0), cA, voffA); PG8_STAGE(PG8_SA(0, 1), cA + hstep, voffA);
        if (wr == 1) PG8_BAR;
        PG8_WAIT_V(2); PG8_BAR;
        PG8_STAGE(PG8_SB(1, 0), cB + kstep, voffB); PG8_STAGE(PG8_SA(1, 0), cA + kstep, voffA);
        PG8_WAIT_V(4); PG8_BAR;
    }
    for (;;) {
        const bool has_next = S.next(ui + 1, nxt);
        const char* nA = has_next ? S.abase(nxt) : cA; const char* nB = has_next ? S.bbase(nxt) : cB;
        for (int t = 0; t < nt; t += 2) {
            if constexpr (Epi::GATED) { if (t != 0 && (t & 15) == 0) { E.flush(acc, yac, cur, (t >> 4) - 1, wr, wc, fr, fq);
#pragma unroll
                for (int a = 0; a < 2; ++a)
#pragma unroll
                    for (int m = 0; m < 4; ++m)
#pragma unroll
                        for (int n = 0; n < 2; ++n) acc[a][0][m][n] = (f32x4){0.f, 0.f, 0.f, 0.f}; } }
            const bool last = (t == nt - 2);
            const char* a1 = cA + (size_t)(t + 1) * kstep;
            const char* a2 = last ? nA : cA + (size_t)(t + 2) * kstep; const char* b2 = last ? nB : cB + (size_t)(t + 2) * kstep;
            const char* a3 = a2 + kstep; const char* b3 = b2 + kstep;
            if constexpr (NB == 2) {
            PG8_LDB(B0, 0, 0); PG8_LDB(B1, 0, 1); PG8_SCHED; PG8_LDA(At, 0, 0); PG8_STAGE(PG8_SA(1, 1), a1 + hstep, voffA);
            PG8_WAIT_V(8); PG8_WAIT_L(0); PG8_BAR; PG8_MMA(0, 0, At, B0); PG8_MMA(0, 1, At, B1); PG8_BAR; PG8_SCHED;
            PG8_LDA(At, 0, 1); PG8_STAGE(PG8_SB(0, 0), b2, voffB); PG8_STAGE(PG8_SB(0, 1), b2 + hstep, voffB); PG8_STAGE(PG8_SA(0, 0), a2, voffA);
            PG8_WAIT_V(8); PG8_WAIT_L(0); PG8_BAR; PG8_MMA(1, 0, At, B0); PG8_MMA(1, 1, At, B1); PG8_BAR; PG8_SCHED;
            PG8_LDB(B0, 1, 0); PG8_LDB(B1, 1, 1); PG8_SCHED; PG8_LDA(At, 1, 0); PG8_STAGE(PG8_SA(0, 1), a2 + hstep, voffA);
            PG8_WAIT_V(8); PG8_WAIT_L(0); PG8_BAR; PG8_MMA(0, 0, At, B0); PG8_MMA(0, 1, At, B1); PG8_BAR; PG8_SCHED;
            PG8_LDA(At, 1, 1); PG8_STAGE(PG8_SB(1, 0), b3, voffB); PG8_STAGE(PG8_SB(1, 1), b3 + hstep, voffB); PG8_STAGE(PG8_SA(1, 0), a3, voffA);
            PG8_WAIT_V(8); PG8_WAIT_L(0); PG8_BAR; PG8_MMA(1, 0, At, B0); PG8_MMA(1, 1, At, B1); PG8_BAR; PG8_SCHED;
            } else {
            PG8_LDB(B0, 0, 0); PG8_SCHED; PG8_LDA(At, 0, 0); PG8_STAGE(PG8_SA(1, 1), a1 + hstep, voffA);
            PG8_WAIT_V(6); PG8_WAIT_L(0); PG8_BAR; PG8_MMA(0, 0, At, B0); PG8_BAR; PG8_SCHED;
            PG8_LDA(At, 0, 1); PG8_STAGE(PG8_SB(0, 0), b2, voffB); PG8_STAGE(PG8_SA(0, 0), a2, voffA);
            PG8_WAIT_V(6); PG8_WAIT_L(0); PG8_BAR; PG8_MMA(1, 0, At, B0); PG8_BAR; PG8_SCHED;
            PG8_LDB(B0, 1, 0); PG8_SCHED; PG8_LDA(At, 1, 0); PG8_STAGE(PG8_SA(0, 1), a2 + hstep, voffA);
            PG8_WAIT_V(6); PG8_WAIT_L(0); PG8_BAR; PG8_MMA(0, 0, At, B0); PG8_BAR; PG8_SCHED;
            PG8_LDA(At, 1, 1); PG8_STAGE(PG8_SB(1, 0), b3, voffB); PG8_STAGE(PG8_SA(1, 0), a3, voffA);
            PG8_WAIT_V(6); PG8_WAIT_L(0); PG8_BAR; PG8_MMA(1, 0, At, B0); PG8_BAR; PG8_SCHED;
            }
        }
        if constexpr (F8) {
            asm volatile("s_nop 15\n\ts_nop 15" ::: "memory");
#pragma unroll
            for (int a = 0; a < 2; ++a)
#pragma unroll
                for (int b = 0; b < NB; ++b)
#pragma unroll
                    for (int m = 0; m < 4; ++m)
#pragma unroll
                        for (int n = 0; n < 2; ++n) asm volatile("" : "+v"(acc[a][b][m][n]));
        }
        if constexpr (ALIGN_EPI) { if (wr == 0) PG8_BAR; }
        if constexpr (Epi::GATED) { E.finish(acc, yac, cur, wr, wc, fr, fq);
#pragma unroll
            for (int a = 0; a < 2; ++a)
#pragma unroll
                for (int m = 0; m < 4; ++m)
#pragma unroll
                    for (int n = 0; n < 2; ++n) yac[a][m][n] = (f32x4){0.f, 0.f, 0.f, 0.f};
        } else { E(acc, cur, wr, wc, fr, fq); }
        if (!has_next) break;
#pragma unroll
        for (int a = 0; a < 2; ++a)
#pragma unroll
            for (int b = 0; b < NB; ++b)
#pragma unroll
                for (int m = 0; m < 4; ++m)
#pragma unroll
                    for (int n = 0; n < 2; ++n) acc[a][b][m][n] = (f32x4){0.f, 0.f, 0.f, 0.f};
        cur = nxt; cA = nA; cB = nB; ++ui;
        if constexpr (ALIGN_EPI) { if (wr == 1) PG8_BAR; }
    }
    PG8_WAIT_V(0);
    if constexpr (!ALIGN_EPI) { if (wr == 0) PG8_BAR; }
    PG8_BAR;
#undef PG8_SA
#undef PG8_SB
#undef PG8_STAGE
#undef PG8_LDA
#undef PG8_LDB
#undef PG8_MMA
#undef PG8_CAT
#undef PG8_WAIT_V
#undef PG8_WAIT_L
#undef PG8_BAR
#undef PG8_SCHED
#undef PG8_WAIT_MAIN
}
}

#define XB_TMO      128
#define XB_XCNT(j)  (256  + 64 * (j))
#define XB_XSUB(j)  (1280 + 64 * (j))
#define XB_XGEN(j)  (2304 + 64 * (j))
#define XB_TOP      3328
#define XB_TOPGEN   3392
#define XCD_BAR_WORDS 3456
#define XB_SPIN_CAP (1u << 18)
DI unsigned xb_ld(unsigned* p)              { return __hip_atomic_load(p, __ATOMIC_RELAXED, __HIP_MEMORY_SCOPE_AGENT); }
DI unsigned xb_add(unsigned* p, unsigned v) { return __hip_atomic_fetch_add(p, v, __ATOMIC_RELAXED, __HIP_MEMORY_SCOPE_AGENT); }
DI unsigned xb_xcc_id() { return (unsigned)__builtin_amdgcn_s_getreg((3 << 11) | 20) & 0xFu; }
#define XB_SPIN(cond, bar) do { unsigned _sp = 0; while (cond) { __builtin_amdgcn_s_sleep(1); \
    if ((++_sp & 255u) == 0u) { if (xb_ld(&(bar)[XB_TMO])) break; if (_sp > XB_SPIN_CAP) { atomicAdd(&(bar)[XB_TMO], 1u); break; } } } } while (0)
struct XcdBarrier { unsigned* bar; unsigned x; volatile LAS unsigned* st; };
DI XcdBarrier xcd_barrier_post(unsigned* bar, volatile LAS unsigned* st) {
    XcdBarrier b; b.bar = bar; b.x = xb_xcc_id(); b.st = st;
    if (threadIdx.x == 0) (void)xb_add(&bar[XB_XCNT(b.x)], 1u);
    return b;
}
DI void xcd_barrier_complete(unsigned* bar, unsigned x, unsigned& nloc, unsigned& nx) {
    const unsigned G = gridDim.x * gridDim.y * gridDim.z;
    unsigned sum, cnt, mine, sp = 0u;
    for (;;) {
        sum = 0u; cnt = 0u; mine = 0u;
#pragma unroll
        for (unsigned j = 0; j < 16; ++j) { const unsigned c = xb_ld(&bar[XB_XCNT(j)]); sum += c; cnt += (c > 0u) ? 1u : 0u; mine = (j == x) ? c : mine; }
        if (sum == G) break;
        __builtin_amdgcn_s_sleep(1);
        if ((++sp & 255u) == 0u) { if (xb_ld(&bar[XB_TMO])) break; if (sp > XB_SPIN_CAP) { atomicAdd(&bar[XB_TMO], 1u); break; } }
    }
    nloc = mine > 0u ? mine : 1u; nx = cnt > 0u ? cnt : 1u;
}
DI void xcd_barrier(const XcdBarrier& b) {
    asm volatile("s_waitcnt vmcnt(0)" ::: "memory");
    __syncthreads();
    if (threadIdx.x == 0) {
        unsigned* bar = b.bar;
        __builtin_amdgcn_s_waitcnt(0);
        unsigned nloc = b.st[0], nx = b.st[1];
        if (nloc == 0u) { xcd_barrier_complete(bar, b.x, nloc, nx); b.st[0] = nloc; b.st[1] = nx; }
        const unsigned old = xb_add(&bar[XB_XSUB(b.x)], 1u);
        const unsigned gen = old / nloc;
        if (old + 1u == (gen + 1u) * nloc) {
            __builtin_amdgcn_fence(__ATOMIC_RELEASE, "agent");
            asm volatile("s_waitcnt vmcnt(0)" ::: "memory");
            const unsigned og = xb_add(&bar[XB_TOP], 1u);
            const unsigned tg = og / nx;
            if (og + 1u == (tg + 1u) * nx) xb_add(&bar[XB_TOPGEN], 1u);
            else XB_SPIN(xb_ld(&bar[XB_TOPGEN]) == tg, bar);
            __builtin_amdgcn_fence(__ATOMIC_ACQUIRE, "agent");
            xb_add(&bar[XB_XGEN(b.x)], 1u);
            asm volatile("s_waitcnt vmcnt(0)" ::: "memory");
        } else {
            XB_SPIN(xb_ld(&bar[XB_XGEN(b.x)]) == gen, bar);
            __builtin_amdgcn_fence(__ATOMIC_ACQUIRE, "agent");
            asm volatile("s_waitcnt vmcnt(0)" ::: "memory");
        }
    }
    __syncthreads();
}

struct Frame {
    LAS unsigned char* lds;
    int tid, lane, wave, G, wg;
    float* out; unsigned char* ws;
};
template <class T> DI T* wsp(const Frame& F, size_t off) { return (T*)(F.ws + off); }

struct EpiH {
    static constexpr bool PERM = true, GATED = false;
    bf16* H; bf16* MK; bf16* MVT;
    DI void operator()(const f32x4 (&acc)[2][2][4][2], const pg8::Unit& u, int wr, int wc, int fr, int fq) const {
        bf16* base = H; size_t ldc = NH; int act = 0;
        if (u.gi == 0) { const int pn = u.pn; act = ((pn >= 4 && pn < 8) || (pn >= 16 && pn < 20) || (pn >= 25 && pn < 29) || (pn >= 33 && pn < 37)) ? 1 : 0; }
        else { const int lx = (u.gi - 1) >> 1, w = (u.gi - 1) & 1; if (w == 0) { base = MK + (size_t)lx * 512 * 1024; ldc = 1024; } else { base = MVT + (size_t)lx * 1024 * 512; ldc = 512; } }
        const int row0 = u.pm * 256 + wr * 64 + fr, col0 = u.pn * 256 + wc * 32 + 8 * fq;
#pragma unroll
        for (int ai = 0; ai < 2; ++ai)
#pragma unroll
            for (int m = 0; m < 4; ++m) { bf16* rowp = base + (size_t)(row0 + ai * 128 + m * 16) * ldc + col0;
#pragma unroll
                for (int bj = 0; bj < 2; ++bj) { f32x4 v0 = acc[ai][bj][m][0], v1 = acc[ai][bj][m][1];
                    if (act != 0) {
#pragma unroll
                        for (int j = 0; j < 4; ++j) { const float s0 = fast_sigmoid(v0[j]), s1 = fast_sigmoid(v1[j]); v0[j] = (act == 1) ? v0[j] * s0 : s0; v1[j] = (act == 1) ? v1[j] * s1 : s1; } }
                    u32x4 w; w.x = cvt_pk_bf16(v0[0], v0[1]); w.y = cvt_pk_bf16(v0[2], v0[3]); w.z = cvt_pk_bf16(v1[0], v1[1]); w.w = cvt_pk_bf16(v1[2], v1[3]);
                    *(u32x4*)(rowp + bj * 128) = w; } }
    }
};
template <int NB> struct EpiMG {
    static constexpr bool PERM = true, GATED = false;
    bf16* H;
    DI void operator()(const f32x4 (&acc)[2][NB][4][2], const pg8::Unit& u, int wr, int wc, int fr, int fq) const {
        const int row0 = u.pm * 256 + wr * 64 + fr, col0 = C_MG + u.pn * (128 * NB) + wc * 32 + 8 * fq;
#pragma unroll
        for (int ai = 0; ai < 2; ++ai)
#pragma unroll
            for (int m = 0; m < 4; ++m) { bf16* rowp = H + (size_t)(row0 + ai * 128 + m * 16) * NH + col0;
#pragma unroll
                for (int bj = 0; bj < NB; ++bj) { f32x4 v0 = acc[ai][bj][m][0], v1 = acc[ai][bj][m][1];
#pragma unroll
                    for (int j = 0; j < 4; ++j) { v0[j] = fast_sigmoid(v0[j] * MG_DESCALE); v1[j] = fast_sigmoid(v1[j] * MG_DESCALE); }
                    u32x4 w; w.x = cvt_pk_bf16(v0[0], v0[1]); w.y = cvt_pk_bf16(v0[2], v0[3]); w.z = cvt_pk_bf16(v1[0], v1[1]); w.w = cvt_pk_bf16(v1[2], v1[3]);
                    *(u32x4*)(rowp + bj * 128) = w; } }
    }
};
struct EpiRes {
    static constexpr bool PERM = false, GATED = false;
    const float* __restrict__ res; float* __restrict__ out;
    DI void operator()(const f32x4 (&acc)[2][2][4][2], const pg8::Unit& u, int wr, int wc, int fr, int fq) const {
        const int row0 = u.pm * 256 + wr * 64 + fr, col0 = u.pn * 256 + wc * 32 + 4 * fq;
#pragma unroll
        for (int ai = 0; ai < 2; ++ai)
#pragma unroll
            for (int m = 0; m < 4; ++m) { const size_t ro = (size_t)(row0 + ai * 128 + m * 16) * DM + col0;
#pragma unroll
                for (int bj = 0; bj < 2; ++bj)
#pragma unroll
                    for (int n = 0; n < 2; ++n) { const size_t o = ro + bj * 128 + n * 16; const f32x4 r = *(const f32x4*)(res + o); *(f32x4*)(out + o) = r * DN_ALPHA + acc[ai][bj][m][n]; } }
    }
};
struct EpiGate {
    static constexpr bool PERM = true, GATED = true;
    const bf16* H; bf16* Y;
    DI void flush(const f32x4 (&acc)[2][1][4][2], f32x4 (&y)[2][4][2], const pg8::Unit& u, int bi, int wr, int wc, int fr, int fq) const {
        const int row0 = u.pm * 256 + wr * 64 + fr, col0 = u.pn * 128 + wc * 32 + 8 * fq;
#pragma unroll
        for (int ai = 0; ai < 2; ++ai)
#pragma unroll
            for (int m = 0; m < 4; ++m) { const u32x4 gw = *(const u32x4*)(H + (size_t)(row0 + ai * 128 + m * 16) * NH + C_MG + bi * DM + col0);
                float g[8]; unpack8(gw, g);
#pragma unroll
                for (int j = 0; j < 4; ++j) { y[ai][m][0][j] += g[j] * acc[ai][0][m][0][j]; y[ai][m][1][j] += g[4 + j] * acc[ai][0][m][1][j]; }
                if (m == 1 || m == 3) __builtin_amdgcn_sched_barrier(0); }
    }
    DI void finish(const f32x4 (&acc)[2][1][4][2], f32x4 (&y)[2][4][2], const pg8::Unit& u, int wr, int wc, int fr, int fq) const {
        flush(acc, y, u, 3, wr, wc, fr, fq);
        const int row0 = u.pm * 256 + wr * 64 + fr, col0 = u.pn * 128 + wc * 32 + 8 * fq;
#pragma unroll
        for (int ai = 0; ai < 2; ++ai)
#pragma unroll
            for (int m = 0; m < 4; ++m) { const f32x4 v0 = y[ai][m][0], v1 = y[ai][m][1];
                u32x4 w; w.x = cvt_pk_bf16(v0[0], v0[1]); w.y = cvt_pk_bf16(v0[2], v0[3]); w.z = cvt_pk_bf16(v1[0], v1[1]); w.w = cvt_pk_bf16(v1[2], v1[3]);
                *(u32x4*)(Y + (size_t)(row0 + ai * 128 + m * 16) * DM + col0) = w; }
    }
};
struct SchedInProj {
    int G, c, n_extra; const char *XB, *WT, *MEMB, *WKV;
    static constexpr int NM = 32, NN = 38, NU = NM * NN;
    static constexpr size_t TSTEP = (size_t)256 * 4096 * 2;
    DI bool next(int i, pg8::Unit& u) const {
        const long L = (long)i * G + c;
        if (L < NU) { pg8::static_tile((int)L, NM, NN, u.pm, u.pn); if (u.pn == 37) u.pn = 101; u.gi = 0; return true; }
        const int e = (int)(L - NU); if (e >= n_extra) return false;
        const int lx = e >> 4, r = e & 15;
        if (r < 8) { u.pm = r >> 2; u.pn = r & 3; u.gi = 1 + 2 * lx; } else { u.pm = (r - 8) >> 1; u.pn = (r - 8) & 1; u.gi = 2 + 2 * lx; }
        return true;
    }
    DI const char* abase(const pg8::Unit& u) const {
        if (u.gi == 0) return XB + (size_t)u.pm * TSTEP;
        const int lx = (u.gi - 1) >> 1, w = (u.gi - 1) & 1;
        return w == 0 ? MEMB + (size_t)u.pm * TSTEP : WKV + (size_t)lx * 2048 * 4096 * 2 + (size_t)(1024 + u.pm * 256) * 4096 * 2;
    }
    DI const char* bbase(const pg8::Unit& u) const {
        if (u.gi == 0) return WT + (size_t)u.pn * TSTEP;
        const int lx = (u.gi - 1) >> 1, w = (u.gi - 1) & 1;
        return w == 0 ? WKV + (size_t)lx * 2048 * 4096 * 2 + (size_t)u.pn * TSTEP : MEMB + (size_t)u.pn * TSTEP;
    }
};

DI int win_src_col(int n) { return n < 5120 ? n : (n < C_LR ? n + 16 : (n < C_LR + 16 ? n - C_LR + 5120 : -1)); }
template <bool WIN> DI void transpose_item(const float* W, size_t ldw, bf16* WT, size_t ldt, int k0, int n0, int kd0, LAS float* scr, int lane) {
    const int nn = lane & 31; int sc = n0 + nn; if (WIN) sc = win_src_col(sc);
    const float* src = W + (size_t)(k0 + (lane >> 5)) * ldw + (sc < 0 ? 0 : sc);
    float v[32];
#pragma unroll
    for (int i = 0; i < 32; ++i) v[i] = src[(size_t)(2 * i) * ldw];
#pragma unroll
    for (int i = 0; i < 32; ++i) scr[(2 * i + (lane >> 5)) * 33 + nn] = (sc < 0) ? 0.f : v[i];
    LDS_WAIT();
    const int c = lane & 7;
#pragma unroll
    for (int j = 0; j < 4; ++j) { const int n = (lane >> 3) + 8 * j; const LAS float* s = scr + (8 * c) * 33 + n;
        u32x4 o; o.x = pk2(s[0 * 33], s[1 * 33]); o.y = pk2(s[2 * 33], s[3 * 33]); o.z = pk2(s[4 * 33], s[5 * 33]); o.w = pk2(s[6 * 33], s[7 * 33]);
        *(u32x4*)(WT + (size_t)(n0 + n) * ldt + kd0 + 8 * c) = o; }
    LDS_WAIT();
}
DI void transpose_item_f8(const float* W, size_t ldw, unsigned char* WT, size_t ldt, int k0, int n0, LAS float* scr, int lane) {
    const int nn = lane & 31; const int sc = win_src_col(n0 + nn);
    const float* src = W + (size_t)(k0 + (lane >> 5)) * ldw + sc;
#pragma unroll
    for (int h = 0; h < 2; ++h) {
        float v[32];
#pragma unroll
        for (int i = 0; i < 32; ++i) v[i] = src[(size_t)(64 * h + 2 * i) * ldw];
#pragma unroll
        for (int i = 0; i < 32; ++i) scr[(64 * h + 2 * i + (lane >> 5)) * 33 + nn] = v[i] * W8_SCALE;
    }
    LDS_WAIT();
    const int c = lane & 7;
#pragma unroll
    for (int j = 0; j < 4; ++j) { const int n = (lane >> 3) + 8 * j; const LAS float* s = scr + (16 * c) * 33 + n;
        u32x4 o; o.x = pk4_fp8(s[0 * 33], s[1 * 33], s[2 * 33], s[3 * 33]); o.y = pk4_fp8(s[4 * 33], s[5 * 33], s[6 * 33], s[7 * 33]);
        o.z = pk4_fp8(s[8 * 33], s[9 * 33], s[10 * 33], s[11 * 33]); o.w = pk4_fp8(s[12 * 33], s[13 * 33], s[14 * 33], s[15 * 33]);
        *(u32x4*)(WT + (size_t)(n0 - C_MG + n) * ldt + k0 + 16 * c) = o; }
    LDS_WAIT();
}
DI void prologue(const Frame& F, const float* x, const float* mem, const int* pos, const float* w_in, const float* w_pool, const float* w_mem_kv, const float* w_branch, const float* w_out) {
    LAS float* scr = (LAS float*)(F.lds + F.wave * 17408);
    const int gw = F.wg * NWAVES + F.wave, NGW = F.G * NWAVES, lane = F.lane;
    constexpr int I_IN = 64 * (NH / 32), I_KV = 64 * 64, I_BR = 16 * 128, I_OUT = 64 * 128, I_PL = 4 * 8;
    constexpr int NITEMS = 2 * I_IN + 2 * I_KV + 8 * I_BR + 2 * I_OUT + 8 * I_PL;
    for (int it = gw; it < NITEMS; it += NGW) {
        int r = it;
        if (r < 2 * I_IN) { const int l = r / I_IN; r -= l * I_IN; const int nb = r >> 6, kb = r & 63;
            if (nb * 32 >= C_MG && nb * 32 < C_LR) { if ((kb & 1) == 0) transpose_item_f8(w_in + (size_t)l * 4096 * D_IN, D_IN, wsp<unsigned char>(F, WS_W8) + (size_t)l * 16384 * 4096, 4096, kb * 64, nb * 32, scr, lane); }
            else transpose_item<true>(w_in + (size_t)l * 4096 * D_IN, D_IN, wsp<bf16>(F, WS_WINT) + (size_t)l * NH * 4096, 4096, kb * 64, nb * 32, kb * 64, scr, lane);
            continue; }
        r -= 2 * I_IN;
        if (r < 2 * I_KV) { const int l = r / I_KV; r -= l * I_KV; const int nb = r >> 6, kb = r & 63;
            transpose_item<false>(w_mem_kv + (size_t)l * 4096 * 2048, 2048, wsp<bf16>(F, WS_WMKVT) + (size_t)l * 2048 * 4096, 4096, kb * 64, nb * 32, kb * 64, scr, lane); continue; }
        r -= 2 * I_KV;
        if (r < 8 * I_BR) { const int lb = r / I_BR; r -= lb * I_BR; const int l = lb >> 2, bi = lb & 3; const int nb = r >> 4, kb = r & 15;
            transpose_item<false>(w_branch + (size_t)lb * 1024 * 4096, 4096, wsp<bf16>(F, WS_WBRT) + (size_t)l * 4096 * 4096, 4096, kb * 64, nb * 32, bi * 1024 + kb * 64, scr, lane); continue; }
        r -= 8 * I_BR;
        if (r < 2 * I_OUT) { const int l = r / I_OUT; r -= l * I_OUT; const int nb = r >> 6, kb = r & 63;
            transpose_item<false>(w_out + (size_t)l * 4096 * 4096, 4096, wsp<bf16>(F, WS_WOUTT) + (size_t)l * 4096 * 4096, 4096, kb * 64, nb * 32, kb * 64, scr, lane); continue; }
        r -= 2 * I_OUT;
        { const int lg = r / I_PL; r -= lg * I_PL; const int nb = r >> 2, kb = r & 3;
            transpose_item<false>(w_pool + (size_t)lg * 256 * 256, 256, wsp<bf16>(F, WS_WPOOLT) + (size_t)lg * 256 * 256, 256, kb * 64, nb * 32, kb * 64, scr, lane); }
    }
    const size_t gt = (size_t)F.wg * NTHR + F.tid, GT = (size_t)F.G * NTHR;
    { const f32x4* xs = (const f32x4*)x; u32x4* xd = wsp<u32x4>(F, WS_XB);
      u32x2* x8 = wsp<u32x2>(F, WS_X8);
      for (size_t i = gt; i < (size_t)MTOK * DM / 8; i += GT) { const f32x4 a = xs[2 * i], b = xs[2 * i + 1]; u32x4 o; o.x = pk2(a.x, a.y); o.y = pk2(a.z, a.w); o.z = pk2(b.x, b.y); o.w = pk2(b.z, b.w); xd[i] = o;
          u32x2 q; q.x = pk4_fp8(a.x * X8_SCALE, a.y * X8_SCALE, a.z * X8_SCALE, a.w * X8_SCALE); q.y = pk4_fp8(b.x * X8_SCALE, b.y * X8_SCALE, b.z * X8_SCALE, b.w * X8_SCALE); x8[i] = q; }
      const f32x4* ms = (const f32x4*)mem; u32x4* md = wsp<u32x4>(F, WS_MEMB);
      for (size_t i = gt; i < (size_t)BATCH * MEMLEN * DM / 8; i += GT) { const f32x4 a = ms[2 * i], b = ms[2 * i + 1]; u32x4 o; o.x = pk2(a.x, a.y); o.y = pk2(a.z, a.w); o.z = pk2(b.x, b.y); o.w = pk2(b.z, b.w); md[i] = o; } }
    { f32x2* rt = wsp<f32x2>(F, WS_ROPE);
      for (size_t i = gt; i < (size_t)MTOK * 8; i += GT) { const int t = (int)(i >> 3), fi = (int)(i & 7);
          const float inv = (float)pow(500000.0, -(double)fi / 8.0); const float ang = (float)pos[t] * inv;
          rt[i] = (f32x2){cosf(ang), sinf(ang)}; } }
}

DI float logsigmoid_f(float z) { return fminf(z, 0.f) - log1pf(expf(-fabsf(z))); }

DI void gla_a_unit(const Frame& F, int l, int unit, const float* w_gla_up, const float* b_gla) {
    const int bh = unit >> 6, c = unit & 63, b = bh >> 2, h = bh & 3, t0 = b * SEQ + c * 64, tid = F.tid, lane = F.lane, wave = F.wave;
    const bf16* H = wsp<bf16>(F, WS_H);
    LAS float* lrs = (LAS float*)(F.lds);
    LAS float* bcs = (LAS float*)(F.lds + 4096);
    LAS float* seg = (LAS float*)(F.lds + 36864);
    LAS bf16* kds = (LAS bf16*)(F.lds + 40960);
    LAS bf16* vs = (LAS bf16*)(F.lds + 59392);
    constexpr int LDK = 136, LDV = 264;
    __syncthreads();
    if (tid < 128) { const int j = tid >> 1, hf = tid & 1; const u32x4 w = *(const u32x4*)(H + (size_t)(t0 + j) * NH + C_LR + 8 * hf); float f[8]; unpack8(w, f);
#pragma unroll
        for (int i = 0; i < 8; ++i) lrs[j * 16 + 8 * hf + i] = f[i]; }
    for (int p = tid; p < 64 * 32; p += NTHR) { const int j = p >> 5, ch = p & 31; *(LAS u32x4*)(vs + j * LDV + 8 * ch) = *(const u32x4*)(H + (size_t)(t0 + j) * NH + C_GV + h * 256 + 8 * ch); }
    __syncthreads();
    const int d = tid & 127, sg = tid >> 7;
    { float w[16];
#pragma unroll
      for (int r = 0; r < 16; ++r) w[r] = w_gla_up[(size_t)l * 16 * 512 + r * 512 + h * 128 + d];
      const float bg = b_gla[l * 512 + h * 128 + d]; float run = 0.f;
      for (int jj = 0; jj < 16; ++jj) { const int j = sg * 16 + jj; float z = bg;
#pragma unroll
          for (int r = 0; r < 16; ++r) z += lrs[j * 16 + r] * w[r];
          run += logsigmoid_f(z) * (1.0f / 16.0f); bcs[j * 128 + d] = run; }
      seg[sg * 128 + d] = run; }
    __syncthreads();
    { float pre = 0.f;
      for (int s = 0; s < sg; ++s) pre += seg[s * 128 + d];
      float* GB = wsp<float>(F, WS_GB);
      for (int jj = 0; jj < 16; ++jj) { const int j = sg * 16 + jj; const float v = bcs[j * 128 + d] + pre; bcs[j * 128 + d] = v; GB[(size_t)(t0 + j) * 512 + h * 128 + d] = v; }
      if (sg == 3) wsp<float>(F, WS_DEC)[(size_t)unit * 128 + d] = expf(bcs[63 * 128 + d]); }
    __syncthreads();
    for (int p = tid; p < 64 * 16; p += NTHR) { const int j = p >> 4, ch = p & 15; const u32x4 w = *(const u32x4*)(H + (size_t)(t0 + j) * NH + C_GK + h * 128 + 8 * ch); float f[8]; unpack8(w, f);
#pragma unroll
        for (int i = 0; i < 8; ++i) f[i] *= expf(bcs[63 * 128 + 8 * ch + i] - bcs[j * 128 + 8 * ch + i]);
        *(LAS u32x4*)(kds + j * LDK + 8 * ch) = pack8(f); }
    __syncthreads();
    f32x4 acc[2][8];
#pragma unroll
    for (int a = 0; a < 2; ++a)
#pragma unroll
        for (int n = 0; n < 8; ++n) acc[a][n] = (f32x4){0.f, 0.f, 0.f, 0.f};
#pragma unroll
    for (int ks = 0; ks < 2; ++ks) {
        bf16x8 af[2];
#pragma unroll
        for (int a = 0; a < 2; ++a) af[a] = frag_tr(vs, LDV, 32 * ks, 32 * wave + 16 * a, lane);
#pragma unroll
        for (int n = 0; n < 8; ++n) { const bf16x8 bfr = frag_tr(kds, LDK, 32 * ks, 16 * n, lane);
#pragma unroll
            for (int a = 0; a < 2; ++a) acc[a][n] = mma16(af[a], bfr, acc[a][n]); }
    }
    float* U = wsp<float>(F, WS_GU) + (size_t)unit * 256 * 128;
#pragma unroll
    for (int a = 0; a < 2; ++a)
#pragma unroll
        for (int n = 0; n < 8; ++n)
#pragma unroll
            for (int r = 0; r < 4; ++r) U[(size_t)(32 * wave + 16 * a + 4 * (lane >> 4) + r) * 128 + 16 * n + (lane & 15)] = acc[a][n][r];
}

DI void gla_scan(const Frame& F) {
    const float* U = wsp<float>(F, WS_GU); const float* DEC = wsp<float>(F, WS_DEC); unsigned* S = wsp<unsigned>(F, WS_GS);
    const int gt = F.wg * NTHR + F.tid, GT = F.G * NTHR;
    for (int it = gt; it < 8 * 256 * 64; it += GT) {
        const int bh = it >> 14, r = it & 16383, e = r >> 6, dp = r & 63;
        float s0 = 0.f, s1 = 0.f;
#pragma unroll 8
        for (int c = 0; c < 64; ++c) { const size_t un = (size_t)bh * 64 + c; const size_t o = (un * 256 + e) * 128 + 2 * dp;
            const f32x2 u = *(const f32x2*)(U + o); const f32x2 dc = *(const f32x2*)(DEC + un * 128 + 2 * dp);
            S[o >> 1] = pk2(s0, s1); s0 = dc.x * s0 + u.x; s1 = dc.y * s1 + u.y; }
    }
}

DI void gla_c_unit(const Frame& F, int l, int unit, const float* gla_norm) {
    const int bh = unit >> 6, c = unit & 63, b = bh >> 2, h = bh & 3, t0 = b * SEQ + c * 64, tid = F.tid, lane = F.lane, wave = F.wave;
    const bf16* H = wsp<bf16>(F, WS_H);
    LAS bf16* qs = (LAS bf16*)(F.lds);
    LAS bf16* ks = (LAS bf16*)(F.lds + 17408);
    LAS bf16* vs = (LAS bf16*)(F.lds + 34816);
    LAS bf16* ps = (LAS bf16*)(F.lds + 68608);
    LAS float* red = (LAS float*)(F.lds + 77824);
    constexpr int LDK = 136, LDV = 264, LDP = 72;
    __syncthreads();
    const float* GB = wsp<float>(F, WS_GB);
    for (int p = tid; p < 64 * 16; p += NTHR) { const int j = p >> 4, ch = p & 15;
        const u32x4 qw = *(const u32x4*)(H + (size_t)(t0 + j) * NH + C_GQ + h * 128 + 8 * ch); const u32x4 kw = *(const u32x4*)(H + (size_t)(t0 + j) * NH + C_GK + h * 128 + 8 * ch);
        const f32x4 b0 = *(const f32x4*)(GB + (size_t)(t0 + j) * 512 + h * 128 + 8 * ch), b1 = *(const f32x4*)(GB + (size_t)(t0 + j) * 512 + h * 128 + 8 * ch + 4);
        float q[8], k[8]; unpack8(qw, q); unpack8(kw, k); const float bb[8] = {b0.x, b0.y, b0.z, b0.w, b1.x, b1.y, b1.z, b1.w};
#pragma unroll
        for (int i = 0; i < 8; ++i) { const float eb = expf(bb[i]); q[i] *= eb * 0.08838834764831845f; k[i] *= expf(-bb[i]); }
        *(LAS u32x4*)(qs + j * LDK + 8 * ch) = pack8(q); *(LAS u32x4*)(ks + j * LDK + 8 * ch) = pack8(k); }
    for (int p = tid; p < 64 * 32; p += NTHR) { const int j = p >> 5, ch = p & 31; *(LAS u32x4*)(vs + j * LDV + 8 * ch) = *(const u32x4*)(H + (size_t)(t0 + j) * NH + C_GV + h * 256 + 8 * ch); }
    __syncthreads();
    { const int it = wave >> 1; f32x4 sa[2] = {(f32x4){0.f, 0.f, 0.f, 0.f}, (f32x4){0.f, 0.f, 0.f, 0.f}};
#pragma unroll
      for (int kk = 0; kk < 4; ++kk) { const bf16x8 qa = frag_lds(qs, LDK, 16 * it, 32 * kk, lane);
#pragma unroll
          for (int jj = 0; jj < 2; ++jj) sa[jj] = mma16(qa, frag_lds(ks, LDK, 16 * (2 * (wave & 1) + jj), 32 * kk, lane), sa[jj]); }
#pragma unroll
      for (int jj = 0; jj < 2; ++jj)
#pragma unroll
          for (int r = 0; r < 4; ++r) { const int i = 16 * it + 4 * (lane >> 4) + r, j = 16 * (2 * (wave & 1) + jj) + (lane & 15);
              ps[i * LDP + j] = (bf16)f2bf(j <= i ? sa[jj][r] : 0.f); } }
    __syncthreads();
    f32x4 acc[2][4];
#pragma unroll
    for (int a = 0; a < 2; ++a)
#pragma unroll
        for (int n = 0; n < 4; ++n) acc[a][n] = (f32x4){0.f, 0.f, 0.f, 0.f};
    const bf16* St = wsp<bf16>(F, WS_GS) + (size_t)unit * 256 * 128;
#pragma unroll
    for (int kk = 0; kk < 4; ++kk) { bf16x8 af[2];
#pragma unroll
        for (int a = 0; a < 2; ++a) af[a] = frag_glb(St, 128, 32 * wave + 16 * a, 32 * kk, lane);
#pragma unroll
        for (int n = 0; n < 4; ++n) { const bf16x8 bq = frag_lds(qs, LDK, 16 * n, 32 * kk, lane);
#pragma unroll
            for (int a = 0; a < 2; ++a) acc[a][n] = mma16(af[a], bq, acc[a][n]); } }
#pragma unroll
    for (int kk = 0; kk < 2; ++kk) { bf16x8 af[2];
#pragma unroll
        for (int a = 0; a < 2; ++a) af[a] = frag_tr(vs, LDV, 32 * kk, 32 * wave + 16 * a, lane);
#pragma unroll
        for (int n = 0; n < 4; ++n) { const bf16x8 bp = frag_lds(ps, LDP, 16 * n, 32 * kk, lane);
#pragma unroll
            for (int a = 0; a < 2; ++a) acc[a][n] = mma16(af[a], bp, acc[a][n]); } }
#pragma unroll
    for (int n = 0; n < 4; ++n) { float s = 0.f;
#pragma unroll
        for (int a = 0; a < 2; ++a)
#pragma unroll
            for (int r = 0; r < 4; ++r) s += acc[a][n][r] * acc[a][n][r];
        s += __shfl_xor(s, 16); s += __shfl_xor(s, 32);
        if (lane < 16) red[wave * 64 + 16 * n + lane] = s; }
    __syncthreads();
    bf16* OB = wsp<bf16>(F, WS_OB);
#pragma unroll
    for (int n = 0; n < 4; ++n) { const int i = 16 * n + (lane & 15); float tot = 0.f;
#pragma unroll
        for (int w = 0; w < 8; ++w) tot += red[w * 64 + i];
        const float rs = 1.0f / sqrtf(tot * (1.0f / 256.0f) + LN_EPS);
#pragma unroll
        for (int a = 0; a < 2; ++a) { const int e = 32 * wave + 16 * a + 4 * (lane >> 4);
            const f32x4 gn = *(const f32x4*)(gla_norm + l * 1024 + h * 256 + e);
            const u32x2 gw = *(const u32x2*)(H + (size_t)(t0 + i) * NH + C_GG + h * 256 + e);
            const float g0 = bf2f(gw.x & 0xffffu), g1 = bf2f(gw.x >> 16), g2 = bf2f(gw.y & 0xffffu), g3 = bf2f(gw.y >> 16);
            u32x2 o; o.x = pk2(acc[a][n][0] * rs * gn.x * g0, acc[a][n][1] * rs * gn.y * g1); o.y = pk2(acc[a][n][2] * rs * gn.z * g2, acc[a][n][3] * rs * gn.w * g3);
            *(u32x2*)(OB + (size_t)(t0 + i) * DM + 1024 + h * 256 + e) = o; } }
}

DI void pool_unit(const Frame& F, int l, int unit, const float* pool_scale) {
    const int gi = unit & 3, tt = unit >> 2, t0 = tt * 64, tid = F.tid, lane = F.lane, wave = F.wave, w = 2 << gi;
    const bf16* H = wsp<bf16>(F, WS_H);
    LAS bf16* pl = (LAS bf16*)(F.lds);
    constexpr int LDP = 264;
    __syncthreads();
    for (int p = tid; p < 64 * 32; p += NTHR) { const int j = p >> 5, ch = p & 31, t = t0 + j, ts = t & (SEQ - 1);
        const int cnt = (ts + 1 < w) ? ts + 1 : w; float a[8];
#pragma unroll
        for (int i = 0; i < 8; ++i) a[i] = 0.f;
        float u0[8];
        for (int s = 0; s < cnt; ++s) { const u32x4 x = *(const u32x4*)(H + (size_t)(t - s) * NH + C_PU + gi * 256 + 8 * ch); float f[8]; unpack8(x, f);
#pragma unroll
            for (int i = 0; i < 8; ++i) { a[i] += f[i]; if (s == 0) u0[i] = f[i]; } }
        const float ic = 1.0f / (float)cnt;
#pragma unroll
        for (int i = 0; i < 8; ++i) a[i] = a[i] * ic - u0[i];
        *(LAS u32x4*)(pl + j * LDP + 8 * ch) = pack8(a); }
    __syncthreads();
    const bf16* WP = wsp<bf16>(F, WS_WPOOLT) + (size_t)(l * 4 + gi) * 256 * 256;
    f32x4 acc[2][4];
#pragma unroll
    for (int a = 0; a < 2; ++a)
#pragma unroll
        for (int n = 0; n < 4; ++n) acc[a][n] = (f32x4){0.f, 0.f, 0.f, 0.f};
#pragma unroll 2
    for (int kk = 0; kk < 8; ++kk) { bf16x8 af[2];
#pragma unroll
        for (int a = 0; a < 2; ++a) af[a] = frag_glb(WP, 256, 32 * wave + 16 * a, 32 * kk, lane);
#pragma unroll
        for (int n = 0; n < 4; ++n) { const bf16x8 bp = frag_lds(pl, LDP, 16 * n, 32 * kk, lane);
#pragma unroll
            for (int a = 0; a < 2; ++a) acc[a][n] = mma16(af[a], bp, acc[a][n]); } }
    bf16* OB = wsp<bf16>(F, WS_OB);
#pragma unroll
    for (int n = 0; n < 4; ++n) { const int t = t0 + 16 * n + (lane & 15);
#pragma unroll
        for (int a = 0; a < 2; ++a) { const int dd = gi * 256 + 32 * wave + 16 * a + 4 * (lane >> 4);
            const f32x4 sc = *(const f32x4*)(pool_scale + l * 1024 + dd);
            const u32x2 gw = *(const u32x2*)(H + (size_t)t * NH + C_PG + dd);
            const float g0 = bf2f(gw.x & 0xffffu), g1 = bf2f(gw.x >> 16), g2 = bf2f(gw.y & 0xffffu), g3 = bf2f(gw.y >> 16);
            u32x2 o; o.x = pk2(acc[a][n][0] * sc.x * g0, acc[a][n][1] * sc.y * g1); o.y = pk2(acc[a][n][2] * sc.z * g2, acc[a][n][3] * sc.w * g3);
            *(u32x2*)(OB + (size_t)t * DM + dd) = o; } }
}

DI void swa_unit(const Frame& F, int l, int unit, const float* sinks) {
    const int n = unit & 31, hq = (unit >> 5) & 15, b = unit >> 9, kvh = hq >> 3, tid = F.tid, lane = F.lane, wave = F.wave;
    const int tq0 = b * SEQ + n * 128, tk0 = tq0 - 128;
    const bf16* H = wsp<bf16>(F, WS_H); const f32x2* RT = wsp<f32x2>(F, WS_ROPE);
    constexpr int LD = 72, LDPW = 168;
    LAS bf16* qs = (LAS bf16*)(F.lds);
    LAS bf16* ks = (LAS bf16*)(F.lds + 18432);
    LAS bf16* vs = (LAS bf16*)(F.lds + 57600);
    LAS bf16* pw = (LAS bf16*)(F.lds + 96768) + wave * 16 * LDPW;
    __syncthreads();
    for (int p = tid; p < 128 * 4; p += NTHR) { const int i = p >> 2, ch = p & 3; const bf16* src = H + (size_t)(tq0 + i) * NH + C_SQ + hq * 64 + 16 * ch;
        float f[16]; { float a[8], c[8]; unpack8(*(const u32x4*)src, a); unpack8(*(const u32x4*)(src + 8), c);
#pragma unroll
            for (int j = 0; j < 8; ++j) { f[j] = a[j]; f[8 + j] = c[j]; } }
        if (ch == 0) {
#pragma unroll
            for (int j = 0; j < 8; ++j) { const f32x2 cs = RT[(size_t)(tq0 + i) * 8 + j]; const float x1 = f[j], x2 = f[8 + j]; f[j] = x1 * cs.x - x2 * cs.y; f[8 + j] = x2 * cs.x + x1 * cs.y; } }
        float o0[8], o1[8];
#pragma unroll
        for (int j = 0; j < 8; ++j) { o0[j] = f[j] * 0.125f; o1[j] = f[8 + j] * 0.125f; }
        *(LAS u32x4*)(qs + i * LD + 16 * ch) = pack8(o0); *(LAS u32x4*)(qs + i * LD + 16 * ch + 8) = pack8(o1); }
    for (int p = tid; p < 272 * 4; p += NTHR) { const int j = p >> 2, ch = p & 3; const bool ok = (j < 256) && (n > 0 || j >= 128);
        u32x4 k0 = (u32x4){0u, 0u, 0u, 0u}, k1 = k0, v0 = k0, v1 = k0;
        if (ok) { const bf16* ksrc = H + (size_t)(tk0 + j) * NH + C_SK + kvh * 64 + 16 * ch; const bf16* vsrc = H + (size_t)(tk0 + j) * NH + C_SV + kvh * 64 + 16 * ch;
            k0 = *(const u32x4*)ksrc; k1 = *(const u32x4*)(ksrc + 8); v0 = *(const u32x4*)vsrc; v1 = *(const u32x4*)(vsrc + 8);
            if (ch == 0) { float a[8], c[8]; unpack8(k0, a); unpack8(k1, c);
#pragma unroll
                for (int jj = 0; jj < 8; ++jj) { const f32x2 cs = RT[(size_t)(tk0 + j) * 8 + jj]; const float x1 = a[jj], x2 = c[jj]; a[jj] = x1 * cs.x - x2 * cs.y; c[jj] = x2 * cs.x + x1 * cs.y; }
                k0 = pack8(a); k1 = pack8(c); } }
        *(LAS u32x4*)(ks + j * LD + 16 * ch) = k0; *(LAS u32x4*)(ks + j * LD + 16 * ch + 8) = k1;
        *(LAS u32x4*)(vs + j * LD + 16 * ch) = v0; *(LAS u32x4*)(vs + j * LD + 16 * ch + 8) = v1; }
    __syncthreads();
    const int qi = 16 * wave + (lane & 15);
    bf16x8 qf[2];
#pragma unroll
    for (int s = 0; s < 2; ++s) qf[s] = frag_lds(qs, LD, 16 * wave, 32 * s, lane);
    f32x4 sc[10];
#pragma unroll
    for (int jt = 0; jt < 10; ++jt) { sc[jt] = (f32x4){0.f, 0.f, 0.f, 0.f};
#pragma unroll
        for (int s = 0; s < 2; ++s) sc[jt] = mma16(frag_lds(ks, LD, 16 * (wave + jt), 32 * s, lane), qf[s], sc[jt]); }
    const float sink = sinks[l * 16 + hq];
    float mx = sink;
#pragma unroll
    for (int jt = 0; jt < 10; ++jt)
#pragma unroll
        for (int r = 0; r < 4; ++r) { const int kj = 16 * (wave + jt) + 4 * (lane >> 4) + r; const bool ok = (kj > qi) && (kj <= qi + 128) && (n > 0 || kj >= 128);
            sc[jt][r] = ok ? sc[jt][r] : -INFINITY; mx = fmaxf(mx, sc[jt][r]); }
    mx = fmaxf(mx, __shfl_xor(mx, 16)); mx = fmaxf(mx, __shfl_xor(mx, 32));
    float sum = 0.f;
#pragma unroll
    for (int jt = 0; jt < 10; ++jt)
#pragma unroll
        for (int r = 0; r < 4; ++r) { const float p = expf(sc[jt][r] - mx); sc[jt][r] = p; sum += p; }
    sum += __shfl_xor(sum, 16); sum += __shfl_xor(sum, 32);
    const float inv = 1.0f / (sum + expf(sink - mx));
#pragma unroll
    for (int jt = 0; jt < 10; ++jt) { u32x2 o; o.x = pk2(sc[jt][0] * inv, sc[jt][1] * inv); o.y = pk2(sc[jt][2] * inv, sc[jt][3] * inv);
        *(LAS u32x2*)(pw + (lane & 15) * LDPW + 16 * jt + 4 * (lane >> 4)) = o; }
    LDS_WAIT();
    f32x4 oa[4];
#pragma unroll
    for (int dt = 0; dt < 4; ++dt) oa[dt] = (f32x4){0.f, 0.f, 0.f, 0.f};
#pragma unroll
    for (int s = 0; s < 5; ++s) { const bf16x8 pf = frag_lds(pw, LDPW, 0, 32 * s, lane);
#pragma unroll
        for (int dt = 0; dt < 4; ++dt) oa[dt] = mma16(frag_tr(vs, LD, 16 * wave + 32 * s, 16 * dt, lane), pf, oa[dt]); }
    bf16* OB = wsp<bf16>(F, WS_OB);
    { const int t = tq0 + qi;
#pragma unroll
      for (int dt = 0; dt < 4; ++dt) { const int dd = hq * 64 + 16 * dt + 4 * (lane >> 4);
          const u32x2 gw = *(const u32x2*)(H + (size_t)t * NH + C_SG + dd);
          const float g0 = bf2f(gw.x & 0xffffu), g1 = bf2f(gw.x >> 16), g2 = bf2f(gw.y & 0xffffu), g3 = bf2f(gw.y >> 16);
          u32x2 o; o.x = pk2(oa[dt][0] * g0, oa[dt][1] * g1); o.y = pk2(oa[dt][2] * g2, oa[dt][3] * g3);
          *(u32x2*)(OB + (size_t)t * DM + 2048 + dd) = o; } }
}

DI void mem_unit(const Frame& F, int l, int unit) {
    const int n = unit & 31, hx = (unit >> 5) & 3, b = unit >> 7, lane = F.lane, wave = F.wave;
    const int tq0 = b * SEQ + n * 128 + 16 * wave;
    const bf16* H = wsp<bf16>(F, WS_H);
    const bf16* MK = wsp<bf16>(F, WS_MK) + (size_t)l * 512 * 1024 + (size_t)b * 256 * 1024 + hx * 256;
    const bf16* MVT = wsp<bf16>(F, WS_MVT) + (size_t)l * 1024 * 512 + (size_t)hx * 256 * 512 + b * 256;
    constexpr int LDPW = 264;
    LAS bf16* pw = (LAS bf16*)(F.lds) + wave * 16 * LDPW;
    __syncthreads();
    bf16x8 qf[8];
#pragma unroll
    for (int s = 0; s < 8; ++s) qf[s] = frag_glb(H + C_XQ + hx * 256, NH, tq0, 32 * s, lane);
    f32x4 sc[16];
#pragma unroll
    for (int jt = 0; jt < 16; ++jt) { sc[jt] = (f32x4){0.f, 0.f, 0.f, 0.f};
#pragma unroll
        for (int s = 0; s < 8; ++s) sc[jt] = mma16(frag_glb(MK, 1024, 16 * jt, 32 * s, lane), qf[s], sc[jt]); }
    float mx = -INFINITY;
#pragma unroll
    for (int jt = 0; jt < 16; ++jt)
#pragma unroll
        for (int r = 0; r < 4; ++r) { sc[jt][r] *= 0.0625f; mx = fmaxf(mx, sc[jt][r]); }
    mx = fmaxf(mx, __shfl_xor(mx, 16)); mx = fmaxf(mx, __shfl_xor(mx, 32));
    float sum = 0.f;
#pragma unroll
    for (int jt = 0; jt < 16; ++jt)
#pragma unroll
        for (int r = 0; r < 4; ++r) { const float p = expf(sc[jt][r] - mx); sc[jt][r] = p; sum += p; }
    sum += __shfl_xor(sum, 16); sum += __shfl_xor(sum, 32);
    const float inv = 1.0f / sum;
#pragma unroll
    for (int jt = 0; jt < 16; ++jt) { u32x2 o; o.x = pk2(sc[jt][0] * inv, sc[jt][1] * inv); o.y = pk2(sc[jt][2] * inv, sc[jt][3] * inv);
        *(LAS u32x2*)(pw + (lane & 15) * LDPW + 16 * jt + 4 * (lane >> 4)) = o; }
    LDS_WAIT();
    bf16x8 pf[8];
#pragma unroll
    for (int s = 0; s < 8; ++s) pf[s] = frag_lds(pw, LDPW, 0, 32 * s, lane);
    bf16* OB = wsp<bf16>(F, WS_OB); const int t = tq0 + (lane & 15);
#pragma unroll 4
    for (int dt = 0; dt < 16; ++dt) { f32x4 oa = (f32x4){0.f, 0.f, 0.f, 0.f};
#pragma unroll
        for (int s = 0; s < 8; ++s) oa = mma16(frag_glb(MVT, 512, 16 * dt, 32 * s, lane), pf[s], oa);
        const int dd = hx * 256 + 16 * dt + 4 * (lane >> 4);
        const u32x2 gw = *(const u32x2*)(H + (size_t)t * NH + C_XG + dd);
        const float g0 = bf2f(gw.x & 0xffffu), g1 = bf2f(gw.x >> 16), g2 = bf2f(gw.y & 0xffffu), g3 = bf2f(gw.y >> 16);
        u32x2 o; o.x = pk2(oa[0] * g0, oa[1] * g1); o.y = pk2(oa[2] * g2, oa[3] * g3);
        *(u32x2*)(OB + (size_t)t * DM + 3072 + dd) = o; }
}

DI void ln_phase(const Frame& F, int l, const float* ln_g, const float* ln_b) {
    const int gw = F.wg * NWAVES + F.wave, NGW = F.G * NWAVES, lane = F.lane;
    const float* g = ln_g + l * DM; const float* bb = ln_b + l * DM;
    for (int m = gw; m < MTOK; m += NGW) {
        f32x4* row = (f32x4*)(F.out + (size_t)m * DM) + lane; const f32x4* zrow = (const f32x4*)(wsp<float>(F, WS_Z) + (size_t)m * DM) + lane;
        f32x4 v[16]; float s = 0.f;
#pragma unroll
        for (int j = 0; j < 16; ++j) { v[j] = zrow[64 * j]; s += (v[j].x + v[j].y) + (v[j].z + v[j].w); }
        const float mean = wave_sum(s) * (1.f / DM); float s2 = 0.f;
#pragma unroll
        for (int j = 0; j < 16; ++j) { v[j] = v[j] - mean; s2 += (v[j].x * v[j].x + v[j].y * v[j].y) + (v[j].z * v[j].z + v[j].w * v[j].w); }
        const float rstd = 1.f / sqrtf(wave_sum(s2) * (1.f / DM) + LN_EPS);
        u32x2* xb = (u32x2*)(wsp<bf16>(F, WS_XB) + (size_t)m * DM) + lane; unsigned* x8 = (unsigned*)(wsp<unsigned char>(F, WS_X8) + (size_t)m * DM) + lane;
#pragma unroll
        for (int j = 0; j < 16; ++j) { const f32x4 gg = *((const f32x4*)g + lane + 64 * j), be = *((const f32x4*)bb + lane + 64 * j);
            const f32x4 o = v[j] * rstd * gg + be; row[64 * j] = o;
            if (l + 1 < DEPTH) { u32x2 w; w.x = pk2(o.x, o.y); w.y = pk2(o.z, o.w); xb[64 * j] = w; x8[64 * j] = pk4_fp8(o.x * X8_SCALE, o.y * X8_SCALE, o.z * X8_SCALE, o.w * X8_SCALE); } }
    }
}

struct Args { const void* in[15]; float* out; unsigned char* ws; int ph_lo, ph_hi; };
constexpr int PH_PER_LAYER = 7, N_PHASES = 1 + PH_PER_LAYER * DEPTH;
#define IN(k) (lo <= (k) && (k) < hi)
#ifndef PH_MASK
#define PH_MASK 0xffff
#endif
#define PHM(b) ((PH_MASK >> (b)) & 1)
#ifndef REP_MASK
#define REP_MASK 0
#endif
#define REPS(b) (((REP_MASK >> (b)) & 1) ? 2 : 1)
#define SEAM(k) do { if (IN(k) && IN((k) + 1)) xcd_barrier(bar); } while (0)
template <int l> DI void layer_body(const Frame& F, const Args& args, const int lo, const int hi, const XcdBarrier& bar) {
        const int p0 = 1 + PH_PER_LAYER * l;
        if (PHM(1) && IN(p0)) { {
            SchedInProj S; S.G = F.G; S.c = F.wg; S.n_extra = (l == 0) ? 32 : 0; S.XB = (const char*)(F.ws + WS_XB); S.WT = (const char*)(F.ws + WS_WINT) + (size_t)l * NH * 4096 * 2;
            S.MEMB = (const char*)(F.ws + WS_MEMB); S.WKV = (const char*)(F.ws + WS_WMKVT);
            EpiH E{wsp<bf16>(F, WS_H), wsp<bf16>(F, WS_MK), wsp<bf16>(F, WS_MVT)};
            pg8::gemm_phase<EpiH, SchedInProj, 2, true>(F.lds, 4096, S, E);
            pg8::SchedStatic S8; S8.nM = 32; S8.nN = 64 * (2 / F8NB); S8.G = F.G; S8.c = F.wg; S8.A = (const char*)(F.ws + WS_X8); S8.B = (const char*)(F.ws + WS_W8) + (size_t)l * 16384 * 4096;
            S8.astep = (size_t)256 * 4096; S8.bstep = (size_t)(128 * F8NB) * 4096;
            EpiMG<F8NB> E8{wsp<bf16>(F, WS_H)};
            pg8::gemm_phase<EpiMG<F8NB>, pg8::SchedStatic, F8NB, (F8NB == 2), true>(F.lds, 2048, S8, E8);
        }
        if (REPS(1) == 2) {
            SchedInProj S; S.G = F.G; S.c = F.wg; S.n_extra = (l == 0) ? 32 : 0; S.XB = (const char*)(F.ws + WS_XB); S.WT = (const char*)(F.ws + WS_WINT) + (size_t)l * NH * 4096 * 2;
            S.MEMB = (const char*)(F.ws + WS_MEMB); S.WKV = (const char*)(F.ws + WS_WMKVT);
            EpiH E{wsp<bf16>(F, WS_H), wsp<bf16>(F, WS_MK), wsp<bf16>(F, WS_MVT)};
            pg8::gemm_phase<EpiH, SchedInProj, 2, true>(F.lds, 4096, S, E);
            pg8::SchedStatic S8; S8.nM = 32; S8.nN = 64 * (2 / F8NB); S8.G = F.G; S8.c = F.wg; S8.A = (const char*)(F.ws + WS_X8); S8.B = (const char*)(F.ws + WS_W8) + (size_t)l * 16384 * 4096;
            S8.astep = (size_t)256 * 4096; S8.bstep = (size_t)(128 * F8NB) * 4096;
            EpiMG<F8NB> E8{wsp<bf16>(F, WS_H)};
            pg8::gemm_phase<EpiMG<F8NB>, pg8::SchedStatic, F8NB, (F8NB == 2), true>(F.lds, 2048, S8, E8);
        } }
        SEAM(p0);
        if (PHM(2) && IN(p0 + 1)) for (int rep = 0; rep < REPS(2); ++rep) { for (int u = F.wg; u < 512; u += F.G) gla_a_unit(F, l, u, (const float*)args.in[6], (const float*)args.in[7]); }
        SEAM(p0 + 1);
        if (PHM(3) && IN(p0 + 2)) for (int rep = 0; rep < REPS(3); ++rep) { gla_scan(F); }
        SEAM(p0 + 2);
        if (PHM(4) && IN(p0 + 3)) for (int rep = 0; rep < REPS(4); ++rep) {
            for (int u = F.wg; u < 512; u += F.G) gla_c_unit(F, l, u, (const float*)args.in[8]);
            for (int u = F.wg; u < 512; u += F.G) pool_unit(F, l, u, (const float*)args.in[5]);
            for (int u = F.wg; u < 1024; u += F.G) swa_unit(F, l, u, (const float*)args.in[9]);
            for (int u = F.wg; u < 256; u += F.G) mem_unit(F, l, u);
            __syncthreads();
        }
        SEAM(p0 + 3);
        if (PHM(5) && IN(p0 + 4)) { {
            pg8::SchedStatic S; S.nM = 32; S.nN = 32; S.G = F.G; S.c = F.wg; S.A = (const char*)(F.ws + WS_OB); S.B = (const char*)(F.ws + WS_WBRT) + (size_t)l * 4096 * 4096 * 2;
            S.astep = (size_t)256 * 4096 * 2; S.bstep = (size_t)128 * 4096 * 2;
            EpiGate E{wsp<bf16>(F, WS_H), wsp<bf16>(F, WS_YB)};
            pg8::gemm_phase<EpiGate, pg8::SchedStatic, 1, false>(F.lds, 4096, S, E);
        }
        if (REPS(5) == 2) {
            pg8::SchedStatic S; S.nM = 32; S.nN = 32; S.G = F.G; S.c = F.wg; S.A = (const char*)(F.ws + WS_OB); S.B = (const char*)(F.ws + WS_WBRT) + (size_t)l * 4096 * 4096 * 2;
            S.astep = (size_t)256 * 4096 * 2; S.bstep = (size_t)128 * 4096 * 2;
            EpiGate E{wsp<bf16>(F, WS_H), wsp<bf16>(F, WS_YB)};
            pg8::gemm_phase<EpiGate, pg8::SchedStatic, 1, false>(F.lds, 4096, S, E);
        } }
        SEAM(p0 + 4);
        if (PHM(6) && IN(p0 + 5)) { {
            pg8::SchedStatic S; S.nM = 32; S.nN = 16; S.G = F.G; S.c = F.wg; S.A = (const char*)(F.ws + WS_YB); S.B = (const char*)(F.ws + WS_WOUTT) + (size_t)l * 4096 * 4096 * 2;
            S.astep = (size_t)256 * 4096 * 2; S.bstep = (size_t)256 * 4096 * 2;
            EpiRes E{l == 0 ? (const float*)args.in[0] : (const float*)F.out, wsp<float>(F, WS_Z)};
            pg8::gemm_phase<EpiRes, pg8::SchedStatic, 2, true>(F.lds, 4096, S, E);
        }
        if (REPS(6) == 2) {
            pg8::SchedStatic S; S.nM = 32; S.nN = 16; S.G = F.G; S.c = F.wg; S.A = (const char*)(F.ws + WS_YB); S.B = (const char*)(F.ws + WS_WOUTT) + (size_t)l * 4096 * 4096 * 2;
            S.astep = (size_t)256 * 4096 * 2; S.bstep = (size_t)256 * 4096 * 2;
            EpiRes E{l == 0 ? (const float*)args.in[0] : (const float*)F.out, wsp<float>(F, WS_Z)};
            pg8::gemm_phase<EpiRes, pg8::SchedStatic, 2, true>(F.lds, 4096, S, E);
        } }
        SEAM(p0 + 5);
        if (PHM(7) && IN(p0 + 6)) for (int rep = 0; rep < REPS(7); ++rep) { ln_phase(F, l, (const float*)args.in[13], (const float*)args.in[14]); }
        SEAM(p0 + 6);
}


__global__ void __launch_bounds__(NTHR, 2) mk_fwd(Args args) {
    extern __shared__ __attribute__((aligned(16))) unsigned char lds_raw[];
    Frame F;
    F.lds = (LAS unsigned char*)lds_raw;
    F.tid = threadIdx.x; F.lane = F.tid & 63; F.wave = __builtin_amdgcn_readfirstlane(F.tid >> 6); F.G = gridDim.x; F.wg = blockIdx.x;
    F.out = args.out; F.ws = args.ws;
    volatile LAS unsigned* MISC = (volatile LAS unsigned*)(F.lds + MISC_OFF);
    for (int u = F.tid; u < (LDS_BYTES - LDSCTL_OFF) / 4; u += NTHR) ((LAS unsigned*)(F.lds + LDSCTL_OFF))[u] = 0u;
    __syncthreads();
    unsigned* barw = (unsigned*)(F.ws + WS_CTL) + CW_BAR;
    XcdBarrier bar; bar.bar = barw; bar.x = 0; bar.st = nullptr;
    const int lo = args.ph_lo, hi = args.ph_hi;
    if (hi - lo > 1) bar = xcd_barrier_post(barw, MISC + 8);

    if (PHM(0) && IN(0)) for (int rep = 0; rep < REPS(0); ++rep) { prologue(F, (const float*)args.in[0], (const float*)args.in[1], (const int*)args.in[2], (const float*)args.in[3], (const float*)args.in[4], (const float*)args.in[10], (const float*)args.in[11], (const float*)args.in[12]); }
    SEAM(0);
    layer_body<0>(F, args, lo, hi, bar);
    layer_body<1>(F, args, lo, hi, bar);
#undef IN
#undef SEAM
}

extern "C" void kernel_launch(void* const* d_in, const int* in_sizes, int n_in, void* d_out, int out_size, void* d_ws, size_t ws_size, hipStream_t stream) {
    static int grid = 0;
    if (grid == 0) {
        if (n_in != 15 || out_size != MTOK * DM || ws_size < WS_END) { fprintf(stderr, "kernel_launch: unexpected sizes (n_in %d, out %d, ws %zu); nothing launched\n", n_in, out_size, ws_size); grid = -1; return; }
        int dev = 0, cus = 0, per_cu = 0;
        if (hipGetDevice(&dev) != hipSuccess || hipDeviceGetAttribute(&cus, hipDeviceAttributeMultiprocessorCount, dev) != hipSuccess) { grid = -1; return; }
        if (hipFuncSetAttribute((const void*)mk_fwd, hipFuncAttributeMaxDynamicSharedMemorySize, LDS_BYTES) != hipSuccess) { fprintf(stderr, "kernel_launch: hipFuncSetAttribute failed\n"); grid = -1; return; }
        if (hipOccupancyMaxActiveBlocksPerMultiprocessor(&per_cu, (const void*)mk_fwd, NTHR, LDS_BYTES) != hipSuccess || per_cu < 1) fprintf(stderr, "kernel_launch: occupancy query says %d\n", per_cu);
        (void)hipGetLastError();
        grid = cus;
    }
    if (grid < 0) return;
    (void)hipMemsetAsync((char*)d_ws + WS_CTL, 0, CTL_ZERO_BYTES, stream);
    Args a{};
    for (int i = 0; i < 15; ++i) a.in[i] = d_in[i];
    a.out = (float*)d_out; a.ws = (unsigned char*)d_ws;
#if MK_PER_PHASE
    for (int p = 0; p < N_PHASES; ++p) { a.ph_lo = p; a.ph_hi = p + 1; hipLaunchKernelGGL(mk_fwd, dim3(grid), dim3(NTHR), LDS_BYTES, stream, a); }
#else
    a.ph_lo = 0; a.ph_hi = N_PHASES;
    hipLaunchKernelGGL(mk_fwd, dim3(grid), dim3(NTHR), LDS_BYTES, stream, a);
#endif
}
```

```cpp
#include <hip/hip_runtime.h>
#include <cstdio>
#include <cstdint>

#ifndef F8ASM1
#define F8ASM1 0
#endif
#ifndef F8NB
#define F8NB 1
#endif
#ifndef MK_PER_PHASE
#define MK_PER_PHASE 0
#endif

#define DI __device__ __forceinline__
#define LAS __attribute__((address_space(3)))
#define GAS __attribute__((address_space(1)))
typedef unsigned short bf16;
typedef short bf16x8 __attribute__((ext_vector_type(8)));
typedef short s16x4 __attribute__((ext_vector_type(4)));
typedef short v4i16_t __attribute__((ext_vector_type(4)));
typedef float f32x4 __attribute__((ext_vector_type(4)));
typedef float f32x2 __attribute__((ext_vector_type(2)));
typedef unsigned u32x4 __attribute__((ext_vector_type(4)));
typedef unsigned u32x2 __attribute__((ext_vector_type(2)));

constexpr int BATCH = 2, SEQ = 4096, DM = 4096, MTOK = BATCH * SEQ, DEPTH = 2;
constexpr int D_IN = 25872, NH = 26112;
constexpr int BW = 1024;
constexpr int MEMLEN = 256;
constexpr int C_PU = 0, C_PG = 1024, C_GQ = 2048, C_GK = 2560, C_GV = 3072, C_GG = 4096, C_SQ = 5120, C_SK = 6144, C_SV = 6272, C_SG = 6400, C_XQ = 7424, C_XG = 8448, C_MG = 9472, C_LR = 25856;
constexpr float LN_EPS = 1e-5f;
constexpr float DN_ALPHA = 1.41421356237309515f;

constexpr size_t MiB = 1u << 20;
constexpr size_t WS_CTL = 0, CTL_ZERO_BYTES = 1 * MiB;
constexpr size_t WS_ROPE = 1 * MiB;
constexpr size_t WS_WPOOLT = 2 * MiB;
constexpr size_t WS_MEMB = 4 * MiB;
constexpr size_t WS_MK = 8 * MiB;
constexpr size_t WS_MVT = 10 * MiB;
constexpr size_t WS_DEC = 12 * MiB;
constexpr size_t WS_WMKVT = 16 * MiB;
constexpr size_t WS_WBRT = 48 * MiB;
constexpr size_t WS_WOUTT = 112 * MiB;
constexpr size_t WS_XB = 176 * MiB;
constexpr size_t WS_OB = 240 * MiB;
constexpr size_t WS_YB = 304 * MiB;
constexpr size_t WS_GU = 368 * MiB;
constexpr size_t WS_GS = 432 * MiB;
constexpr size_t WS_GB = 464 * MiB;
constexpr size_t WS_WINT = 512 * MiB;
constexpr size_t WS_H = 928 * MiB;
constexpr size_t WS_Z = 1336 * MiB;
constexpr size_t WS_X8 = 1464 * MiB;
constexpr size_t WS_W8 = 1496 * MiB;
constexpr size_t WS_END = 1624 * MiB;
constexpr float X8_SCALE = 16.0f, W8_SCALE = 2048.0f, MG_DESCALE = 1.0f / (16.0f * 2048.0f);
constexpr int CW_BAR = 4096;

constexpr int RING_BYTES = 131072;
constexpr int THIN_BYTES = 141312;
constexpr int LDSCTL_OFF = THIN_BYTES, MISC_OFF = LDSCTL_OFF + 320;
constexpr int LDS_BYTES = 147456;
constexpr int NWAVES = 8, NTHR = 512;

DI float bf2f(unsigned v) { return __builtin_bit_cast(float, v << 16); }
DI unsigned f2bf(float f) { unsigned u = __builtin_bit_cast(unsigned, f); return (u + 0x7fffu + ((u >> 16) & 1u)) >> 16; }
DI unsigned pk2(float lo, float hi) { return f2bf(lo) | (f2bf(hi) << 16); }
DI unsigned cvt_pk_bf16(float lo, float hi) { unsigned r; asm volatile("v_cvt_pk_bf16_f32 %0, %1, %2" : "=v"(r) : "v"(lo), "v"(hi)); return r; }
DI float fast_sigmoid(float v) { return __builtin_amdgcn_rcpf(1.0f + __builtin_amdgcn_exp2f(-1.44269504089f * v)); }
DI void unpack8(const u32x4 w, float (&f)[8]) {
    f[0] = bf2f(w.x & 0xffffu); f[1] = bf2f(w.x >> 16); f[2] = bf2f(w.y & 0xffffu); f[3] = bf2f(w.y >> 16);
    f[4] = bf2f(w.z & 0xffffu); f[5] = bf2f(w.z >> 16); f[6] = bf2f(w.w & 0xffffu); f[7] = bf2f(w.w >> 16);
}
DI u32x4 pack8(const float (&f)[8]) { u32x4 w; w.x = pk2(f[0], f[1]); w.y = pk2(f[2], f[3]); w.z = pk2(f[4], f[5]); w.w = pk2(f[6], f[7]); return w; }
DI float clamp448(float v) { return fminf(fmaxf(v, -448.0f), 448.0f); }
DI unsigned pk4_fp8(float a, float b, float c, float d) {
    int w = 0; w = __builtin_amdgcn_cvt_pk_fp8_f32(clamp448(a), clamp448(b), w, false); w = __builtin_amdgcn_cvt_pk_fp8_f32(clamp448(c), clamp448(d), w, true); return (unsigned)w; }
typedef int v8i32 __attribute__((ext_vector_type(8)));
DI f32x4 mma16(bf16x8 a, bf16x8 b, f32x4 c) { return __builtin_amdgcn_mfma_f32_16x16x32_bf16(a, b, c, 0, 0, 0); }
DI bf16x8 frag_lds(const LAS bf16* img, int ld, int idx0, int k0, int lane) { return *(const LAS bf16x8*)(img + (idx0 + (lane & 15)) * ld + k0 + 8 * (lane >> 4)); }
DI bf16x8 frag_glb(const bf16* img, size_t ld, int idx0, int k0, int lane) { return *(const bf16x8*)(img + (size_t)(idx0 + (lane & 15)) * ld + k0 + 8 * (lane >> 4)); }
DI s16x4 tr4(const LAS bf16* p) { return __builtin_bit_cast(s16x4, __builtin_amdgcn_ds_read_tr16_b64_v4i16((LAS v4i16_t*)p)); }
DI bf16x8 frag_tr(const LAS bf16* img, int ld, int k0, int idx0, int lane) {
    const int g = lane >> 4, q = (lane >> 2) & 3, p = lane & 3;
    const LAS bf16* a0 = img + (k0 + 8 * g + q) * ld + idx0 + 4 * p;
    const s16x4 lo = tr4(a0), hi = tr4(a0 + 4 * ld);
    return __builtin_shufflevector(lo, hi, 0, 1, 2, 3, 4, 5, 6, 7);
}
DI float wave_sum(float v) {
#pragma unroll
    for (int o = 1; o < 64; o <<= 1) v += __shfl_xor(v, o);
    return v;
}
#define LDS_WAIT() asm volatile("s_waitcnt lgkmcnt(0)" ::: "memory")
#define VM_WAIT() asm volatile("s_waitcnt vmcnt(0)" ::: "memory")

namespace pg8 {
constexpr int BM = 256, BK = 64, HALF = 128, HTB = HALF * BK * 2, STAGE_BYTES = 8 * HTB, NXCD = 8, WGM = 8;
__host__ __device__ __forceinline__ int lds_byte(int r, int c) { const int st = (r >> 4) * 2 + (c >> 5), rr = r & 15, cc = c & 31, ob = rr * 64 + cc * 2; return st * 1024 + (ob ^ (((ob >> 9) & 1) << 5)); }
__host__ __device__ __forceinline__ void stage_rc(int b, int& R, int& C) { const int st = b / 1024, sb = b % 1024, swz = sb ^ (((sb >> 9) & 1) << 5); R = (st >> 1) * 16 + swz / 64; C = (st & 1) * 32 + (swz % 64) / 2; }
__host__ __device__ __forceinline__ int perm32(int rho) { const int n = rho >> 4, i = rho & 15; return 8 * (i >> 2) + 4 * n + (i & 3); }

struct Unit { int pm, pn, gi; };

DI void static_tile(int L, int nM, int nN, int& pm, int& pn) {
    const int nwg = nM * nN; int wgid = L;
    { const int q = nwg / NXCD, r = nwg % NXCD, xcd = wgid % NXCD, off = wgid / NXCD; wgid = (xcd < r ? xcd * (q + 1) : r * (q + 1) + (xcd - r) * q) + off; }
    const int nig = WGM * nN, gid = wgid / nig, fm = gid * WGM, gsz = (nM - fm) < WGM ? (nM - fm) : WGM;
    pm = fm + ((wgid % nig) % gsz); pn = (wgid % nig) / gsz;
}
struct SchedStatic {
    int nM, nN, G, c; const char* A; const char* B; size_t astep, bstep;
    DI bool next(int i, Unit& u) const { const long L = (long)i * G + c; if (L >= (long)nM * nN) return false; static_tile((int)L, nM, nN, u.pm, u.pn); u.gi = 0; return true; }
    DI const char* abase(const Unit& u) const { return A + (size_t)u.pm * astep; }
    DI const char* bbase(const Unit& u) const { return B + (size_t)u.pn * bstep; }
};

template <class Epi, class Sched, int NB, bool ALIGN_EPI, bool F8 = false>
DI void gemm_phase(LAS unsigned char* lds, const int K, const Sched& S, const Epi& E) {
    const int tid = threadIdx.x, wid = __builtin_amdgcn_readfirstlane(tid >> 6), lane = tid & 63, wr = wid >> 2, wc = wid & 3, fr = lane & 15, fq = lane >> 4;
    const int nt = K / BK;
    unsigned voffA[2], voffB[2];
#pragma unroll
    for (int i = 0; i < 2; ++i) { int R, C; stage_rc(tid * 16 + i * 8192, R, C); const int Rb = Epi::PERM ? ((R & ~31) + perm32(R & 31)) : R;
        voffA[i] = (unsigned)(R * K + C) * 2u; voffB[i] = (unsigned)(Rb * K + C) * 2u; }
    const size_t kstep = (size_t)(BK * 2);
    const size_t hstep = (size_t)HALF * K * 2;
    const unsigned ldsw = (unsigned)wid * 1024u;
    const int aoff = lds_byte(wr * 64 + fr, F8 ? fq * 16 : fq * 8), boff = lds_byte(wc * 32 + fr, F8 ? fq * 16 : fq * 8);
    constexpr int KOFF = F8 ? 16 : 1024;
    const unsigned one_scale = 0x7f7f7f7fu;
#define PG8_SA(b, h) (((b) * 2 + (h)) * HTB)
#define PG8_SB(b, h) ((4 + (b) * 2 + (h)) * HTB)
#define PG8_STAGE(bufoff, gbase, voff) do { _Pragma("unroll") for (int _i = 0; _i < 2; ++_i) \
        __builtin_amdgcn_global_load_lds((const unsigned*)((const char*)(gbase) + (voff)[_i]), (LAS unsigned*)(lds + (bufoff) + ldsw + _i * 8192), 16, 0, 0); } while (0)
#define PG8_LDA(dst, b, h) do { _Pragma("unroll") for (int m = 0; m < 4; ++m) _Pragma("unroll") for (int k = 0; k < 2; ++k) dst[m][k] = *(const LAS bf16x8*)(lds + PG8_SA(b, h) + aoff + m * 2048 + k * KOFF); } while (0)
#define PG8_LDB(dst, b, h) do { _Pragma("unroll") for (int n = 0; n < 2; ++n) _Pragma("unroll") for (int k = 0; k < 2; ++k) dst[n][k] = *(const LAS bf16x8*)(lds + PG8_SB(b, h) + boff + n * 2048 + k * KOFF); } while (0)
#define PG8_CAT(x) __builtin_bit_cast(v8i32, __builtin_shufflevector((x)[0], (x)[1], 0, 1, 2, 3, 4, 5, 6, 7, 8, 9, 10, 11, 12, 13, 14, 15))
#define PG8_MMA(ai, bj, At, Bt) do { __builtin_amdgcn_s_setprio(1); _Pragma("unroll") for (int m = 0; m < 4; ++m) _Pragma("unroll") for (int n = 0; n < 2; ++n) { \
        if constexpr (F8 && NB == 1 && !F8ASM1) acc[ai][bj][m][n] = __builtin_amdgcn_mfma_scale_f32_16x16x128_f8f6f4(PG8_CAT(Bt[n]), PG8_CAT(At[m]), acc[ai][bj][m][n], 0, 0, 0, 0x7f7f7f7f, 0, 0x7f7f7f7f); \
        else if constexpr (F8) { asm volatile("v_mfma_scale_f32_16x16x128_f8f6f4 %0, %1, %2, %0, %3, %3 op_sel_hi:[0,0,0]" : "+v"(acc[ai][bj][m][n]) : "v"(PG8_CAT(Bt[n])), "v"(PG8_CAT(At[m])), "v"(one_scale)); } \
        else { _Pragma("unroll") for (int k = 0; k < 2; ++k) acc[ai][bj][m][n] = __builtin_amdgcn_mfma_f32_16x16x32_bf16(Bt[n][k], At[m][k], acc[ai][bj][m][n], 0, 0, 0); } } \
        __builtin_amdgcn_s_setprio(0); } while (0)
#define PG8_WAIT_V(n) asm volatile("s_waitcnt vmcnt(" #n ")" ::: "memory")
#define PG8_WAIT_L(n) asm volatile("s_waitcnt lgkmcnt(" #n ")" ::: "memory")
#define PG8_BAR __builtin_amdgcn_s_barrier()
#define PG8_SCHED __builtin_amdgcn_sched_barrier(0)
#define PG8_WAIT_MAIN() do { if constexpr (NB == 2) PG8_WAIT_V(8); else PG8_WAIT_V(6); } while (0)
    Unit cur, nxt; int ui = 0;
    if (!S.next(0, cur)) return;
    f32x4 acc[2][NB][4][2];
    f32x4 yac[2][4][2];
#pragma unroll
    for (int a = 0; a < 2; ++a)
#pragma unroll
        for (int m = 0; m < 4; ++m)
#pragma unroll
            for (int n = 0; n < 2; ++n) { yac[a][m][n] = (f32x4){0.f, 0.f, 0.f, 0.f};
#pragma unroll
                for (int b = 0; b < NB; ++b) acc[a][b][m][n] = (f32x4){0.f, 0.f, 0.f, 0.f}; }
    bf16x8 At[4][2], B0[2][2], B1[2][2];
    const char* cA = S.abase(cur); const char* cB = S.bbase(cur);
    if constexpr (NB == 2) {
        PG8_STAGE(PG8_SB(0, 0), cB, voffB); PG8_STAGE(PG8_SB(0, 1), cB + hstep, voffB); PG8_STAGE(PG8_SA(0, 0), cA, voffA); PG8_STAGE(PG8_SA(0, 1), cA + hstep, voffA);
        if (wr == 1) PG8_BAR;
        PG8_WAIT_V(2); PG8_BAR;
        PG8_STAGE(PG8_SB(1, 0), cB + kstep, voffB); PG8_STAGE(PG8_SA(1, 0), cA + kstep, voffA); PG8_STAGE(PG8_SB(1, 1), cB + hstep + kstep, voffB);
        PG8_WAIT_V(6); PG8_BAR;
    } else {
        PG8_STAGE(PG8_SB(0, 0), cB, voffB); PG8_STAGE(PG8_SA(0, 0), cA, voffA); PG8_STAGE(PG8_SA(0, 1), cA + hstep, voffA);
        if (wr == 1) PG8_BAR;
        PG8_WAIT_V(2); PG8_BAR;
        PG8_STAGE(PG8_SB(1, 0), cB + kstep, voffB); PG8_STAGE(PG8_SA(1, 0), cA + kstep, voffA);
        PG8_WAIT_V(4); PG8_BAR;
    }
    for (;;) {
        const bool has_next = S.next(ui + 1, nxt);
        const char* nA = has_next ? S.abase(nxt) : cA; const char* nB = has_next ? S.bbase(nxt) : cB;
        for (int t = 0; t < nt; t += 2) {
            if constexpr (Epi::GATED) { if (t != 0 && (t & 15) == 0) { E.flush(acc, yac, cur, (t >> 4) - 1, wr, wc, fr, fq);
#pragma unroll
                for (int a = 0; a < 2; ++a)
#pragma unroll
                    for (int m = 0; m < 4; ++m)
#pragma unroll
                        for (int n = 0; n < 2; ++n) acc[a][0][m][n] = (f32x4){0.f, 0.f, 0.f, 0.f}; } }
            const bool last = (t == nt - 2);
            const char* a1 = cA + (size_t)(t + 1) * kstep;
            const char* a2 = last ? nA : cA + (size_t)(t + 2) * kstep; const char* b2 = last ? nB : cB + (size_t)(t + 2) * kstep;
            const char* a3 = a2 + kstep; const char* b3 = b2 + kstep;
            if constexpr (NB == 2) {
            PG8_LDB(B0, 0, 0); PG8_LDB(B1, 0, 1); PG8_SCHED; PG8_LDA(At, 0, 0); PG8_STAGE(PG8_SA(1, 1), a1 + hstep, voffA);
            PG8_WAIT_V(8); PG8_WAIT_L(0); PG8_BAR; PG8_MMA(0, 0, At, B0); PG8_MMA(0, 1, At, B1); PG8_BAR; PG8_SCHED;
            PG8_LDA(At, 0, 1); PG8_STAGE(PG8_SB(0, 0), b2, voffB); PG8_STAGE(PG8_SB(0, 1), b2 + hstep, voffB); PG8_STAGE(PG8_SA(0, 0), a2, voffA);
            PG8_WAIT_V(8); PG8_WAIT_L(0); PG8_BAR; PG8_MMA(1, 0, At, B0); PG8_MMA(1, 1, At, B1); PG8_BAR; PG8_SCHED;
            PG8_LDB(B0, 1, 0); PG8_LDB(B1, 1, 1); PG8_SCHED; PG8_LDA(At, 1, 0); PG8_STAGE(PG8_SA(0, 1), a2 + hstep, voffA);
            PG8_WAIT_V(8); PG8_WAIT_L(0); PG8_BAR; PG8_MMA(0, 0, At, B0); PG8_MMA(0, 1, At, B1); PG8_BAR; PG8_SCHED;
            PG8_LDA(At, 1, 1); PG8_STAGE(PG8_SB(1, 0), b3, voffB); PG8_STAGE(PG8_SB(1, 1), b3 + hstep, voffB); PG8_STAGE(PG8_SA(1, 0), a3, voffA);
            PG8_WAIT_V(8); PG8_WAIT_L(0); PG8_BAR; PG8_MMA(1, 0, At, B0); PG8_MMA(1, 1, At, B1); PG8_BAR; PG8_SCHED;
            } else {
            PG8_LDB(B0, 0, 0); PG8_SCHED; PG8_LDA(At, 0, 0); PG8_STAGE(PG8_SA(1, 1), a1 + hstep, voffA);
            PG8_WAIT_V(6); PG8_WAIT_L(0); PG8_BAR; PG8_MMA(0, 0, At, B0); PG8_BAR; PG8_SCHED;
            PG8_LDA(At, 0, 1); PG8_STAGE(PG8_SB(0, 0), b2, voffB); PG8_STAGE(PG8_SA(0, 0), a2, voffA);
            PG8_WAIT_V(6); PG8_WAIT_L(0); PG8_BAR; PG8_MMA(1, 0, At, B0); PG8_BAR; PG8_SCHED;
            PG8_LDB(B0, 1, 0); PG8_SCHED; PG8_LDA(At, 1, 0); PG8_STAGE(PG8_SA(0, 1), a2 + hstep, voffA);
            PG8_WAIT_V(6); PG8_WAIT_L(0); PG8_BAR; PG8_MMA(0, 0, At, B0); PG8_BAR; PG8_SCHED;
            PG8_LDA(At, 1, 1); PG8_STAGE(PG8_SB(1, 0), b3, voffB); PG8_STAGE(PG8_SA(1, 0), a3, voffA);
            PG8_WAIT_V(6); PG8_WAIT_L(0); PG8_BAR; PG8_MMA(1, 0, At, B0); PG8_BAR; PG8_SCHED;
            }
        }
        if constexpr (F8) {
            asm volatile("s_nop 15\n\ts_nop 15" ::: "memory");
#pragma unroll
            for (int a = 0; a < 2; ++a)
#pragma unroll
                for (int b = 0; b < NB; ++b)
#pragma unroll
                    for (int m = 0; m < 4; ++m)
#pragma unroll
                        for (int n = 0; n < 2; ++n) asm volatile("" : "+v"(acc[a][b][m][n]));
        }
        if constexpr (ALIGN_EPI) { if (wr == 0) PG8_BAR; }
        if constexpr (Epi::GATED) { E.finish(acc, yac, cur, wr, wc, fr, fq);
#pragma unroll
            for (int a = 0; a < 2; ++a)
#pragma unroll
                for (int m = 0; m < 4; ++m)
#pragma unroll
                    for (int n = 0; n < 2; ++n) yac[a][m][n] = (f32x4){0.f, 0.f, 0.f, 0.f};
        } else { E(acc, cur, wr, wc, fr, fq); }
        if (!has_next) break;
#pragma unroll
        for (int a = 0; a < 2; ++a)
#pragma unroll
            for (int b = 0; b < NB; ++b)
#pragma unroll
                for (int m = 0; m < 4; ++m)
#pragma unroll
                    for (int n = 0; n < 2; ++n) acc[a][b][m][n] = (f32x4){0.f, 0.f, 0.f, 0.f};
        cur = nxt; cA = nA; cB = nB; ++ui;
        if constexpr (ALIGN_EPI) { if (wr == 1) PG8_BAR; }
    }
    PG8_WAIT_V(0);
    if constexpr (!ALIGN_EPI) { if (wr == 0) PG8_BAR; }
    PG8_BAR;
#undef PG8_SA
#undef PG8_SB
#undef PG8_STAGE
#undef PG8_LDA
#undef PG8_LDB
#undef PG8_MMA
#undef PG8_CAT
#undef PG8_WAIT_V
#undef PG8_WAIT_L
#undef PG8_BAR
#undef PG8_SCHED
#undef PG8_WAIT_MAIN
}
}

#define XB_TMO      128
#define XB_XCNT(j)  (256  + 64 * (j))
#define XB_XSUB(j)  (1280 + 64 * (j))
#define XB_XGEN(j)  (2304 + 64 * (j))
#define XB_TOP      3328
#define XB_TOPGEN   3392
#define XCD_BAR_WORDS 3456
#define XB_SPIN_CAP (1u << 18)
DI unsigned xb_ld(unsigned* p)              { return __hip_atomic_load(p, __ATOMIC_RELAXED, __HIP_MEMORY_SCOPE_AGENT); }
DI unsigned xb_add(unsigned* p, unsigned v) { return __hip_atomic_fetch_add(p, v, __ATOMIC_RELAXED, __HIP_MEMORY_SCOPE_AGENT); }
DI unsigned xb_xcc_id() { return (unsigned)__builtin_amdgcn_s_getreg((3 << 11) | 20) & 0xFu; }
#define XB_SPIN(cond, bar) do { unsigned _sp = 0; while (cond) { __builtin_amdgcn_s_sleep(1); \
    if ((++_sp & 255u) == 0u) { if (xb_ld(&(bar)[XB_TMO])) break; if (_sp > XB_SPIN_CAP) { atomicAdd(&(bar)[XB_TMO], 1u); break; } } } } while (0)
struct XcdBarrier { unsigned* bar; unsigned x; volatile LAS unsigned* st; };
DI XcdBarrier xcd_barrier_post(unsigned* bar, volatile LAS unsigned* st) {
    XcdBarrier b; b.bar = bar; b.x = xb_xcc_id(); b.st = st;
    if (threadIdx.x == 0) (void)xb_add(&bar[XB_XCNT(b.x)], 1u);
    return b;
}
DI void xcd_barrier_complete(unsigned* bar, unsigned x, unsigned& nloc, unsigned& nx) {
    const unsigned G = gridDim.x * gridDim.y * gridDim.z;
    unsigned sum, cnt, mine, sp = 0u;
    for (;;) {
        sum = 0u; cnt = 0u; mine = 0u;
#pragma unroll
        for (unsigned j = 0; j < 16; ++j) { const unsigned c = xb_ld(&bar[XB_XCNT(j)]); sum += c; cnt += (c > 0u) ? 1u : 0u; mine = (j == x) ? c : mine; }
        if (sum == G) break;
        __builtin_amdgcn_s_sleep(1);
        if ((++sp & 255u) == 0u) { if (xb_ld(&bar[XB_TMO])) break; if (sp > XB_SPIN_CAP) { atomicAdd(&bar[XB_TMO], 1u); break; } }
    }
    nloc = mine > 0u ? mine : 1u; nx = cnt > 0u ? cnt : 1u;
}
DI void xcd_barrier(const XcdBarrier& b) {
    asm volatile("s_waitcnt vmcnt(0)" ::: "memory");
    __syncthreads();
    if (threadIdx.x == 0) {
        unsigned* bar = b.bar;
        __builtin_amdgcn_s_waitcnt(0);
        unsigned nloc = b.st[0], nx = b.st[1];
        if (nloc == 0u) { xcd_barrier_complete(bar, b.x, nloc, nx); b.st[0] = nloc; b.st[1] = nx; }
        const unsigned old = xb_add(&bar[XB_XSUB(b.x)], 1u);
        const unsigned gen = old / nloc;
        if (old + 1u == (gen + 1u) * nloc) {
            __builtin_amdgcn_fence(__ATOMIC_RELEASE, "agent");
            asm volatile("s_waitcnt vmcnt(0)" ::: "memory");
            const unsigned og = xb_add(&bar[XB_TOP], 1u);
            const unsigned tg = og / nx;
            if (og + 1u == (tg + 1u) * nx) xb_add(&bar[XB_TOPGEN], 1u);
            else XB_SPIN(xb_ld(&bar[XB_TOPGEN]) == tg, bar);
            __builtin_amdgcn_fence(__ATOMIC_ACQUIRE, "agent");
            xb_add(&bar[XB_XGEN(b.x)], 1u);
            asm volatile("s_waitcnt vmcnt(0)" ::: "memory");
        } else {
            XB_SPIN(xb_ld(&bar[XB_XGEN(b.x)]) == gen, bar);
            __builtin_amdgcn_fence(__ATOMIC_ACQUIRE, "agent");
            asm volatile("s_waitcnt vmcnt(0)" ::: "memory");
        }
    }
    __syncthreads();
}

struct Frame {
    LAS unsigned char* lds;
    int tid, lane, wave, G, wg;
    float* out; unsigned char* ws;
};
template <class T> DI T* wsp(const Frame& F, size_t off) { return (T*)(F.ws + off); }

struct EpiH {
    static constexpr bool PERM = true, GATED = false;
    bf16* H; bf16* MK; bf16* MVT;
    DI void operator()(const f32x4 (&acc)[2][2][4][2], const pg8::Unit& u, int wr, int wc, int fr, int fq) const {
        bf16* base = H; size_t ldc = NH; int act = 0;
        if (u.gi == 0) { const int pn = u.pn; act = ((pn >= 4 && pn < 8) || (pn >= 16 && pn < 20) || (pn >= 25 && pn < 29) || (pn >= 33 && pn < 37)) ? 1 : 0; }
        else { const int lx = (u.gi - 1) >> 1, w = (u.gi - 1) & 1; if (w == 0) { base = MK + (size_t)lx * 512 * 1024; ldc = 1024; } else { base = MVT + (size_t)lx * 1024 * 512; ldc = 512; } }
        const int row0 = u.pm * 256 + wr * 64 + fr, col0 = u.pn * 256 + wc * 32 + 8 * fq;
#pragma unroll
        for (int ai = 0; ai < 2; ++ai)
#pragma unroll
            for (int m = 0; m < 4; ++m) { bf16* rowp = base + (size_t)(row0 + ai * 128 + m * 16) * ldc + col0;
#pragma unroll
                for (int bj = 0; bj < 2; ++bj) { f32x4 v0 = acc[ai][bj][m][0], v1 = acc[ai][bj][m][1];
                    if (act != 0) {
#pragma unroll
                        for (int j = 0; j < 4; ++j) { const float s0 = fast_sigmoid(v0[j]), s1 = fast_sigmoid(v1[j]); v0[j] = (act == 1) ? v0[j] * s0 : s0; v1[j] = (act == 1) ? v1[j] * s1 : s1; } }
                    u32x4 w; w.x = cvt_pk_bf16(v0[0], v0[1]); w.y = cvt_pk_bf16(v0[2], v0[3]); w.z = cvt_pk_bf16(v1[0], v1[1]); w.w = cvt_pk_bf16(v1[2], v1[3]);
                    *(u32x4*)(rowp + bj * 128) = w; } }
    }
};
template <int NB> struct EpiMG {
    static constexpr bool PERM = true, GATED = false;
    bf16* H;
    DI void operator()(const f32x4 (&acc)[2][NB][4][2], const pg8::Unit& u, int wr, int wc, int fr, int fq) const {
        const int row0 = u.pm * 256 + wr * 64 + fr, col0 = C_MG + u.pn * (128 * NB) + wc * 32 + 8 * fq;
#pragma unroll
        for (int ai = 0; ai < 2; ++ai)
#pragma unroll
            for (int m = 0; m < 4; ++m) { bf16* rowp = H + (size_t)(row0 + ai * 128 + m * 16) * NH + col0;
#pragma unroll
                for (int bj = 0; bj < NB; ++bj) { f32x4 v0 = acc[ai][bj][m][0], v1 = acc[ai][bj][m][1];
#pragma unroll
                    for (int j = 0; j < 4; ++j) { v0[j] = fast_sigmoid(v0[j] * MG_DESCALE); v1[j] = fast_sigmoid(v1[j] * MG_DESCALE); }
                    u32x4 w; w.x = cvt_pk_bf16(v0[0], v0[1]); w.y = cvt_pk_bf16(v0[2], v0[3]); w.z = cvt_pk_bf16(v1[0], v1[1]); w.w = cvt_pk_bf16(v1[2], v1[3]);
                    *(u32x4*)(rowp + bj * 128) = w; } }
    }
};
struct EpiRes {
    static constexpr bool PERM = false, GATED = false;
    const float* __restrict__ res; float* __restrict__ out;
    DI void operator()(const f32x4 (&acc)[2][2][4][2], const pg8::Unit& u, int wr, int wc, int fr, int fq) const {
        const int row0 = u.pm * 256 + wr * 64 + fr, col0 = u.pn * 256 + wc * 32 + 4 * fq;
#pragma unroll
        for (int ai = 0; ai < 2; ++ai)
#pragma unroll
            for (int m = 0; m < 4; ++m) { const size_t ro = (size_t)(row0 + ai * 128 + m * 16) * DM + col0;
#pragma unroll
                for (int bj = 0; bj < 2; ++bj)
#pragma unroll
                    for (int n = 0; n < 2; ++n) { const size_t o = ro + bj * 128 + n * 16; const f32x4 r = *(const f32x4*)(res + o); *(f32x4*)(out + o) = r * DN_ALPHA + acc[ai][bj][m][n]; } }
    }
};
struct EpiGate {
    static constexpr bool PERM = true, GATED = true;
    const bf16* H; bf16* Y;
    DI void flush(const f32x4 (&acc)[2][1][4][2], f32x4 (&y)[2][4][2], const pg8::Unit& u, int bi, int wr, int wc, int fr, int fq) const {
        const int row0 = u.pm * 256 + wr * 64 + fr, col0 = u.pn * 128 + wc * 32 + 8 * fq;
#pragma unroll
        for (int ai = 0; ai < 2; ++ai)
#pragma unroll
            for (int m = 0; m < 4; ++m) { const u32x4 gw = *(const u32x4*)(H + (size_t)(row0 + ai * 128 + m * 16) * NH + C_MG + bi * DM + col0);
                float g[8]; unpack8(gw, g);
#pragma unroll
                for (int j = 0; j < 4; ++j) { y[ai][m][0][j] += g[j] * acc[ai][0][m][0][j]; y[ai][m][1][j] += g[4 + j] * acc[ai][0][m][1][j]; }
                if (m == 1 || m == 3) __builtin_amdgcn_sched_barrier(0); }
    }
    DI void finish(const f32x4 (&acc)[2][1][4][2], f32x4 (&y)[2][4][2], const pg8::Unit& u, int wr, int wc, int fr, int fq) const {
        flush(acc, y, u, 3, wr, wc, fr, fq);
        const int row0 = u.pm * 256 + wr * 64 + fr, col0 = u.pn * 128 + wc * 32 + 8 * fq;
#pragma unroll
        for (int ai = 0; ai < 2; ++ai)
#pragma unroll
            for (int m = 0; m < 4; ++m) { const f32x4 v0 = y[ai][m][0], v1 = y[ai][m][1];
                u32x4 w; w.x = cvt_pk_bf16(v0[0], v0[1]); w.y = cvt_pk_bf16(v0[2], v0[3]); w.z = cvt_pk_bf16(v1[0], v1[1]); w.w = cvt_pk_bf16(v1[2], v1[3]);
                *(u32x4*)(Y + (size_t)(row0 + ai * 128 + m * 16) * DM + col0) = w; }
    }
};
struct SchedInProj {
    int G, c, n_extra; const char *XB, *WT, *MEMB, *WKV;
    static constexpr int NM = 32, NN = 38, NU = NM * NN;
    static constexpr size_t TSTEP = (size_t)256 * 4096 * 2;
    DI bool next(int i, pg8::Unit& u) const {
        const long L = (long)i * G + c;
        if (L < NU) { pg8::static_tile((int)L, NM, NN, u.pm, u.pn); if (u.pn == 37) u.pn = 101; u.gi = 0; return true; }
        const int e = (int)(L - NU); if (e >= n_extra) return false;
        const int lx = e >> 4, r = e & 15;
        if (r < 8) { u.pm = r >> 2; u.pn = r & 3; u.gi = 1 + 2 * lx; } else { u.pm = (r - 8) >> 1; u.pn = (r - 8) & 1; u.gi = 2 + 2 * lx; }
        return true;
    }
    DI const char* abase(const pg8::Unit& u) const {
        if (u.gi == 0) return XB + (size_t)u.pm * TSTEP;
        const int lx = (u.gi - 1) >> 1, w = (u.gi - 1) & 1;
        return w == 0 ? MEMB + (size_t)u.pm * TSTEP : WKV + (size_t)lx * 2048 * 4096 * 2 + (size_t)(1024 + u.pm * 256) * 4096 * 2;
    }
    DI const char* bbase(const pg8::Unit& u) const {
        if (u.gi == 0) return WT + (size_t)u.pn * TSTEP;
        const int lx = (u.gi - 1) >> 1, w = (u.gi - 1) & 1;
        return w == 0 ? WKV + (size_t)lx * 2048 * 4096 * 2 + (size_t)u.pn * TSTEP : MEMB + (size_t)u.pn * TSTEP;
    }
};

DI int win_src_col(int n) { return n < 5120 ? n : (n < C_LR ? n + 16 : (n < C_LR + 16 ? n - C_LR + 5120 : -1)); }
template <bool WIN> DI void transpose_item(const float* W, size_t ldw, bf16* WT, size_t ldt, int k0, int n0, int kd0, LAS float* scr, int lane) {
    const int nn = lane & 31; int sc = n0 + nn; if (WIN) sc = win_src_col(sc);
    const float* src = W + (size_t)(k0 + (lane >> 5)) * ldw + (sc < 0 ? 0 : sc);
    float v[32];
#pragma unroll
    for (int i = 0; i < 32; ++i) v[i] = src[(size_t)(2 * i) * ldw];
#pragma unroll
    for (int i = 0; i < 32; ++i) scr[(2 * i + (lane >> 5)) * 33 + nn] = (sc < 0) ? 0.f : v[i];
    LDS_WAIT();
    const int c = lane & 7;
#pragma unroll
    for (int j = 0; j < 4; ++j) { const int n = (lane >> 3) + 8 * j; const LAS float* s = scr + (8 * c) * 33 + n;
        u32x4 o; o.x = pk2(s[0 * 33], s[1 * 33]); o.y = pk2(s[2 * 33], s[3 * 33]); o.z = pk2(s[4 * 33], s[5 * 33]); o.w = pk2(s[6 * 33], s[7 * 33]);
        *(u32x4*)(WT + (size_t)(n0 + n) * ldt + kd0 + 8 * c) = o; }
    LDS_WAIT();
}
DI void transpose_item_f8(const float* W, size_t ldw, unsigned char* WT, size_t ldt, int k0, int n0, LAS float* scr, int lane) {
    const int nn = lane & 31; const int sc = win_src_col(n0 + nn);
    const float* src = W + (size_t)(k0 + (lane >> 5)) * ldw + sc;
#pragma unroll
    for (int h = 0; h < 2; ++h) {
        float v[32];
#pragma unroll
        for (int i = 0; i < 32; ++i) v[i] = src[(size_t)(64 * h + 2 * i) * ldw];
#pragma unroll
        for (int i = 0; i < 32; ++i) scr[(64 * h + 2 * i + (lane >> 5)) * 33 + nn] = v[i] * W8_SCALE;
    }
    LDS_WAIT();
    const int c = lane & 7;
#pragma unroll
    for (int j = 0; j < 4; ++j) { const int n = (lane >> 3) + 8 * j; const LAS float* s = scr + (16 * c) * 33 + n;
        u32x4 o; o.x = pk4_fp8(s[0 * 33], s[1 * 33], s[2 * 33], s[3 * 33]); o.y = pk4_fp8(s[4 * 33], s[5 * 33], s[6 * 33], s[7 * 33]);
        o.z = pk4_fp8(s[8 * 33], s[9 * 33], s[10 * 33], s[11 * 33]); o.w = pk4_fp8(s[12 * 33], s[13 * 33], s[14 * 33], s[15 * 33]);
        *(u32x4*)(WT + (size_t)(n0 - C_MG + n) * ldt + k0 + 16 * c) = o; }
    LDS_WAIT();
}
DI void prologue(const Frame& F, const float* x, const float* mem, const int* pos, const float* w_in, const float* w_pool, const float* w_mem_kv, const float* w_branch, const float* w_out) {
    LAS float* scr = (LAS float*)(F.lds + F.wave * 17408);
    const int gw = F.wg * NWAVES + F.wave, NGW = F.G * NWAVES, lane = F.lane;
    constexpr int I_IN = 64 * (NH / 32), I_KV = 64 * 64, I_BR = 16 * 128, I_OUT = 64 * 128, I_PL = 4 * 8;
    constexpr int NITEMS = 2 * I_IN + 2 * I_KV + 8 * I_BR + 2 * I_OUT + 8 * I_PL;
    for (int it = gw; it < NITEMS; it += NGW) {
        int r = it;
        if (r < 2 * I_IN) { const int l = r / I_IN; r -= l * I_IN; const int nb = r >> 6, kb = r & 63;
            if (nb * 32 >= C_MG && nb * 32 < C_LR) { if ((kb & 1) == 0) transpose_item_f8(w_in + (size_t)l * 4096 * D_IN, D_IN, wsp<unsigned char>(F, WS_W8) + (size_t)l * 16384 * 4096, 4096, kb * 64, nb * 32, scr, lane); }
            else transpose_item<true>(w_in + (size_t)l * 4096 * D_IN, D_IN, wsp<bf16>(F, WS_WINT) + (size_t)l * NH * 4096, 4096, kb * 64, nb * 32, kb * 64, scr, lane);
            continue; }
        r -= 2 * I_IN;
        if (r < 2 * I_KV) { const int l = r / I_KV; r -= l * I_KV; const int nb = r >> 6, kb = r & 63;
            transpose_item<false>(w_mem_kv + (size_t)l * 4096 * 2048, 2048, wsp<bf16>(F, WS_WMKVT) + (size_t)l * 2048 * 4096, 4096, kb * 64, nb * 32, kb * 64, scr, lane); continue; }
        r -= 2 * I_KV;
        if (r < 8 * I_BR) { const int lb = r / I_BR; r -= lb * I_BR; const int l = lb >> 2, bi = lb & 3; const int nb = r >> 4, kb = r & 15;
            transpose_item<false>(w_branch + (size_t)lb * 1024 * 4096, 4096, wsp<bf16>(F, WS_WBRT) + (size_t)l * 4096 * 4096, 4096, kb * 64, nb * 32, bi * 1024 + kb * 64, scr, lane); continue; }
        r -= 8 * I_BR;
        if (r < 2 * I_OUT) { const int l = r / I_OUT; r -= l * I_OUT; const int nb = r >> 6, kb = r & 63;
            transpose_item<false>(w_out + (size_t)l * 4096 * 4096, 4096, wsp<bf16>(F, WS_WOUTT) + (size_t)l * 4096 * 4096, 4096, kb * 64, nb * 32, kb * 64, scr, lane); continue; }
        r -= 2 * I_OUT;
        { const int lg = r / I_PL; r -= lg * I_PL; const int nb = r >> 2, kb = r & 3;
            transpose_item<false>(w_pool + (size_t)lg * 256 * 256, 256, wsp<bf16>(F, WS_WPOOLT) + (size_t)lg * 256 * 256, 256, kb * 64, nb * 32, kb * 64, scr, lane); }
    }
    const size_t gt = (size_t)F.wg * NTHR + F.tid, GT = (size_t)F.G * NTHR;
    { const f32x4* xs = (const f32x4*)x; u32x4* xd = wsp<u32x4>(F, WS_XB);
      u32x2* x8 = wsp<u32x2>(F, WS_X8);
      for (size_t i = gt; i < (size_t)MTOK * DM / 8; i += GT) { const f32x4 a = xs[2 * i], b = xs[2 * i + 1]; u32x4 o; o.x = pk2(a.x, a.y); o.y = pk2(a.z, a.w); o.z = pk2(b.x, b.y); o.w = pk2(b.z, b.w); xd[i] = o;
          u32x2 q; q.x = pk4_fp8(a.x * X8_SCALE, a.y * X8_SCALE, a.z * X8_SCALE, a.w * X8_SCALE); q.y = pk4_fp8(b.x * X8_SCALE, b.y * X8_SCALE, b.z * X8_SCALE, b.w * X8_SCALE); x8[i] = q; }
      const f32x4* ms = (const f32x4*)mem; u32x4* md = wsp<u32x4>(F, WS_MEMB);
      for (size_t i = gt; i < (size_t)BATCH * MEMLEN * DM / 8; i += GT) { const f32x4 a = ms[2 * i], b = ms[2 * i + 1]; u32x4 o; o.x = pk2(a.x, a.y); o.y = pk2(a.z, a.w); o.z = pk2(b.x, b.y); o.w = pk2(b.z, b.w); md[i] = o; } }
    { f32x2* rt = wsp<f32x2>(F, WS_ROPE);
      for (size_t i = gt; i < (size_t)MTOK * 8; i += GT) { const int t = (int)(i >> 3), fi = (int)(i & 7);
          const float inv = (float)pow(500000.0, -(double)fi / 8.0); const float ang = (float)pos[t] * inv;
          rt[i] = (f32x2){cosf(ang), sinf(ang)}; } }
}

DI float fexp(float x) { return __builtin_amdgcn_exp2f(x * 1.44269504089f); }
DI float logsigmoid_f(float z) { return fminf(z, 0.f) - 0.69314718056f * __builtin_amdgcn_logf(1.0f + fexp(-fabsf(z))); }

DI void gla_a_unit(const Frame& F, int l, int unit, const float* w_gla_up, const float* b_gla) {
    const int bh = unit >> 6, c = unit & 63, b = bh >> 2, h = bh & 3, t0 = b * SEQ + c * 64, tid = F.tid, lane = F.lane, wave = F.wave;
    const bf16* H = wsp<bf16>(F, WS_H);
    LAS float* lrs = (LAS float*)(F.lds);
    LAS float* bcs = (LAS float*)(F.lds + 4096);
    LAS float* seg = (LAS float*)(F.lds + 36864);
    LAS bf16* kds = (LAS bf16*)(F.lds + 40960);
    LAS bf16* vs = (LAS bf16*)(F.lds + 59392);
    constexpr int LDK = 136, LDV = 264;
    __syncthreads();
    if (tid < 128) { const int j = tid >> 1, hf = tid & 1; const u32x4 w = *(const u32x4*)(H + (size_t)(t0 + j) * NH + C_LR + 8 * hf); float f[8]; unpack8(w, f);
#pragma unroll
        for (int i = 0; i < 8; ++i) lrs[j * 16 + 8 * hf + i] = f[i]; }
    for (int p = tid; p < 64 * 32; p += NTHR) { const int j = p >> 5, ch = p & 31; *(LAS u32x4*)(vs + j * LDV + 8 * ch) = *(const u32x4*)(H + (size_t)(t0 + j) * NH + C_GV + h * 256 + 8 * ch); }
    __syncthreads();
    const int d = tid & 127, sg = tid >> 7;
    { float w[16];
#pragma unroll
      for (int r = 0; r < 16; ++r) w[r] = w_gla_up[(size_t)l * 16 * 512 + r * 512 + h * 128 + d];
      const float bg = b_gla[l * 512 + h * 128 + d]; float run = 0.f;
      for (int jj = 0; jj < 16; ++jj) { const int j = sg * 16 + jj; float z = bg;
#pragma unroll
          for (int r = 0; r < 16; ++r) z += lrs[j * 16 + r] * w[r];
          run += logsigmoid_f(z) * (1.0f / 16.0f); bcs[j * 128 + d] = run; }
      seg[sg * 128 + d] = run; }
    __syncthreads();
    { float pre = 0.f;
      for (int s = 0; s < sg; ++s) pre += seg[s * 128 + d];
      float* GB = wsp<float>(F, WS_GB);
      for (int jj = 0; jj < 16; ++jj) { const int j = sg * 16 + jj; const float v = bcs[j * 128 + d] + pre; bcs[j * 128 + d] = v; GB[(size_t)(t0 + j) * 512 + h * 128 + d] = v; }
      if (sg == 3) wsp<float>(F, WS_DEC)[(size_t)unit * 128 + d] = expf(bcs[63 * 128 + d]); }
    __syncthreads();
    for (int p = tid; p < 64 * 16; p += NTHR) { const int j = p >> 4, ch = p & 15; const u32x4 w = *(const u32x4*)(H + (size_t)(t0 + j) * NH + C_GK + h * 128 + 8 * ch); float f[8]; unpack8(w, f);
#pragma unroll
        for (int i = 0; i < 8; ++i) f[i] *= fexp(bcs[63 * 128 + 8 * ch + i] - bcs[j * 128 + 8 * ch + i]);
        *(LAS u32x4*)(kds + j * LDK + 8 * ch) = pack8(f); }
    __syncthreads();
    f32x4 acc[2][8];
#pragma unroll
    for (int a = 0; a < 2; ++a)
#pragma unroll
        for (int n = 0; n < 8; ++n) acc[a][n] = (f32x4){0.f, 0.f, 0.f, 0.f};
#pragma unroll
    for (int ks = 0; ks < 2; ++ks) {
        bf16x8 af[2];
#pragma unroll
        for (int a = 0; a < 2; ++a) af[a] = frag_tr(vs, LDV, 32 * ks, 32 * wave + 16 * a, lane);
#pragma unroll
        for (int n = 0; n < 8; ++n) { const bf16x8 bfr = frag_tr(kds, LDK, 32 * ks, 16 * n, lane);
#pragma unroll
            for (int a = 0; a < 2; ++a) acc[a][n] = mma16(af[a], bfr, acc[a][n]); }
    }
    float* U = wsp<float>(F, WS_GU) + (size_t)unit * 256 * 128;
#pragma unroll
    for (int a = 0; a < 2; ++a)
#pragma unroll
        for (int n = 0; n < 8; ++n)
#pragma unroll
            for (int r = 0; r < 4; ++r) U[(size_t)(32 * wave + 16 * a + 4 * (lane >> 4) + r) * 128 + 16 * n + (lane & 15)] = acc[a][n][r];
}

DI void gla_scan(const Frame& F) {
    const float* U = wsp<float>(F, WS_GU); const float* DEC = wsp<float>(F, WS_DEC); unsigned* S = wsp<unsigned>(F, WS_GS);
    const int gt = F.wg * NTHR + F.tid, GT = F.G * NTHR;
    for (int it = gt; it < 8 * 256 * 64; it += GT) {
        const int bh = it >> 14, r = it & 16383, e = r >> 6, dp = r & 63;
        float s0 = 0.f, s1 = 0.f;
#pragma unroll 8
        for (int c = 0; c < 64; ++c) { const size_t un = (size_t)bh * 64 + c; const size_t o = (un * 256 + e) * 128 + 2 * dp;
            const f32x2 u = *(const f32x2*)(U + o); const f32x2 dc = *(const f32x2*)(DEC + un * 128 + 2 * dp);
            S[o >> 1] = pk2(s0, s1); s0 = dc.x * s0 + u.x; s1 = dc.y * s1 + u.y; }
    }
}

DI void gla_c_unit(const Frame& F, int l, int unit, const float* gla_norm) {
    const int bh = unit >> 6, c = unit & 63, b = bh >> 2, h = bh & 3, t0 = b * SEQ + c * 64, tid = F.tid, lane = F.lane, wave = F.wave;
    const bf16* H = wsp<bf16>(F, WS_H);
    LAS bf16* qs = (LAS bf16*)(F.lds);
    LAS bf16* ks = (LAS bf16*)(F.lds + 17408);
    LAS bf16* vs = (LAS bf16*)(F.lds + 34816);
    LAS bf16* ps = (LAS bf16*)(F.lds + 68608);
    LAS float* red = (LAS float*)(F.lds + 77824);
    constexpr int LDK = 136, LDV = 264, LDP = 72;
    __syncthreads();
    const float* GB = wsp<float>(F, WS_GB);
    for (int p = tid; p < 64 * 16; p += NTHR) { const int j = p >> 4, ch = p & 15;
        const u32x4 qw = *(const u32x4*)(H + (size_t)(t0 + j) * NH + C_GQ + h * 128 + 8 * ch); const u32x4 kw = *(const u32x4*)(H + (size_t)(t0 + j) * NH + C_GK + h * 128 + 8 * ch);
        const f32x4 b0 = *(const f32x4*)(GB + (size_t)(t0 + j) * 512 + h * 128 + 8 * ch), b1 = *(const f32x4*)(GB + (size_t)(t0 + j) * 512 + h * 128 + 8 * ch + 4);
        float q[8], k[8]; unpack8(qw, q); unpack8(kw, k); const float bb[8] = {b0.x, b0.y, b0.z, b0.w, b1.x, b1.y, b1.z, b1.w};
#pragma unroll
        for (int i = 0; i < 8; ++i) { const float eb = fexp(bb[i]); q[i] *= eb * 0.08838834764831845f; k[i] *= fexp(-bb[i]); }
        *(LAS u32x4*)(qs + j * LDK + 8 * ch) = pack8(q); *(LAS u32x4*)(ks + j * LDK + 8 * ch) = pack8(k); }
    for (int p = tid; p < 64 * 32; p += NTHR) { const int j = p >> 5, ch = p & 31; *(LAS u32x4*)(vs + j * LDV + 8 * ch) = *(const u32x4*)(H + (size_t)(t0 + j) * NH + C_GV + h * 256 + 8 * ch); }
    __syncthreads();
    { const int it = wave >> 1; f32x4 sa[2] = {(f32x4){0.f, 0.f, 0.f, 0.f}, (f32x4){0.f, 0.f, 0.f, 0.f}};
#pragma unroll
      for (int kk = 0; kk < 4; ++kk) { const bf16x8 qa = frag_lds(qs, LDK, 16 * it, 32 * kk, lane);
#pragma unroll
          for (int jj = 0; jj < 2; ++jj) sa[jj] = mma16(qa, frag_lds(ks, LDK, 16 * (2 * (wave & 1) + jj), 32 * kk, lane), sa[jj]); }
#pragma unroll
      for (int jj = 0; jj < 2; ++jj)
#pragma unroll
          for (int r = 0; r < 4; ++r) { const int i = 16 * it + 4 * (lane >> 4) + r, j = 16 * (2 * (wave & 1) + jj) + (lane & 15);
              ps[i * LDP + j] = (bf16)f2bf(j <= i ? sa[jj][r] : 0.f); } }
    __syncthreads();
    f32x4 acc[2][4];
#pragma unroll
    for (int a = 0; a < 2; ++a)
#pragma unroll
        for (int n = 0; n < 4; ++n) acc[a][n] = (f32x4){0.f, 0.f, 0.f, 0.f};
    const bf16* St = wsp<bf16>(F, WS_GS) + (size_t)unit * 256 * 128;
#pragma unroll
    for (int kk = 0; kk < 4; ++kk) { bf16x8 af[2];
#pragma unroll
        for (int a = 0; a < 2; ++a) af[a] = frag_glb(St, 128, 32 * wave + 16 * a, 32 * kk, lane);
#pragma unroll
        for (int n = 0; n < 4; ++n) { const bf16x8 bq = frag_lds(qs, LDK, 16 * n, 32 * kk, lane);
#pragma unroll
            for (int a = 0; a < 2; ++a) acc[a][n] = mma16(af[a], bq, acc[a][n]); } }
#pragma unroll
    for (int kk = 0; kk < 2; ++kk) { bf16x8 af[2];
#pragma unroll
        for (int a = 0; a < 2; ++a) af[a] = frag_tr(vs, LDV, 32 * kk, 32 * wave + 16 * a, lane);
#pragma unroll
        for (int n = 0; n < 4; ++n) { const bf16x8 bp = frag_lds(ps, LDP, 16 * n, 32 * kk, lane);
#pragma unroll
            for (int a = 0; a < 2; ++a) acc[a][n] = mma16(af[a], bp, acc[a][n]); } }
#pragma unroll
    for (int n = 0; n < 4; ++n) { float s = 0.f;
#pragma unroll
        for (int a = 0; a < 2; ++a)
#pragma unroll
            for (int r = 0; r < 4; ++r) s += acc[a][n][r] * acc[a][n][r];
        s += __shfl_xor(s, 16); s += __shfl_xor(s, 32);
        if (lane < 16) red[wave * 64 + 16 * n + lane] = s; }
    __syncthreads();
    bf16* OB = wsp<bf16>(F, WS_OB);
#pragma unroll
    for (int n = 0; n < 4; ++n) { const int i = 16 * n + (lane & 15); float tot = 0.f;
#pragma unroll
        for (int w = 0; w < 8; ++w) tot += red[w * 64 + i];
        const float rs = 1.0f / sqrtf(tot * (1.0f / 256.0f) + LN_EPS);
#pragma unroll
        for (int a = 0; a < 2; ++a) { const int e = 32 * wave + 16 * a + 4 * (lane >> 4);
            const f32x4 gn = *(const f32x4*)(gla_norm + l * 1024 + h * 256 + e);
            const u32x2 gw = *(const u32x2*)(H + (size_t)(t0 + i) * NH + C_GG + h * 256 + e);
            const float g0 = bf2f(gw.x & 0xffffu), g1 = bf2f(gw.x >> 16), g2 = bf2f(gw.y & 0xffffu), g3 = bf2f(gw.y >> 16);
            u32x2 o; o.x = pk2(acc[a][n][0] * rs * gn.x * g0, acc[a][n][1] * rs * gn.y * g1); o.y = pk2(acc[a][n][2] * rs * gn.z * g2, acc[a][n][3] * rs * gn.w * g3);
            *(u32x2*)(OB + (size_t)(t0 + i) * DM + 1024 + h * 256 + e) = o; } }
}

DI void pool_unit(const Frame& F, int l, int unit, const float* pool_scale) {
    const int gi = unit & 3, tt = unit >> 2, t0 = tt * 64, tid = F.tid, lane = F.lane, wave = F.wave, w = 2 << gi;
    const bf16* H = wsp<bf16>(F, WS_H);
    LAS bf16* pl = (LAS bf16*)(F.lds);
    constexpr int LDP = 264;
    __syncthreads();
    for (int p = tid; p < 64 * 32; p += NTHR) { const int j = p >> 5, ch = p & 31, t = t0 + j, ts = t & (SEQ - 1);
        const int cnt = (ts + 1 < w) ? ts + 1 : w; float a[8];
#pragma unroll
        for (int i = 0; i < 8; ++i) a[i] = 0.f;
        float u0[8];
        for (int s = 0; s < cnt; ++s) { const u32x4 x = *(const u32x4*)(H + (size_t)(t - s) * NH + C_PU + gi * 256 + 8 * ch); float f[8]; unpack8(x, f);
#pragma unroll
            for (int i = 0; i < 8; ++i) { a[i] += f[i]; if (s == 0) u0[i] = f[i]; } }
        const float ic = 1.0f / (float)cnt;
#pragma unroll
        for (int i = 0; i < 8; ++i) a[i] = a[i] * ic - u0[i];
        *(LAS u32x4*)(pl + j * LDP + 8 * ch) = pack8(a); }
    __syncthreads();
    const bf16* WP = wsp<bf16>(F, WS_WPOOLT) + (size_t)(l * 4 + gi) * 256 * 256;
    f32x4 acc[2][4];
#pragma unroll
    for (int a = 0; a < 2; ++a)
#pragma unroll
        for (int n = 0; n < 4; ++n) acc[a][n] = (f32x4){0.f, 0.f, 0.f, 0.f};
#pragma unroll 2
    for (int kk = 0; kk < 8; ++kk) { bf16x8 af[2];
#pragma unroll
        for (int a = 0; a < 2; ++a) af[a] = frag_glb(WP, 256, 32 * wave + 16 * a, 32 * kk, lane);
#pragma unroll
        for (int n = 0; n < 4; ++n) { const bf16x8 bp = frag_lds(pl, LDP, 16 * n, 32 * kk, lane);
#pragma unroll
            for (int a = 0; a < 2; ++a) acc[a][n] = mma16(af[a], bp, acc[a][n]); } }
    bf16* OB = wsp<bf16>(F, WS_OB);
#pragma unroll
    for (int n = 0; n < 4; ++n) { const int t = t0 + 16 * n + (lane & 15);
#pragma unroll
        for (int a = 0; a < 2; ++a) { const int dd = gi * 256 + 32 * wave + 16 * a + 4 * (lane >> 4);
            const f32x4 sc = *(const f32x4*)(pool_scale + l * 1024 + dd);
            const u32x2 gw = *(const u32x2*)(H + (size_t)t * NH + C_PG + dd);
            const float g0 = bf2f(gw.x & 0xffffu), g1 = bf2f(gw.x >> 16), g2 = bf2f(gw.y & 0xffffu), g3 = bf2f(gw.y >> 16);
            u32x2 o; o.x = pk2(acc[a][n][0] * sc.x * g0, acc[a][n][1] * sc.y * g1); o.y = pk2(acc[a][n][2] * sc.z * g2, acc[a][n][3] * sc.w * g3);
            *(u32x2*)(OB + (size_t)t * DM + dd) = o; } }
}

DI void swa_unit(const Frame& F, int l, int unit, const float* sinks) {
    const int n = unit & 31, hq = (unit >> 5) & 15, b = unit >> 9, kvh = hq >> 3, tid = F.tid, lane = F.lane, wave = F.wave;
    const int tq0 = b * SEQ + n * 128, tk0 = tq0 - 128;
    const bf16* H = wsp<bf16>(F, WS_H); const f32x2* RT = wsp<f32x2>(F, WS_ROPE);
    constexpr int LD = 72, LDPW = 168;
    LAS bf16* qs = (LAS bf16*)(F.lds);
    LAS bf16* ks = (LAS bf16*)(F.lds + 18432);
    LAS bf16* vs = (LAS bf16*)(F.lds + 57600);
    LAS bf16* pw = (LAS bf16*)(F.lds + 96768) + wave * 16 * LDPW;
    __syncthreads();
    for (int p = tid; p < 128 * 4; p += NTHR) { const int i = p >> 2, ch = p & 3; const bf16* src = H + (size_t)(tq0 + i) * NH + C_SQ + hq * 64 + 16 * ch;
        float f[16]; { float a[8], c[8]; unpack8(*(const u32x4*)src, a); unpack8(*(const u32x4*)(src + 8), c);
#pragma unroll
            for (int j = 0; j < 8; ++j) { f[j] = a[j]; f[8 + j] = c[j]; } }
        if (ch == 0) {
#pragma unroll
            for (int j = 0; j < 8; ++j) { const f32x2 cs = RT[(size_t)(tq0 + i) * 8 + j]; const float x1 = f[j], x2 = f[8 + j]; f[j] = x1 * cs.x - x2 * cs.y; f[8 + j] = x2 * cs.x + x1 * cs.y; } }
        float o0[8], o1[8];
#pragma unroll
        for (int j = 0; j < 8; ++j) { o0[j] = f[j] * 0.125f; o1[j] = f[8 + j] * 0.125f; }
        *(LAS u32x4*)(qs + i * LD + 16 * ch) = pack8(o0); *(LAS u32x4*)(qs + i * LD + 16 * ch + 8) = pack8(o1); }
    for (int p = tid; p < 272 * 4; p += NTHR) { const int j = p >> 2, ch = p & 3; const bool ok = (j < 256) && (n > 0 || j >= 128);
        u32x4 k0 = (u32x4){0u, 0u, 0u, 0u}, k1 = k0, v0 = k0, v1 = k0;
        if (ok) { const bf16* ksrc = H + (size_t)(tk0 + j) * NH + C_SK + kvh * 64 + 16 * ch; const bf16* vsrc = H + (size_t)(tk0 + j) * NH + C_SV + kvh * 64 + 16 * ch;
            k0 = *(const u32x4*)ksrc; k1 = *(const u32x4*)(ksrc + 8); v0 = *(const u32x4*)vsrc; v1 = *(const u32x4*)(vsrc + 8);
            if (ch == 0) { float a[8], c[8]; unpack8(k0, a); unpack8(k1, c);
#pragma unroll
                for (int jj = 0; jj < 8; ++jj) { const f32x2 cs = RT[(size_t)(tk0 + j) * 8 + jj]; const float x1 = a[jj], x2 = c[jj]; a[jj] = x1 * cs.x - x2 * cs.y; c[jj] = x2 * cs.x + x1 * cs.y; }
                k0 = pack8(a); k1 = pack8(c); } }
        *(LAS u32x4*)(ks + j * LD + 16 * ch) = k0; *(LAS u32x4*)(ks + j * LD + 16 * ch + 8) = k1;
        *(LAS u32x4*)(vs + j * LD + 16 * ch) = v0; *(LAS u32x4*)(vs + j * LD + 16 * ch + 8) = v1; }
    __syncthreads();
    const int qi = 16 * wave + (lane & 15);
    bf16x8 qf[2];
#pragma unroll
    for (int s = 0; s < 2; ++s) qf[s] = frag_lds(qs, LD, 16 * wave, 32 * s, lane);
    f32x4 sc[10];
#pragma unroll
    for (int jt = 0; jt < 10; ++jt) { sc[jt] = (f32x4){0.f, 0.f, 0.f, 0.f};
#pragma unroll
        for (int s = 0; s < 2; ++s) sc[jt] = mma16(frag_lds(ks, LD, 16 * (wave + jt), 32 * s, lane), qf[s], sc[jt]); }
    const float sink = sinks[l * 16 + hq];
    float mx = sink;
#pragma unroll
    for (int jt = 0; jt < 10; ++jt)
#pragma unroll
        for (int r = 0; r < 4; ++r) { const int kj = 16 * (wave + jt) + 4 * (lane >> 4) + r; const bool ok = (kj > qi) && (kj <= qi + 128) && (n > 0 || kj >= 128);
            sc[jt][r] = ok ? sc[jt][r] : -INFINITY; mx = fmaxf(mx, sc[jt][r]); }
    mx = fmaxf(mx, __shfl_xor(mx, 16)); mx = fmaxf(mx, __shfl_xor(mx, 32));
    float sum = 0.f;
#pragma unroll
    for (int jt = 0; jt < 10; ++jt)
#pragma unroll
        for (int r = 0; r < 4; ++r) { const float p = expf(sc[jt][r] - mx); sc[jt][r] = p; sum += p; }
    sum += __shfl_xor(sum, 16); sum += __shfl_xor(sum, 32);
    const float inv = 1.0f / (sum + expf(sink - mx));
#pragma unroll
    for (int jt = 0; jt < 10; ++jt) { u32x2 o; o.x = pk2(sc[jt][0] * inv, sc[jt][1] * inv); o.y = pk2(sc[jt][2] * inv, sc[jt][3] * inv);
        *(LAS u32x2*)(pw + (lane & 15) * LDPW + 16 * jt + 4 * (lane >> 4)) = o; }
    LDS_WAIT();
    f32x4 oa[4];
#pragma unroll
    for (int dt = 0; dt < 4; ++dt) oa[dt] = (f32x4){0.f, 0.f, 0.f, 0.f};
#pragma unroll
    for (int s = 0; s < 5; ++s) { const bf16x8 pf = frag_lds(pw, LDPW, 0, 32 * s, lane);
#pragma unroll
        for (int dt = 0; dt < 4; ++dt) oa[dt] = mma16(frag_tr(vs, LD, 16 * wave + 32 * s, 16 * dt, lane), pf, oa[dt]); }
    bf16* OB = wsp<bf16>(F, WS_OB);
    { const int t = tq0 + qi;
#pragma unroll
      for (int dt = 0; dt < 4; ++dt) { const int dd = hq * 64 + 16 * dt + 4 * (lane >> 4);
          const u32x2 gw = *(const u32x2*)(H + (size_t)t * NH + C_SG + dd);
          const float g0 = bf2f(gw.x & 0xffffu), g1 = bf2f(gw.x >> 16), g2 = bf2f(gw.y & 0xffffu), g3 = bf2f(gw.y >> 16);
          u32x2 o; o.x = pk2(oa[dt][0] * g0, oa[dt][1] * g1); o.y = pk2(oa[dt][2] * g2, oa[dt][3] * g3);
          *(u32x2*)(OB + (size_t)t * DM + 2048 + dd) = o; } }
}

DI void mem_unit(const Frame& F, int l, int unit) {
    const int n = unit & 31, hx = (unit >> 5) & 3, b = unit >> 7, lane = F.lane, wave = F.wave, tid = F.tid;
    const int tq0 = b * SEQ + n * 128 + 16 * wave;
    const bf16* H = wsp<bf16>(F, WS_H);
    const bf16* MK = wsp<bf16>(F, WS_MK) + (size_t)l * 512 * 1024 + (size_t)b * 256 * 1024 + hx * 256;
    const bf16* MVT = wsp<bf16>(F, WS_MVT) + (size_t)l * 1024 * 512 + (size_t)hx * 256 * 512 + b * 256;
    constexpr int LDI = 264;
    LAS bf16* img = (LAS bf16*)(F.lds);
    __syncthreads();
#pragma unroll 4
    for (int p = tid; p < 256 * 32; p += NTHR) { const int r = p >> 5, ch = p & 31; *(LAS u32x4*)(img + r * LDI + 8 * ch) = *(const u32x4*)(MK + (size_t)r * 1024 + 8 * ch); }
    bf16x8 qf[8];
#pragma unroll
    for (int s = 0; s < 8; ++s) qf[s] = frag_glb(H + C_XQ + hx * 256, NH, tq0, 32 * s, lane);
    __syncthreads();
    f32x4 sc[16];
#pragma unroll
    for (int jt = 0; jt < 16; ++jt) { sc[jt] = (f32x4){0.f, 0.f, 0.f, 0.f};
#pragma unroll
        for (int s = 0; s < 8; ++s) sc[jt] = mma16(frag_lds(img, LDI, 16 * jt, 32 * s, lane), qf[s], sc[jt]);
        if (jt & 1) __builtin_amdgcn_sched_barrier(0); }
#pragma unroll
    for (int jt = 0; jt < 16; ++jt) asm volatile("" : "+v"(sc[jt]));
    __syncthreads();
#pragma unroll 4
    for (int p = tid; p < 256 * 32; p += NTHR) { const int r = p >> 5, ch = p & 31; *(LAS u32x4*)(img + r * LDI + 8 * ch) = *(const u32x4*)(MVT + (size_t)r * 512 + 8 * ch); }
    float mx = -INFINITY;
#pragma unroll
    for (int jt = 0; jt < 16; ++jt)
#pragma unroll
        for (int r = 0; r < 4; ++r) { sc[jt][r] *= 0.0625f; mx = fmaxf(mx, sc[jt][r]); }
    mx = fmaxf(mx, __shfl_xor(mx, 16)); mx = fmaxf(mx, __shfl_xor(mx, 32));
    float sum = 0.f;
#pragma unroll
    for (int jt = 0; jt < 16; ++jt)
#pragma unroll
        for (int r = 0; r < 4; ++r) { const float p = __builtin_amdgcn_exp2f((sc[jt][r] - mx) * 1.44269504089f); sc[jt][r] = p; sum += p; }
    sum += __shfl_xor(sum, 16); sum += __shfl_xor(sum, 32);
    const float inv = 1.0f / sum;
    bf16x8 pb[8];
#pragma unroll
    for (int s = 0; s < 8; ++s) { u32x4 w; w.x = pk2(sc[2 * s][0] * inv, sc[2 * s][1] * inv); w.y = pk2(sc[2 * s][2] * inv, sc[2 * s][3] * inv);
        w.z = pk2(sc[2 * s + 1][0] * inv, sc[2 * s + 1][1] * inv); w.w = pk2(sc[2 * s + 1][2] * inv, sc[2 * s + 1][3] * inv); pb[s] = __builtin_bit_cast(bf16x8, w); }
    __syncthreads();
    bf16* OB = wsp<bf16>(F, WS_OB); const int t = tq0 + (lane & 15);
    const LAS bf16* arow = img + (lane & 15) * LDI + 4 * (lane >> 4);
#pragma unroll 4
    for (int dt = 0; dt < 16; ++dt) { f32x4 oa = (f32x4){0.f, 0.f, 0.f, 0.f};
#pragma unroll
        for (int s = 0; s < 8; ++s) { const u32x2 lo = *(const LAS u32x2*)(arow + 16 * dt * LDI + 32 * s), hi = *(const LAS u32x2*)(arow + 16 * dt * LDI + 32 * s + 16);
            const u32x4 av = (u32x4){lo.x, lo.y, hi.x, hi.y};
            oa = mma16(__builtin_bit_cast(bf16x8, av), pb[s], oa); }
        __builtin_amdgcn_sched_barrier(0);
        const int dd = hx * 256 + 16 * dt + 4 * (lane >> 4);
        const u32x2 gw = *(const u32x2*)(H + (size_t)t * NH + C_XG + dd);
        const float g0 = bf2f(gw.x & 0xffffu), g1 = bf2f(gw.x >> 16), g2 = bf2f(gw.y & 0xffffu), g3 = bf2f(gw.y >> 16);
        u32x2 o; o.x = pk2(oa[0] * g0, oa[1] * g1); o.y = pk2(oa[2] * g2, oa[3] * g3);
        *(u32x2*)(OB + (size_t)t * DM + 3072 + dd) = o; }
}

DI void ln_phase(const Frame& F, int l, const float* ln_g, const float* ln_b) {
    const int gw = F.wg * NWAVES + F.wave, NGW = F.G * NWAVES, lane = F.lane;
    const float* g = ln_g + l * DM; const float* bb = ln_b + l * DM;
    for (int m = gw; m < MTOK; m += NGW) {
        f32x4* row = (f32x4*)(F.out + (size_t)m * DM) + lane; const f32x4* zrow = (const f32x4*)(wsp<float>(F, WS_Z) + (size_t)m * DM) + lane;
        f32x4 v[16]; float s = 0.f;
#pragma unroll
        for (int j = 0; j < 16; ++j) { v[j] = zrow[64 * j]; s += (v[j].x + v[j].y) + (v[j].z + v[j].w); }
        const float mean = wave_sum(s) * (1.f / DM); float s2 = 0.f;
#pragma unroll
        for (int j = 0; j < 16; ++j) { v[j] = v[j] - mean; s2 += (v[j].x * v[j].x + v[j].y * v[j].y) + (v[j].z * v[j].z + v[j].w * v[j].w); }
        const float rstd = 1.f / sqrtf(wave_sum(s2) * (1.f / DM) + LN_EPS);
        u32x2* xb = (u32x2*)(wsp<bf16>(F, WS_XB) + (size_t)m * DM) + lane; unsigned* x8 = (unsigned*)(wsp<unsigned char>(F, WS_X8) + (size_t)m * DM) + lane;
#pragma unroll
        for (int j = 0; j < 16; ++j) { const f32x4 gg = *((const f32x4*)g + lane + 64 * j), be = *((const f32x4*)bb + lane + 64 * j);
            const f32x4 o = v[j] * rstd * gg + be; row[64 * j] = o;
            if (l + 1 < DEPTH) { u32x2 w; w.x = pk2(o.x, o.y); w.y = pk2(o.z, o.w); xb[64 * j] = w; x8[64 * j] = pk4_fp8(o.x * X8_SCALE, o.y * X8_SCALE, o.z * X8_SCALE, o.w * X8_SCALE); } }
    }
}

struct Args { const void* in[15]; float* out; unsigned char* ws; int ph_lo, ph_hi; };
constexpr int PH_PER_LAYER = 7, N_PHASES = 1 + PH_PER_LAYER * DEPTH;
#define IN(k) (lo <= (k) && (k) < hi)
#ifndef PH_MASK
#define PH_MASK 0xffff
#endif
#define PHM(b) ((PH_MASK >> (b)) & 1)
#ifndef REP_MASK
#define REP_MASK 0
#endif
#define REPS(b) (((REP_MASK >> (b)) & 1) ? 2 : 1)
#define SEAM(k) do { if (IN(k) && IN((k) + 1)) xcd_barrier(bar); } while (0)
template <int l> DI void layer_body(const Frame& F, const Args& args, const int lo, const int hi, const XcdBarrier& bar) {
        const int p0 = 1 + PH_PER_LAYER * l;
        if (PHM(1) && IN(p0)) { {
            SchedInProj S; S.G = F.G; S.c = F.wg; S.n_extra = (l == 0) ? 32 : 0; S.XB = (const char*)(F.ws + WS_XB); S.WT = (const char*)(F.ws + WS_WINT) + (size_t)l * NH * 4096 * 2;
            S.MEMB = (const char*)(F.ws + WS_MEMB); S.WKV = (const char*)(F.ws + WS_WMKVT);
            EpiH E{wsp<bf16>(F, WS_H), wsp<bf16>(F, WS_MK), wsp<bf16>(F, WS_MVT)};
            pg8::gemm_phase<EpiH, SchedInProj, 2, true>(F.lds, 4096, S, E);
            pg8::SchedStatic S8; S8.nM = 32; S8.nN = 64 * (2 / F8NB); S8.G = F.G; S8.c = F.wg; S8.A = (const char*)(F.ws + WS_X8); S8.B = (const char*)(F.ws + WS_W8) + (size_t)l * 16384 * 4096;
            S8.astep = (size_t)256 * 4096; S8.bstep = (size_t)(128 * F8NB) * 4096;
            EpiMG<F8NB> E8{wsp<bf16>(F, WS_H)};
            pg8::gemm_phase<EpiMG<F8NB>, pg8::SchedStatic, F8NB, (F8NB == 2), true>(F.lds, 2048, S8, E8);
        }
        if (REPS(1) == 2) {
            SchedInProj S; S.G = F.G; S.c = F.wg; S.n_extra = (l == 0) ? 32 : 0; S.XB = (const char*)(F.ws + WS_XB); S.WT = (const char*)(F.ws + WS_WINT) + (size_t)l * NH * 4096 * 2;
            S.MEMB = (const char*)(F.ws + WS_MEMB); S.WKV = (const char*)(F.ws + WS_WMKVT);
            EpiH E{wsp<bf16>(F, WS_H), wsp<bf16>(F, WS_MK), wsp<bf16>(F, WS_MVT)};
            pg8::gemm_phase<EpiH, SchedInProj, 2, true>(F.lds, 4096, S, E);
            pg8::SchedStatic S8; S8.nM = 32; S8.nN = 64 * (2 / F8NB); S8.G = F.G; S8.c = F.wg; S8.A = (const char*)(F.ws + WS_X8); S8.B = (const char*)(F.ws + WS_W8) + (size_t)l * 16384 * 4096;
            S8.astep = (size_t)256 * 4096; S8.bstep = (size_t)(128 * F8NB) * 4096;
            EpiMG<F8NB> E8{wsp<bf16>(F, WS_H)};
            pg8::gemm_phase<EpiMG<F8NB>, pg8::SchedStatic, F8NB, (F8NB == 2), true>(F.lds, 2048, S8, E8);
        } }
        SEAM(p0);
        if (PHM(2) && IN(p0 + 1)) for (int rep = 0; rep < REPS(2); ++rep) { for (int u = F.wg; u < 512; u += F.G) gla_a_unit(F, l, u, (const float*)args.in[6], (const float*)args.in[7]); }
        SEAM(p0 + 1);
        if (PHM(3) && IN(p0 + 2)) for (int rep = 0; rep < REPS(3); ++rep) { gla_scan(F); }
        SEAM(p0 + 2);
        if (PHM(4) && IN(p0 + 3)) for (int rep = 0; rep < REPS(4); ++rep) {
            for (int r2 = 0; r2 < REPS(8); ++r2) for (int u = F.wg; u < 512; u += F.G) gla_c_unit(F, l, u, (const float*)args.in[8]);
            for (int r2 = 0; r2 < REPS(9); ++r2) for (int u = F.wg; u < 512; u += F.G) pool_unit(F, l, u, (const float*)args.in[5]);
            for (int r2 = 0; r2 < REPS(10); ++r2) for (int u = F.wg; u < 1024; u += F.G) swa_unit(F, l, u, (const float*)args.in[9]);
            for (int r2 = 0; r2 < REPS(11); ++r2) for (int u = F.wg; u < 256; u += F.G) mem_unit(F, l, u);
            __syncthreads();
        }
        SEAM(p0 + 3);
        if (PHM(5) && IN(p0 + 4)) { {
            pg8::SchedStatic S; S.nM = 32; S.nN = 32; S.G = F.G; S.c = F.wg; S.A = (const char*)(F.ws + WS_OB); S.B = (const char*)(F.ws + WS_WBRT) + (size_t)l * 4096 * 4096 * 2;
            S.astep = (size_t)256 * 4096 * 2; S.bstep = (size_t)128 * 4096 * 2;
            EpiGate E{wsp<bf16>(F, WS_H), wsp<bf16>(F, WS_YB)};
            pg8::gemm_phase<EpiGate, pg8::SchedStatic, 1, false>(F.lds, 4096, S, E);
        }
        if (REPS(5) == 2) {
            pg8::SchedStatic S; S.nM = 32; S.nN = 32; S.G = F.G; S.c = F.wg; S.A = (const char*)(F.ws + WS_OB); S.B = (const char*)(F.ws + WS_WBRT) + (size_t)l * 4096 * 4096 * 2;
            S.astep = (size_t)256 * 4096 * 2; S.bstep = (size_t)128 * 4096 * 2;
            EpiGate E{wsp<bf16>(F, WS_H), wsp<bf16>(F, WS_YB)};
            pg8::gemm_phase<EpiGate, pg8::SchedStatic, 1, false>(F.lds, 4096, S, E);
        } }
        SEAM(p0 + 4);
        if (PHM(6) && IN(p0 + 5)) { {
            pg8::SchedStatic S; S.nM = 32; S.nN = 16; S.G = F.G; S.c = F.wg; S.A = (const char*)(F.ws + WS_YB); S.B = (const char*)(F.ws + WS_WOUTT) + (size_t)l * 4096 * 4096 * 2;
            S.astep = (size_t)256 * 4096 * 2; S.bstep = (size_t)256 * 4096 * 2;
            EpiRes E{l == 0 ? (const float*)args.in[0] : (const float*)F.out, wsp<float>(F, WS_Z)};
            pg8::gemm_phase<EpiRes, pg8::SchedStatic, 2, true>(F.lds, 4096, S, E);
        }
        if (REPS(6) == 2) {
            pg8::SchedStatic S; S.nM = 32; S.nN = 16; S.G = F.G; S.c = F.wg; S.A = (const char*)(F.ws + WS_YB); S.B = (const char*)(F.ws + WS_WOUTT) + (size_t)l * 4096 * 4096 * 2;
            S.astep = (size_t)256 * 4096 * 2; S.bstep = (size_t)256 * 4096 * 2;
            EpiRes E{l == 0 ? (const float*)args.in[0] : (const float*)F.out, wsp<float>(F, WS_Z)};
            pg8::gemm_phase<EpiRes, pg8::SchedStatic, 2, true>(F.lds, 4096, S, E);
        } }
        SEAM(p0 + 5);
        if (PHM(7) && IN(p0 + 6)) for (int rep = 0; rep < REPS(7); ++rep) { ln_phase(F, l, (const float*)args.in[13], (const float*)args.in[14]); }
        SEAM(p0 + 6);
}


__global__ void __launch_bounds__(NTHR, 2) mk_fwd(Args args) {
    extern __shared__ __attribute__((aligned(16))) unsigned char lds_raw[];
    Frame F;
    F.lds = (LAS unsigned char*)lds_raw;
    F.tid = threadIdx.x; F.lane = F.tid & 63; F.wave = __builtin_amdgcn_readfirstlane(F.tid >> 6); F.G = gridDim.x; F.wg = blockIdx.x;
    F.out = args.out; F.ws = args.ws;
    volatile LAS unsigned* MISC = (volatile LAS unsigned*)(F.lds + MISC_OFF);
    for (int u = F.tid; u < (LDS_BYTES - LDSCTL_OFF) / 4; u += NTHR) ((LAS unsigned*)(F.lds + LDSCTL_OFF))[u] = 0u;
    __syncthreads();
    unsigned* barw = (unsigned*)(F.ws + WS_CTL) + CW_BAR;
    XcdBarrier bar; bar.bar = barw; bar.x = 0; bar.st = nullptr;
    const int lo = args.ph_lo, hi = args.ph_hi;
    if (hi - lo > 1) bar = xcd_barrier_post(barw, MISC + 8);

    if (PHM(0) && IN(0)) for (int rep = 0; rep < REPS(0); ++rep) { prologue(F, (const float*)args.in[0], (const float*)args.in[1], (const int*)args.in[2], (const float*)args.in[3], (const float*)args.in[4], (const float*)args.in[10], (const float*)args.in[11], (const float*)args.in[12]); }
    SEAM(0);
    layer_body<0>(F, args, lo, hi, bar);
    layer_body<1>(F, args, lo, hi, bar);
#undef IN
#undef SEAM
}

extern "C" void kernel_launch(void* const* d_in, const int* in_sizes, int n_in, void* d_out, int out_size, void* d_ws, size_t ws_size, hipStream_t stream) {
    static int grid = 0;
    if (grid == 0) {
        if (n_in != 15 || out_size != MTOK * DM || ws_size < WS_END) { fprintf(stderr, "kernel_launch: unexpected sizes (n_in %d, out %d, ws %zu); nothing launched\n", n_in, out_size, ws_size); grid = -1; return; }
        int dev = 0, cus = 0, per_cu = 0;
        if (hipGetDevice(&dev) != hipSuccess || hipDeviceGetAttribute(&cus, hipDeviceAttributeMultiprocessorCount, dev) != hipSuccess) { grid = -1; return; }
        if (hipFuncSetAttribute((const void*)mk_fwd, hipFuncAttributeMaxDynamicSharedMemorySize, LDS_BYTES) != hipSuccess) { fprintf(stderr, "kernel_launch: hipFuncSetAttribute failed\n"); grid = -1; return; }
        if (hipOccupancyMaxActiveBlocksPerMultiprocessor(&per_cu, (const void*)mk_fwd, NTHR, LDS_BYTES) != hipSuccess || per_cu < 1) fprintf(stderr, "kernel_launch: occupancy query says %d\n", per_cu);
        (void)hipGetLastError();
        grid = cus;
    }
    if (grid < 0) return;
    (void)hipMemsetAsync((char*)d_ws + WS_CTL, 0, CTL_ZERO_BYTES, stream);
    Args a{};
    for (int i = 0; i < 15; ++i) a.in[i] = d_in[i];
    a.out = (float*)d_out; a.ws = (unsigned char*)d_ws;
#if MK_PER_PHASE
    for (int p = 0; p < N_PHASES; ++p) { a.ph_lo = p; a.ph_hi = p + 1; hipLaunchKernelGGL(mk_fwd, dim3(grid), dim3(NTHR), LDS_BYTES, stream, a); }
#else
    a.ph_lo = 0; a.ph_hi = N_PHASES;
    hipLaunchKernelGGL(mk_fwd, dim3(grid), dim3(NTHR), LDS_BYTES, stream, a);
#endif
}
```

```cpp
#include <hip/hip_runtime.h>
#include <cstdio>
#include <cstdint>

#ifndef F8ASM1
#define F8ASM1 0
#endif
#ifndef F8NB
#define F8NB 1
#endif
#ifndef MK_PER_PHASE
#define MK_PER_PHASE 0
#endif

#define DI __device__ __forceinline__
#define LAS __attribute__((address_space(3)))
#define GAS __attribute__((address_space(1)))
typedef unsigned short bf16;
typedef short bf16x8 __attribute__((ext_vector_type(8)));
typedef short s16x4 __attribute__((ext_vector_type(4)));
typedef short v4i16_t __attribute__((ext_vector_type(4)));
typedef float f32x4 __attribute__((ext_vector_type(4)));
typedef float f32x2 __attribute__((ext_vector_type(2)));
typedef unsigned u32x4 __attribute__((ext_vector_type(4)));
typedef unsigned u32x2 __attribute__((ext_vector_type(2)));

constexpr int BATCH = 2, SEQ = 4096, DM = 4096, MTOK = BATCH * SEQ, DEPTH = 2;
constexpr int D_IN = 25872, NH = 26112;
constexpr int BW = 1024;
constexpr int MEMLEN = 256;
constexpr int C_PU = 0, C_PG = 1024, C_GQ = 2048, C_GK = 2560, C_GV = 3072, C_GG = 4096, C_SQ = 5120, C_SK = 6144, C_SV = 6272, C_SG = 6400, C_XQ = 7424, C_XG = 8448, C_MG = 9472, C_LR = 25856;
constexpr float LN_EPS = 1e-5f;
constexpr float DN_ALPHA = 1.41421356237309515f;

constexpr size_t MiB = 1u << 20;
constexpr size_t WS_CTL = 0, CTL_ZERO_BYTES = 1 * MiB;
constexpr size_t WS_ROPE = 1 * MiB;
constexpr size_t WS_WPOOLT = 2 * MiB;
constexpr size_t WS_MEMB = 4 * MiB;
constexpr size_t WS_MK = 8 * MiB;
constexpr size_t WS_MVT = 10 * MiB;
constexpr size_t WS_DEC = 12 * MiB;
constexpr size_t WS_WMKVT = 16 * MiB;
constexpr size_t WS_WBRT = 48 * MiB;
constexpr size_t WS_WOUTT = 112 * MiB;
constexpr size_t WS_XB = 176 * MiB;
constexpr size_t WS_OB = 240 * MiB;
constexpr size_t WS_YB = 304 * MiB;
constexpr size_t WS_GU = 368 * MiB;
constexpr size_t WS_GS = 432 * MiB;
constexpr size_t WS_GB = 464 * MiB;
constexpr size_t WS_WINT = 512 * MiB;
constexpr size_t WS_H = 928 * MiB;
constexpr size_t WS_Z = 1336 * MiB;
constexpr size_t WS_X8 = 1464 * MiB;
constexpr size_t WS_W8 = 1496 * MiB;
constexpr size_t WS_END = 1624 * MiB;
constexpr float X8_SCALE = 16.0f, W8_SCALE = 2048.0f, MG_DESCALE = 1.0f / (16.0f * 2048.0f);
constexpr int CW_BAR = 4096;

constexpr int RING_BYTES = 131072;
constexpr int THIN_BYTES = 141312;
constexpr int LDSCTL_OFF = THIN_BYTES, MISC_OFF = LDSCTL_OFF + 320;
constexpr int LDS_BYTES = 147456;
constexpr int NWAVES = 8, NTHR = 512;

DI float bf2f(unsigned v) { return __builtin_bit_cast(float, v << 16); }
DI unsigned f2bf(float f) { unsigned u = __builtin_bit_cast(unsigned, f); return (u + 0x7fffu + ((u >> 16) & 1u)) >> 16; }
DI unsigned pk2(float lo, float hi) { return f2bf(lo) | (f2bf(hi) << 16); }
DI unsigned cvt_pk_bf16(float lo, float hi) { unsigned r; asm volatile("v_cvt_pk_bf16_f32 %0, %1, %2" : "=v"(r) : "v"(lo), "v"(hi)); return r; }
DI float fast_sigmoid(float v) { return __builtin_amdgcn_rcpf(1.0f + __builtin_amdgcn_exp2f(-1.44269504089f * v)); }
DI void unpack8(const u32x4 w, float (&f)[8]) {
    f[0] = bf2f(w.x & 0xffffu); f[1] = bf2f(w.x >> 16); f[2] = bf2f(w.y & 0xffffu); f[3] = bf2f(w.y >> 16);
    f[4] = bf2f(w.z & 0xffffu); f[5] = bf2f(w.z >> 16); f[6] = bf2f(w.w & 0xffffu); f[7] = bf2f(w.w >> 16);
}
DI u32x4 pack8(const float (&f)[8]) { u32x4 w; w.x = pk2(f[0], f[1]); w.y = pk2(f[2], f[3]); w.z = pk2(f[4], f[5]); w.w = pk2(f[6], f[7]); return w; }
DI float clamp448(float v) { return fminf(fmaxf(v, -448.0f), 448.0f); }
DI unsigned pk4_fp8(float a, float b, float c, float d) {
    int w = 0; w = __builtin_amdgcn_cvt_pk_fp8_f32(clamp448(a), clamp448(b), w, false); w = __builtin_amdgcn_cvt_pk_fp8_f32(clamp448(c), clamp448(d), w, true); return (unsigned)w; }
typedef int v8i32 __attribute__((ext_vector_type(8)));
DI f32x4 mma16(bf16x8 a, bf16x8 b, f32x4 c) { return __builtin_amdgcn_mfma_f32_16x16x32_bf16(a, b, c, 0, 0, 0); }
DI bf16x8 frag_lds(const LAS bf16* img, int ld, int idx0, int k0, int lane) { return *(const LAS bf16x8*)(img + (idx0 + (lane & 15)) * ld + k0 + 8 * (lane >> 4)); }
DI bf16x8 frag_glb(const bf16* img, size_t ld, int idx0, int k0, int lane) { return *(const bf16x8*)(img + (size_t)(idx0 + (lane & 15)) * ld + k0 + 8 * (lane >> 4)); }
DI s16x4 tr4(const LAS bf16* p) { return __builtin_bit_cast(s16x4, __builtin_amdgcn_ds_read_tr16_b64_v4i16((LAS v4i16_t*)p)); }
DI bf16x8 frag_tr(const LAS bf16* img, int ld, int k0, int idx0, int lane) {
    const int g = lane >> 4, q = (lane >> 2) & 3, p = lane & 3;
    const LAS bf16* a0 = img + (k0 + 8 * g + q) * ld + idx0 + 4 * p;
    const s16x4 lo = tr4(a0), hi = tr4(a0 + 4 * ld);
    return __builtin_shufflevector(lo, hi, 0, 1, 2, 3, 4, 5, 6, 7);
}
DI float wave_sum(float v) {
#pragma unroll
    for (int o = 1; o < 64; o <<= 1) v += __shfl_xor(v, o);
    return v;
}
#define LDS_WAIT() asm volatile("s_waitcnt lgkmcnt(0)" ::: "memory")
#define VM_WAIT() asm volatile("s_waitcnt vmcnt(0)" ::: "memory")

namespace pg8 {
constexpr int BM = 256, BK = 64, HALF = 128, HTB = HALF * BK * 2, STAGE_BYTES = 8 * HTB, NXCD = 8, WGM = 8;
__host__ __device__ __forceinline__ int lds_byte(int r, int c) { const int st = (r >> 4) * 2 + (c >> 5), rr = r & 15, cc = c & 31, ob = rr * 64 + cc * 2; return st * 1024 + (ob ^ (((ob >> 9) & 1) << 5)); }
__host__ __device__ __forceinline__ void stage_rc(int b, int& R, int& C) { const int st = b / 1024, sb = b % 1024, swz = sb ^ (((sb >> 9) & 1) << 5); R = (st >> 1) * 16 + swz / 64; C = (st & 1) * 32 + (swz % 64) / 2; }
__host__ __device__ __forceinline__ int perm32(int rho) { const int n = rho >> 4, i = rho & 15; return 8 * (i >> 2) + 4 * n + (i & 3); }

struct Unit { int pm, pn, gi; };

DI void static_tile(int L, int nM, int nN, int& pm, int& pn) {
    const int nwg = nM * nN; int wgid = L;
    { const int q = nwg / NXCD, r = nwg % NXCD, xcd = wgid % NXCD, off = wgid / NXCD; wgid = (xcd < r ? xcd * (q + 1) : r * (q + 1) + (xcd - r) * q) + off; }
    const int nig = WGM * nN, gid = wgid / nig, fm = gid * WGM, gsz = (nM - fm) < WGM ? (nM - fm) : WGM;
    pm = fm + ((wgid % nig) % gsz); pn = (wgid % nig) / gsz;
}
struct SchedStatic {
    int nM, nN, G, c; const char* A; const char* B; size_t astep, bstep;
    DI bool next(int i, Unit& u) const { const long L = (long)i * G + c; if (L >= (long)nM * nN) return false; static_tile((int)L, nM, nN, u.pm, u.pn); u.gi = 0; return true; }
    DI const char* abase(const Unit& u) const { return A + (size_t)u.pm * astep; }
    DI const char* bbase(const Unit& u) const { return B + (size_t)u.pn * bstep; }
};

template <class Epi, class Sched, int NB, bool ALIGN_EPI, bool F8 = false>
DI void gemm_phase(LAS unsigned char* lds, const int K, const Sched& S, const Epi& E) {
    const int tid = threadIdx.x, wid = __builtin_amdgcn_readfirstlane(tid >> 6), lane = tid & 63, wr = wid >> 2, wc = wid & 3, fr = lane & 15, fq = lane >> 4;
    const int nt = K / BK;
    unsigned voffA[2], voffB[2];
#pragma unroll
    for (int i = 0; i < 2; ++i) { int R, C; stage_rc(tid * 16 + i * 8192, R, C); const int Rb = Epi::PERM ? ((R & ~31) + perm32(R & 31)) : R;
        voffA[i] = (unsigned)(R * K + C) * 2u; voffB[i] = (unsigned)(Rb * K + C) * 2u; }
    const size_t kstep = (size_t)(BK * 2);
    const size_t hstep = (size_t)HALF * K * 2;
    const unsigned ldsw = (unsigned)wid * 1024u;
    const int aoff = lds_byte(wr * 64 + fr, F8 ? fq * 16 : fq * 8), boff = lds_byte(wc * 32 + fr, F8 ? fq * 16 : fq * 8);
    constexpr int KOFF = F8 ? 16 : 1024;
    const unsigned one_scale = 0x7f7f7f7fu;
#define PG8_SA(b, h) (((b) * 2 + (h)) * HTB)
#define PG8_SB(b, h) ((4 + (b) * 2 + (h)) * HTB)
#define PG8_STAGE(bufoff, gbase, voff) do { _Pragma("unroll") for (int _i = 0; _i < 2; ++_i) \
        __builtin_amdgcn_global_load_lds((const unsigned*)((const char*)(gbase) + (voff)[_i]), (LAS unsigned*)(lds + (bufoff) + ldsw + _i * 8192), 16, 0, 0); } while (0)
#define PG8_LDA(dst, b, h) do { _Pragma("unroll") for (int m = 0; m < 4; ++m) _Pragma("unroll") for (int k = 0; k < 2; ++k) dst[m][k] = *(const LAS bf16x8*)(lds + PG8_SA(b, h) + aoff + m * 2048 + k * KOFF); } while (0)
#define PG8_LDB(dst, b, h) do { _Pragma("unroll") for (int n = 0; n < 2; ++n) _Pragma("unroll") for (int k = 0; k < 2; ++k) dst[n][k] = *(const LAS bf16x8*)(lds + PG8_SB(b, h) + boff + n * 2048 + k * KOFF); } while (0)
#define PG8_CAT(x) __builtin_bit_cast(v8i32, __builtin_shufflevector((x)[0], (x)[1], 0, 1, 2, 3, 4, 5, 6, 7, 8, 9, 10, 11, 12, 13, 14, 15))
#define PG8_MMA(ai, bj, At, Bt) do { __builtin_amdgcn_s_setprio(1); _Pragma("unroll") for (int m = 0; m < 4; ++m) _Pragma("unroll") for (int n = 0; n < 2; ++n) { \
        if constexpr (F8 && NB == 1 && !F8ASM1) acc[ai][bj][m][n] = __builtin_amdgcn_mfma_scale_f32_16x16x128_f8f6f4(PG8_CAT(Bt[n]), PG8_CAT(At[m]), acc[ai][bj][m][n], 0, 0, 0, 0x7f7f7f7f, 0, 0x7f7f7f7f); \
        else if constexpr (F8) { asm volatile("v_mfma_scale_f32_16x16x128_f8f6f4 %0, %1, %2, %0, %3, %3 op_sel_hi:[0,0,0]" : "+v"(acc[ai][bj][m][n]) : "v"(PG8_CAT(Bt[n])), "v"(PG8_CAT(At[m])), "v"(one_scale)); } \
        else { _Pragma("unroll") for (int k = 0; k < 2; ++k) acc[ai][bj][m][n] = __builtin_amdgcn_mfma_f32_16x16x32_bf16(Bt[n][k], At[m][k], acc[ai][bj][m][n], 0, 0, 0); } } \
        __builtin_amdgcn_s_setprio(0); } while (0)
#define PG8_WAIT_V(n) asm volatile("s_waitcnt vmcnt(" #n ")" ::: "memory")
#define PG8_WAIT_L(n) asm volatile("s_waitcnt lgkmcnt(" #n ")" ::: "memory")
#define PG8_BAR __builtin_amdgcn_s_barrier()
#define PG8_SCHED __builtin_amdgcn_sched_barrier(0)
#define PG8_WAIT_MAIN() do { if constexpr (NB == 2) PG8_WAIT_V(8); else PG8_WAIT_V(6); } while (0)
    Unit cur, nxt; int ui = 0;
    if (!S.next(0, cur)) return;
    f32x4 acc[2][NB][4][2];
    f32x4 yac[2][4][2];
#pragma unroll
    for (int a = 0; a < 2; ++a)
#pragma unroll
        for (int m = 0; m < 4; ++m)
#pragma unroll
            for (int n = 0; n < 2; ++n) { yac[a][m][n] = (f32x4){0.f, 0.f, 0.f, 0.f};
#pragma unroll
                for (int b = 0; b < NB; ++b) acc[a][b][m][n] = (f32x4){0.f, 0.f, 0.f, 0.f}; }
    bf16x8 At[4][2], B0[2][2], B1[2][2];
    const char* cA = S.abase(cur); const char* cB = S.bbase(cur);
    if constexpr (NB == 2) {
        PG8_STAGE(PG8_SB(0, 0), cB, voffB); PG8_STAGE(PG8_SB(0, 1), cB + hstep, voffB); PG8_STAGE(PG8_SA(0, 0), cA, voffA); PG8_STAGE(PG8_SA(0, 1), cA + hstep, voffA);
        if (wr == 1) PG8_BAR;
        PG8_WAIT_V(2); PG8_BAR;
        PG8_STAGE(PG8_SB(1, 0), cB + kstep, voffB); PG8_STAGE(PG8_SA(1, 0), cA + kstep, voffA); PG8_STAGE(PG8_SB(1, 1), cB + hstep + kstep, voffB);
        PG8_WAIT_V(6); PG8_BAR;
    } else {
        PG8_STAGE(PG8_SB(0, 0), cB, voffB); PG8_STAGE(PG8_SA(0, 0), cA, voffA); PG8_STAGE(PG8_SA(0, 1), cA + hstep, voffA);
        if (wr == 1) PG8_BAR;
        PG8_WAIT_V(2); PG8_BAR;
        PG8_STAGE(PG8_SB(1, 0), cB + kstep, voffB); PG8_STAGE(PG8_SA(1, 0), cA + kstep, voffA);
        PG8_WAIT_V(4); PG8_BAR;
    }
    for (;;) {
        const bool has_next = S.next(ui + 1, nxt);
        const char* nA = has_next ? S.abase(nxt) : cA; const char* nB = has_next ? S.bbase(nxt) : cB;
        for (int t = 0; t < nt; t += 2) {
            if constexpr (Epi::GATED) { if (t != 0 && (t & 15) == 0) { E.flush(acc, yac, cur, (t >> 4) - 1, wr, wc, fr, fq);
#pragma unroll
                for (int a = 0; a < 2; ++a)
#pragma unroll
                    for (int m = 0; m < 4; ++m)
#pragma unroll
                        for (int n = 0; n < 2; ++n) acc[a][0][m][n] = (f32x4){0.f, 0.f, 0.f, 0.f}; } }
            const bool last = (t == nt - 2);
            const char* a1 = cA + (size_t)(t + 1) * kstep;
            const char* a2 = last ? nA : cA + (size_t)(t + 2) * kstep; const char* b2 = last ? nB : cB + (size_t)(t + 2) * kstep;
            const char* a3 = a2 + kstep; const char* b3 = b2 + kstep;
            if constexpr (NB == 2) {
            PG8_LDB(B0, 0, 0); PG8_LDB(B1, 0, 1); PG8_SCHED; PG8_LDA(At, 0, 0); PG8_STAGE(PG8_SA(1, 1), a1 + hstep, voffA);
            PG8_WAIT_V(8); PG8_WAIT_L(0); PG8_BAR; PG8_MMA(0, 0, At, B0); PG8_MMA(0, 1, At, B1); PG8_BAR; PG8_SCHED;
            PG8_LDA(At, 0, 1); PG8_STAGE(PG8_SB(0, 0), b2, voffB); PG8_STAGE(PG8_SB(0, 1), b2 + hstep, voffB); PG8_STAGE(PG8_SA(0, 0), a2, voffA);
            PG8_WAIT_V(8); PG8_WAIT_L(0); PG8_BAR; PG8_MMA(1, 0, At, B0); PG8_MMA(1, 1, At, B1); PG8_BAR; PG8_SCHED;
            PG8_LDB(B0, 1, 0); PG8_LDB(B1, 1, 1); PG8_SCHED; PG8_LDA(At, 1, 0); PG8_STAGE(PG8_SA(0, 1), a2 + hstep, voffA);
            PG8_WAIT_V(8); PG8_WAIT_L(0); PG8_BAR; PG8_MMA(0, 0, At, B0); PG8_MMA(0, 1, At, B1); PG8_BAR; PG8_SCHED;
            PG8_LDA(At, 1, 1); PG8_STAGE(PG8_SB(1, 0), b3, voffB); PG8_STAGE(PG8_SB(1, 1), b3 + hstep, voffB); PG8_STAGE(PG8_SA(1, 0), a3, voffA);
            PG8_WAIT_V(8); PG8_WAIT_L(0); PG8_BAR; PG8_MMA(1, 0, At, B0); PG8_MMA(1, 1, At, B1); PG8_BAR; PG8_SCHED;
            } else {
            PG8_LDB(B0, 0, 0); PG8_SCHED; PG8_LDA(At, 0, 0); PG8_STAGE(PG8_SA(1, 1), a1 + hstep, voffA);
            PG8_WAIT_V(6); PG8_WAIT_L(0); PG8_BAR; PG8_MMA(0, 0, At, B0); PG8_BAR; PG8_SCHED;
            PG8_LDA(At, 0, 1); PG8_STAGE(PG8_SB(0, 0), b2, voffB); PG8_STAGE(PG8_SA(0, 0), a2, voffA);
            PG8_WAIT_V(6); PG8_WAIT_L(0); PG8_BAR; PG8_MMA(1, 0, At, B0); PG8_BAR; PG8_SCHED;
            PG8_LDB(B0, 1, 0); PG8_SCHED; PG8_LDA(At, 1, 0); PG8_STAGE(PG8_SA(0, 1), a2 + hstep, voffA);
            PG8_WAIT_V(6); PG8_WAIT_L(0); PG8_BAR; PG8_MMA(0, 0, At, B0); PG8_BAR; PG8_SCHED;
            PG8_LDA(At, 1, 1); PG8_STAGE(PG8_SB(1, 0), b3, voffB); PG8_STAGE(PG8_SA(1, 0), a3, voffA);
            PG8_WAIT_V(6); PG8_WAIT_L(0); PG8_BAR; PG8_MMA(1, 0, At, B0); PG8_BAR; PG8_SCHED;
            }
        }
        if constexpr (F8) {
            asm volatile("s_nop 15\n\ts_nop 15" ::: "memory");
#pragma unroll
            for (int a = 0; a < 2; ++a)
#pragma unroll
                for (int b = 0; b < NB; ++b)
#pragma unroll
                    for (int m = 0; m < 4; ++m)
#pragma unroll
                        for (int n = 0; n < 2; ++n) asm volatile("" : "+v"(acc[a][b][m][n]));
        }
        if constexpr (ALIGN_EPI) { if (wr == 0) PG8_BAR; }
        if constexpr (Epi::GATED) { E.finish(acc, yac, cur, wr, wc, fr, fq);
#pragma unroll
            for (int a = 0; a < 2; ++a)
#pragma unroll
                for (int m = 0; m < 4; ++m)
#pragma unroll
                    for (int n = 0; n < 2; ++n) yac[a][m][n] = (f32x4){0.f, 0.f, 0.f, 0.f};
        } else { E(acc, cur, wr, wc, fr, fq); }
        if (!has_next) break;
#pragma unroll
        for (int a = 0; a < 2; ++a)
#pragma unroll
            for (int b = 0; b < NB; ++b)
#pragma unroll
                for (int m = 0; m < 4; ++m)
#pragma unroll
                    for (int n = 0; n < 2; ++n) acc[a][b][m][n] = (f32x4){0.f, 0.f, 0.f, 0.f};
        cur = nxt; cA = nA; cB = nB; ++ui;
        if constexpr (ALIGN_EPI) { if (wr == 1) PG8_BAR; }
    }
    PG8_WAIT_V(0);
    if constexpr (!ALIGN_EPI) { if (wr == 0) PG8_BAR; }
    PG8_BAR;
#undef PG8_SA
#undef PG8_SB
#undef PG8_STAGE
#undef PG8_LDA
#undef PG8_LDB
#undef PG8_MMA
#undef PG8_CAT
#undef PG8_WAIT_V
#undef PG8_WAIT_L
#undef PG8_BAR
#undef PG8_SCHED
#undef PG8_WAIT_MAIN
}
}

#define XB_TMO      128
#define XB_XCNT(j)  (256  + 64 * (j))
#define XB_XSUB(j)  (1280 + 64 * (j))
#define XB_XGEN(j)  (2304 + 64 * (j))
#define XB_TOP      3328
#define XB_TOPGEN   3392
#define XCD_BAR_WORDS 3456
#define XB_SPIN_CAP (1u << 18)
DI unsigned xb_ld(unsigned* p)              { return __hip_atomic_load(p, __ATOMIC_RELAXED, __HIP_MEMORY_SCOPE_AGENT); }
DI unsigned xb_add(unsigned* p, unsigned v) { return __hip_atomic_fetch_add(p, v, __ATOMIC_RELAXED, __HIP_MEMORY_SCOPE_AGENT); }
DI unsigned xb_xcc_id() { return (unsigned)__builtin_amdgcn_s_getreg((3 << 11) | 20) & 0xFu; }
#define XB_SPIN(cond, bar) do { unsigned _sp = 0; while (cond) { __builtin_amdgcn_s_sleep(1); \
    if ((++_sp & 255u) == 0u) { if (xb_ld(&(bar)[XB_TMO])) break; if (_sp > XB_SPIN_CAP) { atomicAdd(&(bar)[XB_TMO], 1u); break; } } } } while (0)
struct XcdBarrier { unsigned* bar; unsigned x; volatile LAS unsigned* st; };
DI XcdBarrier xcd_barrier_post(unsigned* bar, volatile LAS unsigned* st) {
    XcdBarrier b; b.bar = bar; b.x = xb_xcc_id(); b.st = st;
    if (threadIdx.x == 0) (void)xb_add(&bar[XB_XCNT(b.x)], 1u);
    return b;
}
DI void xcd_barrier_complete(unsigned* bar, unsigned x, unsigned& nloc, unsigned& nx) {
    const unsigned G = gridDim.x * gridDim.y * gridDim.z;
    unsigned sum, cnt, mine, sp = 0u;
    for (;;) {
        sum = 0u; cnt = 0u; mine = 0u;
#pragma unroll
        for (unsigned j = 0; j < 16; ++j) { const unsigned c = xb_ld(&bar[XB_XCNT(j)]); sum += c; cnt += (c > 0u) ? 1u : 0u; mine = (j == x) ? c : mine; }
        if (sum == G) break;
        __builtin_amdgcn_s_sleep(1);
        if ((++sp & 255u) == 0u) { if (xb_ld(&bar[XB_TMO])) break; if (sp > XB_SPIN_CAP) { atomicAdd(&bar[XB_TMO], 1u); break; } }
    }
    nloc = mine > 0u ? mine : 1u; nx = cnt > 0u ? cnt : 1u;
}
DI void xcd_barrier(const XcdBarrier& b) {
    asm volatile("s_waitcnt vmcnt(0)" ::: "memory");
    __syncthreads();
    if (threadIdx.x == 0) {
        unsigned* bar = b.bar;
        __builtin_amdgcn_s_waitcnt(0);
        unsigned nloc = b.st[0], nx = b.st[1];
        if (nloc == 0u) { xcd_barrier_complete(bar, b.x, nloc, nx); b.st[0] = nloc; b.st[1] = nx; }
        const unsigned old = xb_add(&bar[XB_XSUB(b.x)], 1u);
        const unsigned gen = old / nloc;
        if (old + 1u == (gen + 1u) * nloc) {
            __builtin_amdgcn_fence(__ATOMIC_RELEASE, "agent");
            asm volatile("s_waitcnt vmcnt(0)" ::: "memory");
            const unsigned og = xb_add(&bar[XB_TOP], 1u);
            const unsigned tg = og / nx;
            if (og + 1u == (tg + 1u) * nx) xb_add(&bar[XB_TOPGEN], 1u);
            else XB_SPIN(xb_ld(&bar[XB_TOPGEN]) == tg, bar);
            __builtin_amdgcn_fence(__ATOMIC_ACQUIRE, "agent");
            xb_add(&bar[XB_XGEN(b.x)], 1u);
            asm volatile("s_waitcnt vmcnt(0)" ::: "memory");
        } else {
            XB_SPIN(xb_ld(&bar[XB_XGEN(b.x)]) == gen, bar);
            __builtin_amdgcn_fence(__ATOMIC_ACQUIRE, "agent");
            asm volatile("s_waitcnt vmcnt(0)" ::: "memory");
        }
    }
    __syncthreads();
}

struct Frame {
    LAS unsigned char* lds;
    int tid, lane, wave, G, wg;
    float* out; unsigned char* ws;
};
template <class T> DI T* wsp(const Frame& F, size_t off) { return (T*)(F.ws + off); }

struct EpiH {
    static constexpr bool PERM = true, GATED = false;
    bf16* H; bf16* MK; bf16* MVT;
    DI void operator()(const f32x4 (&acc)[2][2][4][2], const pg8::Unit& u, int wr, int wc, int fr, int fq) const {
        bf16* base = H; size_t ldc = NH; int act = 0;
        if (u.gi == 0) { const int pn = u.pn; act = ((pn >= 4 && pn < 8) || (pn >= 16 && pn < 20) || (pn >= 25 && pn < 29) || (pn >= 33 && pn < 37)) ? 1 : 0; }
        else { const int lx = (u.gi - 1) >> 1, w = (u.gi - 1) & 1; if (w == 0) { base = MK + (size_t)lx * 512 * 1024; ldc = 1024; } else { base = MVT + (size_t)lx * 1024 * 512; ldc = 512; } }
        const int row0 = u.pm * 256 + wr * 64 + fr, col0 = u.pn * 256 + wc * 32 + 8 * fq;
#pragma unroll
        for (int ai = 0; ai < 2; ++ai)
#pragma unroll
            for (int m = 0; m < 4; ++m) { bf16* rowp = base + (size_t)(row0 + ai * 128 + m * 16) * ldc + col0;
#pragma unroll
                for (int bj = 0; bj < 2; ++bj) { f32x4 v0 = acc[ai][bj][m][0], v1 = acc[ai][bj][m][1];
                    if (act != 0) {
#pragma unroll
                        for (int j = 0; j < 4; ++j) { const float s0 = fast_sigmoid(v0[j]), s1 = fast_sigmoid(v1[j]); v0[j] = (act == 1) ? v0[j] * s0 : s0; v1[j] = (act == 1) ? v1[j] * s1 : s1; } }
                    u32x4 w; w.x = cvt_pk_bf16(v0[0], v0[1]); w.y = cvt_pk_bf16(v0[2], v0[3]); w.z = cvt_pk_bf16(v1[0], v1[1]); w.w = cvt_pk_bf16(v1[2], v1[3]);
                    *(u32x4*)(rowp + bj * 128) = w; } }
    }
};
template <int NB> struct EpiMG {
    static constexpr bool PERM = true, GATED = false;
    bf16* H;
    DI void operator()(const f32x4 (&acc)[2][NB][4][2], const pg8::Unit& u, int wr, int wc, int fr, int fq) const {
        const int row0 = u.pm * 256 + wr * 64 + fr, col0 = C_MG + u.pn * (128 * NB) + wc * 32 + 8 * fq;
#pragma unroll
        for (int ai = 0; ai < 2; ++ai)
#pragma unroll
            for (int m = 0; m < 4; ++m) { bf16* rowp = H + (size_t)(row0 + ai * 128 + m * 16) * NH + col0;
#pragma unroll
                for (int bj = 0; bj < NB; ++bj) { f32x4 v0 = acc[ai][bj][m][0], v1 = acc[ai][bj][m][1];
#pragma unroll
                    for (int j = 0; j < 4; ++j) { v0[j] = fast_sigmoid(v0[j] * MG_DESCALE); v1[j] = fast_sigmoid(v1[j] * MG_DESCALE); }
                    u32x4 w; w.x = cvt_pk_bf16(v0[0], v0[1]); w.y = cvt_pk_bf16(v0[2], v0[3]); w.z = cvt_pk_bf16(v1[0], v1[1]); w.w = cvt_pk_bf16(v1[2], v1[3]);
                    *(u32x4*)(rowp + bj * 128) = w; } }
    }
};
struct EpiRes {
    static constexpr bool PERM = false, GATED = false;
    const float* __restrict__ res; float* __restrict__ out;
    DI void operator()(const f32x4 (&acc)[2][2][4][2], const pg8::Unit& u, int wr, int wc, int fr, int fq) const {
        const int row0 = u.pm * 256 + wr * 64 + fr, col0 = u.pn * 256 + wc * 32 + 4 * fq;
#pragma unroll
        for (int ai = 0; ai < 2; ++ai)
#pragma unroll
            for (int m = 0; m < 4; ++m) { const size_t ro = (size_t)(row0 + ai * 128 + m * 16) * DM + col0;
#pragma unroll
                for (int bj = 0; bj < 2; ++bj)
#pragma unroll
                    for (int n = 0; n < 2; ++n) { const size_t o = ro + bj * 128 + n * 16; const f32x4 r = *(const f32x4*)(res + o); *(f32x4*)(out + o) = r * DN_ALPHA + acc[ai][bj][m][n]; } }
    }
};
struct EpiGate {
    static constexpr bool PERM = true, GATED = true;
    const bf16* H; bf16* Y;
    DI void flush(const f32x4 (&acc)[2][1][4][2], f32x4 (&y)[2][4][2], const pg8::Unit& u, int bi, int wr, int wc, int fr, int fq) const {
        const int row0 = u.pm * 256 + wr * 64 + fr, col0 = u.pn * 128 + wc * 32 + 8 * fq;
#pragma unroll
        for (int ai = 0; ai < 2; ++ai)
#pragma unroll
            for (int m = 0; m < 4; ++m) { const u32x4 gw = *(const u32x4*)(H + (size_t)(row0 + ai * 128 + m * 16) * NH + C_MG + bi * DM + col0);
                float g[8]; unpack8(gw, g);
#pragma unroll
                for (int j = 0; j < 4; ++j) { y[ai][m][0][j] += g[j] * acc[ai][0][m][0][j]; y[ai][m][1][j] += g[4 + j] * acc[ai][0][m][1][j]; }
                if (m == 1 || m == 3) __builtin_amdgcn_sched_barrier(0); }
    }
    DI void finish(const f32x4 (&acc)[2][1][4][2], f32x4 (&y)[2][4][2], const pg8::Unit& u, int wr, int wc, int fr, int fq) const {
        flush(acc, y, u, 3, wr, wc, fr, fq);
        const int row0 = u.pm * 256 + wr * 64 + fr, col0 = u.pn * 128 + wc * 32 + 8 * fq;
#pragma unroll
        for (int ai = 0; ai < 2; ++ai)
#pragma unroll
            for (int m = 0; m < 4; ++m) { const f32x4 v0 = y[ai][m][0], v1 = y[ai][m][1];
                u32x4 w; w.x = cvt_pk_bf16(v0[0], v0[1]); w.y = cvt_pk_bf16(v0[2], v0[3]); w.z = cvt_pk_bf16(v1[0], v1[1]); w.w = cvt_pk_bf16(v1[2], v1[3]);
                *(u32x4*)(Y + (size_t)(row0 + ai * 128 + m * 16) * DM + col0) = w; }
    }
};
struct SchedInProj {
    int G, c, n_extra; const char *XB, *WT, *MEMB, *WKV;
    static constexpr int NM = 32, NN = 38, NU = NM * NN;
    static constexpr size_t TSTEP = (size_t)256 * 4096 * 2;
    DI bool next(int i, pg8::Unit& u) const {
        const long L = (long)i * G + c;
        if (L < NU) { pg8::static_tile((int)L, NM, NN, u.pm, u.pn); if (u.pn == 37) u.pn = 101; u.gi = 0; return true; }
        const int e = (int)(L - NU); if (e >= n_extra) return false;
        const int lx = e >> 4, r = e & 15;
        if (r < 8) { u.pm = r >> 2; u.pn = r & 3; u.gi = 1 + 2 * lx; } else { u.pm = (r - 8) >> 1; u.pn = (r - 8) & 1; u.gi = 2 + 2 * lx; }
        return true;
    }
    DI const char* abase(const pg8::Unit& u) const {
        if (u.gi == 0) return XB + (size_t)u.pm * TSTEP;
        const int lx = (u.gi - 1) >> 1, w = (u.gi - 1) & 1;
        return w == 0 ? MEMB + (size_t)u.pm * TSTEP : WKV + (size_t)lx * 2048 * 4096 * 2 + (size_t)(1024 + u.pm * 256) * 4096 * 2;
    }
    DI const char* bbase(const pg8::Unit& u) const {
        if (u.gi == 0) return WT + (size_t)u.pn * TSTEP;
        const int lx = (u.gi - 1) >> 1, w = (u.gi - 1) & 1;
        return w == 0 ? WKV + (size_t)lx * 2048 * 4096 * 2 + (size_t)u.pn * TSTEP : MEMB + (size_t)u.pn * TSTEP;
    }
};

DI int win_src_col(int n) { return n < 5120 ? n : (n < C_LR ? n + 16 : (n < C_LR + 16 ? n - C_LR + 5120 : -1)); }
template <bool WIN> DI void transpose_item(const float* W, size_t ldw, bf16* WT, size_t ldt, int k0, int n0, int kd0, LAS float* scr, int lane) {
    const int kr = lane >> 3, nc = lane & 7; int sc = n0 + 4 * nc; if (WIN) sc = win_src_col(sc);
    const float* src = W + (size_t)(k0 + kr) * ldw + (sc < 0 ? 0 : sc);
    f32x4 v[8];
#pragma unroll
    for (int i = 0; i < 8; ++i) v[i] = *(const f32x4*)(src + (size_t)(8 * i) * ldw);
#pragma unroll
    for (int i = 0; i < 8; ++i) { LAS float* d = scr + (8 * i + kr) * 33 + 4 * nc; const f32x4 x = (sc < 0) ? (f32x4){0.f, 0.f, 0.f, 0.f} : v[i]; d[0] = x.x; d[1] = x.y; d[2] = x.z; d[3] = x.w; }
    LDS_WAIT();
    const int c = lane & 7;
#pragma unroll
    for (int j = 0; j < 4; ++j) { const int n = (lane >> 3) + 8 * j; const LAS float* s = scr + (8 * c) * 33 + n;
        u32x4 o; o.x = pk2(s[0 * 33], s[1 * 33]); o.y = pk2(s[2 * 33], s[3 * 33]); o.z = pk2(s[4 * 33], s[5 * 33]); o.w = pk2(s[6 * 33], s[7 * 33]);
        *(u32x4*)(WT + (size_t)(n0 + n) * ldt + kd0 + 8 * c) = o; }
    LDS_WAIT();
}
DI void transpose_item_f8(const float* W, size_t ldw, unsigned char* WT, size_t ldt, int k0, int n0, LAS float* scr, int lane) {
    const int kr = lane >> 3, nc = lane & 7; const int sc = win_src_col(n0 + 4 * nc);
    const float* src = W + (size_t)(k0 + kr) * ldw + sc;
#pragma unroll
    for (int h = 0; h < 2; ++h) {
        f32x4 v[8];
#pragma unroll
        for (int i = 0; i < 8; ++i) v[i] = *(const f32x4*)(src + (size_t)(64 * h + 8 * i) * ldw);
#pragma unroll
        for (int i = 0; i < 8; ++i) { LAS float* d = scr + (64 * h + 8 * i + kr) * 33 + 4 * nc; d[0] = v[i].x * W8_SCALE; d[1] = v[i].y * W8_SCALE; d[2] = v[i].z * W8_SCALE; d[3] = v[i].w * W8_SCALE; }
    }
    LDS_WAIT();
    const int c = lane & 7;
#pragma unroll
    for (int j = 0; j < 4; ++j) { const int n = (lane >> 3) + 8 * j; const LAS float* s = scr + (16 * c) * 33 + n;
        u32x4 o; o.x = pk4_fp8(s[0 * 33], s[1 * 33], s[2 * 33], s[3 * 33]); o.y = pk4_fp8(s[4 * 33], s[5 * 33], s[6 * 33], s[7 * 33]);
        o.z = pk4_fp8(s[8 * 33], s[9 * 33], s[10 * 33], s[11 * 33]); o.w = pk4_fp8(s[12 * 33], s[13 * 33], s[14 * 33], s[15 * 33]);
        *(u32x4*)(WT + (size_t)(n0 - C_MG + n) * ldt + k0 + 16 * c) = o; }
    LDS_WAIT();
}
DI void prologue(const Frame& F, const float* x, const float* mem, const int* pos, const float* w_in, const float* w_pool, const float* w_mem_kv, const float* w_branch, const float* w_out) {
    LAS float* scr = (LAS float*)(F.lds + F.wave * 17408);
    const int gw = F.wg * NWAVES + F.wave, NGW = F.G * NWAVES, lane = F.lane;
    constexpr int I_IN = 64 * (NH / 32), I_KV = 64 * 64, I_BR = 16 * 128, I_OUT = 64 * 128, I_PL = 4 * 8;
    constexpr int NITEMS = 2 * I_IN + 2 * I_KV + 8 * I_BR + 2 * I_OUT + 8 * I_PL;
    for (int it = gw; it < NITEMS; it += NGW) {
        int r = it;
        if (r < 2 * I_IN) { const int l = r / I_IN; r -= l * I_IN; const int nb = r >> 6, kb = r & 63;
            if (nb * 32 >= C_MG && nb * 32 < C_LR) { if ((kb & 1) == 0) transpose_item_f8(w_in + (size_t)l * 4096 * D_IN, D_IN, wsp<unsigned char>(F, WS_W8) + (size_t)l * 16384 * 4096, 4096, kb * 64, nb * 32, scr, lane); }
            else transpose_item<true>(w_in + (size_t)l * 4096 * D_IN, D_IN, wsp<bf16>(F, WS_WINT) + (size_t)l * NH * 4096, 4096, kb * 64, nb * 32, kb * 64, scr, lane);
            continue; }
        r -= 2 * I_IN;
        if (r < 2 * I_KV) { const int l = r / I_KV; r -= l * I_KV; const int nb = r >> 6, kb = r & 63;
            transpose_item<false>(w_mem_kv + (size_t)l * 4096 * 2048, 2048, wsp<bf16>(F, WS_WMKVT) + (size_t)l * 2048 * 4096, 4096, kb * 64, nb * 32, kb * 64, scr, lane); continue; }
        r -= 2 * I_KV;
        if (r < 8 * I_BR) { const int lb = r / I_BR; r -= lb * I_BR; const int l = lb >> 2, bi = lb & 3; const int nb = r >> 4, kb = r & 15;
            transpose_item<false>(w_branch + (size_t)lb * 1024 * 4096, 4096, wsp<bf16>(F, WS_WBRT) + (size_t)l * 4096 * 4096, 4096, kb * 64, nb * 32, bi * 1024 + kb * 64, scr, lane); continue; }
        r -= 8 * I_BR;
        if (r < 2 * I_OUT) { const int l = r / I_OUT; r -= l * I_OUT; const int nb = r >> 6, kb = r & 63;
            transpose_item<false>(w_out + (size_t)l * 4096 * 4096, 4096, wsp<bf16>(F, WS_WOUTT) + (size_t)l * 4096 * 4096, 4096, kb * 64, nb * 32, kb * 64, scr, lane); continue; }
        r -= 2 * I_OUT;
        { const int lg = r / I_PL; r -= lg * I_PL; const int nb = r >> 2, kb = r & 3;
            transpose_item<false>(w_pool + (size_t)lg * 256 * 256, 256, wsp<bf16>(F, WS_WPOOLT) + (size_t)lg * 256 * 256, 256, kb * 64, nb * 32, kb * 64, scr, lane); }
    }
    const size_t gt = (size_t)F.wg * NTHR + F.tid, GT = (size_t)F.G * NTHR;
    { const f32x4* xs = (const f32x4*)x; u32x4* xd = wsp<u32x4>(F, WS_XB);
      u32x2* x8 = wsp<u32x2>(F, WS_X8);
      for (size_t i = gt; i < (size_t)MTOK * DM / 8; i += GT) { const f32x4 a = xs[2 * i], b = xs[2 * i + 1]; u32x4 o; o.x = pk2(a.x, a.y); o.y = pk2(a.z, a.w); o.z = pk2(b.x, b.y); o.w = pk2(b.z, b.w); xd[i] = o;
          u32x2 q; q.x = pk4_fp8(a.x * X8_SCALE, a.y * X8_SCALE, a.z * X8_SCALE, a.w * X8_SCALE); q.y = pk4_fp8(b.x * X8_SCALE, b.y * X8_SCALE, b.z * X8_SCALE, b.w * X8_SCALE); x8[i] = q; }
      const f32x4* ms = (const f32x4*)mem; u32x4* md = wsp<u32x4>(F, WS_MEMB);
      for (size_t i = gt; i < (size_t)BATCH * MEMLEN * DM / 8; i += GT) { const f32x4 a = ms[2 * i], b = ms[2 * i + 1]; u32x4 o; o.x = pk2(a.x, a.y); o.y = pk2(a.z, a.w); o.z = pk2(b.x, b.y); o.w = pk2(b.z, b.w); md[i] = o; } }
    { f32x2* rt = wsp<f32x2>(F, WS_ROPE);
      for (size_t i = gt; i < (size_t)MTOK * 8; i += GT) { const int t = (int)(i >> 3), fi = (int)(i & 7);
          const float inv = (float)pow(500000.0, -(double)fi / 8.0); const float ang = (float)pos[t] * inv;
          rt[i] = (f32x2){cosf(ang), sinf(ang)}; } }
}

DI float fexp(float x) { return __builtin_amdgcn_exp2f(x * 1.44269504089f); }
DI float logsigmoid_f(float z) { return fminf(z, 0.f) - 0.69314718056f * __builtin_amdgcn_logf(1.0f + fexp(-fabsf(z))); }

DI void gla_a_unit(const Frame& F, int l, int unit, const float* w_gla_up, const float* b_gla) {
    const int bh = unit >> 6, c = unit & 63, b = bh >> 2, h = bh & 3, t0 = b * SEQ + c * 64, tid = F.tid, lane = F.lane, wave = F.wave;
    const bf16* H = wsp<bf16>(F, WS_H);
    LAS float* lrs = (LAS float*)(F.lds);
    LAS float* bcs = (LAS float*)(F.lds + 4096);
    LAS float* seg = (LAS float*)(F.lds + 36864);
    LAS bf16* kds = (LAS bf16*)(F.lds + 40960);
    LAS bf16* vs = (LAS bf16*)(F.lds + 59392);
    constexpr int LDK = 136, LDV = 264;
    __syncthreads();
    if (tid < 128) { const int j = tid >> 1, hf = tid & 1; const u32x4 w = *(const u32x4*)(H + (size_t)(t0 + j) * NH + C_LR + 8 * hf); float f[8]; unpack8(w, f);
#pragma unroll
        for (int i = 0; i < 8; ++i) lrs[j * 16 + 8 * hf + i] = f[i]; }
    for (int p = tid; p < 64 * 32; p += NTHR) { const int j = p >> 5, ch = p & 31; *(LAS u32x4*)(vs + j * LDV + 8 * ch) = *(const u32x4*)(H + (size_t)(t0 + j) * NH + C_GV + h * 256 + 8 * ch); }
    __syncthreads();
    const int d = tid & 127, sg = tid >> 7;
    { float w[16];
#pragma unroll
      for (int r = 0; r < 16; ++r) w[r] = w_gla_up[(size_t)l * 16 * 512 + r * 512 + h * 128 + d];
      const float bg = b_gla[l * 512 + h * 128 + d]; float run = 0.f;
      for (int jj = 0; jj < 16; ++jj) { const int j = sg * 16 + jj; float z = bg;
#pragma unroll
          for (int r = 0; r < 16; ++r) z += lrs[j * 16 + r] * w[r];
          run += logsigmoid_f(z) * (1.0f / 16.0f); bcs[j * 128 + d] = run; }
      seg[sg * 128 + d] = run; }
    __syncthreads();
    { float pre = 0.f;
      for (int s = 0; s < sg; ++s) pre += seg[s * 128 + d];
      float* GB = wsp<float>(F, WS_GB);
      for (int jj = 0; jj < 16; ++jj) { const int j = sg * 16 + jj; const float v = bcs[j * 128 + d] + pre; bcs[j * 128 + d] = v; GB[(size_t)(t0 + j) * 512 + h * 128 + d] = v; }
      if (sg == 3) wsp<float>(F, WS_DEC)[(size_t)unit * 128 + d] = expf(bcs[63 * 128 + d]); }
    __syncthreads();
    for (int p = tid; p < 64 * 16; p += NTHR) { const int j = p >> 4, ch = p & 15; const u32x4 w = *(const u32x4*)(H + (size_t)(t0 + j) * NH + C_GK + h * 128 + 8 * ch); float f[8]; unpack8(w, f);
#pragma unroll
        for (int i = 0; i < 8; ++i) f[i] *= fexp(bcs[63 * 128 + 8 * ch + i] - bcs[j * 128 + 8 * ch + i]);
        *(LAS u32x4*)(kds + j * LDK + 8 * ch) = pack8(f); }
    __syncthreads();
    f32x4 acc[2][8];
#pragma unroll
    for (int a = 0; a < 2; ++a)
#pragma unroll
        for (int n = 0; n < 8; ++n) acc[a][n] = (f32x4){0.f, 0.f, 0.f, 0.f};
#pragma unroll
    for (int ks = 0; ks < 2; ++ks) {
        bf16x8 af[2];
#pragma unroll
        for (int a = 0; a < 2; ++a) af[a] = frag_tr(vs, LDV, 32 * ks, 32 * wave + 16 * a, lane);
#pragma unroll
        for (int n = 0; n < 8; ++n) { const bf16x8 bfr = frag_tr(kds, LDK, 32 * ks, 16 * n, lane);
#pragma unroll
            for (int a = 0; a < 2; ++a) acc[a][n] = mma16(bfr, af[a], acc[a][n]); }
    }
    float* U = wsp<float>(F, WS_GU) + (size_t)unit * 256 * 128;
#pragma unroll
    for (int a = 0; a < 2; ++a)
#pragma unroll
        for (int n = 0; n < 8; ++n) *(f32x4*)(U + (size_t)(32 * wave + 16 * a + (lane & 15)) * 128 + 16 * n + 4 * (lane >> 4)) = acc[a][n];
}

DI void gla_scan(const Frame& F) {
    const float* U = wsp<float>(F, WS_GU); const float* DEC = wsp<float>(F, WS_DEC); unsigned* S = wsp<unsigned>(F, WS_GS);
    const int gt = F.wg * NTHR + F.tid, GT = F.G * NTHR;
    for (int it = gt; it < 8 * 256 * 64; it += GT) {
        const int bh = it >> 14, r = it & 16383, e = r >> 6, dp = r & 63;
        float s0 = 0.f, s1 = 0.f;
#pragma unroll 8
        for (int c = 0; c < 64; ++c) { const size_t un = (size_t)bh * 64 + c; const size_t o = (un * 256 + e) * 128 + 2 * dp;
            const f32x2 u = *(const f32x2*)(U + o); const f32x2 dc = *(const f32x2*)(DEC + un * 128 + 2 * dp);
            S[o >> 1] = pk2(s0, s1); s0 = dc.x * s0 + u.x; s1 = dc.y * s1 + u.y; }
    }
}

DI void gla_c_unit(const Frame& F, int l, int unit, const float* gla_norm) {
    const int bh = unit >> 6, c = unit & 63, b = bh >> 2, h = bh & 3, t0 = b * SEQ + c * 64, tid = F.tid, lane = F.lane, wave = F.wave;
    const bf16* H = wsp<bf16>(F, WS_H);
    LAS bf16* qs = (LAS bf16*)(F.lds);
    LAS bf16* ks = (LAS bf16*)(F.lds + 17408);
    LAS bf16* vs = (LAS bf16*)(F.lds + 34816);
    LAS bf16* ps = (LAS bf16*)(F.lds + 68608);
    LAS float* red = (LAS float*)(F.lds + 77824);
    constexpr int LDK = 136, LDV = 264, LDP = 72;
    __syncthreads();
    const float* GB = wsp<float>(F, WS_GB);
    for (int p = tid; p < 64 * 16; p += NTHR) { const int j = p >> 4, ch = p & 15;
        const u32x4 qw = *(const u32x4*)(H + (size_t)(t0 + j) * NH + C_GQ + h * 128 + 8 * ch); const u32x4 kw = *(const u32x4*)(H + (size_t)(t0 + j) * NH + C_GK + h * 128 + 8 * ch);
        const f32x4 b0 = *(const f32x4*)(GB + (size_t)(t0 + j) * 512 + h * 128 + 8 * ch), b1 = *(const f32x4*)(GB + (size_t)(t0 + j) * 512 + h * 128 + 8 * ch + 4);
        float q[8], k[8]; unpack8(qw, q); unpack8(kw, k); const float bb[8] = {b0.x, b0.y, b0.z, b0.w, b1.x, b1.y, b1.z, b1.w};
#pragma unroll
        for (int i = 0; i < 8; ++i) { const float eb = fexp(bb[i]); q[i] *= eb * 0.08838834764831845f; k[i] *= fexp(-bb[i]); }
        *(LAS u32x4*)(qs + j * LDK + 8 * ch) = pack8(q); *(LAS u32x4*)(ks + j * LDK + 8 * ch) = pack8(k); }
    for (int p = tid; p < 64 * 32; p += NTHR) { const int j = p >> 5, ch = p & 31; *(LAS u32x4*)(vs + j * LDV + 8 * ch) = *(const u32x4*)(H + (size_t)(t0 + j) * NH + C_GV + h * 256 + 8 * ch); }
    __syncthreads();
    { const int it = wave >> 1; f32x4 sa[2] = {(f32x4){0.f, 0.f, 0.f, 0.f}, (f32x4){0.f, 0.f, 0.f, 0.f}};
#pragma unroll
      for (int kk = 0; kk < 4; ++kk) { const bf16x8 qa = frag_lds(qs, LDK, 16 * it, 32 * kk, lane);
#pragma unroll
          for (int jj = 0; jj < 2; ++jj) sa[jj] = mma16(qa, frag_lds(ks, LDK, 16 * (2 * (wave & 1) + jj), 32 * kk, lane), sa[jj]); }
#pragma unroll
      for (int jj = 0; jj < 2; ++jj)
#pragma unroll
          for (int r = 0; r < 4; ++r) { const int i = 16 * it + 4 * (lane >> 4) + r, j = 16 * (2 * (wave & 1) + jj) + (lane & 15);
              ps[i * LDP + j] = (bf16)f2bf(j <= i ? sa[jj][r] : 0.f); } }
    __syncthreads();
    f32x4 acc[2][4];
#pragma unroll
    for (int a = 0; a < 2; ++a)
#pragma unroll
        for (int n = 0; n < 4; ++n) acc[a][n] = (f32x4){0.f, 0.f, 0.f, 0.f};
    const bf16* St = wsp<bf16>(F, WS_GS) + (size_t)unit * 256 * 128;
#pragma unroll
    for (int kk = 0; kk < 4; ++kk) { bf16x8 af[2];
#pragma unroll
        for (int a = 0; a < 2; ++a) af[a] = frag_glb(St, 128, 32 * wave + 16 * a, 32 * kk, lane);
#pragma unroll
        for (int n = 0; n < 4; ++n) { const bf16x8 bq = frag_lds(qs, LDK, 16 * n, 32 * kk, lane);
#pragma unroll
            for (int a = 0; a < 2; ++a) acc[a][n] = mma16(af[a], bq, acc[a][n]); } }
#pragma unroll
    for (int kk = 0; kk < 2; ++kk) { bf16x8 af[2];
#pragma unroll
        for (int a = 0; a < 2; ++a) af[a] = frag_tr(vs, LDV, 32 * kk, 32 * wave + 16 * a, lane);
#pragma unroll
        for (int n = 0; n < 4; ++n) { const bf16x8 bp = frag_lds(ps, LDP, 16 * n, 32 * kk, lane);
#pragma unroll
            for (int a = 0; a < 2; ++a) acc[a][n] = mma16(af[a], bp, acc[a][n]); } }
#pragma unroll
    for (int n = 0; n < 4; ++n) { float s = 0.f;
#pragma unroll
        for (int a = 0; a < 2; ++a)
#pragma unroll
            for (int r = 0; r < 4; ++r) s += acc[a][n][r] * acc[a][n][r];
        s += __shfl_xor(s, 16); s += __shfl_xor(s, 32);
        if (lane < 16) red[wave * 64 + 16 * n + lane] = s; }
    __syncthreads();
    bf16* OB = wsp<bf16>(F, WS_OB);
#pragma unroll
    for (int n = 0; n < 4; ++n) { const int i = 16 * n + (lane & 15); float tot = 0.f;
#pragma unroll
        for (int w = 0; w < 8; ++w) tot += red[w * 64 + i];
        const float rs = 1.0f / sqrtf(tot * (1.0f / 256.0f) + LN_EPS);
#pragma unroll
        for (int a = 0; a < 2; ++a) { const int e = 32 * wave + 16 * a + 4 * (lane >> 4);
            const f32x4 gn = *(const f32x4*)(gla_norm + l * 1024 + h * 256 + e);
            const u32x2 gw = *(const u32x2*)(H + (size_t)(t0 + i) * NH + C_GG + h * 256 + e);
            const float g0 = bf2f(gw.x & 0xffffu), g1 = bf2f(gw.x >> 16), g2 = bf2f(gw.y & 0xffffu), g3 = bf2f(gw.y >> 16);
            u32x2 o; o.x = pk2(acc[a][n][0] * rs * gn.x * g0, acc[a][n][1] * rs * gn.y * g1); o.y = pk2(acc[a][n][2] * rs * gn.z * g2, acc[a][n][3] * rs * gn.w * g3);
            *(u32x2*)(OB + (size_t)(t0 + i) * DM + 1024 + h * 256 + e) = o; } }
}

DI void pool_unit(const Frame& F, int l, int unit, const float* pool_scale) {
    const int gi = unit & 3, tt = unit >> 2, t0 = tt * 64, tid = F.tid, lane = F.lane, wave = F.wave, w = 2 << gi;
    const bf16* H = wsp<bf16>(F, WS_H);
    LAS bf16* pl = (LAS bf16*)(F.lds);
    constexpr int LDP = 264;
    __syncthreads();
    for (int p = tid; p < 64 * 32; p += NTHR) { const int j = p >> 5, ch = p & 31, t = t0 + j, ts = t & (SEQ - 1);
        const int cnt = (ts + 1 < w) ? ts + 1 : w; float a[8];
#pragma unroll
        for (int i = 0; i < 8; ++i) a[i] = 0.f;
        float u0[8];
        const bf16* hp = H + (size_t)t * NH + C_PU + gi * 256 + 8 * ch;
        { float f[8]; unpack8(*(const u32x4*)hp, f);
#pragma unroll
          for (int i = 0; i < 8; ++i) { a[i] = f[i]; u0[i] = f[i]; } }
#pragma unroll
        for (int s = 1; s < 16; ++s) if (s < w) { const int sb = (s < cnt) ? s : 0;
            const u32x4 x = *(const u32x4*)(hp - (size_t)sb * NH); float f[8]; unpack8(x, f); const float wgt = (s < cnt) ? 1.f : 0.f;
#pragma unroll
            for (int i = 0; i < 8; ++i) a[i] += wgt * f[i]; }
        const float ic = 1.0f / (float)cnt;
#pragma unroll
        for (int i = 0; i < 8; ++i) a[i] = a[i] * ic - u0[i];
        *(LAS u32x4*)(pl + j * LDP + 8 * ch) = pack8(a); }
    __syncthreads();
    const bf16* WP = wsp<bf16>(F, WS_WPOOLT) + (size_t)(l * 4 + gi) * 256 * 256;
    f32x4 acc[2][4];
#pragma unroll
    for (int a = 0; a < 2; ++a)
#pragma unroll
        for (int n = 0; n < 4; ++n) acc[a][n] = (f32x4){0.f, 0.f, 0.f, 0.f};
#pragma unroll 2
    for (int kk = 0; kk < 8; ++kk) { bf16x8 af[2];
#pragma unroll
        for (int a = 0; a < 2; ++a) af[a] = frag_glb(WP, 256, 32 * wave + 16 * a, 32 * kk, lane);
#pragma unroll
        for (int n = 0; n < 4; ++n) { const bf16x8 bp = frag_lds(pl, LDP, 16 * n, 32 * kk, lane);
#pragma unroll
            for (int a = 0; a < 2; ++a) acc[a][n] = mma16(af[a], bp, acc[a][n]); } }
    bf16* OB = wsp<bf16>(F, WS_OB);
#pragma unroll
    for (int n = 0; n < 4; ++n) { const int t = t0 + 16 * n + (lane & 15);
#pragma unroll
        for (int a = 0; a < 2; ++a) { const int dd = gi * 256 + 32 * wave + 16 * a + 4 * (lane >> 4);
            const f32x4 sc = *(const f32x4*)(pool_scale + l * 1024 + dd);
            const u32x2 gw = *(const u32x2*)(H + (size_t)t * NH + C_PG + dd);
            const float g0 = bf2f(gw.x & 0xffffu), g1 = bf2f(gw.x >> 16), g2 = bf2f(gw.y & 0xffffu), g3 = bf2f(gw.y >> 16);
            u32x2 o; o.x = pk2(acc[a][n][0] * sc.x * g0, acc[a][n][1] * sc.y * g1); o.y = pk2(acc[a][n][2] * sc.z * g2, acc[a][n][3] * sc.w * g3);
            *(u32x2*)(OB + (size_t)t * DM + dd) = o; } }
}

DI void swa_unit(const Frame& F, int l, int unit, const float* sinks) {
    const int n = unit & 31, hq = (unit >> 5) & 15, b = unit >> 9, kvh = hq >> 3, tid = F.tid, lane = F.lane, wave = F.wave;
    const int tq0 = b * SEQ + n * 128, tk0 = tq0 - 128;
    const bf16* H = wsp<bf16>(F, WS_H); const f32x2* RT = wsp<f32x2>(F, WS_ROPE);
    constexpr int LD = 72, LDPW = 168;
    LAS bf16* qs = (LAS bf16*)(F.lds);
    LAS bf16* ks = (LAS bf16*)(F.lds + 18432);
    LAS bf16* vs = (LAS bf16*)(F.lds + 57600);
    LAS bf16* pw = (LAS bf16*)(F.lds + 96768) + wave * 16 * LDPW;
    __syncthreads();
    for (int p = tid; p < 128 * 4; p += NTHR) { const int i = p >> 2, ch = p & 3; const bf16* src = H + (size_t)(tq0 + i) * NH + C_SQ + hq * 64 + 16 * ch;
        float f[16]; { float a[8], c[8]; unpack8(*(const u32x4*)src, a); unpack8(*(const u32x4*)(src + 8), c);
#pragma unroll
            for (int j = 0; j < 8; ++j) { f[j] = a[j]; f[8 + j] = c[j]; } }
        if (ch == 0) {
#pragma unroll
            for (int j = 0; j < 8; ++j) { const f32x2 cs = RT[(size_t)(tq0 + i) * 8 + j]; const float x1 = f[j], x2 = f[8 + j]; f[j] = x1 * cs.x - x2 * cs.y; f[8 + j] = x2 * cs.x + x1 * cs.y; } }
        float o0[8], o1[8];
#pragma unroll
        for (int j = 0; j < 8; ++j) { o0[j] = f[j] * 0.125f; o1[j] = f[8 + j] * 0.125f; }
        *(LAS u32x4*)(qs + i * LD + 16 * ch) = pack8(o0); *(LAS u32x4*)(qs + i * LD + 16 * ch + 8) = pack8(o1); }
    for (int p = tid; p < 272 * 4; p += NTHR) { const int j = p >> 2, ch = p & 3; const bool ok = (j < 256) && (n > 0 || j >= 128);
        u32x4 k0 = (u32x4){0u, 0u, 0u, 0u}, k1 = k0, v0 = k0, v1 = k0;
        if (ok) { const bf16* ksrc = H + (size_t)(tk0 + j) * NH + C_SK + kvh * 64 + 16 * ch; const bf16* vsrc = H + (size_t)(tk0 + j) * NH + C_SV + kvh * 64 + 16 * ch;
            k0 = *(const u32x4*)ksrc; k1 = *(const u32x4*)(ksrc + 8); v0 = *(const u32x4*)vsrc; v1 = *(const u32x4*)(vsrc + 8);
            if (ch == 0) { float a[8], c[8]; unpack8(k0, a); unpack8(k1, c);
#pragma unroll
                for (int jj = 0; jj < 8; ++jj) { const f32x2 cs = RT[(size_t)(tk0 + j) * 8 + jj]; const float x1 = a[jj], x2 = c[jj]; a[jj] = x1 * cs.x - x2 * cs.y; c[jj] = x2 * cs.x + x1 * cs.y; }
                k0 = pack8(a); k1 = pack8(c); } }
        *(LAS u32x4*)(ks + j * LD + 16 * ch) = k0; *(LAS u32x4*)(ks + j * LD + 16 * ch + 8) = k1;
        *(LAS u32x4*)(vs + j * LD + 16 * ch) = v0; *(LAS u32x4*)(vs + j * LD + 16 * ch + 8) = v1; }
    __syncthreads();
    const int qi = 16 * wave + (lane & 15);
    bf16x8 qf[2];
#pragma unroll
    for (int s = 0; s < 2; ++s) qf[s] = frag_lds(qs, LD, 16 * wave, 32 * s, lane);
    f32x4 sc[10];
#pragma unroll
    for (int jt = 0; jt < 10; ++jt) { sc[jt] = (f32x4){0.f, 0.f, 0.f, 0.f};
#pragma unroll
        for (int s = 0; s < 2; ++s) sc[jt] = mma16(frag_lds(ks, LD, 16 * (wave + jt), 32 * s, lane), qf[s], sc[jt]); }
    const float sink = sinks[l * 16 + hq];
    float mx = sink;
#pragma unroll
    for (int jt = 0; jt < 10; ++jt)
#pragma unroll
        for (int r = 0; r < 4; ++r) { const int kj = 16 * (wave + jt) + 4 * (lane >> 4) + r; const bool ok = (kj > qi) && (kj <= qi + 128) && (n > 0 || kj >= 128);
            sc[jt][r] = ok ? sc[jt][r] : -INFINITY; mx = fmaxf(mx, sc[jt][r]); }
    mx = fmaxf(mx, __shfl_xor(mx, 16)); mx = fmaxf(mx, __shfl_xor(mx, 32));
    float sum = 0.f;
#pragma unroll
    for (int jt = 0; jt < 10; ++jt)
#pragma unroll
        for (int r = 0; r < 4; ++r) { const float p = fexp(sc[jt][r] - mx); sc[jt][r] = p; sum += p; }
    sum += __shfl_xor(sum, 16); sum += __shfl_xor(sum, 32);
    const float inv = 1.0f / (sum + fexp(sink - mx));
#pragma unroll
    for (int jt = 0; jt < 10; ++jt) { u32x2 o; o.x = pk2(sc[jt][0] * inv, sc[jt][1] * inv); o.y = pk2(sc[jt][2] * inv, sc[jt][3] * inv);
        *(LAS u32x2*)(pw + (lane & 15) * LDPW + 16 * jt + 4 * (lane >> 4)) = o; }
    LDS_WAIT();
    f32x4 oa[4];
#pragma unroll
    for (int dt = 0; dt < 4; ++dt) oa[dt] = (f32x4){0.f, 0.f, 0.f, 0.f};
#pragma unroll
    for (int s = 0; s < 5; ++s) { const bf16x8 pf = frag_lds(pw, LDPW, 0, 32 * s, lane);
#pragma unroll
        for (int dt = 0; dt < 4; ++dt) oa[dt] = mma16(frag_tr(vs, LD, 16 * wave + 32 * s, 16 * dt, lane), pf, oa[dt]); }
    bf16* OB = wsp<bf16>(F, WS_OB);
    { const int t = tq0 + qi;
#pragma unroll
      for (int dt = 0; dt < 4; ++dt) { const int dd = hq * 64 + 16 * dt + 4 * (lane >> 4);
          const u32x2 gw = *(const u32x2*)(H + (size_t)t * NH + C_SG + dd);
          const float g0 = bf2f(gw.x & 0xffffu), g1 = bf2f(gw.x >> 16), g2 = bf2f(gw.y & 0xffffu), g3 = bf2f(gw.y >> 16);
          u32x2 o; o.x = pk2(oa[dt][0] * g0, oa[dt][1] * g1); o.y = pk2(oa[dt][2] * g2, oa[dt][3] * g3);
          *(u32x2*)(OB + (size_t)t * DM + 2048 + dd) = o; } }
}

DI void mem_unit(const Frame& F, int l, int unit) {
    const int n = unit & 31, hx = (unit >> 5) & 3, b = unit >> 7, lane = F.lane, wave = F.wave, tid = F.tid;
    const int tq0 = b * SEQ + n * 128 + 16 * wave;
    const bf16* H = wsp<bf16>(F, WS_H);
    const bf16* MK = wsp<bf16>(F, WS_MK) + (size_t)l * 512 * 1024 + (size_t)b * 256 * 1024 + hx * 256;
    const bf16* MVT = wsp<bf16>(F, WS_MVT) + (size_t)l * 1024 * 512 + (size_t)hx * 256 * 512 + b * 256;
    constexpr int LDI = 264;
    LAS bf16* img = (LAS bf16*)(F.lds);
    __syncthreads();
#pragma unroll 4
    for (int p = tid; p < 256 * 32; p += NTHR) { const int r = p >> 5, ch = p & 31; *(LAS u32x4*)(img + r * LDI + 8 * ch) = *(const u32x4*)(MK + (size_t)r * 1024 + 8 * ch); }
    bf16x8 qf[8];
#pragma unroll
    for (int s = 0; s < 8; ++s) qf[s] = frag_glb(H + C_XQ + hx * 256, NH, tq0, 32 * s, lane);
    __syncthreads();
    f32x4 sc[16];
#pragma unroll
    for (int jt = 0; jt < 16; ++jt) { sc[jt] = (f32x4){0.f, 0.f, 0.f, 0.f};
#pragma unroll
        for (int s = 0; s < 8; ++s) sc[jt] = mma16(frag_lds(img, LDI, 16 * jt, 32 * s, lane), qf[s], sc[jt]);
        if (jt & 1) __builtin_amdgcn_sched_barrier(0); }
#pragma unroll
    for (int jt = 0; jt < 16; ++jt) asm volatile("" : "+v"(sc[jt]));
    __syncthreads();
#pragma unroll 4
    for (int p = tid; p < 256 * 32; p += NTHR) { const int r = p >> 5, ch = p & 31; *(LAS u32x4*)(img + r * LDI + 8 * ch) = *(const u32x4*)(MVT + (size_t)r * 512 + 8 * ch); }
    float mx = -INFINITY;
#pragma unroll
    for (int jt = 0; jt < 16; ++jt)
#pragma unroll
        for (int r = 0; r < 4; ++r) { sc[jt][r] *= 0.0625f; mx = fmaxf(mx, sc[jt][r]); }
    mx = fmaxf(mx, __shfl_xor(mx, 16)); mx = fmaxf(mx, __shfl_xor(mx, 32));
    float sum = 0.f;
#pragma unroll
    for (int jt = 0; jt < 16; ++jt)
#pragma unroll
        for (int r = 0; r < 4; ++r) { const float p = __builtin_amdgcn_exp2f((sc[jt][r] - mx) * 1.44269504089f); sc[jt][r] = p; sum += p; }
    sum += __shfl_xor(sum, 16); sum += __shfl_xor(sum, 32);
    const float inv = 1.0f / sum;
    bf16x8 pb[8];
#pragma unroll
    for (int s = 0; s < 8; ++s) { u32x4 w; w.x = pk2(sc[2 * s][0] * inv, sc[2 * s][1] * inv); w.y = pk2(sc[2 * s][2] * inv, sc[2 * s][3] * inv);
        w.z = pk2(sc[2 * s + 1][0] * inv, sc[2 * s + 1][1] * inv); w.w = pk2(sc[2 * s + 1][2] * inv, sc[2 * s + 1][3] * inv); pb[s] = __builtin_bit_cast(bf16x8, w); }
    __syncthreads();
    bf16* OB = wsp<bf16>(F, WS_OB); const int t = tq0 + (lane & 15);
    const LAS bf16* arow = img + (lane & 15) * LDI + 4 * (lane >> 4);
#pragma unroll 4
    for (int dt = 0; dt < 16; ++dt) { f32x4 oa = (f32x4){0.f, 0.f, 0.f, 0.f};
#pragma unroll
        for (int s = 0; s < 8; ++s) { const u32x2 lo = *(const LAS u32x2*)(arow + 16 * dt * LDI + 32 * s), hi = *(const LAS u32x2*)(arow + 16 * dt * LDI + 32 * s + 16);
            const u32x4 av = (u32x4){lo.x, lo.y, hi.x, hi.y};
            oa = mma16(__builtin_bit_cast(bf16x8, av), pb[s], oa); }
        __builtin_amdgcn_sched_barrier(0);
        const int dd = hx * 256 + 16 * dt + 4 * (lane >> 4);
        const u32x2 gw = *(const u32x2*)(H + (size_t)t * NH + C_XG + dd);
        const float g0 = bf2f(gw.x & 0xffffu), g1 = bf2f(gw.x >> 16), g2 = bf2f(gw.y & 0xffffu), g3 = bf2f(gw.y >> 16);
        u32x2 o; o.x = pk2(oa[0] * g0, oa[1] * g1); o.y = pk2(oa[2] * g2, oa[3] * g3);
        *(u32x2*)(OB + (size_t)t * DM + 3072 + dd) = o; }
}

#ifndef NAIVE_MASK
#define NAIVE_MASK 0
#endif
DI float Hf(const bf16* H, size_t row, int col) { return bf2f(H[row * NH + col]); }
DI void naive_mem(const Frame& F, int l) {
    const bf16* H = wsp<bf16>(F, WS_H); bf16* OB = wsp<bf16>(F, WS_OB);
    LAS float* qs = (LAS float*)(F.lds) + F.wave * 512; LAS float* ps = qs + 256;
    const int gw = F.wg * NWAVES + F.wave, NGW = F.G * NWAVES, lane = F.lane;
    for (int it = gw; it < MTOK * 4; it += NGW) {
        const int t = it >> 2, hx = it & 3, b = t / SEQ;
        const bf16* MK = wsp<bf16>(F, WS_MK) + (size_t)l * 512 * 1024 + (size_t)b * 256 * 1024 + hx * 256;
        const bf16* MVT = wsp<bf16>(F, WS_MVT) + (size_t)l * 1024 * 512 + (size_t)hx * 256 * 512 + b * 256;
        for (int i = 0; i < 4; ++i) qs[lane + 64 * i] = Hf(H, t, C_XQ + hx * 256 + lane + 64 * i);
        LDS_WAIT();
        float sc[4]; float mx = -INFINITY;
        for (int i = 0; i < 4; ++i) { const int j = lane + 64 * i; float a = 0.f; for (int d = 0; d < 256; ++d) a += qs[d] * bf2f(MK[(size_t)j * 1024 + d]); sc[i] = a * 0.0625f; mx = fmaxf(mx, sc[i]); }
        for (int o = 1; o < 64; o <<= 1) mx = fmaxf(mx, __shfl_xor(mx, o));
        float sum = 0.f; for (int i = 0; i < 4; ++i) { sc[i] = expf(sc[i] - mx); sum += sc[i]; }
        sum = wave_sum(sum);
        for (int i = 0; i < 4; ++i) ps[lane + 64 * i] = sc[i] / sum;
        LDS_WAIT();
        for (int i = 0; i < 4; ++i) { const int d = lane + 64 * i; float a = 0.f; for (int j = 0; j < 256; ++j) a += ps[j] * bf2f(MVT[(size_t)d * 512 + j]);
            OB[(size_t)t * DM + 3072 + hx * 256 + d] = (bf16)f2bf(a * Hf(H, t, C_XG + hx * 256 + d)); }
        LDS_WAIT();
    }
}
DI void naive_swa(const Frame& F, int l, const float* sinks) {
    const bf16* H = wsp<bf16>(F, WS_H); bf16* OB = wsp<bf16>(F, WS_OB); const f32x2* RT = wsp<f32x2>(F, WS_ROPE);
    LAS float* qs = (LAS float*)(F.lds) + F.wave * 256; LAS float* ps = qs + 64;
    const int gw = F.wg * NWAVES + F.wave, NGW = F.G * NWAVES, lane = F.lane;
    for (int it = gw; it < MTOK * 16; it += NGW) {
        const int t = it >> 4, hq = it & 15, kvh = hq >> 3, ts = t & (SEQ - 1);
        { float x = Hf(H, t, C_SQ + hq * 64 + lane);
          if (lane < 16) { const int i = lane & 7; const float x1 = Hf(H, t, C_SQ + hq * 64 + i), x2 = Hf(H, t, C_SQ + hq * 64 + 8 + i); const f32x2 cs = RT[(size_t)t * 8 + i];
              x = (lane < 8) ? x1 * cs.x - x2 * cs.y : x2 * cs.x + x1 * cs.y; }
          qs[lane] = x * 0.125f; }
        LDS_WAIT();
        float sc[2]; const float sink = sinks[l * 16 + hq]; float mx = sink;
        for (int i = 0; i < 2; ++i) { const int back = lane + 64 * i; sc[i] = -INFINITY;
            if (back <= ts) { const int tk = t - back; float a = 0.f;
                for (int d = 0; d < 64; ++d) { float kv = Hf(H, tk, C_SK + kvh * 64 + d);
                    if (d < 16) { const int ii = d & 7; const float x1 = Hf(H, tk, C_SK + kvh * 64 + ii), x2 = Hf(H, tk, C_SK + kvh * 64 + 8 + ii); const f32x2 cs = RT[(size_t)tk * 8 + ii];
                        kv = (d < 8) ? x1 * cs.x - x2 * cs.y : x2 * cs.x + x1 * cs.y; }
                    a += qs[d] * kv; }
                sc[i] = a; }
            mx = fmaxf(mx, sc[i]); }
        for (int o = 1; o < 64; o <<= 1) mx = fmaxf(mx, __shfl_xor(mx, o));
        float sum = 0.f; for (int i = 0; i < 2; ++i) { sc[i] = expf(sc[i] - mx); sum += sc[i]; }
        sum = wave_sum(sum) + expf(sink - mx);
        for (int i = 0; i < 2; ++i) ps[lane + 64 * i] = sc[i] / sum;
        LDS_WAIT();
        { float a = 0.f; const int nk = (ts + 1 < 128) ? ts + 1 : 128;
          for (int back = 0; back < nk; ++back) a += ps[back] * Hf(H, t - back, C_SV + kvh * 64 + lane);
          OB[(size_t)t * DM + 2048 + hq * 64 + lane] = (bf16)f2bf(a * Hf(H, t, C_SG + hq * 64 + lane)); }
        LDS_WAIT();
    }
}
DI void naive_pool(const Frame& F, int l, const float* w_pool, const float* pool_scale) {
    const bf16* H = wsp<bf16>(F, WS_H); bf16* OB = wsp<bf16>(F, WS_OB); LAS float* pl = (LAS float*)(F.lds);
    for (int unit = F.wg; unit < 512; unit += F.G) { const int gi = unit & 3, t0 = (unit >> 2) * 64, w = 2 << gi;
        __syncthreads();
        for (int p = F.tid; p < 64 * 256; p += NTHR) { const int j = p >> 8, c = p & 255, t = t0 + j, ts = t & (SEQ - 1); const int cnt = (ts + 1 < w) ? ts + 1 : w; float a = 0.f;
            for (int s2 = 0; s2 < cnt; ++s2) a += Hf(H, t - s2, C_PU + gi * 256 + c);
            pl[p] = a / (float)cnt - Hf(H, t, C_PU + gi * 256 + c); }
        __syncthreads();
        const float* W = w_pool + (size_t)(l * 4 + gi) * 256 * 256;
        for (int o = F.tid; o < 64 * 256; o += NTHR) { const int j = o >> 8, d = o & 255; float a = 0.f; for (int c = 0; c < 256; ++c) a += pl[j * 256 + c] * W[c * 256 + d];
            const int t = t0 + j; OB[(size_t)t * DM + gi * 256 + d] = (bf16)f2bf(a * pool_scale[l * 1024 + gi * 256 + d] * Hf(H, t, C_PG + gi * 256 + d)); } }
}
DI void naive_gla(const Frame& F, int l, const float* w_gla_up, const float* b_gla) {
    const bf16* H = wsp<bf16>(F, WS_H); float* RAW = wsp<float>(F, WS_GU); LAS float* red = (LAS float*)(F.lds);
    for (int unit = F.wg; unit < 64; unit += F.G) { const int bh = unit >> 3, es = unit & 7, b = bh >> 2, h = bh & 3, e = es * 32 + (F.tid & 31), dg = F.tid >> 5;
        float S[8], wu[8][16], bg[8];
        for (int i = 0; i < 8; ++i) { S[i] = 0.f; bg[i] = b_gla[l * 512 + h * 128 + 8 * dg + i]; for (int r = 0; r < 16; ++r) wu[i][r] = w_gla_up[(size_t)l * 16 * 512 + r * 512 + h * 128 + 8 * dg + i]; }
        for (int ts = 0; ts < SEQ; ++ts) { const size_t t = (size_t)b * SEQ + ts; float lr[16]; for (int r = 0; r < 16; ++r) lr[r] = Hf(H, t, C_LR + r);
            const float v = Hf(H, t, C_GV + h * 256 + e); float part = 0.f;
            for (int i = 0; i < 8; ++i) { float z = bg[i]; for (int r = 0; r < 16; ++r) z += lr[r] * wu[i][r];
                const float a = expf((fminf(z, 0.f) - log1pf(expf(-fabsf(z)))) * (1.0f / 16.0f));
                S[i] = a * S[i] + Hf(H, t, C_GK + h * 128 + 8 * dg + i) * v; part += Hf(H, t, C_GQ + h * 128 + 8 * dg + i) * 0.08838834764831845f * S[i]; }
            __syncthreads(); red[dg * 32 + (F.tid & 31)] = part; __syncthreads();
            if (dg == 0) { float o = 0.f; for (int g = 0; g < 16; ++g) o += red[g * 32 + (F.tid & 31)]; RAW[t * 1024 + h * 256 + e] = o; } } }
}
DI void naive_gla_norm(const Frame& F, int l, const float* gla_norm) {
    const bf16* H = wsp<bf16>(F, WS_H); bf16* OB = wsp<bf16>(F, WS_OB); const float* RAW = wsp<float>(F, WS_GU);
    const int gw = F.wg * NWAVES + F.wave, NGW = F.G * NWAVES, lane = F.lane;
    for (int it = gw; it < MTOK * 4; it += NGW) { const int t = it >> 2, h = it & 3; float o[4], ss = 0.f;
        for (int i = 0; i < 4; ++i) { o[i] = RAW[(size_t)t * 1024 + h * 256 + lane + 64 * i]; ss += o[i] * o[i]; }
        ss = wave_sum(ss); const float rs = 1.0f / sqrtf(ss * (1.0f / 256.0f) + LN_EPS);
        for (int i = 0; i < 4; ++i) { const int e = lane + 64 * i; OB[(size_t)t * DM + 1024 + h * 256 + e] = (bf16)f2bf(o[i] * rs * gla_norm[l * 1024 + h * 256 + e] * Hf(H, t, C_GG + h * 256 + e)); } }
}

DI void ln_phase(const Frame& F, int l, const float* ln_g, const float* ln_b) {
    const int gw = F.wg * NWAVES + F.wave, NGW = F.G * NWAVES, lane = F.lane;
    const float* g = ln_g + l * DM; const float* bb = ln_b + l * DM;
    for (int m = gw; m < MTOK; m += NGW) {
        f32x4* row = (f32x4*)(F.out + (size_t)m * DM) + lane; const f32x4* zrow = (const f32x4*)(wsp<float>(F, WS_Z) + (size_t)m * DM) + lane;
        f32x4 v[16]; float s = 0.f;
#pragma unroll
        for (int j = 0; j < 16; ++j) { v[j] = zrow[64 * j]; s += (v[j].x + v[j].y) + (v[j].z + v[j].w); }
        const float mean = wave_sum(s) * (1.f / DM); float s2 = 0.f;
#pragma unroll
        for (int j = 0; j < 16; ++j) { v[j] = v[j] - mean; s2 += (v[j].x * v[j].x + v[j].y * v[j].y) + (v[j].z * v[j].z + v[j].w * v[j].w); }
        const float rstd = 1.f / sqrtf(wave_sum(s2) * (1.f / DM) + LN_EPS);
        u32x2* xb = (u32x2*)(wsp<bf16>(F, WS_XB) + (size_t)m * DM) + lane; unsigned* x8 = (unsigned*)(wsp<unsigned char>(F, WS_X8) + (size_t)m * DM) + lane;
#pragma unroll
        for (int j = 0; j < 16; ++j) { const f32x4 gg = *((const f32x4*)g + lane + 64 * j), be = *((const f32x4*)bb + lane + 64 * j);
            const f32x4 o = v[j] * rstd * gg + be; row[64 * j] = o;
            if (l + 1 < DEPTH) { u32x2 w; w.x = pk2(o.x, o.y); w.y = pk2(o.z, o.w); xb[64 * j] = w; x8[64 * j] = pk4_fp8(o.x * X8_SCALE, o.y * X8_SCALE, o.z * X8_SCALE, o.w * X8_SCALE); } }
    }
}

struct Args { const void* in[15]; float* out; unsigned char* ws; int ph_lo, ph_hi; };
constexpr int PH_PER_LAYER = 7, N_PHASES = 1 + PH_PER_LAYER * DEPTH;
#define IN(k) (lo <= (k) && (k) < hi)
#ifndef PH_MASK
#define PH_MASK 0xffff
#endif
#define PHM(b) ((PH_MASK >> (b)) & 1)
#ifndef REP_MASK
#define REP_MASK 0
#endif
#define REPS(b) (((REP_MASK >> (b)) & 1) ? 2 : 1)
#define SEAM(k) do { if (IN(k) && IN((k) + 1)) xcd_barrier(bar); } while (0)
template <int l> DI void layer_body(const Frame& F, const Args& args, const int lo, const int hi, const XcdBarrier& bar) {
        const int p0 = 1 + PH_PER_LAYER * l;
        if (PHM(1) && IN(p0)) { {
            SchedInProj S; S.G = F.G; S.c = F.wg; S.n_extra = (l == 0) ? 32 : 0; S.XB = (const char*)(F.ws + WS_XB); S.WT = (const char*)(F.ws + WS_WINT) + (size_t)l * NH * 4096 * 2;
            S.MEMB = (const char*)(F.ws + WS_MEMB); S.WKV = (const char*)(F.ws + WS_WMKVT);
            EpiH E{wsp<bf16>(F, WS_H), wsp<bf16>(F, WS_MK), wsp<bf16>(F, WS_MVT)};
            pg8::gemm_phase<EpiH, SchedInProj, 2, true>(F.lds, 4096, S, E);
            pg8::SchedStatic S8; S8.nM = 32; S8.nN = 64 * (2 / F8NB); S8.G = F.G; S8.c = F.wg; S8.A = (const char*)(F.ws + WS_X8); S8.B = (const char*)(F.ws + WS_W8) + (size_t)l * 16384 * 4096;
            S8.astep = (size_t)256 * 4096; S8.bstep = (size_t)(128 * F8NB) * 4096;
            EpiMG<F8NB> E8{wsp<bf16>(F, WS_H)};
            pg8::gemm_phase<EpiMG<F8NB>, pg8::SchedStatic, F8NB, (F8NB == 2), true>(F.lds, 2048, S8, E8);
        }
        if (REPS(1) == 2) {
            SchedInProj S; S.G = F.G; S.c = F.wg; S.n_extra = (l == 0) ? 32 : 0; S.XB = (const char*)(F.ws + WS_XB); S.WT = (const char*)(F.ws + WS_WINT) + (size_t)l * NH * 4096 * 2;
            S.MEMB = (const char*)(F.ws + WS_MEMB); S.WKV = (const char*)(F.ws + WS_WMKVT);
            EpiH E{wsp<bf16>(F, WS_H), wsp<bf16>(F, WS_MK), wsp<bf16>(F, WS_MVT)};
            pg8::gemm_phase<EpiH, SchedInProj, 2, true>(F.lds, 4096, S, E);
            pg8::SchedStatic S8; S8.nM = 32; S8.nN = 64 * (2 / F8NB); S8.G = F.G; S8.c = F.wg; S8.A = (const char*)(F.ws + WS_X8); S8.B = (const char*)(F.ws + WS_W8) + (size_t)l * 16384 * 4096;
            S8.astep = (size_t)256 * 4096; S8.bstep = (size_t)(128 * F8NB) * 4096;
            EpiMG<F8NB> E8{wsp<bf16>(F, WS_H)};
            pg8::gemm_phase<EpiMG<F8NB>, pg8::SchedStatic, F8NB, (F8NB == 2), true>(F.lds, 2048, S8, E8);
        } }
        SEAM(p0);
        if (PHM(2) && IN(p0 + 1)) for (int rep = 0; rep < REPS(2); ++rep) { if (NAIVE_MASK & 2) naive_gla(F, l, (const float*)args.in[6], (const float*)args.in[7]); else for (int u = F.wg; u < 512; u += F.G) gla_a_unit(F, l, u, (const float*)args.in[6], (const float*)args.in[7]); }
        SEAM(p0 + 1);
        if (PHM(3) && IN(p0 + 2)) for (int rep = 0; rep < REPS(3); ++rep) { if (!(NAIVE_MASK & 2)) gla_scan(F); }
        SEAM(p0 + 2);
        if (PHM(4) && IN(p0 + 3)) for (int rep = 0; rep < REPS(4); ++rep) {
            if (NAIVE_MASK & 2) naive_gla_norm(F, l, (const float*)args.in[8]); else
            for (int r2 = 0; r2 < REPS(8); ++r2) for (int u = F.wg; u < 512; u += F.G) gla_c_unit(F, l, u, (const float*)args.in[8]);
            if (NAIVE_MASK & 1) naive_pool(F, l, (const float*)args.in[4], (const float*)args.in[5]); else
            for (int r2 = 0; r2 < REPS(9); ++r2) for (int u = F.wg; u < 512; u += F.G) pool_unit(F, l, u, (const float*)args.in[5]);
            __syncthreads();
            if (NAIVE_MASK & 4) naive_swa(F, l, (const float*)args.in[9]); else
            for (int r2 = 0; r2 < REPS(10); ++r2) for (int u = F.wg; u < 1024; u += F.G) swa_unit(F, l, u, (const float*)args.in[9]);
            __syncthreads();
            if (NAIVE_MASK & 8) naive_mem(F, l); else
            for (int r2 = 0; r2 < REPS(11); ++r2) for (int u = F.wg; u < 256; u += F.G) mem_unit(F, l, u);
            __syncthreads();
        }
        SEAM(p0 + 3);
        if (PHM(5) && IN(p0 + 4)) { {
            pg8::SchedStatic S; S.nM = 32; S.nN = 32; S.G = F.G; S.c = F.wg; S.A = (const char*)(F.ws + WS_OB); S.B = (const char*)(F.ws + WS_WBRT) + (size_t)l * 4096 * 4096 * 2;
            S.astep = (size_t)256 * 4096 * 2; S.bstep = (size_t)128 * 4096 * 2;
            EpiGate E{wsp<bf16>(F, WS_H), wsp<bf16>(F, WS_YB)};
            pg8::gemm_phase<EpiGate, pg8::SchedStatic, 1, false>(F.lds, 4096, S, E);
        }
        if (REPS(5) == 2) {
            pg8::SchedStatic S; S.nM = 32; S.nN = 32; S.G = F.G; S.c = F.wg; S.A = (const char*)(F.ws + WS_OB); S.B = (const char*)(F.ws + WS_WBRT) + (size_t)l * 4096 * 4096 * 2;
            S.astep = (size_t)256 * 4096 * 2; S.bstep = (size_t)128 * 4096 * 2;
            EpiGate E{wsp<bf16>(F, WS_H), wsp<bf16>(F, WS_YB)};
            pg8::gemm_phase<EpiGate, pg8::SchedStatic, 1, false>(F.lds, 4096, S, E);
        } }
        SEAM(p0 + 4);
        if (PHM(6) && IN(p0 + 5)) { {
            pg8::SchedStatic S; S.nM = 32; S.nN = 16; S.G = F.G; S.c = F.wg; S.A = (const char*)(F.ws + WS_YB); S.B = (const char*)(F.ws + WS_WOUTT) + (size_t)l * 4096 * 4096 * 2;
            S.astep = (size_t)256 * 4096 * 2; S.bstep = (size_t)256 * 4096 * 2;
            EpiRes E{l == 0 ? (const float*)args.in[0] : (const float*)F.out, wsp<float>(F, WS_Z)};
            pg8::gemm_phase<EpiRes, pg8::SchedStatic, 2, true>(F.lds, 4096, S, E);
        }
        if (REPS(6) == 2) {
            pg8::SchedStatic S; S.nM = 32; S.nN = 16; S.G = F.G; S.c = F.wg; S.A = (const char*)(F.ws + WS_YB); S.B = (const char*)(F.ws + WS_WOUTT) + (size_t)l * 4096 * 4096 * 2;
            S.astep = (size_t)256 * 4096 * 2; S.bstep = (size_t)256 * 4096 * 2;
            EpiRes E{l == 0 ? (const float*)args.in[0] : (const float*)F.out, wsp<float>(F, WS_Z)};
            pg8::gemm_phase<EpiRes, pg8::SchedStatic, 2, true>(F.lds, 4096, S, E);
        } }
        SEAM(p0 + 5);
        if (PHM(7) && IN(p0 + 6)) for (int rep = 0; rep < REPS(7); ++rep) { ln_phase(F, l, (const float*)args.in[13], (const float*)args.in[14]); }
        SEAM(p0 + 6);
}


__global__ void __launch_bounds__(NTHR, 2) mk_fwd(Args args) {
    extern __shared__ __attribute__((aligned(16))) unsigned char lds_raw[];
    Frame F;
    F.lds = (LAS unsigned char*)lds_raw;
    F.tid = threadIdx.x; F.lane = F.tid & 63; F.wave = __builtin_amdgcn_readfirstlane(F.tid >> 6); F.G = gridDim.x; F.wg = blockIdx.x;
    F.out = args.out; F.ws = args.ws;
    volatile LAS unsigned* MISC = (volatile LAS unsigned*)(F.lds + MISC_OFF);
    for (int u = F.tid; u < (LDS_BYTES - LDSCTL_OFF) / 4; u += NTHR) ((LAS unsigned*)(F.lds + LDSCTL_OFF))[u] = 0u;
    __syncthreads();
    unsigned* barw = (unsigned*)(F.ws + WS_CTL) + CW_BAR;
    XcdBarrier bar; bar.bar = barw; bar.x = 0; bar.st = nullptr;
    const int lo = args.ph_lo, hi = args.ph_hi;
    if (hi - lo > 1) bar = xcd_barrier_post(barw, MISC + 8);

    if (PHM(0) && IN(0)) for (int rep = 0; rep < REPS(0); ++rep) { prologue(F, (const float*)args.in[0], (const float*)args.in[1], (const int*)args.in[2], (const float*)args.in[3], (const float*)args.in[4], (const float*)args.in[10], (const float*)args.in[11], (const float*)args.in[12]); }
    SEAM(0);
    layer_body<0>(F, args, lo, hi, bar);
    layer_body<1>(F, args, lo, hi, bar);
#undef IN
#undef SEAM
}

extern "C" void kernel_launch(void* const* d_in, const int* in_sizes, int n_in, void* d_out, int out_size, void* d_ws, size_t ws_size, hipStream_t stream) {
    static int grid = 0;
    if (grid == 0) {
        if (n_in != 15 || out_size != MTOK * DM || ws_size < WS_END) { fprintf(stderr, "kernel_launch: unexpected sizes (n_in %d, out %d, ws %zu); nothing launched\n", n_in, out_size, ws_size); grid = -1; return; }
        int dev = 0, cus = 0, per_cu = 0;
        if (hipGetDevice(&dev) != hipSuccess || hipDeviceGetAttribute(&cus, hipDeviceAttributeMultiprocessorCount, dev) != hipSuccess) { grid = -1; return; }
        if (hipFuncSetAttribute((const void*)mk_fwd, hipFuncAttributeMaxDynamicSharedMemorySize, LDS_BYTES) != hipSuccess) { fprintf(stderr, "kernel_launch: hipFuncSetAttribute failed\n"); grid = -1; return; }
        if (hipOccupancyMaxActiveBlocksPerMultiprocessor(&per_cu, (const void*)mk_fwd, NTHR, LDS_BYTES) != hipSuccess || per_cu < 1) fprintf(stderr, "kernel_launch: occupancy query says %d\n", per_cu);
        (void)hipGetLastError();
        grid = cus;
    }
    if (grid < 0) return;
    (void)hipMemsetAsync((char*)d_ws + WS_CTL, 0, CTL_ZERO_BYTES, stream);
    Args a{};
    for (int i = 0; i < 15; ++i) a.in[i] = d_in[i];
    a.out = (float*)d_out; a.ws = (unsigned char*)d_ws;
#if MK_PER_PHASE
    for (int p = 0; p < N_PHASES; ++p) { a.ph_lo = p; a.ph_hi = p + 1; hipLaunchKernelGGL(mk_fwd, dim3(grid), dim3(NTHR), LDS_BYTES, stream, a); }
#else
    a.ph_lo = 0; a.ph_hi = N_PHASES;
    hipLaunchKernelGGL(mk_fwd, dim3(grid), dim3(NTHR), LDS_BYTES, stream, a);
#endif
}
```

```cpp
#include <hip/hip_runtime.h>
#include <cstdio>
#include <cstdint>

#ifndef F8ASM1
#define F8ASM1 0
#endif
#ifndef F8NB
#define F8NB 1
#endif
#ifndef MK_PER_PHASE
#define MK_PER_PHASE 0
#endif

#define DI __device__ __forceinline__
#define LAS __attribute__((address_space(3)))
#define GAS __attribute__((address_space(1)))
typedef unsigned short bf16;
typedef short bf16x8 __attribute__((ext_vector_type(8)));
typedef short s16x4 __attribute__((ext_vector_type(4)));
typedef short v4i16_t __attribute__((ext_vector_type(4)));
typedef float f32x4 __attribute__((ext_vector_type(4)));
typedef float f32x2 __attribute__((ext_vector_type(2)));
typedef unsigned u32x4 __attribute__((ext_vector_type(4)));
typedef unsigned u32x2 __attribute__((ext_vector_type(2)));

constexpr int BATCH = 2, SEQ = 4096, DM = 4096, MTOK = BATCH * SEQ, DEPTH = 2;
constexpr int D_IN = 25872, NH = 26112;
constexpr int BW = 1024;
constexpr int MEMLEN = 256;
constexpr int C_PU = 0, C_PG = 1024, C_GQ = 2048, C_GK = 2560, C_GV = 3072, C_GG = 4096, C_SQ = 5120, C_SK = 6144, C_SV = 6272, C_SG = 6400, C_XQ = 7424, C_XG = 8448, C_MG = 9472, C_LR = 25856;
constexpr float LN_EPS = 1e-5f;
constexpr float DN_ALPHA = 1.41421356237309515f;

constexpr size_t MiB = 1u << 20;
constexpr size_t WS_CTL = 0, CTL_ZERO_BYTES = 1 * MiB;
constexpr size_t WS_ROPE = 1 * MiB;
constexpr size_t WS_WPOOLT = 2 * MiB;
constexpr size_t WS_MEMB = 4 * MiB;
constexpr size_t WS_MK = 8 * MiB;
constexpr size_t WS_MVT = 10 * MiB;
constexpr size_t WS_DEC = 12 * MiB;
constexpr size_t WS_WMKVT = 16 * MiB;
constexpr size_t WS_WBRT = 48 * MiB;
constexpr size_t WS_WOUTT = 112 * MiB;
constexpr size_t WS_XB = 176 * MiB;
constexpr size_t WS_OB = 240 * MiB;
constexpr size_t WS_YB = 304 * MiB;
constexpr size_t WS_GU = 368 * MiB;
constexpr size_t WS_GS = 432 * MiB;
constexpr size_t WS_GB = 464 * MiB;
constexpr size_t WS_WINT = 512 * MiB;
constexpr size_t WS_H = 928 * MiB;
constexpr size_t WS_Z = 1336 * MiB;
constexpr size_t WS_X8 = 1464 * MiB;
constexpr size_t WS_W8 = 1496 * MiB;
constexpr size_t WS_END = 1624 * MiB;
constexpr float X8_SCALE = 16.0f, W8_SCALE = 2048.0f, MG_DESCALE = 1.0f / (16.0f * 2048.0f);
constexpr int CW_BAR = 4096;

constexpr int RING_BYTES = 131072;
constexpr int THIN_BYTES = 141312;
constexpr int LDSCTL_OFF = THIN_BYTES, MISC_OFF = LDSCTL_OFF + 320;
constexpr int LDS_BYTES = 147456;
constexpr int NWAVES = 8, NTHR = 512;

DI float bf2f(unsigned v) { return __builtin_bit_cast(float, v << 16); }
DI unsigned f2bf(float f) { unsigned u = __builtin_bit_cast(unsigned, f); return (u + 0x7fffu + ((u >> 16) & 1u)) >> 16; }
DI unsigned pk2(float lo, float hi) { return f2bf(lo) | (f2bf(hi) << 16); }
DI unsigned cvt_pk_bf16(float lo, float hi) { unsigned r; asm volatile("v_cvt_pk_bf16_f32 %0, %1, %2" : "=v"(r) : "v"(lo), "v"(hi)); return r; }
DI float fast_sigmoid(float v) { return __builtin_amdgcn_rcpf(1.0f + __builtin_amdgcn_exp2f(-1.44269504089f * v)); }
DI void unpack8(const u32x4 w, float (&f)[8]) {
    f[0] = bf2f(w.x & 0xffffu); f[1] = bf2f(w.x >> 16); f[2] = bf2f(w.y & 0xffffu); f[3] = bf2f(w.y >> 16);
    f[4] = bf2f(w.z & 0xffffu); f[5] = bf2f(w.z >> 16); f[6] = bf2f(w.w & 0xffffu); f[7] = bf2f(w.w >> 16);
}
DI u32x4 pack8(const float (&f)[8]) { u32x4 w; w.x = pk2(f[0], f[1]); w.y = pk2(f[2], f[3]); w.z = pk2(f[4], f[5]); w.w = pk2(f[6], f[7]); return w; }
DI float clamp448(float v) { return fminf(fmaxf(v, -448.0f), 448.0f); }
DI unsigned pk4_fp8(float a, float b, float c, float d) {
    int w = 0; w = __builtin_amdgcn_cvt_pk_fp8_f32(clamp448(a), clamp448(b), w, false); w = __builtin_amdgcn_cvt_pk_fp8_f32(clamp448(c), clamp448(d), w, true); return (unsigned)w; }
typedef int v8i32 __attribute__((ext_vector_type(8)));
DI f32x4 mma16(bf16x8 a, bf16x8 b, f32x4 c) { return __builtin_amdgcn_mfma_f32_16x16x32_bf16(a, b, c, 0, 0, 0); }
DI bf16x8 frag_lds(const LAS bf16* img, int ld, int idx0, int k0, int lane) { return *(const LAS bf16x8*)(img + (idx0 + (lane & 15)) * ld + k0 + 8 * (lane >> 4)); }
DI bf16x8 frag_glb(const bf16* img, size_t ld, int idx0, int k0, int lane) { return *(const bf16x8*)(img + (size_t)(idx0 + (lane & 15)) * ld + k0 + 8 * (lane >> 4)); }
DI s16x4 tr4(const LAS bf16* p) { return __builtin_bit_cast(s16x4, __builtin_amdgcn_ds_read_tr16_b64_v4i16((LAS v4i16_t*)p)); }
DI bf16x8 frag_tr(const LAS bf16* img, int ld, int k0, int idx0, int lane) {
    const int g = lane >> 4, q = (lane >> 2) & 3, p = lane & 3;
    const LAS bf16* a0 = img + (k0 + 8 * g + q) * ld + idx0 + 4 * p;
    const s16x4 lo = tr4(a0), hi = tr4(a0 + 4 * ld);
    return __builtin_shufflevector(lo, hi, 0, 1, 2, 3, 4, 5, 6, 7);
}
DI float wave_sum(float v) {
#pragma unroll
    for (int o = 1; o < 64; o <<= 1) v += __shfl_xor(v, o);
    return v;
}
#define LDS_WAIT() asm volatile("s_waitcnt lgkmcnt(0)" ::: "memory")
#define VM_WAIT() asm volatile("s_waitcnt vmcnt(0)" ::: "memory")

namespace pg8 {
constexpr int BM = 256, BK = 64, HALF = 128, HTB = HALF * BK * 2, STAGE_BYTES = 8 * HTB, NXCD = 8, WGM = 8;
__host__ __device__ __forceinline__ int lds_byte(int r, int c) { const int st = (r >> 4) * 2 + (c >> 5), rr = r & 15, cc = c & 31, ob = rr * 64 + cc * 2; return st * 1024 + (ob ^ (((ob >> 9) & 1) << 5)); }
__host__ __device__ __forceinline__ void stage_rc(int b, int& R, int& C) { const int st = b / 1024, sb = b % 1024, swz = sb ^ (((sb >> 9) & 1) << 5); R = (st >> 1) * 16 + swz / 64; C = (st & 1) * 32 + (swz % 64) / 2; }
__host__ __device__ __forceinline__ int perm32(int rho) { const int n = rho >> 4, i = rho & 15; return 8 * (i >> 2) + 4 * n + (i & 3); }

struct Unit { int pm, pn, gi; };

DI void static_tile(int L, int nM, int nN, int& pm, int& pn) {
    const int nwg = nM * nN; int wgid = L;
    { const int q = nwg / NXCD, r = nwg % NXCD, xcd = wgid % NXCD, off = wgid / NXCD; wgid = (xcd < r ? xcd * (q + 1) : r * (q + 1) + (xcd - r) * q) + off; }
    const int nig = WGM * nN, gid = wgid / nig, fm = gid * WGM, gsz = (nM - fm) < WGM ? (nM - fm) : WGM;
    pm = fm + ((wgid % nig) % gsz); pn = (wgid % nig) / gsz;
}
struct SchedStatic {
    int nM, nN, G, c; const char* A; const char* B; size_t astep, bstep;
    DI bool next(int i, Unit& u) const { const long L = (long)i * G + c; if (L >= (long)nM * nN) return false; static_tile((int)L, nM, nN, u.pm, u.pn); u.gi = 0; return true; }
    DI const char* abase(const Unit& u) const { return A + (size_t)u.pm * astep; }
    DI const char* bbase(const Unit& u) const { return B + (size_t)u.pn * bstep; }
};

template <class Epi, class Sched, int NB, bool ALIGN_EPI, bool F8 = false>
DI void gemm_phase(LAS unsigned char* lds, const int K, const Sched& S, const Epi& E) {
    const int tid = threadIdx.x, wid = __builtin_amdgcn_readfirstlane(tid >> 6), lane = tid & 63, wr = wid >> 2, wc = wid & 3, fr = lane & 15, fq = lane >> 4;
    const int nt = K / BK;
    unsigned voffA[2], voffB[2];
#pragma unroll
    for (int i = 0; i < 2; ++i) { int R, C; stage_rc(tid * 16 + i * 8192, R, C); const int Rb = Epi::PERM ? ((R & ~31) + perm32(R & 31)) : R;
        voffA[i] = (unsigned)(R * K + C) * 2u; voffB[i] = (unsigned)(Rb * K + C) * 2u; }
    const size_t kstep = (size_t)(BK * 2);
    const size_t hstep = (size_t)HALF * K * 2;
    const unsigned ldsw = (unsigned)wid * 1024u;
    const int aoff = lds_byte(wr * 64 + fr, F8 ? fq * 16 : fq * 8), boff = lds_byte(wc * 32 + fr, F8 ? fq * 16 : fq * 8);
    constexpr int KOFF = F8 ? 16 : 1024;
    const unsigned one_scale = 0x7f7f7f7fu;
#define PG8_SA(b, h) (((b) * 2 + (h)) * HTB)
#define PG8_SB(b, h) ((4 + (b) * 2 + (h)) * HTB)
#define PG8_STAGE(bufoff, gbase, voff) do { _Pragma("unroll") for (int _i = 0; _i < 2; ++_i) \
        __builtin_amdgcn_global_load_lds((const unsigned*)((const char*)(gbase) + (voff)[_i]), (LAS unsigned*)(lds + (bufoff) + ldsw + _i * 8192), 16, 0, 0); } while (0)
#define PG8_LDA(dst, b, h) do { _Pragma("unroll") for (int m = 0; m < 4; ++m) _Pragma("unroll") for (int k = 0; k < 2; ++k) dst[m][k] = *(const LAS bf16x8*)(lds + PG8_SA(b, h) + aoff + m * 2048 + k * KOFF); } while (0)
#define PG8_LDB(dst, b, h) do { _Pragma("unroll") for (int n = 0; n < 2; ++n) _Pragma("unroll") for (int k = 0; k < 2; ++k) dst[n][k] = *(const LAS bf16x8*)(lds + PG8_SB(b, h) + boff + n * 2048 + k * KOFF); } while (0)
#define PG8_CAT(x) __builtin_bit_cast(v8i32, __builtin_shufflevector((x)[0], (x)[1], 0, 1, 2, 3, 4, 5, 6, 7, 8, 9, 10, 11, 12, 13, 14, 15))
#define PG8_MMA(ai, bj, At, Bt) do { __builtin_amdgcn_s_setprio(1); _Pragma("unroll") for (int m = 0; m < 4; ++m) _Pragma("unroll") for (int n = 0; n < 2; ++n) { \
        if constexpr (F8 && NB == 1 && !F8ASM1) acc[ai][bj][m][n] = __builtin_amdgcn_mfma_scale_f32_16x16x128_f8f6f4(PG8_CAT(Bt[n]), PG8_CAT(At[m]), acc[ai][bj][m][n], 0, 0, 0, 0x7f7f7f7f, 0, 0x7f7f7f7f); \
        else if constexpr (F8) { asm volatile("v_mfma_scale_f32_16x16x128_f8f6f4 %0, %1, %2, %0, %3, %3 op_sel_hi:[0,0,0]" : "+v"(acc[ai][bj][m][n]) : "v"(PG8_CAT(Bt[n])), "v"(PG8_CAT(At[m])), "v"(one_scale)); } \
        else { _Pragma("unroll") for (int k = 0; k < 2; ++k) acc[ai][bj][m][n] = __builtin_amdgcn_mfma_f32_16x16x32_bf16(Bt[n][k], At[m][k], acc[ai][bj][m][n], 0, 0, 0); } } \
        __builtin_amdgcn_s_setprio(0); } while (0)
#define PG8_WAIT_V(n) asm volatile("s_waitcnt vmcnt(" #n ")" ::: "memory")
#define PG8_WAIT_L(n) asm volatile("s_waitcnt lgkmcnt(" #n ")" ::: "memory")
#define PG8_BAR __builtin_amdgcn_s_barrier()
#define PG8_SCHED __builtin_amdgcn_sched_barrier(0)
#define PG8_WAIT_MAIN() do { if constexpr (NB == 2) PG8_WAIT_V(8); else PG8_WAIT_V(6); } while (0)
    Unit cur, nxt; int ui = 0;
    if (!S.next(0, cur)) return;
    f32x4 acc[2][NB][4][2];
    f32x4 yac[2][4][2];
#pragma unroll
    for (int a = 0; a < 2; ++a)
#pragma unroll
        for (int m = 0; m < 4; ++m)
#pragma unroll
            for (int n = 0; n < 2; ++n) { yac[a][m][n] = (f32x4){0.f, 0.f, 0.f, 0.f};
#pragma unroll
                for (int b = 0; b < NB; ++b) acc[a][b][m][n] = (f32x4){0.f, 0.f, 0.f, 0.f}; }
    bf16x8 At[4][2], B0[2][2], B1[2][2];
    const char* cA = S.abase(cur); const char* cB = S.bbase(cur);
    if constexpr (NB == 2) {
        PG8_STAGE(PG8_SB(0, 0), cB, voffB); PG8_STAGE(PG8_SB(0, 1), cB + hstep, voffB); PG8_STAGE(PG8_SA(0, 0), cA, voffA); PG8_STAGE(PG8_SA(0, 1), cA + hstep, voffA);
        if (wr == 1) PG8_BAR;
        PG8_WAIT_V(2); PG8_BAR;
        PG8_STAGE(PG8_SB(1, 0), cB + kstep, voffB); PG8_STAGE(PG8_SA(1, 0), cA + kstep, voffA); PG8_STAGE(PG8_SB(1, 1), cB + hstep + kstep, voffB);
        PG8_WAIT_V(6); PG8_BAR;
    } else {
        PG8_STAGE(PG8_SB(0, 0), cB, voffB); PG8_STAGE(PG8_SA(0, 0), cA, voffA); PG8_STAGE(PG8_SA(0, 1), cA + hstep, voffA);
        if (wr == 1) PG8_BAR;
        PG8_WAIT_V(2); PG8_BAR;
        PG8_STAGE(PG8_SB(1, 0), cB + kstep, voffB); PG8_STAGE(PG8_SA(1, 0), cA + kstep, voffA);
        PG8_WAIT_V(4); PG8_BAR;
    }
    for (;;) {
        const bool has_next = S.next(ui + 1, nxt);
        const char* nA = has_next ? S.abase(nxt) : cA; const char* nB = has_next ? S.bbase(nxt) : cB;
        for (int t = 0; t < nt; t += 2) {
            if constexpr (Epi::GATED) { if (t != 0 && (t & 15) == 0) { E.flush(acc, yac, cur, (t >> 4) - 1, wr, wc, fr, fq);
#pragma unroll
                for (int a = 0; a < 2; ++a)
#pragma unroll
                    for (int m = 0; m < 4; ++m)
#pragma unroll
                        for (int n = 0; n < 2; ++n) acc[a][0][m][n] = (f32x4){0.f, 0.f, 0.f, 0.f}; } }
            const bool last = (t == nt - 2);
            const char* a1 = cA + (size_t)(t + 1) * kstep;
            const char* a2 = last ? nA : cA + (size_t)(t + 2) * kstep; const char* b2 = last ? nB : cB + (size_t)(t + 2) * kstep;
            const char* a3 = a2 + kstep; const char* b3 = b2 + kstep;
            if constexpr (NB == 2) {
            PG8_LDB(B0, 0, 0); PG8_LDB(B1, 0, 1); PG8_SCHED; PG8_LDA(At, 0, 0); PG8_STAGE(PG8_SA(1, 1), a1 + hstep, voffA);
            PG8_WAIT_V(8); PG8_WAIT_L(0); PG8_BAR; PG8_MMA(0, 0, At, B0); PG8_MMA(0, 1, At, B1); PG8_BAR; PG8_SCHED;
            PG8_LDA(At, 0, 1); PG8_STAGE(PG8_SB(0, 0), b2, voffB); PG8_STAGE(PG8_SB(0, 1), b2 + hstep, voffB); PG8_STAGE(PG8_SA(0, 0), a2, voffA);
            PG8_WAIT_V(8); PG8_WAIT_L(0); PG8_BAR; PG8_MMA(1, 0, At, B0); PG8_MMA(1, 1, At, B1); PG8_BAR; PG8_SCHED;
            PG8_LDB(B0, 1, 0); PG8_LDB(B1, 1, 1); PG8_SCHED; PG8_LDA(At, 1, 0); PG8_STAGE(PG8_SA(0, 1), a2 + hstep, voffA);
            PG8_WAIT_V(8); PG8_WAIT_L(0); PG8_BAR; PG8_MMA(0, 0, At, B0); PG8_MMA(0, 1, At, B1); PG8_BAR; PG8_SCHED;
            PG8_LDA(At, 1, 1); PG8_STAGE(PG8_SB(1, 0), b3, voffB); PG8_STAGE(PG8_SB(1, 1), b3 + hstep, voffB); PG8_STAGE(PG8_SA(1, 0), a3, voffA);
            PG8_WAIT_V(8); PG8_WAIT_L(0); PG8_BAR; PG8_MMA(1, 0, At, B0); PG8_MMA(1, 1, At, B1); PG8_BAR; PG8_SCHED;
            } else {
            PG8_LDB(B0, 0, 0); PG8_SCHED; PG8_LDA(At, 0, 0); PG8_STAGE(PG8_SA(1, 1), a1 + hstep, voffA);
            PG8_WAIT_V(6); PG8_WAIT_L(0); PG8_BAR; PG8_MMA(0, 0, At, B0); PG8_BAR; PG8_SCHED;
            PG8_LDA(At, 0, 1); PG8_STAGE(PG8_SB(0, 0), b2, voffB); PG8_STAGE(PG8_SA(0, 0), a2, voffA);
            PG8_WAIT_V(6); PG8_WAIT_L(0); PG8_BAR; PG8_MMA(1, 0, At, B0); PG8_BAR; PG8_SCHED;
            PG8_LDB(B0, 1, 0); PG8_SCHED; PG8_LDA(At, 1, 0); PG8_STAGE(PG8_SA(0, 1), a2 + hstep, voffA);
            PG8_WAIT_V(6); PG8_WAIT_L(0); PG8_BAR; PG8_MMA(0, 0, At, B0); PG8_BAR; PG8_SCHED;
            PG8_LDA(At, 1, 1); PG8_STAGE(PG8_SB(1, 0), b3, voffB); PG8_STAGE(PG8_SA(1, 0), a3, voffA);
            PG8_WAIT_V(6); PG8_WAIT_L(0); PG8_BAR; PG8_MMA(1, 0, At, B0); PG8_BAR; PG8_SCHED;
            }
        }
        if constexpr (F8) {
            asm volatile("s_nop 15\n\ts_nop 15" ::: "memory");
#pragma unroll
            for (int a = 0; a < 2; ++a)
#pragma unroll
                for (int b = 0; b < NB; ++b)
#pragma unroll
                    for (int m = 0; m < 4; ++m)
#pragma unroll
                        for (int n = 0; n < 2; ++n) asm volatile("" : "+v"(acc[a][b][m][n]));
        }
        if constexpr (ALIGN_EPI) { if (wr == 0) PG8_BAR; }
        if constexpr (Epi::GATED) { E.finish(acc, yac, cur, wr, wc, fr, fq);
#pragma unroll
            for (int a = 0; a < 2; ++a)
#pragma unroll
                for (int m = 0; m < 4; ++m)
#pragma unroll
                    for (int n = 0; n < 2; ++n) yac[a][m][n] = (f32x4){0.f, 0.f, 0.f, 0.f};
        } else { E(acc, cur, wr, wc, fr, fq); }
        if (!has_next) break;
#pragma unroll
        for (int a = 0; a < 2; ++a)
#pragma unroll
            for (int b = 0; b < NB; ++b)
#pragma unroll
                for (int m = 0; m < 4; ++m)
#pragma unroll
                    for (int n = 0; n < 2; ++n) acc[a][b][m][n] = (f32x4){0.f, 0.f, 0.f, 0.f};
        cur = nxt; cA = nA; cB = nB; ++ui;
        if constexpr (ALIGN_EPI) { if (wr == 1) PG8_BAR; }
    }
    PG8_WAIT_V(0);
    if constexpr (!ALIGN_EPI) { if (wr == 0) PG8_BAR; }
    PG8_BAR;
#undef PG8_SA
#undef PG8_SB
#undef PG8_STAGE
#undef PG8_LDA
#undef PG8_LDB
#undef PG8_MMA
#undef PG8_CAT
#undef PG8_WAIT_V
#undef PG8_WAIT_L
#undef PG8_BAR
#undef PG8_SCHED
#undef PG8_WAIT_MAIN
}
}

#define XB_TMO      128
#define XB_XCNT(j)  (256  + 64 * (j))
#define XB_XSUB(j)  (1280 + 64 * (j))
#define XB_XGEN(j)  (2304 + 64 * (j))
#define XB_TOP      3328
#define XB_TOPGEN   3392
#define XCD_BAR_WORDS 3456
#define XB_SPIN_CAP (1u << 18)
DI unsigned xb_ld(unsigned* p)              { return __hip_atomic_load(p, __ATOMIC_RELAXED, __HIP_MEMORY_SCOPE_AGENT); }
DI unsigned xb_add(unsigned* p, unsigned v) { return __hip_atomic_fetch_add(p, v, __ATOMIC_RELAXED, __HIP_MEMORY_SCOPE_AGENT); }
DI unsigned xb_xcc_id() { return (unsigned)__builtin_amdgcn_s_getreg((3 << 11) | 20) & 0xFu; }
#define XB_SPIN(cond, bar) do { unsigned _sp = 0; while (cond) { __builtin_amdgcn_s_sleep(1); \
    if ((++_sp & 255u) == 0u) { if (xb_ld(&(bar)[XB_TMO])) break; if (_sp > XB_SPIN_CAP) { atomicAdd(&(bar)[XB_TMO], 1u); break; } } } } while (0)
struct XcdBarrier { unsigned* bar; unsigned x; volatile LAS unsigned* st; };
DI XcdBarrier xcd_barrier_post(unsigned* bar, volatile LAS unsigned* st) {
    XcdBarrier b; b.bar = bar; b.x = xb_xcc_id(); b.st = st;
    if (threadIdx.x == 0) (void)xb_add(&bar[XB_XCNT(b.x)], 1u);
    return b;
}
DI void xcd_barrier_complete(unsigned* bar, unsigned x, unsigned& nloc, unsigned& nx) {
    const unsigned G = gridDim.x * gridDim.y * gridDim.z;
    unsigned sum, cnt, mine, sp = 0u;
    for (;;) {
        sum = 0u; cnt = 0u; mine = 0u;
#pragma unroll
        for (unsigned j = 0; j < 16; ++j) { const unsigned c = xb_ld(&bar[XB_XCNT(j)]); sum += c; cnt += (c > 0u) ? 1u : 0u; mine = (j == x) ? c : mine; }
        if (sum == G) break;
        __builtin_amdgcn_s_sleep(1);
        if ((++sp & 255u) == 0u) { if (xb_ld(&bar[XB_TMO])) break; if (sp > XB_SPIN_CAP) { atomicAdd(&bar[XB_TMO], 1u); break; } }
    }
    nloc = mine > 0u ? mine : 1u; nx = cnt > 0u ? cnt : 1u;
}
DI void xcd_barrier(const XcdBarrier& b) {
    asm volatile("s_waitcnt vmcnt(0)" ::: "memory");
    __syncthreads();
    if (threadIdx.x == 0) {
        unsigned* bar = b.bar;
        __builtin_amdgcn_s_waitcnt(0);
        unsigned nloc = b.st[0], nx = b.st[1];
        if (nloc == 0u) { xcd_barrier_complete(bar, b.x, nloc, nx); b.st[0] = nloc; b.st[1] = nx; }
        const unsigned old = xb_add(&bar[XB_XSUB(b.x)], 1u);
        const unsigned gen = old / nloc;
        if (old + 1u == (gen + 1u) * nloc) {
            __builtin_amdgcn_fence(__ATOMIC_RELEASE, "agent");
            asm volatile("s_waitcnt vmcnt(0)" ::: "memory");
            const unsigned og = xb_add(&bar[XB_TOP], 1u);
            const unsigned tg = og / nx;
            if (og + 1u == (tg + 1u) * nx) xb_add(&bar[XB_TOPGEN], 1u);
            else XB_SPIN(xb_ld(&bar[XB_TOPGEN]) == tg, bar);
            __builtin_amdgcn_fence(__ATOMIC_ACQUIRE, "agent");
            xb_add(&bar[XB_XGEN(b.x)], 1u);
            asm volatile("s_waitcnt vmcnt(0)" ::: "memory");
        } else {
            XB_SPIN(xb_ld(&bar[XB_XGEN(b.x)]) == gen, bar);
            __builtin_amdgcn_fence(__ATOMIC_ACQUIRE, "agent");
            asm volatile("s_waitcnt vmcnt(0)" ::: "memory");
        }
    }
    __syncthreads();
}

struct Frame {
    LAS unsigned char* lds;
    int tid, lane, wave, G, wg;
    float* out; unsigned char* ws;
};
template <class T> DI T* wsp(const Frame& F, size_t off) { return (T*)(F.ws + off); }

struct EpiH {
    static constexpr bool PERM = true, GATED = false;
    bf16* H; bf16* MK; bf16* MVT;
    DI void operator()(const f32x4 (&acc)[2][2][4][2], const pg8::Unit& u, int wr, int wc, int fr, int fq) const {
        bf16* base = H; size_t ldc = NH; int act = 0;
        if (u.gi == 0) { const int pn = u.pn; act = ((pn >= 4 && pn < 8) || (pn >= 16 && pn < 20) || (pn >= 25 && pn < 29) || (pn >= 33 && pn < 37)) ? 1 : 0; }
        else { const int lx = (u.gi - 1) >> 1, w = (u.gi - 1) & 1; if (w == 0) { base = MK + (size_t)lx * 512 * 1024; ldc = 1024; } else { base = MVT + (size_t)lx * 1024 * 512; ldc = 512; } }
        const int row0 = u.pm * 256 + wr * 64 + fr, col0 = u.pn * 256 + wc * 32 + 8 * fq;
#pragma unroll
        for (int ai = 0; ai < 2; ++ai)
#pragma unroll
            for (int m = 0; m < 4; ++m) { bf16* rowp = base + (size_t)(row0 + ai * 128 + m * 16) * ldc + col0;
#pragma unroll
                for (int bj = 0; bj < 2; ++bj) { f32x4 v0 = acc[ai][bj][m][0], v1 = acc[ai][bj][m][1];
                    if (act != 0) {
#pragma unroll
                        for (int j = 0; j < 4; ++j) { const float s0 = fast_sigmoid(v0[j]), s1 = fast_sigmoid(v1[j]); v0[j] = (act == 1) ? v0[j] * s0 : s0; v1[j] = (act == 1) ? v1[j] * s1 : s1; } }
                    u32x4 w; w.x = cvt_pk_bf16(v0[0], v0[1]); w.y = cvt_pk_bf16(v0[2], v0[3]); w.z = cvt_pk_bf16(v1[0], v1[1]); w.w = cvt_pk_bf16(v1[2], v1[3]);
                    *(u32x4*)(rowp + bj * 128) = w; } }
    }
};
template <int NB> struct EpiMG {
    static constexpr bool PERM = true, GATED = false;
    bf16* H;
    DI void operator()(const f32x4 (&acc)[2][NB][4][2], const pg8::Unit& u, int wr, int wc, int fr, int fq) const {
        const int row0 = u.pm * 256 + wr * 64 + fr, col0 = C_MG + u.pn * (128 * NB) + wc * 32 + 8 * fq;
#pragma unroll
        for (int ai = 0; ai < 2; ++ai)
#pragma unroll
            for (int m = 0; m < 4; ++m) { bf16* rowp = H + (size_t)(row0 + ai * 128 + m * 16) * NH + col0;
#pragma unroll
                for (int bj = 0; bj < NB; ++bj) { f32x4 v0 = acc[ai][bj][m][0], v1 = acc[ai][bj][m][1];
#pragma unroll
                    for (int j = 0; j < 4; ++j) { v0[j] = fast_sigmoid(v0[j] * MG_DESCALE); v1[j] = fast_sigmoid(v1[j] * MG_DESCALE); }
                    u32x4 w; w.x = cvt_pk_bf16(v0[0], v0[1]); w.y = cvt_pk_bf16(v0[2], v0[3]); w.z = cvt_pk_bf16(v1[0], v1[1]); w.w = cvt_pk_bf16(v1[2], v1[3]);
                    *(u32x4*)(rowp + bj * 128) = w; } }
    }
};
struct EpiRes {
    static constexpr bool PERM = false, GATED = false;
    const float* __restrict__ res; float* __restrict__ out;
    DI void operator()(const f32x4 (&acc)[2][2][4][2], const pg8::Unit& u, int wr, int wc, int fr, int fq) const {
        const int row0 = u.pm * 256 + wr * 64 + fr, col0 = u.pn * 256 + wc * 32 + 4 * fq;
#pragma unroll
        for (int ai = 0; ai < 2; ++ai)
#pragma unroll
            for (int m = 0; m < 4; ++m) { const size_t ro = (size_t)(row0 + ai * 128 + m * 16) * DM + col0;
#pragma unroll
                for (int bj = 0; bj < 2; ++bj)
#pragma unroll
                    for (int n = 0; n < 2; ++n) { const size_t o = ro + bj * 128 + n * 16; const f32x4 r = *(const f32x4*)(res + o); *(f32x4*)(out + o) = r * DN_ALPHA + acc[ai][bj][m][n]; } }
    }
};
struct EpiGate {
    static constexpr bool PERM = true, GATED = true;
    const bf16* H; bf16* Y;
    DI void flush(const f32x4 (&acc)[2][1][4][2], f32x4 (&y)[2][4][2], const pg8::Unit& u, int bi, int wr, int wc, int fr, int fq) const {
        const int row0 = u.pm * 256 + wr * 64 + fr, col0 = u.pn * 128 + wc * 32 + 8 * fq;
#pragma unroll
        for (int ai = 0; ai < 2; ++ai)
#pragma unroll
            for (int m = 0; m < 4; ++m) { const u32x4 gw = *(const u32x4*)(H + (size_t)(row0 + ai * 128 + m * 16) * NH + C_MG + bi * DM + col0);
                float g[8]; unpack8(gw, g);
#pragma unroll
                for (int j = 0; j < 4; ++j) { y[ai][m][0][j] += g[j] * acc[ai][0][m][0][j]; y[ai][m][1][j] += g[4 + j] * acc[ai][0][m][1][j]; }
                if (m == 1 || m == 3) __builtin_amdgcn_sched_barrier(0); }
    }
    DI void finish(const f32x4 (&acc)[2][1][4][2], f32x4 (&y)[2][4][2], const pg8::Unit& u, int wr, int wc, int fr, int fq) const {
        flush(acc, y, u, 3, wr, wc, fr, fq);
        const int row0 = u.pm * 256 + wr * 64 + fr, col0 = u.pn * 128 + wc * 32 + 8 * fq;
#pragma unroll
        for (int ai = 0; ai < 2; ++ai)
#pragma unroll
            for (int m = 0; m < 4; ++m) { const f32x4 v0 = y[ai][m][0], v1 = y[ai][m][1];
                u32x4 w; w.x = cvt_pk_bf16(v0[0], v0[1]); w.y = cvt_pk_bf16(v0[2], v0[3]); w.z = cvt_pk_bf16(v1[0], v1[1]); w.w = cvt_pk_bf16(v1[2], v1[3]);
                *(u32x4*)(Y + (size_t)(row0 + ai * 128 + m * 16) * DM + col0) = w; }
    }
};
struct SchedInProj {
    int G, c, n_extra; const char *XB, *WT, *MEMB, *WKV;
    static constexpr int NM = 32, NN = 38, NU = NM * NN;
    static constexpr size_t TSTEP = (size_t)256 * 4096 * 2;
    DI bool next(int i, pg8::Unit& u) const {
        const long L = (long)i * G + c;
        if (L < NU) { pg8::static_tile((int)L, NM, NN, u.pm, u.pn); if (u.pn == 37) u.pn = 101; u.gi = 0; return true; }
        const int e = (int)(L - NU); if (e >= n_extra) return false;
        const int lx = e >> 4, r = e & 15;
        if (r < 8) { u.pm = r >> 2; u.pn = r & 3; u.gi = 1 + 2 * lx; } else { u.pm = (r - 8) >> 1; u.pn = (r - 8) & 1; u.gi = 2 + 2 * lx; }
        return true;
    }
    DI const char* abase(const pg8::Unit& u) const {
        if (u.gi == 0) return XB + (size_t)u.pm * TSTEP;
        const int lx = (u.gi - 1) >> 1, w = (u.gi - 1) & 1;
        return w == 0 ? MEMB + (size_t)u.pm * TSTEP : WKV + (size_t)lx * 2048 * 4096 * 2 + (size_t)(1024 + u.pm * 256) * 4096 * 2;
    }
    DI const char* bbase(const pg8::Unit& u) const {
        if (u.gi == 0) return WT + (size_t)u.pn * TSTEP;
        const int lx = (u.gi - 1) >> 1, w = (u.gi - 1) & 1;
        return w == 0 ? WKV + (size_t)lx * 2048 * 4096 * 2 + (size_t)u.pn * TSTEP : MEMB + (size_t)u.pn * TSTEP;
    }
};

DI int win_src_col(int n) { return n < 5120 ? n : (n < C_LR ? n + 16 : (n < C_LR + 16 ? n - C_LR + 5120 : -1)); }
template <bool WIN> DI void transpose_item(const float* W, size_t ldw, bf16* WT, size_t ldt, int k0, int n0, int kd0, LAS float* scr, int lane) {
    const int kr = lane >> 3, nc = lane & 7; int sc = n0 + 4 * nc; if (WIN) sc = win_src_col(sc);
    const float* src = W + (size_t)(k0 + kr) * ldw + (sc < 0 ? 0 : sc);
    f32x4 v[8];
#pragma unroll
    for (int i = 0; i < 8; ++i) v[i] = *(const f32x4*)(src + (size_t)(8 * i) * ldw);
#pragma unroll
    for (int i = 0; i < 8; ++i) { LAS float* d = scr + (8 * i + kr) * 33 + 4 * nc; const f32x4 x = (sc < 0) ? (f32x4){0.f, 0.f, 0.f, 0.f} : v[i]; d[0] = x.x; d[1] = x.y; d[2] = x.z; d[3] = x.w; }
    LDS_WAIT();
    const int c = lane & 7;
#pragma unroll
    for (int j = 0; j < 4; ++j) { const int n = (lane >> 3) + 8 * j; const LAS float* s = scr + (8 * c) * 33 + n;
        u32x4 o; o.x = pk2(s[0 * 33], s[1 * 33]); o.y = pk2(s[2 * 33], s[3 * 33]); o.z = pk2(s[4 * 33], s[5 * 33]); o.w = pk2(s[6 * 33], s[7 * 33]);
        *(u32x4*)(WT + (size_t)(n0 + n) * ldt + kd0 + 8 * c) = o; }
    LDS_WAIT();
}
DI void transpose_item_f8(const float* W, size_t ldw, unsigned char* WT, size_t ldt, int k0, int n0, LAS float* scr, int lane) {
    const int kr = lane >> 3, nc = lane & 7; const int sc = win_src_col(n0 + 4 * nc);
    const float* src = W + (size_t)(k0 + kr) * ldw + sc;
#pragma unroll
    for (int h = 0; h < 2; ++h) {
        f32x4 v[8];
#pragma unroll
        for (int i = 0; i < 8; ++i) v[i] = *(const f32x4*)(src + (size_t)(64 * h + 8 * i) * ldw);
#pragma unroll
        for (int i = 0; i < 8; ++i) { LAS float* d = scr + (64 * h + 8 * i + kr) * 33 + 4 * nc; d[0] = v[i].x * W8_SCALE; d[1] = v[i].y * W8_SCALE; d[2] = v[i].z * W8_SCALE; d[3] = v[i].w * W8_SCALE; }
    }
    LDS_WAIT();
    const int c = lane & 7;
#pragma unroll
    for (int j = 0; j < 4; ++j) { const int n = (lane >> 3) + 8 * j; const LAS float* s = scr + (16 * c) * 33 + n;
        u32x4 o; o.x = pk4_fp8(s[0 * 33], s[1 * 33], s[2 * 33], s[3 * 33]); o.y = pk4_fp8(s[4 * 33], s[5 * 33], s[6 * 33], s[7 * 33]);
        o.z = pk4_fp8(s[8 * 33], s[9 * 33], s[10 * 33], s[11 * 33]); o.w = pk4_fp8(s[12 * 33], s[13 * 33], s[14 * 33], s[15 * 33]);
        *(u32x4*)(WT + (size_t)(n0 - C_MG + n) * ldt + k0 + 16 * c) = o; }
    LDS_WAIT();
}
DI void prologue(const Frame& F, const float* x, const float* mem, const int* pos, const float* w_in, const float* w_pool, const float* w_mem_kv, const float* w_branch, const float* w_out) {
    LAS float* scr = (LAS float*)(F.lds + F.wave * 17408);
    const int gw = F.wg * NWAVES + F.wave, NGW = F.G * NWAVES, lane = F.lane;
    constexpr int I_IN = 64 * (NH / 32), I_KV = 64 * 64, I_BR = 16 * 128, I_OUT = 64 * 128, I_PL = 4 * 8;
    constexpr int NITEMS = 2 * I_IN + 2 * I_KV + 8 * I_BR + 2 * I_OUT + 8 * I_PL;
    for (int it = gw; it < NITEMS; it += NGW) {
        int r = it;
        if (r < 2 * I_IN) { const int l = r / I_IN; r -= l * I_IN; const int nb = r >> 6, kb = r & 63;
            if (nb * 32 >= C_MG && nb * 32 < C_LR) { if ((kb & 1) == 0) transpose_item_f8(w_in + (size_t)l * 4096 * D_IN, D_IN, wsp<unsigned char>(F, WS_W8) + (size_t)l * 16384 * 4096, 4096, kb * 64, nb * 32, scr, lane); }
            else transpose_item<true>(w_in + (size_t)l * 4096 * D_IN, D_IN, wsp<bf16>(F, WS_WINT) + (size_t)l * NH * 4096, 4096, kb * 64, nb * 32, kb * 64, scr, lane);
            continue; }
        r -= 2 * I_IN;
        if (r < 2 * I_KV) { const int l = r / I_KV; r -= l * I_KV; const int nb = r >> 6, kb = r & 63;
            transpose_item<false>(w_mem_kv + (size_t)l * 4096 * 2048, 2048, wsp<bf16>(F, WS_WMKVT) + (size_t)l * 2048 * 4096, 4096, kb * 64, nb * 32, kb * 64, scr, lane); continue; }
        r -= 2 * I_KV;
        if (r < 8 * I_BR) { const int lb = r / I_BR; r -= lb * I_BR; const int l = lb >> 2, bi = lb & 3; const int nb = r >> 4, kb = r & 15;
            transpose_item<false>(w_branch + (size_t)lb * 1024 * 4096, 4096, wsp<bf16>(F, WS_WBRT) + (size_t)l * 4096 * 4096, 4096, kb * 64, nb * 32, bi * 1024 + kb * 64, scr, lane); continue; }
        r -= 8 * I_BR;
        if (r < 2 * I_OUT) { const int l = r / I_OUT; r -= l * I_OUT; const int nb = r >> 6, kb = r & 63;
            transpose_item<false>(w_out + (size_t)l * 4096 * 4096, 4096, wsp<bf16>(F, WS_WOUTT) + (size_t)l * 4096 * 4096, 4096, kb * 64, nb * 32, kb * 64, scr, lane); continue; }
        r -= 2 * I_OUT;
        { const int lg = r / I_PL; r -= lg * I_PL; const int nb = r >> 2, kb = r & 3;
            transpose_item<false>(w_pool + (size_t)lg * 256 * 256, 256, wsp<bf16>(F, WS_WPOOLT) + (size_t)lg * 256 * 256, 256, kb * 64, nb * 32, kb * 64, scr, lane); }
    }
    const size_t gt = (size_t)F.wg * NTHR + F.tid, GT = (size_t)F.G * NTHR;
    { const f32x4* xs = (const f32x4*)x; u32x4* xd = wsp<u32x4>(F, WS_XB);
      u32x2* x8 = wsp<u32x2>(F, WS_X8);
      for (size_t i = gt; i < (size_t)MTOK * DM / 8; i += GT) { const f32x4 a = xs[2 * i], b = xs[2 * i + 1]; u32x4 o; o.x = pk2(a.x, a.y); o.y = pk2(a.z, a.w); o.z = pk2(b.x, b.y); o.w = pk2(b.z, b.w); xd[i] = o;
          u32x2 q; q.x = pk4_fp8(a.x * X8_SCALE, a.y * X8_SCALE, a.z * X8_SCALE, a.w * X8_SCALE); q.y = pk4_fp8(b.x * X8_SCALE, b.y * X8_SCALE, b.z * X8_SCALE, b.w * X8_SCALE); x8[i] = q; }
      const f32x4* ms = (const f32x4*)mem; u32x4* md = wsp<u32x4>(F, WS_MEMB);
      for (size_t i = gt; i < (size_t)BATCH * MEMLEN * DM / 8; i += GT) { const f32x4 a = ms[2 * i], b = ms[2 * i + 1]; u32x4 o; o.x = pk2(a.x, a.y); o.y = pk2(a.z, a.w); o.z = pk2(b.x, b.y); o.w = pk2(b.z, b.w); md[i] = o; } }
    { f32x2* rt = wsp<f32x2>(F, WS_ROPE);
      for (size_t i = gt; i < (size_t)MTOK * 8; i += GT) { const int t = (int)(i >> 3), fi = (int)(i & 7);
          const float inv = (float)pow(500000.0, -(double)fi / 8.0); const float ang = (float)pos[t] * inv;
          rt[i] = (f32x2){cosf(ang), sinf(ang)}; } }
}

DI float fexp(float x) { return __builtin_amdgcn_exp2f(x * 1.44269504089f); }
DI float logsigmoid_f(float z) { return fminf(z, 0.f) - 0.69314718056f * __builtin_amdgcn_logf(1.0f + fexp(-fabsf(z))); }

DI void gla_a_unit(const Frame& F, int l, int unit, const float* w_gla_up, const float* b_gla) {
    const int bh = unit >> 6, c = unit & 63, b = bh >> 2, h = bh & 3, t0 = b * SEQ + c * 64, tid = F.tid, lane = F.lane, wave = F.wave;
    const bf16* H = wsp<bf16>(F, WS_H);
    LAS float* lrs = (LAS float*)(F.lds);
    LAS float* bcs = (LAS float*)(F.lds + 4096);
    LAS float* seg = (LAS float*)(F.lds + 36864);
    LAS bf16* kds = (LAS bf16*)(F.lds + 40960);
    LAS bf16* vs = (LAS bf16*)(F.lds + 59392);
    constexpr int LDK = 136, LDV = 264;
    __syncthreads();
    if (tid < 128) { const int j = tid >> 1, hf = tid & 1; const u32x4 w = *(const u32x4*)(H + (size_t)(t0 + j) * NH + C_LR + 8 * hf); float f[8]; unpack8(w, f);
#pragma unroll
        for (int i = 0; i < 8; ++i) lrs[j * 16 + 8 * hf + i] = f[i]; }
    for (int p = tid; p < 64 * 32; p += NTHR) { const int j = p >> 5, ch = p & 31; *(LAS u32x4*)(vs + j * LDV + 8 * ch) = *(const u32x4*)(H + (size_t)(t0 + j) * NH + C_GV + h * 256 + 8 * ch); }
    __syncthreads();
    const int d = tid & 127, sg = tid >> 7;
    { float w[16];
#pragma unroll
      for (int r = 0; r < 16; ++r) w[r] = w_gla_up[(size_t)l * 16 * 512 + r * 512 + h * 128 + d];
      const float bg = b_gla[l * 512 + h * 128 + d]; float run = 0.f;
      for (int jj = 0; jj < 16; ++jj) { const int j = sg * 16 + jj; float z = bg;
#pragma unroll
          for (int r = 0; r < 16; ++r) z += lrs[j * 16 + r] * w[r];
          run += logsigmoid_f(z) * (1.0f / 16.0f); bcs[j * 128 + d] = run; }
      seg[sg * 128 + d] = run; }
    __syncthreads();
    { float pre = 0.f;
      for (int s = 0; s < sg; ++s) pre += seg[s * 128 + d];
      float* GB = wsp<float>(F, WS_GB);
      for (int jj = 0; jj < 16; ++jj) { const int j = sg * 16 + jj; const float v = bcs[j * 128 + d] + pre; bcs[j * 128 + d] = v; GB[(size_t)(t0 + j) * 512 + h * 128 + d] = v; }
      if (sg == 3) wsp<float>(F, WS_DEC)[(size_t)unit * 128 + d] = expf(bcs[63 * 128 + d]); }
    __syncthreads();
    for (int p = tid; p < 64 * 16; p += NTHR) { const int j = p >> 4, ch = p & 15; const u32x4 w = *(const u32x4*)(H + (size_t)(t0 + j) * NH + C_GK + h * 128 + 8 * ch); float f[8]; unpack8(w, f);
#pragma unroll
        for (int i = 0; i < 8; ++i) f[i] *= fexp(bcs[63 * 128 + 8 * ch + i] - bcs[j * 128 + 8 * ch + i]);
        *(LAS u32x4*)(kds + j * LDK + 8 * ch) = pack8(f); }
    __syncthreads();
    f32x4 acc[2][8];
#pragma unroll
    for (int a = 0; a < 2; ++a)
#pragma unroll
        for (int n = 0; n < 8; ++n) acc[a][n] = (f32x4){0.f, 0.f, 0.f, 0.f};
#pragma unroll
    for (int ks = 0; ks < 2; ++ks) {
        bf16x8 af[2];
#pragma unroll
        for (int a = 0; a < 2; ++a) af[a] = frag_tr(vs, LDV, 32 * ks, 32 * wave + 16 * a, lane);
#pragma unroll
        for (int n = 0; n < 8; ++n) { const bf16x8 bfr = frag_tr(kds, LDK, 32 * ks, 16 * n, lane);
#pragma unroll
            for (int a = 0; a < 2; ++a) acc[a][n] = mma16(bfr, af[a], acc[a][n]); }
    }
    float* U = wsp<float>(F, WS_GU) + (size_t)unit * 256 * 128;
#pragma unroll
    for (int a = 0; a < 2; ++a)
#pragma unroll
        for (int n = 0; n < 8; ++n) *(f32x4*)(U + (size_t)(32 * wave + 16 * a + (lane & 15)) * 128 + 16 * n + 4 * (lane >> 4)) = acc[a][n];
}

DI void gla_scan(const Frame& F) {
    const float* U = wsp<float>(F, WS_GU); const float* DEC = wsp<float>(F, WS_DEC); unsigned* S = wsp<unsigned>(F, WS_GS);
    const int gt = F.wg * NTHR + F.tid, GT = F.G * NTHR;
    for (int it = gt; it < 8 * 256 * 64; it += GT) {
        const int bh = it >> 14, r = it & 16383, e = r >> 6, dp = r & 63;
        float s0 = 0.f, s1 = 0.f;
#pragma unroll 8
        for (int c = 0; c < 64; ++c) { const size_t un = (size_t)bh * 64 + c; const size_t o = (un * 256 + e) * 128 + 2 * dp;
            const f32x2 u = *(const f32x2*)(U + o); const f32x2 dc = *(const f32x2*)(DEC + un * 128 + 2 * dp);
            S[o >> 1] = pk2(s0, s1); s0 = dc.x * s0 + u.x; s1 = dc.y * s1 + u.y; }
    }
}

DI void gla_c_unit(const Frame& F, int l, int unit, const float* gla_norm) {
    const int bh = unit >> 6, c = unit & 63, b = bh >> 2, h = bh & 3, t0 = b * SEQ + c * 64, tid = F.tid, lane = F.lane, wave = F.wave;
    const bf16* H = wsp<bf16>(F, WS_H);
    LAS bf16* qs = (LAS bf16*)(F.lds);
    LAS bf16* ks = (LAS bf16*)(F.lds + 17408);
    LAS bf16* vs = (LAS bf16*)(F.lds + 34816);
    LAS bf16* ps = (LAS bf16*)(F.lds + 68608);
    LAS float* red = (LAS float*)(F.lds + 77824);
    constexpr int LDK = 136, LDV = 264, LDP = 72;
    __syncthreads();
    const float* GB = wsp<float>(F, WS_GB);
    for (int p = tid; p < 64 * 16; p += NTHR) { const int j = p >> 4, ch = p & 15;
        const u32x4 qw = *(const u32x4*)(H + (size_t)(t0 + j) * NH + C_GQ + h * 128 + 8 * ch); const u32x4 kw = *(const u32x4*)(H + (size_t)(t0 + j) * NH + C_GK + h * 128 + 8 * ch);
        const f32x4 b0 = *(const f32x4*)(GB + (size_t)(t0 + j) * 512 + h * 128 + 8 * ch), b1 = *(const f32x4*)(GB + (size_t)(t0 + j) * 512 + h * 128 + 8 * ch + 4);
        float q[8], k[8]; unpack8(qw, q); unpack8(kw, k); const float bb[8] = {b0.x, b0.y, b0.z, b0.w, b1.x, b1.y, b1.z, b1.w};
#pragma unroll
        for (int i = 0; i < 8; ++i) { const float eb = fexp(bb[i]); q[i] *= eb * 0.08838834764831845f; k[i] *= fexp(-bb[i]); }
        *(LAS u32x4*)(qs + j * LDK + 8 * ch) = pack8(q); *(LAS u32x4*)(ks + j * LDK + 8 * ch) = pack8(k); }
    for (int p = tid; p < 64 * 32; p += NTHR) { const int j = p >> 5, ch = p & 31; *(LAS u32x4*)(vs + j * LDV + 8 * ch) = *(const u32x4*)(H + (size_t)(t0 + j) * NH + C_GV + h * 256 + 8 * ch); }
    __syncthreads();
    { const int it = wave >> 1; f32x4 sa[2] = {(f32x4){0.f, 0.f, 0.f, 0.f}, (f32x4){0.f, 0.f, 0.f, 0.f}};
#pragma unroll
      for (int kk = 0; kk < 4; ++kk) { const bf16x8 qa = frag_lds(qs, LDK, 16 * it, 32 * kk, lane);
#pragma unroll
          for (int jj = 0; jj < 2; ++jj) sa[jj] = mma16(qa, frag_lds(ks, LDK, 16 * (2 * (wave & 1) + jj), 32 * kk, lane), sa[jj]); }
#pragma unroll
      for (int jj = 0; jj < 2; ++jj)
#pragma unroll
          for (int r = 0; r < 4; ++r) { const int i = 16 * it + 4 * (lane >> 4) + r, j = 16 * (2 * (wave & 1) + jj) + (lane & 15);
              ps[i * LDP + j] = (bf16)f2bf(j <= i ? sa[jj][r] : 0.f); } }
    __syncthreads();
    f32x4 acc[2][4];
#pragma unroll
    for (int a = 0; a < 2; ++a)
#pragma unroll
        for (int n = 0; n < 4; ++n) acc[a][n] = (f32x4){0.f, 0.f, 0.f, 0.f};
    const bf16* St = wsp<bf16>(F, WS_GS) + (size_t)unit * 256 * 128;
#pragma unroll
    for (int kk = 0; kk < 4; ++kk) { bf16x8 af[2];
#pragma unroll
        for (int a = 0; a < 2; ++a) af[a] = frag_glb(St, 128, 32 * wave + 16 * a, 32 * kk, lane);
#pragma unroll
        for (int n = 0; n < 4; ++n) { const bf16x8 bq = frag_lds(qs, LDK, 16 * n, 32 * kk, lane);
#pragma unroll
            for (int a = 0; a < 2; ++a) acc[a][n] = mma16(af[a], bq, acc[a][n]); } }
#pragma unroll
    for (int kk = 0; kk < 2; ++kk) { bf16x8 af[2];
#pragma unroll
        for (int a = 0; a < 2; ++a) af[a] = frag_tr(vs, LDV, 32 * kk, 32 * wave + 16 * a, lane);
#pragma unroll
        for (int n = 0; n < 4; ++n) { const bf16x8 bp = frag_lds(ps, LDP, 16 * n, 32 * kk, lane);
#pragma unroll
            for (int a = 0; a < 2; ++a) acc[a][n] = mma16(af[a], bp, acc[a][n]); } }
#pragma unroll
    for (int n = 0; n < 4; ++n) { float s = 0.f;
#pragma unroll
        for (int a = 0; a < 2; ++a)
#pragma unroll
            for (int r = 0; r < 4; ++r) s += acc[a][n][r] * acc[a][n][r];
        s += __shfl_xor(s, 16); s += __shfl_xor(s, 32);
        if (lane < 16) red[wave * 64 + 16 * n + lane] = s; }
    __syncthreads();
    bf16* OB = wsp<bf16>(F, WS_OB);
#pragma unroll
    for (int n = 0; n < 4; ++n) { const int i = 16 * n + (lane & 15); float tot = 0.f;
#pragma unroll
        for (int w = 0; w < 8; ++w) tot += red[w * 64 + i];
        const float rs = 1.0f / sqrtf(tot * (1.0f / 256.0f) + LN_EPS);
#pragma unroll
        for (int a = 0; a < 2; ++a) { const int e = 32 * wave + 16 * a + 4 * (lane >> 4);
            const f32x4 gn = *(const f32x4*)(gla_norm + l * 1024 + h * 256 + e);
            const u32x2 gw = *(const u32x2*)(H + (size_t)(t0 + i) * NH + C_GG + h * 256 + e);
            const float g0 = bf2f(gw.x & 0xffffu), g1 = bf2f(gw.x >> 16), g2 = bf2f(gw.y & 0xffffu), g3 = bf2f(gw.y >> 16);
            u32x2 o; o.x = pk2(acc[a][n][0] * rs * gn.x * g0, acc[a][n][1] * rs * gn.y * g1); o.y = pk2(acc[a][n][2] * rs * gn.z * g2, acc[a][n][3] * rs * gn.w * g3);
            *(u32x2*)(OB + (size_t)(t0 + i) * DM + 1024 + h * 256 + e) = o; } }
}

DI void pool_unit(const Frame& F, int l, int unit, const float* pool_scale) {
    const int gi = unit & 3, tt = unit >> 2, t0 = tt * 128, tid = F.tid, lane = F.lane, wave = F.wave, w = 2 << gi;
    const bf16* H = wsp<bf16>(F, WS_H);
    LAS bf16* pl = (LAS bf16*)(F.lds);
    constexpr int LDP = 264;
    __syncthreads();
    for (int p = tid; p < 128 * 32; p += NTHR) { const int j = p >> 5, ch = p & 31, t = t0 + j, ts = t & (SEQ - 1);
        const int cnt = (ts + 1 < w) ? ts + 1 : w; float a[8];
#pragma unroll
        for (int i = 0; i < 8; ++i) a[i] = 0.f;
        float u0[8];
        const bf16* hp = H + (size_t)t * NH + C_PU + gi * 256 + 8 * ch;
        { float f[8]; unpack8(*(const u32x4*)hp, f);
#pragma unroll
          for (int i = 0; i < 8; ++i) { a[i] = f[i]; u0[i] = f[i]; } }
#pragma unroll
        for (int s = 1; s < 16; ++s) if (s < w) { const int sb = (s < cnt) ? s : 0;
            const u32x4 x = *(const u32x4*)(hp - (size_t)sb * NH); float f[8]; unpack8(x, f); const float wgt = (s < cnt) ? 1.f : 0.f;
#pragma unroll
            for (int i = 0; i < 8; ++i) a[i] += wgt * f[i]; }
        const float ic = 1.0f / (float)cnt;
#pragma unroll
        for (int i = 0; i < 8; ++i) a[i] = a[i] * ic - u0[i];
        *(LAS u32x4*)(pl + j * LDP + 8 * ch) = pack8(a); }
    __syncthreads();
    const bf16* WP = wsp<bf16>(F, WS_WPOOLT) + (size_t)(l * 4 + gi) * 256 * 256;
    f32x4 acc[2][8];
#pragma unroll
    for (int a = 0; a < 2; ++a)
#pragma unroll
        for (int n = 0; n < 8; ++n) acc[a][n] = (f32x4){0.f, 0.f, 0.f, 0.f};
#pragma unroll 2
    for (int kk = 0; kk < 8; ++kk) { bf16x8 af[2];
#pragma unroll
        for (int a = 0; a < 2; ++a) af[a] = frag_glb(WP, 256, 32 * wave + 16 * a, 32 * kk, lane);
#pragma unroll
        for (int n = 0; n < 8; ++n) { const bf16x8 bp = frag_lds(pl, LDP, 16 * n, 32 * kk, lane);
#pragma unroll
            for (int a = 0; a < 2; ++a) acc[a][n] = mma16(af[a], bp, acc[a][n]); } }
    bf16* OB = wsp<bf16>(F, WS_OB);
#pragma unroll
    for (int n = 0; n < 8; ++n) { const int t = t0 + 16 * n + (lane & 15);
#pragma unroll
        for (int a = 0; a < 2; ++a) { const int dd = gi * 256 + 32 * wave + 16 * a + 4 * (lane >> 4);
            const f32x4 sc = *(const f32x4*)(pool_scale + l * 1024 + dd);
            const u32x2 gw = *(const u32x2*)(H + (size_t)t * NH + C_PG + dd);
            const float g0 = bf2f(gw.x & 0xffffu), g1 = bf2f(gw.x >> 16), g2 = bf2f(gw.y & 0xffffu), g3 = bf2f(gw.y >> 16);
            u32x2 o; o.x = pk2(acc[a][n][0] * sc.x * g0, acc[a][n][1] * sc.y * g1); o.y = pk2(acc[a][n][2] * sc.z * g2, acc[a][n][3] * sc.w * g3);
            *(u32x2*)(OB + (size_t)t * DM + dd) = o; } }
}

DI void swa_unit(const Frame& F, int l, int unit, const float* sinks) {
    const int n = unit & 31, hq = (unit >> 5) & 15, b = unit >> 9, kvh = hq >> 3, tid = F.tid, lane = F.lane, wave = F.wave;
    const int tq0 = b * SEQ + n * 128, tk0 = tq0 - 128;
    const bf16* H = wsp<bf16>(F, WS_H); const f32x2* RT = wsp<f32x2>(F, WS_ROPE);
    constexpr int LD = 72, LDPW = 168;
    LAS bf16* qs = (LAS bf16*)(F.lds);
    LAS bf16* ks = (LAS bf16*)(F.lds + 18432);
    LAS bf16* vs = (LAS bf16*)(F.lds + 57600);
    LAS bf16* pw = (LAS bf16*)(F.lds + 96768) + wave * 16 * LDPW;
    __syncthreads();
    for (int p = tid; p < 128 * 4; p += NTHR) { const int i = p >> 2, ch = p & 3; const bf16* src = H + (size_t)(tq0 + i) * NH + C_SQ + hq * 64 + 16 * ch;
        float f[16]; { float a[8], c[8]; unpack8(*(const u32x4*)src, a); unpack8(*(const u32x4*)(src + 8), c);
#pragma unroll
            for (int j = 0; j < 8; ++j) { f[j] = a[j]; f[8 + j] = c[j]; } }
        if (ch == 0) {
#pragma unroll
            for (int j = 0; j < 8; ++j) { const f32x2 cs = RT[(size_t)(tq0 + i) * 8 + j]; const float x1 = f[j], x2 = f[8 + j]; f[j] = x1 * cs.x - x2 * cs.y; f[8 + j] = x2 * cs.x + x1 * cs.y; } }
        float o0[8], o1[8];
#pragma unroll
        for (int j = 0; j < 8; ++j) { o0[j] = f[j] * 0.125f; o1[j] = f[8 + j] * 0.125f; }
        *(LAS u32x4*)(qs + i * LD + 16 * ch) = pack8(o0); *(LAS u32x4*)(qs + i * LD + 16 * ch + 8) = pack8(o1); }
    for (int p = tid; p < 272 * 4; p += NTHR) { const int j = p >> 2, ch = p & 3; const bool ok = (j < 256) && (n > 0 || j >= 128);
        u32x4 k0 = (u32x4){0u, 0u, 0u, 0u}, k1 = k0, v0 = k0, v1 = k0;
        if (ok) { const bf16* ksrc = H + (size_t)(tk0 + j) * NH + C_SK + kvh * 64 + 16 * ch; const bf16* vsrc = H + (size_t)(tk0 + j) * NH + C_SV + kvh * 64 + 16 * ch;
            k0 = *(const u32x4*)ksrc; k1 = *(const u32x4*)(ksrc + 8); v0 = *(const u32x4*)vsrc; v1 = *(const u32x4*)(vsrc + 8);
            if (ch == 0) { float a[8], c[8]; unpack8(k0, a); unpack8(k1, c);
#pragma unroll
                for (int jj = 0; jj < 8; ++jj) { const f32x2 cs = RT[(size_t)(tk0 + j) * 8 + jj]; const float x1 = a[jj], x2 = c[jj]; a[jj] = x1 * cs.x - x2 * cs.y; c[jj] = x2 * cs.x + x1 * cs.y; }
                k0 = pack8(a); k1 = pack8(c); } }
        *(LAS u32x4*)(ks + j * LD + 16 * ch) = k0; *(LAS u32x4*)(ks + j * LD + 16 * ch + 8) = k1;
        *(LAS u32x4*)(vs + j * LD + 16 * ch) = v0; *(LAS u32x4*)(vs + j * LD + 16 * ch + 8) = v1; }
    __syncthreads();
    const int qi = 16 * wave + (lane & 15);
    bf16x8 qf[2];
#pragma unroll
    for (int s = 0; s < 2; ++s) qf[s] = frag_lds(qs, LD, 16 * wave, 32 * s, lane);
    f32x4 sc[10];
#pragma unroll
    for (int jt = 0; jt < 10; ++jt) { sc[jt] = (f32x4){0.f, 0.f, 0.f, 0.f};
#pragma unroll
        for (int s = 0; s < 2; ++s) sc[jt] = mma16(frag_lds(ks, LD, 16 * (wave + jt), 32 * s, lane), qf[s], sc[jt]); }
    const float sink = sinks[l * 16 + hq];
    float mx = sink;
#pragma unroll
    for (int jt = 0; jt < 10; ++jt)
#pragma unroll
        for (int r = 0; r < 4; ++r) { const int kj = 16 * (wave + jt) + 4 * (lane >> 4) + r; const bool ok = (kj > qi) && (kj <= qi + 128) && (n > 0 || kj >= 128);
            sc[jt][r] = ok ? sc[jt][r] : -INFINITY; mx = fmaxf(mx, sc[jt][r]); }
    mx = fmaxf(mx, __shfl_xor(mx, 16)); mx = fmaxf(mx, __shfl_xor(mx, 32));
    float sum = 0.f;
#pragma unroll
    for (int jt = 0; jt < 10; ++jt)
#pragma unroll
        for (int r = 0; r < 4; ++r) { const float p = fexp(sc[jt][r] - mx); sc[jt][r] = p; sum += p; }
    sum += __shfl_xor(sum, 16); sum += __shfl_xor(sum, 32);
    const float inv = 1.0f / (sum + fexp(sink - mx));
#pragma unroll
    for (int jt = 0; jt < 10; ++jt) { u32x2 o; o.x = pk2(sc[jt][0] * inv, sc[jt][1] * inv); o.y = pk2(sc[jt][2] * inv, sc[jt][3] * inv);
        *(LAS u32x2*)(pw + (lane & 15) * LDPW + 16 * jt + 4 * (lane >> 4)) = o; }
    LDS_WAIT();
    f32x4 oa[4];
#pragma unroll
    for (int dt = 0; dt < 4; ++dt) oa[dt] = (f32x4){0.f, 0.f, 0.f, 0.f};
#pragma unroll
    for (int s = 0; s < 5; ++s) { const bf16x8 pf = frag_lds(pw, LDPW, 0, 32 * s, lane);
#pragma unroll
        for (int dt = 0; dt < 4; ++dt) oa[dt] = mma16(frag_tr(vs, LD, 16 * wave + 32 * s, 16 * dt, lane), pf, oa[dt]); }
    bf16* OB = wsp<bf16>(F, WS_OB);
    { const int t = tq0 + qi;
#pragma unroll
      for (int dt = 0; dt < 4; ++dt) { const int dd = hq * 64 + 16 * dt + 4 * (lane >> 4);
          const u32x2 gw = *(const u32x2*)(H + (size_t)t * NH + C_SG + dd);
          const float g0 = bf2f(gw.x & 0xffffu), g1 = bf2f(gw.x >> 16), g2 = bf2f(gw.y & 0xffffu), g3 = bf2f(gw.y >> 16);
          u32x2 o; o.x = pk2(oa[dt][0] * g0, oa[dt][1] * g1); o.y = pk2(oa[dt][2] * g2, oa[dt][3] * g3);
          *(u32x2*)(OB + (size_t)t * DM + 2048 + dd) = o; } }
}

DI void mem_unit(const Frame& F, int l, int unit) {
    const int n = unit & 31, hx = (unit >> 5) & 3, b = unit >> 7, lane = F.lane, wave = F.wave, tid = F.tid;
    const int tq0 = b * SEQ + n * 128 + 16 * wave;
    const bf16* H = wsp<bf16>(F, WS_H);
    const bf16* MK = wsp<bf16>(F, WS_MK) + (size_t)l * 512 * 1024 + (size_t)b * 256 * 1024 + hx * 256;
    const bf16* MVT = wsp<bf16>(F, WS_MVT) + (size_t)l * 1024 * 512 + (size_t)hx * 256 * 512 + b * 256;
    constexpr int LDI = 264;
    LAS bf16* img = (LAS bf16*)(F.lds);
    __syncthreads();
#pragma unroll 4
    for (int p = tid; p < 256 * 32; p += NTHR) { const int r = p >> 5, ch = p & 31; *(LAS u32x4*)(img + r * LDI + 8 * ch) = *(const u32x4*)(MK + (size_t)r * 1024 + 8 * ch); }
    bf16x8 qf[8];
#pragma unroll
    for (int s = 0; s < 8; ++s) qf[s] = frag_glb(H + C_XQ + hx * 256, NH, tq0, 32 * s, lane);
    __syncthreads();
    f32x4 sc[16];
#pragma unroll
    for (int jt = 0; jt < 16; ++jt) { sc[jt] = (f32x4){0.f, 0.f, 0.f, 0.f};
#pragma unroll
        for (int s = 0; s < 8; ++s) sc[jt] = mma16(frag_lds(img, LDI, 16 * jt, 32 * s, lane), qf[s], sc[jt]);
        if (jt & 1) __builtin_amdgcn_sched_barrier(0); }
#pragma unroll
    for (int jt = 0; jt < 16; ++jt) asm volatile("" : "+v"(sc[jt]));
    __syncthreads();
#pragma unroll 4
    for (int p = tid; p < 256 * 32; p += NTHR) { const int r = p >> 5, ch = p & 31; *(LAS u32x4*)(img + r * LDI + 8 * ch) = *(const u32x4*)(MVT + (size_t)r * 512 + 8 * ch); }
    float mx = -INFINITY;
#pragma unroll
    for (int jt = 0; jt < 16; ++jt)
#pragma unroll
        for (int r = 0; r < 4; ++r) { sc[jt][r] *= 0.0625f; mx = fmaxf(mx, sc[jt][r]); }
    mx = fmaxf(mx, __shfl_xor(mx, 16)); mx = fmaxf(mx, __shfl_xor(mx, 32));
    float sum = 0.f;
#pragma unroll
    for (int jt = 0; jt < 16; ++jt)
#pragma unroll
        for (int r = 0; r < 4; ++r) { const float p = __builtin_amdgcn_exp2f((sc[jt][r] - mx) * 1.44269504089f); sc[jt][r] = p; sum += p; }
    sum += __shfl_xor(sum, 16); sum += __shfl_xor(sum, 32);
    const float inv = 1.0f / sum;
    bf16x8 pb[8];
#pragma unroll
    for (int s = 0; s < 8; ++s) { u32x4 w; w.x = pk2(sc[2 * s][0] * inv, sc[2 * s][1] * inv); w.y = pk2(sc[2 * s][2] * inv, sc[2 * s][3] * inv);
        w.z = pk2(sc[2 * s + 1][0] * inv, sc[2 * s + 1][1] * inv); w.w = pk2(sc[2 * s + 1][2] * inv, sc[2 * s + 1][3] * inv); pb[s] = __builtin_bit_cast(bf16x8, w); }
    __syncthreads();
    bf16* OB = wsp<bf16>(F, WS_OB); const int t = tq0 + (lane & 15);
    const LAS bf16* arow = img + (lane & 15) * LDI + 4 * (lane >> 4);
#pragma unroll 4
    for (int dt = 0; dt < 16; ++dt) { f32x4 oa = (f32x4){0.f, 0.f, 0.f, 0.f};
#pragma unroll
        for (int s = 0; s < 8; ++s) { const u32x2 lo = *(const LAS u32x2*)(arow + 16 * dt * LDI + 32 * s), hi = *(const LAS u32x2*)(arow + 16 * dt * LDI + 32 * s + 16);
            const u32x4 av = (u32x4){lo.x, lo.y, hi.x, hi.y};
            oa = mma16(__builtin_bit_cast(bf16x8, av), pb[s], oa); }
        __builtin_amdgcn_sched_barrier(0);
        const int dd = hx * 256 + 16 * dt + 4 * (lane >> 4);
        const u32x2 gw = *(const u32x2*)(H + (size_t)t * NH + C_XG + dd);
        const float g0 = bf2f(gw.x & 0xffffu), g1 = bf2f(gw.x >> 16), g2 = bf2f(gw.y & 0xffffu), g3 = bf2f(gw.y >> 16);
        u32x2 o; o.x = pk2(oa[0] * g0, oa[1] * g1); o.y = pk2(oa[2] * g2, oa[3] * g3);
        *(u32x2*)(OB + (size_t)t * DM + 3072 + dd) = o; }
}

#ifndef NAIVE_MASK
#define NAIVE_MASK 0
#endif
DI float Hf(const bf16* H, size_t row, int col) { return bf2f(H[row * NH + col]); }
DI void naive_mem(const Frame& F, int l) {
    const bf16* H = wsp<bf16>(F, WS_H); bf16* OB = wsp<bf16>(F, WS_OB);
    LAS float* qs = (LAS float*)(F.lds) + F.wave * 512; LAS float* ps = qs + 256;
    const int gw = F.wg * NWAVES + F.wave, NGW = F.G * NWAVES, lane = F.lane;
    for (int it = gw; it < MTOK * 4; it += NGW) {
        const int t = it >> 2, hx = it & 3, b = t / SEQ;
        const bf16* MK = wsp<bf16>(F, WS_MK) + (size_t)l * 512 * 1024 + (size_t)b * 256 * 1024 + hx * 256;
        const bf16* MVT = wsp<bf16>(F, WS_MVT) + (size_t)l * 1024 * 512 + (size_t)hx * 256 * 512 + b * 256;
        for (int i = 0; i < 4; ++i) qs[lane + 64 * i] = Hf(H, t, C_XQ + hx * 256 + lane + 64 * i);
        LDS_WAIT();
        float sc[4]; float mx = -INFINITY;
        for (int i = 0; i < 4; ++i) { const int j = lane + 64 * i; float a = 0.f; for (int d = 0; d < 256; ++d) a += qs[d] * bf2f(MK[(size_t)j * 1024 + d]); sc[i] = a * 0.0625f; mx = fmaxf(mx, sc[i]); }
        for (int o = 1; o < 64; o <<= 1) mx = fmaxf(mx, __shfl_xor(mx, o));
        float sum = 0.f; for (int i = 0; i < 4; ++i) { sc[i] = expf(sc[i] - mx); sum += sc[i]; }
        sum = wave_sum(sum);
        for (int i = 0; i < 4; ++i) ps[lane + 64 * i] = sc[i] / sum;
        LDS_WAIT();
        for (int i = 0; i < 4; ++i) { const int d = lane + 64 * i; float a = 0.f; for (int j = 0; j < 256; ++j) a += ps[j] * bf2f(MVT[(size_t)d * 512 + j]);
            OB[(size_t)t * DM + 3072 + hx * 256 + d] = (bf16)f2bf(a * Hf(H, t, C_XG + hx * 256 + d)); }
        LDS_WAIT();
    }
}
DI void naive_swa(const Frame& F, int l, const float* sinks) {
    const bf16* H = wsp<bf16>(F, WS_H); bf16* OB = wsp<bf16>(F, WS_OB); const f32x2* RT = wsp<f32x2>(F, WS_ROPE);
    LAS float* qs = (LAS float*)(F.lds) + F.wave * 256; LAS float* ps = qs + 64;
    const int gw = F.wg * NWAVES + F.wave, NGW = F.G * NWAVES, lane = F.lane;
    for (int it = gw; it < MTOK * 16; it += NGW) {
        const int t = it >> 4, hq = it & 15, kvh = hq >> 3, ts = t & (SEQ - 1);
        { float x = Hf(H, t, C_SQ + hq * 64 + lane);
          if (lane < 16) { const int i = lane & 7; const float x1 = Hf(H, t, C_SQ + hq * 64 + i), x2 = Hf(H, t, C_SQ + hq * 64 + 8 + i); const f32x2 cs = RT[(size_t)t * 8 + i];
              x = (lane < 8) ? x1 * cs.x - x2 * cs.y : x2 * cs.x + x1 * cs.y; }
          qs[lane] = x * 0.125f; }
        LDS_WAIT();
        float sc[2]; const float sink = sinks[l * 16 + hq]; float mx = sink;
        for (int i = 0; i < 2; ++i) { const int back = lane + 64 * i; sc[i] = -INFINITY;
            if (back <= ts) { const int tk = t - back; float a = 0.f;
                for (int d = 0; d < 64; ++d) { float kv = Hf(H, tk, C_SK + kvh * 64 + d);
                    if (d < 16) { const int ii = d & 7; const float x1 = Hf(H, tk, C_SK + kvh * 64 + ii), x2 = Hf(H, tk, C_SK + kvh * 64 + 8 + ii); const f32x2 cs = RT[(size_t)tk * 8 + ii];
                        kv = (d < 8) ? x1 * cs.x - x2 * cs.y : x2 * cs.x + x1 * cs.y; }
                    a += qs[d] * kv; }
                sc[i] = a; }
            mx = fmaxf(mx, sc[i]); }
        for (int o = 1; o < 64; o <<= 1) mx = fmaxf(mx, __shfl_xor(mx, o));
        float sum = 0.f; for (int i = 0; i < 2; ++i) { sc[i] = expf(sc[i] - mx); sum += sc[i]; }
        sum = wave_sum(sum) + expf(sink - mx);
        for (int i = 0; i < 2; ++i) ps[lane + 64 * i] = sc[i] / sum;
        LDS_WAIT();
        { float a = 0.f; const int nk = (ts + 1 < 128) ? ts + 1 : 128;
          for (int back = 0; back < nk; ++back) a += ps[back] * Hf(H, t - back, C_SV + kvh * 64 + lane);
          OB[(size_t)t * DM + 2048 + hq * 64 + lane] = (bf16)f2bf(a * Hf(H, t, C_SG + hq * 64 + lane)); }
        LDS_WAIT();
    }
}
DI void naive_pool(const Frame& F, int l, const float* w_pool, const float* pool_scale) {
    const bf16* H = wsp<bf16>(F, WS_H); bf16* OB = wsp<bf16>(F, WS_OB); LAS float* pl = (LAS float*)(F.lds);
    for (int unit = F.wg; unit < 512; unit += F.G) { const int gi = unit & 3, t0 = (unit >> 2) * 64, w = 2 << gi;
        __syncthreads();
        for (int p = F.tid; p < 64 * 256; p += NTHR) { const int j = p >> 8, c = p & 255, t = t0 + j, ts = t & (SEQ - 1); const int cnt = (ts + 1 < w) ? ts + 1 : w; float a = 0.f;
            for (int s2 = 0; s2 < cnt; ++s2) a += Hf(H, t - s2, C_PU + gi * 256 + c);
            pl[p] = a / (float)cnt - Hf(H, t, C_PU + gi * 256 + c); }
        __syncthreads();
        const float* W = w_pool + (size_t)(l * 4 + gi) * 256 * 256;
        for (int o = F.tid; o < 64 * 256; o += NTHR) { const int j = o >> 8, d = o & 255; float a = 0.f; for (int c = 0; c < 256; ++c) a += pl[j * 256 + c] * W[c * 256 + d];
            const int t = t0 + j; OB[(size_t)t * DM + gi * 256 + d] = (bf16)f2bf(a * pool_scale[l * 1024 + gi * 256 + d] * Hf(H, t, C_PG + gi * 256 + d)); } }
}
DI void naive_gla(const Frame& F, int l, const float* w_gla_up, const float* b_gla) {
    const bf16* H = wsp<bf16>(F, WS_H); float* RAW = wsp<float>(F, WS_GU); LAS float* red = (LAS float*)(F.lds);
    for (int unit = F.wg; unit < 64; unit += F.G) { const int bh = unit >> 3, es = unit & 7, b = bh >> 2, h = bh & 3, e = es * 32 + (F.tid & 31), dg = F.tid >> 5;
        float S[8], wu[8][16], bg[8];
        for (int i = 0; i < 8; ++i) { S[i] = 0.f; bg[i] = b_gla[l * 512 + h * 128 + 8 * dg + i]; for (int r = 0; r < 16; ++r) wu[i][r] = w_gla_up[(size_t)l * 16 * 512 + r * 512 + h * 128 + 8 * dg + i]; }
        for (int ts = 0; ts < SEQ; ++ts) { const size_t t = (size_t)b * SEQ + ts; float lr[16]; for (int r = 0; r < 16; ++r) lr[r] = Hf(H, t, C_LR + r);
            const float v = Hf(H, t, C_GV + h * 256 + e); float part = 0.f;
            for (int i = 0; i < 8; ++i) { float z = bg[i]; for (int r = 0; r < 16; ++r) z += lr[r] * wu[i][r];
                const float a = expf((fminf(z, 0.f) - log1pf(expf(-fabsf(z)))) * (1.0f / 16.0f));
                S[i] = a * S[i] + Hf(H, t, C_GK + h * 128 + 8 * dg + i) * v; part += Hf(H, t, C_GQ + h * 128 + 8 * dg + i) * 0.08838834764831845f * S[i]; }
            __syncthreads(); red[dg * 32 + (F.tid & 31)] = part; __syncthreads();
            if (dg == 0) { float o = 0.f; for (int g = 0; g < 16; ++g) o += red[g * 32 + (F.tid & 31)]; RAW[t * 1024 + h * 256 + e] = o; } } }
}
DI void naive_gla_norm(const Frame& F, int l, const float* gla_norm) {
    const bf16* H = wsp<bf16>(F, WS_H); bf16* OB = wsp<bf16>(F, WS_OB); const float* RAW = wsp<float>(F, WS_GU);
    const int gw = F.wg * NWAVES + F.wave, NGW = F.G * NWAVES, lane = F.lane;
    for (int it = gw; it < MTOK * 4; it += NGW) { const int t = it >> 2, h = it & 3; float o[4], ss = 0.f;
        for (int i = 0; i < 4; ++i) { o[i] = RAW[(size_t)t * 1024 + h * 256 + lane + 64 * i]; ss += o[i] * o[i]; }
        ss = wave_sum(ss); const float rs = 1.0f / sqrtf(ss * (1.0f / 256.0f) + LN_EPS);
        for (int i = 0; i < 4; ++i) { const int e = lane + 64 * i; OB[(size_t)t * DM + 1024 + h * 256 + e] = (bf16)f2bf(o[i] * rs * gla_norm[l * 1024 + h * 256 + e] * Hf(H, t, C_GG + h * 256 + e)); } }
}

DI void ln_phase(const Frame& F, int l, const float* ln_g, const float* ln_b) {
    const int gw = F.wg * NWAVES + F.wave, NGW = F.G * NWAVES, lane = F.lane;
    const float* g = ln_g + l * DM; const float* bb = ln_b + l * DM;
    for (int m = gw; m < MTOK; m += NGW) {
        f32x4* row = (f32x4*)(F.out + (size_t)m * DM) + lane; const f32x4* zrow = (const f32x4*)(wsp<float>(F, WS_Z) + (size_t)m * DM) + lane;
        f32x4 v[16]; float s = 0.f;
#pragma unroll
        for (int j = 0; j < 16; ++j) { v[j] = zrow[64 * j]; s += (v[j].x + v[j].y) + (v[j].z + v[j].w); }
        const float mean = wave_sum(s) * (1.f / DM); float s2 = 0.f;
#pragma unroll
        for (int j = 0; j < 16; ++j) { v[j] = v[j] - mean; s2 += (v[j].x * v[j].x + v[j].y * v[j].y) + (v[j].z * v[j].z + v[j].w * v[j].w); }
        const float rstd = 1.f / sqrtf(wave_sum(s2) * (1.f / DM) + LN_EPS);
        u32x2* xb = (u32x2*)(wsp<bf16>(F, WS_XB) + (size_t)m * DM) + lane; unsigned* x8 = (unsigned*)(wsp<unsigned char>(F, WS_X8) + (size_t)m * DM) + lane;
#pragma unroll
        for (int j = 0; j < 16; ++j) { const f32x4 gg = *((const f32x4*)g + lane + 64 * j), be = *((const f32x4*)bb + lane + 64 * j);
            const f32x4 o = v[j] * rstd * gg + be; row[64 * j] = o;
            if (l + 1 < DEPTH) { u32x2 w; w.x = pk2(o.x, o.y); w.y = pk2(o.z, o.w); xb[64 * j] = w; x8[64 * j] = pk4_fp8(o.x * X8_SCALE, o.y * X8_SCALE, o.z * X8_SCALE, o.w * X8_SCALE); } }
    }
}

struct Args { const void* in[15]; float* out; unsigned char* ws; int ph_lo, ph_hi; };
constexpr int PH_PER_LAYER = 7, N_PHASES = 1 + PH_PER_LAYER * DEPTH;
#define IN(k) (lo <= (k) && (k) < hi)
#ifndef PH_MASK
#define PH_MASK 0xffff
#endif
#define PHM(b) ((PH_MASK >> (b)) & 1)
#ifndef REP_MASK
#define REP_MASK 0
#endif
#define REPS(b) (((REP_MASK >> (b)) & 1) ? 2 : 1)
#define SEAM(k) do { if (IN(k) && IN((k) + 1)) xcd_barrier(bar); } while (0)
template <int l> DI void layer_body(const Frame& F, const Args& args, const int lo, const int hi, const XcdBarrier& bar) {
        const int p0 = 1 + PH_PER_LAYER * l;
        if (PHM(1) && IN(p0)) { {
            SchedInProj S; S.G = F.G; S.c = F.wg; S.n_extra = (l == 0) ? 32 : 0; S.XB = (const char*)(F.ws + WS_XB); S.WT = (const char*)(F.ws + WS_WINT) + (size_t)l * NH * 4096 * 2;
            S.MEMB = (const char*)(F.ws + WS_MEMB); S.WKV = (const char*)(F.ws + WS_WMKVT);
            EpiH E{wsp<bf16>(F, WS_H), wsp<bf16>(F, WS_MK), wsp<bf16>(F, WS_MVT)};
            pg8::gemm_phase<EpiH, SchedInProj, 2, true>(F.lds, 4096, S, E);
            pg8::SchedStatic S8; S8.nM = 32; S8.nN = 64 * (2 / F8NB); S8.G = F.G; S8.c = F.wg; S8.A = (const char*)(F.ws + WS_X8); S8.B = (const char*)(F.ws + WS_W8) + (size_t)l * 16384 * 4096;
            S8.astep = (size_t)256 * 4096; S8.bstep = (size_t)(128 * F8NB) * 4096;
            EpiMG<F8NB> E8{wsp<bf16>(F, WS_H)};
            pg8::gemm_phase<EpiMG<F8NB>, pg8::SchedStatic, F8NB, true, true>(F.lds, 2048, S8, E8);
        }
        if (REPS(1) == 2) {
            SchedInProj S; S.G = F.G; S.c = F.wg; S.n_extra = (l == 0) ? 32 : 0; S.XB = (const char*)(F.ws + WS_XB); S.WT = (const char*)(F.ws + WS_WINT) + (size_t)l * NH * 4096 * 2;
            S.MEMB = (const char*)(F.ws + WS_MEMB); S.WKV = (const char*)(F.ws + WS_WMKVT);
            EpiH E{wsp<bf16>(F, WS_H), wsp<bf16>(F, WS_MK), wsp<bf16>(F, WS_MVT)};
            pg8::gemm_phase<EpiH, SchedInProj, 2, true>(F.lds, 4096, S, E);
            pg8::SchedStatic S8; S8.nM = 32; S8.nN = 64 * (2 / F8NB); S8.G = F.G; S8.c = F.wg; S8.A = (const char*)(F.ws + WS_X8); S8.B = (const char*)(F.ws + WS_W8) + (size_t)l * 16384 * 4096;
            S8.astep = (size_t)256 * 4096; S8.bstep = (size_t)(128 * F8NB) * 4096;
            EpiMG<F8NB> E8{wsp<bf16>(F, WS_H)};
            pg8::gemm_phase<EpiMG<F8NB>, pg8::SchedStatic, F8NB, true, true>(F.lds, 2048, S8, E8);
        } }
        SEAM(p0);
        if (PHM(2) && IN(p0 + 1)) for (int rep = 0; rep < REPS(2); ++rep) { if (NAIVE_MASK & 2) naive_gla(F, l, (const float*)args.in[6], (const float*)args.in[7]); else for (int u = F.wg; u < 512; u += F.G) gla_a_unit(F, l, u, (const float*)args.in[6], (const float*)args.in[7]); }
        SEAM(p0 + 1);
        if (PHM(3) && IN(p0 + 2)) for (int rep = 0; rep < REPS(3); ++rep) { if (!(NAIVE_MASK & 2)) gla_scan(F); }
        SEAM(p0 + 2);
        if (PHM(4) && IN(p0 + 3)) for (int rep = 0; rep < REPS(4); ++rep) {
            if (NAIVE_MASK & 2) naive_gla_norm(F, l, (const float*)args.in[8]); else
            for (int r2 = 0; r2 < REPS(8); ++r2) for (int u = F.wg; u < 512; u += F.G) gla_c_unit(F, l, u, (const float*)args.in[8]);
            if (NAIVE_MASK & 1) naive_pool(F, l, (const float*)args.in[4], (const float*)args.in[5]); else
            for (int r2 = 0; r2 < REPS(9); ++r2) for (int u = F.wg; u < 256; u += F.G) pool_unit(F, l, u, (const float*)args.in[5]);
            __syncthreads();
            if (NAIVE_MASK & 4) naive_swa(F, l, (const float*)args.in[9]); else
            for (int r2 = 0; r2 < REPS(10); ++r2) for (int u = F.wg; u < 1024; u += F.G) swa_unit(F, l, u, (const float*)args.in[9]);
            __syncthreads();
            if (NAIVE_MASK & 8) naive_mem(F, l); else
            for (int r2 = 0; r2 < REPS(11); ++r2) for (int u = F.wg; u < 256; u += F.G) mem_unit(F, l, u);
            __syncthreads();
        }
        SEAM(p0 + 3);
        if (PHM(5) && IN(p0 + 4)) { {
            pg8::SchedStatic S; S.nM = 32; S.nN = 32; S.G = F.G; S.c = F.wg; S.A = (const char*)(F.ws + WS_OB); S.B = (const char*)(F.ws + WS_WBRT) + (size_t)l * 4096 * 4096 * 2;
            S.astep = (size_t)256 * 4096 * 2; S.bstep = (size_t)128 * 4096 * 2;
            EpiGate E{wsp<bf16>(F, WS_H), wsp<bf16>(F, WS_YB)};
            pg8::gemm_phase<EpiGate, pg8::SchedStatic, 1, true>(F.lds, 4096, S, E);
        }
        if (REPS(5) == 2) {
            pg8::SchedStatic S; S.nM = 32; S.nN = 32; S.G = F.G; S.c = F.wg; S.A = (const char*)(F.ws + WS_OB); S.B = (const char*)(F.ws + WS_WBRT) + (size_t)l * 4096 * 4096 * 2;
            S.astep = (size_t)256 * 4096 * 2; S.bstep = (size_t)128 * 4096 * 2;
            EpiGate E{wsp<bf16>(F, WS_H), wsp<bf16>(F, WS_YB)};
            pg8::gemm_phase<EpiGate, pg8::SchedStatic, 1, true>(F.lds, 4096, S, E);
        } }
        SEAM(p0 + 4);
        if (PHM(6) && IN(p0 + 5)) { {
            pg8::SchedStatic S; S.nM = 32; S.nN = 16; S.G = F.G; S.c = F.wg; S.A = (const char*)(F.ws + WS_YB); S.B = (const char*)(F.ws + WS_WOUTT) + (size_t)l * 4096 * 4096 * 2;
            S.astep = (size_t)256 * 4096 * 2; S.bstep = (size_t)256 * 4096 * 2;
            EpiRes E{l == 0 ? (const float*)args.in[0] : (const float*)F.out, wsp<float>(F, WS_Z)};
            pg8::gemm_phase<EpiRes, pg8::SchedStatic, 2, true>(F.lds, 4096, S, E);
        }
        if (REPS(6) == 2) {
            pg8::SchedStatic S; S.nM = 32; S.nN = 16; S.G = F.G; S.c = F.wg; S.A = (const char*)(F.ws + WS_YB); S.B = (const char*)(F.ws + WS_WOUTT) + (size_t)l * 4096 * 4096 * 2;
            S.astep = (size_t)256 * 4096 * 2; S.bstep = (size_t)256 * 4096 * 2;
            EpiRes E{l == 0 ? (const float*)args.in[0] : (const float*)F.out, wsp<float>(F, WS_Z)};
            pg8::gemm_phase<EpiRes, pg8::SchedStatic, 2, true>(F.lds, 4096, S, E);
        } }
        SEAM(p0 + 5);
        if (PHM(7) && IN(p0 + 6)) for (int rep = 0; rep < REPS(7); ++rep) { ln_phase(F, l, (const float*)args.in[13], (const float*)args.in[14]); }
        SEAM(p0 + 6);
}


__global__ void __launch_bounds__(NTHR, 2) mk_fwd(Args args) {
    extern __shared__ __attribute__((aligned(16))) unsigned char lds_raw[];
    Frame F;
    F.lds = (LAS unsigned char*)lds_raw;
    F.tid = threadIdx.x; F.lane = F.tid & 63; F.wave = __builtin_amdgcn_readfirstlane(F.tid >> 6); F.G = gridDim.x; F.wg = blockIdx.x;
    F.out = args.out; F.ws = args.ws;
    volatile LAS unsigned* MISC = (volatile LAS unsigned*)(F.lds + MISC_OFF);
    for (int u = F.tid; u < (LDS_BYTES - LDSCTL_OFF) / 4; u += NTHR) ((LAS unsigned*)(F.lds + LDSCTL_OFF))[u] = 0u;
    __syncthreads();
    unsigned* barw = (unsigned*)(F.ws + WS_CTL) + CW_BAR;
    XcdBarrier bar; bar.bar = barw; bar.x = 0; bar.st = nullptr;
    const int lo = args.ph_lo, hi = args.ph_hi;
    if (hi - lo > 1) bar = xcd_barrier_post(barw, MISC + 8);

    if (PHM(0) && IN(0)) for (int rep = 0; rep < REPS(0); ++rep) { prologue(F, (const float*)args.in[0], (const float*)args.in[1], (const int*)args.in[2], (const float*)args.in[3], (const float*)args.in[4], (const float*)args.in[10], (const float*)args.in[11], (const float*)args.in[12]); }
    SEAM(0);
    layer_body<0>(F, args, lo, hi, bar);
    layer_body<1>(F, args, lo, hi, bar);
#undef IN
#undef SEAM
}

extern "C" void kernel_launch(void* const* d_in, const int* in_sizes, int n_in, void* d_out, int out_size, void* d_ws, size_t ws_size, hipStream_t stream) {
    static int grid = 0;
    if (grid == 0) {
        if (n_in != 15 || out_size != MTOK * DM || ws_size < WS_END) { fprintf(stderr, "kernel_launch: unexpected sizes (n_in %d, out %d, ws %zu); nothing launched\n", n_in, out_size, ws_size); grid = -1; return; }
        int dev = 0, cus = 0, per_cu = 0;
        if (hipGetDevice(&dev) != hipSuccess || hipDeviceGetAttribute(&cus, hipDeviceAttributeMultiprocessorCount, dev) != hipSuccess) { grid = -1; return; }
        if (hipFuncSetAttribute((const void*)mk_fwd, hipFuncAttributeMaxDynamicSharedMemorySize, LDS_BYTES) != hipSuccess) { fprintf(stderr, "kernel_launch: hipFuncSetAttribute failed\n"); grid = -1; return; }
        if (hipOccupancyMaxActiveBlocksPerMultiprocessor(&per_cu, (const void*)mk_fwd, NTHR, LDS_BYTES) != hipSuccess || per_cu < 1) fprintf(stderr, "kernel_launch: occupancy query says %d\n", per_cu);
        (void)hipGetLastError();
        grid = cus;
    }
    if (grid < 0) return;
    (void)hipMemsetAsync((char*)d_ws + WS_CTL, 0, CTL_ZERO_BYTES, stream);
    Args a{};
    for (int i = 0; i < 15; ++i) a.in[i] = d_in[i];
    a.out = (float*)d_out; a.ws = (unsigned char*)d_ws;
#if MK_PER_PHASE
    for (int p = 0; p < N_PHASES; ++p) { a.ph_lo = p; a.ph_hi = p + 1; hipLaunchKernelGGL(mk_fwd, dim3(grid), dim3(NTHR), LDS_BYTES, stream, a); }
#else
    a.ph_lo = 0; a.ph_hi = N_PHASES;
    hipLaunchKernelGGL(mk_fwd, dim3(grid), dim3(NTHR), LDS_BYTES, stream, a);
#endif
}
```

```cpp
#include <hip/hip_runtime.h>
#include <cstdio>
#include <cstdint>

#ifndef F8ASM1
#define F8ASM1 0
#endif
#ifndef F8NB
#define F8NB 2
#endif
#ifndef MK_PER_PHASE
#define MK_PER_PHASE 0
#endif

#define DI __device__ __forceinline__
#define LAS __attribute__((address_space(3)))
#define GAS __attribute__((address_space(1)))
typedef unsigned short bf16;
typedef short bf16x8 __attribute__((ext_vector_type(8)));
typedef short s16x4 __attribute__((ext_vector_type(4)));
typedef short v4i16_t __attribute__((ext_vector_type(4)));
typedef float f32x4 __attribute__((ext_vector_type(4)));
typedef float f32x2 __attribute__((ext_vector_type(2)));
typedef unsigned u32x4 __attribute__((ext_vector_type(4)));
typedef unsigned u32x2 __attribute__((ext_vector_type(2)));

constexpr int BATCH = 2, SEQ = 4096, DM = 4096, MTOK = BATCH * SEQ, DEPTH = 2;
constexpr int D_IN = 25872, NH = 26112;
constexpr int BW = 1024;
constexpr int MEMLEN = 256;
constexpr int C_PU = 0, C_PG = 1024, C_GQ = 2048, C_GK = 2560, C_GV = 3072, C_GG = 4096, C_SQ = 5120, C_SK = 6144, C_SV = 6272, C_SG = 6400, C_XQ = 7424, C_XG = 8448, C_MG = 9472, C_LR = 25856;
constexpr float LN_EPS = 1e-5f;
constexpr float DN_ALPHA = 1.41421356237309515f;

constexpr size_t MiB = 1u << 20;
constexpr size_t WS_CTL = 0, CTL_ZERO_BYTES = 1 * MiB;
constexpr size_t WS_ROPE = 1 * MiB;
constexpr size_t WS_WPOOLT = 2 * MiB;
constexpr size_t WS_MEMB = 4 * MiB;
constexpr size_t WS_MK = 8 * MiB;
constexpr size_t WS_MVT = 10 * MiB;
constexpr size_t WS_DEC = 12 * MiB;
constexpr size_t WS_WMKVT = 16 * MiB;
constexpr size_t WS_WBRT = 48 * MiB;
constexpr size_t WS_WOUTT = 112 * MiB;
constexpr size_t WS_XB = 176 * MiB;
constexpr size_t WS_OB = 240 * MiB;
constexpr size_t WS_YB = 304 * MiB;
constexpr size_t WS_GU = 368 * MiB;
constexpr size_t WS_GS = 432 * MiB;
constexpr size_t WS_GB = 464 * MiB;
constexpr size_t WS_WINT = 512 * MiB;
constexpr size_t WS_H = 928 * MiB;
constexpr size_t WS_Z = 1336 * MiB;
constexpr size_t WS_X8 = 1464 * MiB;
constexpr size_t WS_W8 = 1496 * MiB;
constexpr size_t WS_END = 1624 * MiB;
constexpr float X8_SCALE = 16.0f, W8_SCALE = 2048.0f, MG_DESCALE = 1.0f / (16.0f * 2048.0f);
constexpr int CW_BAR = 4096;

constexpr int RING_BYTES = 131072;
constexpr int THIN_BYTES = 141312;
constexpr int LDSCTL_OFF = THIN_BYTES, MISC_OFF = LDSCTL_OFF + 320;
constexpr int LDS_BYTES = 147456;
constexpr int NWAVES = 8, NTHR = 512;

DI float bf2f(unsigned v) { return __builtin_bit_cast(float, v << 16); }
DI unsigned f2bf(float f) { unsigned u = __builtin_bit_cast(unsigned, f); return (u + 0x7fffu + ((u >> 16) & 1u)) >> 16; }
DI unsigned pk2(float lo, float hi) { return f2bf(lo) | (f2bf(hi) << 16); }
typedef float f32x2_t __attribute__((ext_vector_type(2))); typedef __bf16 bf16x2_t __attribute__((ext_vector_type(2)));
DI unsigned cvt_pk_bf16(float lo, float hi) { const f32x2_t v = {lo, hi}; const bf16x2_t b = __builtin_convertvector(v, bf16x2_t); return __builtin_bit_cast(unsigned, b); }
DI float fast_sigmoid(float v) { return __builtin_amdgcn_rcpf(1.0f + __builtin_amdgcn_exp2f(-1.44269504089f * v)); }
DI void unpack8(const u32x4 w, float (&f)[8]) {
    f[0] = bf2f(w.x & 0xffffu); f[1] = bf2f(w.x >> 16); f[2] = bf2f(w.y & 0xffffu); f[3] = bf2f(w.y >> 16);
    f[4] = bf2f(w.z & 0xffffu); f[5] = bf2f(w.z >> 16); f[6] = bf2f(w.w & 0xffffu); f[7] = bf2f(w.w >> 16);
}
DI u32x4 pack8(const float (&f)[8]) { u32x4 w; w.x = pk2(f[0], f[1]); w.y = pk2(f[2], f[3]); w.z = pk2(f[4], f[5]); w.w = pk2(f[6], f[7]); return w; }
DI float clamp448(float v) { return fminf(fmaxf(v, -448.0f), 448.0f); }
DI unsigned pk4_fp8(float a, float b, float c, float d) {
    int w = 0; w = __builtin_amdgcn_cvt_pk_fp8_f32(clamp448(a), clamp448(b), w, false); w = __builtin_amdgcn_cvt_pk_fp8_f32(clamp448(c), clamp448(d), w, true); return (unsigned)w; }
typedef int v8i32 __attribute__((ext_vector_type(8)));
DI f32x4 mma16(bf16x8 a, bf16x8 b, f32x4 c) { return __builtin_amdgcn_mfma_f32_16x16x32_bf16(a, b, c, 0, 0, 0); }
DI bf16x8 frag_lds(const LAS bf16* img, int ld, int idx0, int k0, int lane) { return *(const LAS bf16x8*)(img + (idx0 + (lane & 15)) * ld + k0 + 8 * (lane >> 4)); }
DI bf16x8 frag_glb(const bf16* img, size_t ld, int idx0, int k0, int lane) { return *(const bf16x8*)(img + (size_t)(idx0 + (lane & 15)) * ld + k0 + 8 * (lane >> 4)); }
DI s16x4 tr4(const LAS bf16* p) { return __builtin_bit_cast(s16x4, __builtin_amdgcn_ds_read_tr16_b64_v4i16((LAS v4i16_t*)p)); }
DI bf16x8 frag_tr(const LAS bf16* img, int ld, int k0, int idx0, int lane) {
    const int g = lane >> 4, q = (lane >> 2) & 3, p = lane & 3;
    const LAS bf16* a0 = img + (k0 + 8 * g + q) * ld + idx0 + 4 * p;
    const s16x4 lo = tr4(a0), hi = tr4(a0 + 4 * ld);
    return __builtin_shufflevector(lo, hi, 0, 1, 2, 3, 4, 5, 6, 7);
}
DI float wave_sum(float v) {
#pragma unroll
    for (int o = 1; o < 64; o <<= 1) v += __shfl_xor(v, o);
    return v;
}
#define LDS_WAIT() asm volatile("s_waitcnt lgkmcnt(0)" ::: "memory")
#define VM_WAIT() asm volatile("s_waitcnt vmcnt(0)" ::: "memory")

namespace pg8 {
constexpr int BM = 256, BK = 64, HALF = 128, HTB = HALF * BK * 2, STAGE_BYTES = 8 * HTB, NXCD = 8, WGM = 8;
__host__ __device__ __forceinline__ int lds_byte(int r, int c) { const int st = (r >> 4) * 2 + (c >> 5), rr = r & 15, cc = c & 31, ob = rr * 64 + cc * 2; return st * 1024 + (ob ^ (((ob >> 9) & 1) << 5)); }
__host__ __device__ __forceinline__ void stage_rc(int b, int& R, int& C) { const int st = b / 1024, sb = b % 1024, swz = sb ^ (((sb >> 9) & 1) << 5); R = (st >> 1) * 16 + swz / 64; C = (st & 1) * 32 + (swz % 64) / 2; }
__host__ __device__ __forceinline__ int perm32(int rho) { const int n = rho >> 4, i = rho & 15; return 8 * (i >> 2) + 4 * n + (i & 3); }

struct Unit { int pm, pn, gi; };

DI void static_tile(int L, int nM, int nN, int& pm, int& pn) {
    const int nwg = nM * nN; int wgid = L;
    { const int q = nwg / NXCD, r = nwg % NXCD, xcd = wgid % NXCD, off = wgid / NXCD; wgid = (xcd < r ? xcd * (q + 1) : r * (q + 1) + (xcd - r) * q) + off; }
    const int nig = WGM * nN, gid = wgid / nig, fm = gid * WGM, gsz = (nM - fm) < WGM ? (nM - fm) : WGM;
    pm = fm + ((wgid % nig) % gsz); pn = (wgid % nig) / gsz;
}
struct SchedStatic {
    int nM, nN, G, c; const char* A; const char* B; size_t astep, bstep;
    DI bool next(int i, Unit& u) const { const long L = (long)i * G + c; if (L >= (long)nM * nN) return false; static_tile((int)L, nM, nN, u.pm, u.pn); u.gi = 0; return true; }
    DI const char* abase(const Unit& u) const { return A + (size_t)u.pm * astep; }
    DI const char* bbase(const Unit& u) const { return B + (size_t)u.pn * bstep; }
};

template <class Epi, class Sched, int NB, bool ALIGN_EPI, bool F8 = false>
DI void gemm_phase(LAS unsigned char* lds, const int K, const Sched& S, const Epi& E) {
    const int tid = threadIdx.x, wid = __builtin_amdgcn_readfirstlane(tid >> 6), lane = tid & 63, wr = wid >> 2, wc = wid & 3, fr = lane & 15, fq = lane >> 4;
    const int nt = K / BK;
    unsigned voffA[2], voffB[2];
#pragma unroll
    for (int i = 0; i < 2; ++i) { int R, C; stage_rc(tid * 16 + i * 8192, R, C); const int Rb = Epi::PERM ? ((R & ~31) + perm32(R & 31)) : R;
        voffA[i] = (unsigned)(R * K + C) * 2u; voffB[i] = (unsigned)(Rb * K + C) * 2u; }
    const size_t kstep = (size_t)(BK * 2);
    const size_t hstep = (size_t)HALF * K * 2;
    const unsigned ldsw = (unsigned)wid * 1024u;
    const int aoff = lds_byte(wr * 64 + fr, F8 ? fq * 16 : fq * 8), boff = lds_byte(wc * 32 + fr, F8 ? fq * 16 : fq * 8);
    constexpr int KOFF = F8 ? 16 : 1024;
    const unsigned one_scale = 0x7f7f7f7fu;
#define PG8_SA(b, h) (((b) * 2 + (h)) * HTB)
#define PG8_SB(b, h) ((4 + (b) * 2 + (h)) * HTB)
#define PG8_STAGE(bufoff, gbase, voff) do { _Pragma("unroll") for (int _i = 0; _i < 2; ++_i) \
        __builtin_amdgcn_global_load_lds((const unsigned*)((const char*)(gbase) + (voff)[_i]), (LAS unsigned*)(lds + (bufoff) + ldsw + _i * 8192), 16, 0, 0); } while (0)
#define PG8_LDA(dst, b, h) do { _Pragma("unroll") for (int m = 0; m < 4; ++m) _Pragma("unroll") for (int k = 0; k < 2; ++k) dst[m][k] = *(const LAS bf16x8*)(lds + PG8_SA(b, h) + aoff + m * 2048 + k * KOFF); } while (0)
#define PG8_LDB(dst, b, h) do { _Pragma("unroll") for (int n = 0; n < 2; ++n) _Pragma("unroll") for (int k = 0; k < 2; ++k) dst[n][k] = *(const LAS bf16x8*)(lds + PG8_SB(b, h) + boff + n * 2048 + k * KOFF); } while (0)
#define PG8_CAT(x) __builtin_bit_cast(v8i32, __builtin_shufflevector((x)[0], (x)[1], 0, 1, 2, 3, 4, 5, 6, 7, 8, 9, 10, 11, 12, 13, 14, 15))
#define PG8_MMA(ai, bj, At, Bt) do { __builtin_amdgcn_s_setprio(1); _Pragma("unroll") for (int m = 0; m < 4; ++m) _Pragma("unroll") for (int n = 0; n < 2; ++n) { \
        if constexpr (F8 && NB == 1 && !F8ASM1) acc[ai][bj][m][n] = __builtin_amdgcn_mfma_scale_f32_16x16x128_f8f6f4(PG8_CAT(Bt[n]), PG8_CAT(At[m]), acc[ai][bj][m][n], 0, 0, 0, 0x7f7f7f7f, 0, 0x7f7f7f7f); \
        else if constexpr (F8) { asm volatile("v_mfma_scale_f32_16x16x128_f8f6f4 %0, %1, %2, %0, %3, %3 op_sel_hi:[0,0,0]" : "+v"(acc[ai][bj][m][n]) : "v"(PG8_CAT(Bt[n])), "v"(PG8_CAT(At[m])), "v"(one_scale)); } \
        else { _Pragma("unroll") for (int k = 0; k < 2; ++k) acc[ai][bj][m][n] = __builtin_amdgcn_mfma_f32_16x16x32_bf16(Bt[n][k], At[m][k], acc[ai][bj][m][n], 0, 0, 0); } } \
        __builtin_amdgcn_s_setprio(0); } while (0)
#define PG8_WAIT_V(n) asm volatile("s_waitcnt vmcnt(" #n ")" ::: "memory")
#define PG8_WAIT_L(n) asm volatile("s_waitcnt lgkmcnt(" #n ")" ::: "memory")
#define PG8_BAR __builtin_amdgcn_s_barrier()
#define PG8_SCHED __builtin_amdgcn_sched_barrier(0)
#define PG8_WAIT_MAIN() do { if constexpr (NB == 2) PG8_WAIT_V(8); else PG8_WAIT_V(6); } while (0)
    Unit cur, nxt; int ui = 0;
    if (!S.next(0, cur)) return;
    f32x4 acc[2][NB][4][2];
    f32x4 yac[2][4][2];
#pragma unroll
    for (int a = 0; a < 2; ++a)
#pragma unroll
        for (int m = 0; m < 4; ++m)
#pragma unroll
            for (int n = 0; n < 2; ++n) { yac[a][m][n] = (f32x4){0.f, 0.f, 0.f, 0.f};
#pragma unroll
                for (int b = 0; b < NB; ++b) acc[a][b][m][n] = (f32x4){0.f, 0.f, 0.f, 0.f}; }
    bf16x8 At[4][2], B0[2][2], B1[2][2];
    const char* cA = S.abase(cur); const char* cB = S.bbase(cur);
    if constexpr (NB == 2) {
        PG8_STAGE(PG8_SB(0, 0), cB, voffB); PG8_STAGE(PG8_SB(0, 1), cB + hstep, voffB); PG8_STAGE(PG8_SA(0, 0), cA, voffA); PG8_STAGE(PG8_SA(0, 1), cA + hstep, voffA);
        if (wr == 1) PG8_BAR;
        PG8_WAIT_V(2); PG8_BAR;
        PG8_STAGE(PG8_SB(1, 0), cB + kstep, voffB); PG8_STAGE(PG8_SA(1, 0), cA + kstep, voffA); PG8_STAGE(PG8_SB(1, 1), cB + hstep + kstep, voffB);
        PG8_WAIT_V(6); PG8_BAR;
    } else {
        PG8_STAGE(PG8_SB(0, 0), cB, voffB); PG8_STAGE(PG8_SA(0, 0), cA, voffA); PG8_STAGE(PG8_SA(0, 1), cA + hstep, voffA);
        if (wr == 1) PG8_BAR;
        PG8_WAIT_V(2); PG8_BAR;
        PG8_STAGE(PG8_SB(1, 0), cB + kstep, voffB); PG8_STAGE(PG8_SA(1, 0), cA + kstep, voffA);
        PG8_WAIT_V(4); PG8_BAR;
    }
    for (;;) {
        const bool has_next = S.next(ui + 1, nxt);
        const char* nA = has_next ? S.abase(nxt) : cA; const char* nB = has_next ? S.bbase(nxt) : cB;
        for (int t = 0; t < nt; t += 2) {
            if constexpr (Epi::GATED) { if (t != 0 && (t & 15) == 0) { E.flush(acc, yac, cur, (t >> 4) - 1, wr, wc, fr, fq);
#pragma unroll
                for (int a = 0; a < 2; ++a)
#pragma unroll
                    for (int m = 0; m < 4; ++m)
#pragma unroll
                        for (int n = 0; n < 2; ++n) acc[a][0][m][n] = (f32x4){0.f, 0.f, 0.f, 0.f}; } }
            const bool last = (t == nt - 2);
            const char* a1 = cA + (size_t)(t + 1) * kstep;
            const char* a2 = last ? nA : cA + (size_t)(t + 2) * kstep; const char* b2 = last ? nB : cB + (size_t)(t + 2) * kstep;
            const char* a3 = a2 + kstep; const char* b3 = b2 + kstep;
            if constexpr (NB == 2) {
            PG8_LDB(B0, 0, 0); PG8_LDB(B1, 0, 1); PG8_SCHED; PG8_LDA(At, 0, 0); PG8_STAGE(PG8_SA(1, 1), a1 + hstep, voffA);
            PG8_WAIT_V(8); PG8_WAIT_L(0); PG8_BAR; PG8_MMA(0, 0, At, B0); PG8_MMA(0, 1, At, B1); PG8_BAR; PG8_SCHED;
            PG8_LDA(At, 0, 1); PG8_STAGE(PG8_SB(0, 0), b2, voffB); PG8_STAGE(PG8_SB(0, 1), b2 + hstep, voffB); PG8_STAGE(PG8_SA(0, 0), a2, voffA);
            PG8_WAIT_V(8); PG8_WAIT_L(0); PG8_BAR; PG8_MMA(1, 0, At, B0); PG8_MMA(1, 1, At, B1); PG8_BAR; PG8_SCHED;
            PG8_LDB(B0, 1, 0); PG8_LDB(B1, 1, 1); PG8_SCHED; PG8_LDA(At, 1, 0); PG8_STAGE(PG8_SA(0, 1), a2 + hstep, voffA);
            PG8_WAIT_V(8); PG8_WAIT_L(0); PG8_BAR; PG8_MMA(0, 0, At, B0); PG8_MMA(0, 1, At, B1); PG8_BAR; PG8_SCHED;
            PG8_LDA(At, 1, 1); PG8_STAGE(PG8_SB(1, 0), b3, voffB); PG8_STAGE(PG8_SB(1, 1), b3 + hstep, voffB); PG8_STAGE(PG8_SA(1, 0), a3, voffA);
            PG8_WAIT_V(8); PG8_WAIT_L(0); PG8_BAR; PG8_MMA(1, 0, At, B0); PG8_MMA(1, 1, At, B1); PG8_BAR; PG8_SCHED;
            } else {
            PG8_LDB(B0, 0, 0); PG8_SCHED; PG8_LDA(At, 0, 0); PG8_STAGE(PG8_SA(1, 1), a1 + hstep, voffA);
            PG8_WAIT_V(6); PG8_WAIT_L(0); PG8_BAR; PG8_MMA(0, 0, At, B0); PG8_BAR; PG8_SCHED;
            PG8_LDA(At, 0, 1); PG8_STAGE(PG8_SB(0, 0), b2, voffB); PG8_STAGE(PG8_SA(0, 0), a2, voffA);
            PG8_WAIT_V(6); PG8_WAIT_L(0); PG8_BAR; PG8_MMA(1, 0, At, B0); PG8_BAR; PG8_SCHED;
            PG8_LDB(B0, 1, 0); PG8_SCHED; PG8_LDA(At, 1, 0); PG8_STAGE(PG8_SA(0, 1), a2 + hstep, voffA);
            PG8_WAIT_V(6); PG8_WAIT_L(0); PG8_BAR; PG8_MMA(0, 0, At, B0); PG8_BAR; PG8_SCHED;
            PG8_LDA(At, 1, 1); PG8_STAGE(PG8_SB(1, 0), b3, voffB); PG8_STAGE(PG8_SA(1, 0), a3, voffA);
            PG8_WAIT_V(6); PG8_WAIT_L(0); PG8_BAR; PG8_MMA(1, 0, At, B0); PG8_BAR; PG8_SCHED;
            }
        }
        if constexpr (F8) {
            asm volatile("s_nop 15\n\ts_nop 15" ::: "memory");
#pragma unroll
            for (int a = 0; a < 2; ++a)
#pragma unroll
                for (int b = 0; b < NB; ++b)
#pragma unroll
                    for (int m = 0; m < 4; ++m)
#pragma unroll
                        for (int n = 0; n < 2; ++n) asm volatile("" : "+v"(acc[a][b][m][n]));
        }
        if constexpr (ALIGN_EPI) { if (wr == 0) PG8_BAR; }
        if constexpr (Epi::GATED) { E.finish(acc, yac, cur, wr, wc, fr, fq);
#pragma unroll
            for (int a = 0; a < 2; ++a)
#pragma unroll
                for (int m = 0; m < 4; ++m)
#pragma unroll
                    for (int n = 0; n < 2; ++n) yac[a][m][n] = (f32x4){0.f, 0.f, 0.f, 0.f};
        } else { E(acc, cur, wr, wc, fr, fq); }
        if (!has_next) break;
#pragma unroll
        for (int a = 0; a < 2; ++a)
#pragma unroll
            for (int b = 0; b < NB; ++b)
#pragma unroll
                for (int m = 0; m < 4; ++m)
#pragma unroll
                    for (int n = 0; n < 2; ++n) acc[a][b][m][n] = (f32x4){0.f, 0.f, 0.f, 0.f};
        cur = nxt; cA = nA; cB = nB; ++ui;
        if constexpr (ALIGN_EPI) { if (wr == 1) PG8_BAR; }
    }
    PG8_WAIT_V(0);
    if constexpr (!ALIGN_EPI) { if (wr == 0) PG8_BAR; }
    PG8_BAR;
#undef PG8_SA
#undef PG8_SB
#undef PG8_STAGE
#undef PG8_LDA
#undef PG8_LDB
#undef PG8_MMA
#undef PG8_CAT
#undef PG8_WAIT_V
#undef PG8_WAIT_L
#undef PG8_BAR
#undef PG8_SCHED
#undef PG8_WAIT_MAIN
}
}

#define XB_TMO      128
#define XB_XCNT(j)  (256  + 64 * (j))
#define XB_XSUB(j)  (1280 + 64 * (j))
#define XB_XGEN(j)  (2304 + 64 * (j))
#define XB_TOP      3328
#define XB_TOPGEN   3392
#define XCD_BAR_WORDS 3456
#define XB_SPIN_CAP (1u << 18)
DI unsigned xb_ld(unsigned* p)              { return __hip_atomic_load(p, __ATOMIC_RELAXED, __HIP_MEMORY_SCOPE_AGENT); }
DI unsigned xb_add(unsigned* p, unsigned v) { return __hip_atomic_fetch_add(p, v, __ATOMIC_RELAXED, __HIP_MEMORY_SCOPE_AGENT); }
DI unsigned xb_xcc_id() { return (unsigned)__builtin_amdgcn_s_getreg((3 << 11) | 20) & 0xFu; }
#define XB_SPIN(cond, bar) do { unsigned _sp = 0; while (cond) { __builtin_amdgcn_s_sleep(1); \
    if ((++_sp & 255u) == 0u) { if (xb_ld(&(bar)[XB_TMO])) break; if (_sp > XB_SPIN_CAP) { atomicAdd(&(bar)[XB_TMO], 1u); break; } } } } while (0)
struct XcdBarrier { unsigned* bar; unsigned x; volatile LAS unsigned* st; };
DI XcdBarrier xcd_barrier_post(unsigned* bar, volatile LAS unsigned* st) {
    XcdBarrier b; b.bar = bar; b.x = xb_xcc_id(); b.st = st;
    if (threadIdx.x == 0) (void)xb_add(&bar[XB_XCNT(b.x)], 1u);
    return b;
}
DI void xcd_barrier_complete(unsigned* bar, unsigned x, unsigned& nloc, unsigned& nx) {
    const unsigned G = gridDim.x * gridDim.y * gridDim.z;
    unsigned sum, cnt, mine, sp = 0u;
    for (;;) {
        sum = 0u; cnt = 0u; mine = 0u;
#pragma unroll
        for (unsigned j = 0; j < 16; ++j) { const unsigned c = xb_ld(&bar[XB_XCNT(j)]); sum += c; cnt += (c > 0u) ? 1u : 0u; mine = (j == x) ? c : mine; }
        if (sum == G) break;
        __builtin_amdgcn_s_sleep(1);
        if ((++sp & 255u) == 0u) { if (xb_ld(&bar[XB_TMO])) break; if (sp > XB_SPIN_CAP) { atomicAdd(&bar[XB_TMO], 1u); break; } }
    }
    nloc = mine > 0u ? mine : 1u; nx = cnt > 0u ? cnt : 1u;
}
DI void xcd_barrier(const XcdBarrier& b) {
    asm volatile("s_waitcnt vmcnt(0)" ::: "memory");
    __syncthreads();
    if (threadIdx.x == 0) {
        unsigned* bar = b.bar;
        __builtin_amdgcn_s_waitcnt(0);
        unsigned nloc = b.st[0], nx = b.st[1];
        if (nloc == 0u) { xcd_barrier_complete(bar, b.x, nloc, nx); b.st[0] = nloc; b.st[1] = nx; }
        const unsigned old = xb_add(&bar[XB_XSUB(b.x)], 1u);
        const unsigned gen = old / nloc;
        if (old + 1u == (gen + 1u) * nloc) {
            __builtin_amdgcn_fence(__ATOMIC_RELEASE, "agent");
            asm volatile("s_waitcnt vmcnt(0)" ::: "memory");
            const unsigned og = xb_add(&bar[XB_TOP], 1u);
            const unsigned tg = og / nx;
            if (og + 1u == (tg + 1u) * nx) xb_add(&bar[XB_TOPGEN], 1u);
            else XB_SPIN(xb_ld(&bar[XB_TOPGEN]) == tg, bar);
            __builtin_amdgcn_fence(__ATOMIC_ACQUIRE, "agent");
            xb_add(&bar[XB_XGEN(b.x)], 1u);
            asm volatile("s_waitcnt vmcnt(0)" ::: "memory");
        } else {
            XB_SPIN(xb_ld(&bar[XB_XGEN(b.x)]) == gen, bar);
            __builtin_amdgcn_fence(__ATOMIC_ACQUIRE, "agent");
            asm volatile("s_waitcnt vmcnt(0)" ::: "memory");
        }
    }
    __syncthreads();
}

struct Frame {
    LAS unsigned char* lds;
    int tid, lane, wave, G, wg;
    float* out; unsigned char* ws;
};
template <class T> DI T* wsp(const Frame& F, size_t off) { return (T*)(F.ws + off); }

struct EpiH {
    static constexpr bool PERM = true, GATED = false;
    bf16* H; bf16* MK; bf16* MVT;
    DI void operator()(const f32x4 (&acc)[2][2][4][2], const pg8::Unit& u, int wr, int wc, int fr, int fq) const {
        bf16* base = H; size_t ldc = NH; int act = 0;
        if (u.gi == 0) { const int pn = u.pn; act = ((pn >= 4 && pn < 8) || (pn >= 16 && pn < 20) || (pn >= 25 && pn < 29) || (pn >= 33 && pn < 37)) ? 1 : 0; }
        else { const int lx = (u.gi - 1) >> 1, w = (u.gi - 1) & 1; if (w == 0) { base = MK + (size_t)lx * 512 * 1024; ldc = 1024; } else { base = MVT + (size_t)lx * 1024 * 512; ldc = 512; } }
        const int row0 = u.pm * 256 + wr * 64 + fr, col0 = u.pn * 256 + wc * 32 + 8 * fq;
#pragma unroll
        for (int ai = 0; ai < 2; ++ai)
#pragma unroll
            for (int m = 0; m < 4; ++m) { bf16* rowp = base + (size_t)(row0 + ai * 128 + m * 16) * ldc + col0;
#pragma unroll
                for (int bj = 0; bj < 2; ++bj) { f32x4 v0 = acc[ai][bj][m][0], v1 = acc[ai][bj][m][1];
                    if (act != 0) {
#pragma unroll
                        for (int j = 0; j < 4; ++j) { const float s0 = fast_sigmoid(v0[j]), s1 = fast_sigmoid(v1[j]); v0[j] = (act == 1) ? v0[j] * s0 : s0; v1[j] = (act == 1) ? v1[j] * s1 : s1; } }
                    u32x4 w; w.x = cvt_pk_bf16(v0[0], v0[1]); w.y = cvt_pk_bf16(v0[2], v0[3]); w.z = cvt_pk_bf16(v1[0], v1[1]); w.w = cvt_pk_bf16(v1[2], v1[3]);
                    *(u32x4*)(rowp + bj * 128) = w; } }
    }
};
template <int NB> struct EpiMG {
    static constexpr bool PERM = true, GATED = false;
    bf16* H;
    DI void operator()(const f32x4 (&acc)[2][NB][4][2], const pg8::Unit& u, int wr, int wc, int fr, int fq) const {
        const int row0 = u.pm * 256 + wr * 64 + fr, col0 = C_MG + u.pn * (128 * NB) + wc * 32 + 8 * fq;
#pragma unroll
        for (int ai = 0; ai < 2; ++ai)
#pragma unroll
            for (int m = 0; m < 4; ++m) { bf16* rowp = H + (size_t)(row0 + ai * 128 + m * 16) * NH + col0;
#pragma unroll
                for (int bj = 0; bj < NB; ++bj) { f32x4 v0 = acc[ai][bj][m][0], v1 = acc[ai][bj][m][1];
#pragma unroll
                    for (int j = 0; j < 4; ++j) { v0[j] = fast_sigmoid(v0[j] * MG_DESCALE); v1[j] = fast_sigmoid(v1[j] * MG_DESCALE); }
                    u32x4 w; w.x = cvt_pk_bf16(v0[0], v0[1]); w.y = cvt_pk_bf16(v0[2], v0[3]); w.z = cvt_pk_bf16(v1[0], v1[1]); w.w = cvt_pk_bf16(v1[2], v1[3]);
                    *(u32x4*)(rowp + bj * 128) = w; } }
    }
};
struct EpiRes {
    static constexpr bool PERM = false, GATED = false;
    const float* __restrict__ res; float* __restrict__ out;
    DI void operator()(const f32x4 (&acc)[2][2][4][2], const pg8::Unit& u, int wr, int wc, int fr, int fq) const {
        const int row0 = u.pm * 256 + wr * 64 + fr, col0 = u.pn * 256 + wc * 32 + 4 * fq;
#pragma unroll
        for (int ai = 0; ai < 2; ++ai)
#pragma unroll
            for (int m = 0; m < 4; ++m) { const size_t ro = (size_t)(row0 + ai * 128 + m * 16) * DM + col0;
#pragma unroll
                for (int bj = 0; bj < 2; ++bj)
#pragma unroll
                    for (int n = 0; n < 2; ++n) { const size_t o = ro + bj * 128 + n * 16; const f32x4 r = *(const f32x4*)(res + o); *(f32x4*)(out + o) = r * DN_ALPHA + acc[ai][bj][m][n]; } }
    }
};
struct EpiGate {
    static constexpr bool PERM = true, GATED = true;
    const bf16* H; bf16* Y;
    DI void flush(const f32x4 (&acc)[2][1][4][2], f32x4 (&y)[2][4][2], const pg8::Unit& u, int bi, int wr, int wc, int fr, int fq) const {
        const int row0 = u.pm * 256 + wr * 64 + fr, col0 = u.pn * 128 + wc * 32 + 8 * fq;
#pragma unroll
        for (int ai = 0; ai < 2; ++ai)
#pragma unroll
            for (int m = 0; m < 4; ++m) { const u32x4 gw = *(const u32x4*)(H + (size_t)(row0 + ai * 128 + m * 16) * NH + C_MG + bi * DM + col0);
                float g[8]; unpack8(gw, g);
#pragma unroll
                for (int j = 0; j < 4; ++j) { y[ai][m][0][j] += g[j] * acc[ai][0][m][0][j]; y[ai][m][1][j] += g[4 + j] * acc[ai][0][m][1][j]; }
                if (m == 1 || m == 3) __builtin_amdgcn_sched_barrier(0); }
    }
    DI void finish(const f32x4 (&acc)[2][1][4][2], f32x4 (&y)[2][4][2], const pg8::Unit& u, int wr, int wc, int fr, int fq) const {
        flush(acc, y, u, 3, wr, wc, fr, fq);
        const int row0 = u.pm * 256 + wr * 64 + fr, col0 = u.pn * 128 + wc * 32 + 8 * fq;
#pragma unroll
        for (int ai = 0; ai < 2; ++ai)
#pragma unroll
            for (int m = 0; m < 4; ++m) { const f32x4 v0 = y[ai][m][0], v1 = y[ai][m][1];
                u32x4 w; w.x = cvt_pk_bf16(v0[0], v0[1]); w.y = cvt_pk_bf16(v0[2], v0[3]); w.z = cvt_pk_bf16(v1[0], v1[1]); w.w = cvt_pk_bf16(v1[2], v1[3]);
                *(u32x4*)(Y + (size_t)(row0 + ai * 128 + m * 16) * DM + col0) = w; }
    }
};
struct SchedInProj {
    int G, c, n_extra; const char *XB, *WT, *MEMB, *WKV;
    static constexpr int NM = 32, NN = 38, NU = NM * NN;
    static constexpr size_t TSTEP = (size_t)256 * 4096 * 2;
    DI bool next(int i, pg8::Unit& u) const {
        const long L = (long)i * G + c;
        if (L < NU) { pg8::static_tile((int)L, NM, NN, u.pm, u.pn); if (u.pn == 37) u.pn = 101; u.gi = 0; return true; }
        const int e = (int)(L - NU); if (e >= n_extra) return false;
        const int lx = e >> 4, r = e & 15;
        if (r < 8) { u.pm = r >> 2; u.pn = r & 3; u.gi = 1 + 2 * lx; } else { u.pm = (r - 8) >> 1; u.pn = (r - 8) & 1; u.gi = 2 + 2 * lx; }
        return true;
    }
    DI const char* abase(const pg8::Unit& u) const {
        if (u.gi == 0) return XB + (size_t)u.pm * TSTEP;
        const int lx = (u.gi - 1) >> 1, w = (u.gi - 1) & 1;
        return w == 0 ? MEMB + (size_t)u.pm * TSTEP : WKV + (size_t)lx * 2048 * 4096 * 2 + (size_t)(1024 + u.pm * 256) * 4096 * 2;
    }
    DI const char* bbase(const pg8::Unit& u) const {
        if (u.gi == 0) return WT + (size_t)u.pn * TSTEP;
        const int lx = (u.gi - 1) >> 1, w = (u.gi - 1) & 1;
        return w == 0 ? WKV + (size_t)lx * 2048 * 4096 * 2 + (size_t)u.pn * TSTEP : MEMB + (size_t)u.pn * TSTEP;
    }
};

DI int win_src_col(int n) { return n < 5120 ? n : (n < C_LR ? n + 16 : (n < C_LR + 16 ? n - C_LR + 5120 : -1)); }
template <bool WIN> DI void transpose_item(const float* W, size_t ldw, bf16* WT, size_t ldt, int k0, int n0, int kd0, LAS float* scr, int lane) {
    const int kr = lane >> 3, nc = lane & 7; int sc = n0 + 4 * nc; if (WIN) sc = win_src_col(sc);
    const float* src = W + (size_t)(k0 + kr) * ldw + (sc < 0 ? 0 : sc);
    f32x4 v[8];
#pragma unroll
    for (int i = 0; i < 8; ++i) v[i] = *(const f32x4*)(src + (size_t)(8 * i) * ldw);
#pragma unroll
    for (int i = 0; i < 8; ++i) { LAS float* d = scr + (8 * i + kr) * 33 + 4 * nc; const f32x4 x = (sc < 0) ? (f32x4){0.f, 0.f, 0.f, 0.f} : v[i]; d[0] = x.x; d[1] = x.y; d[2] = x.z; d[3] = x.w; }
    LDS_WAIT();
    const int c = lane & 7;
#pragma unroll
    for (int j = 0; j < 4; ++j) { const int n = (lane >> 3) + 8 * j; const LAS float* s = scr + (8 * c) * 33 + n;
        u32x4 o; o.x = pk2(s[0 * 33], s[1 * 33]); o.y = pk2(s[2 * 33], s[3 * 33]); o.z = pk2(s[4 * 33], s[5 * 33]); o.w = pk2(s[6 * 33], s[7 * 33]);
        *(u32x4*)(WT + (size_t)(n0 + n) * ldt + kd0 + 8 * c) = o; }
    LDS_WAIT();
}
DI void transpose_item_f8(const float* W, size_t ldw, unsigned char* WT, size_t ldt, int k0, int n0, LAS float* scr, int lane) {
    const int kr = lane >> 3, nc = lane & 7; const int sc = win_src_col(n0 + 4 * nc);
    const float* src = W + (size_t)(k0 + kr) * ldw + sc;
#pragma unroll
    for (int h = 0; h < 2; ++h) {
        f32x4 v[8];
#pragma unroll
        for (int i = 0; i < 8; ++i) v[i] = *(const f32x4*)(src + (size_t)(64 * h + 8 * i) * ldw);
#pragma unroll
        for (int i = 0; i < 8; ++i) { LAS float* d = scr + (64 * h + 8 * i + kr) * 33 + 4 * nc; d[0] = v[i].x * W8_SCALE; d[1] = v[i].y * W8_SCALE; d[2] = v[i].z * W8_SCALE; d[3] = v[i].w * W8_SCALE; }
    }
    LDS_WAIT();
    const int c = lane & 7;
#pragma unroll
    for (int j = 0; j < 4; ++j) { const int n = (lane >> 3) + 8 * j; const LAS float* s = scr + (16 * c) * 33 + n;
        u32x4 o; o.x = pk4_fp8(s[0 * 33], s[1 * 33], s[2 * 33], s[3 * 33]); o.y = pk4_fp8(s[4 * 33], s[5 * 33], s[6 * 33], s[7 * 33]);
        o.z = pk4_fp8(s[8 * 33], s[9 * 33], s[10 * 33], s[11 * 33]); o.w = pk4_fp8(s[12 * 33], s[13 * 33], s[14 * 33], s[15 * 33]);
        *(u32x4*)(WT + (size_t)(n0 - C_MG + n) * ldt + k0 + 16 * c) = o; }
    LDS_WAIT();
}
DI void prologue(const Frame& F, const float* x, const float* mem, const int* pos, const float* w_in, const float* w_pool, const float* w_mem_kv, const float* w_branch, const float* w_out) {
    LAS float* scr = (LAS float*)(F.lds + F.wave * 17408);
    const int gw = F.wg * NWAVES + F.wave, NGW = F.G * NWAVES, lane = F.lane;
    constexpr int I_IN = 64 * (NH / 32), I_KV = 64 * 64, I_BR = 16 * 128, I_OUT = 64 * 128, I_PL = 4 * 8;
    constexpr int NITEMS = 2 * I_IN + 2 * I_KV + 8 * I_BR + 2 * I_OUT + 8 * I_PL;
    for (int it = gw; it < NITEMS; it += NGW) {
        int r = it;
        if (r < 2 * I_IN) { const int l = r / I_IN; r -= l * I_IN; const int nb = r >> 6, kb = r & 63;
            if (nb * 32 >= C_MG && nb * 32 < C_LR) { if ((kb & 1) == 0) transpose_item_f8(w_in + (size_t)l * 4096 * D_IN, D_IN, wsp<unsigned char>(F, WS_W8) + (size_t)l * 16384 * 4096, 4096, kb * 64, nb * 32, scr, lane); }
            else transpose_item<true>(w_in + (size_t)l * 4096 * D_IN, D_IN, wsp<bf16>(F, WS_WINT) + (size_t)l * NH * 4096, 4096, kb * 64, nb * 32, kb * 64, scr, lane);
            continue; }
        r -= 2 * I_IN;
        if (r < 2 * I_KV) { const int l = r / I_KV; r -= l * I_KV; const int nb = r >> 6, kb = r & 63;
            transpose_item<false>(w_mem_kv + (size_t)l * 4096 * 2048, 2048, wsp<bf16>(F, WS_WMKVT) + (size_t)l * 2048 * 4096, 4096, kb * 64, nb * 32, kb * 64, scr, lane); continue; }
        r -= 2 * I_KV;
        if (r < 8 * I_BR) { const int lb = r / I_BR; r -= lb * I_BR; const int l = lb >> 2, bi = lb & 3; const int nb = r >> 4, kb = r & 15;
            transpose_item<false>(w_branch + (size_t)lb * 1024 * 4096, 4096, wsp<bf16>(F, WS_WBRT) + (size_t)l * 4096 * 4096, 4096, kb * 64, nb * 32, bi * 1024 + kb * 64, scr, lane); continue; }
        r -= 8 * I_BR;
        if (r < 2 * I_OUT) { const int l = r / I_OUT; r -= l * I_OUT; const int nb = r >> 6, kb = r & 63;
            transpose_item<false>(w_out + (size_t)l * 4096 * 4096, 4096, wsp<bf16>(F, WS_WOUTT) + (size_t)l * 4096 * 4096, 4096, kb * 64, nb * 32, kb * 64, scr, lane); continue; }
        r -= 2 * I_OUT;
        { const int lg = r / I_PL; r -= lg * I_PL; const int nb = r >> 2, kb = r & 3;
            transpose_item<false>(w_pool + (size_t)lg * 256 * 256, 256, wsp<bf16>(F, WS_WPOOLT) + (size_t)lg * 256 * 256, 256, kb * 64, nb * 32, kb * 64, scr, lane); }
    }
    const size_t gt = (size_t)F.wg * NTHR + F.tid, GT = (size_t)F.G * NTHR;
    { const f32x4* xs = (const f32x4*)x; u32x4* xd = wsp<u32x4>(F, WS_XB);
      u32x2* x8 = wsp<u32x2>(F, WS_X8);
      for (size_t i = gt; i < (size_t)MTOK * DM / 8; i += GT) { const f32x4 a = xs[2 * i], b = xs[2 * i + 1]; u32x4 o; o.x = pk2(a.x, a.y); o.y = pk2(a.z, a.w); o.z = pk2(b.x, b.y); o.w = pk2(b.z, b.w); xd[i] = o;
          u32x2 q; q.x = pk4_fp8(a.x * X8_SCALE, a.y * X8_SCALE, a.z * X8_SCALE, a.w * X8_SCALE); q.y = pk4_fp8(b.x * X8_SCALE, b.y * X8_SCALE, b.z * X8_SCALE, b.w * X8_SCALE); x8[i] = q; }
      const f32x4* ms = (const f32x4*)mem; u32x4* md = wsp<u32x4>(F, WS_MEMB);
      for (size_t i = gt; i < (size_t)BATCH * MEMLEN * DM / 8; i += GT) { const f32x4 a = ms[2 * i], b = ms[2 * i + 1]; u32x4 o; o.x = pk2(a.x, a.y); o.y = pk2(a.z, a.w); o.z = pk2(b.x, b.y); o.w = pk2(b.z, b.w); md[i] = o; } }
    { f32x2* rt = wsp<f32x2>(F, WS_ROPE);
      for (size_t i = gt; i < (size_t)MTOK * 8; i += GT) { const int t = (int)(i >> 3), fi = (int)(i & 7);
          const float inv = (float)pow(500000.0, -(double)fi / 8.0); const float ang = (float)pos[t] * inv;
          rt[i] = (f32x2){cosf(ang), sinf(ang)}; } }
}

DI float fexp(float x) { return __builtin_amdgcn_exp2f(x * 1.44269504089f); }
DI float logsigmoid_f(float z) { return fminf(z, 0.f) - 0.69314718056f * __builtin_amdgcn_logf(1.0f + fexp(-fabsf(z))); }

DI void gla_a_unit(const Frame& F, int l, int unit, const float* w_gla_up, const float* b_gla) {
    const int bh = unit >> 6, c = unit & 63, b = bh >> 2, h = bh & 3, t0 = b * SEQ + c * 64, tid = F.tid, lane = F.lane, wave = F.wave;
    const bf16* H = wsp<bf16>(F, WS_H);
    LAS float* lrs = (LAS float*)(F.lds);
    LAS float* bcs = (LAS float*)(F.lds + 4096);
    LAS float* seg = (LAS float*)(F.lds + 36864);
    LAS bf16* kds = (LAS bf16*)(F.lds + 40960);
    LAS bf16* vs = (LAS bf16*)(F.lds + 59392);
    constexpr int LDK = 136, LDV = 264;
    __syncthreads();
    if (tid < 128) { const int j = tid >> 1, hf = tid & 1; const u32x4 w = *(const u32x4*)(H + (size_t)(t0 + j) * NH + C_LR + 8 * hf); float f[8]; unpack8(w, f);
#pragma unroll
        for (int i = 0; i < 8; ++i) lrs[j * 16 + 8 * hf + i] = f[i]; }
    for (int p = tid; p < 64 * 32; p += NTHR) { const int j = p >> 5, ch = p & 31; *(LAS u32x4*)(vs + j * LDV + 8 * ch) = *(const u32x4*)(H + (size_t)(t0 + j) * NH + C_GV + h * 256 + 8 * ch); }
    __syncthreads();
    const int d = tid & 127, sg = tid >> 7;
    { float w[16];
#pragma unroll
      for (int r = 0; r < 16; ++r) w[r] = w_gla_up[(size_t)l * 16 * 512 + r * 512 + h * 128 + d];
      const float bg = b_gla[l * 512 + h * 128 + d]; float run = 0.f;
      for (int jj = 0; jj < 16; ++jj) { const int j = sg * 16 + jj; float z = bg;
#pragma unroll
          for (int r = 0; r < 16; ++r) z += lrs[j * 16 + r] * w[r];
          run += logsigmoid_f(z) * (1.0f / 16.0f); bcs[j * 128 + d] = run; }
      seg[sg * 128 + d] = run; }
    __syncthreads();
    { float pre = 0.f;
      for (int s = 0; s < sg; ++s) pre += seg[s * 128 + d];
      float* GB = wsp<float>(F, WS_GB);
      for (int jj = 0; jj < 16; ++jj) { const int j = sg * 16 + jj; const float v = bcs[j * 128 + d] + pre; bcs[j * 128 + d] = v; GB[(size_t)(t0 + j) * 512 + h * 128 + d] = v; }
      if (sg == 3) wsp<float>(F, WS_DEC)[(size_t)unit * 128 + d] = expf(bcs[63 * 128 + d]); }
    __syncthreads();
    for (int p = tid; p < 64 * 16; p += NTHR) { const int j = p >> 4, ch = p & 15; const u32x4 w = *(const u32x4*)(H + (size_t)(t0 + j) * NH + C_GK + h * 128 + 8 * ch); float f[8]; unpack8(w, f);
#pragma unroll
        for (int i = 0; i < 8; ++i) f[i] *= fexp(bcs[63 * 128 + 8 * ch + i] - bcs[j * 128 + 8 * ch + i]);
        *(LAS u32x4*)(kds + j * LDK + 8 * ch) = pack8(f); }
    __syncthreads();
    f32x4 acc[2][8];
#pragma unroll
    for (int a = 0; a < 2; ++a)
#pragma unroll
        for (int n = 0; n < 8; ++n) acc[a][n] = (f32x4){0.f, 0.f, 0.f, 0.f};
#pragma unroll
    for (int ks = 0; ks < 2; ++ks) {
        bf16x8 af[2];
#pragma unroll
        for (int a = 0; a < 2; ++a) af[a] = frag_tr(vs, LDV, 32 * ks, 32 * wave + 16 * a, lane);
#pragma unroll
        for (int n = 0; n < 8; ++n) { const bf16x8 bfr = frag_tr(kds, LDK, 32 * ks, 16 * n, lane);
#pragma unroll
            for (int a = 0; a < 2; ++a) acc[a][n] = mma16(bfr, af[a], acc[a][n]); }
    }
    float* U = wsp<float>(F, WS_GU) + (size_t)unit * 256 * 128;
#pragma unroll
    for (int a = 0; a < 2; ++a)
#pragma unroll
        for (int n = 0; n < 8; ++n) *(f32x4*)(U + (size_t)(32 * wave + 16 * a + (lane & 15)) * 128 + 16 * n + 4 * (lane >> 4)) = acc[a][n];
}

DI void gla_scan(const Frame& F) {
    const float* U = wsp<float>(F, WS_GU); const float* DEC = wsp<float>(F, WS_DEC); unsigned* S = wsp<unsigned>(F, WS_GS);
    const int gt = F.wg * NTHR + F.tid, GT = F.G * NTHR;
    for (int it = gt; it < 8 * 256 * 64; it += GT) {
        const int bh = it >> 14, r = it & 16383, e = r >> 6, dp = r & 63;
        float s0 = 0.f, s1 = 0.f;
#pragma unroll 8
        for (int c = 0; c < 64; ++c) { const size_t un = (size_t)bh * 64 + c; const size_t o = (un * 256 + e) * 128 + 2 * dp;
            const f32x2 u = *(const f32x2*)(U + o); const f32x2 dc = *(const f32x2*)(DEC + un * 128 + 2 * dp);
            S[o >> 1] = pk2(s0, s1); s0 = dc.x * s0 + u.x; s1 = dc.y * s1 + u.y; }
    }
}

DI void gla_c_unit(const Frame& F, int l, int unit, const float* gla_norm) {
    const int bh = unit >> 6, c = unit & 63, b = bh >> 2, h = bh & 3, t0 = b * SEQ + c * 64, tid = F.tid, lane = F.lane, wave = F.wave;
    const bf16* H = wsp<bf16>(F, WS_H);
    LAS bf16* qs = (LAS bf16*)(F.lds);
    LAS bf16* ks = (LAS bf16*)(F.lds + 17408);
    LAS bf16* vs = (LAS bf16*)(F.lds + 34816);
    LAS bf16* ps = (LAS bf16*)(F.lds + 68608);
    LAS float* red = (LAS float*)(F.lds + 77824);
    constexpr int LDK = 136, LDV = 264, LDP = 72;
    __syncthreads();
    const float* GB = wsp<float>(F, WS_GB);
    for (int p = tid; p < 64 * 16; p += NTHR) { const int j = p >> 4, ch = p & 15;
        const u32x4 qw = *(const u32x4*)(H + (size_t)(t0 + j) * NH + C_GQ + h * 128 + 8 * ch); const u32x4 kw = *(const u32x4*)(H + (size_t)(t0 + j) * NH + C_GK + h * 128 + 8 * ch);
        const f32x4 b0 = *(const f32x4*)(GB + (size_t)(t0 + j) * 512 + h * 128 + 8 * ch), b1 = *(const f32x4*)(GB + (size_t)(t0 + j) * 512 + h * 128 + 8 * ch + 4);
        float q[8], k[8]; unpack8(qw, q); unpack8(kw, k); const float bb[8] = {b0.x, b0.y, b0.z, b0.w, b1.x, b1.y, b1.z, b1.w};
#pragma unroll
        for (int i = 0; i < 8; ++i) { const float eb = fexp(bb[i]); q[i] *= eb * 0.08838834764831845f; k[i] *= fexp(-bb[i]); }
        *(LAS u32x4*)(qs + j * LDK + 8 * ch) = pack8(q); *(LAS u32x4*)(ks + j * LDK + 8 * ch) = pack8(k); }
    for (int p = tid; p < 64 * 32; p += NTHR) { const int j = p >> 5, ch = p & 31; *(LAS u32x4*)(vs + j * LDV + 8 * ch) = *(const u32x4*)(H + (size_t)(t0 + j) * NH + C_GV + h * 256 + 8 * ch); }
    __syncthreads();
    { const int it = wave >> 1; f32x4 sa[2] = {(f32x4){0.f, 0.f, 0.f, 0.f}, (f32x4){0.f, 0.f, 0.f, 0.f}};
#pragma unroll
      for (int kk = 0; kk < 4; ++kk) { const bf16x8 qa = frag_lds(qs, LDK, 16 * it, 32 * kk, lane);
#pragma unroll
          for (int jj = 0; jj < 2; ++jj) sa[jj] = mma16(qa, frag_lds(ks, LDK, 16 * (2 * (wave & 1) + jj), 32 * kk, lane), sa[jj]); }
#pragma unroll
      for (int jj = 0; jj < 2; ++jj)
#pragma unroll
          for (int r = 0; r < 4; ++r) { const int i = 16 * it + 4 * (lane >> 4) + r, j = 16 * (2 * (wave & 1) + jj) + (lane & 15);
              ps[i * LDP + j] = (bf16)f2bf(j <= i ? sa[jj][r] : 0.f); } }
    __syncthreads();
    f32x4 acc[2][4];
#pragma unroll
    for (int a = 0; a < 2; ++a)
#pragma unroll
        for (int n = 0; n < 4; ++n) acc[a][n] = (f32x4){0.f, 0.f, 0.f, 0.f};
    const bf16* St = wsp<bf16>(F, WS_GS) + (size_t)unit * 256 * 128;
#pragma unroll
    for (int kk = 0; kk < 4; ++kk) { bf16x8 af[2];
#pragma unroll
        for (int a = 0; a < 2; ++a) af[a] = frag_glb(St, 128, 32 * wave + 16 * a, 32 * kk, lane);
#pragma unroll
        for (int n = 0; n < 4; ++n) { const bf16x8 bq = frag_lds(qs, LDK, 16 * n, 32 * kk, lane);
#pragma unroll
            for (int a = 0; a < 2; ++a) acc[a][n] = mma16(af[a], bq, acc[a][n]); } }
#pragma unroll
    for (int kk = 0; kk < 2; ++kk) { bf16x8 af[2];
#pragma unroll
        for (int a = 0; a < 2; ++a) af[a] = frag_tr(vs, LDV, 32 * kk, 32 * wave + 16 * a, lane);
#pragma unroll
        for (int n = 0; n < 4; ++n) { const bf16x8 bp = frag_lds(ps, LDP, 16 * n, 32 * kk, lane);
#pragma unroll
            for (int a = 0; a < 2; ++a) acc[a][n] = mma16(af[a], bp, acc[a][n]); } }
#pragma unroll
    for (int n = 0; n < 4; ++n) { float s = 0.f;
#pragma unroll
        for (int a = 0; a < 2; ++a)
#pragma unroll
            for (int r = 0; r < 4; ++r) s += acc[a][n][r] * acc[a][n][r];
        s += __shfl_xor(s, 16); s += __shfl_xor(s, 32);
        if (lane < 16) red[wave * 64 + 16 * n + lane] = s; }
    __syncthreads();
    bf16* OB = wsp<bf16>(F, WS_OB);
#pragma unroll
    for (int n = 0; n < 4; ++n) { const int i = 16 * n + (lane & 15); float tot = 0.f;
#pragma unroll
        for (int w = 0; w < 8; ++w) tot += red[w * 64 + i];
        const float rs = 1.0f / sqrtf(tot * (1.0f / 256.0f) + LN_EPS);
#pragma unroll
        for (int a = 0; a < 2; ++a) { const int e = 32 * wave + 16 * a + 4 * (lane >> 4);
            const f32x4 gn = *(const f32x4*)(gla_norm + l * 1024 + h * 256 + e);
            const u32x2 gw = *(const u32x2*)(H + (size_t)(t0 + i) * NH + C_GG + h * 256 + e);
            const float g0 = bf2f(gw.x & 0xffffu), g1 = bf2f(gw.x >> 16), g2 = bf2f(gw.y & 0xffffu), g3 = bf2f(gw.y >> 16);
            u32x2 o; o.x = pk2(acc[a][n][0] * rs * gn.x * g0, acc[a][n][1] * rs * gn.y * g1); o.y = pk2(acc[a][n][2] * rs * gn.z * g2, acc[a][n][3] * rs * gn.w * g3);
            *(u32x2*)(OB + (size_t)(t0 + i) * DM + 1024 + h * 256 + e) = o; } }
}

DI void pool_unit(const Frame& F, int l, int unit, const float* pool_scale) {
    const int gi = unit & 3, tt = unit >> 2, t0 = tt * 128, tid = F.tid, lane = F.lane, wave = F.wave, w = 2 << gi;
    const bf16* H = wsp<bf16>(F, WS_H);
    LAS bf16* pl = (LAS bf16*)(F.lds);
    constexpr int LDP = 264;
    __syncthreads();
    for (int p = tid; p < 128 * 32; p += NTHR) { const int j = p >> 5, ch = p & 31, t = t0 + j, ts = t & (SEQ - 1);
        const int cnt = (ts + 1 < w) ? ts + 1 : w; float a[8];
#pragma unroll
        for (int i = 0; i < 8; ++i) a[i] = 0.f;
        float u0[8];
        const bf16* hp = H + (size_t)t * NH + C_PU + gi * 256 + 8 * ch;
        { float f[8]; unpack8(*(const u32x4*)hp, f);
#pragma unroll
          for (int i = 0; i < 8; ++i) { a[i] = f[i]; u0[i] = f[i]; } }
#pragma unroll
        for (int s = 1; s < 16; ++s) if (s < w) { const int sb = (s < cnt) ? s : 0;
            const u32x4 x = *(const u32x4*)(hp - (size_t)sb * NH); float f[8]; unpack8(x, f); const float wgt = (s < cnt) ? 1.f : 0.f;
#pragma unroll
            for (int i = 0; i < 8; ++i) a[i] += wgt * f[i]; }
        const float ic = 1.0f / (float)cnt;
#pragma unroll
        for (int i = 0; i < 8; ++i) a[i] = a[i] * ic - u0[i];
        *(LAS u32x4*)(pl + j * LDP + 8 * ch) = pack8(a); }
    __syncthreads();
    const bf16* WP = wsp<bf16>(F, WS_WPOOLT) + (size_t)(l * 4 + gi) * 256 * 256;
    f32x4 acc[2][8];
#pragma unroll
    for (int a = 0; a < 2; ++a)
#pragma unroll
        for (int n = 0; n < 8; ++n) acc[a][n] = (f32x4){0.f, 0.f, 0.f, 0.f};
#pragma unroll 2
    for (int kk = 0; kk < 8; ++kk) { bf16x8 af[2];
#pragma unroll
        for (int a = 0; a < 2; ++a) af[a] = frag_glb(WP, 256, 32 * wave + 16 * a, 32 * kk, lane);
#pragma unroll
        for (int n = 0; n < 8; ++n) { const bf16x8 bp = frag_lds(pl, LDP, 16 * n, 32 * kk, lane);
#pragma unroll
            for (int a = 0; a < 2; ++a) acc[a][n] = mma16(af[a], bp, acc[a][n]); } }
    bf16* OB = wsp<bf16>(F, WS_OB);
#pragma unroll
    for (int n = 0; n < 8; ++n) { const int t = t0 + 16 * n + (lane & 15);
#pragma unroll
        for (int a = 0; a < 2; ++a) { const int dd = gi * 256 + 32 * wave + 16 * a + 4 * (lane >> 4);
            const f32x4 sc = *(const f32x4*)(pool_scale + l * 1024 + dd);
            const u32x2 gw = *(const u32x2*)(H + (size_t)t * NH + C_PG + dd);
            const float g0 = bf2f(gw.x & 0xffffu), g1 = bf2f(gw.x >> 16), g2 = bf2f(gw.y & 0xffffu), g3 = bf2f(gw.y >> 16);
            u32x2 o; o.x = pk2(acc[a][n][0] * sc.x * g0, acc[a][n][1] * sc.y * g1); o.y = pk2(acc[a][n][2] * sc.z * g2, acc[a][n][3] * sc.w * g3);
            *(u32x2*)(OB + (size_t)t * DM + dd) = o; } }
}

DI void swa_unit(const Frame& F, int l, int unit, const float* sinks) {
    const int n = unit & 31, hq = (unit >> 5) & 15, b = unit >> 9, kvh = hq >> 3, tid = F.tid, lane = F.lane, wave = F.wave;
    const int tq0 = b * SEQ + n * 128, tk0 = tq0 - 128;
    const bf16* H = wsp<bf16>(F, WS_H); const f32x2* RT = wsp<f32x2>(F, WS_ROPE);
    constexpr int LD = 72, LDPW = 168;
    LAS bf16* qs = (LAS bf16*)(F.lds);
    LAS bf16* ks = (LAS bf16*)(F.lds + 18432);
    LAS bf16* vs = (LAS bf16*)(F.lds + 57600);
    LAS bf16* pw = (LAS bf16*)(F.lds + 96768) + wave * 16 * LDPW;
    __syncthreads();
    for (int p = tid; p < 128 * 4; p += NTHR) { const int i = p >> 2, ch = p & 3; const bf16* src = H + (size_t)(tq0 + i) * NH + C_SQ + hq * 64 + 16 * ch;
        float f[16]; { float a[8], c[8]; unpack8(*(const u32x4*)src, a); unpack8(*(const u32x4*)(src + 8), c);
#pragma unroll
            for (int j = 0; j < 8; ++j) { f[j] = a[j]; f[8 + j] = c[j]; } }
        if (ch == 0) {
#pragma unroll
            for (int j = 0; j < 8; ++j) { const f32x2 cs = RT[(size_t)(tq0 + i) * 8 + j]; const float x1 = f[j], x2 = f[8 + j]; f[j] = x1 * cs.x - x2 * cs.y; f[8 + j] = x2 * cs.x + x1 * cs.y; } }
        float o0[8], o1[8];
#pragma unroll
        for (int j = 0; j < 8; ++j) { o0[j] = f[j] * 0.125f; o1[j] = f[8 + j] * 0.125f; }
        *(LAS u32x4*)(qs + i * LD + 16 * ch) = pack8(o0); *(LAS u32x4*)(qs + i * LD + 16 * ch + 8) = pack8(o1); }
    for (int p = tid; p < 272 * 4; p += NTHR) { const int j = p >> 2, ch = p & 3; const bool ok = (j < 256) && (n > 0 || j >= 128);
        u32x4 k0 = (u32x4){0u, 0u, 0u, 0u}, k1 = k0, v0 = k0, v1 = k0;
        if (ok) { const bf16* ksrc = H + (size_t)(tk0 + j) * NH + C_SK + kvh * 64 + 16 * ch; const bf16* vsrc = H + (size_t)(tk0 + j) * NH + C_SV + kvh * 64 + 16 * ch;
            k0 = *(const u32x4*)ksrc; k1 = *(const u32x4*)(ksrc + 8); v0 = *(const u32x4*)vsrc; v1 = *(const u32x4*)(vsrc + 8);
            if (ch == 0) { float a[8], c[8]; unpack8(k0, a); unpack8(k1, c);
#pragma unroll
                for (int jj = 0; jj < 8; ++jj) { const f32x2 cs = RT[(size_t)(tk0 + j) * 8 + jj]; const float x1 = a[jj], x2 = c[jj]; a[jj] = x1 * cs.x - x2 * cs.y; c[jj] = x2 * cs.x + x1 * cs.y; }
                k0 = pack8(a); k1 = pack8(c); } }
        *(LAS u32x4*)(ks + j * LD + 16 * ch) = k0; *(LAS u32x4*)(ks + j * LD + 16 * ch + 8) = k1;
        *(LAS u32x4*)(vs + j * LD + 16 * ch) = v0; *(LAS u32x4*)(vs + j * LD + 16 * ch + 8) = v1; }
    __syncthreads();
    const int qi = 16 * wave + (lane & 15);
    bf16x8 qf[2];
#pragma unroll
    for (int s = 0; s < 2; ++s) qf[s] = frag_lds(qs, LD, 16 * wave, 32 * s, lane);
    f32x4 sc[10];
#pragma unroll
    for (int jt = 0; jt < 10; ++jt) { sc[jt] = (f32x4){0.f, 0.f, 0.f, 0.f};
#pragma unroll
        for (int s = 0; s < 2; ++s) sc[jt] = mma16(frag_lds(ks, LD, 16 * (wave + jt), 32 * s, lane), qf[s], sc[jt]); }
    const float sink = sinks[l * 16 + hq];
    float mx = sink;
#pragma unroll
    for (int jt = 0; jt < 10; ++jt)
#pragma unroll
        for (int r = 0; r < 4; ++r) { const int kj = 16 * (wave + jt) + 4 * (lane >> 4) + r; const bool ok = (kj > qi) && (kj <= qi + 128) && (n > 0 || kj >= 128);
            sc[jt][r] = ok ? sc[jt][r] : -INFINITY; mx = fmaxf(mx, sc[jt][r]); }
    mx = fmaxf(mx, __shfl_xor(mx, 16)); mx = fmaxf(mx, __shfl_xor(mx, 32));
    float sum = 0.f;
#pragma unroll
    for (int jt = 0; jt < 10; ++jt)
#pragma unroll
        for (int r = 0; r < 4; ++r) { const float p = fexp(sc[jt][r] - mx); sc[jt][r] = p; sum += p; }
    sum += __shfl_xor(sum, 16); sum += __shfl_xor(sum, 32);
    const float inv = 1.0f / (sum + fexp(sink - mx));
#pragma unroll
    for (int jt = 0; jt < 10; ++jt) { u32x2 o; o.x = pk2(sc[jt][0] * inv, sc[jt][1] * inv); o.y = pk2(sc[jt][2] * inv, sc[jt][3] * inv);
        *(LAS u32x2*)(pw + (lane & 15) * LDPW + 16 * jt + 4 * (lane >> 4)) = o; }
    LDS_WAIT();
    f32x4 oa[4];
#pragma unroll
    for (int dt = 0; dt < 4; ++dt) oa[dt] = (f32x4){0.f, 0.f, 0.f, 0.f};
#pragma unroll
    for (int s = 0; s < 5; ++s) { const bf16x8 pf = frag_lds(pw, LDPW, 0, 32 * s, lane);
#pragma unroll
        for (int dt = 0; dt < 4; ++dt) oa[dt] = mma16(frag_tr(vs, LD, 16 * wave + 32 * s, 16 * dt, lane), pf, oa[dt]); }
    bf16* OB = wsp<bf16>(F, WS_OB);
    { const int t = tq0 + qi;
#pragma unroll
      for (int dt = 0; dt < 4; ++dt) { const int dd = hq * 64 + 16 * dt + 4 * (lane >> 4);
          const u32x2 gw = *(const u32x2*)(H + (size_t)t * NH + C_SG + dd);
          const float g0 = bf2f(gw.x & 0xffffu), g1 = bf2f(gw.x >> 16), g2 = bf2f(gw.y & 0xffffu), g3 = bf2f(gw.y >> 16);
          u32x2 o; o.x = pk2(oa[dt][0] * g0, oa[dt][1] * g1); o.y = pk2(oa[dt][2] * g2, oa[dt][3] * g3);
          *(u32x2*)(OB + (size_t)t * DM + 2048 + dd) = o; } }
}

DI void mem_unit(const Frame& F, int l, int unit) {
    const int n = unit & 31, hx = (unit >> 5) & 3, b = unit >> 7, lane = F.lane, wave = F.wave, tid = F.tid;
    const int tq0 = b * SEQ + n * 128 + 16 * wave;
    const bf16* H = wsp<bf16>(F, WS_H);
    const bf16* MK = wsp<bf16>(F, WS_MK) + (size_t)l * 512 * 1024 + (size_t)b * 256 * 1024 + hx * 256;
    const bf16* MVT = wsp<bf16>(F, WS_MVT) + (size_t)l * 1024 * 512 + (size_t)hx * 256 * 512 + b * 256;
    constexpr int LDI = 264;
    LAS bf16* img = (LAS bf16*)(F.lds);
    __syncthreads();
#pragma unroll 4
    for (int p = tid; p < 256 * 32; p += NTHR) { const int r = p >> 5, ch = p & 31; *(LAS u32x4*)(img + r * LDI + 8 * ch) = *(const u32x4*)(MK + (size_t)r * 1024 + 8 * ch); }
    bf16x8 qf[8];
#pragma unroll
    for (int s = 0; s < 8; ++s) qf[s] = frag_glb(H + C_XQ + hx * 256, NH, tq0, 32 * s, lane);
    __syncthreads();
    f32x4 sc[16];
#pragma unroll
    for (int jt = 0; jt < 16; ++jt) { sc[jt] = (f32x4){0.f, 0.f, 0.f, 0.f};
#pragma unroll
        for (int s = 0; s < 8; ++s) sc[jt] = mma16(frag_lds(img, LDI, 16 * jt, 32 * s, lane), qf[s], sc[jt]);
        if (jt & 1) __builtin_amdgcn_sched_barrier(0); }
#pragma unroll
    for (int jt = 0; jt < 16; ++jt) asm volatile("" : "+v"(sc[jt]));
    __syncthreads();
#pragma unroll 4
    for (int p = tid; p < 256 * 32; p += NTHR) { const int r = p >> 5, ch = p & 31; *(LAS u32x4*)(img + r * LDI + 8 * ch) = *(const u32x4*)(MVT + (size_t)r * 512 + 8 * ch); }
    float mx = -INFINITY;
#pragma unroll
    for (int jt = 0; jt < 16; ++jt)
#pragma unroll
        for (int r = 0; r < 4; ++r) { sc[jt][r] *= 0.0625f; mx = fmaxf(mx, sc[jt][r]); }
    mx = fmaxf(mx, __shfl_xor(mx, 16)); mx = fmaxf(mx, __shfl_xor(mx, 32));
    float sum = 0.f;
#pragma unroll
    for (int jt = 0; jt < 16; ++jt)
#pragma unroll
        for (int r = 0; r < 4; ++r) { const float p = __builtin_amdgcn_exp2f((sc[jt][r] - mx) * 1.44269504089f); sc[jt][r] = p; sum += p; }
    sum += __shfl_xor(sum, 16); sum += __shfl_xor(sum, 32);
    const float inv = 1.0f / sum;
    bf16x8 pb[8];
#pragma unroll
    for (int s = 0; s < 8; ++s) { u32x4 w; w.x = pk2(sc[2 * s][0] * inv, sc[2 * s][1] * inv); w.y = pk2(sc[2 * s][2] * inv, sc[2 * s][3] * inv);
        w.z = pk2(sc[2 * s + 1][0] * inv, sc[2 * s + 1][1] * inv); w.w = pk2(sc[2 * s + 1][2] * inv, sc[2 * s + 1][3] * inv); pb[s] = __builtin_bit_cast(bf16x8, w); }
    __syncthreads();
    bf16* OB = wsp<bf16>(F, WS_OB); const int t = tq0 + (lane & 15);
    const LAS bf16* arow = img + (lane & 15) * LDI + 4 * (lane >> 4);
#pragma unroll 4
    for (int dt = 0; dt < 16; ++dt) { f32x4 oa = (f32x4){0.f, 0.f, 0.f, 0.f};
#pragma unroll
        for (int s = 0; s < 8; ++s) { const u32x2 lo = *(const LAS u32x2*)(arow + 16 * dt * LDI + 32 * s), hi = *(const LAS u32x2*)(arow + 16 * dt * LDI + 32 * s + 16);
            const u32x4 av = (u32x4){lo.x, lo.y, hi.x, hi.y};
            oa = mma16(__builtin_bit_cast(bf16x8, av), pb[s], oa); }
        __builtin_amdgcn_sched_barrier(0);
        const int dd = hx * 256 + 16 * dt + 4 * (lane >> 4);
        const u32x2 gw = *(const u32x2*)(H + (size_t)t * NH + C_XG + dd);
        const float g0 = bf2f(gw.x & 0xffffu), g1 = bf2f(gw.x >> 16), g2 = bf2f(gw.y & 0xffffu), g3 = bf2f(gw.y >> 16);
        u32x2 o; o.x = pk2(oa[0] * g0, oa[1] * g1); o.y = pk2(oa[2] * g2, oa[3] * g3);
        *(u32x2*)(OB + (size_t)t * DM + 3072 + dd) = o; }
}

#ifndef NAIVE_MASK
#define NAIVE_MASK 0
#endif
DI float Hf(const bf16* H, size_t row, int col) { return bf2f(H[row * NH + col]); }
DI void naive_mem(const Frame& F, int l) {
    const bf16* H = wsp<bf16>(F, WS_H); bf16* OB = wsp<bf16>(F, WS_OB);
    LAS float* qs = (LAS float*)(F.lds) + F.wave * 512; LAS float* ps = qs + 256;
    const int gw = F.wg * NWAVES + F.wave, NGW = F.G * NWAVES, lane = F.lane;
    for (int it = gw; it < MTOK * 4; it += NGW) {
        const int t = it >> 2, hx = it & 3, b = t / SEQ;
        const bf16* MK = wsp<bf16>(F, WS_MK) + (size_t)l * 512 * 1024 + (size_t)b * 256 * 1024 + hx * 256;
        const bf16* MVT = wsp<bf16>(F, WS_MVT) + (size_t)l * 1024 * 512 + (size_t)hx * 256 * 512 + b * 256;
        for (int i = 0; i < 4; ++i) qs[lane + 64 * i] = Hf(H, t, C_XQ + hx * 256 + lane + 64 * i);
        LDS_WAIT();
        float sc[4]; float mx = -INFINITY;
        for (int i = 0; i < 4; ++i) { const int j = lane + 64 * i; float a = 0.f; for (int d = 0; d < 256; ++d) a += qs[d] * bf2f(MK[(size_t)j * 1024 + d]); sc[i] = a * 0.0625f; mx = fmaxf(mx, sc[i]); }
        for (int o = 1; o < 64; o <<= 1) mx = fmaxf(mx, __shfl_xor(mx, o));
        float sum = 0.f; for (int i = 0; i < 4; ++i) { sc[i] = expf(sc[i] - mx); sum += sc[i]; }
        sum = wave_sum(sum);
        for (int i = 0; i < 4; ++i) ps[lane + 64 * i] = sc[i] / sum;
        LDS_WAIT();
        for (int i = 0; i < 4; ++i) { const int d = lane + 64 * i; float a = 0.f; for (int j = 0; j < 256; ++j) a += ps[j] * bf2f(MVT[(size_t)d * 512 + j]);
            OB[(size_t)t * DM + 3072 + hx * 256 + d] = (bf16)f2bf(a * Hf(H, t, C_XG + hx * 256 + d)); }
        LDS_WAIT();
    }
}
DI void naive_swa(const Frame& F, int l, const float* sinks) {
    const bf16* H = wsp<bf16>(F, WS_H); bf16* OB = wsp<bf16>(F, WS_OB); const f32x2* RT = wsp<f32x2>(F, WS_ROPE);
    LAS float* qs = (LAS float*)(F.lds) + F.wave * 256; LAS float* ps = qs + 64;
    const int gw = F.wg * NWAVES + F.wave, NGW = F.G * NWAVES, lane = F.lane;
    for (int it = gw; it < MTOK * 16; it += NGW) {
        const int t = it >> 4, hq = it & 15, kvh = hq >> 3, ts = t & (SEQ - 1);
        { float x = Hf(H, t, C_SQ + hq * 64 + lane);
          if (lane < 16) { const int i = lane & 7; const float x1 = Hf(H, t, C_SQ + hq * 64 + i), x2 = Hf(H, t, C_SQ + hq * 64 + 8 + i); const f32x2 cs = RT[(size_t)t * 8 + i];
              x = (lane < 8) ? x1 * cs.x - x2 * cs.y : x2 * cs.x + x1 * cs.y; }
          qs[lane] = x * 0.125f; }
        LDS_WAIT();
        float sc[2]; const float sink = sinks[l * 16 + hq]; float mx = sink;
        for (int i = 0; i < 2; ++i) { const int back = lane + 64 * i; sc[i] = -INFINITY;
            if (back <= ts) { const int tk = t - back; float a = 0.f;
                for (int d = 0; d < 64; ++d) { float kv = Hf(H, tk, C_SK + kvh * 64 + d);
                    if (d < 16) { const int ii = d & 7; const float x1 = Hf(H, tk, C_SK + kvh * 64 + ii), x2 = Hf(H, tk, C_SK + kvh * 64 + 8 + ii); const f32x2 cs = RT[(size_t)tk * 8 + ii];
                        kv = (d < 8) ? x1 * cs.x - x2 * cs.y : x2 * cs.x + x1 * cs.y; }
                    a += qs[d] * kv; }
                sc[i] = a; }
            mx = fmaxf(mx, sc[i]); }
        for (int o = 1; o < 64; o <<= 1) mx = fmaxf(mx, __shfl_xor(mx, o));
        float sum = 0.f; for (int i = 0; i < 2; ++i) { sc[i] = expf(sc[i] - mx); sum += sc[i]; }
        sum = wave_sum(sum) + expf(sink - mx);
        for (int i = 0; i < 2; ++i) ps[lane + 64 * i] = sc[i] / sum;
        LDS_WAIT();
        { float a = 0.f; const int nk = (ts + 1 < 128) ? ts + 1 : 128;
          for (int back = 0; back < nk; ++back) a += ps[back] * Hf(H, t - back, C_SV + kvh * 64 + lane);
          OB[(size_t)t * DM + 2048 + hq * 64 + lane] = (bf16)f2bf(a * Hf(H, t, C_SG + hq * 64 + lane)); }
        LDS_WAIT();
    }
}
DI void naive_pool(const Frame& F, int l, const float* w_pool, const float* pool_scale) {
    const bf16* H = wsp<bf16>(F, WS_H); bf16* OB = wsp<bf16>(F, WS_OB); LAS float* pl = (LAS float*)(F.lds);
    for (int unit = F.wg; unit < 512; unit += F.G) { const int gi = unit & 3, t0 = (unit >> 2) * 64, w = 2 << gi;
        __syncthreads();
        for (int p = F.tid; p < 64 * 256; p += NTHR) { const int j = p >> 8, c = p & 255, t = t0 + j, ts = t & (SEQ - 1); const int cnt = (ts + 1 < w) ? ts + 1 : w; float a = 0.f;
            for (int s2 = 0; s2 < cnt; ++s2) a += Hf(H, t - s2, C_PU + gi * 256 + c);
            pl[p] = a / (float)cnt - Hf(H, t, C_PU + gi * 256 + c); }
        __syncthreads();
        const float* W = w_pool + (size_t)(l * 4 + gi) * 256 * 256;
        for (int o = F.tid; o < 64 * 256; o += NTHR) { const int j = o >> 8, d = o & 255; float a = 0.f; for (int c = 0; c < 256; ++c) a += pl[j * 256 + c] * W[c * 256 + d];
            const int t = t0 + j; OB[(size_t)t * DM + gi * 256 + d] = (bf16)f2bf(a * pool_scale[l * 1024 + gi * 256 + d] * Hf(H, t, C_PG + gi * 256 + d)); } }
}
DI void naive_gla(const Frame& F, int l, const float* w_gla_up, const float* b_gla) {
    const bf16* H = wsp<bf16>(F, WS_H); float* RAW = wsp<float>(F, WS_GU); LAS float* red = (LAS float*)(F.lds);
    for (int unit = F.wg; unit < 64; unit += F.G) { const int bh = unit >> 3, es = unit & 7, b = bh >> 2, h = bh & 3, e = es * 32 + (F.tid & 31), dg = F.tid >> 5;
        float S[8], wu[8][16], bg[8];
        for (int i = 0; i < 8; ++i) { S[i] = 0.f; bg[i] = b_gla[l * 512 + h * 128 + 8 * dg + i]; for (int r = 0; r < 16; ++r) wu[i][r] = w_gla_up[(size_t)l * 16 * 512 + r * 512 + h * 128 + 8 * dg + i]; }
        for (int ts = 0; ts < SEQ; ++ts) { const size_t t = (size_t)b * SEQ + ts; float lr[16]; for (int r = 0; r < 16; ++r) lr[r] = Hf(H, t, C_LR + r);
            const float v = Hf(H, t, C_GV + h * 256 + e); float part = 0.f;
            for (int i = 0; i < 8; ++i) { float z = bg[i]; for (int r = 0; r < 16; ++r) z += lr[r] * wu[i][r];
                const float a = expf((fminf(z, 0.f) - log1pf(expf(-fabsf(z)))) * (1.0f / 16.0f));
                S[i] = a * S[i] + Hf(H, t, C_GK + h * 128 + 8 * dg + i) * v; part += Hf(H, t, C_GQ + h * 128 + 8 * dg + i) * 0.08838834764831845f * S[i]; }
            __syncthreads(); red[dg * 32 + (F.tid & 31)] = part; __syncthreads();
            if (dg == 0) { float o = 0.f; for (int g = 0; g < 16; ++g) o += red[g * 32 + (F.tid & 31)]; RAW[t * 1024 + h * 256 + e] = o; } } }
}
DI void naive_gla_norm(const Frame& F, int l, const float* gla_norm) {
    const bf16* H = wsp<bf16>(F, WS_H); bf16* OB = wsp<bf16>(F, WS_OB); const float* RAW = wsp<float>(F, WS_GU);
    const int gw = F.wg * NWAVES + F.wave, NGW = F.G * NWAVES, lane = F.lane;
    for (int it = gw; it < MTOK * 4; it += NGW) { const int t = it >> 2, h = it & 3; float o[4], ss = 0.f;
        for (int i = 0; i < 4; ++i) { o[i] = RAW[(size_t)t * 1024 + h * 256 + lane + 64 * i]; ss += o[i] * o[i]; }
        ss = wave_sum(ss); const float rs = 1.0f / sqrtf(ss * (1.0f / 256.0f) + LN_EPS);
        for (int i = 0; i < 4; ++i) { const int e = lane + 64 * i; OB[(size_t)t * DM + 1024 + h * 256 + e] = (bf16)f2bf(o[i] * rs * gla_norm[l * 1024 + h * 256 + e] * Hf(H, t, C_GG + h * 256 + e)); } }
}

DI void ln_phase(const Frame& F, int l, const float* ln_g, const float* ln_b) {
    const int gw = F.wg * NWAVES + F.wave, NGW = F.G * NWAVES, lane = F.lane;
    const float* g = ln_g + l * DM; const float* bb = ln_b + l * DM;
    for (int m = gw; m < MTOK; m += NGW) {
        f32x4* row = (f32x4*)(F.out + (size_t)m * DM) + lane; const f32x4* zrow = (const f32x4*)(wsp<float>(F, WS_Z) + (size_t)m * DM) + lane;
        f32x4 v[16]; float s = 0.f;
#pragma unroll
        for (int j = 0; j < 16; ++j) { v[j] = zrow[64 * j]; s += (v[j].x + v[j].y) + (v[j].z + v[j].w); }
        const float mean = wave_sum(s) * (1.f / DM); float s2 = 0.f;
#pragma unroll
        for (int j = 0; j < 16; ++j) { v[j] = v[j] - mean; s2 += (v[j].x * v[j].x + v[j].y * v[j].y) + (v[j].z * v[j].z + v[j].w * v[j].w); }
        const float rstd = 1.f / sqrtf(wave_sum(s2) * (1.f / DM) + LN_EPS);
        u32x2* xb = (u32x2*)(wsp<bf16>(F, WS_XB) + (size_t)m * DM) + lane; unsigned* x8 = (unsigned*)(wsp<unsigned char>(F, WS_X8) + (size_t)m * DM) + lane;
#pragma unroll
        for (int j = 0; j < 16; ++j) { const f32x4 gg = *((const f32x4*)g + lane + 64 * j), be = *((const f32x4*)bb + lane + 64 * j);
            const f32x4 o = v[j] * rstd * gg + be; row[64 * j] = o;
            if (l + 1 < DEPTH) { u32x2 w; w.x = pk2(o.x, o.y); w.y = pk2(o.z, o.w); xb[64 * j] = w; x8[64 * j] = pk4_fp8(o.x * X8_SCALE, o.y * X8_SCALE, o.z * X8_SCALE, o.w * X8_SCALE); } }
    }
}

struct Args { const void* in[15]; float* out; unsigned char* ws; int ph_lo, ph_hi; };
constexpr int PH_PER_LAYER = 7, N_PHASES = 1 + PH_PER_LAYER * DEPTH;
#define IN(k) (lo <= (k) && (k) < hi)
#ifndef PH_MASK
#define PH_MASK 0xffff
#endif
#define PHM(b) ((PH_MASK >> (b)) & 1)
#ifndef REP_MASK
#define REP_MASK 0
#endif
#define REPS(b) (((REP_MASK >> (b)) & 1) ? 2 : 1)
#define SEAM(k) do { if (IN(k) && IN((k) + 1)) xcd_barrier(bar); } while (0)
template <int l> DI void layer_body(const Frame& F, const Args& args, const int lo, const int hi, const XcdBarrier& bar) {
        const int p0 = 1 + PH_PER_LAYER * l;
        if (PHM(1) && IN(p0)) { {
            SchedInProj S; S.G = F.G; S.c = F.wg; S.n_extra = (l == 0) ? 32 : 0; S.XB = (const char*)(F.ws + WS_XB); S.WT = (const char*)(F.ws + WS_WINT) + (size_t)l * NH * 4096 * 2;
            S.MEMB = (const char*)(F.ws + WS_MEMB); S.WKV = (const char*)(F.ws + WS_WMKVT);
            EpiH E{wsp<bf16>(F, WS_H), wsp<bf16>(F, WS_MK), wsp<bf16>(F, WS_MVT)};
            pg8::gemm_phase<EpiH, SchedInProj, 2, true>(F.lds, 4096, S, E);
            pg8::SchedStatic S8; S8.nM = 32; S8.nN = 64 * (2 / F8NB); S8.G = F.G; S8.c = F.wg; S8.A = (const char*)(F.ws + WS_X8); S8.B = (const char*)(F.ws + WS_W8) + (size_t)l * 16384 * 4096;
            S8.astep = (size_t)256 * 4096; S8.bstep = (size_t)(128 * F8NB) * 4096;
            EpiMG<F8NB> E8{wsp<bf16>(F, WS_H)};
            pg8::gemm_phase<EpiMG<F8NB>, pg8::SchedStatic, F8NB, true, true>(F.lds, 2048, S8, E8);
        }
        if (REPS(1) == 2) {
            SchedInProj S; S.G = F.G; S.c = F.wg; S.n_extra = (l == 0) ? 32 : 0; S.XB = (const char*)(F.ws + WS_XB); S.WT = (const char*)(F.ws + WS_WINT) + (size_t)l * NH * 4096 * 2;
            S.MEMB = (const char*)(F.ws + WS_MEMB); S.WKV = (const char*)(F.ws + WS_WMKVT);
            EpiH E{wsp<bf16>(F, WS_H), wsp<bf16>(F, WS_MK), wsp<bf16>(F, WS_MVT)};
            pg8::gemm_phase<EpiH, SchedInProj, 2, true>(F.lds, 4096, S, E);
            pg8::SchedStatic S8; S8.nM = 32; S8.nN = 64 * (2 / F8NB); S8.G = F.G; S8.c = F.wg; S8.A = (const char*)(F.ws + WS_X8); S8.B = (const char*)(F.ws + WS_W8) + (size_t)l * 16384 * 4096;
            S8.astep = (size_t)256 * 4096; S8.bstep = (size_t)(128 * F8NB) * 4096;
            EpiMG<F8NB> E8{wsp<bf16>(F, WS_H)};
            pg8::gemm_phase<EpiMG<F8NB>, pg8::SchedStatic, F8NB, true, true>(F.lds, 2048, S8, E8);
        } }
        SEAM(p0);
        if (PHM(2) && IN(p0 + 1)) for (int rep = 0; rep < REPS(2); ++rep) { if (NAIVE_MASK & 2) naive_gla(F, l, (const float*)args.in[6], (const float*)args.in[7]); else for (int u = F.wg; u < 512; u += F.G) gla_a_unit(F, l, u, (const float*)args.in[6], (const float*)args.in[7]); }
        SEAM(p0 + 1);
        if (PHM(3) && IN(p0 + 2)) for (int rep = 0; rep < REPS(3); ++rep) { if (!(NAIVE_MASK & 2)) gla_scan(F); }
        SEAM(p0 + 2);
        if (PHM(4) && IN(p0 + 3)) for (int rep = 0; rep < REPS(4); ++rep) {
            if (NAIVE_MASK & 2) naive_gla_norm(F, l, (const float*)args.in[8]); else
            for (int r2 = 0; r2 < REPS(8); ++r2) for (int u = F.wg; u < 512; u += F.G) gla_c_unit(F, l, u, (const float*)args.in[8]);
            if (NAIVE_MASK & 1) naive_pool(F, l, (const float*)args.in[4], (const float*)args.in[5]); else
            for (int r2 = 0; r2 < REPS(9); ++r2) for (int u = F.wg; u < 256; u += F.G) pool_unit(F, l, u, (const float*)args.in[5]);
            __syncthreads();
            if (NAIVE_MASK & 4) naive_swa(F, l, (const float*)args.in[9]); else
            for (int r2 = 0; r2 < REPS(10); ++r2) for (int u = F.wg; u < 1024; u += F.G) swa_unit(F, l, u, (const float*)args.in[9]);
            __syncthreads();
            if (NAIVE_MASK & 8) naive_mem(F, l); else
            for (int r2 = 0; r2 < REPS(11); ++r2) for (int u = F.wg; u < 256; u += F.G) mem_unit(F, l, u);
            __syncthreads();
        }
        SEAM(p0 + 3);
        if (PHM(5) && IN(p0 + 4)) { {
            pg8::SchedStatic S; S.nM = 32; S.nN = 32; S.G = F.G; S.c = F.wg; S.A = (const char*)(F.ws + WS_OB); S.B = (const char*)(F.ws + WS_WBRT) + (size_t)l * 4096 * 4096 * 2;
            S.astep = (size_t)256 * 4096 * 2; S.bstep = (size_t)128 * 4096 * 2;
            EpiGate E{wsp<bf16>(F, WS_H), wsp<bf16>(F, WS_YB)};
            pg8::gemm_phase<EpiGate, pg8::SchedStatic, 1, true>(F.lds, 4096, S, E);
        }
        if (REPS(5) == 2) {
            pg8::SchedStatic S; S.nM = 32; S.nN = 32; S.G = F.G; S.c = F.wg; S.A = (const char*)(F.ws + WS_OB); S.B = (const char*)(F.ws + WS_WBRT) + (size_t)l * 4096 * 4096 * 2;
            S.astep = (size_t)256 * 4096 * 2; S.bstep = (size_t)128 * 4096 * 2;
            EpiGate E{wsp<bf16>(F, WS_H), wsp<bf16>(F, WS_YB)};
            pg8::gemm_phase<EpiGate, pg8::SchedStatic, 1, true>(F.lds, 4096, S, E);
        } }
        SEAM(p0 + 4);
        if (PHM(6) && IN(p0 + 5)) { {
            pg8::SchedStatic S; S.nM = 32; S.nN = 16; S.G = F.G; S.c = F.wg; S.A = (const char*)(F.ws + WS_YB); S.B = (const char*)(F.ws + WS_WOUTT) + (size_t)l * 4096 * 4096 * 2;
            S.astep = (size_t)256 * 4096 * 2; S.bstep = (size_t)256 * 4096 * 2;
            EpiRes E{l == 0 ? (const float*)args.in[0] : (const float*)F.out, wsp<float>(F, WS_Z)};
            pg8::gemm_phase<EpiRes, pg8::SchedStatic, 2, true>(F.lds, 4096, S, E);
        }
        if (REPS(6) == 2) {
            pg8::SchedStatic S; S.nM = 32; S.nN = 16; S.G = F.G; S.c = F.wg; S.A = (const char*)(F.ws + WS_YB); S.B = (const char*)(F.ws + WS_WOUTT) + (size_t)l * 4096 * 4096 * 2;
            S.astep = (size_t)256 * 4096 * 2; S.bstep = (size_t)256 * 4096 * 2;
            EpiRes E{l == 0 ? (const float*)args.in[0] : (const float*)F.out, wsp<float>(F, WS_Z)};
            pg8::gemm_phase<EpiRes, pg8::SchedStatic, 2, true>(F.lds, 4096, S, E);
        } }
        SEAM(p0 + 5);
        if (PHM(7) && IN(p0 + 6)) for (int rep = 0; rep < REPS(7); ++rep) { ln_phase(F, l, (const float*)args.in[13], (const float*)args.in[14]); }
        SEAM(p0 + 6);
}


__global__ void __launch_bounds__(NTHR, 2) mk_fwd(Args args) {
    extern __shared__ __attribute__((aligned(16))) unsigned char lds_raw[];
    Frame F;
    F.lds = (LAS unsigned char*)lds_raw;
    F.tid = threadIdx.x; F.lane = F.tid & 63; F.wave = __builtin_amdgcn_readfirstlane(F.tid >> 6); F.G = gridDim.x; F.wg = blockIdx.x;
    F.out = args.out; F.ws = args.ws;
    volatile LAS unsigned* MISC = (volatile LAS unsigned*)(F.lds + MISC_OFF);
    for (int u = F.tid; u < (LDS_BYTES - LDSCTL_OFF) / 4; u += NTHR) ((LAS unsigned*)(F.lds + LDSCTL_OFF))[u] = 0u;
    __syncthreads();
    unsigned* barw = (unsigned*)(F.ws + WS_CTL) + CW_BAR;
    XcdBarrier bar; bar.bar = barw; bar.x = 0; bar.st = nullptr;
    const int lo = args.ph_lo, hi = args.ph_hi;
    if (hi - lo > 1) bar = xcd_barrier_post(barw, MISC + 8);

    if (PHM(0) && IN(0)) for (int rep = 0; rep < REPS(0); ++rep) { prologue(F, (const float*)args.in[0], (const float*)args.in[1], (const int*)args.in[2], (const float*)args.in[3], (const float*)args.in[4], (const float*)args.in[10], (const float*)args.in[11], (const float*)args.in[12]); }
    SEAM(0);
    layer_body<0>(F, args, lo, hi, bar);
    layer_body<1>(F, args, lo, hi, bar);
#undef IN
#undef SEAM
}

extern "C" void kernel_launch(void* const* d_in, const int* in_sizes, int n_in, void* d_out, int out_size, void* d_ws, size_t ws_size, hipStream_t stream) {
    static int grid = 0;
    if (grid == 0) {
        if (n_in != 15 || out_size != MTOK * DM || ws_size < WS_END) { fprintf(stderr, "kernel_launch: unexpected sizes (n_in %d, out %d, ws %zu); nothing launched\n", n_in, out_size, ws_size); grid = -1; return; }
        int dev = 0, cus = 0, per_cu = 0;
        if (hipGetDevice(&dev) != hipSuccess || hipDeviceGetAttribute(&cus, hipDeviceAttributeMultiprocessorCount, dev) != hipSuccess) { grid = -1; return; }
        if (hipFuncSetAttribute((const void*)mk_fwd, hipFuncAttributeMaxDynamicSharedMemorySize, LDS_BYTES) != hipSuccess) { fprintf(stderr, "kernel_launch: hipFuncSetAttribute failed\n"); grid = -1; return; }
        if (hipOccupancyMaxActiveBlocksPerMultiprocessor(&per_cu, (const void*)mk_fwd, NTHR, LDS_BYTES) != hipSuccess || per_cu < 1) fprintf(stderr, "kernel_launch: occupancy query says %d\n", per_cu);
        (void)hipGetLastError();
        grid = cus;
    }
    if (grid < 0) return;
    (void)hipMemsetAsync((char*)d_ws + WS_CTL, 0, CTL_ZERO_BYTES, stream);
    Args a{};
    for (int i = 0; i < 15; ++i) a.in[i] = d_in[i];
    a.out = (float*)d_out; a.ws = (unsigned char*)d_ws;
#if MK_PER_PHASE
    for (int p = 0; p < N_PHASES; ++p) { a.ph_lo = p; a.ph_hi = p + 1; hipLaunchKernelGGL(mk_fwd, dim3(grid), dim3(NTHR), LDS_BYTES, stream, a); }
#else
    a.ph_lo = 0; a.ph_hi = N_PHASES;
    hipLaunchKernelGGL(mk_fwd, dim3(grid), dim3(NTHR), LDS_BYTES, stream, a);
#endif
}
```

```cpp
#include <hip/hip_runtime.h>
#include <cstdio>
#include <cstdint>

#ifndef F8ASM1
#define F8ASM1 0
#endif
#ifndef F8NB
#define F8NB 2
#endif
#ifndef MK_PER_PHASE
#define MK_PER_PHASE 0
#endif

#define DI __device__ __forceinline__
#define LAS __attribute__((address_space(3)))
#define GAS __attribute__((address_space(1)))
typedef unsigned short bf16;
typedef short bf16x8 __attribute__((ext_vector_type(8)));
typedef short s16x4 __attribute__((ext_vector_type(4)));
typedef short v4i16_t __attribute__((ext_vector_type(4)));
typedef float f32x4 __attribute__((ext_vector_type(4)));
typedef float f32x2 __attribute__((ext_vector_type(2)));
typedef unsigned u32x4 __attribute__((ext_vector_type(4)));
typedef unsigned u32x2 __attribute__((ext_vector_type(2)));

constexpr int BATCH = 2, SEQ = 4096, DM = 4096, MTOK = BATCH * SEQ, DEPTH = 2;
constexpr int D_IN = 25872, NH = 26112;
constexpr int BW = 1024;
constexpr int MEMLEN = 256;
constexpr int C_PU = 0, C_PG = 1024, C_GQ = 2048, C_GK = 2560, C_GV = 3072, C_GG = 4096, C_SQ = 5120, C_SK = 6144, C_SV = 6272, C_SG = 6400, C_XQ = 7424, C_XG = 8448, C_MG = 9472, C_LR = 25856;
constexpr float LN_EPS = 1e-5f;
constexpr float DN_ALPHA = 1.41421356237309515f;

constexpr size_t MiB = 1u << 20;
constexpr size_t WS_CTL = 0, CTL_ZERO_BYTES = 1 * MiB;
constexpr size_t WS_ROPE = 1 * MiB;
constexpr size_t WS_WPOOLT = 2 * MiB;
constexpr size_t WS_MEMB = 4 * MiB;
constexpr size_t WS_MK = 8 * MiB;
constexpr size_t WS_MVT = 10 * MiB;
constexpr size_t WS_DEC = 12 * MiB;
constexpr size_t WS_WMKVT = 16 * MiB;
constexpr size_t WS_WBRT = 48 * MiB;
constexpr size_t WS_WOUTT = 112 * MiB;
constexpr size_t WS_XB = 176 * MiB;
constexpr size_t WS_OB = 240 * MiB;
constexpr size_t WS_YB = 304 * MiB;
constexpr size_t WS_GU = 368 * MiB;
constexpr size_t WS_GS = 432 * MiB;
constexpr size_t WS_GB = 464 * MiB;
constexpr size_t WS_WINT = 512 * MiB;
constexpr size_t WS_H = 928 * MiB;
constexpr size_t WS_Z = 1336 * MiB;
constexpr size_t WS_X8 = 1464 * MiB;
constexpr size_t WS_W8 = 1496 * MiB;
constexpr size_t WS_END = 1660 * MiB;
constexpr int C_F8 = C_SQ, N_F8 = C_LR - C_F8;
#ifndef F8_ROT
#define F8_ROT 64
#endif
constexpr float X8_SCALE = 16.0f, W8_SCALE = 2048.0f, MG_DESCALE = 1.0f / (16.0f * 2048.0f);
constexpr int CW_BAR = 4096;

constexpr int RING_BYTES = 131072;
constexpr int THIN_BYTES = 141312;
constexpr int LDSCTL_OFF = THIN_BYTES, MISC_OFF = LDSCTL_OFF + 320;
constexpr int LDS_BYTES = 147456;
constexpr int NWAVES = 8, NTHR = 512;

DI float bf2f(unsigned v) { return __builtin_bit_cast(float, v << 16); }
DI unsigned f2bf(float f) { unsigned u = __builtin_bit_cast(unsigned, f); return (u + 0x7fffu + ((u >> 16) & 1u)) >> 16; }
typedef float f32x2_t __attribute__((ext_vector_type(2))); typedef __bf16 bf16x2_t __attribute__((ext_vector_type(2)));
DI unsigned cvt_pk_bf16(float lo, float hi) { const f32x2_t v = {lo, hi}; const bf16x2_t b = __builtin_convertvector(v, bf16x2_t); return __builtin_bit_cast(unsigned, b); }
DI unsigned pk2(float lo, float hi) { return cvt_pk_bf16(lo, hi); }
DI float fast_sigmoid(float v) { return __builtin_amdgcn_rcpf(1.0f + __builtin_amdgcn_exp2f(-1.44269504089f * v)); }
DI void unpack8(const u32x4 w, float (&f)[8]) {
    f[0] = bf2f(w.x & 0xffffu); f[1] = bf2f(w.x >> 16); f[2] = bf2f(w.y & 0xffffu); f[3] = bf2f(w.y >> 16);
    f[4] = bf2f(w.z & 0xffffu); f[5] = bf2f(w.z >> 16); f[6] = bf2f(w.w & 0xffffu); f[7] = bf2f(w.w >> 16);
}
DI u32x4 pack8(const float (&f)[8]) { u32x4 w; w.x = pk2(f[0], f[1]); w.y = pk2(f[2], f[3]); w.z = pk2(f[4], f[5]); w.w = pk2(f[6], f[7]); return w; }
DI float clamp448(float v) { return fminf(fmaxf(v, -448.0f), 448.0f); }
DI unsigned pk4_fp8(float a, float b, float c, float d) {
    int w = 0; w = __builtin_amdgcn_cvt_pk_fp8_f32(clamp448(a), clamp448(b), w, false); w = __builtin_amdgcn_cvt_pk_fp8_f32(clamp448(c), clamp448(d), w, true); return (unsigned)w; }
typedef int v8i32 __attribute__((ext_vector_type(8)));
DI f32x4 mma16(bf16x8 a, bf16x8 b, f32x4 c) { return __builtin_amdgcn_mfma_f32_16x16x32_bf16(a, b, c, 0, 0, 0); }
DI bf16x8 frag_lds(const LAS bf16* img, int ld, int idx0, int k0, int lane) { return *(const LAS bf16x8*)(img + (idx0 + (lane & 15)) * ld + k0 + 8 * (lane >> 4)); }
DI bf16x8 frag_glb(const bf16* img, size_t ld, int idx0, int k0, int lane) { return *(const bf16x8*)(img + (size_t)(idx0 + (lane & 15)) * ld + k0 + 8 * (lane >> 4)); }
DI s16x4 tr4(const LAS bf16* p) { return __builtin_bit_cast(s16x4, __builtin_amdgcn_ds_read_tr16_b64_v4i16((LAS v4i16_t*)p)); }
DI bf16x8 frag_tr(const LAS bf16* img, int ld, int k0, int idx0, int lane) {
    const int g = lane >> 4, q = (lane >> 2) & 3, p = lane & 3;
    const LAS bf16* a0 = img + (k0 + 8 * g + q) * ld + idx0 + 4 * p;
    const s16x4 lo = tr4(a0), hi = tr4(a0 + 4 * ld);
    return __builtin_shufflevector(lo, hi, 0, 1, 2, 3, 4, 5, 6, 7);
}
DI float wave_sum(float v) {
#pragma unroll
    for (int o = 1; o < 64; o <<= 1) v += __shfl_xor(v, o);
    return v;
}
#define LDS_WAIT() asm volatile("s_waitcnt lgkmcnt(0)" ::: "memory")
#define VM_WAIT() asm volatile("s_waitcnt vmcnt(0)" ::: "memory")

namespace pg8 {
constexpr int BM = 256, BK = 64, HALF = 128, HTB = HALF * BK * 2, STAGE_BYTES = 8 * HTB, NXCD = 8, WGM = 8;
__host__ __device__ __forceinline__ int lds_byte(int r, int c) { const int st = (r >> 4) * 2 + (c >> 5), rr = r & 15, cc = c & 31, ob = rr * 64 + cc * 2; return st * 1024 + (ob ^ (((ob >> 9) & 1) << 5)); }
__host__ __device__ __forceinline__ void stage_rc(int b, int& R, int& C) { const int st = b / 1024, sb = b % 1024, swz = sb ^ (((sb >> 9) & 1) << 5); R = (st >> 1) * 16 + swz / 64; C = (st & 1) * 32 + (swz % 64) / 2; }
__host__ __device__ __forceinline__ int perm32(int rho) { const int n = rho >> 4, i = rho & 15; return 8 * (i >> 2) + 4 * n + (i & 3); }

struct Unit { int pm, pn, gi; };

DI void static_tile(int L, int nM, int nN, int& pm, int& pn) {
    const int nwg = nM * nN; int wgid = L;
    { const int q = nwg / NXCD, r = nwg % NXCD, xcd = wgid % NXCD, off = wgid / NXCD; wgid = (xcd < r ? xcd * (q + 1) : r * (q + 1) + (xcd - r) * q) + off; }
    const int nig = WGM * nN, gid = wgid / nig, fm = gid * WGM, gsz = (nM - fm) < WGM ? (nM - fm) : WGM;
    pm = fm + ((wgid % nig) % gsz); pn = (wgid % nig) / gsz;
}
struct SchedStatic {
    int nM, nN, G, c; const char* A; const char* B; size_t astep, bstep;
    DI bool next(int i, Unit& u) const { const long L = (long)i * G + c; if (L >= (long)nM * nN) return false; static_tile((int)L, nM, nN, u.pm, u.pn); u.gi = 0; return true; }
    DI const char* abase(const Unit& u) const { return A + (size_t)u.pm * astep; }
    DI const char* bbase(const Unit& u) const { return B + (size_t)u.pn * bstep; }
};

template <class Epi, class Sched, int NB, bool ALIGN_EPI, bool F8 = false>
DI void gemm_phase(LAS unsigned char* lds, const int K, const Sched& S, const Epi& E) {
    const int tid = threadIdx.x, wid = __builtin_amdgcn_readfirstlane(tid >> 6), lane = tid & 63, wr = wid >> 2, wc = wid & 3, fr = lane & 15, fq = lane >> 4;
    const int nt = K / BK;
    unsigned voffA[2], voffB[2];
#pragma unroll
    for (int i = 0; i < 2; ++i) { int R, C; stage_rc(tid * 16 + i * 8192, R, C); const int Rb = Epi::PERM ? ((R & ~31) + perm32(R & 31)) : R;
        voffA[i] = (unsigned)(R * K + C) * 2u; voffB[i] = (unsigned)(Rb * K + C) * 2u; }
    const size_t kstep = (size_t)(BK * 2);
    const size_t hstep = (size_t)HALF * K * 2;
    const unsigned ldsw = (unsigned)wid * 1024u;
    const int aoff = lds_byte(wr * 64 + fr, F8 ? fq * 16 : fq * 8), boff = lds_byte(wc * 32 + fr, F8 ? fq * 16 : fq * 8);
    constexpr int KOFF = F8 ? 16 : 1024;
    const unsigned one_scale = 0x7f7f7f7fu;
#define PG8_SA(b, h) (((b) * 2 + (h)) * HTB)
#define PG8_SB(b, h) ((4 + (b) * 2 + (h)) * HTB)
#define PG8_STAGE(bufoff, gbase, voff) do { _Pragma("unroll") for (int _i = 0; _i < 2; ++_i) \
        __builtin_amdgcn_global_load_lds((const unsigned*)((const char*)(gbase) + (voff)[_i]), (LAS unsigned*)(lds + (bufoff) + ldsw + _i * 8192), 16, 0, 0); } while (0)
#define PG8_LDA(dst, b, h) do { _Pragma("unroll") for (int m = 0; m < 4; ++m) _Pragma("unroll") for (int k = 0; k < 2; ++k) dst[m][k] = *(const LAS bf16x8*)(lds + PG8_SA(b, h) + aoff + m * 2048 + k * KOFF); } while (0)
#define PG8_LDB(dst, b, h) do { _Pragma("unroll") for (int n = 0; n < 2; ++n) _Pragma("unroll") for (int k = 0; k < 2; ++k) dst[n][k] = *(const LAS bf16x8*)(lds + PG8_SB(b, h) + boff + n * 2048 + k * KOFF); } while (0)
#define PG8_CAT(x) __builtin_bit_cast(v8i32, __builtin_shufflevector((x)[0], (x)[1], 0, 1, 2, 3, 4, 5, 6, 7, 8, 9, 10, 11, 12, 13, 14, 15))
#define PG8_MMA(ai, bj, At, Bt) do { __builtin_amdgcn_s_setprio(1); _Pragma("unroll") for (int m = 0; m < 4; ++m) _Pragma("unroll") for (int n = 0; n < 2; ++n) { \
        if constexpr (F8 && NB == 1 && !F8ASM1) acc[ai][bj][m][n] = __builtin_amdgcn_mfma_scale_f32_16x16x128_f8f6f4(PG8_CAT(Bt[n]), PG8_CAT(At[m]), acc[ai][bj][m][n], 0, 0, 0, 0x7f7f7f7f, 0, 0x7f7f7f7f); \
        else if constexpr (F8) { asm volatile("v_mfma_scale_f32_16x16x128_f8f6f4 %0, %1, %2, %0, %3, %3 op_sel_hi:[0,0,0]" : "+v"(acc[ai][bj][m][n]) : "v"(PG8_CAT(Bt[n])), "v"(PG8_CAT(At[m])), "v"(one_scale)); } \
        else { _Pragma("unroll") for (int k = 0; k < 2; ++k) acc[ai][bj][m][n] = __builtin_amdgcn_mfma_f32_16x16x32_bf16(Bt[n][k], At[m][k], acc[ai][bj][m][n], 0, 0, 0); } } \
        __builtin_amdgcn_s_setprio(0); } while (0)
#define PG8_WAIT_V(n) asm volatile("s_waitcnt vmcnt(" #n ")" ::: "memory")
#define PG8_WAIT_L(n) asm volatile("s_waitcnt lgkmcnt(" #n ")" ::: "memory")
#define PG8_BAR __builtin_amdgcn_s_barrier()
#define PG8_SCHED __builtin_amdgcn_sched_barrier(0)
#define PG8_WAIT_MAIN() do { if constexpr (NB == 2) PG8_WAIT_V(8); else PG8_WAIT_V(6); } while (0)
    Unit cur, nxt; int ui = 0;
    if (!S.next(0, cur)) return;
    f32x4 acc[2][NB][4][2];
    f32x4 yac[2][4][2];
#pragma unroll
    for (int a = 0; a < 2; ++a)
#pragma unroll
        for (int m = 0; m < 4; ++m)
#pragma unroll
            for (int n = 0; n < 2; ++n) { yac[a][m][n] = (f32x4){0.f, 0.f, 0.f, 0.f};
#pragma unroll
                for (int b = 0; b < NB; ++b) acc[a][b][m][n] = (f32x4){0.f, 0.f, 0.f, 0.f}; }
    bf16x8 At[4][2], B0[2][2], B1[2][2];
    const char* cA = S.abase(cur); const char* cB = S.bbase(cur);
    if constexpr (NB == 2) {
        PG8_STAGE(PG8_SB(0, 0), cB, voffB); PG8_STAGE(PG8_SB(0, 1), cB + hstep, voffB); PG8_STAGE(PG8_SA(0, 0), cA, voffA); PG8_STAGE(PG8_SA(0, 1), cA + hstep, voffA);
        if (wr == 1) PG8_BAR;
        PG8_WAIT_V(2); PG8_BAR;
        PG8_STAGE(PG8_SB(1, 0), cB + kstep, voffB); PG8_STAGE(PG8_SA(1, 0), cA + kstep, voffA); PG8_STAGE(PG8_SB(1, 1), cB + hstep + kstep, voffB);
        PG8_WAIT_V(6); PG8_BAR;
    } else {
        PG8_STAGE(PG8_SB(0, 0), cB, voffB); PG8_STAGE(PG8_SA(0, 0), cA, voffA); PG8_STAGE(PG8_SA(0, 1), cA + hstep, voffA);
        if (wr == 1) PG8_BAR;
        PG8_WAIT_V(2); PG8_BAR;
        PG8_STAGE(PG8_SB(1, 0), cB + kstep, voffB); PG8_STAGE(PG8_SA(1, 0), cA + kstep, voffA);
        PG8_WAIT_V(4); PG8_BAR;
    }
    for (;;) {
        const bool has_next = S.next(ui + 1, nxt);
        const char* nA = has_next ? S.abase(nxt) : cA; const char* nB = has_next ? S.bbase(nxt) : cB;
        for (int t = 0; t < nt; t += 2) {
            if constexpr (Epi::GATED) { if (t != 0 && (t & 15) == 0) { E.flush(acc, yac, cur, (t >> 4) - 1, wr, wc, fr, fq);
#pragma unroll
                for (int a = 0; a < 2; ++a)
#pragma unroll
                    for (int m = 0; m < 4; ++m)
#pragma unroll
                        for (int n = 0; n < 2; ++n) acc[a][0][m][n] = (f32x4){0.f, 0.f, 0.f, 0.f}; } }
            const bool last = (t == nt - 2);
            const char* a1 = cA + (size_t)(t + 1) * kstep;
            const char* a2 = last ? nA : cA + (size_t)(t + 2) * kstep; const char* b2 = last ? nB : cB + (size_t)(t + 2) * kstep;
            const char* a3 = a2 + kstep; const char* b3 = b2 + kstep;
            if constexpr (NB == 2) {
            PG8_LDB(B0, 0, 0); PG8_LDB(B1, 0, 1); PG8_SCHED; PG8_LDA(At, 0, 0); PG8_STAGE(PG8_SA(1, 1), a1 + hstep, voffA);
            PG8_WAIT_V(8); PG8_WAIT_L(0); PG8_BAR; PG8_MMA(0, 0, At, B0); PG8_MMA(0, 1, At, B1); PG8_BAR; PG8_SCHED;
            PG8_LDA(At, 0, 1); PG8_STAGE(PG8_SB(0, 0), b2, voffB); PG8_STAGE(PG8_SB(0, 1), b2 + hstep, voffB); PG8_STAGE(PG8_SA(0, 0), a2, voffA);
            PG8_WAIT_V(8); PG8_WAIT_L(0); PG8_BAR; PG8_MMA(1, 0, At, B0); PG8_MMA(1, 1, At, B1); PG8_BAR; PG8_SCHED;
            PG8_LDB(B0, 1, 0); PG8_LDB(B1, 1, 1); PG8_SCHED; PG8_LDA(At, 1, 0); PG8_STAGE(PG8_SA(0, 1), a2 + hstep, voffA);
            PG8_WAIT_V(8); PG8_WAIT_L(0); PG8_BAR; PG8_MMA(0, 0, At, B0); PG8_MMA(0, 1, At, B1); PG8_BAR; PG8_SCHED;
            PG8_LDA(At, 1, 1); PG8_STAGE(PG8_SB(1, 0), b3, voffB); PG8_STAGE(PG8_SB(1, 1), b3 + hstep, voffB); PG8_STAGE(PG8_SA(1, 0), a3, voffA);
            PG8_WAIT_V(8); PG8_WAIT_L(0); PG8_BAR; PG8_MMA(1, 0, At, B0); PG8_MMA(1, 1, At, B1); PG8_BAR; PG8_SCHED;
            } else {
            PG8_LDB(B0, 0, 0); PG8_SCHED; PG8_LDA(At, 0, 0); PG8_STAGE(PG8_SA(1, 1), a1 + hstep, voffA);
            PG8_WAIT_V(6); PG8_WAIT_L(0); PG8_BAR; PG8_MMA(0, 0, At, B0); PG8_BAR; PG8_SCHED;
            PG8_LDA(At, 0, 1); PG8_STAGE(PG8_SB(0, 0), b2, voffB); PG8_STAGE(PG8_SA(0, 0), a2, voffA);
            PG8_WAIT_V(6); PG8_WAIT_L(0); PG8_BAR; PG8_MMA(1, 0, At, B0); PG8_BAR; PG8_SCHED;
            PG8_LDB(B0, 1, 0); PG8_SCHED; PG8_LDA(At, 1, 0); PG8_STAGE(PG8_SA(0, 1), a2 + hstep, voffA);
            PG8_WAIT_V(6); PG8_WAIT_L(0); PG8_BAR; PG8_MMA(0, 0, At, B0); PG8_BAR; PG8_SCHED;
            PG8_LDA(At, 1, 1); PG8_STAGE(PG8_SB(1, 0), b3, voffB); PG8_STAGE(PG8_SA(1, 0), a3, voffA);
            PG8_WAIT_V(6); PG8_WAIT_L(0); PG8_BAR; PG8_MMA(1, 0, At, B0); PG8_BAR; PG8_SCHED;
            }
        }
        if constexpr (F8) {
            asm volatile("s_nop 15\n\ts_nop 15" ::: "memory");
#pragma unroll
            for (int a = 0; a < 2; ++a)
#pragma unroll
                for (int b = 0; b < NB; ++b)
#pragma unroll
                    for (int m = 0; m < 4; ++m)
#pragma unroll
                        for (int n = 0; n < 2; ++n) asm volatile("" : "+v"(acc[a][b][m][n]));
        }
        if constexpr (ALIGN_EPI) { if (wr == 0) PG8_BAR; }
        if constexpr (Epi::GATED) { E.finish(acc, yac, cur, wr, wc, fr, fq);
#pragma unroll
            for (int a = 0; a < 2; ++a)
#pragma unroll
                for (int m = 0; m < 4; ++m)
#pragma unroll
                    for (int n = 0; n < 2; ++n) yac[a][m][n] = (f32x4){0.f, 0.f, 0.f, 0.f};
        } else { E(acc, cur, wr, wc, fr, fq); }
        if (!has_next) break;
#pragma unroll
        for (int a = 0; a < 2; ++a)
#pragma unroll
            for (int b = 0; b < NB; ++b)
#pragma unroll
                for (int m = 0; m < 4; ++m)
#pragma unroll
                    for (int n = 0; n < 2; ++n) acc[a][b][m][n] = (f32x4){0.f, 0.f, 0.f, 0.f};
        cur = nxt; cA = nA; cB = nB; ++ui;
        if constexpr (ALIGN_EPI) { if (wr == 1) PG8_BAR; }
    }
    PG8_WAIT_V(0);
    if constexpr (!ALIGN_EPI) { if (wr == 0) PG8_BAR; }
    PG8_BAR;
#undef PG8_SA
#undef PG8_SB
#undef PG8_STAGE
#undef PG8_LDA
#undef PG8_LDB
#undef PG8_MMA
#undef PG8_CAT
#undef PG8_WAIT_V
#undef PG8_WAIT_L
#undef PG8_BAR
#undef PG8_SCHED
#undef PG8_WAIT_MAIN
}
}

#define XB_TMO      128
#define XB_XCNT(j)  (256  + 64 * (j))
#define XB_XSUB(j)  (1280 + 64 * (j))
#define XB_XGEN(j)  (2304 + 64 * (j))
#define XB_TOP      3328
#define XB_TOPGEN   3392
#define XCD_BAR_WORDS 3456
#define XB_SPIN_CAP (1u << 18)
DI unsigned xb_ld(unsigned* p)              { return __hip_atomic_load(p, __ATOMIC_RELAXED, __HIP_MEMORY_SCOPE_AGENT); }
DI unsigned xb_add(unsigned* p, unsigned v) { return __hip_atomic_fetch_add(p, v, __ATOMIC_RELAXED, __HIP_MEMORY_SCOPE_AGENT); }
DI unsigned xb_xcc_id() { return (unsigned)__builtin_amdgcn_s_getreg((3 << 11) | 20) & 0xFu; }
#define XB_SPIN(cond, bar) do { unsigned _sp = 0; while (cond) { __builtin_amdgcn_s_sleep(1); \
    if ((++_sp & 255u) == 0u) { if (xb_ld(&(bar)[XB_TMO])) break; if (_sp > XB_SPIN_CAP) { atomicAdd(&(bar)[XB_TMO], 1u); break; } } } } while (0)
struct XcdBarrier { unsigned* bar; unsigned x; volatile LAS unsigned* st; };
DI XcdBarrier xcd_barrier_post(unsigned* bar, volatile LAS unsigned* st) {
    XcdBarrier b; b.bar = bar; b.x = xb_xcc_id(); b.st = st;
    if (threadIdx.x == 0) (void)xb_add(&bar[XB_XCNT(b.x)], 1u);
    return b;
}
DI void xcd_barrier_complete(unsigned* bar, unsigned x, unsigned& nloc, unsigned& nx) {
    const unsigned G = gridDim.x * gridDim.y * gridDim.z;
    unsigned sum, cnt, mine, sp = 0u;
    for (;;) {
        sum = 0u; cnt = 0u; mine = 0u;
#pragma unroll
        for (unsigned j = 0; j < 16; ++j) { const unsigned c = xb_ld(&bar[XB_XCNT(j)]); sum += c; cnt += (c > 0u) ? 1u : 0u; mine = (j == x) ? c : mine; }
        if (sum == G) break;
        __builtin_amdgcn_s_sleep(1);
        if ((++sp & 255u) == 0u) { if (xb_ld(&bar[XB_TMO])) break; if (sp > XB_SPIN_CAP) { atomicAdd(&bar[XB_TMO], 1u); break; } }
    }
    nloc = mine > 0u ? mine : 1u; nx = cnt > 0u ? cnt : 1u;
}
DI void xcd_barrier(const XcdBarrier& b) {
    asm volatile("s_waitcnt vmcnt(0)" ::: "memory");
    __syncthreads();
    if (threadIdx.x == 0) {
        unsigned* bar = b.bar;
        __builtin_amdgcn_s_waitcnt(0);
        unsigned nloc = b.st[0], nx = b.st[1];
        if (nloc == 0u) { xcd_barrier_complete(bar, b.x, nloc, nx); b.st[0] = nloc; b.st[1] = nx; }
        const unsigned old = xb_add(&bar[XB_XSUB(b.x)], 1u);
        const unsigned gen = old / nloc;
        if (old + 1u == (gen + 1u) * nloc) {
            __builtin_amdgcn_fence(__ATOMIC_RELEASE, "agent");
            asm volatile("s_waitcnt vmcnt(0)" ::: "memory");
            const unsigned og = xb_add(&bar[XB_TOP], 1u);
            const unsigned tg = og / nx;
            if (og + 1u == (tg + 1u) * nx) xb_add(&bar[XB_TOPGEN], 1u);
            else XB_SPIN(xb_ld(&bar[XB_TOPGEN]) == tg, bar);
            __builtin_amdgcn_fence(__ATOMIC_ACQUIRE, "agent");
            xb_add(&bar[XB_XGEN(b.x)], 1u);
            asm volatile("s_waitcnt vmcnt(0)" ::: "memory");
        } else {
            XB_SPIN(xb_ld(&bar[XB_XGEN(b.x)]) == gen, bar);
            __builtin_amdgcn_fence(__ATOMIC_ACQUIRE, "agent");
            asm volatile("s_waitcnt vmcnt(0)" ::: "memory");
        }
    }
    __syncthreads();
}

struct Frame {
    LAS unsigned char* lds;
    int tid, lane, wave, G, wg;
    float* out; unsigned char* ws;
};
template <class T> DI T* wsp(const Frame& F, size_t off) { return (T*)(F.ws + off); }

struct EpiH {
    static constexpr bool PERM = true, GATED = false;
    bf16* H; bf16* MK; bf16* MVT;
    DI void operator()(const f32x4 (&acc)[2][2][4][2], const pg8::Unit& u, int wr, int wc, int fr, int fq) const {
        bf16* base = H; size_t ldc = NH; int act = 0;
        if (u.gi == 0) { const int pn = u.pn; act = ((pn >= 4 && pn < 8) || (pn >= 16 && pn < 20)) ? 1 : 0; }
        else { const int lx = (u.gi - 1) >> 1, w = (u.gi - 1) & 1; if (w == 0) { base = MK + (size_t)lx * 512 * 1024; ldc = 1024; } else { base = MVT + (size_t)lx * 1024 * 512; ldc = 512; } }
        const int row0 = u.pm * 256 + wr * 64 + fr, col0 = u.pn * 256 + wc * 32 + 8 * fq;
#pragma unroll
        for (int ai = 0; ai < 2; ++ai)
#pragma unroll
            for (int m = 0; m < 4; ++m) { bf16* rowp = base + (size_t)(row0 + ai * 128 + m * 16) * ldc + col0;
#pragma unroll
                for (int bj = 0; bj < 2; ++bj) { f32x4 v0 = acc[ai][bj][m][0], v1 = acc[ai][bj][m][1];
                    if (act != 0) {
#pragma unroll
                        for (int j = 0; j < 4; ++j) { const float s0 = fast_sigmoid(v0[j]), s1 = fast_sigmoid(v1[j]); v0[j] = (act == 1) ? v0[j] * s0 : s0; v1[j] = (act == 1) ? v1[j] * s1 : s1; } }
                    u32x4 w; w.x = cvt_pk_bf16(v0[0], v0[1]); w.y = cvt_pk_bf16(v0[2], v0[3]); w.z = cvt_pk_bf16(v1[0], v1[1]); w.w = cvt_pk_bf16(v1[2], v1[3]);
                    *(u32x4*)(rowp + bj * 128) = w; } }
    }
};
template <int NB> struct EpiMG {
    static constexpr bool PERM = true, GATED = false;
    bf16* H;
    DI void operator()(const f32x4 (&acc)[2][NB][4][2], const pg8::Unit& u, int wr, int wc, int fr, int fq) const {
        const int colu = C_F8 + u.pn * (128 * NB);
        const int act = (colu >= C_MG) ? 2 : (((colu >= C_SG && colu < C_XQ) || colu >= C_XG) ? 1 : 0);
        const int row0 = u.pm * 256 + wr * 64 + fr, col0 = colu + wc * 32 + 8 * fq;
#pragma unroll
        for (int ai = 0; ai < 2; ++ai)
#pragma unroll
            for (int m = 0; m < 4; ++m) { bf16* rowp = H + (size_t)(row0 + ai * 128 + m * 16) * NH + col0;
#pragma unroll
                for (int bj = 0; bj < NB; ++bj) { f32x4 v0 = acc[ai][bj][m][0], v1 = acc[ai][bj][m][1];
#pragma unroll
                    for (int j = 0; j < 4; ++j) { const float a0 = v0[j] * MG_DESCALE, a1 = v1[j] * MG_DESCALE, s0 = fast_sigmoid(a0), s1 = fast_sigmoid(a1);
                        v0[j] = (act == 2) ? s0 : ((act == 1) ? a0 * s0 : a0); v1[j] = (act == 2) ? s1 : ((act == 1) ? a1 * s1 : a1); }
                    u32x4 w; w.x = cvt_pk_bf16(v0[0], v0[1]); w.y = cvt_pk_bf16(v0[2], v0[3]); w.z = cvt_pk_bf16(v1[0], v1[1]); w.w = cvt_pk_bf16(v1[2], v1[3]);
                    *(u32x4*)(rowp + bj * 128) = w; } }
    }
};
struct EpiRes {
    static constexpr bool PERM = false, GATED = false;
    const float* __restrict__ res; float* __restrict__ out;
    DI void operator()(const f32x4 (&acc)[2][2][4][2], const pg8::Unit& u, int wr, int wc, int fr, int fq) const {
        const int row0 = u.pm * 256 + wr * 64 + fr, col0 = u.pn * 256 + wc * 32 + 4 * fq;
#pragma unroll
        for (int ai = 0; ai < 2; ++ai)
#pragma unroll
            for (int m = 0; m < 4; ++m) { const size_t ro = (size_t)(row0 + ai * 128 + m * 16) * DM + col0;
#pragma unroll
                for (int bj = 0; bj < 2; ++bj)
#pragma unroll
                    for (int n = 0; n < 2; ++n) { const size_t o = ro + bj * 128 + n * 16; const f32x4 r = *(const f32x4*)(res + o); *(f32x4*)(out + o) = r * DN_ALPHA + acc[ai][bj][m][n]; } }
    }
};
struct EpiGate {
    static constexpr bool PERM = true, GATED = true;
    const bf16* H; bf16* Y;
    DI void flush(const f32x4 (&acc)[2][1][4][2], f32x4 (&y)[2][4][2], const pg8::Unit& u, int bi, int wr, int wc, int fr, int fq) const {
        const int row0 = u.pm * 256 + wr * 64 + fr, col0 = u.pn * 128 + wc * 32 + 8 * fq;
#pragma unroll
        for (int ai = 0; ai < 2; ++ai)
#pragma unroll
            for (int m = 0; m < 4; ++m) { const u32x4 gw = *(const u32x4*)(H + (size_t)(row0 + ai * 128 + m * 16) * NH + C_MG + bi * DM + col0);
                float g[8]; unpack8(gw, g);
#pragma unroll
                for (int j = 0; j < 4; ++j) { y[ai][m][0][j] += g[j] * acc[ai][0][m][0][j]; y[ai][m][1][j] += g[4 + j] * acc[ai][0][m][1][j]; }
                if (m == 1 || m == 3) __builtin_amdgcn_sched_barrier(0); }
    }
    DI void finish(const f32x4 (&acc)[2][1][4][2], f32x4 (&y)[2][4][2], const pg8::Unit& u, int wr, int wc, int fr, int fq) const {
        flush(acc, y, u, 3, wr, wc, fr, fq);
        const int row0 = u.pm * 256 + wr * 64 + fr, col0 = u.pn * 128 + wc * 32 + 8 * fq;
#pragma unroll
        for (int ai = 0; ai < 2; ++ai)
#pragma unroll
            for (int m = 0; m < 4; ++m) { const f32x4 v0 = y[ai][m][0], v1 = y[ai][m][1];
                u32x4 w; w.x = cvt_pk_bf16(v0[0], v0[1]); w.y = cvt_pk_bf16(v0[2], v0[3]); w.z = cvt_pk_bf16(v1[0], v1[1]); w.w = cvt_pk_bf16(v1[2], v1[3]);
                *(u32x4*)(Y + (size_t)(row0 + ai * 128 + m * 16) * DM + col0) = w; }
    }
};
struct SchedInProj {
    int G, c, n_extra; const char *XB, *WT, *MEMB, *WKV;
    static constexpr int NM = 32, NN = 21, NU = NM * NN;
    static constexpr size_t TSTEP = (size_t)256 * 4096 * 2;
    DI bool next(int i, pg8::Unit& u) const {
        const long L = (long)i * G + c;
        if (L < NU) { pg8::static_tile((int)L, NM, NN, u.pm, u.pn); if (u.pn == 20) u.pn = 101; u.gi = 0; return true; }
        const int e = (int)(L - NU); if (e >= n_extra) return false;
        const int lx = e >> 4, r = e & 15;
        if (r < 8) { u.pm = r >> 2; u.pn = r & 3; u.gi = 1 + 2 * lx; } else { u.pm = (r - 8) >> 1; u.pn = (r - 8) & 1; u.gi = 2 + 2 * lx; }
        return true;
    }
    DI const char* abase(const pg8::Unit& u) const {
        if (u.gi == 0) return XB + (size_t)u.pm * TSTEP;
        const int lx = (u.gi - 1) >> 1, w = (u.gi - 1) & 1;
        return w == 0 ? MEMB + (size_t)u.pm * TSTEP : WKV + (size_t)lx * 2048 * 4096 * 2 + (size_t)(1024 + u.pm * 256) * 4096 * 2;
    }
    DI const char* bbase(const pg8::Unit& u) const {
        if (u.gi == 0) return WT + (size_t)u.pn * TSTEP;
        const int lx = (u.gi - 1) >> 1, w = (u.gi - 1) & 1;
        return w == 0 ? WKV + (size_t)lx * 2048 * 4096 * 2 + (size_t)u.pn * TSTEP : MEMB + (size_t)u.pn * TSTEP;
    }
};

DI int win_src_col(int n) { return n < 5120 ? n : (n < C_LR ? n + 16 : (n < C_LR + 16 ? n - C_LR + 5120 : -1)); }
template <bool WIN> DI void transpose_item(const float* W, size_t ldw, bf16* WT, size_t ldt, int k0, int n0, int kd0, LAS float* scr, int lane) {
    const int kr = lane >> 3, nc = lane & 7; int sc = n0 + 4 * nc; if (WIN) sc = win_src_col(sc);
    const float* src = W + (size_t)(k0 + kr) * ldw + (sc < 0 ? 0 : sc);
    f32x4 v[8];
#pragma unroll
    for (int i = 0; i < 8; ++i) v[i] = *(const f32x4*)(src + (size_t)(8 * i) * ldw);
#pragma unroll
    for (int i = 0; i < 8; ++i) { LAS float* d = scr + (8 * i + kr) * 33 + 4 * nc; const f32x4 x = (sc < 0) ? (f32x4){0.f, 0.f, 0.f, 0.f} : v[i]; d[0] = x.x; d[1] = x.y; d[2] = x.z; d[3] = x.w; }
    LDS_WAIT();
    const int c = lane & 7;
#pragma unroll
    for (int j = 0; j < 4; ++j) { const int n = (lane >> 3) + 8 * j; const LAS float* s = scr + (8 * c) * 33 + n;
        u32x4 o; o.x = pk2(s[0 * 33], s[1 * 33]); o.y = pk2(s[2 * 33], s[3 * 33]); o.z = pk2(s[4 * 33], s[5 * 33]); o.w = pk2(s[6 * 33], s[7 * 33]);
        *(u32x4*)(WT + (size_t)(n0 + n) * ldt + kd0 + 8 * c) = o; }
    LDS_WAIT();
}
DI void transpose_item_f8(const float* W, size_t ldw, unsigned char* WT, size_t ldt, int k0, int n0, LAS float* scr, int lane) {
    const int kr = lane >> 3, nc = lane & 7; const int sc = win_src_col(n0 + 4 * nc);
    const float* src = W + (size_t)(k0 + kr) * ldw + sc;
#pragma unroll
    for (int h = 0; h < 2; ++h) {
        f32x4 v[8];
#pragma unroll
        for (int i = 0; i < 8; ++i) v[i] = *(const f32x4*)(src + (size_t)(64 * h + 8 * i) * ldw);
#pragma unroll
        for (int i = 0; i < 8; ++i) { LAS float* d = scr + (64 * h + 8 * i + kr) * 33 + 4 * nc; d[0] = v[i].x * W8_SCALE; d[1] = v[i].y * W8_SCALE; d[2] = v[i].z * W8_SCALE; d[3] = v[i].w * W8_SCALE; }
    }
    LDS_WAIT();
    const int c = lane & 7;
#pragma unroll
    for (int j = 0; j < 4; ++j) { const int n = (lane >> 3) + 8 * j; const LAS float* s = scr + (16 * c) * 33 + n;
        u32x4 o; o.x = pk4_fp8(s[0 * 33], s[1 * 33], s[2 * 33], s[3 * 33]); o.y = pk4_fp8(s[4 * 33], s[5 * 33], s[6 * 33], s[7 * 33]);
        o.z = pk4_fp8(s[8 * 33], s[9 * 33], s[10 * 33], s[11 * 33]); o.w = pk4_fp8(s[12 * 33], s[13 * 33], s[14 * 33], s[15 * 33]);
        *(u32x4*)(WT + (size_t)(n0 - C_F8 + n) * ldt + k0 + 16 * c) = o; }
    LDS_WAIT();
}
DI void prologue(const Frame& F, const float* x, const float* mem, const int* pos, const float* w_in, const float* w_pool, const float* w_mem_kv, const float* w_branch, const float* w_out) {
    LAS float* scr = (LAS float*)(F.lds + F.wave * 17408);
    const int gw = F.wg * NWAVES + F.wave, NGW = F.G * NWAVES, lane = F.lane;
    constexpr int I_IN = 64 * (NH / 32), I_KV = 64 * 64, I_BR = 16 * 128, I_OUT = 64 * 128, I_PL = 4 * 8;
    constexpr int NITEMS = 2 * I_IN + 2 * I_KV + 8 * I_BR + 2 * I_OUT + 8 * I_PL;
    for (int it = gw; it < NITEMS; it += NGW) {
        int r = it;
        if (r < 2 * I_IN) { const int l = r / I_IN; r -= l * I_IN; const int nb = r >> 6, kb = r & 63;
            if (nb * 32 >= C_F8 && nb * 32 < C_LR) { if ((kb & 1) == 0) transpose_item_f8(w_in + (size_t)l * 4096 * D_IN, D_IN, wsp<unsigned char>(F, WS_W8) + (size_t)l * N_F8 * 4096, 4096, kb * 64, nb * 32, scr, lane); }
            else transpose_item<true>(w_in + (size_t)l * 4096 * D_IN, D_IN, wsp<bf16>(F, WS_WINT) + (size_t)l * NH * 4096, 4096, kb * 64, nb * 32, kb * 64, scr, lane);
            continue; }
        r -= 2 * I_IN;
        if (r < 2 * I_KV) { const int l = r / I_KV; r -= l * I_KV; const int nb = r >> 6, kb = r & 63;
            transpose_item<false>(w_mem_kv + (size_t)l * 4096 * 2048, 2048, wsp<bf16>(F, WS_WMKVT) + (size_t)l * 2048 * 4096, 4096, kb * 64, nb * 32, kb * 64, scr, lane); continue; }
        r -= 2 * I_KV;
        if (r < 8 * I_BR) { const int lb = r / I_BR; r -= lb * I_BR; const int l = lb >> 2, bi = lb & 3; const int nb = r >> 4, kb = r & 15;
            transpose_item<false>(w_branch + (size_t)lb * 1024 * 4096, 4096, wsp<bf16>(F, WS_WBRT) + (size_t)l * 4096 * 4096, 4096, kb * 64, nb * 32, bi * 1024 + kb * 64, scr, lane); continue; }
        r -= 8 * I_BR;
        if (r < 2 * I_OUT) { const int l = r / I_OUT; r -= l * I_OUT; const int nb = r >> 6, kb = r & 63;
            transpose_item<false>(w_out + (size_t)l * 4096 * 4096, 4096, wsp<bf16>(F, WS_WOUTT) + (size_t)l * 4096 * 4096, 4096, kb * 64, nb * 32, kb * 64, scr, lane); continue; }
        r -= 2 * I_OUT;
        { const int lg = r / I_PL; r -= lg * I_PL; const int nb = r >> 2, kb = r & 3;
            transpose_item<false>(w_pool + (size_t)lg * 256 * 256, 256, wsp<bf16>(F, WS_WPOOLT) + (size_t)lg * 256 * 256, 256, kb * 64, nb * 32, kb * 64, scr, lane); }
    }
    const size_t gt = (size_t)F.wg * NTHR + F.tid, GT = (size_t)F.G * NTHR;
    { const f32x4* xs = (const f32x4*)x; u32x4* xd = wsp<u32x4>(F, WS_XB);
      u32x2* x8 = wsp<u32x2>(F, WS_X8);
      for (size_t i = gt; i < (size_t)MTOK * DM / 8; i += GT) { const f32x4 a = xs[2 * i], b = xs[2 * i + 1]; u32x4 o; o.x = pk2(a.x, a.y); o.y = pk2(a.z, a.w); o.z = pk2(b.x, b.y); o.w = pk2(b.z, b.w); xd[i] = o;
          u32x2 q; q.x = pk4_fp8(a.x * X8_SCALE, a.y * X8_SCALE, a.z * X8_SCALE, a.w * X8_SCALE); q.y = pk4_fp8(b.x * X8_SCALE, b.y * X8_SCALE, b.z * X8_SCALE, b.w * X8_SCALE); x8[i] = q; }
      const f32x4* ms = (const f32x4*)mem; u32x4* md = wsp<u32x4>(F, WS_MEMB);
      for (size_t i = gt; i < (size_t)BATCH * MEMLEN * DM / 8; i += GT) { const f32x4 a = ms[2 * i], b = ms[2 * i + 1]; u32x4 o; o.x = pk2(a.x, a.y); o.y = pk2(a.z, a.w); o.z = pk2(b.x, b.y); o.w = pk2(b.z, b.w); md[i] = o; } }
    { f32x2* rt = wsp<f32x2>(F, WS_ROPE);
      for (size_t i = gt; i < (size_t)MTOK * 8; i += GT) { const int t = (int)(i >> 3), fi = (int)(i & 7);
          const float inv = (float)pow(500000.0, -(double)fi / 8.0); const float ang = (float)pos[t] * inv;
          rt[i] = (f32x2){cosf(ang), sinf(ang)}; } }
}

DI float fexp(float x) { return __builtin_amdgcn_exp2f(x * 1.44269504089f); }
DI float logsigmoid_f(float z) { return fminf(z, 0.f) - 0.69314718056f * __builtin_amdgcn_logf(1.0f + fexp(-fabsf(z))); }

DI void gla_a_unit(const Frame& F, int l, int unit, const float* w_gla_up, const float* b_gla) {
    const int bh = unit >> 6, c = unit & 63, b = bh >> 2, h = bh & 3, t0 = b * SEQ + c * 64, tid = F.tid, lane = F.lane, wave = F.wave;
    const bf16* H = wsp<bf16>(F, WS_H);
    LAS float* lrs = (LAS float*)(F.lds);
    LAS float* bcs = (LAS float*)(F.lds + 4096);
    LAS float* seg = (LAS float*)(F.lds + 36864);
    LAS bf16* kds = (LAS bf16*)(F.lds + 40960);
    LAS bf16* vs = (LAS bf16*)(F.lds + 59392);
    constexpr int LDK = 136, LDV = 264;
    __syncthreads();
    if (tid < 128) { const int j = tid >> 1, hf = tid & 1; const u32x4 w = *(const u32x4*)(H + (size_t)(t0 + j) * NH + C_LR + 8 * hf); float f[8]; unpack8(w, f);
#pragma unroll
        for (int i = 0; i < 8; ++i) lrs[j * 16 + 8 * hf + i] = f[i]; }
    for (int p = tid; p < 64 * 32; p += NTHR) { const int j = p >> 5, ch = p & 31; *(LAS u32x4*)(vs + j * LDV + 8 * ch) = *(const u32x4*)(H + (size_t)(t0 + j) * NH + C_GV + h * 256 + 8 * ch); }
    __syncthreads();
    const int d = tid & 127, sg = tid >> 7;
    { float w[16];
#pragma unroll
      for (int r = 0; r < 16; ++r) w[r] = w_gla_up[(size_t)l * 16 * 512 + r * 512 + h * 128 + d];
      const float bg = b_gla[l * 512 + h * 128 + d]; float run = 0.f;
      for (int jj = 0; jj < 16; ++jj) { const int j = sg * 16 + jj; float z = bg;
#pragma unroll
          for (int r = 0; r < 16; ++r) z += lrs[j * 16 + r] * w[r];
          run += logsigmoid_f(z) * (1.0f / 16.0f); bcs[j * 128 + d] = run; }
      seg[sg * 128 + d] = run; }
    __syncthreads();
    { float pre = 0.f;
      for (int s = 0; s < sg; ++s) pre += seg[s * 128 + d];
      float* GB = wsp<float>(F, WS_GB);
      for (int jj = 0; jj < 16; ++jj) { const int j = sg * 16 + jj; const float v = bcs[j * 128 + d] + pre; bcs[j * 128 + d] = v; GB[(size_t)(t0 + j) * 512 + h * 128 + d] = v; }
      if (sg == 3) wsp<float>(F, WS_DEC)[(size_t)unit * 128 + d] = expf(bcs[63 * 128 + d]); }
    __syncthreads();
    for (int p = tid; p < 64 * 16; p += NTHR) { const int j = p >> 4, ch = p & 15; const u32x4 w = *(const u32x4*)(H + (size_t)(t0 + j) * NH + C_GK + h * 128 + 8 * ch); float f[8]; unpack8(w, f);
#pragma unroll
        for (int i = 0; i < 8; ++i) f[i] *= fexp(bcs[63 * 128 + 8 * ch + i] - bcs[j * 128 + 8 * ch + i]);
        *(LAS u32x4*)(kds + j * LDK + 8 * ch) = pack8(f); }
    __syncthreads();
    f32x4 acc[2][8];
#pragma unroll
    for (int a = 0; a < 2; ++a)
#pragma unroll
        for (int n = 0; n < 8; ++n) acc[a][n] = (f32x4){0.f, 0.f, 0.f, 0.f};
#pragma unroll
    for (int ks = 0; ks < 2; ++ks) {
        bf16x8 af[2];
#pragma unroll
        for (int a = 0; a < 2; ++a) af[a] = frag_tr(vs, LDV, 32 * ks, 32 * wave + 16 * a, lane);
#pragma unroll
        for (int n = 0; n < 8; ++n) { const bf16x8 bfr = frag_tr(kds, LDK, 32 * ks, 16 * n, lane);
#pragma unroll
            for (int a = 0; a < 2; ++a) acc[a][n] = mma16(bfr, af[a], acc[a][n]); }
    }
    float* U = wsp<float>(F, WS_GU) + (size_t)unit * 256 * 128;
#pragma unroll
    for (int a = 0; a < 2; ++a)
#pragma unroll
        for (int n = 0; n < 8; ++n) *(f32x4*)(U + (size_t)(32 * wave + 16 * a + (lane & 15)) * 128 + 16 * n + 4 * (lane >> 4)) = acc[a][n];
}

DI void gla_scan(const Frame& F) {
    const float* U = wsp<float>(F, WS_GU); const float* DEC = wsp<float>(F, WS_DEC); unsigned* S = wsp<unsigned>(F, WS_GS);
    const int gt = F.wg * NTHR + F.tid, GT = F.G * NTHR;
    for (int it = gt; it < 8 * 256 * 64; it += GT) {
        const int bh = it >> 14, r = it & 16383, e = r >> 6, dp = r & 63;
        float s0 = 0.f, s1 = 0.f;
#pragma unroll 8
        for (int c = 0; c < 64; ++c) { const size_t un = (size_t)bh * 64 + c; const size_t o = (un * 256 + e) * 128 + 2 * dp;
            const f32x2 u = *(const f32x2*)(U + o); const f32x2 dc = *(const f32x2*)(DEC + un * 128 + 2 * dp);
            S[o >> 1] = pk2(s0, s1); s0 = dc.x * s0 + u.x; s1 = dc.y * s1 + u.y; }
    }
}

DI void gla_c_unit(const Frame& F, int l, int unit, const float* gla_norm) {
    const int bh = unit >> 6, c = unit & 63, b = bh >> 2, h = bh & 3, t0 = b * SEQ + c * 64, tid = F.tid, lane = F.lane, wave = F.wave;
    const bf16* H = wsp<bf16>(F, WS_H);
    LAS bf16* qs = (LAS bf16*)(F.lds);
    LAS bf16* ks = (LAS bf16*)(F.lds + 17408);
    LAS bf16* vs = (LAS bf16*)(F.lds + 34816);
    LAS bf16* ps = (LAS bf16*)(F.lds + 68608);
    LAS float* red = (LAS float*)(F.lds + 77824);
    constexpr int LDK = 136, LDV = 264, LDP = 72;
    __syncthreads();
    const float* GB = wsp<float>(F, WS_GB);
    for (int p = tid; p < 64 * 16; p += NTHR) { const int j = p >> 4, ch = p & 15;
        const u32x4 qw = *(const u32x4*)(H + (size_t)(t0 + j) * NH + C_GQ + h * 128 + 8 * ch); const u32x4 kw = *(const u32x4*)(H + (size_t)(t0 + j) * NH + C_GK + h * 128 + 8 * ch);
        const f32x4 b0 = *(const f32x4*)(GB + (size_t)(t0 + j) * 512 + h * 128 + 8 * ch), b1 = *(const f32x4*)(GB + (size_t)(t0 + j) * 512 + h * 128 + 8 * ch + 4);
        float q[8], k[8]; unpack8(qw, q); unpack8(kw, k); const float bb[8] = {b0.x, b0.y, b0.z, b0.w, b1.x, b1.y, b1.z, b1.w};
#pragma unroll
        for (int i = 0; i < 8; ++i) { const float eb = fexp(bb[i]); q[i] *= eb * 0.08838834764831845f; k[i] *= fexp(-bb[i]); }
        *(LAS u32x4*)(qs + j * LDK + 8 * ch) = pack8(q); *(LAS u32x4*)(ks + j * LDK + 8 * ch) = pack8(k); }
    for (int p = tid; p < 64 * 32; p += NTHR) { const int j = p >> 5, ch = p & 31; *(LAS u32x4*)(vs + j * LDV + 8 * ch) = *(const u32x4*)(H + (size_t)(t0 + j) * NH + C_GV + h * 256 + 8 * ch); }
    __syncthreads();
    { const int it = wave >> 1; f32x4 sa[2] = {(f32x4){0.f, 0.f, 0.f, 0.f}, (f32x4){0.f, 0.f, 0.f, 0.f}};
#pragma unroll
      for (int kk = 0; kk < 4; ++kk) { const bf16x8 qa = frag_lds(qs, LDK, 16 * it, 32 * kk, lane);
#pragma unroll
          for (int jj = 0; jj < 2; ++jj) sa[jj] = mma16(qa, frag_lds(ks, LDK, 16 * (2 * (wave & 1) + jj), 32 * kk, lane), sa[jj]); }
#pragma unroll
      for (int jj = 0; jj < 2; ++jj)
#pragma unroll
          for (int r = 0; r < 4; ++r) { const int i = 16 * it + 4 * (lane >> 4) + r, j = 16 * (2 * (wave & 1) + jj) + (lane & 15);
              ps[i * LDP + j] = (bf16)f2bf(j <= i ? sa[jj][r] : 0.f); } }
    __syncthreads();
    f32x4 acc[2][4];
#pragma unroll
    for (int a = 0; a < 2; ++a)
#pragma unroll
        for (int n = 0; n < 4; ++n) acc[a][n] = (f32x4){0.f, 0.f, 0.f, 0.f};
    const bf16* St = wsp<bf16>(F, WS_GS) + (size_t)unit * 256 * 128;
#pragma unroll
    for (int kk = 0; kk < 4; ++kk) { bf16x8 af[2];
#pragma unroll
        for (int a = 0; a < 2; ++a) af[a] = frag_glb(St, 128, 32 * wave + 16 * a, 32 * kk, lane);
#pragma unroll
        for (int n = 0; n < 4; ++n) { const bf16x8 bq = frag_lds(qs, LDK, 16 * n, 32 * kk, lane);
#pragma unroll
            for (int a = 0; a < 2; ++a) acc[a][n] = mma16(af[a], bq, acc[a][n]); } }
#pragma unroll
    for (int kk = 0; kk < 2; ++kk) { bf16x8 af[2];
#pragma unroll
        for (int a = 0; a < 2; ++a) af[a] = frag_tr(vs, LDV, 32 * kk, 32 * wave + 16 * a, lane);
#pragma unroll
        for (int n = 0; n < 4; ++n) { const bf16x8 bp = frag_lds(ps, LDP, 16 * n, 32 * kk, lane);
#pragma unroll
            for (int a = 0; a < 2; ++a) acc[a][n] = mma16(af[a], bp, acc[a][n]); } }
#pragma unroll
    for (int n = 0; n < 4; ++n) { float s = 0.f;
#pragma unroll
        for (int a = 0; a < 2; ++a)
#pragma unroll
            for (int r = 0; r < 4; ++r) s += acc[a][n][r] * acc[a][n][r];
        s += __shfl_xor(s, 16); s += __shfl_xor(s, 32);
        if (lane < 16) red[wave * 64 + 16 * n + lane] = s; }
    __syncthreads();
    bf16* OB = wsp<bf16>(F, WS_OB);
#pragma unroll
    for (int n = 0; n < 4; ++n) { const int i = 16 * n + (lane & 15); float tot = 0.f;
#pragma unroll
        for (int w = 0; w < 8; ++w) tot += red[w * 64 + i];
        const float rs = 1.0f / sqrtf(tot * (1.0f / 256.0f) + LN_EPS);
#pragma unroll
        for (int a = 0; a < 2; ++a) { const int e = 32 * wave + 16 * a + 4 * (lane >> 4);
            const f32x4 gn = *(const f32x4*)(gla_norm + l * 1024 + h * 256 + e);
            const u32x2 gw = *(const u32x2*)(H + (size_t)(t0 + i) * NH + C_GG + h * 256 + e);
            const float g0 = bf2f(gw.x & 0xffffu), g1 = bf2f(gw.x >> 16), g2 = bf2f(gw.y & 0xffffu), g3 = bf2f(gw.y >> 16);
            u32x2 o; o.x = pk2(acc[a][n][0] * rs * gn.x * g0, acc[a][n][1] * rs * gn.y * g1); o.y = pk2(acc[a][n][2] * rs * gn.z * g2, acc[a][n][3] * rs * gn.w * g3);
            *(u32x2*)(OB + (size_t)(t0 + i) * DM + 1024 + h * 256 + e) = o; } }
}

DI void pool_unit(const Frame& F, int l, int unit, const float* pool_scale) {
    const int gi = unit & 3, tt = unit >> 2, t0 = tt * 128, tid = F.tid, lane = F.lane, wave = F.wave, w = 2 << gi;
    const bf16* H = wsp<bf16>(F, WS_H);
    LAS bf16* pl = (LAS bf16*)(F.lds);
    constexpr int LDP = 264;
    __syncthreads();
    for (int p = tid; p < 128 * 32; p += NTHR) { const int j = p >> 5, ch = p & 31, t = t0 + j, ts = t & (SEQ - 1);
        const int cnt = (ts + 1 < w) ? ts + 1 : w; float a[8];
#pragma unroll
        for (int i = 0; i < 8; ++i) a[i] = 0.f;
        float u0[8];
        const bf16* hp = H + (size_t)t * NH + C_PU + gi * 256 + 8 * ch;
        { float f[8]; unpack8(*(const u32x4*)hp, f);
#pragma unroll
          for (int i = 0; i < 8; ++i) { a[i] = f[i]; u0[i] = f[i]; } }
#pragma unroll
        for (int s = 1; s < 16; ++s) if (s < w) { const int sb = (s < cnt) ? s : 0;
            const u32x4 x = *(const u32x4*)(hp - (size_t)sb * NH); float f[8]; unpack8(x, f); const float wgt = (s < cnt) ? 1.f : 0.f;
#pragma unroll
            for (int i = 0; i < 8; ++i) a[i] += wgt * f[i]; }
        const float ic = 1.0f / (float)cnt;
#pragma unroll
        for (int i = 0; i < 8; ++i) a[i] = a[i] * ic - u0[i];
        *(LAS u32x4*)(pl + j * LDP + 8 * ch) = pack8(a); }
    __syncthreads();
    const bf16* WP = wsp<bf16>(F, WS_WPOOLT) + (size_t)(l * 4 + gi) * 256 * 256;
    f32x4 acc[2][8];
#pragma unroll
    for (int a = 0; a < 2; ++a)
#pragma unroll
        for (int n = 0; n < 8; ++n) acc[a][n] = (f32x4){0.f, 0.f, 0.f, 0.f};
#pragma unroll 2
    for (int kk = 0; kk < 8; ++kk) { bf16x8 af[2];
#pragma unroll
        for (int a = 0; a < 2; ++a) af[a] = frag_glb(WP, 256, 32 * wave + 16 * a, 32 * kk, lane);
#pragma unroll
        for (int n = 0; n < 8; ++n) { const bf16x8 bp = frag_lds(pl, LDP, 16 * n, 32 * kk, lane);
#pragma unroll
            for (int a = 0; a < 2; ++a) acc[a][n] = mma16(af[a], bp, acc[a][n]); } }
    bf16* OB = wsp<bf16>(F, WS_OB);
#pragma unroll
    for (int n = 0; n < 8; ++n) { const int t = t0 + 16 * n + (lane & 15);
#pragma unroll
        for (int a = 0; a < 2; ++a) { const int dd = gi * 256 + 32 * wave + 16 * a + 4 * (lane >> 4);
            const f32x4 sc = *(const f32x4*)(pool_scale + l * 1024 + dd);
            const u32x2 gw = *(const u32x2*)(H + (size_t)t * NH + C_PG + dd);
            const float g0 = bf2f(gw.x & 0xffffu), g1 = bf2f(gw.x >> 16), g2 = bf2f(gw.y & 0xffffu), g3 = bf2f(gw.y >> 16);
            u32x2 o; o.x = pk2(acc[a][n][0] * sc.x * g0, acc[a][n][1] * sc.y * g1); o.y = pk2(acc[a][n][2] * sc.z * g2, acc[a][n][3] * sc.w * g3);
            *(u32x2*)(OB + (size_t)t * DM + dd) = o; } }
}

DI void swa_unit(const Frame& F, int l, int unit, const float* sinks) {
    const int n = unit & 31, hq = (unit >> 5) & 15, b = unit >> 9, kvh = hq >> 3, tid = F.tid, lane = F.lane, wave = F.wave;
    const int tq0 = b * SEQ + n * 128, tk0 = tq0 - 128;
    const bf16* H = wsp<bf16>(F, WS_H); const f32x2* RT = wsp<f32x2>(F, WS_ROPE);
    constexpr int LD = 72, LDPW = 168;
    LAS bf16* qs = (LAS bf16*)(F.lds);
    LAS bf16* ks = (LAS bf16*)(F.lds + 18432);
    LAS bf16* vs = (LAS bf16*)(F.lds + 57600);
    LAS bf16* pw = (LAS bf16*)(F.lds + 96768) + wave * 16 * LDPW;
    __syncthreads();
    for (int p = tid; p < 128 * 4; p += NTHR) { const int i = p >> 2, ch = p & 3; const bf16* src = H + (size_t)(tq0 + i) * NH + C_SQ + hq * 64 + 16 * ch;
        float f[16]; { float a[8], c[8]; unpack8(*(const u32x4*)src, a); unpack8(*(const u32x4*)(src + 8), c);
#pragma unroll
            for (int j = 0; j < 8; ++j) { f[j] = a[j]; f[8 + j] = c[j]; } }
        if (ch == 0) {
#pragma unroll
            for (int j = 0; j < 8; ++j) { const f32x2 cs = RT[(size_t)(tq0 + i) * 8 + j]; const float x1 = f[j], x2 = f[8 + j]; f[j] = x1 * cs.x - x2 * cs.y; f[8 + j] = x2 * cs.x + x1 * cs.y; } }
        float o0[8], o1[8];
#pragma unroll
        for (int j = 0; j < 8; ++j) { o0[j] = f[j] * 0.125f; o1[j] = f[8 + j] * 0.125f; }
        *(LAS u32x4*)(qs + i * LD + 16 * ch) = pack8(o0); *(LAS u32x4*)(qs + i * LD + 16 * ch + 8) = pack8(o1); }
    for (int p = tid; p < 272 * 4; p += NTHR) { const int j = p >> 2, ch = p & 3; const bool ok = (j < 256) && (n > 0 || j >= 128);
        u32x4 k0 = (u32x4){0u, 0u, 0u, 0u}, k1 = k0, v0 = k0, v1 = k0;
        if (ok) { const bf16* ksrc = H + (size_t)(tk0 + j) * NH + C_SK + kvh * 64 + 16 * ch; const bf16* vsrc = H + (size_t)(tk0 + j) * NH + C_SV + kvh * 64 + 16 * ch;
            k0 = *(const u32x4*)ksrc; k1 = *(const u32x4*)(ksrc + 8); v0 = *(const u32x4*)vsrc; v1 = *(const u32x4*)(vsrc + 8);
            if (ch == 0) { float a[8], c[8]; unpack8(k0, a); unpack8(k1, c);
#pragma unroll
                for (int jj = 0; jj < 8; ++jj) { const f32x2 cs = RT[(size_t)(tk0 + j) * 8 + jj]; const float x1 = a[jj], x2 = c[jj]; a[jj] = x1 * cs.x - x2 * cs.y; c[jj] = x2 * cs.x + x1 * cs.y; }
                k0 = pack8(a); k1 = pack8(c); } }
        *(LAS u32x4*)(ks + j * LD + 16 * ch) = k0; *(LAS u32x4*)(ks + j * LD + 16 * ch + 8) = k1;
        *(LAS u32x4*)(vs + j * LD + 16 * ch) = v0; *(LAS u32x4*)(vs + j * LD + 16 * ch + 8) = v1; }
    __syncthreads();
    const int qi = 16 * wave + (lane & 15);
    bf16x8 qf[2];
#pragma unroll
    for (int s = 0; s < 2; ++s) qf[s] = frag_lds(qs, LD, 16 * wave, 32 * s, lane);
    f32x4 sc[10];
#pragma unroll
    for (int jt = 0; jt < 10; ++jt) { sc[jt] = (f32x4){0.f, 0.f, 0.f, 0.f};
#pragma unroll
        for (int s = 0; s < 2; ++s) sc[jt] = mma16(frag_lds(ks, LD, 16 * (wave + jt), 32 * s, lane), qf[s], sc[jt]); }
    const float sink = sinks[l * 16 + hq];
    float mx = sink;
#pragma unroll
    for (int jt = 0; jt < 10; ++jt)
#pragma unroll
        for (int r = 0; r < 4; ++r) { const int kj = 16 * (wave + jt) + 4 * (lane >> 4) + r; const bool ok = (kj > qi) && (kj <= qi + 128) && (n > 0 || kj >= 128);
            sc[jt][r] = ok ? sc[jt][r] : -INFINITY; mx = fmaxf(mx, sc[jt][r]); }
    mx = fmaxf(mx, __shfl_xor(mx, 16)); mx = fmaxf(mx, __shfl_xor(mx, 32));
    float sum = 0.f;
#pragma unroll
    for (int jt = 0; jt < 10; ++jt)
#pragma unroll
        for (int r = 0; r < 4; ++r) { const float p = fexp(sc[jt][r] - mx); sc[jt][r] = p; sum += p; }
    sum += __shfl_xor(sum, 16); sum += __shfl_xor(sum, 32);
    const float inv = 1.0f / (sum + fexp(sink - mx));
#pragma unroll
    for (int jt = 0; jt < 10; ++jt) { u32x2 o; o.x = pk2(sc[jt][0] * inv, sc[jt][1] * inv); o.y = pk2(sc[jt][2] * inv, sc[jt][3] * inv);
        *(LAS u32x2*)(pw + (lane & 15) * LDPW + 16 * jt + 4 * (lane >> 4)) = o; }
    LDS_WAIT();
    f32x4 oa[4];
#pragma unroll
    for (int dt = 0; dt < 4; ++dt) oa[dt] = (f32x4){0.f, 0.f, 0.f, 0.f};
#pragma unroll
    for (int s = 0; s < 5; ++s) { const bf16x8 pf = frag_lds(pw, LDPW, 0, 32 * s, lane);
#pragma unroll
        for (int dt = 0; dt < 4; ++dt) oa[dt] = mma16(frag_tr(vs, LD, 16 * wave + 32 * s, 16 * dt, lane), pf, oa[dt]); }
    bf16* OB = wsp<bf16>(F, WS_OB);
    { const int t = tq0 + qi;
#pragma unroll
      for (int dt = 0; dt < 4; ++dt) { const int dd = hq * 64 + 16 * dt + 4 * (lane >> 4);
          const u32x2 gw = *(const u32x2*)(H + (size_t)t * NH + C_SG + dd);
          const float g0 = bf2f(gw.x & 0xffffu), g1 = bf2f(gw.x >> 16), g2 = bf2f(gw.y & 0xffffu), g3 = bf2f(gw.y >> 16);
          u32x2 o; o.x = pk2(oa[dt][0] * g0, oa[dt][1] * g1); o.y = pk2(oa[dt][2] * g2, oa[dt][3] * g3);
          *(u32x2*)(OB + (size_t)t * DM + 2048 + dd) = o; } }
}

DI void mem_unit(const Frame& F, int l, int unit) {
    const int n = unit & 31, hx = (unit >> 5) & 3, b = unit >> 7, lane = F.lane, wave = F.wave, tid = F.tid;
    const int tq0 = b * SEQ + n * 128 + 16 * wave;
    const bf16* H = wsp<bf16>(F, WS_H);
    const bf16* MK = wsp<bf16>(F, WS_MK) + (size_t)l * 512 * 1024 + (size_t)b * 256 * 1024 + hx * 256;
    const bf16* MVT = wsp<bf16>(F, WS_MVT) + (size_t)l * 1024 * 512 + (size_t)hx * 256 * 512 + b * 256;
    constexpr int LDI = 264;
    LAS bf16* img = (LAS bf16*)(F.lds);
    __syncthreads();
#pragma unroll 4
    for (int p = tid; p < 256 * 32; p += NTHR) { const int r = p >> 5, ch = p & 31; *(LAS u32x4*)(img + r * LDI + 8 * ch) = *(const u32x4*)(MK + (size_t)r * 1024 + 8 * ch); }
    bf16x8 qf[8];
#pragma unroll
    for (int s = 0; s < 8; ++s) qf[s] = frag_glb(H + C_XQ + hx * 256, NH, tq0, 32 * s, lane);
    __syncthreads();
    f32x4 sc[16];
#pragma unroll
    for (int jt = 0; jt < 16; ++jt) { sc[jt] = (f32x4){0.f, 0.f, 0.f, 0.f};
#pragma unroll
        for (int s = 0; s < 8; ++s) sc[jt] = mma16(frag_lds(img, LDI, 16 * jt, 32 * s, lane), qf[s], sc[jt]);
        if (jt & 1) __builtin_amdgcn_sched_barrier(0); }
#pragma unroll
    for (int jt = 0; jt < 16; ++jt) asm volatile("" : "+v"(sc[jt]));
    __syncthreads();
#pragma unroll 4
    for (int p = tid; p < 256 * 32; p += NTHR) { const int r = p >> 5, ch = p & 31; *(LAS u32x4*)(img + r * LDI + 8 * ch) = *(const u32x4*)(MVT + (size_t)r * 512 + 8 * ch); }
    float mx = -INFINITY;
#pragma unroll
    for (int jt = 0; jt < 16; ++jt)
#pragma unroll
        for (int r = 0; r < 4; ++r) { sc[jt][r] *= 0.0625f; mx = fmaxf(mx, sc[jt][r]); }
    mx = fmaxf(mx, __shfl_xor(mx, 16)); mx = fmaxf(mx, __shfl_xor(mx, 32));
    float sum = 0.f;
#pragma unroll
    for (int jt = 0; jt < 16; ++jt)
#pragma unroll
        for (int r = 0; r < 4; ++r) { const float p = __builtin_amdgcn_exp2f((sc[jt][r] - mx) * 1.44269504089f); sc[jt][r] = p; sum += p; }
    sum += __shfl_xor(sum, 16); sum += __shfl_xor(sum, 32);
    const float inv = 1.0f / sum;
    bf16x8 pb[8];
#pragma unroll
    for (int s = 0; s < 8; ++s) { u32x4 w; w.x = pk2(sc[2 * s][0] * inv, sc[2 * s][1] * inv); w.y = pk2(sc[2 * s][2] * inv, sc[2 * s][3] * inv);
        w.z = pk2(sc[2 * s + 1][0] * inv, sc[2 * s + 1][1] * inv); w.w = pk2(sc[2 * s + 1][2] * inv, sc[2 * s + 1][3] * inv); pb[s] = __builtin_bit_cast(bf16x8, w); }
    __syncthreads();
    bf16* OB = wsp<bf16>(F, WS_OB); const int t = tq0 + (lane & 15);
    const LAS bf16* arow = img + (lane & 15) * LDI + 4 * (lane >> 4);
#pragma unroll 4
    for (int dt = 0; dt < 16; ++dt) { f32x4 oa = (f32x4){0.f, 0.f, 0.f, 0.f};
#pragma unroll
        for (int s = 0; s < 8; ++s) { const u32x2 lo = *(const LAS u32x2*)(arow + 16 * dt * LDI + 32 * s), hi = *(const LAS u32x2*)(arow + 16 * dt * LDI + 32 * s + 16);
            const u32x4 av = (u32x4){lo.x, lo.y, hi.x, hi.y};
            oa = mma16(__builtin_bit_cast(bf16x8, av), pb[s], oa); }
        __builtin_amdgcn_sched_barrier(0);
        const int dd = hx * 256 + 16 * dt + 4 * (lane >> 4);
        const u32x2 gw = *(const u32x2*)(H + (size_t)t * NH + C_XG + dd);
        const float g0 = bf2f(gw.x & 0xffffu), g1 = bf2f(gw.x >> 16), g2 = bf2f(gw.y & 0xffffu), g3 = bf2f(gw.y >> 16);
        u32x2 o; o.x = pk2(oa[0] * g0, oa[1] * g1); o.y = pk2(oa[2] * g2, oa[3] * g3);
        *(u32x2*)(OB + (size_t)t * DM + 3072 + dd) = o; }
}

#ifndef NAIVE_MASK
#define NAIVE_MASK 0
#endif
DI float Hf(const bf16* H, size_t row, int col) { return bf2f(H[row * NH + col]); }
DI void naive_mem(const Frame& F, int l) {
    const bf16* H = wsp<bf16>(F, WS_H); bf16* OB = wsp<bf16>(F, WS_OB);
    LAS float* qs = (LAS float*)(F.lds) + F.wave * 512; LAS float* ps = qs + 256;
    const int gw = F.wg * NWAVES + F.wave, NGW = F.G * NWAVES, lane = F.lane;
    for (int it = gw; it < MTOK * 4; it += NGW) {
        const int t = it >> 2, hx = it & 3, b = t / SEQ;
        const bf16* MK = wsp<bf16>(F, WS_MK) + (size_t)l * 512 * 1024 + (size_t)b * 256 * 1024 + hx * 256;
        const bf16* MVT = wsp<bf16>(F, WS_MVT) + (size_t)l * 1024 * 512 + (size_t)hx * 256 * 512 + b * 256;
        for (int i = 0; i < 4; ++i) qs[lane + 64 * i] = Hf(H, t, C_XQ + hx * 256 + lane + 64 * i);
        LDS_WAIT();
        float sc[4]; float mx = -INFINITY;
        for (int i = 0; i < 4; ++i) { const int j = lane + 64 * i; float a = 0.f; for (int d = 0; d < 256; ++d) a += qs[d] * bf2f(MK[(size_t)j * 1024 + d]); sc[i] = a * 0.0625f; mx = fmaxf(mx, sc[i]); }
        for (int o = 1; o < 64; o <<= 1) mx = fmaxf(mx, __shfl_xor(mx, o));
        float sum = 0.f; for (int i = 0; i < 4; ++i) { sc[i] = expf(sc[i] - mx); sum += sc[i]; }
        sum = wave_sum(sum);
        for (int i = 0; i < 4; ++i) ps[lane + 64 * i] = sc[i] / sum;
        LDS_WAIT();
        for (int i = 0; i < 4; ++i) { const int d = lane + 64 * i; float a = 0.f; for (int j = 0; j < 256; ++j) a += ps[j] * bf2f(MVT[(size_t)d * 512 + j]);
            OB[(size_t)t * DM + 3072 + hx * 256 + d] = (bf16)f2bf(a * Hf(H, t, C_XG + hx * 256 + d)); }
        LDS_WAIT();
    }
}
DI void naive_swa(const Frame& F, int l, const float* sinks) {
    const bf16* H = wsp<bf16>(F, WS_H); bf16* OB = wsp<bf16>(F, WS_OB); const f32x2* RT = wsp<f32x2>(F, WS_ROPE);
    LAS float* qs = (LAS float*)(F.lds) + F.wave * 256; LAS float* ps = qs + 64;
    const int gw = F.wg * NWAVES + F.wave, NGW = F.G * NWAVES, lane = F.lane;
    for (int it = gw; it < MTOK * 16; it += NGW) {
        const int t = it >> 4, hq = it & 15, kvh = hq >> 3, ts = t & (SEQ - 1);
        { float x = Hf(H, t, C_SQ + hq * 64 + lane);
          if (lane < 16) { const int i = lane & 7; const float x1 = Hf(H, t, C_SQ + hq * 64 + i), x2 = Hf(H, t, C_SQ + hq * 64 + 8 + i); const f32x2 cs = RT[(size_t)t * 8 + i];
              x = (lane < 8) ? x1 * cs.x - x2 * cs.y : x2 * cs.x + x1 * cs.y; }
          qs[lane] = x * 0.125f; }
        LDS_WAIT();
        float sc[2]; const float sink = sinks[l * 16 + hq]; float mx = sink;
        for (int i = 0; i < 2; ++i) { const int back = lane + 64 * i; sc[i] = -INFINITY;
            if (back <= ts) { const int tk = t - back; float a = 0.f;
                for (int d = 0; d < 64; ++d) { float kv = Hf(H, tk, C_SK + kvh * 64 + d);
                    if (d < 16) { const int ii = d & 7; const float x1 = Hf(H, tk, C_SK + kvh * 64 + ii), x2 = Hf(H, tk, C_SK + kvh * 64 + 8 + ii); const f32x2 cs = RT[(size_t)tk * 8 + ii];
                        kv = (d < 8) ? x1 * cs.x - x2 * cs.y : x2 * cs.x + x1 * cs.y; }
                    a += qs[d] * kv; }
                sc[i] = a; }
            mx = fmaxf(mx, sc[i]); }
        for (int o = 1; o < 64; o <<= 1) mx = fmaxf(mx, __shfl_xor(mx, o));
        float sum = 0.f; for (int i = 0; i < 2; ++i) { sc[i] = expf(sc[i] - mx); sum += sc[i]; }
        sum = wave_sum(sum) + expf(sink - mx);
        for (int i = 0; i < 2; ++i) ps[lane + 64 * i] = sc[i] / sum;
        LDS_WAIT();
        { float a = 0.f; const int nk = (ts + 1 < 128) ? ts + 1 : 128;
          for (int back = 0; back < nk; ++back) a += ps[back] * Hf(H, t - back, C_SV + kvh * 64 + lane);
          OB[(size_t)t * DM + 2048 + hq * 64 + lane] = (bf16)f2bf(a * Hf(H, t, C_SG + hq * 64 + lane)); }
        LDS_WAIT();
    }
}
DI void naive_pool(const Frame& F, int l, const float* w_pool, const float* pool_scale) {
    const bf16* H = wsp<bf16>(F, WS_H); bf16* OB = wsp<bf16>(F, WS_OB); LAS float* pl = (LAS float*)(F.lds);
    for (int unit = F.wg; unit < 512; unit += F.G) { const int gi = unit & 3, t0 = (unit >> 2) * 64, w = 2 << gi;
        __syncthreads();
        for (int p = F.tid; p < 64 * 256; p += NTHR) { const int j = p >> 8, c = p & 255, t = t0 + j, ts = t & (SEQ - 1); const int cnt = (ts + 1 < w) ? ts + 1 : w; float a = 0.f;
            for (int s2 = 0; s2 < cnt; ++s2) a += Hf(H, t - s2, C_PU + gi * 256 + c);
            pl[p] = a / (float)cnt - Hf(H, t, C_PU + gi * 256 + c); }
        __syncthreads();
        const float* W = w_pool + (size_t)(l * 4 + gi) * 256 * 256;
        for (int o = F.tid; o < 64 * 256; o += NTHR) { const int j = o >> 8, d = o & 255; float a = 0.f; for (int c = 0; c < 256; ++c) a += pl[j * 256 + c] * W[c * 256 + d];
            const int t = t0 + j; OB[(size_t)t * DM + gi * 256 + d] = (bf16)f2bf(a * pool_scale[l * 1024 + gi * 256 + d] * Hf(H, t, C_PG + gi * 256 + d)); } }
}
DI void naive_gla(const Frame& F, int l, const float* w_gla_up, const float* b_gla) {
    const bf16* H = wsp<bf16>(F, WS_H); float* RAW = wsp<float>(F, WS_GU); LAS float* red = (LAS float*)(F.lds);
    for (int unit = F.wg; unit < 64; unit += F.G) { const int bh = unit >> 3, es = unit & 7, b = bh >> 2, h = bh & 3, e = es * 32 + (F.tid & 31), dg = F.tid >> 5;
        float S[8], wu[8][16], bg[8];
        for (int i = 0; i < 8; ++i) { S[i] = 0.f; bg[i] = b_gla[l * 512 + h * 128 + 8 * dg + i]; for (int r = 0; r < 16; ++r) wu[i][r] = w_gla_up[(size_t)l * 16 * 512 + r * 512 + h * 128 + 8 * dg + i]; }
        for (int ts = 0; ts < SEQ; ++ts) { const size_t t = (size_t)b * SEQ + ts; float lr[16]; for (int r = 0; r < 16; ++r) lr[r] = Hf(H, t, C_LR + r);
            const float v = Hf(H, t, C_GV + h * 256 + e); float part = 0.f;
            for (int i = 0; i < 8; ++i) { float z = bg[i]; for (int r = 0; r < 16; ++r) z += lr[r] * wu[i][r];
                const float a = expf((fminf(z, 0.f) - log1pf(expf(-fabsf(z)))) * (1.0f / 16.0f));
                S[i] = a * S[i] + Hf(H, t, C_GK + h * 128 + 8 * dg + i) * v; part += Hf(H, t, C_GQ + h * 128 + 8 * dg + i) * 0.08838834764831845f * S[i]; }
            __syncthreads(); red[dg * 32 + (F.tid & 31)] = part; __syncthreads();
            if (dg == 0) { float o = 0.f; for (int g = 0; g < 16; ++g) o += red[g * 32 + (F.tid & 31)]; RAW[t * 1024 + h * 256 + e] = o; } } }
}
DI void naive_gla_norm(const Frame& F, int l, const float* gla_norm) {
    const bf16* H = wsp<bf16>(F, WS_H); bf16* OB = wsp<bf16>(F, WS_OB); const float* RAW = wsp<float>(F, WS_GU);
    const int gw = F.wg * NWAVES + F.wave, NGW = F.G * NWAVES, lane = F.lane;
    for (int it = gw; it < MTOK * 4; it += NGW) { const int t = it >> 2, h = it & 3; float o[4], ss = 0.f;
        for (int i = 0; i < 4; ++i) { o[i] = RAW[(size_t)t * 1024 + h * 256 + lane + 64 * i]; ss += o[i] * o[i]; }
        ss = wave_sum(ss); const float rs = 1.0f / sqrtf(ss * (1.0f / 256.0f) + LN_EPS);
        for (int i = 0; i < 4; ++i) { const int e = lane + 64 * i; OB[(size_t)t * DM + 1024 + h * 256 + e] = (bf16)f2bf(o[i] * rs * gla_norm[l * 1024 + h * 256 + e] * Hf(H, t, C_GG + h * 256 + e)); } }
}

DI void ln_phase(const Frame& F, int l, const float* ln_g, const float* ln_b) {
    const int gw = F.wg * NWAVES + F.wave, NGW = F.G * NWAVES, lane = F.lane;
    const float* g = ln_g + l * DM; const float* bb = ln_b + l * DM;
    for (int m = gw; m < MTOK; m += NGW) {
        f32x4* row = (f32x4*)(F.out + (size_t)m * DM) + lane; const f32x4* zrow = (const f32x4*)(wsp<float>(F, WS_Z) + (size_t)m * DM) + lane;
        f32x4 v[16]; float s = 0.f;
#pragma unroll
        for (int j = 0; j < 16; ++j) { v[j] = zrow[64 * j]; s += (v[j].x + v[j].y) + (v[j].z + v[j].w); }
        const float mean = wave_sum(s) * (1.f / DM); float s2 = 0.f;
#pragma unroll
        for (int j = 0; j < 16; ++j) { v[j] = v[j] - mean; s2 += (v[j].x * v[j].x + v[j].y * v[j].y) + (v[j].z * v[j].z + v[j].w * v[j].w); }
        const float rstd = 1.f / sqrtf(wave_sum(s2) * (1.f / DM) + LN_EPS);
        u32x2* xb = (u32x2*)(wsp<bf16>(F, WS_XB) + (size_t)m * DM) + lane; unsigned* x8 = (unsigned*)(wsp<unsigned char>(F, WS_X8) + (size_t)m * DM) + lane;
#pragma unroll
        for (int j = 0; j < 16; ++j) { const f32x4 gg = *((const f32x4*)g + lane + 64 * j), be = *((const f32x4*)bb + lane + 64 * j);
            const f32x4 o = v[j] * rstd * gg + be; row[64 * j] = o;
            if (l + 1 < DEPTH) { u32x2 w; w.x = pk2(o.x, o.y); w.y = pk2(o.z, o.w); xb[64 * j] = w; x8[64 * j] = pk4_fp8(o.x * X8_SCALE, o.y * X8_SCALE, o.z * X8_SCALE, o.w * X8_SCALE); } }
    }
}

struct Args { const void* in[15]; float* out; unsigned char* ws; int ph_lo, ph_hi; };
constexpr int PH_PER_LAYER = 7, N_PHASES = 1 + PH_PER_LAYER * DEPTH;
#define IN(k) (lo <= (k) && (k) < hi)
#ifndef PH_MASK
#define PH_MASK 0xffff
#endif
#define PHM(b) ((PH_MASK >> (b)) & 1)
#ifndef REP_MASK
#define REP_MASK 0
#endif
#define REPS(b) (((REP_MASK >> (b)) & 1) ? 2 : 1)
#define SEAM(k) do { if (IN(k) && IN((k) + 1)) xcd_barrier(bar); } while (0)
template <int l> DI void layer_body(const Frame& F, const Args& args, const int lo, const int hi, const XcdBarrier& bar) {
        const int p0 = 1 + PH_PER_LAYER * l;
        if (PHM(1) && IN(p0)) { {
            SchedInProj S; S.G = F.G; S.c = F.wg; S.n_extra = (l == 0) ? 32 : 0; S.XB = (const char*)(F.ws + WS_XB); S.WT = (const char*)(F.ws + WS_WINT) + (size_t)l * NH * 4096 * 2;
            S.MEMB = (const char*)(F.ws + WS_MEMB); S.WKV = (const char*)(F.ws + WS_WMKVT);
            EpiH E{wsp<bf16>(F, WS_H), wsp<bf16>(F, WS_MK), wsp<bf16>(F, WS_MVT)};
            pg8::gemm_phase<EpiH, SchedInProj, 2, true>(F.lds, 4096, S, E);
            pg8::SchedStatic S8; S8.nM = 32; S8.nN = N_F8 / (128 * F8NB); S8.G = F.G; S8.c = (F.wg + F8_ROT) % F.G; S8.A = (const char*)(F.ws + WS_X8); S8.B = (const char*)(F.ws + WS_W8) + (size_t)l * N_F8 * 4096;
            S8.astep = (size_t)256 * 4096; S8.bstep = (size_t)(128 * F8NB) * 4096;
            EpiMG<F8NB> E8{wsp<bf16>(F, WS_H)};
            pg8::gemm_phase<EpiMG<F8NB>, pg8::SchedStatic, F8NB, true, true>(F.lds, 2048, S8, E8);
        }
        if (REPS(1) == 2) {
            SchedInProj S; S.G = F.G; S.c = F.wg; S.n_extra = (l == 0) ? 32 : 0; S.XB = (const char*)(F.ws + WS_XB); S.WT = (const char*)(F.ws + WS_WINT) + (size_t)l * NH * 4096 * 2;
            S.MEMB = (const char*)(F.ws + WS_MEMB); S.WKV = (const char*)(F.ws + WS_WMKVT);
            EpiH E{wsp<bf16>(F, WS_H), wsp<bf16>(F, WS_MK), wsp<bf16>(F, WS_MVT)};
            pg8::gemm_phase<EpiH, SchedInProj, 2, true>(F.lds, 4096, S, E);
            pg8::SchedStatic S8; S8.nM = 32; S8.nN = N_F8 / (128 * F8NB); S8.G = F.G; S8.c = (F.wg + F8_ROT) % F.G; S8.A = (const char*)(F.ws + WS_X8); S8.B = (const char*)(F.ws + WS_W8) + (size_t)l * N_F8 * 4096;
            S8.astep = (size_t)256 * 4096; S8.bstep = (size_t)(128 * F8NB) * 4096;
            EpiMG<F8NB> E8{wsp<bf16>(F, WS_H)};
            pg8::gemm_phase<EpiMG<F8NB>, pg8::SchedStatic, F8NB, true, true>(F.lds, 2048, S8, E8);
        } }
        SEAM(p0);
        if (PHM(2) && IN(p0 + 1)) for (int rep = 0; rep < REPS(2); ++rep) { if (NAIVE_MASK & 2) naive_gla(F, l, (const float*)args.in[6], (const float*)args.in[7]); else for (int u = F.wg; u < 512; u += F.G) gla_a_unit(F, l, u, (const float*)args.in[6], (const float*)args.in[7]); }
        SEAM(p0 + 1);
        if (PHM(3) && IN(p0 + 2)) for (int rep = 0; rep < REPS(3); ++rep) { if (!(NAIVE_MASK & 2)) gla_scan(F); }
        SEAM(p0 + 2);
        if (PHM(4) && IN(p0 + 3)) for (int rep = 0; rep < REPS(4); ++rep) {
            if (NAIVE_MASK & 2) naive_gla_norm(F, l, (const float*)args.in[8]); else
            for (int r2 = 0; r2 < REPS(8); ++r2) for (int u = F.wg; u < 512; u += F.G) gla_c_unit(F, l, u, (const float*)args.in[8]);
            if (NAIVE_MASK & 1) naive_pool(F, l, (const float*)args.in[4], (const float*)args.in[5]); else
            for (int r2 = 0; r2 < REPS(9); ++r2) for (int u = F.wg; u < 256; u += F.G) pool_unit(F, l, u, (const float*)args.in[5]);
            __syncthreads();
            if (NAIVE_MASK & 4) naive_swa(F, l, (const float*)args.in[9]); else
            for (int r2 = 0; r2 < REPS(10); ++r2) for (int u = F.wg; u < 1024; u += F.G) swa_unit(F, l, u, (const float*)args.in[9]);
            __syncthreads();
            if (NAIVE_MASK & 8) naive_mem(F, l); else
            for (int r2 = 0; r2 < REPS(11); ++r2) for (int u = F.wg; u < 256; u += F.G) mem_unit(F, l, u);
            __syncthreads();
        }
        SEAM(p0 + 3);
        if (PHM(5) && IN(p0 + 4)) { {
            pg8::SchedStatic S; S.nM = 32; S.nN = 32; S.G = F.G; S.c = F.wg; S.A = (const char*)(F.ws + WS_OB); S.B = (const char*)(F.ws + WS_WBRT) + (size_t)l * 4096 * 4096 * 2;
            S.astep = (size_t)256 * 4096 * 2; S.bstep = (size_t)128 * 4096 * 2;
            EpiGate E{wsp<bf16>(F, WS_H), wsp<bf16>(F, WS_YB)};
            pg8::gemm_phase<EpiGate, pg8::SchedStatic, 1, true>(F.lds, 4096, S, E);
        }
        if (REPS(5) == 2) {
            pg8::SchedStatic S; S.nM = 32; S.nN = 32; S.G = F.G; S.c = F.wg; S.A = (const char*)(F.ws + WS_OB); S.B = (const char*)(F.ws + WS_WBRT) + (size_t)l * 4096 * 4096 * 2;
            S.astep = (size_t)256 * 4096 * 2; S.bstep = (size_t)128 * 4096 * 2;
            EpiGate E{wsp<bf16>(F, WS_H), wsp<bf16>(F, WS_YB)};
            pg8::gemm_phase<EpiGate, pg8::SchedStatic, 1, true>(F.lds, 4096, S, E);
        } }
        SEAM(p0 + 4);
        if (PHM(6) && IN(p0 + 5)) { {
            pg8::SchedStatic S; S.nM = 32; S.nN = 16; S.G = F.G; S.c = F.wg; S.A = (const char*)(F.ws + WS_YB); S.B = (const char*)(F.ws + WS_WOUTT) + (size_t)l * 4096 * 4096 * 2;
            S.astep = (size_t)256 * 4096 * 2; S.bstep = (size_t)256 * 4096 * 2;
            EpiRes E{l == 0 ? (const float*)args.in[0] : (const float*)F.out, wsp<float>(F, WS_Z)};
            pg8::gemm_phase<EpiRes, pg8::SchedStatic, 2, true>(F.lds, 4096, S, E);
        }
        if (REPS(6) == 2) {
            pg8::SchedStatic S; S.nM = 32; S.nN = 16; S.G = F.G; S.c = F.wg; S.A = (const char*)(F.ws + WS_YB); S.B = (const char*)(F.ws + WS_WOUTT) + (size_t)l * 4096 * 4096 * 2;
            S.astep = (size_t)256 * 4096 * 2; S.bstep = (size_t)256 * 4096 * 2;
            EpiRes E{l == 0 ? (const float*)args.in[0] : (const float*)F.out, wsp<float>(F, WS_Z)};
            pg8::gemm_phase<EpiRes, pg8::SchedStatic, 2, true>(F.lds, 4096, S, E);
        } }
        SEAM(p0 + 5);
        if (PHM(7) && IN(p0 + 6)) for (int rep = 0; rep < REPS(7); ++rep) { ln_phase(F, l, (const float*)args.in[13], (const float*)args.in[14]); }
        SEAM(p0 + 6);
}


__global__ void __launch_bounds__(NTHR, 2) mk_fwd(Args args) {
    extern __shared__ __attribute__((aligned(16))) unsigned char lds_raw[];
    Frame F;
    F.lds = (LAS unsigned char*)lds_raw;
    F.tid = threadIdx.x; F.lane = F.tid & 63; F.wave = __builtin_amdgcn_readfirstlane(F.tid >> 6); F.G = gridDim.x; F.wg = blockIdx.x;
    F.out = args.out; F.ws = args.ws;
    volatile LAS unsigned* MISC = (volatile LAS unsigned*)(F.lds + MISC_OFF);
    for (int u = F.tid; u < (LDS_BYTES - LDSCTL_OFF) / 4; u += NTHR) ((LAS unsigned*)(F.lds + LDSCTL_OFF))[u] = 0u;
    __syncthreads();
    unsigned* barw = (unsigned*)(F.ws + WS_CTL) + CW_BAR;
    XcdBarrier bar; bar.bar = barw; bar.x = 0; bar.st = nullptr;
    const int lo = args.ph_lo, hi = args.ph_hi;
    if (hi - lo > 1) bar = xcd_barrier_post(barw, MISC + 8);

    if (PHM(0) && IN(0)) for (int rep = 0; rep < REPS(0); ++rep) { prologue(F, (const float*)args.in[0], (const float*)args.in[1], (const int*)args.in[2], (const float*)args.in[3], (const float*)args.in[4], (const float*)args.in[10], (const float*)args.in[11], (const float*)args.in[12]); }
    SEAM(0);
    layer_body<0>(F, args, lo, hi, bar);
    layer_body<1>(F, args, lo, hi, bar);
#undef IN
#undef SEAM
}

extern "C" void kernel_launch(void* const* d_in, const int* in_sizes, int n_in, void* d_out, int out_size, void* d_ws, size_t ws_size, hipStream_t stream) {
    static int grid = 0;
    if (grid == 0) {
        if (n_in != 15 || out_size != MTOK * DM || ws_size < WS_END) { fprintf(stderr, "kernel_launch: unexpected sizes (n_in %d, out %d, ws %zu); nothing launched\n", n_in, out_size, ws_size); grid = -1; return; }
        int dev = 0, cus = 0, per_cu = 0;
        if (hipGetDevice(&dev) != hipSuccess || hipDeviceGetAttribute(&cus, hipDeviceAttributeMultiprocessorCount, dev) != hipSuccess) { grid = -1; return; }
        if (hipFuncSetAttribute((const void*)mk_fwd, hipFuncAttributeMaxDynamicSharedMemorySize, LDS_BYTES) != hipSuccess) { fprintf(stderr, "kernel_launch: hipFuncSetAttribute failed\n"); grid = -1; return; }
        if (hipOccupancyMaxActiveBlocksPerMultiprocessor(&per_cu, (const void*)mk_fwd, NTHR, LDS_BYTES) != hipSuccess || per_cu < 1) fprintf(stderr, "kernel_launch: occupancy query says %d\n", per_cu);
        (void)hipGetLastError();
        grid = cus;
    }
    if (grid < 0) return;
    (void)hipMemsetAsync((char*)d_ws + WS_CTL, 0, CTL_ZERO_BYTES, stream);
    Args a{};
    for (int i = 0; i < 15; ++i) a.in[i] = d_in[i];
    a.out = (float*)d_out; a.ws = (unsigned char*)d_ws;
#if MK_PER_PHASE
    for (int p = 0; p < N_PHASES; ++p) { a.ph_lo = p; a.ph_hi = p + 1; hipLaunchKernelGGL(mk_fwd, dim3(grid), dim3(NTHR), LDS_BYTES, stream, a); }
#else
    a.ph_lo = 0; a.ph_hi = N_PHASES;
    hipLaunchKernelGGL(mk_fwd, dim3(grid), dim3(NTHR), LDS_BYTES, stream, a);
#endif
}
```

```cpp
#include <hip/hip_runtime.h>
#include <cstdio>
#include <cstdint>

#ifndef F8ASM1
#define F8ASM1 0
#endif
#ifndef F8NB
#define F8NB 2
#endif
#ifndef MK_PER_PHASE
#define MK_PER_PHASE 0
#endif

#define DI __device__ __forceinline__
#define LAS __attribute__((address_space(3)))
#define GAS __attribute__((address_space(1)))
typedef unsigned short bf16;
typedef short bf16x8 __attribute__((ext_vector_type(8)));
typedef short s16x4 __attribute__((ext_vector_type(4)));
typedef short v4i16_t __attribute__((ext_vector_type(4)));
typedef float f32x4 __attribute__((ext_vector_type(4)));
typedef float f32x2 __attribute__((ext_vector_type(2)));
typedef unsigned u32x4 __attribute__((ext_vector_type(4)));
typedef unsigned u32x2 __attribute__((ext_vector_type(2)));

constexpr int BATCH = 2, SEQ = 4096, DM = 4096, MTOK = BATCH * SEQ, DEPTH = 2;
constexpr int D_IN = 25872, NH = 26112;
constexpr int BW = 1024;
constexpr int MEMLEN = 256;
constexpr int C_PU = 0, C_PG = 1024, C_GQ = 2048, C_GK = 2560, C_GV = 3072, C_GG = 4096, C_SQ = 5120, C_SK = 6144, C_SV = 6272, C_SG = 6400, C_XQ = 7424, C_XG = 8448, C_MG = 9472, C_LR = 25856;
constexpr float LN_EPS = 1e-5f;
constexpr float DN_ALPHA = 1.41421356237309515f;

constexpr size_t MiB = 1u << 20;
constexpr size_t WS_CTL = 0, CTL_ZERO_BYTES = 1 * MiB;
constexpr size_t WS_ROPE = 1 * MiB;
constexpr size_t WS_WPOOLT = 2 * MiB;
constexpr size_t WS_MEMB = 4 * MiB;
constexpr size_t WS_MK = 8 * MiB;
constexpr size_t WS_MVT = 10 * MiB;
constexpr size_t WS_DEC = 12 * MiB;
constexpr size_t WS_WMKVT = 16 * MiB;
constexpr size_t WS_WBRT = 48 * MiB;
constexpr size_t WS_WOUTT = 112 * MiB;
constexpr size_t WS_XB = 176 * MiB;
constexpr size_t WS_OB = 240 * MiB;
constexpr size_t WS_YB = 304 * MiB;
constexpr size_t WS_GU = 368 * MiB;
constexpr size_t WS_GS = 432 * MiB;
constexpr size_t WS_GB = 464 * MiB;
constexpr size_t WS_WINT = 512 * MiB;
constexpr size_t WS_H = 928 * MiB;
constexpr size_t WS_Z = 1336 * MiB;
constexpr size_t WS_X8 = 1464 * MiB;
constexpr size_t WS_W8 = 1496 * MiB;
constexpr size_t WS_END = 1660 * MiB;
constexpr int C_F8 = C_SQ, N_F8 = C_LR - C_F8;
#ifndef STAGE_LATE
#define STAGE_LATE 0
#endif
#ifndef PRO_NFAST
#define PRO_NFAST 1
#endif
#ifndef BLK_GATE
#define BLK_GATE 1
#endif
#ifndef BLK_OUT
#define BLK_OUT 1
#endif
#ifndef F6_FIRST
#define F6_FIRST 1
#endif
#ifndef F8_ROT
#define F8_ROT 64
#endif
#ifndef F6
#define F6 1
#endif
constexpr size_t W8_LAYER = F6 ? (size_t)(N_F8 / 128) * 32 * 12288 : (size_t)N_F8 * 4096;
constexpr float X8_SCALE = F6 ? 2.0f : 16.0f, W8_SCALE = F6 ? 128.0f : 2048.0f, MG_DESCALE = 1.0f / (X8_SCALE * W8_SCALE);
constexpr int CW_BAR = 4096;

constexpr int RING_BYTES = 131072;
constexpr int THIN_BYTES = 141312;
constexpr int LDSCTL_OFF = THIN_BYTES, MISC_OFF = LDSCTL_OFF + 320;
constexpr int LDS_BYTES = 147456;
constexpr int NWAVES = 8, NTHR = 512;

DI float bf2f(unsigned v) { return __builtin_bit_cast(float, v << 16); }
DI unsigned f2bf(float f) { unsigned u = __builtin_bit_cast(unsigned, f); return (u + 0x7fffu + ((u >> 16) & 1u)) >> 16; }
typedef float f32x2_t __attribute__((ext_vector_type(2))); typedef __bf16 bf16x2_t __attribute__((ext_vector_type(2)));
DI unsigned cvt_pk_bf16(float lo, float hi) { const f32x2_t v = {lo, hi}; const bf16x2_t b = __builtin_convertvector(v, bf16x2_t); return __builtin_bit_cast(unsigned, b); }
DI unsigned pk2(float lo, float hi) { return cvt_pk_bf16(lo, hi); }
DI float fast_sigmoid(float v) { return __builtin_amdgcn_rcpf(1.0f + __builtin_amdgcn_exp2f(-1.44269504089f * v)); }
DI void unpack8(const u32x4 w, float (&f)[8]) {
    f[0] = bf2f(w.x & 0xffffu); f[1] = bf2f(w.x >> 16); f[2] = bf2f(w.y & 0xffffu); f[3] = bf2f(w.y >> 16);
    f[4] = bf2f(w.z & 0xffffu); f[5] = bf2f(w.z >> 16); f[6] = bf2f(w.w & 0xffffu); f[7] = bf2f(w.w >> 16);
}
DI u32x4 pack8(const float (&f)[8]) { u32x4 w; w.x = pk2(f[0], f[1]); w.y = pk2(f[2], f[3]); w.z = pk2(f[4], f[5]); w.w = pk2(f[6], f[7]); return w; }
DI float clamp448(float v) { return fminf(fmaxf(v, -448.0f), 448.0f); }
DI unsigned pk4_fp8(float a, float b, float c, float d) {
    int w = 0; w = __builtin_amdgcn_cvt_pk_fp8_f32(clamp448(a), clamp448(b), w, false); w = __builtin_amdgcn_cvt_pk_fp8_f32(clamp448(c), clamp448(d), w, true); return (unsigned)w; }
typedef int v8i32 __attribute__((ext_vector_type(8)));
typedef int v6i32 __attribute__((ext_vector_type(6)));
typedef int v4i32 __attribute__((ext_vector_type(4)));
typedef unsigned u32x6 __attribute__((ext_vector_type(6)));
typedef float f32x16 __attribute__((ext_vector_type(16)));
DI void pk32_fp6(const float (&f)[32], u32x4& lo, u32x4& hi) {
    f32x16 a, b;
#pragma unroll
    for (int i = 0; i < 16; ++i) { a[i] = f[i]; b[i] = f[16 + i]; }
    const u32x6 r = __builtin_amdgcn_cvt_scalef32_2xpk16_fp6_f32(a, b, 1.0f);
    lo.x = r[0]; lo.y = r[1]; lo.z = r[2]; lo.w = r[3]; hi.x = r[4]; hi.y = r[5]; hi.z = 0u; hi.w = 0u;
}
DI f32x4 mma16(bf16x8 a, bf16x8 b, f32x4 c) { return __builtin_amdgcn_mfma_f32_16x16x32_bf16(a, b, c, 0, 0, 0); }
DI bf16x8 frag_lds(const LAS bf16* img, int ld, int idx0, int k0, int lane) { return *(const LAS bf16x8*)(img + (idx0 + (lane & 15)) * ld + k0 + 8 * (lane >> 4)); }
DI bf16x8 frag_glb(const bf16* img, size_t ld, int idx0, int k0, int lane) { return *(const bf16x8*)(img + (size_t)(idx0 + (lane & 15)) * ld + k0 + 8 * (lane >> 4)); }
DI s16x4 tr4(const LAS bf16* p) { return __builtin_bit_cast(s16x4, __builtin_amdgcn_ds_read_tr16_b64_v4i16((LAS v4i16_t*)p)); }
DI bf16x8 frag_tr(const LAS bf16* img, int ld, int k0, int idx0, int lane) {
    const int g = lane >> 4, q = (lane >> 2) & 3, p = lane & 3;
    const LAS bf16* a0 = img + (k0 + 8 * g + q) * ld + idx0 + 4 * p;
    const s16x4 lo = tr4(a0), hi = tr4(a0 + 4 * ld);
    return __builtin_shufflevector(lo, hi, 0, 1, 2, 3, 4, 5, 6, 7);
}
DI float wave_sum(float v) {
#pragma unroll
    for (int o = 1; o < 64; o <<= 1) v += __shfl_xor(v, o);
    return v;
}
#define LDS_WAIT() asm volatile("s_waitcnt lgkmcnt(0)" ::: "memory")
#define VM_WAIT() asm volatile("s_waitcnt vmcnt(0)" ::: "memory")

namespace pg8 {
constexpr int BM = 256, BK = 64, HALF = 128, HTB = HALF * BK * 2, STAGE_BYTES = 8 * HTB, NXCD = 8, WGM = 8;
__host__ __device__ __forceinline__ int lds_byte(int r, int c) { const int st = (r >> 4) * 2 + (c >> 5), rr = r & 15, cc = c & 31, ob = rr * 64 + cc * 2; return st * 1024 + (ob ^ (((ob >> 9) & 1) << 5)); }
__host__ __device__ __forceinline__ void stage_rc(int b, int& R, int& C) { const int st = b / 1024, sb = b % 1024, swz = sb ^ (((sb >> 9) & 1) << 5); R = (st >> 1) * 16 + swz / 64; C = (st & 1) * 32 + (swz % 64) / 2; }
__host__ __device__ __forceinline__ int perm32(int rho) { const int n = rho >> 4, i = rho & 15; return 8 * (i >> 2) + 4 * n + (i & 3); }
__host__ __device__ __forceinline__ int invperm32(int v) { return 16 * ((v >> 2) & 1) + 4 * (v >> 3) + (v & 3); }
template <bool PERM> __host__ __device__ __forceinline__ size_t blk_off(int row, int k, int NT) {
    const int r = PERM ? ((row & ~31) + invperm32(row & 31)) : row;
    return ((size_t)(r >> 7) * NT + (k >> 6)) * 16384 + lds_byte(r & 127, k & 63);
}
__host__ __device__ __forceinline__ void f6_off(int row, int step, int q, size_t& lo, size_t& hi) {
    const int ht = row >> 7, rb = (row >> 4) & 7, rr = row & 15;
    const size_t base = ((size_t)ht * 32 + step) * 12288;
    lo = base + rb * 1024 + lds_byte(rr, q * 8);
    hi = base + 8192 + rb * 512 + q * 128 + rr * 8;
}

struct Unit { int pm, pn, gi; };

DI void static_tile(int L, int nM, int nN, int& pm, int& pn) {
    const int nwg = nM * nN; int wgid = L;
    { const int q = nwg / NXCD, r = nwg % NXCD, xcd = wgid % NXCD, off = wgid / NXCD; wgid = (xcd < r ? xcd * (q + 1) : r * (q + 1) + (xcd - r) * q) + off; }
    const int nig = WGM * nN, gid = wgid / nig, fm = gid * WGM, gsz = (nM - fm) < WGM ? (nM - fm) : WGM;
    pm = fm + ((wgid % nig) % gsz); pn = (wgid % nig) / gsz;
}
struct SchedStatic {
    static constexpr bool BLK = false;
    int nM, nN, G, c; const char* A; const char* B; size_t astep, bstep;
    DI bool next(int i, Unit& u) const { const long L = (long)i * G + c; if (L >= (long)nM * nN) return false; static_tile((int)L, nM, nN, u.pm, u.pn); u.gi = 0; return true; }
    DI const char* abase(const Unit& u) const { return A + (size_t)u.pm * astep; }
    DI const char* bbase(const Unit& u) const { return B + (size_t)u.pn * bstep; }
};
struct SchedStaticBlk : SchedStatic { static constexpr bool BLK = true; };

template <class Epi, class Sched, int NB, bool ALIGN_EPI, bool F8 = false>
DI void gemm_phase(LAS unsigned char* lds, const int K, const Sched& S, const Epi& E) {
    const int tid = threadIdx.x, wid = __builtin_amdgcn_readfirstlane(tid >> 6), lane = tid & 63, wr = wid >> 2, wc = wid & 3, fr = lane & 15, fq = lane >> 4;
    const int nt = K / BK;
    constexpr bool FP6 = F8 && (F6 != 0);
    unsigned voffA[2], voffB[2];
#pragma unroll
    for (int i = 0; i < 2; ++i) { int R, C; stage_rc(tid * 16 + i * 8192, R, C); const int Rb = Epi::PERM ? ((R & ~31) + perm32(R & 31)) : R;
        voffA[i] = (unsigned)(R * K + C) * 2u; voffB[i] = (unsigned)(Rb * K + C) * 2u;
        if constexpr (FP6) { voffA[i] = (unsigned)(((wid & 3) + 4 * i) * 1024 + lane * 16); voffB[i] = voffA[i]; }
        if constexpr (Sched::BLK) { voffA[i] = (unsigned)((wid + 8 * i) * 1024 + lane * 16); voffB[i] = voffA[i]; } }
    const unsigned voffS = (unsigned)((8 + (wid & 3)) * 1024 + lane * 16);
    const size_t kstep = FP6 ? (size_t)12288 : (Sched::BLK ? (size_t)16384 : (size_t)(BK * 2));
    const size_t hstep = FP6 ? (size_t)nt * 12288 : (Sched::BLK ? (size_t)nt * 16384 : (size_t)HALF * K * 2);
    const unsigned ldsw = (unsigned)wid * 1024u;
    const int swz6 = lds_byte(fr, fq * 8), hof6 = fq * 128 + fr * 8;
    const int aoff6 = wr * 4096 + swz6, ahi6 = 8192 + wr * 2048 + hof6, boff6 = wc * 2048 + swz6, bhi6 = 8192 + wc * 1024 + hof6;
    const int aoff = lds_byte(wr * 64 + fr, fq * 8), boff = lds_byte(wc * 32 + fr, fq * 8);
    constexpr int KOFF = 1024;
    const unsigned one_scale = 0x7f7f7f7fu;
#define PG8_SA(b, h) (((b) * 2 + (h)) * HTB)
#define PG8_SB(b, h) ((4 + (b) * 2 + (h)) * HTB)
#define PG8_STAGE(bufoff, gbase, voff) do { if constexpr (FP6) { \
        if ((wid >> 2) != (((bufoff) / HTB) & 1)) { _Pragma("unroll") for (int _i = 0; _i < 2; ++_i) \
            __builtin_amdgcn_global_load_lds((const unsigned*)((const char*)(gbase) + voffA[_i]), (LAS unsigned*)(lds + (bufoff) + (wid & 3) * 1024 + _i * 4096), 16, 0, 0); } \
        else __builtin_amdgcn_global_load_lds((const unsigned*)((const char*)(gbase) + voffS), (LAS unsigned*)(lds + (bufoff) + 8192 + (wid & 3) * 1024), 16, 0, 0); \
    } else { _Pragma("unroll") for (int _i = 0; _i < 2; ++_i) \
        __builtin_amdgcn_global_load_lds((const unsigned*)((const char*)(gbase) + (voff)[_i]), (LAS unsigned*)(lds + (bufoff) + ldsw + _i * 8192), 16, 0, 0); } } while (0)
#define PG8_W64(p) ({ const s16x4 _v = *(const volatile LAS s16x4*)(p); __builtin_shufflevector(_v, _v, 0, 1, 2, 3, -1, -1, -1, -1); })
#define PG8_LDA(dst, b, h) do { if constexpr (FP6) { _Pragma("unroll") for (int m = 0; m < 4; ++m) { dst[m][0] = *(const LAS bf16x8*)(lds + PG8_SA(b, h) + aoff6 + m * 1024); dst[m][1] = PG8_W64(lds + PG8_SA(b, h) + ahi6 + m * 512); } } \
    else { _Pragma("unroll") for (int m = 0; m < 4; ++m) _Pragma("unroll") for (int k = 0; k < 2; ++k) dst[m][k] = *(const LAS bf16x8*)(lds + PG8_SA(b, h) + aoff + m * 2048 + k * KOFF); } } while (0)
#define PG8_LDB(dst, b, h) do { if constexpr (FP6) { _Pragma("unroll") for (int n = 0; n < 2; ++n) { dst[n][0] = *(const LAS bf16x8*)(lds + PG8_SB(b, h) + boff6 + n * 1024); dst[n][1] = PG8_W64(lds + PG8_SB(b, h) + bhi6 + n * 512); } } \
    else { _Pragma("unroll") for (int n = 0; n < 2; ++n) _Pragma("unroll") for (int k = 0; k < 2; ++k) dst[n][k] = *(const LAS bf16x8*)(lds + PG8_SB(b, h) + boff + n * 2048 + k * KOFF); } } while (0)
#define PG8_CAT6(x) __builtin_shufflevector(__builtin_bit_cast(v4i32, (x)[0]), __builtin_bit_cast(v4i32, (x)[1]), 0, 1, 2, 3, 4, 5)
#define PG8_CAT(x) __builtin_bit_cast(v8i32, __builtin_shufflevector((x)[0], (x)[1], 0, 1, 2, 3, 4, 5, 6, 7, 8, 9, 10, 11, 12, 13, 14, 15))
#define PG8_MMA(ai, bj, At, Bt) do { __builtin_amdgcn_s_setprio(1); _Pragma("unroll") for (int m = 0; m < 4; ++m) _Pragma("unroll") for (int n = 0; n < 2; ++n) { \
        if constexpr (F8 && NB == 1 && !F8ASM1) acc[ai][bj][m][n] = __builtin_amdgcn_mfma_scale_f32_16x16x128_f8f6f4(PG8_CAT(Bt[n]), PG8_CAT(At[m]), acc[ai][bj][m][n], 0, 0, 0, 0x7f7f7f7f, 0, 0x7f7f7f7f); \
        else if constexpr (F8 && F6 != 0) { asm volatile("s_nop 1\n\tv_mfma_scale_f32_16x16x128_f8f6f4 %0, %1, %2, %0, %3, %3 op_sel_hi:[0,0,0] cbsz:2 blgp:2" : "+v"(acc[ai][bj][m][n]) : "v"(PG8_CAT6(Bt[n])), "v"(PG8_CAT6(At[m])), "v"(one_scale)); } \
        else if constexpr (F8) { asm volatile("s_nop 1\n\tv_mfma_scale_f32_16x16x128_f8f6f4 %0, %1, %2, %0, %3, %3 op_sel_hi:[0,0,0]" : "+v"(acc[ai][bj][m][n]) : "v"(PG8_CAT(Bt[n])), "v"(PG8_CAT(At[m])), "v"(one_scale)); } \
        else { _Pragma("unroll") for (int k = 0; k < 2; ++k) acc[ai][bj][m][n] = __builtin_amdgcn_mfma_f32_16x16x32_bf16(Bt[n][k], At[m][k], acc[ai][bj][m][n], 0, 0, 0); } } \
        __builtin_amdgcn_s_setprio(0); } while (0)
#define PG8_WAIT_V(n) asm volatile("s_waitcnt vmcnt(" #n ")" ::: "memory")
#define PG8_WAIT_L(n) asm volatile("s_waitcnt lgkmcnt(" #n ")" ::: "memory")
#define PG8_BAR __builtin_amdgcn_s_barrier()
#define PG8_SCHED __builtin_amdgcn_sched_barrier(0)
#define PG8_WAIT_LA() do { if constexpr (FP6) PG8_WAIT_V(4); else PG8_WAIT_V(6); } while (0)
#define PG8_WAIT_LB() do { if constexpr (FP6) PG8_WAIT_V(1); else PG8_WAIT_V(2); } while (0)
#define PG8_WAIT_MAIN() do { if constexpr (FP6) PG8_WAIT_V(6); else PG8_WAIT_V(8); } while (0)
    Unit cur, nxt; int ui = 0;
    if (!S.next(0, cur)) return;
    f32x4 acc[2][NB][4][2];
    f32x4 yac[2][4][2];
#pragma unroll
    for (int a = 0; a < 2; ++a)
#pragma unroll
        for (int m = 0; m < 4; ++m)
#pragma unroll
            for (int n = 0; n < 2; ++n) { yac[a][m][n] = (f32x4){0.f, 0.f, 0.f, 0.f};
#pragma unroll
                for (int b = 0; b < NB; ++b) acc[a][b][m][n] = (f32x4){0.f, 0.f, 0.f, 0.f}; }
    bf16x8 At[4][2], B0[2][2], B1[2][2];
    const char* cA = S.abase(cur); const char* cB = S.bbase(cur);
    if constexpr (NB == 2) {
        PG8_STAGE(PG8_SB(0, 0), cB, voffB); PG8_STAGE(PG8_SB(0, 1), cB + hstep, voffB); PG8_STAGE(PG8_SA(0, 0), cA, voffA); PG8_STAGE(PG8_SA(0, 1), cA + hstep, voffA);
        if (wr == 1) PG8_BAR;
        if constexpr (FP6) PG8_WAIT_V(1); else PG8_WAIT_V(2);
        PG8_BAR;
        PG8_STAGE(PG8_SB(1, 0), cB + kstep, voffB); PG8_STAGE(PG8_SA(1, 0), cA + kstep, voffA); PG8_STAGE(PG8_SB(1, 1), cB + hstep + kstep, voffB);
        if constexpr (FP6) PG8_WAIT_V(4); else PG8_WAIT_V(6);
        PG8_BAR;
    } else {
        PG8_STAGE(PG8_SB(0, 0), cB, voffB); PG8_STAGE(PG8_SA(0, 0), cA, voffA); PG8_STAGE(PG8_SA(0, 1), cA + hstep, voffA);
        if (wr == 1) PG8_BAR;
        PG8_WAIT_V(2); PG8_BAR;
        PG8_STAGE(PG8_SB(1, 0), cB + kstep, voffB); PG8_STAGE(PG8_SA(1, 0), cA + kstep, voffA);
        PG8_WAIT_V(4); PG8_BAR;
    }
    for (;;) {
        const bool has_next = S.next(ui + 1, nxt);
        const char* nA = has_next ? S.abase(nxt) : cA; const char* nB = has_next ? S.bbase(nxt) : cB;
        for (int t = 0; t < nt; t += 2) {
            if constexpr (Epi::GATED) { if (t != 0 && (t & 15) == 0) { E.flush(acc, yac, cur, (t >> 4) - 1, wr, wc, fr, fq);
#pragma unroll
                for (int a = 0; a < 2; ++a)
#pragma unroll
                    for (int m = 0; m < 4; ++m)
#pragma unroll
                        for (int n = 0; n < 2; ++n) acc[a][0][m][n] = (f32x4){0.f, 0.f, 0.f, 0.f}; } }
            const bool last = (t == nt - 2);
            const char* a1 = cA + (size_t)(t + 1) * kstep;
            const char* a2 = last ? nA : cA + (size_t)(t + 2) * kstep; const char* b2 = last ? nB : cB + (size_t)(t + 2) * kstep;
            const char* a3 = a2 + kstep; const char* b3 = b2 + kstep;
            if constexpr (NB == 2 && STAGE_LATE != 0) {
            PG8_LDB(B0, 0, 0); PG8_LDB(B1, 0, 1); PG8_SCHED; PG8_LDA(At, 0, 0);
            PG8_WAIT_LA(); PG8_WAIT_L(0); PG8_BAR; PG8_MMA(0, 0, At, B0); PG8_MMA(0, 1, At, B1); PG8_STAGE(PG8_SA(1, 1), a1 + hstep, voffA); PG8_BAR; PG8_SCHED;
            PG8_LDA(At, 0, 1);
            PG8_WAIT_LB(); PG8_WAIT_L(0); PG8_BAR; PG8_MMA(1, 0, At, B0); PG8_MMA(1, 1, At, B1); PG8_STAGE(PG8_SB(0, 0), b2, voffB); PG8_STAGE(PG8_SB(0, 1), b2 + hstep, voffB); PG8_STAGE(PG8_SA(0, 0), a2, voffA); PG8_BAR; PG8_SCHED;
            PG8_LDB(B0, 1, 0); PG8_LDB(B1, 1, 1); PG8_SCHED; PG8_LDA(At, 1, 0);
            PG8_WAIT_LA(); PG8_WAIT_L(0); PG8_BAR; PG8_MMA(0, 0, At, B0); PG8_MMA(0, 1, At, B1); PG8_STAGE(PG8_SA(0, 1), a2 + hstep, voffA); PG8_BAR; PG8_SCHED;
            PG8_LDA(At, 1, 1);
            PG8_WAIT_LB(); PG8_WAIT_L(0); PG8_BAR; PG8_MMA(1, 0, At, B0); PG8_MMA(1, 1, At, B1); PG8_STAGE(PG8_SB(1, 0), b3, voffB); PG8_STAGE(PG8_SB(1, 1), b3 + hstep, voffB); PG8_STAGE(PG8_SA(1, 0), a3, voffA); PG8_BAR; PG8_SCHED;
            } else if constexpr (NB == 2) {
            PG8_LDB(B0, 0, 0); PG8_LDB(B1, 0, 1); PG8_SCHED; PG8_LDA(At, 0, 0); PG8_STAGE(PG8_SA(1, 1), a1 + hstep, voffA);
            PG8_WAIT_MAIN(); PG8_WAIT_L(0); PG8_BAR; PG8_MMA(0, 0, At, B0); PG8_MMA(0, 1, At, B1); PG8_BAR; PG8_SCHED;
            PG8_LDA(At, 0, 1); PG8_STAGE(PG8_SB(0, 0), b2, voffB); PG8_STAGE(PG8_SB(0, 1), b2 + hstep, voffB); PG8_STAGE(PG8_SA(0, 0), a2, voffA);
            PG8_WAIT_MAIN(); PG8_WAIT_L(0); PG8_BAR; PG8_MMA(1, 0, At, B0); PG8_MMA(1, 1, At, B1); PG8_BAR; PG8_SCHED;
            PG8_LDB(B0, 1, 0); PG8_LDB(B1, 1, 1); PG8_SCHED; PG8_LDA(At, 1, 0); PG8_STAGE(PG8_SA(0, 1), a2 + hstep, voffA);
            PG8_WAIT_MAIN(); PG8_WAIT_L(0); PG8_BAR; PG8_MMA(0, 0, At, B0); PG8_MMA(0, 1, At, B1); PG8_BAR; PG8_SCHED;
            PG8_LDA(At, 1, 1); PG8_STAGE(PG8_SB(1, 0), b3, voffB); PG8_STAGE(PG8_SB(1, 1), b3 + hstep, voffB); PG8_STAGE(PG8_SA(1, 0), a3, voffA);
            PG8_WAIT_MAIN(); PG8_WAIT_L(0); PG8_BAR; PG8_MMA(1, 0, At, B0); PG8_MMA(1, 1, At, B1); PG8_BAR; PG8_SCHED;
            } else {
            PG8_LDB(B0, 0, 0); PG8_SCHED; PG8_LDA(At, 0, 0); PG8_STAGE(PG8_SA(1, 1), a1 + hstep, voffA);
            PG8_WAIT_V(6); PG8_WAIT_L(0); PG8_BAR; PG8_MMA(0, 0, At, B0); PG8_BAR; PG8_SCHED;
            PG8_LDA(At, 0, 1); PG8_STAGE(PG8_SB(0, 0), b2, voffB); PG8_STAGE(PG8_SA(0, 0), a2, voffA);
            PG8_WAIT_V(6); PG8_WAIT_L(0); PG8_BAR; PG8_MMA(1, 0, At, B0); PG8_BAR; PG8_SCHED;
            PG8_LDB(B0, 1, 0); PG8_SCHED; PG8_LDA(At, 1, 0); PG8_STAGE(PG8_SA(0, 1), a2 + hstep, voffA);
            PG8_WAIT_V(6); PG8_WAIT_L(0); PG8_BAR; PG8_MMA(0, 0, At, B0); PG8_BAR; PG8_SCHED;
            PG8_LDA(At, 1, 1); PG8_STAGE(PG8_SB(1, 0), b3, voffB); PG8_STAGE(PG8_SA(1, 0), a3, voffA);
            PG8_WAIT_V(6); PG8_WAIT_L(0); PG8_BAR; PG8_MMA(1, 0, At, B0); PG8_BAR; PG8_SCHED;
            }
        }
        if constexpr (F8) {
            asm volatile("s_nop 15\n\ts_nop 15" ::: "memory");
#pragma unroll
            for (int a = 0; a < 2; ++a)
#pragma unroll
                for (int b = 0; b < NB; ++b)
#pragma unroll
                    for (int m = 0; m < 4; ++m)
#pragma unroll
                        for (int n = 0; n < 2; ++n) asm volatile("" : "+v"(acc[a][b][m][n]));
        }
        if constexpr (ALIGN_EPI) { if (wr == 0) PG8_BAR; }
        if constexpr (Epi::GATED) { E.finish(acc, yac, cur, wr, wc, fr, fq);
#pragma unroll
            for (int a = 0; a < 2; ++a)
#pragma unroll
                for (int m = 0; m < 4; ++m)
#pragma unroll
                    for (int n = 0; n < 2; ++n) yac[a][m][n] = (f32x4){0.f, 0.f, 0.f, 0.f};
        } else { E(acc, cur, wr, wc, fr, fq); }
        if (!has_next) break;
#pragma unroll
        for (int a = 0; a < 2; ++a)
#pragma unroll
            for (int b = 0; b < NB; ++b)
#pragma unroll
                for (int m = 0; m < 4; ++m)
#pragma unroll
                    for (int n = 0; n < 2; ++n) acc[a][b][m][n] = (f32x4){0.f, 0.f, 0.f, 0.f};
        cur = nxt; cA = nA; cB = nB; ++ui;
        if constexpr (ALIGN_EPI) { if (wr == 1) PG8_BAR; }
    }
    PG8_WAIT_V(0);
    if constexpr (!ALIGN_EPI) { if (wr == 0) PG8_BAR; }
    PG8_BAR;
#undef PG8_SA
#undef PG8_SB
#undef PG8_STAGE
#undef PG8_LDA
#undef PG8_LDB
#undef PG8_MMA
#undef PG8_CAT
#undef PG8_WAIT_V
#undef PG8_WAIT_L
#undef PG8_BAR
#undef PG8_SCHED
#undef PG8_WAIT_MAIN
}
}

#define XB_TMO      128
#define XB_XCNT(j)  (256  + 64 * (j))
#define XB_XSUB(j)  (1280 + 64 * (j))
#define XB_XGEN(j)  (2304 + 64 * (j))
#define XB_TOP      3328
#define XB_TOPGEN   3392
#define XCD_BAR_WORDS 3456
#define XB_SPIN_CAP (1u << 18)
DI unsigned xb_ld(unsigned* p)              { return __hip_atomic_load(p, __ATOMIC_RELAXED, __HIP_MEMORY_SCOPE_AGENT); }
DI unsigned xb_add(unsigned* p, unsigned v) { return __hip_atomic_fetch_add(p, v, __ATOMIC_RELAXED, __HIP_MEMORY_SCOPE_AGENT); }
DI unsigned xb_xcc_id() { return (unsigned)__builtin_amdgcn_s_getreg((3 << 11) | 20) & 0xFu; }
#define XB_SPIN(cond, bar) do { unsigned _sp = 0; while (cond) { __builtin_amdgcn_s_sleep(1); \
    if ((++_sp & 255u) == 0u) { if (xb_ld(&(bar)[XB_TMO])) break; if (_sp > XB_SPIN_CAP) { atomicAdd(&(bar)[XB_TMO], 1u); break; } } } } while (0)
struct XcdBarrier { unsigned* bar; unsigned x; volatile LAS unsigned* st; };
DI XcdBarrier xcd_barrier_post(unsigned* bar, volatile LAS unsigned* st) {
    XcdBarrier b; b.bar = bar; b.x = xb_xcc_id(); b.st = st;
    if (threadIdx.x == 0) (void)xb_add(&bar[XB_XCNT(b.x)], 1u);
    return b;
}
DI void xcd_barrier_complete(unsigned* bar, unsigned x, unsigned& nloc, unsigned& nx) {
    const unsigned G = gridDim.x * gridDim.y * gridDim.z;
    unsigned sum, cnt, mine, sp = 0u;
    for (;;) {
        sum = 0u; cnt = 0u; mine = 0u;
#pragma unroll
        for (unsigned j = 0; j < 16; ++j) { const unsigned c = xb_ld(&bar[XB_XCNT(j)]); sum += c; cnt += (c > 0u) ? 1u : 0u; mine = (j == x) ? c : mine; }
        if (sum == G) break;
        __builtin_amdgcn_s_sleep(1);
        if ((++sp & 255u) == 0u) { if (xb_ld(&bar[XB_TMO])) break; if (sp > XB_SPIN_CAP) { atomicAdd(&bar[XB_TMO], 1u); break; } }
    }
    nloc = mine > 0u ? mine : 1u; nx = cnt > 0u ? cnt : 1u;
}
DI void xcd_barrier(const XcdBarrier& b) {
    asm volatile("s_waitcnt vmcnt(0)" ::: "memory");
    __syncthreads();
    if (threadIdx.x == 0) {
        unsigned* bar = b.bar;
        __builtin_amdgcn_s_waitcnt(0);
        unsigned nloc = b.st[0], nx = b.st[1];
        if (nloc == 0u) { xcd_barrier_complete(bar, b.x, nloc, nx); b.st[0] = nloc; b.st[1] = nx; }
        const unsigned old = xb_add(&bar[XB_XSUB(b.x)], 1u);
        const unsigned gen = old / nloc;
        if (old + 1u == (gen + 1u) * nloc) {
            __builtin_amdgcn_fence(__ATOMIC_RELEASE, "agent");
            asm volatile("s_waitcnt vmcnt(0)" ::: "memory");
            const unsigned og = xb_add(&bar[XB_TOP], 1u);
            const unsigned tg = og / nx;
            if (og + 1u == (tg + 1u) * nx) xb_add(&bar[XB_TOPGEN], 1u);
            else XB_SPIN(xb_ld(&bar[XB_TOPGEN]) == tg, bar);
            __builtin_amdgcn_fence(__ATOMIC_ACQUIRE, "agent");
            xb_add(&bar[XB_XGEN(b.x)], 1u);
            asm volatile("s_waitcnt vmcnt(0)" ::: "memory");
        } else {
            XB_SPIN(xb_ld(&bar[XB_XGEN(b.x)]) == gen, bar);
            __builtin_amdgcn_fence(__ATOMIC_ACQUIRE, "agent");
            asm volatile("s_waitcnt vmcnt(0)" ::: "memory");
        }
    }
    __syncthreads();
}

struct Frame {
    LAS unsigned char* lds;
    int tid, lane, wave, G, wg;
    float* out; unsigned char* ws;
};
template <class T> DI T* wsp(const Frame& F, size_t off) { return (T*)(F.ws + off); }

struct EpiH {
    static constexpr bool PERM = true, GATED = false;
    bf16* H; bf16* MK; bf16* MVT;
    DI void operator()(const f32x4 (&acc)[2][2][4][2], const pg8::Unit& u, int wr, int wc, int fr, int fq) const {
        bf16* base = H; size_t ldc = NH; int act = 0;
        if (u.gi == 0) { const int pn = u.pn; act = ((pn >= 4 && pn < 8) || (pn >= 16 && pn < 20)) ? 1 : 0; }
        else { const int lx = (u.gi - 1) >> 1, w = (u.gi - 1) & 1; if (w == 0) { base = MK + (size_t)lx * 512 * 1024; ldc = 1024; } else { base = MVT + (size_t)lx * 1024 * 512; ldc = 512; } }
        const int row0 = u.pm * 256 + wr * 64 + fr, col0 = u.pn * 256 + wc * 32 + 8 * fq;
#pragma unroll
        for (int ai = 0; ai < 2; ++ai)
#pragma unroll
            for (int m = 0; m < 4; ++m) { bf16* rowp = base + (size_t)(row0 + ai * 128 + m * 16) * ldc + col0;
#pragma unroll
                for (int bj = 0; bj < 2; ++bj) { f32x4 v0 = acc[ai][bj][m][0], v1 = acc[ai][bj][m][1];
                    if (act != 0) {
#pragma unroll
                        for (int j = 0; j < 4; ++j) { const float s0 = fast_sigmoid(v0[j]), s1 = fast_sigmoid(v1[j]); v0[j] = (act == 1) ? v0[j] * s0 : s0; v1[j] = (act == 1) ? v1[j] * s1 : s1; } }
                    u32x4 w; w.x = cvt_pk_bf16(v0[0], v0[1]); w.y = cvt_pk_bf16(v0[2], v0[3]); w.z = cvt_pk_bf16(v1[0], v1[1]); w.w = cvt_pk_bf16(v1[2], v1[3]);
                    *(u32x4*)(rowp + bj * 128) = w; } }
    }
};
template <int NB> struct EpiMG {
    static constexpr bool PERM = true, GATED = false;
    bf16* H;
    DI void operator()(const f32x4 (&acc)[2][NB][4][2], const pg8::Unit& u, int wr, int wc, int fr, int fq) const {
        const int colu = C_F8 + u.pn * (128 * NB);
        const int act = (colu >= C_MG) ? 2 : (((colu >= C_SG && colu < C_XQ) || colu >= C_XG) ? 1 : 0);
        const int row0 = u.pm * 256 + wr * 64 + fr, col0 = colu + wc * 32 + 8 * fq;
#pragma unroll
        for (int ai = 0; ai < 2; ++ai)
#pragma unroll
            for (int m = 0; m < 4; ++m) { bf16* rowp = H + (size_t)(row0 + ai * 128 + m * 16) * NH + col0;
#pragma unroll
                for (int bj = 0; bj < NB; ++bj) { f32x4 v0 = acc[ai][bj][m][0], v1 = acc[ai][bj][m][1];
                    if (act == 2) {
#pragma unroll
                        for (int j = 0; j < 4; ++j) { v0[j] = __builtin_amdgcn_rcpf(1.0f + __builtin_amdgcn_exp2f(v0[j] * (-1.44269504089f * MG_DESCALE)));
                            v1[j] = __builtin_amdgcn_rcpf(1.0f + __builtin_amdgcn_exp2f(v1[j] * (-1.44269504089f * MG_DESCALE))); }
                    } else if (act == 1) {
#pragma unroll
                        for (int j = 0; j < 4; ++j) { const float a0 = v0[j] * MG_DESCALE, a1 = v1[j] * MG_DESCALE; v0[j] = a0 * fast_sigmoid(a0); v1[j] = a1 * fast_sigmoid(a1); }
                    } else {
#pragma unroll
                        for (int j = 0; j < 4; ++j) { v0[j] *= MG_DESCALE; v1[j] *= MG_DESCALE; } }
                    u32x4 w; w.x = cvt_pk_bf16(v0[0], v0[1]); w.y = cvt_pk_bf16(v0[2], v0[3]); w.z = cvt_pk_bf16(v1[0], v1[1]); w.w = cvt_pk_bf16(v1[2], v1[3]);
                    *(u32x4*)(rowp + bj * 128) = w; } }
    }
};
struct EpiRes {
    static constexpr bool PERM = true, GATED = false;
    const float* __restrict__ res; float* __restrict__ out;
    DI void operator()(const f32x4 (&acc)[2][2][4][2], const pg8::Unit& u, int wr, int wc, int fr, int fq) const {
        const int row0 = u.pm * 256 + wr * 64 + fr, col0 = u.pn * 256 + wc * 32 + 8 * fq;
#pragma unroll
        for (int ai = 0; ai < 2; ++ai)
#pragma unroll
            for (int m = 0; m < 4; ++m) { const size_t ro = (size_t)(row0 + ai * 128 + m * 16) * DM + col0;
#pragma unroll
                for (int bj = 0; bj < 2; ++bj)
#pragma unroll
                    for (int n = 0; n < 2; ++n) { const size_t o = ro + bj * 128 + n * 4; const f32x4 r = *(const f32x4*)(res + o); *(f32x4*)(out + o) = r * DN_ALPHA + acc[ai][bj][m][n]; } }
    }
};
struct EpiGate {
    static constexpr bool PERM = true, GATED = true;
    const bf16* H; bf16* Y;
    DI void flush(const f32x4 (&acc)[2][1][4][2], f32x4 (&y)[2][4][2], const pg8::Unit& u, int bi, int wr, int wc, int fr, int fq) const {
        const int row0 = u.pm * 256 + wr * 64 + fr, col0 = u.pn * 128 + wc * 32 + 8 * fq;
#pragma unroll
        for (int ai = 0; ai < 2; ++ai)
#pragma unroll
            for (int m = 0; m < 4; ++m) { const u32x4 gw = *(const u32x4*)(H + (size_t)(row0 + ai * 128 + m * 16) * NH + C_MG + bi * DM + col0);
                float g[8]; unpack8(gw, g);
#pragma unroll
                for (int j = 0; j < 4; ++j) { y[ai][m][0][j] += g[j] * acc[ai][0][m][0][j]; y[ai][m][1][j] += g[4 + j] * acc[ai][0][m][1][j]; }
                if (m == 1 || m == 3) __builtin_amdgcn_sched_barrier(0); }
    }
    DI void finish(const f32x4 (&acc)[2][1][4][2], f32x4 (&y)[2][4][2], const pg8::Unit& u, int wr, int wc, int fr, int fq) const {
        flush(acc, y, u, 3, wr, wc, fr, fq);
        const int row0 = u.pm * 256 + wr * 64 + fr, col0 = u.pn * 128 + wc * 32 + 8 * fq;
#pragma unroll
        for (int ai = 0; ai < 2; ++ai)
#pragma unroll
            for (int m = 0; m < 4; ++m) { const f32x4 v0 = y[ai][m][0], v1 = y[ai][m][1];
                u32x4 w; w.x = cvt_pk_bf16(v0[0], v0[1]); w.y = cvt_pk_bf16(v0[2], v0[3]); w.z = cvt_pk_bf16(v1[0], v1[1]); w.w = cvt_pk_bf16(v1[2], v1[3]);
                if (BLK_OUT) *(u32x4*)((char*)Y + pg8::blk_off<false>(row0 + ai * 128 + m * 16, col0, DM / 64)) = w; else *(u32x4*)(Y + (size_t)(row0 + ai * 128 + m * 16) * DM + col0) = w; }
    }
};
struct SchedInProj {
    static constexpr bool BLK = false;
    int G, c, n_extra; const char *XB, *WT, *MEMB, *WKV;
    static constexpr int NM = 32, NN = 21, NU = NM * NN;
    static constexpr size_t TSTEP = (size_t)256 * 4096 * 2;
    DI bool next(int i, pg8::Unit& u) const {
        const long L = (long)i * G + c;
        if (L < NU) { pg8::static_tile((int)L, NM, NN, u.pm, u.pn); if (u.pn == 20) u.pn = 101; u.gi = 0; return true; }
        const int e = (int)(L - NU); if (e >= n_extra) return false;
        const int lx = e >> 4, r = e & 15;
        if (r < 8) { u.pm = r >> 2; u.pn = r & 3; u.gi = 1 + 2 * lx; } else { u.pm = (r - 8) >> 1; u.pn = (r - 8) & 1; u.gi = 2 + 2 * lx; }
        return true;
    }
    DI const char* abase(const pg8::Unit& u) const {
        if (u.gi == 0) return XB + (size_t)u.pm * TSTEP;
        const int lx = (u.gi - 1) >> 1, w = (u.gi - 1) & 1;
        return w == 0 ? MEMB + (size_t)u.pm * TSTEP : WKV + (size_t)lx * 2048 * 4096 * 2 + (size_t)(1024 + u.pm * 256) * 4096 * 2;
    }
    DI const char* bbase(const pg8::Unit& u) const {
        if (u.gi == 0) return WT + (size_t)u.pn * TSTEP;
        const int lx = (u.gi - 1) >> 1, w = (u.gi - 1) & 1;
        return w == 0 ? WKV + (size_t)lx * 2048 * 4096 * 2 + (size_t)u.pn * TSTEP : MEMB + (size_t)u.pn * TSTEP;
    }
};

DI int win_src_col(int n) { return n < 5120 ? n : (n < C_LR ? n + 16 : (n < C_LR + 16 ? n - C_LR + 5120 : -1)); }
template <bool WIN, int LAY = 0> DI void transpose_item(const float* W, size_t ldw, bf16* WT, size_t ldt, int k0, int n0, int kd0, LAS float* scr, int lane) {
    const int kr = lane >> 3, nc = lane & 7; int sc = n0 + 4 * nc; if (WIN) sc = win_src_col(sc);
    const float* src = W + (size_t)(k0 + kr) * ldw + (sc < 0 ? 0 : sc);
    f32x4 v[8];
#pragma unroll
    for (int i = 0; i < 8; ++i) v[i] = *(const f32x4*)(src + (size_t)(8 * i) * ldw);
#pragma unroll
    for (int i = 0; i < 8; ++i) { LAS float* d = scr + (8 * i + kr) * 33 + 4 * nc; const f32x4 x = (sc < 0) ? (f32x4){0.f, 0.f, 0.f, 0.f} : v[i]; d[0] = x.x; d[1] = x.y; d[2] = x.z; d[3] = x.w; }
    LDS_WAIT();
    const int c = lane & 7;
#pragma unroll
    for (int j = 0; j < 4; ++j) { const int n = (lane >> 3) + 8 * j; const LAS float* s = scr + (8 * c) * 33 + n;
        u32x4 o; o.x = pk2(s[0 * 33], s[1 * 33]); o.y = pk2(s[2 * 33], s[3 * 33]); o.z = pk2(s[4 * 33], s[5 * 33]); o.w = pk2(s[6 * 33], s[7 * 33]);
        if constexpr (LAY == 0) *(u32x4*)(WT + (size_t)(n0 + n) * ldt + kd0 + 8 * c) = o; else *(u32x4*)((char*)WT + pg8::blk_off<LAY == 2>(n0 + n, kd0 + 8 * c, (int)(ldt / 64))) = o; }
    LDS_WAIT();
}
DI void transpose_item_f8(const float* W, size_t ldw, unsigned char* WT, size_t ldt, int k0, int n0, LAS float* scr, int lane) {
    const int kr = lane >> 3, nc = lane & 7; const int sc = win_src_col(n0 + 4 * nc);
    const float* src = W + (size_t)(k0 + kr) * ldw + sc;
#pragma unroll
    for (int h = 0; h < 2; ++h) {
        f32x4 v[8];
#pragma unroll
        for (int i = 0; i < 8; ++i) v[i] = *(const f32x4*)(src + (size_t)(64 * h + 8 * i) * ldw);
#pragma unroll
        for (int i = 0; i < 8; ++i) { LAS float* d = scr + (64 * h + 8 * i + kr) * 33 + 4 * nc; d[0] = v[i].x * W8_SCALE; d[1] = v[i].y * W8_SCALE; d[2] = v[i].z * W8_SCALE; d[3] = v[i].w * W8_SCALE; }
    }
    LDS_WAIT();
#if F6
    { const int q = lane >> 4;
#pragma unroll
      for (int j = 0; j < 2; ++j) { const int n = (lane & 15) + 16 * j; const LAS float* sp = scr + (32 * q) * 33 + n; float f[32];
#pragma unroll
          for (int e = 0; e < 32; ++e) f[e] = sp[e * 33];
          u32x4 lo, hi; pk32_fp6(f, lo, hi); const int R = n0 - C_F8 + n; size_t ol, oh; pg8::f6_off((R & ~31) + pg8::invperm32(R & 31), k0 >> 7, q, ol, oh);
          *(u32x4*)(WT + ol) = lo; u32x2 h2; h2.x = hi.x; h2.y = hi.y; *(u32x2*)(WT + oh) = h2; } }
#else
    const int c = lane & 7;
#pragma unroll
    for (int j = 0; j < 4; ++j) { const int n = (lane >> 3) + 8 * j; const LAS float* s = scr + (16 * c) * 33 + n;
        u32x4 o; o.x = pk4_fp8(s[0 * 33], s[1 * 33], s[2 * 33], s[3 * 33]); o.y = pk4_fp8(s[4 * 33], s[5 * 33], s[6 * 33], s[7 * 33]);
        o.z = pk4_fp8(s[8 * 33], s[9 * 33], s[10 * 33], s[11 * 33]); o.w = pk4_fp8(s[12 * 33], s[13 * 33], s[14 * 33], s[15 * 33]);
        *(u32x4*)(WT + (size_t)(n0 - C_F8 + n) * ldt + k0 + 16 * c) = o; }
#endif
    LDS_WAIT();
}
DI void prologue(const Frame& F, const float* x, const float* mem, const int* pos, const float* w_in, const float* w_pool, const float* w_mem_kv, const float* w_branch, const float* w_out) {
    LAS float* scr = (LAS float*)(F.lds + F.wave * 17408);
    const int gw = F.wg * NWAVES + F.wave, NGW = F.G * NWAVES, lane = F.lane;
    constexpr int I_B16 = 64 * ((NH - N_F8) / 32), I_F8 = 32 * (N_F8 / 32), I_KV = 64 * 64, I_BR = 16 * 128, I_OUT = 64 * 128, I_PL = 4 * 8;
    constexpr int NITEMS = 2 * I_B16 + 2 * I_F8 + 2 * I_KV + 8 * I_BR + 2 * I_OUT + 8 * I_PL;
    LAS unsigned* qc = (LAS unsigned*)(F.lds + MISC_OFF) + 16;
    (void)gw;
    int q = 0; if (lane == 0) q = (int)__hip_atomic_fetch_add(qc, 1u, __ATOMIC_RELAXED, __HIP_MEMORY_SCOPE_WORKGROUP); q = __builtin_amdgcn_readfirstlane(q);
    for (;;) {
        const int it = (q >> 3) * NGW + F.wg * NWAVES + (q & 7); if (it >= NITEMS) break;
        if (lane == 0) q = (int)__hip_atomic_fetch_add(qc, 1u, __ATOMIC_RELAXED, __HIP_MEMORY_SCOPE_WORKGROUP);
        q = __builtin_amdgcn_readfirstlane(q);
        int r = it;
        if (r < 2 * I_F8) { const int l = r / I_F8; r -= l * I_F8; const int nb = C_F8 / 32 + (PRO_NFAST ? r % (N_F8 / 32) : (r >> 5)), kb = PRO_NFAST ? r / (N_F8 / 32) : (r & 31);
            transpose_item_f8(w_in + (size_t)l * 4096 * D_IN, D_IN, wsp<unsigned char>(F, WS_W8) + (size_t)l * W8_LAYER, 4096, kb * 128, nb * 32, scr, lane); continue; }
        r -= 2 * I_F8;
        if (r < 2 * I_B16) { const int l = r / I_B16; r -= l * I_B16; int nb = r >> 6; const int kb = r & 63; if (nb >= C_F8 / 32) nb += N_F8 / 32;
            transpose_item<true>(w_in + (size_t)l * 4096 * D_IN, D_IN, wsp<bf16>(F, WS_WINT) + (size_t)l * NH * 4096, 4096, kb * 64, nb * 32, kb * 64, scr, lane); continue; }
        r -= 2 * I_B16;
        if (r < 2 * I_KV) { const int l = r / I_KV; r -= l * I_KV; const int nb = r >> 6, kb = r & 63;
            transpose_item<false>(w_mem_kv + (size_t)l * 4096 * 2048, 2048, wsp<bf16>(F, WS_WMKVT) + (size_t)l * 2048 * 4096, 4096, kb * 64, nb * 32, kb * 64, scr, lane); continue; }
        r -= 2 * I_KV;
        if (r < 8 * I_BR) { const int lb = r / I_BR; r -= lb * I_BR; const int l = lb >> 2, bi = lb & 3; const int nb = PRO_NFAST ? (r & 127) : (r >> 4), kb = PRO_NFAST ? (r >> 7) : (r & 15);
            transpose_item<false, BLK_GATE ? 2 : 0>(w_branch + (size_t)lb * 1024 * 4096, 4096, wsp<bf16>(F, WS_WBRT) + (size_t)l * 4096 * 4096, 4096, kb * 64, nb * 32, bi * 1024 + kb * 64, scr, lane); continue; }
        r -= 8 * I_BR;
        if (r < 2 * I_OUT) { const int l = r / I_OUT; r -= l * I_OUT; const int nb = PRO_NFAST ? (r & 127) : (r >> 6), kb = PRO_NFAST ? (r >> 7) : (r & 63);
            transpose_item<false, BLK_OUT ? 2 : 0>(w_out + (size_t)l * 4096 * 4096, 4096, wsp<bf16>(F, WS_WOUTT) + (size_t)l * 4096 * 4096, 4096, kb * 64, nb * 32, kb * 64, scr, lane); continue; }
        r -= 2 * I_OUT;
        { const int lg = r / I_PL; r -= lg * I_PL; const int nb = r >> 2, kb = r & 3;
            transpose_item<false>(w_pool + (size_t)lg * 256 * 256, 256, wsp<bf16>(F, WS_WPOOLT) + (size_t)lg * 256 * 256, 256, kb * 64, nb * 32, kb * 64, scr, lane); }
    }
    const size_t gt = (size_t)F.wg * NTHR + F.tid, GT = (size_t)F.G * NTHR;
    { const f32x4* xs = (const f32x4*)x; u32x4* xd = wsp<u32x4>(F, WS_XB);
      u32x2* x8 = wsp<u32x2>(F, WS_X8);
#if F6
      (void)x8;
      for (size_t i = gt; i < (size_t)MTOK * DM / 32; i += GT) { float f[32];
#pragma unroll
          for (int t = 0; t < 4; ++t) { const f32x4 a = xs[8 * i + 2 * t], b = xs[8 * i + 2 * t + 1]; u32x4 o; o.x = pk2(a.x, a.y); o.y = pk2(a.z, a.w); o.z = pk2(b.x, b.y); o.w = pk2(b.z, b.w); xd[4 * i + t] = o;
              f[8 * t] = a.x * X8_SCALE; f[8 * t + 1] = a.y * X8_SCALE; f[8 * t + 2] = a.z * X8_SCALE; f[8 * t + 3] = a.w * X8_SCALE;
              f[8 * t + 4] = b.x * X8_SCALE; f[8 * t + 5] = b.y * X8_SCALE; f[8 * t + 6] = b.z * X8_SCALE; f[8 * t + 7] = b.w * X8_SCALE; }
          u32x4 lo, hi; pk32_fp6(f, lo, hi); size_t ol, oh; pg8::f6_off((int)(i >> 7), (int)((i >> 2) & 31), (int)(i & 3), ol, oh);
          *(u32x4*)(wsp<unsigned char>(F, WS_X8) + ol) = lo; u32x2 h2; h2.x = hi.x; h2.y = hi.y; *(u32x2*)(wsp<unsigned char>(F, WS_X8) + oh) = h2; }
#else
      for (size_t i = gt; i < (size_t)MTOK * DM / 8; i += GT) { const f32x4 a = xs[2 * i], b = xs[2 * i + 1]; u32x4 o; o.x = pk2(a.x, a.y); o.y = pk2(a.z, a.w); o.z = pk2(b.x, b.y); o.w = pk2(b.z, b.w); xd[i] = o;
          u32x2 q; q.x = pk4_fp8(a.x * X8_SCALE, a.y * X8_SCALE, a.z * X8_SCALE, a.w * X8_SCALE); q.y = pk4_fp8(b.x * X8_SCALE, b.y * X8_SCALE, b.z * X8_SCALE, b.w * X8_SCALE); x8[i] = q; }
#endif
      const f32x4* ms = (const f32x4*)mem; u32x4* md = wsp<u32x4>(F, WS_MEMB);
      for (size_t i = gt; i < (size_t)BATCH * MEMLEN * DM / 8; i += GT) { const f32x4 a = ms[2 * i], b = ms[2 * i + 1]; u32x4 o; o.x = pk2(a.x, a.y); o.y = pk2(a.z, a.w); o.z = pk2(b.x, b.y); o.w = pk2(b.z, b.w); md[i] = o; } }
    { f32x2* rt = wsp<f32x2>(F, WS_ROPE);
      for (size_t i = gt; i < (size_t)MTOK * 8; i += GT) { const int t = (int)(i >> 3), fi = (int)(i & 7);
          const float inv = (float)pow(500000.0, -(double)fi / 8.0); const float ang = (float)pos[t] * inv;
          rt[i] = (f32x2){cosf(ang), sinf(ang)}; } }
}

DI bf16* ob_at(bf16* OB, int t, int col) { return BLK_GATE ? (bf16*)((char*)OB + pg8::blk_off<false>(t, col, DM / 64)) : OB + (size_t)t * DM + col; }
DI float fexp(float x) { return __builtin_amdgcn_exp2f(x * 1.44269504089f); }
DI float logsigmoid_f(float z) { return fminf(z, 0.f) - 0.69314718056f * __builtin_amdgcn_logf(1.0f + fexp(-fabsf(z))); }

DI void gla_a_unit(const Frame& F, int l, int unit, const float* w_gla_up, const float* b_gla) {
    const int bh = unit >> 6, c = unit & 63, b = bh >> 2, h = bh & 3, t0 = b * SEQ + c * 64, tid = F.tid, lane = F.lane, wave = F.wave;
    const bf16* H = wsp<bf16>(F, WS_H);
    LAS float* lrs = (LAS float*)(F.lds);
    LAS float* bcs = (LAS float*)(F.lds + 4096);
    LAS float* seg = (LAS float*)(F.lds + 36864);
    LAS bf16* kds = (LAS bf16*)(F.lds + 40960);
    LAS bf16* vs = (LAS bf16*)(F.lds + 59392);
    constexpr int LDK = 136, LDV = 264;
    __syncthreads();
    if (tid < 128) { const int j = tid >> 1, hf = tid & 1; const u32x4 w = *(const u32x4*)(H + (size_t)(t0 + j) * NH + C_LR + 8 * hf); float f[8]; unpack8(w, f);
#pragma unroll
        for (int i = 0; i < 8; ++i) lrs[j * 16 + 8 * hf + i] = f[i]; }
    for (int p = tid; p < 64 * 32; p += NTHR) { const int j = p >> 5, ch = p & 31; *(LAS u32x4*)(vs + j * LDV + 8 * ch) = *(const u32x4*)(H + (size_t)(t0 + j) * NH + C_GV + h * 256 + 8 * ch); }
    __syncthreads();
    const int d = tid & 127, sg = tid >> 7;
    { float w[16];
#pragma unroll
      for (int r = 0; r < 16; ++r) w[r] = w_gla_up[(size_t)l * 16 * 512 + r * 512 + h * 128 + d];
      const float bg = b_gla[l * 512 + h * 128 + d]; float run = 0.f;
      for (int jj = 0; jj < 16; ++jj) { const int j = sg * 16 + jj; float z = bg;
#pragma unroll
          for (int r = 0; r < 16; ++r) z += lrs[j * 16 + r] * w[r];
          run += logsigmoid_f(z) * (1.0f / 16.0f); bcs[j * 128 + d] = run; }
      seg[sg * 128 + d] = run; }
    __syncthreads();
    { float pre = 0.f;
      for (int s = 0; s < sg; ++s) pre += seg[s * 128 + d];
      float* GB = wsp<float>(F, WS_GB);
      for (int jj = 0; jj < 16; ++jj) { const int j = sg * 16 + jj; const float v = bcs[j * 128 + d] + pre; bcs[j * 128 + d] = v; GB[(size_t)(t0 + j) * 512 + h * 128 + d] = v; }
      if (sg == 3) wsp<float>(F, WS_DEC)[(size_t)unit * 128 + d] = expf(bcs[63 * 128 + d]); }
    __syncthreads();
    for (int p = tid; p < 64 * 16; p += NTHR) { const int j = p >> 4, ch = p & 15; const u32x4 w = *(const u32x4*)(H + (size_t)(t0 + j) * NH + C_GK + h * 128 + 8 * ch); float f[8]; unpack8(w, f);
#pragma unroll
        for (int i = 0; i < 8; ++i) f[i] *= fexp(bcs[63 * 128 + 8 * ch + i] - bcs[j * 128 + 8 * ch + i]);
        *(LAS u32x4*)(kds + j * LDK + 8 * ch) = pack8(f); }
    __syncthreads();
    f32x4 acc[2][8];
#pragma unroll
    for (int a = 0; a < 2; ++a)
#pragma unroll
        for (int n = 0; n < 8; ++n) acc[a][n] = (f32x4){0.f, 0.f, 0.f, 0.f};
#pragma unroll
    for (int ks = 0; ks < 2; ++ks) {
        bf16x8 af[2];
#pragma unroll
        for (int a = 0; a < 2; ++a) af[a] = frag_tr(vs, LDV, 32 * ks, 32 * wave + 16 * a, lane);
#pragma unroll
        for (int n = 0; n < 8; ++n) { const bf16x8 bfr = frag_tr(kds, LDK, 32 * ks, 16 * n, lane);
#pragma unroll
            for (int a = 0; a < 2; ++a) acc[a][n] = mma16(bfr, af[a], acc[a][n]); }
    }
    float* U = wsp<float>(F, WS_GU) + (size_t)unit * 256 * 128;
#pragma unroll
    for (int a = 0; a < 2; ++a)
#pragma unroll
        for (int n = 0; n < 8; ++n) *(f32x4*)(U + (size_t)(32 * wave + 16 * a + (lane & 15)) * 128 + 16 * n + 4 * (lane >> 4)) = acc[a][n];
}

DI void gla_scan(const Frame& F) {
    const float* U = wsp<float>(F, WS_GU); const float* DEC = wsp<float>(F, WS_DEC); unsigned* S = wsp<unsigned>(F, WS_GS);
    const int gt = F.wg * NTHR + F.tid, GT = F.G * NTHR;
    for (int it = gt; it < 8 * 256 * 64; it += GT) {
        const int bh = it >> 14, r = it & 16383, e = r >> 6, dp = r & 63;
        float s0 = 0.f, s1 = 0.f;
#pragma unroll 8
        for (int c = 0; c < 64; ++c) { const size_t un = (size_t)bh * 64 + c; const size_t o = (un * 256 + e) * 128 + 2 * dp;
            const f32x2 u = *(const f32x2*)(U + o); const f32x2 dc = *(const f32x2*)(DEC + un * 128 + 2 * dp);
            S[o >> 1] = pk2(s0, s1); s0 = dc.x * s0 + u.x; s1 = dc.y * s1 + u.y; }
    }
}

#ifndef PROBE_T
#define PROBE_T 0
#endif
#if PROBE_T
#define PT_STAMP(k) do { if (F.wg == 0 && F.tid == 0) { const unsigned _now = (unsigned)wall_clock64(); volatile LAS unsigned* _pt = (volatile LAS unsigned*)(F.lds + MISC_OFF + 128); if ((k) > 0) _pt[k] += _now - _pt[0]; _pt[0] = _now; } } while (0)
#else
#define PT_STAMP(k) do {} while (0)
#endif
DI void gla_c_unit(const Frame& F, int l, int unit, const float* gla_norm) {
    const int bh = unit >> 6, c = unit & 63, b = bh >> 2, h = bh & 3, t0 = b * SEQ + c * 64, tid = F.tid, lane = F.lane, wave = F.wave;
    const bf16* H = wsp<bf16>(F, WS_H);
    LAS bf16* qs = (LAS bf16*)(F.lds);
    LAS bf16* ks = (LAS bf16*)(F.lds + 17408);
    LAS bf16* vs = (LAS bf16*)(F.lds + 34816);
    LAS bf16* ps = (LAS bf16*)(F.lds + 68608);
    LAS float* red = (LAS float*)(F.lds + 77824);
    constexpr int LDK = 136, LDV = 264, LDP = 72;
    __syncthreads();
    PT_STAMP(0);
    const float* GB = wsp<float>(F, WS_GB);
    u32x4 qw[2], kw[2], vw[4]; f32x4 b0[2], b1[2];
#pragma unroll
    for (int it = 0; it < 2; ++it) { const int p = tid + it * NTHR, j = p >> 4, ch = p & 15;
        qw[it] = *(const u32x4*)(H + (size_t)(t0 + j) * NH + C_GQ + h * 128 + 8 * ch); kw[it] = *(const u32x4*)(H + (size_t)(t0 + j) * NH + C_GK + h * 128 + 8 * ch);
        b0[it] = *(const f32x4*)(GB + (size_t)(t0 + j) * 512 + h * 128 + 8 * ch); b1[it] = *(const f32x4*)(GB + (size_t)(t0 + j) * 512 + h * 128 + 8 * ch + 4); }
#pragma unroll
    for (int it = 0; it < 4; ++it) { const int p = tid + it * NTHR, j = p >> 5, ch = p & 31; vw[it] = *(const u32x4*)(H + (size_t)(t0 + j) * NH + C_GV + h * 256 + 8 * ch); }
    const bf16* St = wsp<bf16>(F, WS_GS) + (size_t)unit * 256 * 128;
    bf16x8 sf[4][2];
#pragma unroll
    for (int kk = 0; kk < 4; ++kk)
#pragma unroll
        for (int a = 0; a < 2; ++a) sf[kk][a] = frag_glb(St, 128, 32 * wave + 16 * a, 32 * kk, lane);
    f32x4 gn[2]; u32x2 gw[4][2];
#pragma unroll
    for (int a = 0; a < 2; ++a) { const int e = 32 * wave + 16 * a + 4 * (lane >> 4); gn[a] = *(const f32x4*)(gla_norm + l * 1024 + h * 256 + e);
#pragma unroll
        for (int n = 0; n < 4; ++n) gw[n][a] = *(const u32x2*)(H + (size_t)(t0 + 16 * n + (lane & 15)) * NH + C_GG + h * 256 + e); }
#pragma unroll
    for (int it = 0; it < 2; ++it) { const int p = tid + it * NTHR, j = p >> 4, ch = p & 15;
        float q[8], k[8]; unpack8(qw[it], q); unpack8(kw[it], k); const float bb[8] = {b0[it].x, b0[it].y, b0[it].z, b0[it].w, b1[it].x, b1[it].y, b1[it].z, b1[it].w};
#pragma unroll
        for (int i = 0; i < 8; ++i) { const float eb = fexp(bb[i]); q[i] *= eb * 0.08838834764831845f; k[i] *= fexp(-bb[i]); }
        *(LAS u32x4*)(qs + j * LDK + 8 * ch) = pack8(q); *(LAS u32x4*)(ks + j * LDK + 8 * ch) = pack8(k); }
#pragma unroll
    for (int it = 0; it < 4; ++it) { const int p = tid + it * NTHR, j = p >> 5, ch = p & 31; *(LAS u32x4*)(vs + j * LDV + 8 * ch) = vw[it]; }
    __syncthreads();
    PT_STAMP(1);
    { const int it = wave >> 1; f32x4 sa[2] = {(f32x4){0.f, 0.f, 0.f, 0.f}, (f32x4){0.f, 0.f, 0.f, 0.f}};
#pragma unroll
      for (int kk = 0; kk < 4; ++kk) { const bf16x8 qa = frag_lds(qs, LDK, 16 * it, 32 * kk, lane);
#pragma unroll
          for (int jj = 0; jj < 2; ++jj) sa[jj] = mma16(qa, frag_lds(ks, LDK, 16 * (2 * (wave & 1) + jj), 32 * kk, lane), sa[jj]); }
#pragma unroll
      for (int jj = 0; jj < 2; ++jj)
#pragma unroll
          for (int r = 0; r < 4; ++r) { const int i = 16 * it + 4 * (lane >> 4) + r, j = 16 * (2 * (wave & 1) + jj) + (lane & 15);
              ps[i * LDP + j] = (bf16)f2bf(j <= i ? sa[jj][r] : 0.f); } }
    __syncthreads();
    PT_STAMP(2);
    f32x4 acc[2][4];
#pragma unroll
    for (int a = 0; a < 2; ++a)
#pragma unroll
        for (int n = 0; n < 4; ++n) acc[a][n] = (f32x4){0.f, 0.f, 0.f, 0.f};
#pragma unroll
    for (int kk = 0; kk < 4; ++kk) {
#pragma unroll
        for (int n = 0; n < 4; ++n) { const bf16x8 bq = frag_lds(qs, LDK, 16 * n, 32 * kk, lane);
#pragma unroll
            for (int a = 0; a < 2; ++a) acc[a][n] = mma16(sf[kk][a], bq, acc[a][n]); } }
#pragma unroll
    for (int kk = 0; kk < 2; ++kk) { bf16x8 af[2];
#pragma unroll
        for (int a = 0; a < 2; ++a) af[a] = frag_tr(vs, LDV, 32 * kk, 32 * wave + 16 * a, lane);
#pragma unroll
        for (int n = 0; n < 4; ++n) { const bf16x8 bp = frag_lds(ps, LDP, 16 * n, 32 * kk, lane);
#pragma unroll
            for (int a = 0; a < 2; ++a) acc[a][n] = mma16(af[a], bp, acc[a][n]); } }
#pragma unroll
    for (int n = 0; n < 4; ++n) { float s = 0.f;
#pragma unroll
        for (int a = 0; a < 2; ++a)
#pragma unroll
            for (int r = 0; r < 4; ++r) s += acc[a][n][r] * acc[a][n][r];
        s += __shfl_xor(s, 16); s += __shfl_xor(s, 32);
        if (lane < 16) red[wave * 64 + 16 * n + lane] = s; }
    __syncthreads();
    PT_STAMP(3);
    bf16* OB = wsp<bf16>(F, WS_OB);
#pragma unroll
    for (int n = 0; n < 4; ++n) { const int i = 16 * n + (lane & 15); float tot = 0.f;
#pragma unroll
        for (int w = 0; w < 8; ++w) tot += red[w * 64 + i];
        const float rs = 1.0f / sqrtf(tot * (1.0f / 256.0f) + LN_EPS);
#pragma unroll
        for (int a = 0; a < 2; ++a) { const int e = 32 * wave + 16 * a + 4 * (lane >> 4);
            const float g0 = bf2f(gw[n][a].x & 0xffffu), g1 = bf2f(gw[n][a].x >> 16), g2 = bf2f(gw[n][a].y & 0xffffu), g3 = bf2f(gw[n][a].y >> 16);
            u32x2 o; o.x = pk2(acc[a][n][0] * rs * gn[a].x * g0, acc[a][n][1] * rs * gn[a].y * g1); o.y = pk2(acc[a][n][2] * rs * gn[a].z * g2, acc[a][n][3] * rs * gn[a].w * g3);
            *(u32x2*)ob_at(OB, t0 + i, 1024 + h * 256 + e) = o; } }
    PT_STAMP(4);
}

DI void pool_unit(const Frame& F, int l, int unit, const float* pool_scale) {
    const int gi = unit & 3, tt = unit >> 2, t0 = tt * 128, tid = F.tid, lane = F.lane, wave = F.wave, w = 2 << gi;
    const bf16* H = wsp<bf16>(F, WS_H);
    LAS bf16* pl = (LAS bf16*)(F.lds);
    constexpr int LDP = 264;
    __syncthreads();
    for (int p = tid; p < 128 * 32; p += NTHR) { const int j = p >> 5, ch = p & 31, t = t0 + j, ts = t & (SEQ - 1);
        const int cnt = (ts + 1 < w) ? ts + 1 : w; float a[8];
#pragma unroll
        for (int i = 0; i < 8; ++i) a[i] = 0.f;
        float u0[8];
        const bf16* hp = H + (size_t)t * NH + C_PU + gi * 256 + 8 * ch;
        { float f[8]; unpack8(*(const u32x4*)hp, f);
#pragma unroll
          for (int i = 0; i < 8; ++i) { a[i] = f[i]; u0[i] = f[i]; } }
#pragma unroll
        for (int s = 1; s < 16; ++s) if (s < w) { const int sb = (s < cnt) ? s : 0;
            const u32x4 x = *(const u32x4*)(hp - (size_t)sb * NH); float f[8]; unpack8(x, f); const float wgt = (s < cnt) ? 1.f : 0.f;
#pragma unroll
            for (int i = 0; i < 8; ++i) a[i] += wgt * f[i]; }
        const float ic = 1.0f / (float)cnt;
#pragma unroll
        for (int i = 0; i < 8; ++i) a[i] = a[i] * ic - u0[i];
        *(LAS u32x4*)(pl + j * LDP + 8 * ch) = pack8(a); }
    __syncthreads();
    const bf16* WP = wsp<bf16>(F, WS_WPOOLT) + (size_t)(l * 4 + gi) * 256 * 256;
    f32x4 acc[2][8];
#pragma unroll
    for (int a = 0; a < 2; ++a)
#pragma unroll
        for (int n = 0; n < 8; ++n) acc[a][n] = (f32x4){0.f, 0.f, 0.f, 0.f};
#pragma unroll 2
    for (int kk = 0; kk < 8; ++kk) { bf16x8 af[2];
#pragma unroll
        for (int a = 0; a < 2; ++a) af[a] = frag_glb(WP, 256, 32 * wave + 16 * a, 32 * kk, lane);
#pragma unroll
        for (int n = 0; n < 8; ++n) { const bf16x8 bp = frag_lds(pl, LDP, 16 * n, 32 * kk, lane);
#pragma unroll
            for (int a = 0; a < 2; ++a) acc[a][n] = mma16(af[a], bp, acc[a][n]); } }
    bf16* OB = wsp<bf16>(F, WS_OB);
#pragma unroll
    for (int n = 0; n < 8; ++n) { const int t = t0 + 16 * n + (lane & 15);
#pragma unroll
        for (int a = 0; a < 2; ++a) { const int dd = gi * 256 + 32 * wave + 16 * a + 4 * (lane >> 4);
            const f32x4 sc = *(const f32x4*)(pool_scale + l * 1024 + dd);
            const u32x2 gw = *(const u32x2*)(H + (size_t)t * NH + C_PG + dd);
            const float g0 = bf2f(gw.x & 0xffffu), g1 = bf2f(gw.x >> 16), g2 = bf2f(gw.y & 0xffffu), g3 = bf2f(gw.y >> 16);
            u32x2 o; o.x = pk2(acc[a][n][0] * sc.x * g0, acc[a][n][1] * sc.y * g1); o.y = pk2(acc[a][n][2] * sc.z * g2, acc[a][n][3] * sc.w * g3);
            *(u32x2*)ob_at(OB, t, dd) = o; } }
}

DI void swa_unit(const Frame& F, int l, int unit, const float* sinks) {
    const int n = unit & 31, hq = (unit >> 5) & 15, b = unit >> 9, kvh = hq >> 3, tid = F.tid, lane = F.lane, wave = F.wave;
    const int tq0 = b * SEQ + n * 128, tk0 = tq0 - 128;
    const bf16* H = wsp<bf16>(F, WS_H); const f32x2* RT = wsp<f32x2>(F, WS_ROPE);
    constexpr int LD = 72, LDPW = 168;
    LAS bf16* qs = (LAS bf16*)(F.lds);
    LAS bf16* ks = (LAS bf16*)(F.lds + 18432);
    LAS bf16* vs = (LAS bf16*)(F.lds + 57600);
    LAS bf16* pw = (LAS bf16*)(F.lds + 96768) + wave * 16 * LDPW;
    __syncthreads();
    for (int p = tid; p < 128 * 4; p += NTHR) { const int i = p >> 2, ch = p & 3; const bf16* src = H + (size_t)(tq0 + i) * NH + C_SQ + hq * 64 + 16 * ch;
        float f[16]; { float a[8], c[8]; unpack8(*(const u32x4*)src, a); unpack8(*(const u32x4*)(src + 8), c);
#pragma unroll
            for (int j = 0; j < 8; ++j) { f[j] = a[j]; f[8 + j] = c[j]; } }
        if (ch == 0) {
#pragma unroll
            for (int j = 0; j < 8; ++j) { const f32x2 cs = RT[(size_t)(tq0 + i) * 8 + j]; const float x1 = f[j], x2 = f[8 + j]; f[j] = x1 * cs.x - x2 * cs.y; f[8 + j] = x2 * cs.x + x1 * cs.y; } }
        float o0[8], o1[8];
#pragma unroll
        for (int j = 0; j < 8; ++j) { o0[j] = f[j] * 0.125f; o1[j] = f[8 + j] * 0.125f; }
        *(LAS u32x4*)(qs + i * LD + 16 * ch) = pack8(o0); *(LAS u32x4*)(qs + i * LD + 16 * ch + 8) = pack8(o1); }
    for (int p = tid; p < 272 * 4; p += NTHR) { const int j = p >> 2, ch = p & 3; const bool ok = (j < 256) && (n > 0 || j >= 128);
        u32x4 k0 = (u32x4){0u, 0u, 0u, 0u}, k1 = k0, v0 = k0, v1 = k0;
        if (ok) { const bf16* ksrc = H + (size_t)(tk0 + j) * NH + C_SK + kvh * 64 + 16 * ch; const bf16* vsrc = H + (size_t)(tk0 + j) * NH + C_SV + kvh * 64 + 16 * ch;
            k0 = *(const u32x4*)ksrc; k1 = *(const u32x4*)(ksrc + 8); v0 = *(const u32x4*)vsrc; v1 = *(const u32x4*)(vsrc + 8);
            if (ch == 0) { float a[8], c[8]; unpack8(k0, a); unpack8(k1, c);
#pragma unroll
                for (int jj = 0; jj < 8; ++jj) { const f32x2 cs = RT[(size_t)(tk0 + j) * 8 + jj]; const float x1 = a[jj], x2 = c[jj]; a[jj] = x1 * cs.x - x2 * cs.y; c[jj] = x2 * cs.x + x1 * cs.y; }
                k0 = pack8(a); k1 = pack8(c); } }
        *(LAS u32x4*)(ks + j * LD + 16 * ch) = k0; *(LAS u32x4*)(ks + j * LD + 16 * ch + 8) = k1;
        *(LAS u32x4*)(vs + j * LD + 16 * ch) = v0; *(LAS u32x4*)(vs + j * LD + 16 * ch + 8) = v1; }
    __syncthreads();
    const int qi = 16 * wave + (lane & 15);
    bf16x8 qf[2];
#pragma unroll
    for (int s = 0; s < 2; ++s) qf[s] = frag_lds(qs, LD, 16 * wave, 32 * s, lane);
    f32x4 sc[10];
#pragma unroll
    for (int jt = 0; jt < 10; ++jt) { sc[jt] = (f32x4){0.f, 0.f, 0.f, 0.f};
#pragma unroll
        for (int s = 0; s < 2; ++s) sc[jt] = mma16(frag_lds(ks, LD, 16 * (wave + jt), 32 * s, lane), qf[s], sc[jt]); }
    const float sink = sinks[l * 16 + hq];
    float mx = sink;
#pragma unroll
    for (int jt = 0; jt < 10; ++jt)
#pragma unroll
        for (int r = 0; r < 4; ++r) { const int kj = 16 * (wave + jt) + 4 * (lane >> 4) + r; const bool ok = (kj > qi) && (kj <= qi + 128) && (n > 0 || kj >= 128);
            sc[jt][r] = ok ? sc[jt][r] : -INFINITY; mx = fmaxf(mx, sc[jt][r]); }
    mx = fmaxf(mx, __shfl_xor(mx, 16)); mx = fmaxf(mx, __shfl_xor(mx, 32));
    float sum = 0.f;
#pragma unroll
    for (int jt = 0; jt < 10; ++jt)
#pragma unroll
        for (int r = 0; r < 4; ++r) { const float p = fexp(sc[jt][r] - mx); sc[jt][r] = p; sum += p; }
    sum += __shfl_xor(sum, 16); sum += __shfl_xor(sum, 32);
    const float inv = 1.0f / (sum + fexp(sink - mx));
#pragma unroll
    for (int jt = 0; jt < 10; ++jt) { u32x2 o; o.x = pk2(sc[jt][0] * inv, sc[jt][1] * inv); o.y = pk2(sc[jt][2] * inv, sc[jt][3] * inv);
        *(LAS u32x2*)(pw + (lane & 15) * LDPW + 16 * jt + 4 * (lane >> 4)) = o; }
    LDS_WAIT();
    f32x4 oa[4];
#pragma unroll
    for (int dt = 0; dt < 4; ++dt) oa[dt] = (f32x4){0.f, 0.f, 0.f, 0.f};
#pragma unroll
    for (int s = 0; s < 5; ++s) { const bf16x8 pf = frag_lds(pw, LDPW, 0, 32 * s, lane);
#pragma unroll
        for (int dt = 0; dt < 4; ++dt) oa[dt] = mma16(frag_tr(vs, LD, 16 * wave + 32 * s, 16 * dt, lane), pf, oa[dt]); }
    bf16* OB = wsp<bf16>(F, WS_OB);
    { const int t = tq0 + qi;
#pragma unroll
      for (int dt = 0; dt < 4; ++dt) { const int dd = hq * 64 + 16 * dt + 4 * (lane >> 4);
          const u32x2 gw = *(const u32x2*)(H + (size_t)t * NH + C_SG + dd);
          const float g0 = bf2f(gw.x & 0xffffu), g1 = bf2f(gw.x >> 16), g2 = bf2f(gw.y & 0xffffu), g3 = bf2f(gw.y >> 16);
          u32x2 o; o.x = pk2(oa[dt][0] * g0, oa[dt][1] * g1); o.y = pk2(oa[dt][2] * g2, oa[dt][3] * g3);
          *(u32x2*)ob_at(OB, t, 2048 + dd) = o; } }
}

DI void mem_unit(const Frame& F, int l, int unit) {
    const int n = unit & 31, hx = (unit >> 5) & 3, b = unit >> 7, lane = F.lane, wave = F.wave, tid = F.tid;
    const int tq0 = b * SEQ + n * 128 + 16 * wave;
    const bf16* H = wsp<bf16>(F, WS_H);
    const bf16* MK = wsp<bf16>(F, WS_MK) + (size_t)l * 512 * 1024 + (size_t)b * 256 * 1024 + hx * 256;
    const bf16* MVT = wsp<bf16>(F, WS_MVT) + (size_t)l * 1024 * 512 + (size_t)hx * 256 * 512 + b * 256;
    constexpr int LDI = 264;
    LAS bf16* img = (LAS bf16*)(F.lds);
    __syncthreads();
#pragma unroll 4
    for (int p = tid; p < 256 * 32; p += NTHR) { const int r = p >> 5, ch = p & 31; *(LAS u32x4*)(img + r * LDI + 8 * ch) = *(const u32x4*)(MK + (size_t)r * 1024 + 8 * ch); }
    bf16x8 qf[8];
#pragma unroll
    for (int s = 0; s < 8; ++s) qf[s] = frag_glb(H + C_XQ + hx * 256, NH, tq0, 32 * s, lane);
    __syncthreads();
    f32x4 sc[16];
#pragma unroll
    for (int jt = 0; jt < 16; ++jt) { sc[jt] = (f32x4){0.f, 0.f, 0.f, 0.f};
#pragma unroll
        for (int s = 0; s < 8; ++s) sc[jt] = mma16(frag_lds(img, LDI, 16 * jt, 32 * s, lane), qf[s], sc[jt]);
        if (jt & 1) __builtin_amdgcn_sched_barrier(0); }
#pragma unroll
    for (int jt = 0; jt < 16; ++jt) asm volatile("" : "+v"(sc[jt]));
    __syncthreads();
#pragma unroll 4
    for (int p = tid; p < 256 * 32; p += NTHR) { const int r = p >> 5, ch = p & 31; *(LAS u32x4*)(img + r * LDI + 8 * ch) = *(const u32x4*)(MVT + (size_t)r * 512 + 8 * ch); }
    float mx = -INFINITY;
#pragma unroll
    for (int jt = 0; jt < 16; ++jt)
#pragma unroll
        for (int r = 0; r < 4; ++r) { sc[jt][r] *= 0.0625f; mx = fmaxf(mx, sc[jt][r]); }
    mx = fmaxf(mx, __shfl_xor(mx, 16)); mx = fmaxf(mx, __shfl_xor(mx, 32));
    float sum = 0.f;
#pragma unroll
    for (int jt = 0; jt < 16; ++jt)
#pragma unroll
        for (int r = 0; r < 4; ++r) { const float p = __builtin_amdgcn_exp2f((sc[jt][r] - mx) * 1.44269504089f); sc[jt][r] = p; sum += p; }
    sum += __shfl_xor(sum, 16); sum += __shfl_xor(sum, 32);
    const float inv = 1.0f / sum;
    bf16x8 pb[8];
#pragma unroll
    for (int s = 0; s < 8; ++s) { u32x4 w; w.x = pk2(sc[2 * s][0] * inv, sc[2 * s][1] * inv); w.y = pk2(sc[2 * s][2] * inv, sc[2 * s][3] * inv);
        w.z = pk2(sc[2 * s + 1][0] * inv, sc[2 * s + 1][1] * inv); w.w = pk2(sc[2 * s + 1][2] * inv, sc[2 * s + 1][3] * inv); pb[s] = __builtin_bit_cast(bf16x8, w); }
    __syncthreads();
    bf16* OB = wsp<bf16>(F, WS_OB); const int t = tq0 + (lane & 15);
    const LAS bf16* arow = img + (lane & 15) * LDI + 4 * (lane >> 4);
#pragma unroll 4
    for (int dt = 0; dt < 16; ++dt) { f32x4 oa = (f32x4){0.f, 0.f, 0.f, 0.f};
#pragma unroll
        for (int s = 0; s < 8; ++s) { const u32x2 lo = *(const LAS u32x2*)(arow + 16 * dt * LDI + 32 * s), hi = *(const LAS u32x2*)(arow + 16 * dt * LDI + 32 * s + 16);
            const u32x4 av = (u32x4){lo.x, lo.y, hi.x, hi.y};
            oa = mma16(__builtin_bit_cast(bf16x8, av), pb[s], oa); }
        __builtin_amdgcn_sched_barrier(0);
        const int dd = hx * 256 + 16 * dt + 4 * (lane >> 4);
        const u32x2 gw = *(const u32x2*)(H + (size_t)t * NH + C_XG + dd);
        const float g0 = bf2f(gw.x & 0xffffu), g1 = bf2f(gw.x >> 16), g2 = bf2f(gw.y & 0xffffu), g3 = bf2f(gw.y >> 16);
        u32x2 o; o.x = pk2(oa[0] * g0, oa[1] * g1); o.y = pk2(oa[2] * g2, oa[3] * g3);
        *(u32x2*)ob_at(OB, t, 3072 + dd) = o; }
}

#ifndef NAIVE_MASK
#define NAIVE_MASK 0
#endif
DI float Hf(const bf16* H, size_t row, int col) { return bf2f(H[row * NH + col]); }
DI void naive_mem(const Frame& F, int l) {
    const bf16* H = wsp<bf16>(F, WS_H); bf16* OB = wsp<bf16>(F, WS_OB);
    LAS float* qs = (LAS float*)(F.lds) + F.wave * 512; LAS float* ps = qs + 256;
    const int gw = F.wg * NWAVES + F.wave, NGW = F.G * NWAVES, lane = F.lane;
    for (int it = gw; it < MTOK * 4; it += NGW) {
        const int t = it >> 2, hx = it & 3, b = t / SEQ;
        const bf16* MK = wsp<bf16>(F, WS_MK) + (size_t)l * 512 * 1024 + (size_t)b * 256 * 1024 + hx * 256;
        const bf16* MVT = wsp<bf16>(F, WS_MVT) + (size_t)l * 1024 * 512 + (size_t)hx * 256 * 512 + b * 256;
        for (int i = 0; i < 4; ++i) qs[lane + 64 * i] = Hf(H, t, C_XQ + hx * 256 + lane + 64 * i);
        LDS_WAIT();
        float sc[4]; float mx = -INFINITY;
        for (int i = 0; i < 4; ++i) { const int j = lane + 64 * i; float a = 0.f; for (int d = 0; d < 256; ++d) a += qs[d] * bf2f(MK[(size_t)j * 1024 + d]); sc[i] = a * 0.0625f; mx = fmaxf(mx, sc[i]); }
        for (int o = 1; o < 64; o <<= 1) mx = fmaxf(mx, __shfl_xor(mx, o));
        float sum = 0.f; for (int i = 0; i < 4; ++i) { sc[i] = expf(sc[i] - mx); sum += sc[i]; }
        sum = wave_sum(sum);
        for (int i = 0; i < 4; ++i) ps[lane + 64 * i] = sc[i] / sum;
        LDS_WAIT();
        for (int i = 0; i < 4; ++i) { const int d = lane + 64 * i; float a = 0.f; for (int j = 0; j < 256; ++j) a += ps[j] * bf2f(MVT[(size_t)d * 512 + j]);
            *ob_at(OB, t, 3072 + hx * 256 + d) = (bf16)f2bf(a * Hf(H, t, C_XG + hx * 256 + d)); }
        LDS_WAIT();
    }
}
DI void naive_swa(const Frame& F, int l, const float* sinks) {
    const bf16* H = wsp<bf16>(F, WS_H); bf16* OB = wsp<bf16>(F, WS_OB); const f32x2* RT = wsp<f32x2>(F, WS_ROPE);
    LAS float* qs = (LAS float*)(F.lds) + F.wave * 256; LAS float* ps = qs + 64;
    const int gw = F.wg * NWAVES + F.wave, NGW = F.G * NWAVES, lane = F.lane;
    for (int it = gw; it < MTOK * 16; it += NGW) {
        const int t = it >> 4, hq = it & 15, kvh = hq >> 3, ts = t & (SEQ - 1);
        { float x = Hf(H, t, C_SQ + hq * 64 + lane);
          if (lane < 16) { const int i = lane & 7; const float x1 = Hf(H, t, C_SQ + hq * 64 + i), x2 = Hf(H, t, C_SQ + hq * 64 + 8 + i); const f32x2 cs = RT[(size_t)t * 8 + i];
              x = (lane < 8) ? x1 * cs.x - x2 * cs.y : x2 * cs.x + x1 * cs.y; }
          qs[lane] = x * 0.125f; }
        LDS_WAIT();
        float sc[2]; const float sink = sinks[l * 16 + hq]; float mx = sink;
        for (int i = 0; i < 2; ++i) { const int back = lane + 64 * i; sc[i] = -INFINITY;
            if (back <= ts) { const int tk = t - back; float a = 0.f;
                for (int d = 0; d < 64; ++d) { float kv = Hf(H, tk, C_SK + kvh * 64 + d);
                    if (d < 16) { const int ii = d & 7; const float x1 = Hf(H, tk, C_SK + kvh * 64 + ii), x2 = Hf(H, tk, C_SK + kvh * 64 + 8 + ii); const f32x2 cs = RT[(size_t)tk * 8 + ii];
                        kv = (d < 8) ? x1 * cs.x - x2 * cs.y : x2 * cs.x + x1 * cs.y; }
                    a += qs[d] * kv; }
                sc[i] = a; }
            mx = fmaxf(mx, sc[i]); }
        for (int o = 1; o < 64; o <<= 1) mx = fmaxf(mx, __shfl_xor(mx, o));
        float sum = 0.f; for (int i = 0; i < 2; ++i) { sc[i] = expf(sc[i] - mx); sum += sc[i]; }
        sum = wave_sum(sum) + expf(sink - mx);
        for (int i = 0; i < 2; ++i) ps[lane + 64 * i] = sc[i] / sum;
        LDS_WAIT();
        { float a = 0.f; const int nk = (ts + 1 < 128) ? ts + 1 : 128;
          for (int back = 0; back < nk; ++back) a += ps[back] * Hf(H, t - back, C_SV + kvh * 64 + lane);
          *ob_at(OB, t, 2048 + hq * 64 + lane) = (bf16)f2bf(a * Hf(H, t, C_SG + hq * 64 + lane)); }
        LDS_WAIT();
    }
}
DI void naive_pool(const Frame& F, int l, const float* w_pool, const float* pool_scale) {
    const bf16* H = wsp<bf16>(F, WS_H); bf16* OB = wsp<bf16>(F, WS_OB); LAS float* pl = (LAS float*)(F.lds);
    for (int unit = F.wg; unit < 512; unit += F.G) { const int gi = unit & 3, t0 = (unit >> 2) * 64, w = 2 << gi;
        __syncthreads();
        for (int p = F.tid; p < 64 * 256; p += NTHR) { const int j = p >> 8, c = p & 255, t = t0 + j, ts = t & (SEQ - 1); const int cnt = (ts + 1 < w) ? ts + 1 : w; float a = 0.f;
            for (int s2 = 0; s2 < cnt; ++s2) a += Hf(H, t - s2, C_PU + gi * 256 + c);
            pl[p] = a / (float)cnt - Hf(H, t, C_PU + gi * 256 + c); }
        __syncthreads();
        const float* W = w_pool + (size_t)(l * 4 + gi) * 256 * 256;
        for (int o = F.tid; o < 64 * 256; o += NTHR) { const int j = o >> 8, d = o & 255; float a = 0.f; for (int c = 0; c < 256; ++c) a += pl[j * 256 + c] * W[c * 256 + d];
            const int t = t0 + j; *ob_at(OB, t, gi * 256 + d) = (bf16)f2bf(a * pool_scale[l * 1024 + gi * 256 + d] * Hf(H, t, C_PG + gi * 256 + d)); } }
}
DI void naive_gla(const Frame& F, int l, const float* w_gla_up, const float* b_gla) {
    const bf16* H = wsp<bf16>(F, WS_H); float* RAW = wsp<float>(F, WS_GU); LAS float* red = (LAS float*)(F.lds);
    for (int unit = F.wg; unit < 64; unit += F.G) { const int bh = unit >> 3, es = unit & 7, b = bh >> 2, h = bh & 3, e = es * 32 + (F.tid & 31), dg = F.tid >> 5;
        float S[8], wu[8][16], bg[8];
        for (int i = 0; i < 8; ++i) { S[i] = 0.f; bg[i] = b_gla[l * 512 + h * 128 + 8 * dg + i]; for (int r = 0; r < 16; ++r) wu[i][r] = w_gla_up[(size_t)l * 16 * 512 + r * 512 + h * 128 + 8 * dg + i]; }
        for (int ts = 0; ts < SEQ; ++ts) { const size_t t = (size_t)b * SEQ + ts; float lr[16]; for (int r = 0; r < 16; ++r) lr[r] = Hf(H, t, C_LR + r);
            const float v = Hf(H, t, C_GV + h * 256 + e); float part = 0.f;
            for (int i = 0; i < 8; ++i) { float z = bg[i]; for (int r = 0; r < 16; ++r) z += lr[r] * wu[i][r];
                const float a = expf((fminf(z, 0.f) - log1pf(expf(-fabsf(z)))) * (1.0f / 16.0f));
                S[i] = a * S[i] + Hf(H, t, C_GK + h * 128 + 8 * dg + i) * v; part += Hf(H, t, C_GQ + h * 128 + 8 * dg + i) * 0.08838834764831845f * S[i]; }
            __syncthreads(); red[dg * 32 + (F.tid & 31)] = part; __syncthreads();
            if (dg == 0) { float o = 0.f; for (int g = 0; g < 16; ++g) o += red[g * 32 + (F.tid & 31)]; RAW[t * 1024 + h * 256 + e] = o; } } }
}
DI void naive_gla_norm(const Frame& F, int l, const float* gla_norm) {
    const bf16* H = wsp<bf16>(F, WS_H); bf16* OB = wsp<bf16>(F, WS_OB); const float* RAW = wsp<float>(F, WS_GU);
    const int gw = F.wg * NWAVES + F.wave, NGW = F.G * NWAVES, lane = F.lane;
    for (int it = gw; it < MTOK * 4; it += NGW) { const int t = it >> 2, h = it & 3; float o[4], ss = 0.f;
        for (int i = 0; i < 4; ++i) { o[i] = RAW[(size_t)t * 1024 + h * 256 + lane + 64 * i]; ss += o[i] * o[i]; }
        ss = wave_sum(ss); const float rs = 1.0f / sqrtf(ss * (1.0f / 256.0f) + LN_EPS);
        for (int i = 0; i < 4; ++i) { const int e = lane + 64 * i; *ob_at(OB, t, 1024 + h * 256 + e) = (bf16)f2bf(o[i] * rs * gla_norm[l * 1024 + h * 256 + e] * Hf(H, t, C_GG + h * 256 + e)); } }
}

DI void ln_phase(const Frame& F, int l, const float* ln_g, const float* ln_b) {
    const int gw = F.wg * NWAVES + F.wave, NGW = F.G * NWAVES, lane = F.lane;
    const float* g = ln_g + l * DM; const float* bb = ln_b + l * DM;
    for (int m = gw; m < MTOK; m += NGW) {
        f32x4* row = (f32x4*)(F.out + (size_t)m * DM) + lane; const f32x4* zrow = (const f32x4*)(wsp<float>(F, WS_Z) + (size_t)m * DM) + lane;
        f32x4 v[16]; float s = 0.f;
#pragma unroll
        for (int j = 0; j < 16; ++j) { v[j] = zrow[64 * j]; s += (v[j].x + v[j].y) + (v[j].z + v[j].w); }
        const float mean = wave_sum(s) * (1.f / DM); float s2 = 0.f;
#pragma unroll
        for (int j = 0; j < 16; ++j) { v[j] = v[j] - mean; s2 += (v[j].x * v[j].x + v[j].y * v[j].y) + (v[j].z * v[j].z + v[j].w * v[j].w); }
        const float rstd = 1.f / sqrtf(wave_sum(s2) * (1.f / DM) + LN_EPS);
        u32x2* xb = (u32x2*)(wsp<bf16>(F, WS_XB) + (size_t)m * DM) + lane; unsigned* x8 = (unsigned*)(wsp<unsigned char>(F, WS_X8) + (size_t)m * DM) + lane;
#pragma unroll
        for (int j = 0; j < 16; ++j) { const f32x4 gg = *((const f32x4*)g + lane + 64 * j), be = *((const f32x4*)bb + lane + 64 * j);
            const f32x4 o = v[j] * rstd * gg + be; row[64 * j] = o;
#if F6
            if (l + 1 < DEPTH) { u32x2 w; w.x = pk2(o.x, o.y); w.y = pk2(o.z, o.w); xb[64 * j] = w;
                LAS unsigned char* lw = F.lds + F.wave * 9216;
                *(LAS f32x4*)(lw + ((lane >> 3) + 8 * (j & 7)) * 144 + (lane & 7) * 16) = o * X8_SCALE;
                if ((j & 7) == 7) { LDS_WAIT(); float f[32];
#pragma unroll
                    for (int t = 0; t < 8; ++t) { const f32x4 q = *(const LAS f32x4*)(lw + lane * 144 + 16 * t); f[4 * t] = q.x; f[4 * t + 1] = q.y; f[4 * t + 2] = q.z; f[4 * t + 3] = q.w; }
                    u32x4 lo, hi; pk32_fp6(f, lo, hi); const int gi = 64 * (j >> 3) + lane; size_t ol, oh; pg8::f6_off(m, gi >> 2, gi & 3, ol, oh);
                    *(u32x4*)(wsp<unsigned char>(F, WS_X8) + ol) = lo; u32x2 h2; h2.x = hi.x; h2.y = hi.y; *(u32x2*)(wsp<unsigned char>(F, WS_X8) + oh) = h2; LDS_WAIT(); } } }
#else
            if (l + 1 < DEPTH) { u32x2 w; w.x = pk2(o.x, o.y); w.y = pk2(o.z, o.w); xb[64 * j] = w; x8[64 * j] = pk4_fp8(o.x * X8_SCALE, o.y * X8_SCALE, o.z * X8_SCALE, o.w * X8_SCALE); } }
#endif
    }
}

struct Args { const void* in[15]; float* out; unsigned char* ws; int ph_lo, ph_hi; };
constexpr int PH_PER_LAYER = 7, N_PHASES = 1 + PH_PER_LAYER * DEPTH;
#define IN(k) (lo <= (k) && (k) < hi)
#ifndef PH_MASK
#define PH_MASK 0xffff
#endif
#define PHM(b) ((PH_MASK >> (b)) & 1)
#ifndef REP_MASK
#define REP_MASK 0
#endif
#define REPS(b) (((REP_MASK >> (b)) & 1) ? 2 : 1)
#define SEAM(k) do { if (IN(k) && IN((k) + 1)) xcd_barrier(bar); } while (0)
#ifndef PROBE_CLK
#define PROBE_CLK 0
#endif
#ifndef PROBE_HOT
#define PROBE_HOT 0
#endif
struct SchedHot {
    static constexpr bool BLK = false;
    int G, c, mode; const char* A; const char* B;
    DI bool next(int i, pg8::Unit& u) const { if (i >= 4) return false; if (mode == 1) { u.pm = c & 7; u.pn = 0; } else if (mode == 4) { u.pm = c & 7; u.pn = c & 7; } else pg8::static_tile(i * G + c, 32, 32, u.pm, u.pn); u.gi = 0; return true; }
    DI const char* abase(const pg8::Unit& u) const { return A + (size_t)u.pm * 256 * 4096 * 2; }
    DI const char* bbase(const pg8::Unit& u) const { return B + (size_t)u.pn * 256 * 4096 * 2; }
};
struct SchedHot6 {
    static constexpr bool BLK = false;
    int G, c, mode; const char* A; const char* B;
    DI bool next(int i, pg8::Unit& u) const { if (i >= 4) return false; if (mode == 6) { u.pm = c & 7; u.pn = c & 7; } else pg8::static_tile(i * G + c, 32, 32, u.pm, u.pn); u.gi = 0; return true; }
    DI const char* abase(const pg8::Unit& u) const { return A + (size_t)u.pm * 786432; }
    DI const char* bbase(const pg8::Unit& u) const { return (mode == 6 ? A : B) + (size_t)u.pn * 786432; }
};
struct SchedHotBlk : SchedHot { static constexpr bool BLK = true; };
template <int l> DI void layer_body(const Frame& F, const Args& args, const int lo, const int hi, const XcdBarrier& bar) {
        const int p0 = 1 + PH_PER_LAYER * l;
        if (PHM(1) && IN(p0)) { {
            SchedInProj S; S.G = F.G; S.c = F.wg; S.n_extra = (l == 0) ? 32 : 0; S.XB = (const char*)(F.ws + WS_XB); S.WT = (const char*)(F.ws + WS_WINT) + (size_t)l * NH * 4096 * 2;
            S.MEMB = (const char*)(F.ws + WS_MEMB); S.WKV = (const char*)(F.ws + WS_WMKVT);
            EpiH E{wsp<bf16>(F, WS_H), wsp<bf16>(F, WS_MK), wsp<bf16>(F, WS_MVT)};
            pg8::SchedStatic S8; S8.nM = 32; S8.nN = N_F8 / (128 * F8NB); S8.G = F.G; S8.c = (F.wg + F8_ROT) % F.G; S8.A = (const char*)(F.ws + WS_X8); S8.B = (const char*)(F.ws + WS_W8) + (size_t)l * W8_LAYER;
            S8.astep = F6 ? (size_t)2 * 32 * 12288 : (size_t)256 * 4096; S8.bstep = F6 ? (size_t)F8NB * 32 * 12288 : (size_t)(128 * F8NB) * 4096;
            EpiMG<F8NB> E8{wsp<bf16>(F, WS_H)};
#if F6_FIRST
            pg8::gemm_phase<EpiMG<F8NB>, pg8::SchedStatic, F8NB, true, true>(F.lds, 2048, S8, E8);
            pg8::gemm_phase<EpiH, SchedInProj, 2, true>(F.lds, 4096, S, E);
#else
            pg8::gemm_phase<EpiH, SchedInProj, 2, true>(F.lds, 4096, S, E);
            pg8::gemm_phase<EpiMG<F8NB>, pg8::SchedStatic, F8NB, true, true>(F.lds, 2048, S8, E8);
#endif
        }
        if (PROBE_HOT >= 5 && l == 0) {
            SchedHot6 S6; S6.G = F.G; S6.c = F.wg; S6.mode = PROBE_HOT; S6.A = (const char*)(F.ws + WS_X8); S6.B = (const char*)(F.ws + WS_W8);
            EpiMG<F8NB> E6{(bf16*)(F.ws + (size_t)1700 * MiB)};
            pg8::gemm_phase<EpiMG<F8NB>, SchedHot6, F8NB, true, true>(F.lds, 2048, S6, E6);
        } else
        if (PROBE_HOT != 0 && l == 0) {
            SchedHot S; S.G = F.G; S.c = F.wg; S.mode = PROBE_HOT; S.A = (const char*)(F.ws + WS_XB); S.B = (PROBE_HOT == 4) ? (const char*)(F.ws + WS_XB) : (const char*)(F.ws + WS_WINT);
            EpiH E{(bf16*)(F.ws + (size_t)1700 * MiB), wsp<bf16>(F, WS_MK), wsp<bf16>(F, WS_MVT)};
            if (PROBE_HOT == 3) { SchedHotBlk S3; S3.G = S.G; S3.c = S.c; S3.mode = 2; S3.A = S.A; S3.B = S.B; pg8::gemm_phase<EpiH, SchedHotBlk, 2, true>(F.lds, 4096, S3, E); }
            else pg8::gemm_phase<EpiH, SchedHot, 2, true>(F.lds, 4096, S, E);
        }
        if (REPS(1) == 2) {
            SchedInProj S; S.G = F.G; S.c = F.wg; S.n_extra = (l == 0) ? 32 : 0; S.XB = (const char*)(F.ws + WS_XB); S.WT = (const char*)(F.ws + WS_WINT) + (size_t)l * NH * 4096 * 2;
            S.MEMB = (const char*)(F.ws + WS_MEMB); S.WKV = (const char*)(F.ws + WS_WMKVT);
            EpiH E{wsp<bf16>(F, WS_H), wsp<bf16>(F, WS_MK), wsp<bf16>(F, WS_MVT)};
            pg8::gemm_phase<EpiH, SchedInProj, 2, true>(F.lds, 4096, S, E);
            pg8::SchedStatic S8; S8.nM = 32; S8.nN = N_F8 / (128 * F8NB); S8.G = F.G; S8.c = (F.wg + F8_ROT) % F.G; S8.A = (const char*)(F.ws + WS_X8); S8.B = (const char*)(F.ws + WS_W8) + (size_t)l * W8_LAYER;
            S8.astep = F6 ? (size_t)2 * 32 * 12288 : (size_t)256 * 4096; S8.bstep = F6 ? (size_t)F8NB * 32 * 12288 : (size_t)(128 * F8NB) * 4096;
            EpiMG<F8NB> E8{wsp<bf16>(F, WS_H)};
            pg8::gemm_phase<EpiMG<F8NB>, pg8::SchedStatic, F8NB, true, true>(F.lds, 2048, S8, E8);
        } }
        SEAM(p0);
        if (PHM(2) && IN(p0 + 1)) for (int rep = 0; rep < REPS(2); ++rep) { if (NAIVE_MASK & 2) naive_gla(F, l, (const float*)args.in[6], (const float*)args.in[7]); else for (int u = F.wg; u < 512; u += F.G) gla_a_unit(F, l, u, (const float*)args.in[6], (const float*)args.in[7]); }
        SEAM(p0 + 1);
        if (PHM(3) && IN(p0 + 2)) for (int rep = 0; rep < REPS(3); ++rep) { if (!(NAIVE_MASK & 2)) gla_scan(F); }
        SEAM(p0 + 2);
        if (PHM(4) && IN(p0 + 3)) for (int rep = 0; rep < REPS(4); ++rep) {
            if (NAIVE_MASK & 2) naive_gla_norm(F, l, (const float*)args.in[8]); else
            for (int r2 = 0; r2 < REPS(8); ++r2) for (int u = F.wg; u < 512; u += F.G) gla_c_unit(F, l, u, (const float*)args.in[8]);
            if (NAIVE_MASK & 1) naive_pool(F, l, (const float*)args.in[4], (const float*)args.in[5]); else
            for (int r2 = 0; r2 < REPS(9); ++r2) for (int u = F.wg; u < 256; u += F.G) pool_unit(F, l, u, (const float*)args.in[5]);
            __syncthreads();
            if (NAIVE_MASK & 4) naive_swa(F, l, (const float*)args.in[9]); else
            for (int r2 = 0; r2 < REPS(10); ++r2) for (int u = F.wg; u < 1024; u += F.G) swa_unit(F, l, u, (const float*)args.in[9]);
            __syncthreads();
            if (NAIVE_MASK & 8) naive_mem(F, l); else
            for (int r2 = 0; r2 < REPS(11); ++r2) for (int u = F.wg; u < 256; u += F.G) mem_unit(F, l, u);
            __syncthreads();
        }
        SEAM(p0 + 3);
        if (PHM(5) && IN(p0 + 4)) { {
            pg8::SchedStatic S; S.nM = 32; S.nN = 32; S.G = F.G; S.c = F.wg; S.A = (const char*)(F.ws + WS_OB); S.B = (const char*)(F.ws + WS_WBRT) + (size_t)l * 4096 * 4096 * 2;
            S.astep = (size_t)256 * 4096 * 2; S.bstep = (size_t)128 * 4096 * 2;
            EpiGate E{wsp<bf16>(F, WS_H), wsp<bf16>(F, WS_YB)};
            if (BLK_GATE) { pg8::SchedStaticBlk SB; (pg8::SchedStatic&)SB = S; pg8::gemm_phase<EpiGate, pg8::SchedStaticBlk, 1, true>(F.lds, 4096, SB, E); } else
            pg8::gemm_phase<EpiGate, pg8::SchedStatic, 1, true>(F.lds, 4096, S, E);
        }
        if (REPS(5) == 2) {
            pg8::SchedStatic S; S.nM = 32; S.nN = 32; S.G = F.G; S.c = F.wg; S.A = (const char*)(F.ws + WS_OB); S.B = (const char*)(F.ws + WS_WBRT) + (size_t)l * 4096 * 4096 * 2;
            S.astep = (size_t)256 * 4096 * 2; S.bstep = (size_t)128 * 4096 * 2;
            EpiGate E{wsp<bf16>(F, WS_H), wsp<bf16>(F, WS_YB)};
            if (BLK_GATE) { pg8::SchedStaticBlk SB; (pg8::SchedStatic&)SB = S; pg8::gemm_phase<EpiGate, pg8::SchedStaticBlk, 1, true>(F.lds, 4096, SB, E); } else
            pg8::gemm_phase<EpiGate, pg8::SchedStatic, 1, true>(F.lds, 4096, S, E);
        } }
        SEAM(p0 + 4);
        if (PHM(6) && IN(p0 + 5)) { {
            pg8::SchedStatic S; S.nM = 32; S.nN = 16; S.G = F.G; S.c = F.wg; S.A = (const char*)(F.ws + WS_YB); S.B = (const char*)(F.ws + WS_WOUTT) + (size_t)l * 4096 * 4096 * 2;
            S.astep = (size_t)256 * 4096 * 2; S.bstep = (size_t)256 * 4096 * 2;
            EpiRes E{l == 0 ? (const float*)args.in[0] : (const float*)F.out, wsp<float>(F, WS_Z)};
            if (BLK_OUT) { pg8::SchedStaticBlk SB; (pg8::SchedStatic&)SB = S; pg8::gemm_phase<EpiRes, pg8::SchedStaticBlk, 2, true>(F.lds, 4096, SB, E); } else
            pg8::gemm_phase<EpiRes, pg8::SchedStatic, 2, true>(F.lds, 4096, S, E);
        }
        if (REPS(6) == 2) {
            pg8::SchedStatic S; S.nM = 32; S.nN = 16; S.G = F.G; S.c = F.wg; S.A = (const char*)(F.ws + WS_YB); S.B = (const char*)(F.ws + WS_WOUTT) + (size_t)l * 4096 * 4096 * 2;
            S.astep = (size_t)256 * 4096 * 2; S.bstep = (size_t)256 * 4096 * 2;
            EpiRes E{l == 0 ? (const float*)args.in[0] : (const float*)F.out, wsp<float>(F, WS_Z)};
            if (BLK_OUT) { pg8::SchedStaticBlk SB; (pg8::SchedStatic&)SB = S; pg8::gemm_phase<EpiRes, pg8::SchedStaticBlk, 2, true>(F.lds, 4096, SB, E); } else
            pg8::gemm_phase<EpiRes, pg8::SchedStatic, 2, true>(F.lds, 4096, S, E);
        } }
        SEAM(p0 + 5);
        if (PHM(7) && IN(p0 + 6)) for (int rep = 0; rep < REPS(7); ++rep) { ln_phase(F, l, (const float*)args.in[13], (const float*)args.in[14]); }
        SEAM(p0 + 6);
}


__global__ void __launch_bounds__(NTHR, 2) mk_fwd(Args args) {
    extern __shared__ __attribute__((aligned(16))) unsigned char lds_raw[];
    Frame F;
    F.lds = (LAS unsigned char*)lds_raw;
    F.tid = threadIdx.x; F.lane = F.tid & 63; F.wave = __builtin_amdgcn_readfirstlane(F.tid >> 6); F.G = gridDim.x; F.wg = blockIdx.x;
    F.out = args.out; F.ws = args.ws;
    volatile LAS unsigned* MISC = (volatile LAS unsigned*)(F.lds + MISC_OFF);
    for (int u = F.tid; u < (LDS_BYTES - LDSCTL_OFF) / 4; u += NTHR) ((LAS unsigned*)(F.lds + LDSCTL_OFF))[u] = 0u;
    __syncthreads();
    unsigned* barw = (unsigned*)(F.ws + WS_CTL) + CW_BAR;
    XcdBarrier bar; bar.bar = barw; bar.x = 0; bar.st = nullptr;
    const int lo = args.ph_lo, hi = args.ph_hi;
    if (hi - lo > 1) bar = xcd_barrier_post(barw, MISC + 8);

    if (PHM(0) && IN(0)) for (int rep = 0; rep < REPS(0); ++rep) { prologue(F, (const float*)args.in[0], (const float*)args.in[1], (const int*)args.in[2], (const float*)args.in[3], (const float*)args.in[4], (const float*)args.in[10], (const float*)args.in[11], (const float*)args.in[12]); }
    SEAM(0);
    layer_body<0>(F, args, lo, hi, bar);
#if PROBE_CLK
    const long long pc0 = clock64(), pw0 = wall_clock64();
#endif
    layer_body<1>(F, args, lo, hi, bar);
#if PROBE_CLK
    if (blockIdx.x == 0 && threadIdx.x == 0) {
        const long long dc = clock64() - pc0, dw = wall_clock64() - pw0; const long long fmhz = dw > 0 ? 100 * dc / dw : 0; const long long ticks = (fmhz - 1000) * 100;
        if (ticks > 0 && ticks < 300000) { const long long s0 = wall_clock64(); while (wall_clock64() - s0 < ticks) __builtin_amdgcn_s_sleep(8); }
    }
#endif
#if PROBE_T
    if (blockIdx.x == 0 && threadIdx.x == 0) {
        const unsigned acc_t = ((volatile LAS unsigned*)(F.lds + MISC_OFF + 128))[PROBE_T]; const long long ticks = 8ll * acc_t;
        if (ticks > 0 && ticks < 400000) { const long long s0 = wall_clock64(); while (wall_clock64() - s0 < ticks) __builtin_amdgcn_s_sleep(8); }
    }
#endif
#undef IN
#undef SEAM
}

extern "C" void kernel_launch(void* const* d_in, const int* in_sizes, int n_in, void* d_out, int out_size, void* d_ws, size_t ws_size, hipStream_t stream) {
    static int grid = 0;
    if (grid == 0) {
        if (n_in != 15 || out_size != MTOK * DM || ws_size < WS_END) { fprintf(stderr, "kernel_launch: unexpected sizes (n_in %d, out %d, ws %zu); nothing launched\n", n_in, out_size, ws_size); grid = -1; return; }
        int dev = 0, cus = 0, per_cu = 0;
        if (hipGetDevice(&dev) != hipSuccess || hipDeviceGetAttribute(&cus, hipDeviceAttributeMultiprocessorCount, dev) != hipSuccess) { grid = -1; return; }
        if (hipFuncSetAttribute((const void*)mk_fwd, hipFuncAttributeMaxDynamicSharedMemorySize, LDS_BYTES) != hipSuccess) { fprintf(stderr, "kernel_launch: hipFuncSetAttribute failed\n"); grid = -1; return; }
        if (hipOccupancyMaxActiveBlocksPerMultiprocessor(&per_cu, (const void*)mk_fwd, NTHR, LDS_BYTES) != hipSuccess || per_cu < 1) fprintf(stderr, "kernel_launch: occupancy query says %d\n", per_cu);
        (void)hipGetLastError();
        grid = cus;
    }
    if (grid < 0) return;
    (void)hipMemsetAsync((char*)d_ws + WS_CTL, 0, CTL_ZERO_BYTES, stream);
    Args a{};
    for (int i = 0; i < 15; ++i) a.in[i] = d_in[i];
    a.out = (float*)d_out; a.ws = (unsigned char*)d_ws;
#if MK_PER_PHASE
    for (int p = 0; p < N_PHASES; ++p) { a.ph_lo = p; a.ph_hi = p + 1; hipLaunchKernelGGL(mk_fwd, dim3(grid), dim3(NTHR), LDS_BYTES, stream, a); }
#else
    a.ph_lo = 0; a.ph_hi = N_PHASES;
    hipLaunchKernelGGL(mk_fwd, dim3(grid), dim3(NTHR), LDS_BYTES, stream, a);
#endif
}
```

```cpp
#include <hip/hip_runtime.h>
#include <cstdio>
#include <cstdint>

#ifndef F8ASM1
#define F8ASM1 0
#endif
#ifndef F8NB
#define F8NB 2
#endif
#ifndef MK_PER_PHASE
#define MK_PER_PHASE 0
#endif

#define DI __device__ __forceinline__
#define LAS __attribute__((address_space(3)))
#define GAS __attribute__((address_space(1)))
typedef unsigned short bf16;
typedef short bf16x8 __attribute__((ext_vector_type(8)));
typedef short s16x4 __attribute__((ext_vector_type(4)));
typedef short v4i16_t __attribute__((ext_vector_type(4)));
typedef float f32x4 __attribute__((ext_vector_type(4)));
typedef float f32x2 __attribute__((ext_vector_type(2)));
typedef unsigned u32x4 __attribute__((ext_vector_type(4)));
typedef unsigned u32x2 __attribute__((ext_vector_type(2)));

constexpr int BATCH = 2, SEQ = 4096, DM = 4096, MTOK = BATCH * SEQ, DEPTH = 2;
constexpr int D_IN = 25872, NH = 26112;
constexpr int BW = 1024;
constexpr int MEMLEN = 256;
constexpr int C_PU = 0, C_PG = 1024, C_GQ = 2048, C_GK = 2560, C_GV = 3072, C_GG = 4096, C_SQ = 5120, C_SK = 6144, C_SV = 6272, C_SG = 6400, C_XQ = 7424, C_XG = 8448, C_MG = 9472, C_LR = 25856;
constexpr float LN_EPS = 1e-5f;
constexpr float DN_ALPHA = 1.41421356237309515f;

constexpr size_t MiB = 1u << 20;
constexpr size_t WS_CTL = 0, CTL_ZERO_BYTES = 1 * MiB;
constexpr size_t WS_ROPE = 1 * MiB;
constexpr size_t WS_WPOOLT = 2 * MiB;
constexpr size_t WS_MEMB = 4 * MiB;
constexpr size_t WS_MK = 8 * MiB;
constexpr size_t WS_MVT = 10 * MiB;
constexpr size_t WS_DEC = 12 * MiB;
constexpr size_t WS_WMKVT = 16 * MiB;
constexpr size_t WS_WBRT = 48 * MiB;
constexpr size_t WS_WOUTT = 112 * MiB;
constexpr size_t WS_XB = 176 * MiB;
constexpr size_t WS_OB = 240 * MiB;
constexpr size_t WS_YB = 304 * MiB;
constexpr size_t WS_GU = 368 * MiB;
constexpr size_t WS_GS = 432 * MiB;
constexpr size_t WS_GB = 464 * MiB;
constexpr size_t WS_WINT = 512 * MiB;
constexpr size_t WS_H = 928 * MiB;
constexpr size_t WS_Z = 1336 * MiB;
constexpr size_t WS_X8 = 1464 * MiB;
constexpr size_t WS_W8 = 1496 * MiB;
constexpr size_t WS_END = 1660 * MiB;
constexpr int C_F8 = C_SQ, N_F8 = C_LR - C_F8;
#ifndef STAGE_LATE
#define STAGE_LATE 0
#endif
#ifndef PRO_NFAST
#define PRO_NFAST 1
#endif
#ifndef BLK_GATE
#define BLK_GATE 1
#endif
#ifndef BLK_OUT
#define BLK_OUT 1
#endif
#ifndef F6_FIRST
#define F6_FIRST 1
#endif
#ifndef F8_ROT
#define F8_ROT 64
#endif
#ifndef F6
#define F6 1
#endif
constexpr size_t W8_LAYER = F6 ? (size_t)(N_F8 / 128) * 32 * 12288 : (size_t)N_F8 * 4096;
constexpr float X8_SCALE = F6 ? 2.0f : 16.0f, W8_SCALE = F6 ? 128.0f : 2048.0f, MG_DESCALE = 1.0f / (X8_SCALE * W8_SCALE);
constexpr int CW_BAR = 4096;

constexpr int RING_BYTES = 131072;
constexpr int THIN_BYTES = 141312;
constexpr int LDSCTL_OFF = THIN_BYTES, MISC_OFF = LDSCTL_OFF + 320;
constexpr int LDS_BYTES = 147456;
constexpr int NWAVES = 8, NTHR = 512;

DI float bf2f(unsigned v) { return __builtin_bit_cast(float, v << 16); }
DI unsigned f2bf(float f) { unsigned u = __builtin_bit_cast(unsigned, f); return (u + 0x7fffu + ((u >> 16) & 1u)) >> 16; }
typedef float f32x2_t __attribute__((ext_vector_type(2))); typedef __bf16 bf16x2_t __attribute__((ext_vector_type(2)));
DI unsigned cvt_pk_bf16(float lo, float hi) { const f32x2_t v = {lo, hi}; const bf16x2_t b = __builtin_convertvector(v, bf16x2_t); return __builtin_bit_cast(unsigned, b); }
DI unsigned pk2(float lo, float hi) { return cvt_pk_bf16(lo, hi); }
DI float fast_sigmoid(float v) { return __builtin_amdgcn_rcpf(1.0f + __builtin_amdgcn_exp2f(-1.44269504089f * v)); }
DI void unpack8(const u32x4 w, float (&f)[8]) {
    f[0] = bf2f(w.x & 0xffffu); f[1] = bf2f(w.x >> 16); f[2] = bf2f(w.y & 0xffffu); f[3] = bf2f(w.y >> 16);
    f[4] = bf2f(w.z & 0xffffu); f[5] = bf2f(w.z >> 16); f[6] = bf2f(w.w & 0xffffu); f[7] = bf2f(w.w >> 16);
}
DI u32x4 pack8(const float (&f)[8]) { u32x4 w; w.x = pk2(f[0], f[1]); w.y = pk2(f[2], f[3]); w.z = pk2(f[4], f[5]); w.w = pk2(f[6], f[7]); return w; }
DI float clamp448(float v) { return fminf(fmaxf(v, -448.0f), 448.0f); }
DI unsigned pk4_fp8(float a, float b, float c, float d) {
    int w = 0; w = __builtin_amdgcn_cvt_pk_fp8_f32(clamp448(a), clamp448(b), w, false); w = __builtin_amdgcn_cvt_pk_fp8_f32(clamp448(c), clamp448(d), w, true); return (unsigned)w; }
typedef int v8i32 __attribute__((ext_vector_type(8)));
typedef int v6i32 __attribute__((ext_vector_type(6)));
typedef int v4i32 __attribute__((ext_vector_type(4)));
typedef unsigned u32x6 __attribute__((ext_vector_type(6)));
typedef float f32x16 __attribute__((ext_vector_type(16)));
DI void pk32_fp6(const float (&f)[32], u32x4& lo, u32x4& hi) {
    f32x16 a, b;
#pragma unroll
    for (int i = 0; i < 16; ++i) { a[i] = f[i]; b[i] = f[16 + i]; }
    const u32x6 r = __builtin_amdgcn_cvt_scalef32_2xpk16_fp6_f32(a, b, 1.0f);
    lo.x = r[0]; lo.y = r[1]; lo.z = r[2]; lo.w = r[3]; hi.x = r[4]; hi.y = r[5]; hi.z = 0u; hi.w = 0u;
}
DI f32x4 mma16(bf16x8 a, bf16x8 b, f32x4 c) { return __builtin_amdgcn_mfma_f32_16x16x32_bf16(a, b, c, 0, 0, 0); }
DI bf16x8 frag_lds(const LAS bf16* img, int ld, int idx0, int k0, int lane) { return *(const LAS bf16x8*)(img + (idx0 + (lane & 15)) * ld + k0 + 8 * (lane >> 4)); }
DI bf16x8 frag_glb(const bf16* img, size_t ld, int idx0, int k0, int lane) { return *(const bf16x8*)(img + (size_t)(idx0 + (lane & 15)) * ld + k0 + 8 * (lane >> 4)); }
DI s16x4 tr4(const LAS bf16* p) { return __builtin_bit_cast(s16x4, __builtin_amdgcn_ds_read_tr16_b64_v4i16((LAS v4i16_t*)p)); }
DI bf16x8 frag_tr(const LAS bf16* img, int ld, int k0, int idx0, int lane) {
    const int g = lane >> 4, q = (lane >> 2) & 3, p = lane & 3;
    const LAS bf16* a0 = img + (k0 + 8 * g + q) * ld + idx0 + 4 * p;
    const s16x4 lo = tr4(a0), hi = tr4(a0 + 4 * ld);
    return __builtin_shufflevector(lo, hi, 0, 1, 2, 3, 4, 5, 6, 7);
}
DI float wave_sum(float v) {
#pragma unroll
    for (int o = 1; o < 64; o <<= 1) v += __shfl_xor(v, o);
    return v;
}
#define LDS_WAIT() asm volatile("s_waitcnt lgkmcnt(0)" ::: "memory")
#define VM_WAIT() asm volatile("s_waitcnt vmcnt(0)" ::: "memory")

namespace pg8 {
constexpr int BM = 256, BK = 64, HALF = 128, HTB = HALF * BK * 2, STAGE_BYTES = 8 * HTB, NXCD = 8, WGM = 8;
__host__ __device__ __forceinline__ int lds_byte(int r, int c) { const int st = (r >> 4) * 2 + (c >> 5), rr = r & 15, cc = c & 31, ob = rr * 64 + cc * 2; return st * 1024 + (ob ^ (((ob >> 9) & 1) << 5)); }
__host__ __device__ __forceinline__ void stage_rc(int b, int& R, int& C) { const int st = b / 1024, sb = b % 1024, swz = sb ^ (((sb >> 9) & 1) << 5); R = (st >> 1) * 16 + swz / 64; C = (st & 1) * 32 + (swz % 64) / 2; }
__host__ __device__ __forceinline__ int perm32(int rho) { const int n = rho >> 4, i = rho & 15; return 8 * (i >> 2) + 4 * n + (i & 3); }
__host__ __device__ __forceinline__ int invperm32(int v) { return 16 * ((v >> 2) & 1) + 4 * (v >> 3) + (v & 3); }
template <bool PERM> __host__ __device__ __forceinline__ size_t blk_off(int row, int k, int NT) {
    const int r = PERM ? ((row & ~31) + invperm32(row & 31)) : row;
    return ((size_t)(r >> 7) * NT + (k >> 6)) * 16384 + lds_byte(r & 127, k & 63);
}
__host__ __device__ __forceinline__ void f6_off(int row, int step, int q, size_t& lo, size_t& hi) {
    const int ht = row >> 7, rb = (row >> 4) & 7, rr = row & 15;
    const size_t base = ((size_t)ht * 32 + step) * 12288;
    lo = base + rb * 1024 + lds_byte(rr, q * 8);
    hi = base + 8192 + rb * 512 + q * 128 + rr * 8;
}

struct Unit { int pm, pn, gi; };

DI void static_tile(int L, int nM, int nN, int& pm, int& pn) {
    const int nwg = nM * nN; int wgid = L;
    { const int q = nwg / NXCD, r = nwg % NXCD, xcd = wgid % NXCD, off = wgid / NXCD; wgid = (xcd < r ? xcd * (q + 1) : r * (q + 1) + (xcd - r) * q) + off; }
    const int nig = WGM * nN, gid = wgid / nig, fm = gid * WGM, gsz = (nM - fm) < WGM ? (nM - fm) : WGM;
    pm = fm + ((wgid % nig) % gsz); pn = (wgid % nig) / gsz;
}
struct SchedStatic {
    static constexpr bool BLK = false;
    int nM, nN, G, c; const char* A; const char* B; size_t astep, bstep;
    DI bool next(int i, Unit& u) const { const long L = (long)i * G + c; if (L >= (long)nM * nN) return false; static_tile((int)L, nM, nN, u.pm, u.pn); u.gi = 0; return true; }
    DI const char* abase(const Unit& u) const { return A + (size_t)u.pm * astep; }
    DI const char* bbase(const Unit& u) const { return B + (size_t)u.pn * bstep; }
};
struct SchedStaticBlk : SchedStatic { static constexpr bool BLK = true; };

template <class Epi, class Sched, int NB, bool ALIGN_EPI, bool F8 = false>
DI void gemm_phase(LAS unsigned char* lds, const int K, const Sched& S, const Epi& E) {
    const int tid = threadIdx.x, wid = __builtin_amdgcn_readfirstlane(tid >> 6), lane = tid & 63, wr = wid >> 2, wc = wid & 3, fr = lane & 15, fq = lane >> 4;
    const int nt = K / BK;
    constexpr bool FP6 = F8 && (F6 != 0);
    unsigned voffA[2], voffB[2];
#pragma unroll
    for (int i = 0; i < 2; ++i) { int R, C; stage_rc(tid * 16 + i * 8192, R, C); const int Rb = Epi::PERM ? ((R & ~31) + perm32(R & 31)) : R;
        voffA[i] = (unsigned)(R * K + C) * 2u; voffB[i] = (unsigned)(Rb * K + C) * 2u;
        if constexpr (FP6) { voffA[i] = (unsigned)(((wid & 3) + 4 * i) * 1024 + lane * 16); voffB[i] = voffA[i]; }
        if constexpr (Sched::BLK) { voffA[i] = (unsigned)((wid + 8 * i) * 1024 + lane * 16); voffB[i] = voffA[i]; } }
    const unsigned voffS = (unsigned)((8 + (wid & 3)) * 1024 + lane * 16);
    const size_t kstep = FP6 ? (size_t)12288 : (Sched::BLK ? (size_t)16384 : (size_t)(BK * 2));
    const size_t hstep = FP6 ? (size_t)nt * 12288 : (Sched::BLK ? (size_t)nt * 16384 : (size_t)HALF * K * 2);
    const unsigned ldsw = (unsigned)wid * 1024u;
    const int swz6 = lds_byte(fr, fq * 8), hof6 = fq * 128 + fr * 8;
    const int aoff6 = wr * 4096 + swz6, ahi6 = 8192 + wr * 2048 + hof6, boff6 = wc * 2048 + swz6, bhi6 = 8192 + wc * 1024 + hof6;
    const int aoff = lds_byte(wr * 64 + fr, fq * 8), boff = lds_byte(wc * 32 + fr, fq * 8);
    constexpr int KOFF = 1024;
    const unsigned one_scale = 0x7f7f7f7fu;
#define PG8_SA(b, h) (((b) * 2 + (h)) * HTB)
#define PG8_SB(b, h) ((4 + (b) * 2 + (h)) * HTB)
#define PG8_STAGE(bufoff, gbase, voff) do { if constexpr (FP6) { \
        if ((wid >> 2) != (((bufoff) / HTB) & 1)) { _Pragma("unroll") for (int _i = 0; _i < 2; ++_i) \
            __builtin_amdgcn_global_load_lds((const unsigned*)((const char*)(gbase) + voffA[_i]), (LAS unsigned*)(lds + (bufoff) + (wid & 3) * 1024 + _i * 4096), 16, 0, 0); } \
        else __builtin_amdgcn_global_load_lds((const unsigned*)((const char*)(gbase) + voffS), (LAS unsigned*)(lds + (bufoff) + 8192 + (wid & 3) * 1024), 16, 0, 0); \
    } else { _Pragma("unroll") for (int _i = 0; _i < 2; ++_i) \
        __builtin_amdgcn_global_load_lds((const unsigned*)((const char*)(gbase) + (voff)[_i]), (LAS unsigned*)(lds + (bufoff) + ldsw + _i * 8192), 16, 0, 0); } } while (0)
#define PG8_W64(p) ({ const s16x4 _v = *(const volatile LAS s16x4*)(p); __builtin_shufflevector(_v, _v, 0, 1, 2, 3, -1, -1, -1, -1); })
#define PG8_LDA(dst, b, h) do { if constexpr (FP6) { _Pragma("unroll") for (int m = 0; m < 4; ++m) { dst[m][0] = *(const LAS bf16x8*)(lds + PG8_SA(b, h) + aoff6 + m * 1024); dst[m][1] = PG8_W64(lds + PG8_SA(b, h) + ahi6 + m * 512); } } \
    else { _Pragma("unroll") for (int m = 0; m < 4; ++m) _Pragma("unroll") for (int k = 0; k < 2; ++k) dst[m][k] = *(const LAS bf16x8*)(lds + PG8_SA(b, h) + aoff + m * 2048 + k * KOFF); } } while (0)
#define PG8_LDB(dst, b, h) do { if constexpr (FP6) { _Pragma("unroll") for (int n = 0; n < 2; ++n) { dst[n][0] = *(const LAS bf16x8*)(lds + PG8_SB(b, h) + boff6 + n * 1024); dst[n][1] = PG8_W64(lds + PG8_SB(b, h) + bhi6 + n * 512); } } \
    else { _Pragma("unroll") for (int n = 0; n < 2; ++n) _Pragma("unroll") for (int k = 0; k < 2; ++k) dst[n][k] = *(const LAS bf16x8*)(lds + PG8_SB(b, h) + boff + n * 2048 + k * KOFF); } } while (0)
#define PG8_CAT6(x) __builtin_shufflevector(__builtin_bit_cast(v4i32, (x)[0]), __builtin_bit_cast(v4i32, (x)[1]), 0, 1, 2, 3, 4, 5)
#define PG8_CAT(x) __builtin_bit_cast(v8i32, __builtin_shufflevector((x)[0], (x)[1], 0, 1, 2, 3, 4, 5, 6, 7, 8, 9, 10, 11, 12, 13, 14, 15))
#define PG8_MMA(ai, bj, At, Bt) do { __builtin_amdgcn_s_setprio(1); _Pragma("unroll") for (int m = 0; m < 4; ++m) _Pragma("unroll") for (int n = 0; n < 2; ++n) { \
        if constexpr (F8 && NB == 1 && !F8ASM1) acc[ai][bj][m][n] = __builtin_amdgcn_mfma_scale_f32_16x16x128_f8f6f4(PG8_CAT(Bt[n]), PG8_CAT(At[m]), acc[ai][bj][m][n], 0, 0, 0, 0x7f7f7f7f, 0, 0x7f7f7f7f); \
        else if constexpr (F8 && F6 != 0) { asm volatile("s_nop 1\n\tv_mfma_scale_f32_16x16x128_f8f6f4 %0, %1, %2, %0, %3, %3 op_sel_hi:[0,0,0] cbsz:2 blgp:2" : "+v"(acc[ai][bj][m][n]) : "v"(PG8_CAT6(Bt[n])), "v"(PG8_CAT6(At[m])), "v"(one_scale)); } \
        else if constexpr (F8) { asm volatile("s_nop 1\n\tv_mfma_scale_f32_16x16x128_f8f6f4 %0, %1, %2, %0, %3, %3 op_sel_hi:[0,0,0]" : "+v"(acc[ai][bj][m][n]) : "v"(PG8_CAT(Bt[n])), "v"(PG8_CAT(At[m])), "v"(one_scale)); } \
        else { _Pragma("unroll") for (int k = 0; k < 2; ++k) acc[ai][bj][m][n] = __builtin_amdgcn_mfma_f32_16x16x32_bf16(Bt[n][k], At[m][k], acc[ai][bj][m][n], 0, 0, 0); } } \
        __builtin_amdgcn_s_setprio(0); } while (0)
#define PG8_WAIT_V(n) asm volatile("s_waitcnt vmcnt(" #n ")" ::: "memory")
#define PG8_WAIT_L(n) asm volatile("s_waitcnt lgkmcnt(" #n ")" ::: "memory")
#define PG8_BAR __builtin_amdgcn_s_barrier()
#define PG8_SCHED __builtin_amdgcn_sched_barrier(0)
#define PG8_WAIT_LA() do { if constexpr (FP6) PG8_WAIT_V(4); else PG8_WAIT_V(6); } while (0)
#define PG8_WAIT_LB() do { if constexpr (FP6) PG8_WAIT_V(1); else PG8_WAIT_V(2); } while (0)
#define PG8_WAIT_MAIN() do { if constexpr (FP6) PG8_WAIT_V(6); else PG8_WAIT_V(8); } while (0)
    Unit cur, nxt; int ui = 0;
    if (!S.next(0, cur)) return;
    f32x4 acc[2][NB][4][2];
    f32x4 yac[2][4][2];
#pragma unroll
    for (int a = 0; a < 2; ++a)
#pragma unroll
        for (int m = 0; m < 4; ++m)
#pragma unroll
            for (int n = 0; n < 2; ++n) { yac[a][m][n] = (f32x4){0.f, 0.f, 0.f, 0.f};
#pragma unroll
                for (int b = 0; b < NB; ++b) acc[a][b][m][n] = (f32x4){0.f, 0.f, 0.f, 0.f}; }
    bf16x8 At[4][2], B0[2][2], B1[2][2];
    const char* cA = S.abase(cur); const char* cB = S.bbase(cur);
    if constexpr (NB == 2) {
        PG8_STAGE(PG8_SB(0, 0), cB, voffB); PG8_STAGE(PG8_SB(0, 1), cB + hstep, voffB); PG8_STAGE(PG8_SA(0, 0), cA, voffA); PG8_STAGE(PG8_SA(0, 1), cA + hstep, voffA);
        if (wr == 1) PG8_BAR;
        if constexpr (FP6) PG8_WAIT_V(1); else PG8_WAIT_V(2);
        PG8_BAR;
        PG8_STAGE(PG8_SB(1, 0), cB + kstep, voffB); PG8_STAGE(PG8_SA(1, 0), cA + kstep, voffA); PG8_STAGE(PG8_SB(1, 1), cB + hstep + kstep, voffB);
        if constexpr (FP6) PG8_WAIT_V(4); else PG8_WAIT_V(6);
        PG8_BAR;
    } else {
        PG8_STAGE(PG8_SB(0, 0), cB, voffB); PG8_STAGE(PG8_SA(0, 0), cA, voffA); PG8_STAGE(PG8_SA(0, 1), cA + hstep, voffA);
        if (wr == 1) PG8_BAR;
        PG8_WAIT_V(2); PG8_BAR;
        PG8_STAGE(PG8_SB(1, 0), cB + kstep, voffB); PG8_STAGE(PG8_SA(1, 0), cA + kstep, voffA);
        PG8_WAIT_V(4); PG8_BAR;
    }
    for (;;) {
        const bool has_next = S.next(ui + 1, nxt);
        const char* nA = has_next ? S.abase(nxt) : cA; const char* nB = has_next ? S.bbase(nxt) : cB;
        for (int t = 0; t < nt; t += 2) {
            if constexpr (Epi::GATED) { if (t != 0 && (t & 15) == 0) { E.flush(acc, yac, cur, (t >> 4) - 1, wr, wc, fr, fq);
#pragma unroll
                for (int a = 0; a < 2; ++a)
#pragma unroll
                    for (int m = 0; m < 4; ++m)
#pragma unroll
                        for (int n = 0; n < 2; ++n) acc[a][0][m][n] = (f32x4){0.f, 0.f, 0.f, 0.f}; } }
            const bool last = (t == nt - 2);
            const char* a1 = cA + (size_t)(t + 1) * kstep;
            const char* a2 = last ? nA : cA + (size_t)(t + 2) * kstep; const char* b2 = last ? nB : cB + (size_t)(t + 2) * kstep;
            const char* a3 = a2 + kstep; const char* b3 = b2 + kstep;
            if constexpr (NB == 2 && STAGE_LATE != 0) {
            PG8_LDB(B0, 0, 0); PG8_LDB(B1, 0, 1); PG8_SCHED; PG8_LDA(At, 0, 0);
            PG8_WAIT_LA(); PG8_WAIT_L(0); PG8_BAR; PG8_MMA(0, 0, At, B0); PG8_MMA(0, 1, At, B1); PG8_STAGE(PG8_SA(1, 1), a1 + hstep, voffA); PG8_BAR; PG8_SCHED;
            PG8_LDA(At, 0, 1);
            PG8_WAIT_LB(); PG8_WAIT_L(0); PG8_BAR; PG8_MMA(1, 0, At, B0); PG8_MMA(1, 1, At, B1); PG8_STAGE(PG8_SB(0, 0), b2, voffB); PG8_STAGE(PG8_SB(0, 1), b2 + hstep, voffB); PG8_STAGE(PG8_SA(0, 0), a2, voffA); PG8_BAR; PG8_SCHED;
            PG8_LDB(B0, 1, 0); PG8_LDB(B1, 1, 1); PG8_SCHED; PG8_LDA(At, 1, 0);
            PG8_WAIT_LA(); PG8_WAIT_L(0); PG8_BAR; PG8_MMA(0, 0, At, B0); PG8_MMA(0, 1, At, B1); PG8_STAGE(PG8_SA(0, 1), a2 + hstep, voffA); PG8_BAR; PG8_SCHED;
            PG8_LDA(At, 1, 1);
            PG8_WAIT_LB(); PG8_WAIT_L(0); PG8_BAR; PG8_MMA(1, 0, At, B0); PG8_MMA(1, 1, At, B1); PG8_STAGE(PG8_SB(1, 0), b3, voffB); PG8_STAGE(PG8_SB(1, 1), b3 + hstep, voffB); PG8_STAGE(PG8_SA(1, 0), a3, voffA); PG8_BAR; PG8_SCHED;
            } else if constexpr (NB == 2) {
            PG8_LDB(B0, 0, 0); PG8_LDB(B1, 0, 1); PG8_SCHED; PG8_LDA(At, 0, 0); PG8_STAGE(PG8_SA(1, 1), a1 + hstep, voffA);
            PG8_WAIT_MAIN(); PG8_WAIT_L(0); PG8_BAR; PG8_MMA(0, 0, At, B0); PG8_MMA(0, 1, At, B1); PG8_BAR; PG8_SCHED;
            PG8_LDA(At, 0, 1); PG8_STAGE(PG8_SB(0, 0), b2, voffB); PG8_STAGE(PG8_SB(0, 1), b2 + hstep, voffB); PG8_STAGE(PG8_SA(0, 0), a2, voffA);
            PG8_WAIT_MAIN(); PG8_WAIT_L(0); PG8_BAR; PG8_MMA(1, 0, At, B0); PG8_MMA(1, 1, At, B1); PG8_BAR; PG8_SCHED;
            PG8_LDB(B0, 1, 0); PG8_LDB(B1, 1, 1); PG8_SCHED; PG8_LDA(At, 1, 0); PG8_STAGE(PG8_SA(0, 1), a2 + hstep, voffA);
            PG8_WAIT_MAIN(); PG8_WAIT_L(0); PG8_BAR; PG8_MMA(0, 0, At, B0); PG8_MMA(0, 1, At, B1); PG8_BAR; PG8_SCHED;
            PG8_LDA(At, 1, 1); PG8_STAGE(PG8_SB(1, 0), b3, voffB); PG8_STAGE(PG8_SB(1, 1), b3 + hstep, voffB); PG8_STAGE(PG8_SA(1, 0), a3, voffA);
            PG8_WAIT_MAIN(); PG8_WAIT_L(0); PG8_BAR; PG8_MMA(1, 0, At, B0); PG8_MMA(1, 1, At, B1); PG8_BAR; PG8_SCHED;
            } else {
            PG8_LDB(B0, 0, 0); PG8_SCHED; PG8_LDA(At, 0, 0); PG8_STAGE(PG8_SA(1, 1), a1 + hstep, voffA);
            PG8_WAIT_V(6); PG8_WAIT_L(0); PG8_BAR; PG8_MMA(0, 0, At, B0); PG8_BAR; PG8_SCHED;
            PG8_LDA(At, 0, 1); PG8_STAGE(PG8_SB(0, 0), b2, voffB); PG8_STAGE(PG8_SA(0, 0), a2, voffA);
            PG8_WAIT_V(6); PG8_WAIT_L(0); PG8_BAR; PG8_MMA(1, 0, At, B0); PG8_BAR; PG8_SCHED;
            PG8_LDB(B0, 1, 0); PG8_SCHED; PG8_LDA(At, 1, 0); PG8_STAGE(PG8_SA(0, 1), a2 + hstep, voffA);
            PG8_WAIT_V(6); PG8_WAIT_L(0); PG8_BAR; PG8_MMA(0, 0, At, B0); PG8_BAR; PG8_SCHED;
            PG8_LDA(At, 1, 1); PG8_STAGE(PG8_SB(1, 0), b3, voffB); PG8_STAGE(PG8_SA(1, 0), a3, voffA);
            PG8_WAIT_V(6); PG8_WAIT_L(0); PG8_BAR; PG8_MMA(1, 0, At, B0); PG8_BAR; PG8_SCHED;
            }
        }
        if constexpr (F8) {
            asm volatile("s_nop 15\n\ts_nop 15" ::: "memory");
#pragma unroll
            for (int a = 0; a < 2; ++a)
#pragma unroll
                for (int b = 0; b < NB; ++b)
#pragma unroll
                    for (int m = 0; m < 4; ++m)
#pragma unroll
                        for (int n = 0; n < 2; ++n) asm volatile("" : "+v"(acc[a][b][m][n]));
        }
        if constexpr (ALIGN_EPI) { if (wr == 0) PG8_BAR; }
        if constexpr (Epi::GATED) { E.finish(acc, yac, cur, wr, wc, fr, fq);
#pragma unroll
            for (int a = 0; a < 2; ++a)
#pragma unroll
                for (int m = 0; m < 4; ++m)
#pragma unroll
                    for (int n = 0; n < 2; ++n) yac[a][m][n] = (f32x4){0.f, 0.f, 0.f, 0.f};
        } else { E(acc, cur, wr, wc, fr, fq); }
        if (!has_next) break;
#pragma unroll
        for (int a = 0; a < 2; ++a)
#pragma unroll
            for (int b = 0; b < NB; ++b)
#pragma unroll
                for (int m = 0; m < 4; ++m)
#pragma unroll
                    for (int n = 0; n < 2; ++n) acc[a][b][m][n] = (f32x4){0.f, 0.f, 0.f, 0.f};
        cur = nxt; cA = nA; cB = nB; ++ui;
        if constexpr (ALIGN_EPI) { if (wr == 1) PG8_BAR; }
    }
    PG8_WAIT_V(0);
    if constexpr (!ALIGN_EPI) { if (wr == 0) PG8_BAR; }
    PG8_BAR;
#undef PG8_SA
#undef PG8_SB
#undef PG8_STAGE
#undef PG8_LDA
#undef PG8_LDB
#undef PG8_MMA
#undef PG8_CAT
#undef PG8_WAIT_V
#undef PG8_WAIT_L
#undef PG8_BAR
#undef PG8_SCHED
#undef PG8_WAIT_MAIN
}
}

#define XB_TMO      128
#define XB_XCNT(j)  (256  + 64 * (j))
#define XB_XSUB(j)  (1280 + 64 * (j))
#define XB_XGEN(j)  (2304 + 64 * (j))
#define XB_TOP      3328
#define XB_TOPGEN   3392
#define XCD_BAR_WORDS 3456
#define XB_SPIN_CAP (1u << 18)
DI unsigned xb_ld(unsigned* p)              { return __hip_atomic_load(p, __ATOMIC_RELAXED, __HIP_MEMORY_SCOPE_AGENT); }
DI unsigned xb_add(unsigned* p, unsigned v) { return __hip_atomic_fetch_add(p, v, __ATOMIC_RELAXED, __HIP_MEMORY_SCOPE_AGENT); }
DI unsigned xb_xcc_id() { return (unsigned)__builtin_amdgcn_s_getreg((3 << 11) | 20) & 0xFu; }
#define XB_SPIN(cond, bar) do { unsigned _sp = 0; while (cond) { __builtin_amdgcn_s_sleep(1); \
    if ((++_sp & 255u) == 0u) { if (xb_ld(&(bar)[XB_TMO])) break; if (_sp > XB_SPIN_CAP) { atomicAdd(&(bar)[XB_TMO], 1u); break; } } } } while (0)
struct XcdBarrier { unsigned* bar; unsigned x; volatile LAS unsigned* st; };
DI XcdBarrier xcd_barrier_post(unsigned* bar, volatile LAS unsigned* st) {
    XcdBarrier b; b.bar = bar; b.x = xb_xcc_id(); b.st = st;
    if (threadIdx.x == 0) (void)xb_add(&bar[XB_XCNT(b.x)], 1u);
    return b;
}
DI void xcd_barrier_complete(unsigned* bar, unsigned x, unsigned& nloc, unsigned& nx) {
    const unsigned G = gridDim.x * gridDim.y * gridDim.z;
    unsigned sum, cnt, mine, sp = 0u;
    for (;;) {
        sum = 0u; cnt = 0u; mine = 0u;
#pragma unroll
        for (unsigned j = 0; j < 16; ++j) { const unsigned c = xb_ld(&bar[XB_XCNT(j)]); sum += c; cnt += (c > 0u) ? 1u : 0u; mine = (j == x) ? c : mine; }
        if (sum == G) break;
        __builtin_amdgcn_s_sleep(1);
        if ((++sp & 255u) == 0u) { if (xb_ld(&bar[XB_TMO])) break; if (sp > XB_SPIN_CAP) { atomicAdd(&bar[XB_TMO], 1u); break; } }
    }
    nloc = mine > 0u ? mine : 1u; nx = cnt > 0u ? cnt : 1u;
}
DI void xcd_barrier(const XcdBarrier& b) {
    asm volatile("s_waitcnt vmcnt(0)" ::: "memory");
    __syncthreads();
    if (threadIdx.x == 0) {
        unsigned* bar = b.bar;
        __builtin_amdgcn_s_waitcnt(0);
        unsigned nloc = b.st[0], nx = b.st[1];
        if (nloc == 0u) { xcd_barrier_complete(bar, b.x, nloc, nx); b.st[0] = nloc; b.st[1] = nx; }
        const unsigned old = xb_add(&bar[XB_XSUB(b.x)], 1u);
        const unsigned gen = old / nloc;
        if (old + 1u == (gen + 1u) * nloc) {
            __builtin_amdgcn_fence(__ATOMIC_RELEASE, "agent");
            asm volatile("s_waitcnt vmcnt(0)" ::: "memory");
            const unsigned og = xb_add(&bar[XB_TOP], 1u);
            const unsigned tg = og / nx;
            if (og + 1u == (tg + 1u) * nx) xb_add(&bar[XB_TOPGEN], 1u);
            else XB_SPIN(xb_ld(&bar[XB_TOPGEN]) == tg, bar);
            __builtin_amdgcn_fence(__ATOMIC_ACQUIRE, "agent");
            xb_add(&bar[XB_XGEN(b.x)], 1u);
            asm volatile("s_waitcnt vmcnt(0)" ::: "memory");
        } else {
            XB_SPIN(xb_ld(&bar[XB_XGEN(b.x)]) == gen, bar);
            __builtin_amdgcn_fence(__ATOMIC_ACQUIRE, "agent");
            asm volatile("s_waitcnt vmcnt(0)" ::: "memory");
        }
    }
    __syncthreads();
}

struct Frame {
    LAS unsigned char* lds;
    int tid, lane, wave, G, wg;
    float* out; unsigned char* ws;
};
template <class T> DI T* wsp(const Frame& F, size_t off) { return (T*)(F.ws + off); }

struct EpiH {
    static constexpr bool PERM = true, GATED = false;
    bf16* H; bf16* MK; bf16* MVT;
    DI void operator()(const f32x4 (&acc)[2][2][4][2], const pg8::Unit& u, int wr, int wc, int fr, int fq) const {
        bf16* base = H; size_t ldc = NH; int act = 0;
        if (u.gi == 0) { const int pn = u.pn; act = ((pn >= 4 && pn < 8) || (pn >= 16 && pn < 20)) ? 1 : 0; }
        else { const int lx = (u.gi - 1) >> 1, w = (u.gi - 1) & 1; if (w == 0) { base = MK + (size_t)lx * 512 * 1024; ldc = 1024; } else { base = MVT + (size_t)lx * 1024 * 512; ldc = 512; } }
        const int row0 = u.pm * 256 + wr * 64 + fr, col0 = u.pn * 256 + wc * 32 + 8 * fq;
#pragma unroll
        for (int ai = 0; ai < 2; ++ai)
#pragma unroll
            for (int m = 0; m < 4; ++m) { bf16* rowp = base + (size_t)(row0 + ai * 128 + m * 16) * ldc + col0;
#pragma unroll
                for (int bj = 0; bj < 2; ++bj) { f32x4 v0 = acc[ai][bj][m][0], v1 = acc[ai][bj][m][1];
                    if (act != 0) {
#pragma unroll
                        for (int j = 0; j < 4; ++j) { const float s0 = fast_sigmoid(v0[j]), s1 = fast_sigmoid(v1[j]); v0[j] = (act == 1) ? v0[j] * s0 : s0; v1[j] = (act == 1) ? v1[j] * s1 : s1; } }
                    u32x4 w; w.x = cvt_pk_bf16(v0[0], v0[1]); w.y = cvt_pk_bf16(v0[2], v0[3]); w.z = cvt_pk_bf16(v1[0], v1[1]); w.w = cvt_pk_bf16(v1[2], v1[3]);
                    *(u32x4*)(rowp + bj * 128) = w; } }
    }
};
template <int NB> struct EpiMG {
    static constexpr bool PERM = true, GATED = false;
    bf16* H;
    DI void operator()(const f32x4 (&acc)[2][NB][4][2], const pg8::Unit& u, int wr, int wc, int fr, int fq) const {
        const int colu = C_F8 + u.pn * (128 * NB);
        const int act = (colu >= C_MG) ? 2 : (((colu >= C_SG && colu < C_XQ) || colu >= C_XG) ? 1 : 0);
        const int row0 = u.pm * 256 + wr * 64 + fr, col0 = colu + wc * 32 + 8 * fq;
#pragma unroll
        for (int ai = 0; ai < 2; ++ai)
#pragma unroll
            for (int m = 0; m < 4; ++m) { bf16* rowp = H + (size_t)(row0 + ai * 128 + m * 16) * NH + col0;
#pragma unroll
                for (int bj = 0; bj < NB; ++bj) { f32x4 v0 = acc[ai][bj][m][0], v1 = acc[ai][bj][m][1];
                    if (act == 2) {
#pragma unroll
                        for (int j = 0; j < 4; ++j) { v0[j] = __builtin_amdgcn_rcpf(1.0f + __builtin_amdgcn_exp2f(v0[j] * (-1.44269504089f * MG_DESCALE)));
                            v1[j] = __builtin_amdgcn_rcpf(1.0f + __builtin_amdgcn_exp2f(v1[j] * (-1.44269504089f * MG_DESCALE))); }
                    } else if (act == 1) {
#pragma unroll
                        for (int j = 0; j < 4; ++j) { const float a0 = v0[j] * MG_DESCALE, a1 = v1[j] * MG_DESCALE; v0[j] = a0 * fast_sigmoid(a0); v1[j] = a1 * fast_sigmoid(a1); }
                    } else {
#pragma unroll
                        for (int j = 0; j < 4; ++j) { v0[j] *= MG_DESCALE; v1[j] *= MG_DESCALE; } }
                    u32x4 w; w.x = cvt_pk_bf16(v0[0], v0[1]); w.y = cvt_pk_bf16(v0[2], v0[3]); w.z = cvt_pk_bf16(v1[0], v1[1]); w.w = cvt_pk_bf16(v1[2], v1[3]);
                    *(u32x4*)(rowp + bj * 128) = w; } }
    }
};
struct EpiRes {
    static constexpr bool PERM = true, GATED = false;
    const float* __restrict__ res; float* __restrict__ out;
    DI void operator()(const f32x4 (&acc)[2][2][4][2], const pg8::Unit& u, int wr, int wc, int fr, int fq) const {
        const int row0 = u.pm * 256 + wr * 64 + fr, col0 = u.pn * 256 + wc * 32 + 8 * fq;
#pragma unroll
        for (int ai = 0; ai < 2; ++ai)
#pragma unroll
            for (int m = 0; m < 4; ++m) { const size_t ro = (size_t)(row0 + ai * 128 + m * 16) * DM + col0;
#pragma unroll
                for (int bj = 0; bj < 2; ++bj)
#pragma unroll
                    for (int n = 0; n < 2; ++n) { const size_t o = ro + bj * 128 + n * 4; const f32x4 r = *(const f32x4*)(res + o); *(f32x4*)(out + o) = r * DN_ALPHA + acc[ai][bj][m][n]; } }
    }
};
struct EpiGate {
    static constexpr bool PERM = true, GATED = true;
    const bf16* H; bf16* Y;
    DI void flush(const f32x4 (&acc)[2][1][4][2], f32x4 (&y)[2][4][2], const pg8::Unit& u, int bi, int wr, int wc, int fr, int fq) const {
        const int row0 = u.pm * 256 + wr * 64 + fr, col0 = u.pn * 128 + wc * 32 + 8 * fq;
#pragma unroll
        for (int ai = 0; ai < 2; ++ai)
#pragma unroll
            for (int m = 0; m < 4; ++m) { const u32x4 gw = *(const u32x4*)(H + (size_t)(row0 + ai * 128 + m * 16) * NH + C_MG + bi * DM + col0);
                float g[8]; unpack8(gw, g);
#pragma unroll
                for (int j = 0; j < 4; ++j) { y[ai][m][0][j] += g[j] * acc[ai][0][m][0][j]; y[ai][m][1][j] += g[4 + j] * acc[ai][0][m][1][j]; }
                if (m == 1 || m == 3) __builtin_amdgcn_sched_barrier(0); }
    }
    DI void finish(const f32x4 (&acc)[2][1][4][2], f32x4 (&y)[2][4][2], const pg8::Unit& u, int wr, int wc, int fr, int fq) const {
        flush(acc, y, u, 3, wr, wc, fr, fq);
        const int row0 = u.pm * 256 + wr * 64 + fr, col0 = u.pn * 128 + wc * 32 + 8 * fq;
#pragma unroll
        for (int ai = 0; ai < 2; ++ai)
#pragma unroll
            for (int m = 0; m < 4; ++m) { const f32x4 v0 = y[ai][m][0], v1 = y[ai][m][1];
                u32x4 w; w.x = cvt_pk_bf16(v0[0], v0[1]); w.y = cvt_pk_bf16(v0[2], v0[3]); w.z = cvt_pk_bf16(v1[0], v1[1]); w.w = cvt_pk_bf16(v1[2], v1[3]);
                if (BLK_OUT) *(u32x4*)((char*)Y + pg8::blk_off<false>(row0 + ai * 128 + m * 16, col0, DM / 64)) = w; else *(u32x4*)(Y + (size_t)(row0 + ai * 128 + m * 16) * DM + col0) = w; }
    }
};
struct SchedInProj {
    static constexpr bool BLK = false;
    int G, c, n_extra; const char *XB, *WT, *MEMB, *WKV;
    static constexpr int NM = 32, NN = 21, NU = NM * NN;
    static constexpr size_t TSTEP = (size_t)256 * 4096 * 2;
    DI bool next(int i, pg8::Unit& u) const {
        const long L = (long)i * G + c;
        if (L < NU) { pg8::static_tile((int)L, NM, NN, u.pm, u.pn); if (u.pn == 20) u.pn = 101; u.gi = 0; return true; }
        const int e = (int)(L - NU); if (e >= n_extra) return false;
        const int lx = e >> 4, r = e & 15;
        if (r < 8) { u.pm = r >> 2; u.pn = r & 3; u.gi = 1 + 2 * lx; } else { u.pm = (r - 8) >> 1; u.pn = (r - 8) & 1; u.gi = 2 + 2 * lx; }
        return true;
    }
    DI const char* abase(const pg8::Unit& u) const {
        if (u.gi == 0) return XB + (size_t)u.pm * TSTEP;
        const int lx = (u.gi - 1) >> 1, w = (u.gi - 1) & 1;
        return w == 0 ? MEMB + (size_t)u.pm * TSTEP : WKV + (size_t)lx * 2048 * 4096 * 2 + (size_t)(1024 + u.pm * 256) * 4096 * 2;
    }
    DI const char* bbase(const pg8::Unit& u) const {
        if (u.gi == 0) return WT + (size_t)u.pn * TSTEP;
        const int lx = (u.gi - 1) >> 1, w = (u.gi - 1) & 1;
        return w == 0 ? WKV + (size_t)lx * 2048 * 4096 * 2 + (size_t)u.pn * TSTEP : MEMB + (size_t)u.pn * TSTEP;
    }
};

DI int win_src_col(int n) { return n < 5120 ? n : (n < C_LR ? n + 16 : (n < C_LR + 16 ? n - C_LR + 5120 : -1)); }
template <bool WIN, int LAY = 0> DI void transpose_item(const float* W, size_t ldw, bf16* WT, size_t ldt, int k0, int n0, int kd0, LAS float* scr, int lane) {
    const int kr = lane >> 3, nc = lane & 7; int sc = n0 + 4 * nc; if (WIN) sc = win_src_col(sc);
    const float* src = W + (size_t)(k0 + kr) * ldw + (sc < 0 ? 0 : sc);
    f32x4 v[8];
#pragma unroll
    for (int i = 0; i < 8; ++i) v[i] = *(const f32x4*)(src + (size_t)(8 * i) * ldw);
#pragma unroll
    for (int i = 0; i < 8; ++i) { LAS float* d = scr + (8 * i + kr) * 33 + 4 * nc; const f32x4 x = (sc < 0) ? (f32x4){0.f, 0.f, 0.f, 0.f} : v[i]; d[0] = x.x; d[1] = x.y; d[2] = x.z; d[3] = x.w; }
    LDS_WAIT();
    const int c = lane & 7;
#pragma unroll
    for (int j = 0; j < 4; ++j) { const int n = (lane >> 3) + 8 * j; const LAS float* s = scr + (8 * c) * 33 + n;
        u32x4 o; o.x = pk2(s[0 * 33], s[1 * 33]); o.y = pk2(s[2 * 33], s[3 * 33]); o.z = pk2(s[4 * 33], s[5 * 33]); o.w = pk2(s[6 * 33], s[7 * 33]);
        if constexpr (LAY == 0) *(u32x4*)(WT + (size_t)(n0 + n) * ldt + kd0 + 8 * c) = o; else *(u32x4*)((char*)WT + pg8::blk_off<LAY == 2>(n0 + n, kd0 + 8 * c, (int)(ldt / 64))) = o; }
    LDS_WAIT();
}
DI void transpose_item_f8(const float* W, size_t ldw, unsigned char* WT, size_t ldt, int k0, int n0, LAS float* scr, int lane) {
    const int kr = lane >> 3, nc = lane & 7; const int sc = win_src_col(n0 + 4 * nc);
    const float* src = W + (size_t)(k0 + kr) * ldw + sc;
#pragma unroll
    for (int h = 0; h < 2; ++h) {
        f32x4 v[8];
#pragma unroll
        for (int i = 0; i < 8; ++i) v[i] = *(const f32x4*)(src + (size_t)(64 * h + 8 * i) * ldw);
#pragma unroll
        for (int i = 0; i < 8; ++i) { LAS float* d = scr + (64 * h + 8 * i + kr) * 33 + 4 * nc; d[0] = v[i].x * W8_SCALE; d[1] = v[i].y * W8_SCALE; d[2] = v[i].z * W8_SCALE; d[3] = v[i].w * W8_SCALE; }
    }
    LDS_WAIT();
#if F6
    { const int q = lane >> 4;
#pragma unroll
      for (int j = 0; j < 2; ++j) { const int n = (lane & 15) + 16 * j; const LAS float* sp = scr + (32 * q) * 33 + n; float f[32];
#pragma unroll
          for (int e = 0; e < 32; ++e) f[e] = sp[e * 33];
          u32x4 lo, hi; pk32_fp6(f, lo, hi); const int R = n0 - C_F8 + n; size_t ol, oh; pg8::f6_off((R & ~31) + pg8::invperm32(R & 31), k0 >> 7, q, ol, oh);
          *(u32x4*)(WT + ol) = lo; u32x2 h2; h2.x = hi.x; h2.y = hi.y; *(u32x2*)(WT + oh) = h2; } }
#else
    const int c = lane & 7;
#pragma unroll
    for (int j = 0; j < 4; ++j) { const int n = (lane >> 3) + 8 * j; const LAS float* s = scr + (16 * c) * 33 + n;
        u32x4 o; o.x = pk4_fp8(s[0 * 33], s[1 * 33], s[2 * 33], s[3 * 33]); o.y = pk4_fp8(s[4 * 33], s[5 * 33], s[6 * 33], s[7 * 33]);
        o.z = pk4_fp8(s[8 * 33], s[9 * 33], s[10 * 33], s[11 * 33]); o.w = pk4_fp8(s[12 * 33], s[13 * 33], s[14 * 33], s[15 * 33]);
        *(u32x4*)(WT + (size_t)(n0 - C_F8 + n) * ldt + k0 + 16 * c) = o; }
#endif
    LDS_WAIT();
}
DI void prologue(const Frame& F, const float* x, const float* mem, const int* pos, const float* w_in, const float* w_pool, const float* w_mem_kv, const float* w_branch, const float* w_out) {
    LAS float* scr = (LAS float*)(F.lds + F.wave * 17408);
    const int gw = F.wg * NWAVES + F.wave, NGW = F.G * NWAVES, lane = F.lane;
    constexpr int I_B16 = 64 * ((NH - N_F8) / 32), I_F8 = 32 * (N_F8 / 32), I_KV = 64 * 64, I_BR = 16 * 128, I_OUT = 64 * 128, I_PL = 4 * 8;
    constexpr int NITEMS = 2 * I_B16 + 2 * I_F8 + 2 * I_KV + 8 * I_BR + 2 * I_OUT + 8 * I_PL;
    LAS unsigned* qc = (LAS unsigned*)(F.lds + MISC_OFF) + 16;
    (void)gw;
    int q = 0; if (lane == 0) q = (int)__hip_atomic_fetch_add(qc, 1u, __ATOMIC_RELAXED, __HIP_MEMORY_SCOPE_WORKGROUP); q = __builtin_amdgcn_readfirstlane(q);
    for (;;) {
        const int it = (q >> 3) * NGW + F.wg * NWAVES + (q & 7); if (it >= NITEMS) break;
        if (lane == 0) q = (int)__hip_atomic_fetch_add(qc, 1u, __ATOMIC_RELAXED, __HIP_MEMORY_SCOPE_WORKGROUP);
        q = __builtin_amdgcn_readfirstlane(q);
        int r = it;
        if (r < 2 * I_F8) { const int l = r / I_F8; r -= l * I_F8; const int nb = C_F8 / 32 + (PRO_NFAST ? r % (N_F8 / 32) : (r >> 5)), kb = PRO_NFAST ? r / (N_F8 / 32) : (r & 31);
            transpose_item_f8(w_in + (size_t)l * 4096 * D_IN, D_IN, wsp<unsigned char>(F, WS_W8) + (size_t)l * W8_LAYER, 4096, kb * 128, nb * 32, scr, lane); continue; }
        r -= 2 * I_F8;
        if (r < 2 * I_B16) { const int l = r / I_B16; r -= l * I_B16; int nb = r >> 6; const int kb = r & 63; if (nb >= C_F8 / 32) nb += N_F8 / 32;
            transpose_item<true>(w_in + (size_t)l * 4096 * D_IN, D_IN, wsp<bf16>(F, WS_WINT) + (size_t)l * NH * 4096, 4096, kb * 64, nb * 32, kb * 64, scr, lane); continue; }
        r -= 2 * I_B16;
        if (r < 2 * I_KV) { const int l = r / I_KV; r -= l * I_KV; const int nb = r >> 6, kb = r & 63;
            transpose_item<false>(w_mem_kv + (size_t)l * 4096 * 2048, 2048, wsp<bf16>(F, WS_WMKVT) + (size_t)l * 2048 * 4096, 4096, kb * 64, nb * 32, kb * 64, scr, lane); continue; }
        r -= 2 * I_KV;
        if (r < 8 * I_BR) { const int lb = r / I_BR; r -= lb * I_BR; const int l = lb >> 2, bi = lb & 3; const int nb = PRO_NFAST ? (r & 127) : (r >> 4), kb = PRO_NFAST ? (r >> 7) : (r & 15);
            transpose_item<false, BLK_GATE ? 2 : 0>(w_branch + (size_t)lb * 1024 * 4096, 4096, wsp<bf16>(F, WS_WBRT) + (size_t)l * 4096 * 4096, 4096, kb * 64, nb * 32, bi * 1024 + kb * 64, scr, lane); continue; }
        r -= 8 * I_BR;
        if (r < 2 * I_OUT) { const int l = r / I_OUT; r -= l * I_OUT; const int nb = PRO_NFAST ? (r & 127) : (r >> 6), kb = PRO_NFAST ? (r >> 7) : (r & 63);
            transpose_item<false, BLK_OUT ? 2 : 0>(w_out + (size_t)l * 4096 * 4096, 4096, wsp<bf16>(F, WS_WOUTT) + (size_t)l * 4096 * 4096, 4096, kb * 64, nb * 32, kb * 64, scr, lane); continue; }
        r -= 2 * I_OUT;
        { const int lg = r / I_PL; r -= lg * I_PL; const int nb = r >> 2, kb = r & 3;
            transpose_item<false>(w_pool + (size_t)lg * 256 * 256, 256, wsp<bf16>(F, WS_WPOOLT) + (size_t)lg * 256 * 256, 256, kb * 64, nb * 32, kb * 64, scr, lane); }
    }
    const size_t gt = (size_t)F.wg * NTHR + F.tid, GT = (size_t)F.G * NTHR;
    { const f32x4* xs = (const f32x4*)x; u32x4* xd = wsp<u32x4>(F, WS_XB);
      u32x2* x8 = wsp<u32x2>(F, WS_X8);
#if F6
      (void)x8; (void)xd;
      { LAS unsigned char* lw = (LAS unsigned char*)scr; u32x2* xb2 = wsp<u32x2>(F, WS_XB);
        for (size_t g0 = (size_t)gw * 64; g0 < (size_t)MTOK * DM / 32; g0 += (size_t)NGW * 64) {
            const f32x4* src = xs + g0 * 8;
            f32x4 v[8];
#pragma unroll
            for (int t = 0; t < 8; ++t) v[t] = src[64 * t + lane];
#pragma unroll
            for (int t = 0; t < 8; ++t) { u32x2 w; w.x = pk2(v[t].x, v[t].y); w.y = pk2(v[t].z, v[t].w); xb2[g0 * 8 + 64 * t + lane] = w;
                *(LAS f32x4*)(lw + ((lane >> 3) + 8 * t) * 144 + (lane & 7) * 16) = v[t] * X8_SCALE; }
            LDS_WAIT();
            float f[32];
#pragma unroll
            for (int t = 0; t < 8; ++t) { const f32x4 qv = *(const LAS f32x4*)(lw + lane * 144 + 16 * t); f[4 * t] = qv.x; f[4 * t + 1] = qv.y; f[4 * t + 2] = qv.z; f[4 * t + 3] = qv.w; }
            const size_t gi = g0 + lane; u32x4 lo, hi; pk32_fp6(f, lo, hi); size_t ol, oh; pg8::f6_off((int)(gi >> 7), (int)((gi >> 2) & 31), (int)(gi & 3), ol, oh);
            *(u32x4*)(wsp<unsigned char>(F, WS_X8) + ol) = lo; u32x2 h2; h2.x = hi.x; h2.y = hi.y; *(u32x2*)(wsp<unsigned char>(F, WS_X8) + oh) = h2;
            LDS_WAIT();
        } }
#else
      for (size_t i = gt; i < (size_t)MTOK * DM / 8; i += GT) { const f32x4 a = xs[2 * i], b = xs[2 * i + 1]; u32x4 o; o.x = pk2(a.x, a.y); o.y = pk2(a.z, a.w); o.z = pk2(b.x, b.y); o.w = pk2(b.z, b.w); xd[i] = o;
          u32x2 q; q.x = pk4_fp8(a.x * X8_SCALE, a.y * X8_SCALE, a.z * X8_SCALE, a.w * X8_SCALE); q.y = pk4_fp8(b.x * X8_SCALE, b.y * X8_SCALE, b.z * X8_SCALE, b.w * X8_SCALE); x8[i] = q; }
#endif
      const f32x4* ms = (const f32x4*)mem; u32x4* md = wsp<u32x4>(F, WS_MEMB);
      for (size_t i = gt; i < (size_t)BATCH * MEMLEN * DM / 8; i += GT) { const f32x4 a = ms[2 * i], b = ms[2 * i + 1]; u32x4 o; o.x = pk2(a.x, a.y); o.y = pk2(a.z, a.w); o.z = pk2(b.x, b.y); o.w = pk2(b.z, b.w); md[i] = o; } }
    { f32x2* rt = wsp<f32x2>(F, WS_ROPE);
      for (size_t i = gt; i < (size_t)MTOK * 8; i += GT) { const int t = (int)(i >> 3), fi = (int)(i & 7);
          const float inv = (float)pow(500000.0, -(double)fi / 8.0); const float ang = (float)pos[t] * inv;
          rt[i] = (f32x2){cosf(ang), sinf(ang)}; } }
}

DI bf16* ob_at(bf16* OB, int t, int col) { return BLK_GATE ? (bf16*)((char*)OB + pg8::blk_off<false>(t, col, DM / 64)) : OB + (size_t)t * DM + col; }
DI float fexp(float x) { return __builtin_amdgcn_exp2f(x * 1.44269504089f); }
DI float logsigmoid_f(float z) { return fminf(z, 0.f) - 0.69314718056f * __builtin_amdgcn_logf(1.0f + fexp(-fabsf(z))); }

DI void gla_a_unit(const Frame& F, int l, int unit, const float* w_gla_up, const float* b_gla) {
    const int bh = unit >> 6, c = unit & 63, b = bh >> 2, h = bh & 3, t0 = b * SEQ + c * 64, tid = F.tid, lane = F.lane, wave = F.wave;
    const bf16* H = wsp<bf16>(F, WS_H);
    LAS float* lrs = (LAS float*)(F.lds);
    LAS float* bcs = (LAS float*)(F.lds + 4096);
    LAS float* seg = (LAS float*)(F.lds + 36864);
    LAS bf16* kds = (LAS bf16*)(F.lds + 40960);
    LAS bf16* vs = (LAS bf16*)(F.lds + 59392);
    constexpr int LDK = 136, LDV = 264;
    __syncthreads();
    if (tid < 128) { const int j = tid >> 1, hf = tid & 1; const u32x4 w = *(const u32x4*)(H + (size_t)(t0 + j) * NH + C_LR + 8 * hf); float f[8]; unpack8(w, f);
#pragma unroll
        for (int i = 0; i < 8; ++i) lrs[j * 16 + 8 * hf + i] = f[i]; }
    for (int p = tid; p < 64 * 32; p += NTHR) { const int j = p >> 5, ch = p & 31; *(LAS u32x4*)(vs + j * LDV + 8 * ch) = *(const u32x4*)(H + (size_t)(t0 + j) * NH + C_GV + h * 256 + 8 * ch); }
    __syncthreads();
    const int d = tid & 127, sg = tid >> 7;
    { float w[16];
#pragma unroll
      for (int r = 0; r < 16; ++r) w[r] = w_gla_up[(size_t)l * 16 * 512 + r * 512 + h * 128 + d];
      const float bg = b_gla[l * 512 + h * 128 + d]; float run = 0.f;
      for (int jj = 0; jj < 16; ++jj) { const int j = sg * 16 + jj; float z = bg;
#pragma unroll
          for (int r = 0; r < 16; ++r) z += lrs[j * 16 + r] * w[r];
          run += logsigmoid_f(z) * (1.0f / 16.0f); bcs[j * 128 + d] = run; }
      seg[sg * 128 + d] = run; }
    __syncthreads();
    { float pre = 0.f;
      for (int s = 0; s < sg; ++s) pre += seg[s * 128 + d];
      float* GB = wsp<float>(F, WS_GB);
      for (int jj = 0; jj < 16; ++jj) { const int j = sg * 16 + jj; const float v = bcs[j * 128 + d] + pre; bcs[j * 128 + d] = v; GB[(size_t)(t0 + j) * 512 + h * 128 + d] = v; }
      if (sg == 3) wsp<float>(F, WS_DEC)[(size_t)unit * 128 + d] = expf(bcs[63 * 128 + d]); }
    __syncthreads();
    for (int p = tid; p < 64 * 16; p += NTHR) { const int j = p >> 4, ch = p & 15; const u32x4 w = *(const u32x4*)(H + (size_t)(t0 + j) * NH + C_GK + h * 128 + 8 * ch); float f[8]; unpack8(w, f);
#pragma unroll
        for (int i = 0; i < 8; ++i) f[i] *= fexp(bcs[63 * 128 + 8 * ch + i] - bcs[j * 128 + 8 * ch + i]);
        *(LAS u32x4*)(kds + j * LDK + 8 * ch) = pack8(f); }
    __syncthreads();
    f32x4 acc[2][8];
#pragma unroll
    for (int a = 0; a < 2; ++a)
#pragma unroll
        for (int n = 0; n < 8; ++n) acc[a][n] = (f32x4){0.f, 0.f, 0.f, 0.f};
#pragma unroll
    for (int ks = 0; ks < 2; ++ks) {
        bf16x8 af[2];
#pragma unroll
        for (int a = 0; a < 2; ++a) af[a] = frag_tr(vs, LDV, 32 * ks, 32 * wave + 16 * a, lane);
#pragma unroll
        for (int n = 0; n < 8; ++n) { const bf16x8 bfr = frag_tr(kds, LDK, 32 * ks, 16 * n, lane);
#pragma unroll
            for (int a = 0; a < 2; ++a) acc[a][n] = mma16(bfr, af[a], acc[a][n]); }
    }
    float* U = wsp<float>(F, WS_GU) + (size_t)unit * 256 * 128;
#pragma unroll
    for (int a = 0; a < 2; ++a)
#pragma unroll
        for (int n = 0; n < 8; ++n) *(f32x4*)(U + (size_t)(32 * wave + 16 * a + (lane & 15)) * 128 + 16 * n + 4 * (lane >> 4)) = acc[a][n];
}

DI void gla_scan(const Frame& F) {
    const float* U = wsp<float>(F, WS_GU); const float* DEC = wsp<float>(F, WS_DEC); unsigned* S = wsp<unsigned>(F, WS_GS);
    const int gt = F.wg * NTHR + F.tid, GT = F.G * NTHR;
    for (int it = gt; it < 8 * 256 * 64; it += GT) {
        const int bh = it >> 14, r = it & 16383, e = r >> 6, dp = r & 63;
        float s0 = 0.f, s1 = 0.f;
#pragma unroll 8
        for (int c = 0; c < 64; ++c) { const size_t un = (size_t)bh * 64 + c; const size_t o = (un * 256 + e) * 128 + 2 * dp;
            const f32x2 u = *(const f32x2*)(U + o); const f32x2 dc = *(const f32x2*)(DEC + un * 128 + 2 * dp);
            S[o >> 1] = pk2(s0, s1); s0 = dc.x * s0 + u.x; s1 = dc.y * s1 + u.y; }
    }
}

#ifndef PROBE_T
#define PROBE_T 0
#endif
#if PROBE_T
#define PT_STAMP(k) do { if (F.wg == 0 && F.tid == 0) { const unsigned _now = (unsigned)wall_clock64(); volatile LAS unsigned* _pt = (volatile LAS unsigned*)(F.lds + MISC_OFF + 128); if ((k) > 0) _pt[k] += _now - _pt[0]; _pt[0] = _now; } } while (0)
#else
#define PT_STAMP(k) do {} while (0)
#endif
DI void gla_c_unit(const Frame& F, int l, int unit, const float* gla_norm) {
    const int bh = unit >> 6, c = unit & 63, b = bh >> 2, h = bh & 3, t0 = b * SEQ + c * 64, tid = F.tid, lane = F.lane, wave = F.wave;
    const bf16* H = wsp<bf16>(F, WS_H);
    LAS bf16* qs = (LAS bf16*)(F.lds);
    LAS bf16* ks = (LAS bf16*)(F.lds + 17408);
    LAS bf16* vs = (LAS bf16*)(F.lds + 34816);
    LAS bf16* ps = (LAS bf16*)(F.lds + 68608);
    LAS float* red = (LAS float*)(F.lds + 77824);
    constexpr int LDK = 136, LDV = 264, LDP = 72;
    __syncthreads();
    PT_STAMP(0);
    const float* GB = wsp<float>(F, WS_GB);
    u32x4 qw[2], kw[2], vw[4]; f32x4 b0[2], b1[2];
#pragma unroll
    for (int it = 0; it < 2; ++it) { const int p = tid + it * NTHR, j = p >> 4, ch = p & 15;
        qw[it] = *(const u32x4*)(H + (size_t)(t0 + j) * NH + C_GQ + h * 128 + 8 * ch); kw[it] = *(const u32x4*)(H + (size_t)(t0 + j) * NH + C_GK + h * 128 + 8 * ch);
        b0[it] = *(const f32x4*)(GB + (size_t)(t0 + j) * 512 + h * 128 + 8 * ch); b1[it] = *(const f32x4*)(GB + (size_t)(t0 + j) * 512 + h * 128 + 8 * ch + 4); }
#pragma unroll
    for (int it = 0; it < 4; ++it) { const int p = tid + it * NTHR, j = p >> 5, ch = p & 31; vw[it] = *(const u32x4*)(H + (size_t)(t0 + j) * NH + C_GV + h * 256 + 8 * ch); }
    const bf16* St = wsp<bf16>(F, WS_GS) + (size_t)unit * 256 * 128;
    bf16x8 sf[4][2];
#pragma unroll
    for (int kk = 0; kk < 4; ++kk)
#pragma unroll
        for (int a = 0; a < 2; ++a) sf[kk][a] = frag_glb(St, 128, 32 * wave + 16 * a, 32 * kk, lane);
    f32x4 gn[2]; u32x2 gw[4][2];
#pragma unroll
    for (int a = 0; a < 2; ++a) { const int e = 32 * wave + 16 * a + 4 * (lane >> 4); gn[a] = *(const f32x4*)(gla_norm + l * 1024 + h * 256 + e);
#pragma unroll
        for (int n = 0; n < 4; ++n) gw[n][a] = *(const u32x2*)(H + (size_t)(t0 + 16 * n + (lane & 15)) * NH + C_GG + h * 256 + e); }
#pragma unroll
    for (int it = 0; it < 2; ++it) { const int p = tid + it * NTHR, j = p >> 4, ch = p & 15;
        float q[8], k[8]; unpack8(qw[it], q); unpack8(kw[it], k); const float bb[8] = {b0[it].x, b0[it].y, b0[it].z, b0[it].w, b1[it].x, b1[it].y, b1[it].z, b1[it].w};
#pragma unroll
        for (int i = 0; i < 8; ++i) { const float eb = fexp(bb[i]); q[i] *= eb * 0.08838834764831845f; k[i] *= fexp(-bb[i]); }
        *(LAS u32x4*)(qs + j * LDK + 8 * ch) = pack8(q); *(LAS u32x4*)(ks + j * LDK + 8 * ch) = pack8(k); }
#pragma unroll
    for (int it = 0; it < 4; ++it) { const int p = tid + it * NTHR, j = p >> 5, ch = p & 31; *(LAS u32x4*)(vs + j * LDV + 8 * ch) = vw[it]; }
    __syncthreads();
    PT_STAMP(1);
    { const int it = wave >> 1; f32x4 sa[2] = {(f32x4){0.f, 0.f, 0.f, 0.f}, (f32x4){0.f, 0.f, 0.f, 0.f}};
#pragma unroll
      for (int kk = 0; kk < 4; ++kk) { const bf16x8 qa = frag_lds(qs, LDK, 16 * it, 32 * kk, lane);
#pragma unroll
          for (int jj = 0; jj < 2; ++jj) sa[jj] = mma16(qa, frag_lds(ks, LDK, 16 * (2 * (wave & 1) + jj), 32 * kk, lane), sa[jj]); }
#pragma unroll
      for (int jj = 0; jj < 2; ++jj)
#pragma unroll
          for (int r = 0; r < 4; ++r) { const int i = 16 * it + 4 * (lane >> 4) + r, j = 16 * (2 * (wave & 1) + jj) + (lane & 15);
              ps[i * LDP + j] = (bf16)f2bf(j <= i ? sa[jj][r] : 0.f); } }
    __syncthreads();
    PT_STAMP(2);
    f32x4 acc[2][4];
#pragma unroll
    for (int a = 0; a < 2; ++a)
#pragma unroll
        for (int n = 0; n < 4; ++n) acc[a][n] = (f32x4){0.f, 0.f, 0.f, 0.f};
#pragma unroll
    for (int kk = 0; kk < 4; ++kk) {
#pragma unroll
        for (int n = 0; n < 4; ++n) { const bf16x8 bq = frag_lds(qs, LDK, 16 * n, 32 * kk, lane);
#pragma unroll
            for (int a = 0; a < 2; ++a) acc[a][n] = mma16(sf[kk][a], bq, acc[a][n]); } }
#pragma unroll
    for (int kk = 0; kk < 2; ++kk) { bf16x8 af[2];
#pragma unroll
        for (int a = 0; a < 2; ++a) af[a] = frag_tr(vs, LDV, 32 * kk, 32 * wave + 16 * a, lane);
#pragma unroll
        for (int n = 0; n < 4; ++n) { const bf16x8 bp = frag_lds(ps, LDP, 16 * n, 32 * kk, lane);
#pragma unroll
            for (int a = 0; a < 2; ++a) acc[a][n] = mma16(af[a], bp, acc[a][n]); } }
#pragma unroll
    for (int n = 0; n < 4; ++n) { float s = 0.f;
#pragma unroll
        for (int a = 0; a < 2; ++a)
#pragma unroll
            for (int r = 0; r < 4; ++r) s += acc[a][n][r] * acc[a][n][r];
        s += __shfl_xor(s, 16); s += __shfl_xor(s, 32);
        if (lane < 16) red[wave * 64 + 16 * n + lane] = s; }
    __syncthreads();
    PT_STAMP(3);
    bf16* OB = wsp<bf16>(F, WS_OB);
#pragma unroll
    for (int n = 0; n < 4; ++n) { const int i = 16 * n + (lane & 15); float tot = 0.f;
#pragma unroll
        for (int w = 0; w < 8; ++w) tot += red[w * 64 + i];
        const float rs = 1.0f / sqrtf(tot * (1.0f / 256.0f) + LN_EPS);
#pragma unroll
        for (int a = 0; a < 2; ++a) { const int e = 32 * wave + 16 * a + 4 * (lane >> 4);
            const float g0 = bf2f(gw[n][a].x & 0xffffu), g1 = bf2f(gw[n][a].x >> 16), g2 = bf2f(gw[n][a].y & 0xffffu), g3 = bf2f(gw[n][a].y >> 16);
            u32x2 o; o.x = pk2(acc[a][n][0] * rs * gn[a].x * g0, acc[a][n][1] * rs * gn[a].y * g1); o.y = pk2(acc[a][n][2] * rs * gn[a].z * g2, acc[a][n][3] * rs * gn[a].w * g3);
            *(u32x2*)ob_at(OB, t0 + i, 1024 + h * 256 + e) = o; } }
    PT_STAMP(4);
}

DI void pool_unit(const Frame& F, int l, int unit, const float* pool_scale) {
    const int gi = unit & 3, tt = unit >> 2, t0 = tt * 128, tid = F.tid, lane = F.lane, wave = F.wave, w = 2 << gi;
    const bf16* H = wsp<bf16>(F, WS_H);
    LAS bf16* pl = (LAS bf16*)(F.lds);
    constexpr int LDP = 264;
    __syncthreads();
    for (int p = tid; p < 128 * 32; p += NTHR) { const int j = p >> 5, ch = p & 31, t = t0 + j, ts = t & (SEQ - 1);
        const int cnt = (ts + 1 < w) ? ts + 1 : w; float a[8];
#pragma unroll
        for (int i = 0; i < 8; ++i) a[i] = 0.f;
        float u0[8];
        const bf16* hp = H + (size_t)t * NH + C_PU + gi * 256 + 8 * ch;
        { float f[8]; unpack8(*(const u32x4*)hp, f);
#pragma unroll
          for (int i = 0; i < 8; ++i) { a[i] = f[i]; u0[i] = f[i]; } }
#pragma unroll
        for (int s = 1; s < 16; ++s) if (s < w) { const int sb = (s < cnt) ? s : 0;
            const u32x4 x = *(const u32x4*)(hp - (size_t)sb * NH); float f[8]; unpack8(x, f); const float wgt = (s < cnt) ? 1.f : 0.f;
#pragma unroll
            for (int i = 0; i < 8; ++i) a[i] += wgt * f[i]; }
        const float ic = 1.0f / (float)cnt;
#pragma unroll
        for (int i = 0; i < 8; ++i) a[i] = a[i] * ic - u0[i];
        *(LAS u32x4*)(pl + j * LDP + 8 * ch) = pack8(a); }
    __syncthreads();
    const bf16* WP = wsp<bf16>(F, WS_WPOOLT) + (size_t)(l * 4 + gi) * 256 * 256;
    f32x4 acc[2][8];
#pragma unroll
    for (int a = 0; a < 2; ++a)
#pragma unroll
        for (int n = 0; n < 8; ++n) acc[a][n] = (f32x4){0.f, 0.f, 0.f, 0.f};
#pragma unroll 2
    for (int kk = 0; kk < 8; ++kk) { bf16x8 af[2];
#pragma unroll
        for (int a = 0; a < 2; ++a) af[a] = frag_glb(WP, 256, 32 * wave + 16 * a, 32 * kk, lane);
#pragma unroll
        for (int n = 0; n < 8; ++n) { const bf16x8 bp = frag_lds(pl, LDP, 16 * n, 32 * kk, lane);
#pragma unroll
            for (int a = 0; a < 2; ++a) acc[a][n] = mma16(af[a], bp, acc[a][n]); } }
    bf16* OB = wsp<bf16>(F, WS_OB);
#pragma unroll
    for (int n = 0; n < 8; ++n) { const int t = t0 + 16 * n + (lane & 15);
#pragma unroll
        for (int a = 0; a < 2; ++a) { const int dd = gi * 256 + 32 * wave + 16 * a + 4 * (lane >> 4);
            const f32x4 sc = *(const f32x4*)(pool_scale + l * 1024 + dd);
            const u32x2 gw = *(const u32x2*)(H + (size_t)t * NH + C_PG + dd);
            const float g0 = bf2f(gw.x & 0xffffu), g1 = bf2f(gw.x >> 16), g2 = bf2f(gw.y & 0xffffu), g3 = bf2f(gw.y >> 16);
            u32x2 o; o.x = pk2(acc[a][n][0] * sc.x * g0, acc[a][n][1] * sc.y * g1); o.y = pk2(acc[a][n][2] * sc.z * g2, acc[a][n][3] * sc.w * g3);
            *(u32x2*)ob_at(OB, t, dd) = o; } }
}

DI void swa_unit(const Frame& F, int l, int unit, const float* sinks) {
    const int n = unit & 31, hq = (unit >> 5) & 15, b = unit >> 9, kvh = hq >> 3, tid = F.tid, lane = F.lane, wave = F.wave;
    const int tq0 = b * SEQ + n * 128, tk0 = tq0 - 128;
    const bf16* H = wsp<bf16>(F, WS_H); const f32x2* RT = wsp<f32x2>(F, WS_ROPE);
    constexpr int LD = 72, LDPW = 168;
    LAS bf16* qs = (LAS bf16*)(F.lds);
    LAS bf16* ks = (LAS bf16*)(F.lds + 18432);
    LAS bf16* vs = (LAS bf16*)(F.lds + 57600);
    LAS bf16* pw = (LAS bf16*)(F.lds + 96768) + wave * 16 * LDPW;
    __syncthreads();
    for (int p = tid; p < 128 * 4; p += NTHR) { const int i = p >> 2, ch = p & 3; const bf16* src = H + (size_t)(tq0 + i) * NH + C_SQ + hq * 64 + 16 * ch;
        float f[16]; { float a[8], c[8]; unpack8(*(const u32x4*)src, a); unpack8(*(const u32x4*)(src + 8), c);
#pragma unroll
            for (int j = 0; j < 8; ++j) { f[j] = a[j]; f[8 + j] = c[j]; } }
        if (ch == 0) {
#pragma unroll
            for (int j = 0; j < 8; ++j) { const f32x2 cs = RT[(size_t)(tq0 + i) * 8 + j]; const float x1 = f[j], x2 = f[8 + j]; f[j] = x1 * cs.x - x2 * cs.y; f[8 + j] = x2 * cs.x + x1 * cs.y; } }
        float o0[8], o1[8];
#pragma unroll
        for (int j = 0; j < 8; ++j) { o0[j] = f[j] * 0.125f; o1[j] = f[8 + j] * 0.125f; }
        *(LAS u32x4*)(qs + i * LD + 16 * ch) = pack8(o0); *(LAS u32x4*)(qs + i * LD + 16 * ch + 8) = pack8(o1); }
    for (int p = tid; p < 272 * 4; p += NTHR) { const int j = p >> 2, ch = p & 3; const bool ok = (j < 256) && (n > 0 || j >= 128);
        u32x4 k0 = (u32x4){0u, 0u, 0u, 0u}, k1 = k0, v0 = k0, v1 = k0;
        if (ok) { const bf16* ksrc = H + (size_t)(tk0 + j) * NH + C_SK + kvh * 64 + 16 * ch; const bf16* vsrc = H + (size_t)(tk0 + j) * NH + C_SV + kvh * 64 + 16 * ch;
            k0 = *(const u32x4*)ksrc; k1 = *(const u32x4*)(ksrc + 8); v0 = *(const u32x4*)vsrc; v1 = *(const u32x4*)(vsrc + 8);
            if (ch == 0) { float a[8], c[8]; unpack8(k0, a); unpack8(k1, c);
#pragma unroll
                for (int jj = 0; jj < 8; ++jj) { const f32x2 cs = RT[(size_t)(tk0 + j) * 8 + jj]; const float x1 = a[jj], x2 = c[jj]; a[jj] = x1 * cs.x - x2 * cs.y; c[jj] = x2 * cs.x + x1 * cs.y; }
                k0 = pack8(a); k1 = pack8(c); } }
        *(LAS u32x4*)(ks + j * LD + 16 * ch) = k0; *(LAS u32x4*)(ks + j * LD + 16 * ch + 8) = k1;
        *(LAS u32x4*)(vs + j * LD + 16 * ch) = v0; *(LAS u32x4*)(vs + j * LD + 16 * ch + 8) = v1; }
    __syncthreads();
    const int qi = 16 * wave + (lane & 15);
    bf16x8 qf[2];
#pragma unroll
    for (int s = 0; s < 2; ++s) qf[s] = frag_lds(qs, LD, 16 * wave, 32 * s, lane);
    f32x4 sc[10];
#pragma unroll
    for (int jt = 0; jt < 10; ++jt) { sc[jt] = (f32x4){0.f, 0.f, 0.f, 0.f};
#pragma unroll
        for (int s = 0; s < 2; ++s) sc[jt] = mma16(frag_lds(ks, LD, 16 * (wave + jt), 32 * s, lane), qf[s], sc[jt]); }
    const float sink = sinks[l * 16 + hq];
    float mx = sink;
#pragma unroll
    for (int jt = 0; jt < 10; ++jt)
#pragma unroll
        for (int r = 0; r < 4; ++r) { const int kj = 16 * (wave + jt) + 4 * (lane >> 4) + r; const bool ok = (kj > qi) && (kj <= qi + 128) && (n > 0 || kj >= 128);
            sc[jt][r] = ok ? sc[jt][r] : -INFINITY; mx = fmaxf(mx, sc[jt][r]); }
    mx = fmaxf(mx, __shfl_xor(mx, 16)); mx = fmaxf(mx, __shfl_xor(mx, 32));
    float sum = 0.f;
#pragma unroll
    for (int jt = 0; jt < 10; ++jt)
#pragma unroll
        for (int r = 0; r < 4; ++r) { const float p = fexp(sc[jt][r] - mx); sc[jt][r] = p; sum += p; }
    sum += __shfl_xor(sum, 16); sum += __shfl_xor(sum, 32);
    const float inv = 1.0f / (sum + fexp(sink - mx));
#pragma unroll
    for (int jt = 0; jt < 10; ++jt) { u32x2 o; o.x = pk2(sc[jt][0] * inv, sc[jt][1] * inv); o.y = pk2(sc[jt][2] * inv, sc[jt][3] * inv);
        *(LAS u32x2*)(pw + (lane & 15) * LDPW + 16 * jt + 4 * (lane >> 4)) = o; }
    LDS_WAIT();
    f32x4 oa[4];
#pragma unroll
    for (int dt = 0; dt < 4; ++dt) oa[dt] = (f32x4){0.f, 0.f, 0.f, 0.f};
#pragma unroll
    for (int s = 0; s < 5; ++s) { const bf16x8 pf = frag_lds(pw, LDPW, 0, 32 * s, lane);
#pragma unroll
        for (int dt = 0; dt < 4; ++dt) oa[dt] = mma16(frag_tr(vs, LD, 16 * wave + 32 * s, 16 * dt, lane), pf, oa[dt]); }
    bf16* OB = wsp<bf16>(F, WS_OB);
    { const int t = tq0 + qi;
#pragma unroll
      for (int dt = 0; dt < 4; ++dt) { const int dd = hq * 64 + 16 * dt + 4 * (lane >> 4);
          const u32x2 gw = *(const u32x2*)(H + (size_t)t * NH + C_SG + dd);
          const float g0 = bf2f(gw.x & 0xffffu), g1 = bf2f(gw.x >> 16), g2 = bf2f(gw.y & 0xffffu), g3 = bf2f(gw.y >> 16);
          u32x2 o; o.x = pk2(oa[dt][0] * g0, oa[dt][1] * g1); o.y = pk2(oa[dt][2] * g2, oa[dt][3] * g3);
          *(u32x2*)ob_at(OB, t, 2048 + dd) = o; } }
}

DI void mem_unit(const Frame& F, int l, int unit) {
    const int n = unit & 31, hx = (unit >> 5) & 3, b = unit >> 7, lane = F.lane, wave = F.wave, tid = F.tid;
    const int tq0 = b * SEQ + n * 128 + 16 * wave;
    const bf16* H = wsp<bf16>(F, WS_H);
    const bf16* MK = wsp<bf16>(F, WS_MK) + (size_t)l * 512 * 1024 + (size_t)b * 256 * 1024 + hx * 256;
    const bf16* MVT = wsp<bf16>(F, WS_MVT) + (size_t)l * 1024 * 512 + (size_t)hx * 256 * 512 + b * 256;
    constexpr int LDI = 264;
    LAS bf16* img = (LAS bf16*)(F.lds);
    __syncthreads();
#pragma unroll 4
    for (int p = tid; p < 256 * 32; p += NTHR) { const int r = p >> 5, ch = p & 31; *(LAS u32x4*)(img + r * LDI + 8 * ch) = *(const u32x4*)(MK + (size_t)r * 1024 + 8 * ch); }
    bf16x8 qf[8];
#pragma unroll
    for (int s = 0; s < 8; ++s) qf[s] = frag_glb(H + C_XQ + hx * 256, NH, tq0, 32 * s, lane);
    __syncthreads();
    f32x4 sc[16];
#pragma unroll
    for (int jt = 0; jt < 16; ++jt) { sc[jt] = (f32x4){0.f, 0.f, 0.f, 0.f};
#pragma unroll
        for (int s = 0; s < 8; ++s) sc[jt] = mma16(frag_lds(img, LDI, 16 * jt, 32 * s, lane), qf[s], sc[jt]);
        if (jt & 1) __builtin_amdgcn_sched_barrier(0); }
#pragma unroll
    for (int jt = 0; jt < 16; ++jt) asm volatile("" : "+v"(sc[jt]));
    __syncthreads();
#pragma unroll 4
    for (int p = tid; p < 256 * 32; p += NTHR) { const int r = p >> 5, ch = p & 31; *(LAS u32x4*)(img + r * LDI + 8 * ch) = *(const u32x4*)(MVT + (size_t)r * 512 + 8 * ch); }
    float mx = -INFINITY;
#pragma unroll
    for (int jt = 0; jt < 16; ++jt)
#pragma unroll
        for (int r = 0; r < 4; ++r) { sc[jt][r] *= 0.0625f; mx = fmaxf(mx, sc[jt][r]); }
    mx = fmaxf(mx, __shfl_xor(mx, 16)); mx = fmaxf(mx, __shfl_xor(mx, 32));
    float sum = 0.f;
#pragma unroll
    for (int jt = 0; jt < 16; ++jt)
#pragma unroll
        for (int r = 0; r < 4; ++r) { const float p = __builtin_amdgcn_exp2f((sc[jt][r] - mx) * 1.44269504089f); sc[jt][r] = p; sum += p; }
    sum += __shfl_xor(sum, 16); sum += __shfl_xor(sum, 32);
    const float inv = 1.0f / sum;
    bf16x8 pb[8];
#pragma unroll
    for (int s = 0; s < 8; ++s) { u32x4 w; w.x = pk2(sc[2 * s][0] * inv, sc[2 * s][1] * inv); w.y = pk2(sc[2 * s][2] * inv, sc[2 * s][3] * inv);
        w.z = pk2(sc[2 * s + 1][0] * inv, sc[2 * s + 1][1] * inv); w.w = pk2(sc[2 * s + 1][2] * inv, sc[2 * s + 1][3] * inv); pb[s] = __builtin_bit_cast(bf16x8, w); }
    __syncthreads();
    bf16* OB = wsp<bf16>(F, WS_OB); const int t = tq0 + (lane & 15);
    const LAS bf16* arow = img + (lane & 15) * LDI + 4 * (lane >> 4);
#pragma unroll 4
    for (int dt = 0; dt < 16; ++dt) { f32x4 oa = (f32x4){0.f, 0.f, 0.f, 0.f};
#pragma unroll
        for (int s = 0; s < 8; ++s) { const u32x2 lo = *(const LAS u32x2*)(arow + 16 * dt * LDI + 32 * s), hi = *(const LAS u32x2*)(arow + 16 * dt * LDI + 32 * s + 16);
            const u32x4 av = (u32x4){lo.x, lo.y, hi.x, hi.y};
            oa = mma16(__builtin_bit_cast(bf16x8, av), pb[s], oa); }
        __builtin_amdgcn_sched_barrier(0);
        const int dd = hx * 256 + 16 * dt + 4 * (lane >> 4);
        const u32x2 gw = *(const u32x2*)(H + (size_t)t * NH + C_XG + dd);
        const float g0 = bf2f(gw.x & 0xffffu), g1 = bf2f(gw.x >> 16), g2 = bf2f(gw.y & 0xffffu), g3 = bf2f(gw.y >> 16);
        u32x2 o; o.x = pk2(oa[0] * g0, oa[1] * g1); o.y = pk2(oa[2] * g2, oa[3] * g3);
        *(u32x2*)ob_at(OB, t, 3072 + dd) = o; }
}

#ifndef NAIVE_MASK
#define NAIVE_MASK 0
#endif
DI float Hf(const bf16* H, size_t row, int col) { return bf2f(H[row * NH + col]); }
DI void naive_mem(const Frame& F, int l) {
    const bf16* H = wsp<bf16>(F, WS_H); bf16* OB = wsp<bf16>(F, WS_OB);
    LAS float* qs = (LAS float*)(F.lds) + F.wave * 512; LAS float* ps = qs + 256;
    const int gw = F.wg * NWAVES + F.wave, NGW = F.G * NWAVES, lane = F.lane;
    for (int it = gw; it < MTOK * 4; it += NGW) {
        const int t = it >> 2, hx = it & 3, b = t / SEQ;
        const bf16* MK = wsp<bf16>(F, WS_MK) + (size_t)l * 512 * 1024 + (size_t)b * 256 * 1024 + hx * 256;
        const bf16* MVT = wsp<bf16>(F, WS_MVT) + (size_t)l * 1024 * 512 + (size_t)hx * 256 * 512 + b * 256;
        for (int i = 0; i < 4; ++i) qs[lane + 64 * i] = Hf(H, t, C_XQ + hx * 256 + lane + 64 * i);
        LDS_WAIT();
        float sc[4]; float mx = -INFINITY;
        for (int i = 0; i < 4; ++i) { const int j = lane + 64 * i; float a = 0.f; for (int d = 0; d < 256; ++d) a += qs[d] * bf2f(MK[(size_t)j * 1024 + d]); sc[i] = a * 0.0625f; mx = fmaxf(mx, sc[i]); }
        for (int o = 1; o < 64; o <<= 1) mx = fmaxf(mx, __shfl_xor(mx, o));
        float sum = 0.f; for (int i = 0; i < 4; ++i) { sc[i] = expf(sc[i] - mx); sum += sc[i]; }
        sum = wave_sum(sum);
        for (int i = 0; i < 4; ++i) ps[lane + 64 * i] = sc[i] / sum;
        LDS_WAIT();
        for (int i = 0; i < 4; ++i) { const int d = lane + 64 * i; float a = 0.f; for (int j = 0; j < 256; ++j) a += ps[j] * bf2f(MVT[(size_t)d * 512 + j]);
            *ob_at(OB, t, 3072 + hx * 256 + d) = (bf16)f2bf(a * Hf(H, t, C_XG + hx * 256 + d)); }
        LDS_WAIT();
    }
}
DI void naive_swa(const Frame& F, int l, const float* sinks) {
    const bf16* H = wsp<bf16>(F, WS_H); bf16* OB = wsp<bf16>(F, WS_OB); const f32x2* RT = wsp<f32x2>(F, WS_ROPE);
    LAS float* qs = (LAS float*)(F.lds) + F.wave * 256; LAS float* ps = qs + 64;
    const int gw = F.wg * NWAVES + F.wave, NGW = F.G * NWAVES, lane = F.lane;
    for (int it = gw; it < MTOK * 16; it += NGW) {
        const int t = it >> 4, hq = it & 15, kvh = hq >> 3, ts = t & (SEQ - 1);
        { float x = Hf(H, t, C_SQ + hq * 64 + lane);
          if (lane < 16) { const int i = lane & 7; const float x1 = Hf(H, t, C_SQ + hq * 64 + i), x2 = Hf(H, t, C_SQ + hq * 64 + 8 + i); const f32x2 cs = RT[(size_t)t * 8 + i];
              x = (lane < 8) ? x1 * cs.x - x2 * cs.y : x2 * cs.x + x1 * cs.y; }
          qs[lane] = x * 0.125f; }
        LDS_WAIT();
        float sc[2]; const float sink = sinks[l * 16 + hq]; float mx = sink;
        for (int i = 0; i < 2; ++i) { const int back = lane + 64 * i; sc[i] = -INFINITY;
            if (back <= ts) { const int tk = t - back; float a = 0.f;
                for (int d = 0; d < 64; ++d) { float kv = Hf(H, tk, C_SK + kvh * 64 + d);
                    if (d < 16) { const int ii = d & 7; const float x1 = Hf(H, tk, C_SK + kvh * 64 + ii), x2 = Hf(H, tk, C_SK + kvh * 64 + 8 + ii); const f32x2 cs = RT[(size_t)tk * 8 + ii];
                        kv = (d < 8) ? x1 * cs.x - x2 * cs.y : x2 * cs.x + x1 * cs.y; }
                    a += qs[d] * kv; }
                sc[i] = a; }
            mx = fmaxf(mx, sc[i]); }
        for (int o = 1; o < 64; o <<= 1) mx = fmaxf(mx, __shfl_xor(mx, o));
        float sum = 0.f; for (int i = 0; i < 2; ++i) { sc[i] = expf(sc[i] - mx); sum += sc[i]; }
        sum = wave_sum(sum) + expf(sink - mx);
        for (int i = 0; i < 2; ++i) ps[lane + 64 * i] = sc[i] / sum;
        LDS_WAIT();
        { float a = 0.f; const int nk = (ts + 1 < 128) ? ts + 1 : 128;
          for (int back = 0; back < nk; ++back) a += ps[back] * Hf(H, t - back, C_SV + kvh * 64 + lane);
          *ob_at(OB, t, 2048 + hq * 64 + lane) = (bf16)f2bf(a * Hf(H, t, C_SG + hq * 64 + lane)); }
        LDS_WAIT();
    }
}
DI void naive_pool(const Frame& F, int l, const float* w_pool, const float* pool_scale) {
    const bf16* H = wsp<bf16>(F, WS_H); bf16* OB = wsp<bf16>(F, WS_OB); LAS float* pl = (LAS float*)(F.lds);
    for (int unit = F.wg; unit < 512; unit += F.G) { const int gi = unit & 3, t0 = (unit >> 2) * 64, w = 2 << gi;
        __syncthreads();
        for (int p = F.tid; p < 64 * 256; p += NTHR) { const int j = p >> 8, c = p & 255, t = t0 + j, ts = t & (SEQ - 1); const int cnt = (ts + 1 < w) ? ts + 1 : w; float a = 0.f;
            for (int s2 = 0; s2 < cnt; ++s2) a += Hf(H, t - s2, C_PU + gi * 256 + c);
            pl[p] = a / (float)cnt - Hf(H, t, C_PU + gi * 256 + c); }
        __syncthreads();
        const float* W = w_pool + (size_t)(l * 4 + gi) * 256 * 256;
        for (int o = F.tid; o < 64 * 256; o += NTHR) { const int j = o >> 8, d = o & 255; float a = 0.f; for (int c = 0; c < 256; ++c) a += pl[j * 256 + c] * W[c * 256 + d];
            const int t = t0 + j; *ob_at(OB, t, gi * 256 + d) = (bf16)f2bf(a * pool_scale[l * 1024 + gi * 256 + d] * Hf(H, t, C_PG + gi * 256 + d)); } }
}
DI void naive_gla(const Frame& F, int l, const float* w_gla_up, const float* b_gla) {
    const bf16* H = wsp<bf16>(F, WS_H); float* RAW = wsp<float>(F, WS_GU); LAS float* red = (LAS float*)(F.lds);
    for (int unit = F.wg; unit < 64; unit += F.G) { const int bh = unit >> 3, es = unit & 7, b = bh >> 2, h = bh & 3, e = es * 32 + (F.tid & 31), dg = F.tid >> 5;
        float S[8], wu[8][16], bg[8];
        for (int i = 0; i < 8; ++i) { S[i] = 0.f; bg[i] = b_gla[l * 512 + h * 128 + 8 * dg + i]; for (int r = 0; r < 16; ++r) wu[i][r] = w_gla_up[(size_t)l * 16 * 512 + r * 512 + h * 128 + 8 * dg + i]; }
        for (int ts = 0; ts < SEQ; ++ts) { const size_t t = (size_t)b * SEQ + ts; float lr[16]; for (int r = 0; r < 16; ++r) lr[r] = Hf(H, t, C_LR + r);
            const float v = Hf(H, t, C_GV + h * 256 + e); float part = 0.f;
            for (int i = 0; i < 8; ++i) { float z = bg[i]; for (int r = 0; r < 16; ++r) z += lr[r] * wu[i][r];
                const float a = expf((fminf(z, 0.f) - log1pf(expf(-fabsf(z)))) * (1.0f / 16.0f));
                S[i] = a * S[i] + Hf(H, t, C_GK + h * 128 + 8 * dg + i) * v; part += Hf(H, t, C_GQ + h * 128 + 8 * dg + i) * 0.08838834764831845f * S[i]; }
            __syncthreads(); red[dg * 32 + (F.tid & 31)] = part; __syncthreads();
            if (dg == 0) { float o = 0.f; for (int g = 0; g < 16; ++g) o += red[g * 32 + (F.tid & 31)]; RAW[t * 1024 + h * 256 + e] = o; } } }
}
DI void naive_gla_norm(const Frame& F, int l, const float* gla_norm) {
    const bf16* H = wsp<bf16>(F, WS_H); bf16* OB = wsp<bf16>(F, WS_OB); const float* RAW = wsp<float>(F, WS_GU);
    const int gw = F.wg * NWAVES + F.wave, NGW = F.G * NWAVES, lane = F.lane;
    for (int it = gw; it < MTOK * 4; it += NGW) { const int t = it >> 2, h = it & 3; float o[4], ss = 0.f;
        for (int i = 0; i < 4; ++i) { o[i] = RAW[(size_t)t * 1024 + h * 256 + lane + 64 * i]; ss += o[i] * o[i]; }
        ss = wave_sum(ss); const float rs = 1.0f / sqrtf(ss * (1.0f / 256.0f) + LN_EPS);
        for (int i = 0; i < 4; ++i) { const int e = lane + 64 * i; *ob_at(OB, t, 1024 + h * 256 + e) = (bf16)f2bf(o[i] * rs * gla_norm[l * 1024 + h * 256 + e] * Hf(H, t, C_GG + h * 256 + e)); } }
}

DI void ln_phase(const Frame& F, int l, const float* ln_g, const float* ln_b) {
    const int gw = F.wg * NWAVES + F.wave, NGW = F.G * NWAVES, lane = F.lane;
    const float* g = ln_g + l * DM; const float* bb = ln_b + l * DM;
    for (int m = gw; m < MTOK; m += NGW) {
        f32x4* row = (f32x4*)(F.out + (size_t)m * DM) + lane; const f32x4* zrow = (const f32x4*)(wsp<float>(F, WS_Z) + (size_t)m * DM) + lane;
        f32x4 v[16]; float s = 0.f;
#pragma unroll
        for (int j = 0; j < 16; ++j) { v[j] = zrow[64 * j]; s += (v[j].x + v[j].y) + (v[j].z + v[j].w); }
        const float mean = wave_sum(s) * (1.f / DM); float s2 = 0.f;
#pragma unroll
        for (int j = 0; j < 16; ++j) { v[j] = v[j] - mean; s2 += (v[j].x * v[j].x + v[j].y * v[j].y) + (v[j].z * v[j].z + v[j].w * v[j].w); }
        const float rstd = 1.f / sqrtf(wave_sum(s2) * (1.f / DM) + LN_EPS);
        u32x2* xb = (u32x2*)(wsp<bf16>(F, WS_XB) + (size_t)m * DM) + lane; unsigned* x8 = (unsigned*)(wsp<unsigned char>(F, WS_X8) + (size_t)m * DM) + lane;
#pragma unroll
        for (int j = 0; j < 16; ++j) { const f32x4 gg = *((const f32x4*)g + lane + 64 * j), be = *((const f32x4*)bb + lane + 64 * j);
            const f32x4 o = v[j] * rstd * gg + be; row[64 * j] = o;
#if F6
            if (l + 1 < DEPTH) { u32x2 w; w.x = pk2(o.x, o.y); w.y = pk2(o.z, o.w); xb[64 * j] = w;
                LAS unsigned char* lw = F.lds + F.wave * 9216;
                *(LAS f32x4*)(lw + ((lane >> 3) + 8 * (j & 7)) * 144 + (lane & 7) * 16) = o * X8_SCALE;
                if ((j & 7) == 7) { LDS_WAIT(); float f[32];
#pragma unroll
                    for (int t = 0; t < 8; ++t) { const f32x4 q = *(const LAS f32x4*)(lw + lane * 144 + 16 * t); f[4 * t] = q.x; f[4 * t + 1] = q.y; f[4 * t + 2] = q.z; f[4 * t + 3] = q.w; }
                    u32x4 lo, hi; pk32_fp6(f, lo, hi); const int gi = 64 * (j >> 3) + lane; size_t ol, oh; pg8::f6_off(m, gi >> 2, gi & 3, ol, oh);
                    *(u32x4*)(wsp<unsigned char>(F, WS_X8) + ol) = lo; u32x2 h2; h2.x = hi.x; h2.y = hi.y; *(u32x2*)(wsp<unsigned char>(F, WS_X8) + oh) = h2; LDS_WAIT(); } } }
#else
            if (l + 1 < DEPTH) { u32x2 w; w.x = pk2(o.x, o.y); w.y = pk2(o.z, o.w); xb[64 * j] = w; x8[64 * j] = pk4_fp8(o.x * X8_SCALE, o.y * X8_SCALE, o.z * X8_SCALE, o.w * X8_SCALE); } }
#endif
    }
}

struct Args { const void* in[15]; float* out; unsigned char* ws; int ph_lo, ph_hi; };
constexpr int PH_PER_LAYER = 7, N_PHASES = 1 + PH_PER_LAYER * DEPTH;
#define IN(k) (lo <= (k) && (k) < hi)
#ifndef PH_MASK
#define PH_MASK 0xffff
#endif
#define PHM(b) ((PH_MASK >> (b)) & 1)
#ifndef REP_MASK
#define REP_MASK 0
#endif
#define REPS(b) (((REP_MASK >> (b)) & 1) ? 2 : 1)
#define SEAM(k) do { if (IN(k) && IN((k) + 1)) xcd_barrier(bar); } while (0)
#ifndef PROBE_CLK
#define PROBE_CLK 0
#endif
#ifndef PROBE_HOT
#define PROBE_HOT 0
#endif
struct SchedHot {
    static constexpr bool BLK = false;
    int G, c, mode; const char* A; const char* B;
    DI bool next(int i, pg8::Unit& u) const { if (i >= 4) return false; if (mode == 1) { u.pm = c & 7; u.pn = 0; } else if (mode == 4) { u.pm = c & 7; u.pn = c & 7; } else pg8::static_tile(i * G + c, 32, 32, u.pm, u.pn); u.gi = 0; return true; }
    DI const char* abase(const pg8::Unit& u) const { return A + (size_t)u.pm * 256 * 4096 * 2; }
    DI const char* bbase(const pg8::Unit& u) const { return B + (size_t)u.pn * 256 * 4096 * 2; }
};
struct SchedHot6 {
    static constexpr bool BLK = false;
    int G, c, mode; const char* A; const char* B;
    DI bool next(int i, pg8::Unit& u) const { if (i >= 4) return false; if (mode == 6) { u.pm = c & 7; u.pn = c & 7; } else pg8::static_tile(i * G + c, 32, 32, u.pm, u.pn); u.gi = 0; return true; }
    DI const char* abase(const pg8::Unit& u) const { return A + (size_t)u.pm * 786432; }
    DI const char* bbase(const pg8::Unit& u) const { return (mode == 6 ? A : B) + (size_t)u.pn * 786432; }
};
struct SchedHotBlk : SchedHot { static constexpr bool BLK = true; };
template <int l> DI void layer_body(const Frame& F, const Args& args, const int lo, const int hi, const XcdBarrier& bar) {
        const int p0 = 1 + PH_PER_LAYER * l;
        if (PHM(1) && IN(p0)) { {
            SchedInProj S; S.G = F.G; S.c = F.wg; S.n_extra = (l == 0) ? 32 : 0; S.XB = (const char*)(F.ws + WS_XB); S.WT = (const char*)(F.ws + WS_WINT) + (size_t)l * NH * 4096 * 2;
            S.MEMB = (const char*)(F.ws + WS_MEMB); S.WKV = (const char*)(F.ws + WS_WMKVT);
            EpiH E{wsp<bf16>(F, WS_H), wsp<bf16>(F, WS_MK), wsp<bf16>(F, WS_MVT)};
            pg8::SchedStatic S8; S8.nM = 32; S8.nN = N_F8 / (128 * F8NB); S8.G = F.G; S8.c = (F.wg + F8_ROT) % F.G; S8.A = (const char*)(F.ws + WS_X8); S8.B = (const char*)(F.ws + WS_W8) + (size_t)l * W8_LAYER;
            S8.astep = F6 ? (size_t)2 * 32 * 12288 : (size_t)256 * 4096; S8.bstep = F6 ? (size_t)F8NB * 32 * 12288 : (size_t)(128 * F8NB) * 4096;
            EpiMG<F8NB> E8{wsp<bf16>(F, WS_H)};
#if F6_FIRST
            pg8::gemm_phase<EpiMG<F8NB>, pg8::SchedStatic, F8NB, true, true>(F.lds, 2048, S8, E8);
            pg8::gemm_phase<EpiH, SchedInProj, 2, true>(F.lds, 4096, S, E);
#else
            pg8::gemm_phase<EpiH, SchedInProj, 2, true>(F.lds, 4096, S, E);
            pg8::gemm_phase<EpiMG<F8NB>, pg8::SchedStatic, F8NB, true, true>(F.lds, 2048, S8, E8);
#endif
        }
        if (PROBE_HOT >= 5 && l == 0) {
            SchedHot6 S6; S6.G = F.G; S6.c = F.wg; S6.mode = PROBE_HOT; S6.A = (const char*)(F.ws + WS_X8); S6.B = (const char*)(F.ws + WS_W8);
            EpiMG<F8NB> E6{(bf16*)(F.ws + (size_t)1700 * MiB)};
            pg8::gemm_phase<EpiMG<F8NB>, SchedHot6, F8NB, true, true>(F.lds, 2048, S6, E6);
        } else
        if (PROBE_HOT != 0 && l == 0) {
            SchedHot S; S.G = F.G; S.c = F.wg; S.mode = PROBE_HOT; S.A = (const char*)(F.ws + WS_XB); S.B = (PROBE_HOT == 4) ? (const char*)(F.ws + WS_XB) : (const char*)(F.ws + WS_WINT);
            EpiH E{(bf16*)(F.ws + (size_t)1700 * MiB), wsp<bf16>(F, WS_MK), wsp<bf16>(F, WS_MVT)};
            if (PROBE_HOT == 3) { SchedHotBlk S3; S3.G = S.G; S3.c = S.c; S3.mode = 2; S3.A = S.A; S3.B = S.B; pg8::gemm_phase<EpiH, SchedHotBlk, 2, true>(F.lds, 4096, S3, E); }
            else pg8::gemm_phase<EpiH, SchedHot, 2, true>(F.lds, 4096, S, E);
        }
        if (REPS(1) == 2) {
            SchedInProj S; S.G = F.G; S.c = F.wg; S.n_extra = (l == 0) ? 32 : 0; S.XB = (const char*)(F.ws + WS_XB); S.WT = (const char*)(F.ws + WS_WINT) + (size_t)l * NH * 4096 * 2;
            S.MEMB = (const char*)(F.ws + WS_MEMB); S.WKV = (const char*)(F.ws + WS_WMKVT);
            EpiH E{wsp<bf16>(F, WS_H), wsp<bf16>(F, WS_MK), wsp<bf16>(F, WS_MVT)};
            pg8::gemm_phase<EpiH, SchedInProj, 2, true>(F.lds, 4096, S, E);
            pg8::SchedStatic S8; S8.nM = 32; S8.nN = N_F8 / (128 * F8NB); S8.G = F.G; S8.c = (F.wg + F8_ROT) % F.G; S8.A = (const char*)(F.ws + WS_X8); S8.B = (const char*)(F.ws + WS_W8) + (size_t)l * W8_LAYER;
            S8.astep = F6 ? (size_t)2 * 32 * 12288 : (size_t)256 * 4096; S8.bstep = F6 ? (size_t)F8NB * 32 * 12288 : (size_t)(128 * F8NB) * 4096;
            EpiMG<F8NB> E8{wsp<bf16>(F, WS_H)};
            pg8::gemm_phase<EpiMG<F8NB>, pg8::SchedStatic, F8NB, true, true>(F.lds, 2048, S8, E8);
        } }
        SEAM(p0);
        if (PHM(2) && IN(p0 + 1)) for (int rep = 0; rep < REPS(2); ++rep) { if (NAIVE_MASK & 2) naive_gla(F, l, (const float*)args.in[6], (const float*)args.in[7]); else for (int u = F.wg; u < 512; u += F.G) gla_a_unit(F, l, u, (const float*)args.in[6], (const float*)args.in[7]); }
        SEAM(p0 + 1);
        if (PHM(3) && IN(p0 + 2)) for (int rep = 0; rep < REPS(3); ++rep) { if (!(NAIVE_MASK & 2)) gla_scan(F); }
        SEAM(p0 + 2);
        if (PHM(4) && IN(p0 + 3)) for (int rep = 0; rep < REPS(4); ++rep) {
            if (NAIVE_MASK & 2) naive_gla_norm(F, l, (const float*)args.in[8]); else
            for (int r2 = 0; r2 < REPS(8); ++r2) for (int u = F.wg; u < 512; u += F.G) gla_c_unit(F, l, u, (const float*)args.in[8]);
            if (NAIVE_MASK & 1) naive_pool(F, l, (const float*)args.in[4], (const float*)args.in[5]); else
            for (int r2 = 0; r2 < REPS(9); ++r2) for (int u = F.wg; u < 256; u += F.G) pool_unit(F, l, u, (const float*)args.in[5]);
            __syncthreads();
            if (NAIVE_MASK & 4) naive_swa(F, l, (const float*)args.in[9]); else
            for (int r2 = 0; r2 < REPS(10); ++r2) for (int u = F.wg; u < 1024; u += F.G) swa_unit(F, l, u, (const float*)args.in[9]);
            __syncthreads();
            if (NAIVE_MASK & 8) naive_mem(F, l); else
            for (int r2 = 0; r2 < REPS(11); ++r2) for (int u = F.wg; u < 256; u += F.G) mem_unit(F, l, u);
            __syncthreads();
        }
        SEAM(p0 + 3);
        if (PHM(5) && IN(p0 + 4)) { {
            pg8::SchedStatic S; S.nM = 32; S.nN = 32; S.G = F.G; S.c = F.wg; S.A = (const char*)(F.ws + WS_OB); S.B = (const char*)(F.ws + WS_WBRT) + (size_t)l * 4096 * 4096 * 2;
            S.astep = (size_t)256 * 4096 * 2; S.bstep = (size_t)128 * 4096 * 2;
            EpiGate E{wsp<bf16>(F, WS_H), wsp<bf16>(F, WS_YB)};
            if (BLK_GATE) { pg8::SchedStaticBlk SB; (pg8::SchedStatic&)SB = S; pg8::gemm_phase<EpiGate, pg8::SchedStaticBlk, 1, true>(F.lds, 4096, SB, E); } else
            pg8::gemm_phase<EpiGate, pg8::SchedStatic, 1, true>(F.lds, 4096, S, E);
        }
        if (REPS(5) == 2) {
            pg8::SchedStatic S; S.nM = 32; S.nN = 32; S.G = F.G; S.c = F.wg; S.A = (const char*)(F.ws + WS_OB); S.B = (const char*)(F.ws + WS_WBRT) + (size_t)l * 4096 * 4096 * 2;
            S.astep = (size_t)256 * 4096 * 2; S.bstep = (size_t)128 * 4096 * 2;
            EpiGate E{wsp<bf16>(F, WS_H), wsp<bf16>(F, WS_YB)};
            if (BLK_GATE) { pg8::SchedStaticBlk SB; (pg8::SchedStatic&)SB = S; pg8::gemm_phase<EpiGate, pg8::SchedStaticBlk, 1, true>(F.lds, 4096, SB, E); } else
            pg8::gemm_phase<EpiGate, pg8::SchedStatic, 1, true>(F.lds, 4096, S, E);
        } }
        SEAM(p0 + 4);
        if (PHM(6) && IN(p0 + 5)) { {
            pg8::SchedStatic S; S.nM = 32; S.nN = 16; S.G = F.G; S.c = F.wg; S.A = (const char*)(F.ws + WS_YB); S.B = (const char*)(F.ws + WS_WOUTT) + (size_t)l * 4096 * 4096 * 2;
            S.astep = (size_t)256 * 4096 * 2; S.bstep = (size_t)256 * 4096 * 2;
            EpiRes E{l == 0 ? (const float*)args.in[0] : (const float*)F.out, wsp<float>(F, WS_Z)};
            if (BLK_OUT) { pg8::SchedStaticBlk SB; (pg8::SchedStatic&)SB = S; pg8::gemm_phase<EpiRes, pg8::SchedStaticBlk, 2, true>(F.lds, 4096, SB, E); } else
            pg8::gemm_phase<EpiRes, pg8::SchedStatic, 2, true>(F.lds, 4096, S, E);
        }
        if (REPS(6) == 2) {
            pg8::SchedStatic S; S.nM = 32; S.nN = 16; S.G = F.G; S.c = F.wg; S.A = (const char*)(F.ws + WS_YB); S.B = (const char*)(F.ws + WS_WOUTT) + (size_t)l * 4096 * 4096 * 2;
            S.astep = (size_t)256 * 4096 * 2; S.bstep = (size_t)256 * 4096 * 2;
            EpiRes E{l == 0 ? (const float*)args.in[0] : (const float*)F.out, wsp<float>(F, WS_Z)};
            if (BLK_OUT) { pg8::SchedStaticBlk SB; (pg8::SchedStatic&)SB = S; pg8::gemm_phase<EpiRes, pg8::SchedStaticBlk, 2, true>(F.lds, 4096, SB, E); } else
            pg8::gemm_phase<EpiRes, pg8::SchedStatic, 2, true>(F.lds, 4096, S, E);
        } }
        SEAM(p0 + 5);
        if (PHM(7) && IN(p0 + 6)) for (int rep = 0; rep < REPS(7); ++rep) { ln_phase(F, l, (const float*)args.in[13], (const float*)args.in[14]); }
        SEAM(p0 + 6);
}


__global__ void __launch_bounds__(NTHR, 2) mk_fwd(Args args) {
    extern __shared__ __attribute__((aligned(16))) unsigned char lds_raw[];
    Frame F;
    F.lds = (LAS unsigned char*)lds_raw;
    F.tid = threadIdx.x; F.lane = F.tid & 63; F.wave = __builtin_amdgcn_readfirstlane(F.tid >> 6); F.G = gridDim.x; F.wg = blockIdx.x;
    F.out = args.out; F.ws = args.ws;
    volatile LAS unsigned* MISC = (volatile LAS unsigned*)(F.lds + MISC_OFF);
    for (int u = F.tid; u < (LDS_BYTES - LDSCTL_OFF) / 4; u += NTHR) ((LAS unsigned*)(F.lds + LDSCTL_OFF))[u] = 0u;
    __syncthreads();
    unsigned* barw = (unsigned*)(F.ws + WS_CTL) + CW_BAR;
    XcdBarrier bar; bar.bar = barw; bar.x = 0; bar.st = nullptr;
    const int lo = args.ph_lo, hi = args.ph_hi;
    if (hi - lo > 1) bar = xcd_barrier_post(barw, MISC + 8);

    if (PHM(0) && IN(0)) for (int rep = 0; rep < REPS(0); ++rep) { prologue(F, (const float*)args.in[0], (const float*)args.in[1], (const int*)args.in[2], (const float*)args.in[3], (const float*)args.in[4], (const float*)args.in[10], (const float*)args.in[11], (const float*)args.in[12]); }
    SEAM(0);
    layer_body<0>(F, args, lo, hi, bar);
#if PROBE_CLK
    const long long pc0 = clock64(), pw0 = wall_clock64();
#endif
    layer_body<1>(F, args, lo, hi, bar);
#if PROBE_CLK
    if (blockIdx.x == 0 && threadIdx.x == 0) {
        const long long dc = clock64() - pc0, dw = wall_clock64() - pw0; const long long fmhz = dw > 0 ? 100 * dc / dw : 0; const long long ticks = (fmhz - 1000) * 100;
        if (ticks > 0 && ticks < 300000) { const long long s0 = wall_clock64(); while (wall_clock64() - s0 < ticks) __builtin_amdgcn_s_sleep(8); }
    }
#endif
#if PROBE_T
    if (blockIdx.x == 0 && threadIdx.x == 0) {
        const unsigned acc_t = ((volatile LAS unsigned*)(F.lds + MISC_OFF + 128))[PROBE_T]; const long long ticks = 8ll * acc_t;
        if (ticks > 0 && ticks < 400000) { const long long s0 = wall_clock64(); while (wall_clock64() - s0 < ticks) __builtin_amdgcn_s_sleep(8); }
    }
#endif
#undef IN
#undef SEAM
}

extern "C" void kernel_launch(void* const* d_in, const int* in_sizes, int n_in, void* d_out, int out_size, void* d_ws, size_t ws_size, hipStream_t stream) {
    static int grid = 0;
    if (grid == 0) {
        if (n_in != 15 || out_size != MTOK * DM || ws_size < WS_END) { fprintf(stderr, "kernel_launch: unexpected sizes (n_in %d, out %d, ws %zu); nothing launched\n", n_in, out_size, ws_size); grid = -1; return; }
        int dev = 0, cus = 0, per_cu = 0;
        if (hipGetDevice(&dev) != hipSuccess || hipDeviceGetAttribute(&cus, hipDeviceAttributeMultiprocessorCount, dev) != hipSuccess) { grid = -1; return; }
        if (hipFuncSetAttribute((const void*)mk_fwd, hipFuncAttributeMaxDynamicSharedMemorySize, LDS_BYTES) != hipSuccess) { fprintf(stderr, "kernel_launch: hipFuncSetAttribute failed\n"); grid = -1; return; }
        if (hipOccupancyMaxActiveBlocksPerMultiprocessor(&per_cu, (const void*)mk_fwd, NTHR, LDS_BYTES) != hipSuccess || per_cu < 1) fprintf(stderr, "kernel_launch: occupancy query says %d\n", per_cu);
        (void)hipGetLastError();
        grid = cus;
    }
    if (grid < 0) return;
    (void)hipMemsetAsync((char*)d_ws + WS_CTL, 0, CTL_ZERO_BYTES, stream);
    Args a{};
    for (int i = 0; i < 15; ++i) a.in[i] = d_in[i];
    a.out = (float*)d_out; a.ws = (unsigned char*)d_ws;
#if MK_PER_PHASE
    for (int p = 0; p < N_PHASES; ++p) { a.ph_lo = p; a.ph_hi = p + 1; hipLaunchKernelGGL(mk_fwd, dim3(grid), dim3(NTHR), LDS_BYTES, stream, a); }
#else
    a.ph_lo = 0; a.ph_hi = N_PHASES;
    hipLaunchKernelGGL(mk_fwd, dim3(grid), dim3(NTHR), LDS_BYTES, stream, a);
#endif
}
```

```cpp
#include <hip/hip_runtime.h>
#include <cstdio>
#include <cstdint>

#ifndef F8ASM1
#define F8ASM1 0
#endif
#ifndef F8NB
#define F8NB 2
#endif
#ifndef MK_PER_PHASE
#define MK_PER_PHASE 0
#endif

#define DI __device__ __forceinline__
#define LAS __attribute__((address_space(3)))
#define GAS __attribute__((address_space(1)))
typedef unsigned short bf16;
typedef short bf16x8 __attribute__((ext_vector_type(8)));
typedef short s16x4 __attribute__((ext_vector_type(4)));
typedef short v4i16_t __attribute__((ext_vector_type(4)));
typedef float f32x4 __attribute__((ext_vector_type(4)));
typedef float f32x2 __attribute__((ext_vector_type(2)));
typedef unsigned u32x4 __attribute__((ext_vector_type(4)));
typedef unsigned u32x2 __attribute__((ext_vector_type(2)));

constexpr int BATCH = 2, SEQ = 4096, DM = 4096, MTOK = BATCH * SEQ, DEPTH = 2;
constexpr int D_IN = 25872, NH = 26112;
constexpr int BW = 1024;
constexpr int MEMLEN = 256;
constexpr int C_PU = 0, C_PG = 1024, C_GQ = 2048, C_GK = 2560, C_GV = 3072, C_GG = 4096, C_SQ = 5120, C_SK = 6144, C_SV = 6272, C_SG = 6400, C_XQ = 7424, C_XG = 8448, C_MG = 9472, C_LR = 25856;
constexpr float LN_EPS = 1e-5f;
constexpr float DN_ALPHA = 1.41421356237309515f;

constexpr size_t MiB = 1u << 20;
constexpr size_t WS_CTL = 0, CTL_ZERO_BYTES = 1 * MiB;
constexpr size_t WS_ROPE = 1 * MiB;
constexpr size_t WS_WPOOLT = 2 * MiB;
constexpr size_t WS_MEMB = 4 * MiB;
constexpr size_t WS_MK = 8 * MiB;
constexpr size_t WS_MVT = 10 * MiB;
constexpr size_t WS_DEC = 12 * MiB;
constexpr size_t WS_WMKVT = 16 * MiB;
constexpr size_t WS_WBRT = 48 * MiB;
constexpr size_t WS_WOUTT = 112 * MiB;
constexpr size_t WS_XB = 176 * MiB;
constexpr size_t WS_OB = 240 * MiB;
constexpr size_t WS_YB = 304 * MiB;
constexpr size_t WS_GU = 368 * MiB;
constexpr size_t WS_GS = 432 * MiB;
constexpr size_t WS_GB = 464 * MiB;
constexpr size_t WS_WINT = 512 * MiB;
constexpr size_t WS_H = 928 * MiB;
constexpr size_t WS_Z = 1336 * MiB;
constexpr size_t WS_X8 = 1464 * MiB;
constexpr size_t WS_W8 = 1496 * MiB;
constexpr size_t WS_END = 1660 * MiB;
constexpr int C_F8 = C_SQ, N_F8 = C_LR - C_F8;
#ifndef STAGE_LATE
#define STAGE_LATE 0
#endif
#ifndef PRO_NFAST
#define PRO_NFAST 1
#endif
#ifndef BLK_GATE
#define BLK_GATE 1
#endif
#ifndef BLK_OUT
#define BLK_OUT 1
#endif
#ifndef F6_FIRST
#define F6_FIRST 1
#endif
#ifndef F8_ROT
#define F8_ROT 64
#endif
#ifndef F6
#define F6 1
#endif
constexpr size_t W8_LAYER = F6 ? (size_t)(N_F8 / 128) * 32 * 12288 : (size_t)N_F8 * 4096;
constexpr float X8_SCALE = F6 ? 2.0f : 16.0f, W8_SCALE = F6 ? 128.0f : 2048.0f, MG_DESCALE = 1.0f / (X8_SCALE * W8_SCALE);
constexpr int CW_BAR = 4096;

constexpr int RING_BYTES = 131072;
constexpr int THIN_BYTES = 141312;
constexpr int LDSCTL_OFF = THIN_BYTES, MISC_OFF = LDSCTL_OFF + 320;
constexpr int LDS_BYTES = 147456;
constexpr int NWAVES = 8, NTHR = 512;

DI float bf2f(unsigned v) { return __builtin_bit_cast(float, v << 16); }
DI unsigned f2bf(float f) { unsigned u = __builtin_bit_cast(unsigned, f); return (u + 0x7fffu + ((u >> 16) & 1u)) >> 16; }
typedef float f32x2_t __attribute__((ext_vector_type(2))); typedef __bf16 bf16x2_t __attribute__((ext_vector_type(2)));
DI unsigned cvt_pk_bf16(float lo, float hi) { const f32x2_t v = {lo, hi}; const bf16x2_t b = __builtin_convertvector(v, bf16x2_t); return __builtin_bit_cast(unsigned, b); }
DI unsigned pk2(float lo, float hi) { return cvt_pk_bf16(lo, hi); }
DI float fast_sigmoid(float v) { return __builtin_amdgcn_rcpf(1.0f + __builtin_amdgcn_exp2f(-1.44269504089f * v)); }
DI void unpack8(const u32x4 w, float (&f)[8]) {
    f[0] = bf2f(w.x & 0xffffu); f[1] = bf2f(w.x >> 16); f[2] = bf2f(w.y & 0xffffu); f[3] = bf2f(w.y >> 16);
    f[4] = bf2f(w.z & 0xffffu); f[5] = bf2f(w.z >> 16); f[6] = bf2f(w.w & 0xffffu); f[7] = bf2f(w.w >> 16);
}
DI u32x4 pack8(const float (&f)[8]) { u32x4 w; w.x = pk2(f[0], f[1]); w.y = pk2(f[2], f[3]); w.z = pk2(f[4], f[5]); w.w = pk2(f[6], f[7]); return w; }
DI float clamp448(float v) { return fminf(fmaxf(v, -448.0f), 448.0f); }
DI unsigned pk4_fp8(float a, float b, float c, float d) {
    int w = 0; w = __builtin_amdgcn_cvt_pk_fp8_f32(clamp448(a), clamp448(b), w, false); w = __builtin_amdgcn_cvt_pk_fp8_f32(clamp448(c), clamp448(d), w, true); return (unsigned)w; }
typedef int v8i32 __attribute__((ext_vector_type(8)));
typedef int v6i32 __attribute__((ext_vector_type(6)));
typedef int v4i32 __attribute__((ext_vector_type(4)));
typedef unsigned u32x6 __attribute__((ext_vector_type(6)));
typedef float f32x16 __attribute__((ext_vector_type(16)));
DI void pk32_fp6(const float (&f)[32], u32x4& lo, u32x4& hi) {
    f32x16 a, b;
#pragma unroll
    for (int i = 0; i < 16; ++i) { a[i] = f[i]; b[i] = f[16 + i]; }
    const u32x6 r = __builtin_amdgcn_cvt_scalef32_2xpk16_fp6_f32(a, b, 1.0f);
    lo.x = r[0]; lo.y = r[1]; lo.z = r[2]; lo.w = r[3]; hi.x = r[4]; hi.y = r[5]; hi.z = 0u; hi.w = 0u;
}
DI f32x4 mma16(bf16x8 a, bf16x8 b, f32x4 c) { return __builtin_amdgcn_mfma_f32_16x16x32_bf16(a, b, c, 0, 0, 0); }
DI bf16x8 frag_lds(const LAS bf16* img, int ld, int idx0, int k0, int lane) { return *(const LAS bf16x8*)(img + (idx0 + (lane & 15)) * ld + k0 + 8 * (lane >> 4)); }
DI bf16x8 frag_glb(const bf16* img, size_t ld, int idx0, int k0, int lane) { return *(const bf16x8*)(img + (size_t)(idx0 + (lane & 15)) * ld + k0 + 8 * (lane >> 4)); }
DI s16x4 tr4(const LAS bf16* p) { return __builtin_bit_cast(s16x4, __builtin_amdgcn_ds_read_tr16_b64_v4i16((LAS v4i16_t*)p)); }
DI bf16x8 frag_tr(const LAS bf16* img, int ld, int k0, int idx0, int lane) {
    const int g = lane >> 4, q = (lane >> 2) & 3, p = lane & 3;
    const LAS bf16* a0 = img + (k0 + 8 * g + q) * ld + idx0 + 4 * p;
    const s16x4 lo = tr4(a0), hi = tr4(a0 + 4 * ld);
    return __builtin_shufflevector(lo, hi, 0, 1, 2, 3, 4, 5, 6, 7);
}
DI float wave_sum(float v) {
#pragma unroll
    for (int o = 1; o < 64; o <<= 1) v += __shfl_xor(v, o);
    return v;
}
#define LDS_WAIT() asm volatile("s_waitcnt lgkmcnt(0)" ::: "memory")
#define VM_WAIT() asm volatile("s_waitcnt vmcnt(0)" ::: "memory")

namespace pg8 {
constexpr int BM = 256, BK = 64, HALF = 128, HTB = HALF * BK * 2, STAGE_BYTES = 8 * HTB, NXCD = 8, WGM = 8;
__host__ __device__ __forceinline__ int lds_byte(int r, int c) { const int st = (r >> 4) * 2 + (c >> 5), rr = r & 15, cc = c & 31, ob = rr * 64 + cc * 2; return st * 1024 + (ob ^ (((ob >> 9) & 1) << 5)); }
__host__ __device__ __forceinline__ void stage_rc(int b, int& R, int& C) { const int st = b / 1024, sb = b % 1024, swz = sb ^ (((sb >> 9) & 1) << 5); R = (st >> 1) * 16 + swz / 64; C = (st & 1) * 32 + (swz % 64) / 2; }
__host__ __device__ __forceinline__ int perm32(int rho) { const int n = rho >> 4, i = rho & 15; return 8 * (i >> 2) + 4 * n + (i & 3); }
__host__ __device__ __forceinline__ int invperm32(int v) { return 16 * ((v >> 2) & 1) + 4 * (v >> 3) + (v & 3); }
template <bool PERM> __host__ __device__ __forceinline__ size_t blk_off(int row, int k, int NT) {
    const int r = PERM ? ((row & ~31) + invperm32(row & 31)) : row;
    return ((size_t)(r >> 7) * NT + (k >> 6)) * 16384 + lds_byte(r & 127, k & 63);
}
__host__ __device__ __forceinline__ void f6_off(int row, int step, int q, size_t& lo, size_t& hi) {
    const int ht = row >> 7, rb = (row >> 4) & 7, rr = row & 15;
    const size_t base = ((size_t)ht * 32 + step) * 12288;
    lo = base + rb * 1024 + lds_byte(rr, q * 8);
    hi = base + 8192 + rb * 512 + q * 128 + rr * 8;
}

struct Unit { int pm, pn, gi; };

DI void static_tile(int L, int nM, int nN, int& pm, int& pn) {
    const int nwg = nM * nN; int wgid = L;
    { const int q = nwg / NXCD, r = nwg % NXCD, xcd = wgid % NXCD, off = wgid / NXCD; wgid = (xcd < r ? xcd * (q + 1) : r * (q + 1) + (xcd - r) * q) + off; }
    const int nig = WGM * nN, gid = wgid / nig, fm = gid * WGM, gsz = (nM - fm) < WGM ? (nM - fm) : WGM;
    pm = fm + ((wgid % nig) % gsz); pn = (wgid % nig) / gsz;
}
struct SchedStatic {
    static constexpr bool BLK = false;
    int nM, nN, G, c; const char* A; const char* B; size_t astep, bstep;
    DI bool next(int i, Unit& u) const { const long L = (long)i * G + c; if (L >= (long)nM * nN) return false; static_tile((int)L, nM, nN, u.pm, u.pn); u.gi = 0; return true; }
    DI const char* abase(const Unit& u) const { return A + (size_t)u.pm * astep; }
    DI const char* bbase(const Unit& u) const { return B + (size_t)u.pn * bstep; }
};
struct SchedStaticBlk : SchedStatic { static constexpr bool BLK = true; };

template <class Epi, class Sched, int NB, bool ALIGN_EPI, bool F8 = false>
DI void gemm_phase(LAS unsigned char* lds, const int K, const Sched& S, const Epi& E) {
    const int tid = threadIdx.x, wid = __builtin_amdgcn_readfirstlane(tid >> 6), lane = tid & 63, wr = wid >> 2, wc = wid & 3, fr = lane & 15, fq = lane >> 4;
    const int nt = K / BK;
    constexpr bool FP6 = F8 && (F6 != 0);
    unsigned voffA[2], voffB[2];
#pragma unroll
    for (int i = 0; i < 2; ++i) { int R, C; stage_rc(tid * 16 + i * 8192, R, C); const int Rb = Epi::PERM ? ((R & ~31) + perm32(R & 31)) : R;
        voffA[i] = (unsigned)(R * K + C) * 2u; voffB[i] = (unsigned)(Rb * K + C) * 2u;
        if constexpr (FP6) { voffA[i] = (unsigned)(((wid & 3) + 4 * i) * 1024 + lane * 16); voffB[i] = voffA[i]; }
        if constexpr (Sched::BLK) { voffA[i] = (unsigned)((wid + 8 * i) * 1024 + lane * 16); voffB[i] = voffA[i]; } }
    const unsigned voffS = (unsigned)((8 + (wid & 3)) * 1024 + lane * 16);
    const size_t kstep = FP6 ? (size_t)12288 : (Sched::BLK ? (size_t)16384 : (size_t)(BK * 2));
    const size_t hstep = FP6 ? (size_t)nt * 12288 : (Sched::BLK ? (size_t)nt * 16384 : (size_t)HALF * K * 2);
    const unsigned ldsw = (unsigned)wid * 1024u;
    const int swz6 = lds_byte(fr, fq * 8), hof6 = fq * 128 + fr * 8;
    const int aoff6 = wr * 4096 + swz6, ahi6 = 8192 + wr * 2048 + hof6, boff6 = wc * 2048 + swz6, bhi6 = 8192 + wc * 1024 + hof6;
    const int aoff = lds_byte(wr * 64 + fr, fq * 8), boff = lds_byte(wc * 32 + fr, fq * 8);
    constexpr int KOFF = 1024;
    const unsigned one_scale = 0x7f7f7f7fu;
#define PG8_SA(b, h) (((b) * 2 + (h)) * HTB)
#define PG8_SB(b, h) ((4 + (b) * 2 + (h)) * HTB)
#define PG8_STAGE(bufoff, gbase, voff) do { if constexpr (FP6) { \
        if ((wid >> 2) != (((bufoff) / HTB) & 1)) { _Pragma("unroll") for (int _i = 0; _i < 2; ++_i) \
            __builtin_amdgcn_global_load_lds((const unsigned*)((const char*)(gbase) + voffA[_i]), (LAS unsigned*)(lds + (bufoff) + (wid & 3) * 1024 + _i * 4096), 16, 0, 0); } \
        else __builtin_amdgcn_global_load_lds((const unsigned*)((const char*)(gbase) + voffS), (LAS unsigned*)(lds + (bufoff) + 8192 + (wid & 3) * 1024), 16, 0, 0); \
    } else { _Pragma("unroll") for (int _i = 0; _i < 2; ++_i) \
        __builtin_amdgcn_global_load_lds((const unsigned*)((const char*)(gbase) + (voff)[_i]), (LAS unsigned*)(lds + (bufoff) + ldsw + _i * 8192), 16, 0, 0); } } while (0)
#define PG8_W64(p) ({ const s16x4 _v = *(const volatile LAS s16x4*)(p); __builtin_shufflevector(_v, _v, 0, 1, 2, 3, -1, -1, -1, -1); })
#define PG8_LDA(dst, b, h) do { if constexpr (FP6) { _Pragma("unroll") for (int m = 0; m < 4; ++m) { dst[m][0] = *(const LAS bf16x8*)(lds + PG8_SA(b, h) + aoff6 + m * 1024); dst[m][1] = PG8_W64(lds + PG8_SA(b, h) + ahi6 + m * 512); } } \
    else { _Pragma("unroll") for (int m = 0; m < 4; ++m) _Pragma("unroll") for (int k = 0; k < 2; ++k) dst[m][k] = *(const LAS bf16x8*)(lds + PG8_SA(b, h) + aoff + m * 2048 + k * KOFF); } } while (0)
#define PG8_LDB(dst, b, h) do { if constexpr (FP6) { _Pragma("unroll") for (int n = 0; n < 2; ++n) { dst[n][0] = *(const LAS bf16x8*)(lds + PG8_SB(b, h) + boff6 + n * 1024); dst[n][1] = PG8_W64(lds + PG8_SB(b, h) + bhi6 + n * 512); } } \
    else { _Pragma("unroll") for (int n = 0; n < 2; ++n) _Pragma("unroll") for (int k = 0; k < 2; ++k) dst[n][k] = *(const LAS bf16x8*)(lds + PG8_SB(b, h) + boff + n * 2048 + k * KOFF); } } while (0)
#define PG8_CAT6(x) __builtin_shufflevector(__builtin_bit_cast(v4i32, (x)[0]), __builtin_bit_cast(v4i32, (x)[1]), 0, 1, 2, 3, 4, 5)
#define PG8_CAT(x) __builtin_bit_cast(v8i32, __builtin_shufflevector((x)[0], (x)[1], 0, 1, 2, 3, 4, 5, 6, 7, 8, 9, 10, 11, 12, 13, 14, 15))
#define PG8_MMA(ai, bj, At, Bt) do { __builtin_amdgcn_s_setprio(1); _Pragma("unroll") for (int m = 0; m < 4; ++m) _Pragma("unroll") for (int n = 0; n < 2; ++n) { \
        if constexpr (F8 && NB == 1 && !F8ASM1) acc[ai][bj][m][n] = __builtin_amdgcn_mfma_scale_f32_16x16x128_f8f6f4(PG8_CAT(Bt[n]), PG8_CAT(At[m]), acc[ai][bj][m][n], 0, 0, 0, 0x7f7f7f7f, 0, 0x7f7f7f7f); \
        else if constexpr (F8 && F6 != 0) { asm volatile("s_nop 1\n\tv_mfma_scale_f32_16x16x128_f8f6f4 %0, %1, %2, %0, %3, %3 op_sel_hi:[0,0,0] cbsz:2 blgp:2" : "+v"(acc[ai][bj][m][n]) : "v"(PG8_CAT6(Bt[n])), "v"(PG8_CAT6(At[m])), "v"(one_scale)); } \
        else if constexpr (F8) { asm volatile("s_nop 1\n\tv_mfma_scale_f32_16x16x128_f8f6f4 %0, %1, %2, %0, %3, %3 op_sel_hi:[0,0,0]" : "+v"(acc[ai][bj][m][n]) : "v"(PG8_CAT(Bt[n])), "v"(PG8_CAT(At[m])), "v"(one_scale)); } \
        else { _Pragma("unroll") for (int k = 0; k < 2; ++k) acc[ai][bj][m][n] = __builtin_amdgcn_mfma_f32_16x16x32_bf16(Bt[n][k], At[m][k], acc[ai][bj][m][n], 0, 0, 0); } } \
        __builtin_amdgcn_s_setprio(0); } while (0)
#define PG8_WAIT_V(n) asm volatile("s_waitcnt vmcnt(" #n ")" ::: "memory")
#define PG8_WAIT_L(n) asm volatile("s_waitcnt lgkmcnt(" #n ")" ::: "memory")
#define PG8_BAR __builtin_amdgcn_s_barrier()
#define PG8_SCHED __builtin_amdgcn_sched_barrier(0)
#define PG8_WAIT_LA() do { if constexpr (FP6) PG8_WAIT_V(4); else PG8_WAIT_V(6); } while (0)
#define PG8_WAIT_LB() do { if constexpr (FP6) PG8_WAIT_V(1); else PG8_WAIT_V(2); } while (0)
#define PG8_WAIT_MAIN() do { if constexpr (FP6) PG8_WAIT_V(6); else PG8_WAIT_V(8); } while (0)
    Unit cur, nxt; int ui = 0;
    if (!S.next(0, cur)) return;
    f32x4 acc[2][NB][4][2];
    f32x4 yac[2][4][2];
#pragma unroll
    for (int a = 0; a < 2; ++a)
#pragma unroll
        for (int m = 0; m < 4; ++m)
#pragma unroll
            for (int n = 0; n < 2; ++n) { yac[a][m][n] = (f32x4){0.f, 0.f, 0.f, 0.f};
#pragma unroll
                for (int b = 0; b < NB; ++b) acc[a][b][m][n] = (f32x4){0.f, 0.f, 0.f, 0.f}; }
    bf16x8 At[4][2], B0[2][2], B1[2][2];
    const char* cA = S.abase(cur); const char* cB = S.bbase(cur);
    if constexpr (NB == 2) {
        PG8_STAGE(PG8_SB(0, 0), cB, voffB); PG8_STAGE(PG8_SB(0, 1), cB + hstep, voffB); PG8_STAGE(PG8_SA(0, 0), cA, voffA); PG8_STAGE(PG8_SA(0, 1), cA + hstep, voffA);
        if (wr == 1) PG8_BAR;
        if constexpr (FP6) PG8_WAIT_V(1); else PG8_WAIT_V(2);
        PG8_BAR;
        PG8_STAGE(PG8_SB(1, 0), cB + kstep, voffB); PG8_STAGE(PG8_SA(1, 0), cA + kstep, voffA); PG8_STAGE(PG8_SB(1, 1), cB + hstep + kstep, voffB);
        if constexpr (FP6) PG8_WAIT_V(4); else PG8_WAIT_V(6);
        PG8_BAR;
    } else {
        PG8_STAGE(PG8_SB(0, 0), cB, voffB); PG8_STAGE(PG8_SA(0, 0), cA, voffA); PG8_STAGE(PG8_SA(0, 1), cA + hstep, voffA);
        if (wr == 1) PG8_BAR;
        PG8_WAIT_V(2); PG8_BAR;
        PG8_STAGE(PG8_SB(1, 0), cB + kstep, voffB); PG8_STAGE(PG8_SA(1, 0), cA + kstep, voffA);
        PG8_WAIT_V(4); PG8_BAR;
    }
    for (;;) {
        const bool has_next = S.next(ui + 1, nxt);
        const char* nA = has_next ? S.abase(nxt) : cA; const char* nB = has_next ? S.bbase(nxt) : cB;
        for (int t = 0; t < nt; t += 2) {
            if constexpr (Epi::GATED) { if (t != 0 && (t & 15) == 0) { E.flush(acc, yac, cur, (t >> 4) - 1, wr, wc, fr, fq);
#pragma unroll
                for (int a = 0; a < 2; ++a)
#pragma unroll
                    for (int m = 0; m < 4; ++m)
#pragma unroll
                        for (int n = 0; n < 2; ++n) acc[a][0][m][n] = (f32x4){0.f, 0.f, 0.f, 0.f}; } }
            const bool last = (t == nt - 2);
            const char* a1 = cA + (size_t)(t + 1) * kstep;
            const char* a2 = last ? nA : cA + (size_t)(t + 2) * kstep; const char* b2 = last ? nB : cB + (size_t)(t + 2) * kstep;
            const char* a3 = a2 + kstep; const char* b3 = b2 + kstep;
            if constexpr (NB == 2 && STAGE_LATE != 0) {
            PG8_LDB(B0, 0, 0); PG8_LDB(B1, 0, 1); PG8_SCHED; PG8_LDA(At, 0, 0);
            PG8_WAIT_LA(); PG8_WAIT_L(0); PG8_BAR; PG8_MMA(0, 0, At, B0); PG8_MMA(0, 1, At, B1); PG8_STAGE(PG8_SA(1, 1), a1 + hstep, voffA); PG8_BAR; PG8_SCHED;
            PG8_LDA(At, 0, 1);
            PG8_WAIT_LB(); PG8_WAIT_L(0); PG8_BAR; PG8_MMA(1, 0, At, B0); PG8_MMA(1, 1, At, B1); PG8_STAGE(PG8_SB(0, 0), b2, voffB); PG8_STAGE(PG8_SB(0, 1), b2 + hstep, voffB); PG8_STAGE(PG8_SA(0, 0), a2, voffA); PG8_BAR; PG8_SCHED;
            PG8_LDB(B0, 1, 0); PG8_LDB(B1, 1, 1); PG8_SCHED; PG8_LDA(At, 1, 0);
            PG8_WAIT_LA(); PG8_WAIT_L(0); PG8_BAR; PG8_MMA(0, 0, At, B0); PG8_MMA(0, 1, At, B1); PG8_STAGE(PG8_SA(0, 1), a2 + hstep, voffA); PG8_BAR; PG8_SCHED;
            PG8_LDA(At, 1, 1);
            PG8_WAIT_LB(); PG8_WAIT_L(0); PG8_BAR; PG8_MMA(1, 0, At, B0); PG8_MMA(1, 1, At, B1); PG8_STAGE(PG8_SB(1, 0), b3, voffB); PG8_STAGE(PG8_SB(1, 1), b3 + hstep, voffB); PG8_STAGE(PG8_SA(1, 0), a3, voffA); PG8_BAR; PG8_SCHED;
            } else if constexpr (NB == 2) {
            PG8_LDB(B0, 0, 0); PG8_LDB(B1, 0, 1); PG8_SCHED; PG8_LDA(At, 0, 0); PG8_STAGE(PG8_SA(1, 1), a1 + hstep, voffA);
            PG8_WAIT_MAIN(); PG8_WAIT_L(0); PG8_BAR; PG8_MMA(0, 0, At, B0); PG8_MMA(0, 1, At, B1); PG8_BAR; PG8_SCHED;
            PG8_LDA(At, 0, 1); PG8_STAGE(PG8_SB(0, 0), b2, voffB); PG8_STAGE(PG8_SB(0, 1), b2 + hstep, voffB); PG8_STAGE(PG8_SA(0, 0), a2, voffA);
            PG8_WAIT_MAIN(); PG8_WAIT_L(0); PG8_BAR; PG8_MMA(1, 0, At, B0); PG8_MMA(1, 1, At, B1); PG8_BAR; PG8_SCHED;
            PG8_LDB(B0, 1, 0); PG8_LDB(B1, 1, 1); PG8_SCHED; PG8_LDA(At, 1, 0); PG8_STAGE(PG8_SA(0, 1), a2 + hstep, voffA);
            PG8_WAIT_MAIN(); PG8_WAIT_L(0); PG8_BAR; PG8_MMA(0, 0, At, B0); PG8_MMA(0, 1, At, B1); PG8_BAR; PG8_SCHED;
            PG8_LDA(At, 1, 1); PG8_STAGE(PG8_SB(1, 0), b3, voffB); PG8_STAGE(PG8_SB(1, 1), b3 + hstep, voffB); PG8_STAGE(PG8_SA(1, 0), a3, voffA);
            PG8_WAIT_MAIN(); PG8_WAIT_L(0); PG8_BAR; PG8_MMA(1, 0, At, B0); PG8_MMA(1, 1, At, B1); PG8_BAR; PG8_SCHED;
            } else {
            PG8_LDB(B0, 0, 0); PG8_SCHED; PG8_LDA(At, 0, 0); PG8_STAGE(PG8_SA(1, 1), a1 + hstep, voffA);
            PG8_WAIT_V(6); PG8_WAIT_L(0); PG8_BAR; PG8_MMA(0, 0, At, B0); PG8_BAR; PG8_SCHED;
            PG8_LDA(At, 0, 1); PG8_STAGE(PG8_SB(0, 0), b2, voffB); PG8_STAGE(PG8_SA(0, 0), a2, voffA);
            PG8_WAIT_V(6); PG8_WAIT_L(0); PG8_BAR; PG8_MMA(1, 0, At, B0); PG8_BAR; PG8_SCHED;
            PG8_LDB(B0, 1, 0); PG8_SCHED; PG8_LDA(At, 1, 0); PG8_STAGE(PG8_SA(0, 1), a2 + hstep, voffA);
            PG8_WAIT_V(6); PG8_WAIT_L(0); PG8_BAR; PG8_MMA(0, 0, At, B0); PG8_BAR; PG8_SCHED;
            PG8_LDA(At, 1, 1); PG8_STAGE(PG8_SB(1, 0), b3, voffB); PG8_STAGE(PG8_SA(1, 0), a3, voffA);
            PG8_WAIT_V(6); PG8_WAIT_L(0); PG8_BAR; PG8_MMA(1, 0, At, B0); PG8_BAR; PG8_SCHED;
            }
        }
        if constexpr (F8) {
            asm volatile("s_nop 15\n\ts_nop 15" ::: "memory");
#pragma unroll
            for (int a = 0; a < 2; ++a)
#pragma unroll
                for (int b = 0; b < NB; ++b)
#pragma unroll
                    for (int m = 0; m < 4; ++m)
#pragma unroll
                        for (int n = 0; n < 2; ++n) asm volatile("" : "+v"(acc[a][b][m][n]));
        }
        if constexpr (ALIGN_EPI) { if (wr == 0) PG8_BAR; }
        if constexpr (Epi::GATED) { E.finish(acc, yac, cur, wr, wc, fr, fq);
#pragma unroll
            for (int a = 0; a < 2; ++a)
#pragma unroll
                for (int m = 0; m < 4; ++m)
#pragma unroll
                    for (int n = 0; n < 2; ++n) yac[a][m][n] = (f32x4){0.f, 0.f, 0.f, 0.f};
        } else { E(acc, cur, wr, wc, fr, fq); }
        if (!has_next) break;
#pragma unroll
        for (int a = 0; a < 2; ++a)
#pragma unroll
            for (int b = 0; b < NB; ++b)
#pragma unroll
                for (int m = 0; m < 4; ++m)
#pragma unroll
                    for (int n = 0; n < 2; ++n) acc[a][b][m][n] = (f32x4){0.f, 0.f, 0.f, 0.f};
        cur = nxt; cA = nA; cB = nB; ++ui;
        if constexpr (ALIGN_EPI) { if (wr == 1) PG8_BAR; }
    }
    PG8_WAIT_V(0);
    if constexpr (!ALIGN_EPI) { if (wr == 0) PG8_BAR; }
    PG8_BAR;
#undef PG8_SA
#undef PG8_SB
#undef PG8_STAGE
#undef PG8_LDA
#undef PG8_LDB
#undef PG8_MMA
#undef PG8_CAT
#undef PG8_WAIT_V
#undef PG8_WAIT_L
#undef PG8_BAR
#undef PG8_SCHED
#undef PG8_WAIT_MAIN
}
}

#define XB_TMO      128
#define XB_XCNT(j)  (256  + 64 * (j))
#define XB_XSUB(j)  (1280 + 64 * (j))
#define XB_XGEN(j)  (2304 + 64 * (j))
#define XB_TOP      3328
#define XB_TOPGEN   3392
#define XCD_BAR_WORDS 3456
#define XB_SPIN_CAP (1u << 18)
DI unsigned xb_ld(unsigned* p)              { return __hip_atomic_load(p, __ATOMIC_RELAXED, __HIP_MEMORY_SCOPE_AGENT); }
DI unsigned xb_add(unsigned* p, unsigned v) { return __hip_atomic_fetch_add(p, v, __ATOMIC_RELAXED, __HIP_MEMORY_SCOPE_AGENT); }
DI unsigned xb_xcc_id() { return (unsigned)__builtin_amdgcn_s_getreg((3 << 11) | 20) & 0xFu; }
#define XB_SPIN(cond, bar) do { unsigned _sp = 0; while (cond) { __builtin_amdgcn_s_sleep(1); \
    if ((++_sp & 255u) == 0u) { if (xb_ld(&(bar)[XB_TMO])) break; if (_sp > XB_SPIN_CAP) { atomicAdd(&(bar)[XB_TMO], 1u); break; } } } } while (0)
struct XcdBarrier { unsigned* bar; unsigned x; volatile LAS unsigned* st; };
DI XcdBarrier xcd_barrier_post(unsigned* bar, volatile LAS unsigned* st) {
    XcdBarrier b; b.bar = bar; b.x = xb_xcc_id(); b.st = st;
    if (threadIdx.x == 0) (void)xb_add(&bar[XB_XCNT(b.x)], 1u);
    return b;
}
DI void xcd_barrier_complete(unsigned* bar, unsigned x, unsigned& nloc, unsigned& nx) {
    const unsigned G = gridDim.x * gridDim.y * gridDim.z;
    unsigned sum, cnt, mine, sp = 0u;
    for (;;) {
        sum = 0u; cnt = 0u; mine = 0u;
#pragma unroll
        for (unsigned j = 0; j < 16; ++j) { const unsigned c = xb_ld(&bar[XB_XCNT(j)]); sum += c; cnt += (c > 0u) ? 1u : 0u; mine = (j == x) ? c : mine; }
        if (sum == G) break;
        __builtin_amdgcn_s_sleep(1);
        if ((++sp & 255u) == 0u) { if (xb_ld(&bar[XB_TMO])) break; if (sp > XB_SPIN_CAP) { atomicAdd(&bar[XB_TMO], 1u); break; } }
    }
    nloc = mine > 0u ? mine : 1u; nx = cnt > 0u ? cnt : 1u;
}
DI void xcd_barrier(const XcdBarrier& b) {
    asm volatile("s_waitcnt vmcnt(0)" ::: "memory");
    __syncthreads();
    if (threadIdx.x == 0) {
        unsigned* bar = b.bar;
        __builtin_amdgcn_s_waitcnt(0);
        unsigned nloc = b.st[0], nx = b.st[1];
        if (nloc == 0u) { xcd_barrier_complete(bar, b.x, nloc, nx); b.st[0] = nloc; b.st[1] = nx; }
        const unsigned old = xb_add(&bar[XB_XSUB(b.x)], 1u);
        const unsigned gen = old / nloc;
        if (old + 1u == (gen + 1u) * nloc) {
            __builtin_amdgcn_fence(__ATOMIC_RELEASE, "agent");
            asm volatile("s_waitcnt vmcnt(0)" ::: "memory");
            const unsigned og = xb_add(&bar[XB_TOP], 1u);
            const unsigned tg = og / nx;
            if (og + 1u == (tg + 1u) * nx) xb_add(&bar[XB_TOPGEN], 1u);
            else XB_SPIN(xb_ld(&bar[XB_TOPGEN]) == tg, bar);
            __builtin_amdgcn_fence(__ATOMIC_ACQUIRE, "agent");
            xb_add(&bar[XB_XGEN(b.x)], 1u);
            asm volatile("s_waitcnt vmcnt(0)" ::: "memory");
        } else {
            XB_SPIN(xb_ld(&bar[XB_XGEN(b.x)]) == gen, bar);
            __builtin_amdgcn_fence(__ATOMIC_ACQUIRE, "agent");
            asm volatile("s_waitcnt vmcnt(0)" ::: "memory");
        }
    }
    __syncthreads();
}

struct Frame {
    LAS unsigned char* lds;
    int tid, lane, wave, G, wg;
    float* out; unsigned char* ws;
};
template <class T> DI T* wsp(const Frame& F, size_t off) { return (T*)(F.ws + off); }

struct EpiH {
    static constexpr bool PERM = true, GATED = false;
    bf16* H; bf16* MK; bf16* MVT;
    DI void operator()(const f32x4 (&acc)[2][2][4][2], const pg8::Unit& u, int wr, int wc, int fr, int fq) const {
        bf16* base = H; size_t ldc = NH; int act = 0;
        if (u.gi == 0) { const int pn = u.pn; act = ((pn >= 4 && pn < 8) || (pn >= 16 && pn < 20)) ? 1 : 0; }
        else { const int lx = (u.gi - 1) >> 1, w = (u.gi - 1) & 1; if (w == 0) { base = MK + (size_t)lx * 512 * 1024; ldc = 1024; } else { base = MVT + (size_t)lx * 1024 * 512; ldc = 512; } }
        const int row0 = u.pm * 256 + wr * 64 + fr, col0 = u.pn * 256 + wc * 32 + 8 * fq;
#pragma unroll
        for (int ai = 0; ai < 2; ++ai)
#pragma unroll
            for (int m = 0; m < 4; ++m) { bf16* rowp = base + (size_t)(row0 + ai * 128 + m * 16) * ldc + col0;
#pragma unroll
                for (int bj = 0; bj < 2; ++bj) { f32x4 v0 = acc[ai][bj][m][0], v1 = acc[ai][bj][m][1];
                    if (act != 0) {
#pragma unroll
                        for (int j = 0; j < 4; ++j) { const float s0 = fast_sigmoid(v0[j]), s1 = fast_sigmoid(v1[j]); v0[j] = (act == 1) ? v0[j] * s0 : s0; v1[j] = (act == 1) ? v1[j] * s1 : s1; } }
                    u32x4 w; w.x = cvt_pk_bf16(v0[0], v0[1]); w.y = cvt_pk_bf16(v0[2], v0[3]); w.z = cvt_pk_bf16(v1[0], v1[1]); w.w = cvt_pk_bf16(v1[2], v1[3]);
                    *(u32x4*)(rowp + bj * 128) = w; } }
    }
};
template <int NB> struct EpiMG {
    static constexpr bool PERM = true, GATED = false;
    bf16* H;
    DI void operator()(const f32x4 (&acc)[2][NB][4][2], const pg8::Unit& u, int wr, int wc, int fr, int fq) const {
        const int colu = C_F8 + u.pn * (128 * NB);
        const int act = (colu >= C_MG) ? 2 : (((colu >= C_SG && colu < C_XQ) || colu >= C_XG) ? 1 : 0);
        const int row0 = u.pm * 256 + wr * 64 + fr, col0 = colu + wc * 32 + 8 * fq;
#pragma unroll
        for (int ai = 0; ai < 2; ++ai)
#pragma unroll
            for (int m = 0; m < 4; ++m) { bf16* rowp = H + (size_t)(row0 + ai * 128 + m * 16) * NH + col0;
#pragma unroll
                for (int bj = 0; bj < NB; ++bj) { f32x4 v0 = acc[ai][bj][m][0], v1 = acc[ai][bj][m][1];
                    if (act == 2) {
#pragma unroll
                        for (int j = 0; j < 4; ++j) { v0[j] = __builtin_amdgcn_rcpf(1.0f + __builtin_amdgcn_exp2f(v0[j] * (-1.44269504089f * MG_DESCALE)));
                            v1[j] = __builtin_amdgcn_rcpf(1.0f + __builtin_amdgcn_exp2f(v1[j] * (-1.44269504089f * MG_DESCALE))); }
                    } else if (act == 1) {
#pragma unroll
                        for (int j = 0; j < 4; ++j) { const float a0 = v0[j] * MG_DESCALE, a1 = v1[j] * MG_DESCALE; v0[j] = a0 * fast_sigmoid(a0); v1[j] = a1 * fast_sigmoid(a1); }
                    } else {
#pragma unroll
                        for (int j = 0; j < 4; ++j) { v0[j] *= MG_DESCALE; v1[j] *= MG_DESCALE; } }
                    u32x4 w; w.x = cvt_pk_bf16(v0[0], v0[1]); w.y = cvt_pk_bf16(v0[2], v0[3]); w.z = cvt_pk_bf16(v1[0], v1[1]); w.w = cvt_pk_bf16(v1[2], v1[3]);
                    *(u32x4*)(rowp + bj * 128) = w; } }
    }
};
struct EpiRes {
    static constexpr bool PERM = true, GATED = false;
    const float* __restrict__ res; float* __restrict__ out;
    DI void operator()(const f32x4 (&acc)[2][2][4][2], const pg8::Unit& u, int wr, int wc, int fr, int fq) const {
        const int row0 = u.pm * 256 + wr * 64 + fr, col0 = u.pn * 256 + wc * 32 + 8 * fq;
#pragma unroll
        for (int ai = 0; ai < 2; ++ai)
#pragma unroll
            for (int m = 0; m < 4; ++m) { const size_t ro = (size_t)(row0 + ai * 128 + m * 16) * DM + col0;
#pragma unroll
                for (int bj = 0; bj < 2; ++bj)
#pragma unroll
                    for (int n = 0; n < 2; ++n) { const size_t o = ro + bj * 128 + n * 4; const f32x4 r = *(const f32x4*)(res + o); *(f32x4*)(out + o) = r * DN_ALPHA + acc[ai][bj][m][n]; } }
    }
};
struct EpiGate {
    static constexpr bool PERM = true, GATED = true;
    const bf16* H; bf16* Y;
    DI void flush(const f32x4 (&acc)[2][1][4][2], f32x4 (&y)[2][4][2], const pg8::Unit& u, int bi, int wr, int wc, int fr, int fq) const {
        const int row0 = u.pm * 256 + wr * 64 + fr, col0 = u.pn * 128 + wc * 32 + 8 * fq;
#pragma unroll
        for (int ai = 0; ai < 2; ++ai)
#pragma unroll
            for (int m = 0; m < 4; ++m) { const u32x4 gw = *(const u32x4*)(H + (size_t)(row0 + ai * 128 + m * 16) * NH + C_MG + bi * DM + col0);
                float g[8]; unpack8(gw, g);
#pragma unroll
                for (int j = 0; j < 4; ++j) { y[ai][m][0][j] += g[j] * acc[ai][0][m][0][j]; y[ai][m][1][j] += g[4 + j] * acc[ai][0][m][1][j]; }
                if (m == 1 || m == 3) __builtin_amdgcn_sched_barrier(0); }
    }
    DI void finish(const f32x4 (&acc)[2][1][4][2], f32x4 (&y)[2][4][2], const pg8::Unit& u, int wr, int wc, int fr, int fq) const {
        flush(acc, y, u, 3, wr, wc, fr, fq);
        const int row0 = u.pm * 256 + wr * 64 + fr, col0 = u.pn * 128 + wc * 32 + 8 * fq;
#pragma unroll
        for (int ai = 0; ai < 2; ++ai)
#pragma unroll
            for (int m = 0; m < 4; ++m) { const f32x4 v0 = y[ai][m][0], v1 = y[ai][m][1];
                u32x4 w; w.x = cvt_pk_bf16(v0[0], v0[1]); w.y = cvt_pk_bf16(v0[2], v0[3]); w.z = cvt_pk_bf16(v1[0], v1[1]); w.w = cvt_pk_bf16(v1[2], v1[3]);
                if (BLK_OUT) *(u32x4*)((char*)Y + pg8::blk_off<false>(row0 + ai * 128 + m * 16, col0, DM / 64)) = w; else *(u32x4*)(Y + (size_t)(row0 + ai * 128 + m * 16) * DM + col0) = w; }
    }
};
struct SchedInProj {
    static constexpr bool BLK = false;
    int G, c, n_extra; const char *XB, *WT, *MEMB, *WKV;
    static constexpr int NM = 32, NN = 21, NU = NM * NN;
    static constexpr size_t TSTEP = (size_t)256 * 4096 * 2;
    DI bool next(int i, pg8::Unit& u) const {
        const long L = (long)i * G + c;
        if (L < NU) { pg8::static_tile((int)L, NM, NN, u.pm, u.pn); if (u.pn == 20) u.pn = 101; u.gi = 0; return true; }
        const int e = (int)(L - NU); if (e >= n_extra) return false;
        const int lx = e >> 4, r = e & 15;
        if (r < 8) { u.pm = r >> 2; u.pn = r & 3; u.gi = 1 + 2 * lx; } else { u.pm = (r - 8) >> 1; u.pn = (r - 8) & 1; u.gi = 2 + 2 * lx; }
        return true;
    }
    DI const char* abase(const pg8::Unit& u) const {
        if (u.gi == 0) return XB + (size_t)u.pm * TSTEP;
        const int lx = (u.gi - 1) >> 1, w = (u.gi - 1) & 1;
        return w == 0 ? MEMB + (size_t)u.pm * TSTEP : WKV + (size_t)lx * 2048 * 4096 * 2 + (size_t)(1024 + u.pm * 256) * 4096 * 2;
    }
    DI const char* bbase(const pg8::Unit& u) const {
        if (u.gi == 0) return WT + (size_t)u.pn * TSTEP;
        const int lx = (u.gi - 1) >> 1, w = (u.gi - 1) & 1;
        return w == 0 ? WKV + (size_t)lx * 2048 * 4096 * 2 + (size_t)u.pn * TSTEP : MEMB + (size_t)u.pn * TSTEP;
    }
};

DI int win_src_col(int n) { return n < 5120 ? n : (n < C_LR ? n + 16 : (n < C_LR + 16 ? n - C_LR + 5120 : -1)); }
template <bool WIN, int LAY = 0> DI void transpose_item(const float* W, size_t ldw, bf16* WT, size_t ldt, int k0, int n0, int kd0, LAS float* scr, int lane) {
    const int kr = lane >> 3, nc = lane & 7; int sc = n0 + 4 * nc; if (WIN) sc = win_src_col(sc);
    const float* src = W + (size_t)(k0 + kr) * ldw + (sc < 0 ? 0 : sc);
    f32x4 v[8];
#pragma unroll
    for (int i = 0; i < 8; ++i) v[i] = *(const f32x4*)(src + (size_t)(8 * i) * ldw);
#pragma unroll
    for (int i = 0; i < 8; ++i) { LAS float* d = scr + (8 * i + kr) * 33 + 4 * nc; const f32x4 x = (sc < 0) ? (f32x4){0.f, 0.f, 0.f, 0.f} : v[i]; d[0] = x.x; d[1] = x.y; d[2] = x.z; d[3] = x.w; }
    LDS_WAIT();
    const int c = lane & 7;
#pragma unroll
    for (int j = 0; j < 4; ++j) { const int n = (lane >> 3) + 8 * j; const LAS float* s = scr + (8 * c) * 33 + n;
        u32x4 o; o.x = pk2(s[0 * 33], s[1 * 33]); o.y = pk2(s[2 * 33], s[3 * 33]); o.z = pk2(s[4 * 33], s[5 * 33]); o.w = pk2(s[6 * 33], s[7 * 33]);
        if constexpr (LAY == 0) *(u32x4*)(WT + (size_t)(n0 + n) * ldt + kd0 + 8 * c) = o; else *(u32x4*)((char*)WT + pg8::blk_off<LAY == 2>(n0 + n, kd0 + 8 * c, (int)(ldt / 64))) = o; }
    LDS_WAIT();
}
DI void transpose_item_f8(const float* W, size_t ldw, unsigned char* WT, size_t ldt, int k0, int n0, LAS float* scr, int lane) {
    const int kr = lane >> 3, nc = lane & 7; const int sc = win_src_col(n0 + 4 * nc);
    const float* src = W + (size_t)(k0 + kr) * ldw + sc;
#pragma unroll
    for (int h = 0; h < 2; ++h) {
        f32x4 v[8];
#pragma unroll
        for (int i = 0; i < 8; ++i) v[i] = *(const f32x4*)(src + (size_t)(64 * h + 8 * i) * ldw);
#pragma unroll
        for (int i = 0; i < 8; ++i) { LAS float* d = scr + (64 * h + 8 * i + kr) * 33 + 4 * nc; d[0] = v[i].x * W8_SCALE; d[1] = v[i].y * W8_SCALE; d[2] = v[i].z * W8_SCALE; d[3] = v[i].w * W8_SCALE; }
    }
    LDS_WAIT();
#if F6
    { const int q = lane >> 4;
#pragma unroll
      for (int j = 0; j < 2; ++j) { const int n = (lane & 15) + 16 * j; const LAS float* sp = scr + (32 * q) * 33 + n; float f[32];
#pragma unroll
          for (int e = 0; e < 32; ++e) f[e] = sp[e * 33];
          u32x4 lo, hi; pk32_fp6(f, lo, hi); const int R = n0 - C_F8 + n; size_t ol, oh; pg8::f6_off((R & ~31) + pg8::invperm32(R & 31), k0 >> 7, q, ol, oh);
          *(u32x4*)(WT + ol) = lo; u32x2 h2; h2.x = hi.x; h2.y = hi.y; *(u32x2*)(WT + oh) = h2; } }
#else
    const int c = lane & 7;
#pragma unroll
    for (int j = 0; j < 4; ++j) { const int n = (lane >> 3) + 8 * j; const LAS float* s = scr + (16 * c) * 33 + n;
        u32x4 o; o.x = pk4_fp8(s[0 * 33], s[1 * 33], s[2 * 33], s[3 * 33]); o.y = pk4_fp8(s[4 * 33], s[5 * 33], s[6 * 33], s[7 * 33]);
        o.z = pk4_fp8(s[8 * 33], s[9 * 33], s[10 * 33], s[11 * 33]); o.w = pk4_fp8(s[12 * 33], s[13 * 33], s[14 * 33], s[15 * 33]);
        *(u32x4*)(WT + (size_t)(n0 - C_F8 + n) * ldt + k0 + 16 * c) = o; }
#endif
    LDS_WAIT();
}
DI void prologue(const Frame& F, const float* x, const float* mem, const int* pos, const float* w_in, const float* w_pool, const float* w_mem_kv, const float* w_branch, const float* w_out) {
    LAS float* scr = (LAS float*)(F.lds + F.wave * 17408);
    const int gw = F.wg * NWAVES + F.wave, NGW = F.G * NWAVES, lane = F.lane;
    constexpr int I_B16 = 64 * ((NH - N_F8) / 32), I_F8 = 32 * (N_F8 / 32), I_KV = 64 * 64, I_BR = 16 * 128, I_OUT = 64 * 128, I_PL = 4 * 8;
    constexpr int NITEMS = 2 * I_B16 + 2 * I_F8 + 2 * I_KV + 8 * I_BR + 2 * I_OUT + 8 * I_PL;
    LAS unsigned* qc = (LAS unsigned*)(F.lds + MISC_OFF) + 16;
    (void)gw;
    int q = 0; if (lane == 0) q = (int)__hip_atomic_fetch_add(qc, 1u, __ATOMIC_RELAXED, __HIP_MEMORY_SCOPE_WORKGROUP); q = __builtin_amdgcn_readfirstlane(q);
    for (;;) {
        const int it = (q >> 3) * NGW + F.wg * NWAVES + (q & 7); if (it >= NITEMS) break;
        if (lane == 0) q = (int)__hip_atomic_fetch_add(qc, 1u, __ATOMIC_RELAXED, __HIP_MEMORY_SCOPE_WORKGROUP);
        q = __builtin_amdgcn_readfirstlane(q);
        int r = it;
        if (r < 2 * I_F8) { const int l = r / I_F8; r -= l * I_F8; const int nb = C_F8 / 32 + (PRO_NFAST ? r % (N_F8 / 32) : (r >> 5)), kb = PRO_NFAST ? r / (N_F8 / 32) : (r & 31);
            transpose_item_f8(w_in + (size_t)l * 4096 * D_IN, D_IN, wsp<unsigned char>(F, WS_W8) + (size_t)l * W8_LAYER, 4096, kb * 128, nb * 32, scr, lane); continue; }
        r -= 2 * I_F8;
        if (r < 2 * I_B16) { const int l = r / I_B16; r -= l * I_B16; int nb = r >> 6; const int kb = r & 63; if (nb >= C_F8 / 32) nb += N_F8 / 32;
            transpose_item<true>(w_in + (size_t)l * 4096 * D_IN, D_IN, wsp<bf16>(F, WS_WINT) + (size_t)l * NH * 4096, 4096, kb * 64, nb * 32, kb * 64, scr, lane); continue; }
        r -= 2 * I_B16;
        if (r < 2 * I_KV) { const int l = r / I_KV; r -= l * I_KV; const int nb = r >> 6, kb = r & 63;
            transpose_item<false>(w_mem_kv + (size_t)l * 4096 * 2048, 2048, wsp<bf16>(F, WS_WMKVT) + (size_t)l * 2048 * 4096, 4096, kb * 64, nb * 32, kb * 64, scr, lane); continue; }
        r -= 2 * I_KV;
        if (r < 8 * I_BR) { const int lb = r / I_BR; r -= lb * I_BR; const int l = lb >> 2, bi = lb & 3; const int nb = PRO_NFAST ? (r & 127) : (r >> 4), kb = PRO_NFAST ? (r >> 7) : (r & 15);
            transpose_item<false, BLK_GATE ? 2 : 0>(w_branch + (size_t)lb * 1024 * 4096, 4096, wsp<bf16>(F, WS_WBRT) + (size_t)l * 4096 * 4096, 4096, kb * 64, nb * 32, bi * 1024 + kb * 64, scr, lane); continue; }
        r -= 8 * I_BR;
        if (r < 2 * I_OUT) { const int l = r / I_OUT; r -= l * I_OUT; const int nb = PRO_NFAST ? (r & 127) : (r >> 6), kb = PRO_NFAST ? (r >> 7) : (r & 63);
            transpose_item<false, BLK_OUT ? 2 : 0>(w_out + (size_t)l * 4096 * 4096, 4096, wsp<bf16>(F, WS_WOUTT) + (size_t)l * 4096 * 4096, 4096, kb * 64, nb * 32, kb * 64, scr, lane); continue; }
        r -= 2 * I_OUT;
        { const int lg = r / I_PL; r -= lg * I_PL; const int nb = r >> 2, kb = r & 3;
            transpose_item<false>(w_pool + (size_t)lg * 256 * 256, 256, wsp<bf16>(F, WS_WPOOLT) + (size_t)lg * 256 * 256, 256, kb * 64, nb * 32, kb * 64, scr, lane); }
    }
    const size_t gt = (size_t)F.wg * NTHR + F.tid, GT = (size_t)F.G * NTHR;
    { const f32x4* xs = (const f32x4*)x; u32x4* xd = wsp<u32x4>(F, WS_XB);
      u32x2* x8 = wsp<u32x2>(F, WS_X8);
#if F6
      (void)x8; (void)xd;
      { LAS unsigned char* lw = (LAS unsigned char*)scr; u32x2* xb2 = wsp<u32x2>(F, WS_XB);
        for (size_t g0 = (size_t)gw * 64; g0 < (size_t)MTOK * DM / 32; g0 += (size_t)NGW * 64) {
            const f32x4* src = xs + g0 * 8;
            f32x4 v[8];
#pragma unroll
            for (int t = 0; t < 8; ++t) v[t] = src[64 * t + lane];
#pragma unroll
            for (int t = 0; t < 8; ++t) { u32x2 w; w.x = pk2(v[t].x, v[t].y); w.y = pk2(v[t].z, v[t].w); xb2[g0 * 8 + 64 * t + lane] = w;
                *(LAS f32x4*)(lw + ((lane >> 3) + 8 * t) * 144 + (lane & 7) * 16) = v[t] * X8_SCALE; }
            LDS_WAIT();
            float f[32];
#pragma unroll
            for (int t = 0; t < 8; ++t) { const f32x4 qv = *(const LAS f32x4*)(lw + lane * 144 + 16 * t); f[4 * t] = qv.x; f[4 * t + 1] = qv.y; f[4 * t + 2] = qv.z; f[4 * t + 3] = qv.w; }
            const size_t gi = g0 + lane; u32x4 lo, hi; pk32_fp6(f, lo, hi); size_t ol, oh; pg8::f6_off((int)(gi >> 7), (int)((gi >> 2) & 31), (int)(gi & 3), ol, oh);
            *(u32x4*)(wsp<unsigned char>(F, WS_X8) + ol) = lo; u32x2 h2; h2.x = hi.x; h2.y = hi.y; *(u32x2*)(wsp<unsigned char>(F, WS_X8) + oh) = h2;
            LDS_WAIT();
        } }
#else
      for (size_t i = gt; i < (size_t)MTOK * DM / 8; i += GT) { const f32x4 a = xs[2 * i], b = xs[2 * i + 1]; u32x4 o; o.x = pk2(a.x, a.y); o.y = pk2(a.z, a.w); o.z = pk2(b.x, b.y); o.w = pk2(b.z, b.w); xd[i] = o;
          u32x2 q; q.x = pk4_fp8(a.x * X8_SCALE, a.y * X8_SCALE, a.z * X8_SCALE, a.w * X8_SCALE); q.y = pk4_fp8(b.x * X8_SCALE, b.y * X8_SCALE, b.z * X8_SCALE, b.w * X8_SCALE); x8[i] = q; }
#endif
      const f32x4* ms = (const f32x4*)mem; u32x4* md = wsp<u32x4>(F, WS_MEMB);
      for (size_t i = gt; i < (size_t)BATCH * MEMLEN * DM / 8; i += GT) { const f32x4 a = ms[2 * i], b = ms[2 * i + 1]; u32x4 o; o.x = pk2(a.x, a.y); o.y = pk2(a.z, a.w); o.z = pk2(b.x, b.y); o.w = pk2(b.z, b.w); md[i] = o; } }
    { f32x2* rt = wsp<f32x2>(F, WS_ROPE);
      for (size_t i = gt; i < (size_t)MTOK * 8; i += GT) { const int t = (int)(i >> 3), fi = (int)(i & 7);
          const double invd = fi == 0 ? 1 : fi == 1 ? 0.19392274474868576 : fi == 2 ? 0.037606030930863933 : fi == 3 ? 0.0072926647372171093 : fi == 4 ? 0.001414213562373095 : fi == 5 ? 0.0002742481756762073 : fi == 6 ? 5.3182958969449883e-05 : 1.031338537721246e-05;
          const float inv = (float)invd; const float ang = (float)pos[t] * inv;
          rt[i] = (f32x2){cosf(ang), sinf(ang)}; } }
}

DI bf16* ob_at(bf16* OB, int t, int col) { return BLK_GATE ? (bf16*)((char*)OB + pg8::blk_off<false>(t, col, DM / 64)) : OB + (size_t)t * DM + col; }
DI float fexp(float x) { return __builtin_amdgcn_exp2f(x * 1.44269504089f); }
DI float logsigmoid_f(float z) { return fminf(z, 0.f) - 0.69314718056f * __builtin_amdgcn_logf(1.0f + fexp(-fabsf(z))); }

DI void gla_a_unit(const Frame& F, int l, int unit, const float* w_gla_up, const float* b_gla) {
    const int bh = unit >> 6, c = unit & 63, b = bh >> 2, h = bh & 3, t0 = b * SEQ + c * 64, tid = F.tid, lane = F.lane, wave = F.wave;
    const bf16* H = wsp<bf16>(F, WS_H);
    LAS float* lrs = (LAS float*)(F.lds);
    LAS float* bcs = (LAS float*)(F.lds + 4096);
    LAS float* seg = (LAS float*)(F.lds + 36864);
    LAS bf16* kds = (LAS bf16*)(F.lds + 40960);
    LAS bf16* vs = (LAS bf16*)(F.lds + 59392);
    constexpr int LDK = 136, LDV = 264;
    __syncthreads();
    if (tid < 128) { const int j = tid >> 1, hf = tid & 1; const u32x4 w = *(const u32x4*)(H + (size_t)(t0 + j) * NH + C_LR + 8 * hf); float f[8]; unpack8(w, f);
#pragma unroll
        for (int i = 0; i < 8; ++i) lrs[j * 16 + 8 * hf + i] = f[i]; }
    for (int p = tid; p < 64 * 32; p += NTHR) { const int j = p >> 5, ch = p & 31; *(LAS u32x4*)(vs + j * LDV + 8 * ch) = *(const u32x4*)(H + (size_t)(t0 + j) * NH + C_GV + h * 256 + 8 * ch); }
    __syncthreads();
    const int d = tid & 127, sg = tid >> 7;
    { float w[16];
#pragma unroll
      for (int r = 0; r < 16; ++r) w[r] = w_gla_up[(size_t)l * 16 * 512 + r * 512 + h * 128 + d];
      const float bg = b_gla[l * 512 + h * 128 + d]; float run = 0.f;
      for (int jj = 0; jj < 16; ++jj) { const int j = sg * 16 + jj; float z = bg;
#pragma unroll
          for (int r = 0; r < 16; ++r) z += lrs[j * 16 + r] * w[r];
          run += logsigmoid_f(z) * (1.0f / 16.0f); bcs[j * 128 + d] = run; }
      seg[sg * 128 + d] = run; }
    __syncthreads();
    { float pre = 0.f;
      for (int s = 0; s < sg; ++s) pre += seg[s * 128 + d];
      float* GB = wsp<float>(F, WS_GB);
      for (int jj = 0; jj < 16; ++jj) { const int j = sg * 16 + jj; const float v = bcs[j * 128 + d] + pre; bcs[j * 128 + d] = v; GB[(size_t)(t0 + j) * 512 + h * 128 + d] = v; }
      if (sg == 3) wsp<float>(F, WS_DEC)[(size_t)unit * 128 + d] = expf(bcs[63 * 128 + d]); }
    __syncthreads();
    for (int p = tid; p < 64 * 16; p += NTHR) { const int j = p >> 4, ch = p & 15; const u32x4 w = *(const u32x4*)(H + (size_t)(t0 + j) * NH + C_GK + h * 128 + 8 * ch); float f[8]; unpack8(w, f);
#pragma unroll
        for (int i = 0; i < 8; ++i) f[i] *= fexp(bcs[63 * 128 + 8 * ch + i] - bcs[j * 128 + 8 * ch + i]);
        *(LAS u32x4*)(kds + j * LDK + 8 * ch) = pack8(f); }
    __syncthreads();
    f32x4 acc[2][8];
#pragma unroll
    for (int a = 0; a < 2; ++a)
#pragma unroll
        for (int n = 0; n < 8; ++n) acc[a][n] = (f32x4){0.f, 0.f, 0.f, 0.f};
#pragma unroll
    for (int ks = 0; ks < 2; ++ks) {
        bf16x8 af[2];
#pragma unroll
        for (int a = 0; a < 2; ++a) af[a] = frag_tr(vs, LDV, 32 * ks, 32 * wave + 16 * a, lane);
#pragma unroll
        for (int n = 0; n < 8; ++n) { const bf16x8 bfr = frag_tr(kds, LDK, 32 * ks, 16 * n, lane);
#pragma unroll
            for (int a = 0; a < 2; ++a) acc[a][n] = mma16(bfr, af[a], acc[a][n]); }
    }
    float* U = wsp<float>(F, WS_GU) + (size_t)unit * 256 * 128;
#pragma unroll
    for (int a = 0; a < 2; ++a)
#pragma unroll
        for (int n = 0; n < 8; ++n) *(f32x4*)(U + (size_t)(32 * wave + 16 * a + (lane & 15)) * 128 + 16 * n + 4 * (lane >> 4)) = acc[a][n];
}

DI void gla_scan(const Frame& F) {
    const float* U = wsp<float>(F, WS_GU); const float* DEC = wsp<float>(F, WS_DEC); unsigned* S = wsp<unsigned>(F, WS_GS);
    const int gt = F.wg * NTHR + F.tid, GT = F.G * NTHR;
    for (int it = gt; it < 8 * 256 * 64; it += GT) {
        const int bh = it >> 14, r = it & 16383, e = r >> 6, dp = r & 63;
        float s0 = 0.f, s1 = 0.f;
#pragma unroll 8
        for (int c = 0; c < 64; ++c) { const size_t un = (size_t)bh * 64 + c; const size_t o = (un * 256 + e) * 128 + 2 * dp;
            const f32x2 u = *(const f32x2*)(U + o); const f32x2 dc = *(const f32x2*)(DEC + un * 128 + 2 * dp);
            S[o >> 1] = pk2(s0, s1); s0 = dc.x * s0 + u.x; s1 = dc.y * s1 + u.y; }
    }
}

#ifndef PROBE_T
#define PROBE_T 0
#endif
#if PROBE_T
#define PT_STAMP(k) do { if (F.wg == 0 && F.tid == 0) { const unsigned _now = (unsigned)wall_clock64(); volatile LAS unsigned* _pt = (volatile LAS unsigned*)(F.lds + MISC_OFF + 128); if ((k) > 0) _pt[k] += _now - _pt[0]; _pt[0] = _now; } } while (0)
#else
#define PT_STAMP(k) do {} while (0)
#endif
DI void gla_c_unit(const Frame& F, int l, int unit, const float* gla_norm) {
    const int bh = unit >> 6, c = unit & 63, b = bh >> 2, h = bh & 3, t0 = b * SEQ + c * 64, tid = F.tid, lane = F.lane, wave = F.wave;
    const bf16* H = wsp<bf16>(F, WS_H);
    LAS bf16* qs = (LAS bf16*)(F.lds);
    LAS bf16* ks = (LAS bf16*)(F.lds + 17408);
    LAS bf16* vs = (LAS bf16*)(F.lds + 34816);
    LAS bf16* ps = (LAS bf16*)(F.lds + 68608);
    LAS float* red = (LAS float*)(F.lds + 77824);
    constexpr int LDK = 136, LDV = 264, LDP = 72;
    __syncthreads();
    PT_STAMP(0);
    const float* GB = wsp<float>(F, WS_GB);
    u32x4 qw[2], kw[2], vw[4]; f32x4 b0[2], b1[2];
#pragma unroll
    for (int it = 0; it < 2; ++it) { const int p = tid + it * NTHR, j = p >> 4, ch = p & 15;
        qw[it] = *(const u32x4*)(H + (size_t)(t0 + j) * NH + C_GQ + h * 128 + 8 * ch); kw[it] = *(const u32x4*)(H + (size_t)(t0 + j) * NH + C_GK + h * 128 + 8 * ch);
        b0[it] = *(const f32x4*)(GB + (size_t)(t0 + j) * 512 + h * 128 + 8 * ch); b1[it] = *(const f32x4*)(GB + (size_t)(t0 + j) * 512 + h * 128 + 8 * ch + 4); }
#pragma unroll
    for (int it = 0; it < 4; ++it) { const int p = tid + it * NTHR, j = p >> 5, ch = p & 31; vw[it] = *(const u32x4*)(H + (size_t)(t0 + j) * NH + C_GV + h * 256 + 8 * ch); }
    const bf16* St = wsp<bf16>(F, WS_GS) + (size_t)unit * 256 * 128;
    bf16x8 sf[4][2];
#pragma unroll
    for (int kk = 0; kk < 4; ++kk)
#pragma unroll
        for (int a = 0; a < 2; ++a) sf[kk][a] = frag_glb(St, 128, 32 * wave + 16 * a, 32 * kk, lane);
    f32x4 gn[2]; u32x2 gw[4][2];
#pragma unroll
    for (int a = 0; a < 2; ++a) { const int e = 32 * wave + 16 * a + 4 * (lane >> 4); gn[a] = *(const f32x4*)(gla_norm + l * 1024 + h * 256 + e);
#pragma unroll
        for (int n = 0; n < 4; ++n) gw[n][a] = *(const u32x2*)(H + (size_t)(t0 + 16 * n + (lane & 15)) * NH + C_GG + h * 256 + e); }
#pragma unroll
    for (int it = 0; it < 2; ++it) { const int p = tid + it * NTHR, j = p >> 4, ch = p & 15;
        float q[8], k[8]; unpack8(qw[it], q); unpack8(kw[it], k); const float bb[8] = {b0[it].x, b0[it].y, b0[it].z, b0[it].w, b1[it].x, b1[it].y, b1[it].z, b1[it].w};
#pragma unroll
        for (int i = 0; i < 8; ++i) { const float eb = fexp(bb[i]); q[i] *= eb * 0.08838834764831845f; k[i] *= fexp(-bb[i]); }
        *(LAS u32x4*)(qs + j * LDK + 8 * ch) = pack8(q); *(LAS u32x4*)(ks + j * LDK + 8 * ch) = pack8(k); }
#pragma unroll
    for (int it = 0; it < 4; ++it) { const int p = tid + it * NTHR, j = p >> 5, ch = p & 31; *(LAS u32x4*)(vs + j * LDV + 8 * ch) = vw[it]; }
    __syncthreads();
    PT_STAMP(1);
    { const int it = wave >> 1; f32x4 sa[2] = {(f32x4){0.f, 0.f, 0.f, 0.f}, (f32x4){0.f, 0.f, 0.f, 0.f}};
#pragma unroll
      for (int kk = 0; kk < 4; ++kk) { const bf16x8 qa = frag_lds(qs, LDK, 16 * it, 32 * kk, lane);
#pragma unroll
          for (int jj = 0; jj < 2; ++jj) sa[jj] = mma16(qa, frag_lds(ks, LDK, 16 * (2 * (wave & 1) + jj), 32 * kk, lane), sa[jj]); }
#pragma unroll
      for (int jj = 0; jj < 2; ++jj)
#pragma unroll
          for (int r = 0; r < 4; ++r) { const int i = 16 * it + 4 * (lane >> 4) + r, j = 16 * (2 * (wave & 1) + jj) + (lane & 15);
              ps[i * LDP + j] = (bf16)f2bf(j <= i ? sa[jj][r] : 0.f); } }
    __syncthreads();
    PT_STAMP(2);
    f32x4 acc[2][4];
#pragma unroll
    for (int a = 0; a < 2; ++a)
#pragma unroll
        for (int n = 0; n < 4; ++n) acc[a][n] = (f32x4){0.f, 0.f, 0.f, 0.f};
#pragma unroll
    for (int kk = 0; kk < 4; ++kk) {
#pragma unroll
        for (int n = 0; n < 4; ++n) { const bf16x8 bq = frag_lds(qs, LDK, 16 * n, 32 * kk, lane);
#pragma unroll
            for (int a = 0; a < 2; ++a) acc[a][n] = mma16(sf[kk][a], bq, acc[a][n]); } }
#pragma unroll
    for (int kk = 0; kk < 2; ++kk) { bf16x8 af[2];
#pragma unroll
        for (int a = 0; a < 2; ++a) af[a] = frag_tr(vs, LDV, 32 * kk, 32 * wave + 16 * a, lane);
#pragma unroll
        for (int n = 0; n < 4; ++n) { const bf16x8 bp = frag_lds(ps, LDP, 16 * n, 32 * kk, lane);
#pragma unroll
            for (int a = 0; a < 2; ++a) acc[a][n] = mma16(af[a], bp, acc[a][n]); } }
#pragma unroll
    for (int n = 0; n < 4; ++n) { float s = 0.f;
#pragma unroll
        for (int a = 0; a < 2; ++a)
#pragma unroll
            for (int r = 0; r < 4; ++r) s += acc[a][n][r] * acc[a][n][r];
        s += __shfl_xor(s, 16); s += __shfl_xor(s, 32);
        if (lane < 16) red[wave * 64 + 16 * n + lane] = s; }
    __syncthreads();
    PT_STAMP(3);
    bf16* OB = wsp<bf16>(F, WS_OB);
#pragma unroll
    for (int n = 0; n < 4; ++n) { const int i = 16 * n + (lane & 15); float tot = 0.f;
#pragma unroll
        for (int w = 0; w < 8; ++w) tot += red[w * 64 + i];
        const float rs = 1.0f / sqrtf(tot * (1.0f / 256.0f) + LN_EPS);
#pragma unroll
        for (int a = 0; a < 2; ++a) { const int e = 32 * wave + 16 * a + 4 * (lane >> 4);
            const float g0 = bf2f(gw[n][a].x & 0xffffu), g1 = bf2f(gw[n][a].x >> 16), g2 = bf2f(gw[n][a].y & 0xffffu), g3 = bf2f(gw[n][a].y >> 16);
            u32x2 o; o.x = pk2(acc[a][n][0] * rs * gn[a].x * g0, acc[a][n][1] * rs * gn[a].y * g1); o.y = pk2(acc[a][n][2] * rs * gn[a].z * g2, acc[a][n][3] * rs * gn[a].w * g3);
            *(u32x2*)ob_at(OB, t0 + i, 1024 + h * 256 + e) = o; } }
    PT_STAMP(4);
}

DI void pool_unit(const Frame& F, int l, int unit, const float* pool_scale) {
    const int gi = unit & 3, tt = unit >> 2, t0 = tt * 128, tid = F.tid, lane = F.lane, wave = F.wave, w = 2 << gi;
    const bf16* H = wsp<bf16>(F, WS_H);
    LAS bf16* pl = (LAS bf16*)(F.lds);
    constexpr int LDP = 264;
    __syncthreads();
    for (int p = tid; p < 128 * 32; p += NTHR) { const int j = p >> 5, ch = p & 31, t = t0 + j, ts = t & (SEQ - 1);
        const int cnt = (ts + 1 < w) ? ts + 1 : w; float a[8];
#pragma unroll
        for (int i = 0; i < 8; ++i) a[i] = 0.f;
        float u0[8];
        const bf16* hp = H + (size_t)t * NH + C_PU + gi * 256 + 8 * ch;
        { float f[8]; unpack8(*(const u32x4*)hp, f);
#pragma unroll
          for (int i = 0; i < 8; ++i) { a[i] = f[i]; u0[i] = f[i]; } }
#pragma unroll
        for (int s = 1; s < 16; ++s) if (s < w) { const int sb = (s < cnt) ? s : 0;
            const u32x4 x = *(const u32x4*)(hp - (size_t)sb * NH); float f[8]; unpack8(x, f); const float wgt = (s < cnt) ? 1.f : 0.f;
#pragma unroll
            for (int i = 0; i < 8; ++i) a[i] += wgt * f[i]; }
        const float ic = 1.0f / (float)cnt;
#pragma unroll
        for (int i = 0; i < 8; ++i) a[i] = a[i] * ic - u0[i];
        *(LAS u32x4*)(pl + j * LDP + 8 * ch) = pack8(a); }
    __syncthreads();
    const bf16* WP = wsp<bf16>(F, WS_WPOOLT) + (size_t)(l * 4 + gi) * 256 * 256;
    f32x4 acc[2][8];
#pragma unroll
    for (int a = 0; a < 2; ++a)
#pragma unroll
        for (int n = 0; n < 8; ++n) acc[a][n] = (f32x4){0.f, 0.f, 0.f, 0.f};
#pragma unroll 2
    for (int kk = 0; kk < 8; ++kk) { bf16x8 af[2];
#pragma unroll
        for (int a = 0; a < 2; ++a) af[a] = frag_glb(WP, 256, 32 * wave + 16 * a, 32 * kk, lane);
#pragma unroll
        for (int n = 0; n < 8; ++n) { const bf16x8 bp = frag_lds(pl, LDP, 16 * n, 32 * kk, lane);
#pragma unroll
            for (int a = 0; a < 2; ++a) acc[a][n] = mma16(af[a], bp, acc[a][n]); } }
    bf16* OB = wsp<bf16>(F, WS_OB);
#pragma unroll
    for (int n = 0; n < 8; ++n) { const int t = t0 + 16 * n + (lane & 15);
#pragma unroll
        for (int a = 0; a < 2; ++a) { const int dd = gi * 256 + 32 * wave + 16 * a + 4 * (lane >> 4);
            const f32x4 sc = *(const f32x4*)(pool_scale + l * 1024 + dd);
            const u32x2 gw = *(const u32x2*)(H + (size_t)t * NH + C_PG + dd);
            const float g0 = bf2f(gw.x & 0xffffu), g1 = bf2f(gw.x >> 16), g2 = bf2f(gw.y & 0xffffu), g3 = bf2f(gw.y >> 16);
            u32x2 o; o.x = pk2(acc[a][n][0] * sc.x * g0, acc[a][n][1] * sc.y * g1); o.y = pk2(acc[a][n][2] * sc.z * g2, acc[a][n][3] * sc.w * g3);
            *(u32x2*)ob_at(OB, t, dd) = o; } }
}

DI void swa_unit(const Frame& F, int l, int unit, const float* sinks) {
    const int n = unit & 31, hq = (unit >> 5) & 15, b = unit >> 9, kvh = hq >> 3, tid = F.tid, lane = F.lane, wave = F.wave;
    const int tq0 = b * SEQ + n * 128, tk0 = tq0 - 128;
    const bf16* H = wsp<bf16>(F, WS_H); const f32x2* RT = wsp<f32x2>(F, WS_ROPE);
    constexpr int LD = 72, LDPW = 168;
    LAS bf16* qs = (LAS bf16*)(F.lds);
    LAS bf16* ks = (LAS bf16*)(F.lds + 18432);
    LAS bf16* vs = (LAS bf16*)(F.lds + 57600);
    LAS bf16* pw = (LAS bf16*)(F.lds + 96768) + wave * 16 * LDPW;
    __syncthreads();
    for (int p = tid; p < 128 * 4; p += NTHR) { const int i = p >> 2, ch = p & 3; const bf16* src = H + (size_t)(tq0 + i) * NH + C_SQ + hq * 64 + 16 * ch;
        float f[16]; { float a[8], c[8]; unpack8(*(const u32x4*)src, a); unpack8(*(const u32x4*)(src + 8), c);
#pragma unroll
            for (int j = 0; j < 8; ++j) { f[j] = a[j]; f[8 + j] = c[j]; } }
        if (ch == 0) {
#pragma unroll
            for (int j = 0; j < 8; ++j) { const f32x2 cs = RT[(size_t)(tq0 + i) * 8 + j]; const float x1 = f[j], x2 = f[8 + j]; f[j] = x1 * cs.x - x2 * cs.y; f[8 + j] = x2 * cs.x + x1 * cs.y; } }
        float o0[8], o1[8];
#pragma unroll
        for (int j = 0; j < 8; ++j) { o0[j] = f[j] * 0.125f; o1[j] = f[8 + j] * 0.125f; }
        *(LAS u32x4*)(qs + i * LD + 16 * ch) = pack8(o0); *(LAS u32x4*)(qs + i * LD + 16 * ch + 8) = pack8(o1); }
    for (int p = tid; p < 272 * 4; p += NTHR) { const int j = p >> 2, ch = p & 3; const bool ok = (j < 256) && (n > 0 || j >= 128);
        u32x4 k0 = (u32x4){0u, 0u, 0u, 0u}, k1 = k0, v0 = k0, v1 = k0;
        if (ok) { const bf16* ksrc = H + (size_t)(tk0 + j) * NH + C_SK + kvh * 64 + 16 * ch; const bf16* vsrc = H + (size_t)(tk0 + j) * NH + C_SV + kvh * 64 + 16 * ch;
            k0 = *(const u32x4*)ksrc; k1 = *(const u32x4*)(ksrc + 8); v0 = *(const u32x4*)vsrc; v1 = *(const u32x4*)(vsrc + 8);
            if (ch == 0) { float a[8], c[8]; unpack8(k0, a); unpack8(k1, c);
#pragma unroll
                for (int jj = 0; jj < 8; ++jj) { const f32x2 cs = RT[(size_t)(tk0 + j) * 8 + jj]; const float x1 = a[jj], x2 = c[jj]; a[jj] = x1 * cs.x - x2 * cs.y; c[jj] = x2 * cs.x + x1 * cs.y; }
                k0 = pack8(a); k1 = pack8(c); } }
        *(LAS u32x4*)(ks + j * LD + 16 * ch) = k0; *(LAS u32x4*)(ks + j * LD + 16 * ch + 8) = k1;
        *(LAS u32x4*)(vs + j * LD + 16 * ch) = v0; *(LAS u32x4*)(vs + j * LD + 16 * ch + 8) = v1; }
    __syncthreads();
    const int qi = 16 * wave + (lane & 15);
    bf16x8 qf[2];
#pragma unroll
    for (int s = 0; s < 2; ++s) qf[s] = frag_lds(qs, LD, 16 * wave, 32 * s, lane);
    f32x4 sc[10];
#pragma unroll
    for (int jt = 0; jt < 10; ++jt) { sc[jt] = (f32x4){0.f, 0.f, 0.f, 0.f};
#pragma unroll
        for (int s = 0; s < 2; ++s) sc[jt] = mma16(frag_lds(ks, LD, 16 * (wave + jt), 32 * s, lane), qf[s], sc[jt]); }
    const float sink = sinks[l * 16 + hq];
    float mx = sink;
#pragma unroll
    for (int jt = 0; jt < 10; ++jt)
#pragma unroll
        for (int r = 0; r < 4; ++r) { const int kj = 16 * (wave + jt) + 4 * (lane >> 4) + r; const bool ok = (kj > qi) && (kj <= qi + 128) && (n > 0 || kj >= 128);
            sc[jt][r] = ok ? sc[jt][r] : -INFINITY; mx = fmaxf(mx, sc[jt][r]); }
    mx = fmaxf(mx, __shfl_xor(mx, 16)); mx = fmaxf(mx, __shfl_xor(mx, 32));
    float sum = 0.f;
#pragma unroll
    for (int jt = 0; jt < 10; ++jt)
#pragma unroll
        for (int r = 0; r < 4; ++r) { const float p = fexp(sc[jt][r] - mx); sc[jt][r] = p; sum += p; }
    sum += __shfl_xor(sum, 16); sum += __shfl_xor(sum, 32);
    const float inv = 1.0f / (sum + fexp(sink - mx));
#pragma unroll
    for (int jt = 0; jt < 10; ++jt) { u32x2 o; o.x = pk2(sc[jt][0] * inv, sc[jt][1] * inv); o.y = pk2(sc[jt][2] * inv, sc[jt][3] * inv);
        *(LAS u32x2*)(pw + (lane & 15) * LDPW + 16 * jt + 4 * (lane >> 4)) = o; }
    LDS_WAIT();
    f32x4 oa[4];
#pragma unroll
    for (int dt = 0; dt < 4; ++dt) oa[dt] = (f32x4){0.f, 0.f, 0.f, 0.f};
#pragma unroll
    for (int s = 0; s < 5; ++s) { const bf16x8 pf = frag_lds(pw, LDPW, 0, 32 * s, lane);
#pragma unroll
        for (int dt = 0; dt < 4; ++dt) oa[dt] = mma16(frag_tr(vs, LD, 16 * wave + 32 * s, 16 * dt, lane), pf, oa[dt]); }
    bf16* OB = wsp<bf16>(F, WS_OB);
    { const int t = tq0 + qi;
#pragma unroll
      for (int dt = 0; dt < 4; ++dt) { const int dd = hq * 64 + 16 * dt + 4 * (lane >> 4);
          const u32x2 gw = *(const u32x2*)(H + (size_t)t * NH + C_SG + dd);
          const float g0 = bf2f(gw.x & 0xffffu), g1 = bf2f(gw.x >> 16), g2 = bf2f(gw.y & 0xffffu), g3 = bf2f(gw.y >> 16);
          u32x2 o; o.x = pk2(oa[dt][0] * g0, oa[dt][1] * g1); o.y = pk2(oa[dt][2] * g2, oa[dt][3] * g3);
          *(u32x2*)ob_at(OB, t, 2048 + dd) = o; } }
}

DI void mem_unit(const Frame& F, int l, int unit) {
    const int n = unit & 31, hx = (unit >> 5) & 3, b = unit >> 7, lane = F.lane, wave = F.wave, tid = F.tid;
    const int tq0 = b * SEQ + n * 128 + 16 * wave;
    const bf16* H = wsp<bf16>(F, WS_H);
    const bf16* MK = wsp<bf16>(F, WS_MK) + (size_t)l * 512 * 1024 + (size_t)b * 256 * 1024 + hx * 256;
    const bf16* MVT = wsp<bf16>(F, WS_MVT) + (size_t)l * 1024 * 512 + (size_t)hx * 256 * 512 + b * 256;
    constexpr int LDI = 264;
    LAS bf16* img = (LAS bf16*)(F.lds);
    __syncthreads();
#pragma unroll 4
    for (int p = tid; p < 256 * 32; p += NTHR) { const int r = p >> 5, ch = p & 31; *(LAS u32x4*)(img + r * LDI + 8 * ch) = *(const u32x4*)(MK + (size_t)r * 1024 + 8 * ch); }
    bf16x8 qf[8];
#pragma unroll
    for (int s = 0; s < 8; ++s) qf[s] = frag_glb(H + C_XQ + hx * 256, NH, tq0, 32 * s, lane);
    __syncthreads();
    f32x4 sc[16];
#pragma unroll
    for (int jt = 0; jt < 16; ++jt) { sc[jt] = (f32x4){0.f, 0.f, 0.f, 0.f};
#pragma unroll
        for (int s = 0; s < 8; ++s) sc[jt] = mma16(frag_lds(img, LDI, 16 * jt, 32 * s, lane), qf[s], sc[jt]);
        if (jt & 1) __builtin_amdgcn_sched_barrier(0); }
#pragma unroll
    for (int jt = 0; jt < 16; ++jt) asm volatile("" : "+v"(sc[jt]));
    __syncthreads();
#pragma unroll 4
    for (int p = tid; p < 256 * 32; p += NTHR) { const int r = p >> 5, ch = p & 31; *(LAS u32x4*)(img + r * LDI + 8 * ch) = *(const u32x4*)(MVT + (size_t)r * 512 + 8 * ch); }
    float mx = -INFINITY;
#pragma unroll
    for (int jt = 0; jt < 16; ++jt)
#pragma unroll
        for (int r = 0; r < 4; ++r) { sc[jt][r] *= 0.0625f; mx = fmaxf(mx, sc[jt][r]); }
    mx = fmaxf(mx, __shfl_xor(mx, 16)); mx = fmaxf(mx, __shfl_xor(mx, 32));
    float sum = 0.f;
#pragma unroll
    for (int jt = 0; jt < 16; ++jt)
#pragma unroll
        for (int r = 0; r < 4; ++r) { const float p = __builtin_amdgcn_exp2f((sc[jt][r] - mx) * 1.44269504089f); sc[jt][r] = p; sum += p; }
    sum += __shfl_xor(sum, 16); sum += __shfl_xor(sum, 32);
    const float inv = 1.0f / sum;
    bf16x8 pb[8];
#pragma unroll
    for (int s = 0; s < 8; ++s) { u32x4 w; w.x = pk2(sc[2 * s][0] * inv, sc[2 * s][1] * inv); w.y = pk2(sc[2 * s][2] * inv, sc[2 * s][3] * inv);
        w.z = pk2(sc[2 * s + 1][0] * inv, sc[2 * s + 1][1] * inv); w.w = pk2(sc[2 * s + 1][2] * inv, sc[2 * s + 1][3] * inv); pb[s] = __builtin_bit_cast(bf16x8, w); }
    __syncthreads();
    bf16* OB = wsp<bf16>(F, WS_OB); const int t = tq0 + (lane & 15);
    const LAS bf16* arow = img + (lane & 15) * LDI + 4 * (lane >> 4);
#pragma unroll 4
    for (int dt = 0; dt < 16; ++dt) { f32x4 oa = (f32x4){0.f, 0.f, 0.f, 0.f};
#pragma unroll
        for (int s = 0; s < 8; ++s) { const u32x2 lo = *(const LAS u32x2*)(arow + 16 * dt * LDI + 32 * s), hi = *(const LAS u32x2*)(arow + 16 * dt * LDI + 32 * s + 16);
            const u32x4 av = (u32x4){lo.x, lo.y, hi.x, hi.y};
            oa = mma16(__builtin_bit_cast(bf16x8, av), pb[s], oa); }
        __builtin_amdgcn_sched_barrier(0);
        const int dd = hx * 256 + 16 * dt + 4 * (lane >> 4);
        const u32x2 gw = *(const u32x2*)(H + (size_t)t * NH + C_XG + dd);
        const float g0 = bf2f(gw.x & 0xffffu), g1 = bf2f(gw.x >> 16), g2 = bf2f(gw.y & 0xffffu), g3 = bf2f(gw.y >> 16);
        u32x2 o; o.x = pk2(oa[0] * g0, oa[1] * g1); o.y = pk2(oa[2] * g2, oa[3] * g3);
        *(u32x2*)ob_at(OB, t, 3072 + dd) = o; }
}

#ifndef NAIVE_MASK
#define NAIVE_MASK 0
#endif
DI float Hf(const bf16* H, size_t row, int col) { return bf2f(H[row * NH + col]); }
DI void naive_mem(const Frame& F, int l) {
    const bf16* H = wsp<bf16>(F, WS_H); bf16* OB = wsp<bf16>(F, WS_OB);
    LAS float* qs = (LAS float*)(F.lds) + F.wave * 512; LAS float* ps = qs + 256;
    const int gw = F.wg * NWAVES + F.wave, NGW = F.G * NWAVES, lane = F.lane;
    for (int it = gw; it < MTOK * 4; it += NGW) {
        const int t = it >> 2, hx = it & 3, b = t / SEQ;
        const bf16* MK = wsp<bf16>(F, WS_MK) + (size_t)l * 512 * 1024 + (size_t)b * 256 * 1024 + hx * 256;
        const bf16* MVT = wsp<bf16>(F, WS_MVT) + (size_t)l * 1024 * 512 + (size_t)hx * 256 * 512 + b * 256;
        for (int i = 0; i < 4; ++i) qs[lane + 64 * i] = Hf(H, t, C_XQ + hx * 256 + lane + 64 * i);
        LDS_WAIT();
        float sc[4]; float mx = -INFINITY;
        for (int i = 0; i < 4; ++i) { const int j = lane + 64 * i; float a = 0.f; for (int d = 0; d < 256; ++d) a += qs[d] * bf2f(MK[(size_t)j * 1024 + d]); sc[i] = a * 0.0625f; mx = fmaxf(mx, sc[i]); }
        for (int o = 1; o < 64; o <<= 1) mx = fmaxf(mx, __shfl_xor(mx, o));
        float sum = 0.f; for (int i = 0; i < 4; ++i) { sc[i] = expf(sc[i] - mx); sum += sc[i]; }
        sum = wave_sum(sum);
        for (int i = 0; i < 4; ++i) ps[lane + 64 * i] = sc[i] / sum;
        LDS_WAIT();
        for (int i = 0; i < 4; ++i) { const int d = lane + 64 * i; float a = 0.f; for (int j = 0; j < 256; ++j) a += ps[j] * bf2f(MVT[(size_t)d * 512 + j]);
            *ob_at(OB, t, 3072 + hx * 256 + d) = (bf16)f2bf(a * Hf(H, t, C_XG + hx * 256 + d)); }
        LDS_WAIT();
    }
}
DI void naive_swa(const Frame& F, int l, const float* sinks) {
    const bf16* H = wsp<bf16>(F, WS_H); bf16* OB = wsp<bf16>(F, WS_OB); const f32x2* RT = wsp<f32x2>(F, WS_ROPE);
    LAS float* qs = (LAS float*)(F.lds) + F.wave * 256; LAS float* ps = qs + 64;
    const int gw = F.wg * NWAVES + F.wave, NGW = F.G * NWAVES, lane = F.lane;
    for (int it = gw; it < MTOK * 16; it += NGW) {
        const int t = it >> 4, hq = it & 15, kvh = hq >> 3, ts = t & (SEQ - 1);
        { float x = Hf(H, t, C_SQ + hq * 64 + lane);
          if (lane < 16) { const int i = lane & 7; const float x1 = Hf(H, t, C_SQ + hq * 64 + i), x2 = Hf(H, t, C_SQ + hq * 64 + 8 + i); const f32x2 cs = RT[(size_t)t * 8 + i];
              x = (lane < 8) ? x1 * cs.x - x2 * cs.y : x2 * cs.x + x1 * cs.y; }
          qs[lane] = x * 0.125f; }
        LDS_WAIT();
        float sc[2]; const float sink = sinks[l * 16 + hq]; float mx = sink;
        for (int i = 0; i < 2; ++i) { const int back = lane + 64 * i; sc[i] = -INFINITY;
            if (back <= ts) { const int tk = t - back; float a = 0.f;
                for (int d = 0; d < 64; ++d) { float kv = Hf(H, tk, C_SK + kvh * 64 + d);
                    if (d < 16) { const int ii = d & 7; const float x1 = Hf(H, tk, C_SK + kvh * 64 + ii), x2 = Hf(H, tk, C_SK + kvh * 64 + 8 + ii); const f32x2 cs = RT[(size_t)tk * 8 + ii];
                        kv = (d < 8) ? x1 * cs.x - x2 * cs.y : x2 * cs.x + x1 * cs.y; }
                    a += qs[d] * kv; }
                sc[i] = a; }
            mx = fmaxf(mx, sc[i]); }
        for (int o = 1; o < 64; o <<= 1) mx = fmaxf(mx, __shfl_xor(mx, o));
        float sum = 0.f; for (int i = 0; i < 2; ++i) { sc[i] = expf(sc[i] - mx); sum += sc[i]; }
        sum = wave_sum(sum) + expf(sink - mx);
        for (int i = 0; i < 2; ++i) ps[lane + 64 * i] = sc[i] / sum;
        LDS_WAIT();
        { float a = 0.f; const int nk = (ts + 1 < 128) ? ts + 1 : 128;
          for (int back = 0; back < nk; ++back) a += ps[back] * Hf(H, t - back, C_SV + kvh * 64 + lane);
          *ob_at(OB, t, 2048 + hq * 64 + lane) = (bf16)f2bf(a * Hf(H, t, C_SG + hq * 64 + lane)); }
        LDS_WAIT();
    }
}
DI void naive_pool(const Frame& F, int l, const float* w_pool, const float* pool_scale) {
    const bf16* H = wsp<bf16>(F, WS_H); bf16* OB = wsp<bf16>(F, WS_OB); LAS float* pl = (LAS float*)(F.lds);
    for (int unit = F.wg; unit < 512; unit += F.G) { const int gi = unit & 3, t0 = (unit >> 2) * 64, w = 2 << gi;
        __syncthreads();
        for (int p = F.tid; p < 64 * 256; p += NTHR) { const int j = p >> 8, c = p & 255, t = t0 + j, ts = t & (SEQ - 1); const int cnt = (ts + 1 < w) ? ts + 1 : w; float a = 0.f;
            for (int s2 = 0; s2 < cnt; ++s2) a += Hf(H, t - s2, C_PU + gi * 256 + c);
            pl[p] = a / (float)cnt - Hf(H, t, C_PU + gi * 256 + c); }
        __syncthreads();
        const float* W = w_pool + (size_t)(l * 4 + gi) * 256 * 256;
        for (int o = F.tid; o < 64 * 256; o += NTHR) { const int j = o >> 8, d = o & 255; float a = 0.f; for (int c = 0; c < 256; ++c) a += pl[j * 256 + c] * W[c * 256 + d];
            const int t = t0 + j; *ob_at(OB, t, gi * 256 + d) = (bf16)f2bf(a * pool_scale[l * 1024 + gi * 256 + d] * Hf(H, t, C_PG + gi * 256 + d)); } }
}
DI void naive_gla(const Frame& F, int l, const float* w_gla_up, const float* b_gla) {
    const bf16* H = wsp<bf16>(F, WS_H); float* RAW = wsp<float>(F, WS_GU); LAS float* red = (LAS float*)(F.lds);
    for (int unit = F.wg; unit < 64; unit += F.G) { const int bh = unit >> 3, es = unit & 7, b = bh >> 2, h = bh & 3, e = es * 32 + (F.tid & 31), dg = F.tid >> 5;
        float S[8], wu[8][16], bg[8];
        for (int i = 0; i < 8; ++i) { S[i] = 0.f; bg[i] = b_gla[l * 512 + h * 128 + 8 * dg + i]; for (int r = 0; r < 16; ++r) wu[i][r] = w_gla_up[(size_t)l * 16 * 512 + r * 512 + h * 128 + 8 * dg + i]; }
        for (int ts = 0; ts < SEQ; ++ts) { const size_t t = (size_t)b * SEQ + ts; float lr[16]; for (int r = 0; r < 16; ++r) lr[r] = Hf(H, t, C_LR + r);
            const float v = Hf(H, t, C_GV + h * 256 + e); float part = 0.f;
            for (int i = 0; i < 8; ++i) { float z = bg[i]; for (int r = 0; r < 16; ++r) z += lr[r] * wu[i][r];
                const float a = expf((fminf(z, 0.f) - log1pf(expf(-fabsf(z)))) * (1.0f / 16.0f));
                S[i] = a * S[i] + Hf(H, t, C_GK + h * 128 + 8 * dg + i) * v; part += Hf(H, t, C_GQ + h * 128 + 8 * dg + i) * 0.08838834764831845f * S[i]; }
            __syncthreads(); red[dg * 32 + (F.tid & 31)] = part; __syncthreads();
            if (dg == 0) { float o = 0.f; for (int g = 0; g < 16; ++g) o += red[g * 32 + (F.tid & 31)]; RAW[t * 1024 + h * 256 + e] = o; } } }
}
DI void naive_gla_norm(const Frame& F, int l, const float* gla_norm) {
    const bf16* H = wsp<bf16>(F, WS_H); bf16* OB = wsp<bf16>(F, WS_OB); const float* RAW = wsp<float>(F, WS_GU);
    const int gw = F.wg * NWAVES + F.wave, NGW = F.G * NWAVES, lane = F.lane;
    for (int it = gw; it < MTOK * 4; it += NGW) { const int t = it >> 2, h = it & 3; float o[4], ss = 0.f;
        for (int i = 0; i < 4; ++i) { o[i] = RAW[(size_t)t * 1024 + h * 256 + lane + 64 * i]; ss += o[i] * o[i]; }
        ss = wave_sum(ss); const float rs = 1.0f / sqrtf(ss * (1.0f / 256.0f) + LN_EPS);
        for (int i = 0; i < 4; ++i) { const int e = lane + 64 * i; *ob_at(OB, t, 1024 + h * 256 + e) = (bf16)f2bf(o[i] * rs * gla_norm[l * 1024 + h * 256 + e] * Hf(H, t, C_GG + h * 256 + e)); } }
}

DI void ln_phase(const Frame& F, int l, const float* ln_g, const float* ln_b) {
    const int gw = F.wg * NWAVES + F.wave, NGW = F.G * NWAVES, lane = F.lane;
    const float* g = ln_g + l * DM; const float* bb = ln_b + l * DM;
    for (int m = gw; m < MTOK; m += NGW) {
        f32x4* row = (f32x4*)(F.out + (size_t)m * DM) + lane; const f32x4* zrow = (const f32x4*)(wsp<float>(F, WS_Z) + (size_t)m * DM) + lane;
        f32x4 v[16]; float s = 0.f;
#pragma unroll
        for (int j = 0; j < 16; ++j) { v[j] = zrow[64 * j]; s += (v[j].x + v[j].y) + (v[j].z + v[j].w); }
        const float mean = wave_sum(s) * (1.f / DM); float s2 = 0.f;
#pragma unroll
        for (int j = 0; j < 16; ++j) { v[j] = v[j] - mean; s2 += (v[j].x * v[j].x + v[j].y * v[j].y) + (v[j].z * v[j].z + v[j].w * v[j].w); }
        const float rstd = 1.f / sqrtf(wave_sum(s2) * (1.f / DM) + LN_EPS);
        u32x2* xb = (u32x2*)(wsp<bf16>(F, WS_XB) + (size_t)m * DM) + lane; unsigned* x8 = (unsigned*)(wsp<unsigned char>(F, WS_X8) + (size_t)m * DM) + lane;
#pragma unroll
        for (int j = 0; j < 16; ++j) { const f32x4 gg = *((const f32x4*)g + lane + 64 * j), be = *((const f32x4*)bb + lane + 64 * j);
            const f32x4 o = v[j] * rstd * gg + be; row[64 * j] = o;
#if F6
            if (l + 1 < DEPTH) { u32x2 w; w.x = pk2(o.x, o.y); w.y = pk2(o.z, o.w); xb[64 * j] = w;
                LAS unsigned char* lw = F.lds + F.wave * 9216;
                *(LAS f32x4*)(lw + ((lane >> 3) + 8 * (j & 7)) * 144 + (lane & 7) * 16) = o * X8_SCALE;
                if ((j & 7) == 7) { LDS_WAIT(); float f[32];
#pragma unroll
                    for (int t = 0; t < 8; ++t) { const f32x4 q = *(const LAS f32x4*)(lw + lane * 144 + 16 * t); f[4 * t] = q.x; f[4 * t + 1] = q.y; f[4 * t + 2] = q.z; f[4 * t + 3] = q.w; }
                    u32x4 lo, hi; pk32_fp6(f, lo, hi); const int gi = 64 * (j >> 3) + lane; size_t ol, oh; pg8::f6_off(m, gi >> 2, gi & 3, ol, oh);
                    *(u32x4*)(wsp<unsigned char>(F, WS_X8) + ol) = lo; u32x2 h2; h2.x = hi.x; h2.y = hi.y; *(u32x2*)(wsp<unsigned char>(F, WS_X8) + oh) = h2; LDS_WAIT(); } } }
#else
            if (l + 1 < DEPTH) { u32x2 w; w.x = pk2(o.x, o.y); w.y = pk2(o.z, o.w); xb[64 * j] = w; x8[64 * j] = pk4_fp8(o.x * X8_SCALE, o.y * X8_SCALE, o.z * X8_SCALE, o.w * X8_SCALE); } }
#endif
    }
}

struct Args { const void* in[15]; float* out; unsigned char* ws; int ph_lo, ph_hi; };
constexpr int PH_PER_LAYER = 7, N_PHASES = 1 + PH_PER_LAYER * DEPTH;
#define IN(k) (lo <= (k) && (k) < hi)
#ifndef PH_MASK
#define PH_MASK 0xffff
#endif
#define PHM(b) ((PH_MASK >> (b)) & 1)
#ifndef REP_MASK
#define REP_MASK 0
#endif
#define REPS(b) (((REP_MASK >> (b)) & 1) ? 2 : 1)
#define SEAM(k) do { if (IN(k) && IN((k) + 1)) xcd_barrier(bar); } while (0)
#ifndef PROBE_CLK
#define PROBE_CLK 0
#endif
#ifndef PROBE_HOT
#define PROBE_HOT 0
#endif
struct SchedHot {
    static constexpr bool BLK = false;
    int G, c, mode; const char* A; const char* B;
    DI bool next(int i, pg8::Unit& u) const { if (i >= 4) return false; if (mode == 1) { u.pm = c & 7; u.pn = 0; } else if (mode == 4) { u.pm = c & 7; u.pn = c & 7; } else pg8::static_tile(i * G + c, 32, 32, u.pm, u.pn); u.gi = 0; return true; }
    DI const char* abase(const pg8::Unit& u) const { return A + (size_t)u.pm * 256 * 4096 * 2; }
    DI const char* bbase(const pg8::Unit& u) const { return B + (size_t)u.pn * 256 * 4096 * 2; }
};
struct SchedHot6 {
    static constexpr bool BLK = false;
    int G, c, mode; const char* A; const char* B;
    DI bool next(int i, pg8::Unit& u) const { if (i >= 4) return false; if (mode == 6) { u.pm = c & 7; u.pn = c & 7; } else pg8::static_tile(i * G + c, 32, 32, u.pm, u.pn); u.gi = 0; return true; }
    DI const char* abase(const pg8::Unit& u) const { return A + (size_t)u.pm * 786432; }
    DI const char* bbase(const pg8::Unit& u) const { return (mode == 6 ? A : B) + (size_t)u.pn * 786432; }
};
struct SchedHotBlk : SchedHot { static constexpr bool BLK = true; };
template <int l> DI void layer_body(const Frame& F, const Args& args, const int lo, const int hi, const XcdBarrier& bar) {
        const int p0 = 1 + PH_PER_LAYER * l;
        if (PHM(1) && IN(p0)) { {
            SchedInProj S; S.G = F.G; S.c = F.wg; S.n_extra = (l == 0) ? 32 : 0; S.XB = (const char*)(F.ws + WS_XB); S.WT = (const char*)(F.ws + WS_WINT) + (size_t)l * NH * 4096 * 2;
            S.MEMB = (const char*)(F.ws + WS_MEMB); S.WKV = (const char*)(F.ws + WS_WMKVT);
            EpiH E{wsp<bf16>(F, WS_H), wsp<bf16>(F, WS_MK), wsp<bf16>(F, WS_MVT)};
            pg8::SchedStatic S8; S8.nM = 32; S8.nN = N_F8 / (128 * F8NB); S8.G = F.G; S8.c = (F.wg + F8_ROT) % F.G; S8.A = (const char*)(F.ws + WS_X8); S8.B = (const char*)(F.ws + WS_W8) + (size_t)l * W8_LAYER;
            S8.astep = F6 ? (size_t)2 * 32 * 12288 : (size_t)256 * 4096; S8.bstep = F6 ? (size_t)F8NB * 32 * 12288 : (size_t)(128 * F8NB) * 4096;
            EpiMG<F8NB> E8{wsp<bf16>(F, WS_H)};
#if F6_FIRST
            pg8::gemm_phase<EpiMG<F8NB>, pg8::SchedStatic, F8NB, true, true>(F.lds, 2048, S8, E8);
            pg8::gemm_phase<EpiH, SchedInProj, 2, true>(F.lds, 4096, S, E);
#else
            pg8::gemm_phase<EpiH, SchedInProj, 2, true>(F.lds, 4096, S, E);
            pg8::gemm_phase<EpiMG<F8NB>, pg8::SchedStatic, F8NB, true, true>(F.lds, 2048, S8, E8);
#endif
        }
        if (PROBE_HOT >= 5 && l == 0) {
            SchedHot6 S6; S6.G = F.G; S6.c = F.wg; S6.mode = PROBE_HOT; S6.A = (const char*)(F.ws + WS_X8); S6.B = (const char*)(F.ws + WS_W8);
            EpiMG<F8NB> E6{(bf16*)(F.ws + (size_t)1700 * MiB)};
            pg8::gemm_phase<EpiMG<F8NB>, SchedHot6, F8NB, true, true>(F.lds, 2048, S6, E6);
        } else
        if (PROBE_HOT != 0 && l == 0) {
            SchedHot S; S.G = F.G; S.c = F.wg; S.mode = PROBE_HOT; S.A = (const char*)(F.ws + WS_XB); S.B = (PROBE_HOT == 4) ? (const char*)(F.ws + WS_XB) : (const char*)(F.ws + WS_WINT);
            EpiH E{(bf16*)(F.ws + (size_t)1700 * MiB), wsp<bf16>(F, WS_MK), wsp<bf16>(F, WS_MVT)};
            if (PROBE_HOT == 3) { SchedHotBlk S3; S3.G = S.G; S3.c = S.c; S3.mode = 2; S3.A = S.A; S3.B = S.B; pg8::gemm_phase<EpiH, SchedHotBlk, 2, true>(F.lds, 4096, S3, E); }
            else pg8::gemm_phase<EpiH, SchedHot, 2, true>(F.lds, 4096, S, E);
        }
        if (REPS(1) == 2) {
            SchedInProj S; S.G = F.G; S.c = F.wg; S.n_extra = (l == 0) ? 32 : 0; S.XB = (const char*)(F.ws + WS_XB); S.WT = (const char*)(F.ws + WS_WINT) + (size_t)l * NH * 4096 * 2;
            S.MEMB = (const char*)(F.ws + WS_MEMB); S.WKV = (const char*)(F.ws + WS_WMKVT);
            EpiH E{wsp<bf16>(F, WS_H), wsp<bf16>(F, WS_MK), wsp<bf16>(F, WS_MVT)};
            pg8::gemm_phase<EpiH, SchedInProj, 2, true>(F.lds, 4096, S, E);
            pg8::SchedStatic S8; S8.nM = 32; S8.nN = N_F8 / (128 * F8NB); S8.G = F.G; S8.c = (F.wg + F8_ROT) % F.G; S8.A = (const char*)(F.ws + WS_X8); S8.B = (const char*)(F.ws + WS_W8) + (size_t)l * W8_LAYER;
            S8.astep = F6 ? (size_t)2 * 32 * 12288 : (size_t)256 * 4096; S8.bstep = F6 ? (size_t)F8NB * 32 * 12288 : (size_t)(128 * F8NB) * 4096;
            EpiMG<F8NB> E8{wsp<bf16>(F, WS_H)};
            pg8::gemm_phase<EpiMG<F8NB>, pg8::SchedStatic, F8NB, true, true>(F.lds, 2048, S8, E8);
        } }
        SEAM(p0);
        if (PHM(2) && IN(p0 + 1)) for (int rep = 0; rep < REPS(2); ++rep) { if (NAIVE_MASK & 2) naive_gla(F, l, (const float*)args.in[6], (const float*)args.in[7]); else for (int u = F.wg; u < 512; u += F.G) gla_a_unit(F, l, u, (const float*)args.in[6], (const float*)args.in[7]); }
        SEAM(p0 + 1);
        if (PHM(3) && IN(p0 + 2)) for (int rep = 0; rep < REPS(3); ++rep) { if (!(NAIVE_MASK & 2)) gla_scan(F); }
        SEAM(p0 + 2);
        if (PHM(4) && IN(p0 + 3)) for (int rep = 0; rep < REPS(4); ++rep) {
            if (NAIVE_MASK & 2) naive_gla_norm(F, l, (const float*)args.in[8]); else
            for (int r2 = 0; r2 < REPS(8); ++r2) for (int u = F.wg; u < 512; u += F.G) gla_c_unit(F, l, u, (const float*)args.in[8]);
            if (NAIVE_MASK & 1) naive_pool(F, l, (const float*)args.in[4], (const float*)args.in[5]); else
            for (int r2 = 0; r2 < REPS(9); ++r2) for (int u = F.wg; u < 256; u += F.G) pool_unit(F, l, u, (const float*)args.in[5]);
            __syncthreads();
            if (NAIVE_MASK & 4) naive_swa(F, l, (const float*)args.in[9]); else
            for (int r2 = 0; r2 < REPS(10); ++r2) for (int u = F.wg; u < 1024; u += F.G) swa_unit(F, l, u, (const float*)args.in[9]);
            __syncthreads();
            if (NAIVE_MASK & 8) naive_mem(F, l); else
            for (int r2 = 0; r2 < REPS(11); ++r2) for (int u = F.wg; u < 256; u += F.G) mem_unit(F, l, u);
            __syncthreads();
        }
        SEAM(p0 + 3);
        if (PHM(5) && IN(p0 + 4)) { {
            pg8::SchedStatic S; S.nM = 32; S.nN = 32; S.G = F.G; S.c = F.wg; S.A = (const char*)(F.ws + WS_OB); S.B = (const char*)(F.ws + WS_WBRT) + (size_t)l * 4096 * 4096 * 2;
            S.astep = (size_t)256 * 4096 * 2; S.bstep = (size_t)128 * 4096 * 2;
            EpiGate E{wsp<bf16>(F, WS_H), wsp<bf16>(F, WS_YB)};
            if (BLK_GATE) { pg8::SchedStaticBlk SB; (pg8::SchedStatic&)SB = S; pg8::gemm_phase<EpiGate, pg8::SchedStaticBlk, 1, true>(F.lds, 4096, SB, E); } else
            pg8::gemm_phase<EpiGate, pg8::SchedStatic, 1, true>(F.lds, 4096, S, E);
        }
        if (REPS(5) == 2) {
            pg8::SchedStatic S; S.nM = 32; S.nN = 32; S.G = F.G; S.c = F.wg; S.A = (const char*)(F.ws + WS_OB); S.B = (const char*)(F.ws + WS_WBRT) + (size_t)l * 4096 * 4096 * 2;
            S.astep = (size_t)256 * 4096 * 2; S.bstep = (size_t)128 * 4096 * 2;
            EpiGate E{wsp<bf16>(F, WS_H), wsp<bf16>(F, WS_YB)};
            if (BLK_GATE) { pg8::SchedStaticBlk SB; (pg8::SchedStatic&)SB = S; pg8::gemm_phase<EpiGate, pg8::SchedStaticBlk, 1, true>(F.lds, 4096, SB, E); } else
            pg8::gemm_phase<EpiGate, pg8::SchedStatic, 1, true>(F.lds, 4096, S, E);
        } }
        SEAM(p0 + 4);
        if (PHM(6) && IN(p0 + 5)) { {
            pg8::SchedStatic S; S.nM = 32; S.nN = 16; S.G = F.G; S.c = F.wg; S.A = (const char*)(F.ws + WS_YB); S.B = (const char*)(F.ws + WS_WOUTT) + (size_t)l * 4096 * 4096 * 2;
            S.astep = (size_t)256 * 4096 * 2; S.bstep = (size_t)256 * 4096 * 2;
            EpiRes E{l == 0 ? (const float*)args.in[0] : (const float*)F.out, wsp<float>(F, WS_Z)};
            if (BLK_OUT) { pg8::SchedStaticBlk SB; (pg8::SchedStatic&)SB = S; pg8::gemm_phase<EpiRes, pg8::SchedStaticBlk, 2, true>(F.lds, 4096, SB, E); } else
            pg8::gemm_phase<EpiRes, pg8::SchedStatic, 2, true>(F.lds, 4096, S, E);
        }
        if (REPS(6) == 2) {
            pg8::SchedStatic S; S.nM = 32; S.nN = 16; S.G = F.G; S.c = F.wg; S.A = (const char*)(F.ws + WS_YB); S.B = (const char*)(F.ws + WS_WOUTT) + (size_t)l * 4096 * 4096 * 2;
            S.astep = (size_t)256 * 4096 * 2; S.bstep = (size_t)256 * 4096 * 2;
            EpiRes E{l == 0 ? (const float*)args.in[0] : (const float*)F.out, wsp<float>(F, WS_Z)};
            if (BLK_OUT) { pg8::SchedStaticBlk SB; (pg8::SchedStatic&)SB = S; pg8::gemm_phase<EpiRes, pg8::SchedStaticBlk, 2, true>(F.lds, 4096, SB, E); } else
            pg8::gemm_phase<EpiRes, pg8::SchedStatic, 2, true>(F.lds, 4096, S, E);
        } }
        SEAM(p0 + 5);
        if (PHM(7) && IN(p0 + 6)) for (int rep = 0; rep < REPS(7); ++rep) { ln_phase(F, l, (const float*)args.in[13], (const float*)args.in[14]); }
        SEAM(p0 + 6);
}


__global__ void __launch_bounds__(NTHR, 2) mk_fwd(Args args) {
    extern __shared__ __attribute__((aligned(16))) unsigned char lds_raw[];
    Frame F;
    F.lds = (LAS unsigned char*)lds_raw;
    F.tid = threadIdx.x; F.lane = F.tid & 63; F.wave = __builtin_amdgcn_readfirstlane(F.tid >> 6); F.G = gridDim.x; F.wg = blockIdx.x;
    F.out = args.out; F.ws = args.ws;
    volatile LAS unsigned* MISC = (volatile LAS unsigned*)(F.lds + MISC_OFF);
    for (int u = F.tid; u < (LDS_BYTES - LDSCTL_OFF) / 4; u += NTHR) ((LAS unsigned*)(F.lds + LDSCTL_OFF))[u] = 0u;
    __syncthreads();
    unsigned* barw = (unsigned*)(F.ws + WS_CTL) + CW_BAR;
    XcdBarrier bar; bar.bar = barw; bar.x = 0; bar.st = nullptr;
    const int lo = args.ph_lo, hi = args.ph_hi;
    if (hi - lo > 1) bar = xcd_barrier_post(barw, MISC + 8);

    if (PHM(0) && IN(0)) for (int rep = 0; rep < REPS(0); ++rep) { prologue(F, (const float*)args.in[0], (const float*)args.in[1], (const int*)args.in[2], (const float*)args.in[3], (const float*)args.in[4], (const float*)args.in[10], (const float*)args.in[11], (const float*)args.in[12]); }
    SEAM(0);
    layer_body<0>(F, args, lo, hi, bar);
#if PROBE_CLK
    const long long pc0 = clock64(), pw0 = wall_clock64();
#endif
    layer_body<1>(F, args, lo, hi, bar);
#if PROBE_CLK
    if (blockIdx.x == 0 && threadIdx.x == 0) {
        const long long dc = clock64() - pc0, dw = wall_clock64() - pw0; const long long fmhz = dw > 0 ? 100 * dc / dw : 0; const long long ticks = (fmhz - 1000) * 100;
        if (ticks > 0 && ticks < 300000) { const long long s0 = wall_clock64(); while (wall_clock64() - s0 < ticks) __builtin_amdgcn_s_sleep(8); }
    }
#endif
#if PROBE_T
    if (blockIdx.x == 0 && threadIdx.x == 0) {
        const unsigned acc_t = ((volatile LAS unsigned*)(F.lds + MISC_OFF + 128))[PROBE_T]; const long long ticks = 8ll * acc_t;
        if (ticks > 0 && ticks < 400000) { const long long s0 = wall_clock64(); while (wall_clock64() - s0 < ticks) __builtin_amdgcn_s_sleep(8); }
    }
#endif
#undef IN
#undef SEAM
}

extern "C" void kernel_launch(void* const* d_in, const int* in_sizes, int n_in, void* d_out, int out_size, void* d_ws, size_t ws_size, hipStream_t stream) {
    static int grid = 0;
    if (grid == 0) {
        if (n_in != 15 || out_size != MTOK * DM || ws_size < WS_END) { fprintf(stderr, "kernel_launch: unexpected sizes (n_in %d, out %d, ws %zu); nothing launched\n", n_in, out_size, ws_size); grid = -1; return; }
        int dev = 0, cus = 0, per_cu = 0;
        if (hipGetDevice(&dev) != hipSuccess || hipDeviceGetAttribute(&cus, hipDeviceAttributeMultiprocessorCount, dev) != hipSuccess) { grid = -1; return; }
        if (hipFuncSetAttribute((const void*)mk_fwd, hipFuncAttributeMaxDynamicSharedMemorySize, LDS_BYTES) != hipSuccess) { fprintf(stderr, "kernel_launch: hipFuncSetAttribute failed\n"); grid = -1; return; }
        if (hipOccupancyMaxActiveBlocksPerMultiprocessor(&per_cu, (const void*)mk_fwd, NTHR, LDS_BYTES) != hipSuccess || per_cu < 1) fprintf(stderr, "kernel_launch: occupancy query says %d\n", per_cu);
        (void)hipGetLastError();
        grid = cus;
    }
    if (grid < 0) return;
    (void)hipMemsetAsync((char*)d_ws + WS_CTL, 0, CTL_ZERO_BYTES, stream);
    Args a{};
    for (int i = 0; i < 15; ++i) a.in[i] = d_in[i];
    a.out = (float*)d_out; a.ws = (unsigned char*)d_ws;
#if MK_PER_PHASE
    for (int p = 0; p < N_PHASES; ++p) { a.ph_lo = p; a.ph_hi = p + 1; hipLaunchKernelGGL(mk_fwd, dim3(grid), dim3(NTHR), LDS_BYTES, stream, a); }
#else
    a.ph_lo = 0; a.ph_hi = N_PHASES;
    hipLaunchKernelGGL(mk_fwd, dim3(grid), dim3(NTHR), LDS_BYTES, stream, a);
#endif
}
```

```cpp
#include <hip/hip_runtime.h>
#include <cstdio>
#include <cstdint>

#ifndef F8ASM1
#define F8ASM1 0
#endif
#ifndef F8NB
#define F8NB 2
#endif
#ifndef MK_PER_PHASE
#define MK_PER_PHASE 0
#endif

#define DI __device__ __forceinline__
#define LAS __attribute__((address_space(3)))
#define GAS __attribute__((address_space(1)))
typedef unsigned short bf16;
typedef short bf16x8 __attribute__((ext_vector_type(8)));
typedef short s16x4 __attribute__((ext_vector_type(4)));
typedef short v4i16_t __attribute__((ext_vector_type(4)));
typedef float f32x4 __attribute__((ext_vector_type(4)));
typedef float f32x2 __attribute__((ext_vector_type(2)));
typedef unsigned u32x4 __attribute__((ext_vector_type(4)));
typedef unsigned u32x2 __attribute__((ext_vector_type(2)));

constexpr int BATCH = 2, SEQ = 4096, DM = 4096, MTOK = BATCH * SEQ, DEPTH = 2;
constexpr int D_IN = 25872, NH = 26112;
constexpr int BW = 1024;
constexpr int MEMLEN = 256;
constexpr int C_PU = 0, C_PG = 1024, C_GQ = 2048, C_GK = 2560, C_GV = 3072, C_GG = 4096, C_SQ = 5120, C_SK = 6144, C_SV = 6272, C_SG = 6400, C_XQ = 7424, C_XG = 8448, C_MG = 9472, C_LR = 25856;
constexpr float LN_EPS = 1e-5f;
constexpr float DN_ALPHA = 1.41421356237309515f;

constexpr size_t MiB = 1u << 20;
constexpr size_t WS_CTL = 0, CTL_ZERO_BYTES = 1 * MiB;
constexpr size_t WS_ROPE = 1 * MiB;
constexpr size_t WS_WPOOLT = 2 * MiB;
constexpr size_t WS_MEMB = 4 * MiB;
constexpr size_t WS_MK = 8 * MiB;
constexpr size_t WS_MVT = 10 * MiB;
constexpr size_t WS_DEC = 12 * MiB;
constexpr size_t WS_WMKVT = 16 * MiB;
constexpr size_t WS_WBRT = 48 * MiB;
constexpr size_t WS_WOUTT = 112 * MiB;
constexpr size_t WS_XB = 176 * MiB;
constexpr size_t WS_OB = 240 * MiB;
constexpr size_t WS_YB = 304 * MiB;
constexpr size_t WS_GU = 368 * MiB;
constexpr size_t WS_GS = 432 * MiB;
constexpr size_t WS_GB = 464 * MiB;
constexpr size_t WS_WINT = 512 * MiB;
constexpr size_t WS_H = 928 * MiB;
constexpr size_t WS_Z = 1336 * MiB;
constexpr size_t WS_X8 = 1464 * MiB;
constexpr size_t WS_W8 = 1496 * MiB;
constexpr size_t WS_END = 1660 * MiB;
constexpr int C_F8 = C_SQ, N_F8 = C_LR - C_F8;
#ifndef STAGE_LATE
#define STAGE_LATE 0
#endif
#ifndef PRO_NFAST
#define PRO_NFAST 1
#endif
#ifndef BLK_GATE
#define BLK_GATE 1
#endif
#ifndef BLK_OUT
#define BLK_OUT 1
#endif
#ifndef F6_FIRST
#define F6_FIRST 1
#endif
#ifndef F8_ROT
#define F8_ROT 64
#endif
#ifndef F6
#define F6 1
#endif
constexpr size_t W8_LAYER = F6 ? (size_t)(N_F8 / 128) * 32 * 12288 : (size_t)N_F8 * 4096;
constexpr float X8_SCALE = F6 ? 2.0f : 16.0f, W8_SCALE = F6 ? 128.0f : 2048.0f, MG_DESCALE = 1.0f / (X8_SCALE * W8_SCALE);
constexpr int CW_BAR = 4096;

constexpr int RING_BYTES = 131072;
constexpr int THIN_BYTES = 141312;
constexpr int LDSCTL_OFF = THIN_BYTES, MISC_OFF = LDSCTL_OFF + 320;
constexpr int LDS_BYTES = 147456;
constexpr int NWAVES = 8, NTHR = 512;

DI float bf2f(unsigned v) { return __builtin_bit_cast(float, v << 16); }
DI unsigned f2bf(float f) { unsigned u = __builtin_bit_cast(unsigned, f); return (u + 0x7fffu + ((u >> 16) & 1u)) >> 16; }
typedef float f32x2_t __attribute__((ext_vector_type(2))); typedef __bf16 bf16x2_t __attribute__((ext_vector_type(2)));
DI unsigned cvt_pk_bf16(float lo, float hi) { const f32x2_t v = {lo, hi}; const bf16x2_t b = __builtin_convertvector(v, bf16x2_t); return __builtin_bit_cast(unsigned, b); }
DI unsigned pk2(float lo, float hi) { return cvt_pk_bf16(lo, hi); }
DI float fast_sigmoid(float v) { return __builtin_amdgcn_rcpf(1.0f + __builtin_amdgcn_exp2f(-1.44269504089f * v)); }
DI void unpack8(const u32x4 w, float (&f)[8]) {
    f[0] = bf2f(w.x & 0xffffu); f[1] = bf2f(w.x >> 16); f[2] = bf2f(w.y & 0xffffu); f[3] = bf2f(w.y >> 16);
    f[4] = bf2f(w.z & 0xffffu); f[5] = bf2f(w.z >> 16); f[6] = bf2f(w.w & 0xffffu); f[7] = bf2f(w.w >> 16);
}
DI u32x4 pack8(const float (&f)[8]) { u32x4 w; w.x = pk2(f[0], f[1]); w.y = pk2(f[2], f[3]); w.z = pk2(f[4], f[5]); w.w = pk2(f[6], f[7]); return w; }
DI float clamp448(float v) { return fminf(fmaxf(v, -448.0f), 448.0f); }
DI unsigned pk4_fp8(float a, float b, float c, float d) {
    int w = 0; w = __builtin_amdgcn_cvt_pk_fp8_f32(clamp448(a), clamp448(b), w, false); w = __builtin_amdgcn_cvt_pk_fp8_f32(clamp448(c), clamp448(d), w, true); return (unsigned)w; }
typedef int v8i32 __attribute__((ext_vector_type(8)));
typedef int v6i32 __attribute__((ext_vector_type(6)));
typedef int v4i32 __attribute__((ext_vector_type(4)));
typedef unsigned u32x6 __attribute__((ext_vector_type(6)));
typedef float f32x16 __attribute__((ext_vector_type(16)));
DI void pk32_fp6(const float (&f)[32], u32x4& lo, u32x4& hi) {
    f32x16 a, b;
#pragma unroll
    for (int i = 0; i < 16; ++i) { a[i] = f[i]; b[i] = f[16 + i]; }
    const u32x6 r = __builtin_amdgcn_cvt_scalef32_2xpk16_fp6_f32(a, b, 1.0f);
    lo.x = r[0]; lo.y = r[1]; lo.z = r[2]; lo.w = r[3]; hi.x = r[4]; hi.y = r[5]; hi.z = 0u; hi.w = 0u;
}
DI f32x4 mma16(bf16x8 a, bf16x8 b, f32x4 c) { return __builtin_amdgcn_mfma_f32_16x16x32_bf16(a, b, c, 0, 0, 0); }
DI bf16x8 frag_lds(const LAS bf16* img, int ld, int idx0, int k0, int lane) { return *(const LAS bf16x8*)(img + (idx0 + (lane & 15)) * ld + k0 + 8 * (lane >> 4)); }
DI bf16x8 frag_glb(const bf16* img, size_t ld, int idx0, int k0, int lane) { return *(const bf16x8*)(img + (size_t)(idx0 + (lane & 15)) * ld + k0 + 8 * (lane >> 4)); }
DI s16x4 tr4(const LAS bf16* p) { return __builtin_bit_cast(s16x4, __builtin_amdgcn_ds_read_tr16_b64_v4i16((LAS v4i16_t*)p)); }
DI bf16x8 frag_tr(const LAS bf16* img, int ld, int k0, int idx0, int lane) {
    const int g = lane >> 4, q = (lane >> 2) & 3, p = lane & 3;
    const LAS bf16* a0 = img + (k0 + 8 * g + q) * ld + idx0 + 4 * p;
    const s16x4 lo = tr4(a0), hi = tr4(a0 + 4 * ld);
    return __builtin_shufflevector(lo, hi, 0, 1, 2, 3, 4, 5, 6, 7);
}
DI float wave_sum(float v) {
#pragma unroll
    for (int o = 1; o < 64; o <<= 1) v += __shfl_xor(v, o);
    return v;
}
#define LDS_WAIT() asm volatile("s_waitcnt lgkmcnt(0)" ::: "memory")
#define VM_WAIT() asm volatile("s_waitcnt vmcnt(0)" ::: "memory")

namespace pg8 {
constexpr int BM = 256, BK = 64, HALF = 128, HTB = HALF * BK * 2, STAGE_BYTES = 8 * HTB, NXCD = 8, WGM = 8;
__host__ __device__ __forceinline__ int lds_byte(int r, int c) { const int st = (r >> 4) * 2 + (c >> 5), rr = r & 15, cc = c & 31, ob = rr * 64 + cc * 2; return st * 1024 + (ob ^ (((ob >> 9) & 1) << 5)); }
__host__ __device__ __forceinline__ void stage_rc(int b, int& R, int& C) { const int st = b / 1024, sb = b % 1024, swz = sb ^ (((sb >> 9) & 1) << 5); R = (st >> 1) * 16 + swz / 64; C = (st & 1) * 32 + (swz % 64) / 2; }
__host__ __device__ __forceinline__ int perm32(int rho) { const int n = rho >> 4, i = rho & 15; return 8 * (i >> 2) + 4 * n + (i & 3); }
__host__ __device__ __forceinline__ int invperm32(int v) { return 16 * ((v >> 2) & 1) + 4 * (v >> 3) + (v & 3); }
template <bool PERM> __host__ __device__ __forceinline__ size_t blk_off(int row, int k, int NT) {
    const int r = PERM ? ((row & ~31) + invperm32(row & 31)) : row;
    return ((size_t)(r >> 7) * NT + (k >> 6)) * 16384 + lds_byte(r & 127, k & 63);
}
__host__ __device__ __forceinline__ void f6_off(int row, int step, int q, size_t& lo, size_t& hi) {
    const int ht = row >> 7, rb = (row >> 4) & 7, rr = row & 15;
    const size_t base = ((size_t)ht * 32 + step) * 12288;
    lo = base + rb * 1024 + lds_byte(rr, q * 8);
    hi = base + 8192 + rb * 512 + q * 128 + rr * 8;
}

struct Unit { int pm, pn, gi; };

DI void static_tile(int L, int nM, int nN, int& pm, int& pn) {
    const int nwg = nM * nN; int wgid = L;
    { const int q = nwg / NXCD, r = nwg % NXCD, xcd = wgid % NXCD, off = wgid / NXCD; wgid = (xcd < r ? xcd * (q + 1) : r * (q + 1) + (xcd - r) * q) + off; }
    const int nig = WGM * nN, gid = wgid / nig, fm = gid * WGM, gsz = (nM - fm) < WGM ? (nM - fm) : WGM;
    pm = fm + ((wgid % nig) % gsz); pn = (wgid % nig) / gsz;
}
struct SchedStatic {
    static constexpr bool BLK = false;
    int nM, nN, G, c; const char* A; const char* B; size_t astep, bstep;
    DI bool next(int i, Unit& u) const { const long L = (long)i * G + c; if (L >= (long)nM * nN) return false; static_tile((int)L, nM, nN, u.pm, u.pn); u.gi = 0; return true; }
    DI const char* abase(const Unit& u) const { return A + (size_t)u.pm * astep; }
    DI const char* bbase(const Unit& u) const { return B + (size_t)u.pn * bstep; }
};
struct SchedStaticBlk : SchedStatic { static constexpr bool BLK = true; };

template <class Epi, class Sched, int NB, bool ALIGN_EPI, bool F8 = false>
DI void gemm_phase(LAS unsigned char* lds, const int K, const Sched& S, const Epi& E) {
    const int tid = threadIdx.x, wid = __builtin_amdgcn_readfirstlane(tid >> 6), lane = tid & 63, wr = wid >> 2, wc = wid & 3, fr = lane & 15, fq = lane >> 4;
    const int nt = K / BK;
    constexpr bool FP6 = F8 && (F6 != 0);
    unsigned voffA[2], voffB[2];
#pragma unroll
    for (int i = 0; i < 2; ++i) { int R, C; stage_rc(tid * 16 + i * 8192, R, C); const int Rb = Epi::PERM ? ((R & ~31) + perm32(R & 31)) : R;
        voffA[i] = (unsigned)(R * K + C) * 2u; voffB[i] = (unsigned)(Rb * K + C) * 2u;
        if constexpr (FP6) { voffA[i] = (unsigned)(((wid & 3) + 4 * i) * 1024 + lane * 16); voffB[i] = voffA[i]; }
        if constexpr (Sched::BLK) { voffA[i] = (unsigned)((wid + 8 * i) * 1024 + lane * 16); voffB[i] = voffA[i]; } }
    const unsigned voffS = (unsigned)((8 + (wid & 3)) * 1024 + lane * 16);
    const size_t kstep = FP6 ? (size_t)12288 : (Sched::BLK ? (size_t)16384 : (size_t)(BK * 2));
    const size_t hstep = FP6 ? (size_t)nt * 12288 : (Sched::BLK ? (size_t)nt * 16384 : (size_t)HALF * K * 2);
    const unsigned ldsw = (unsigned)wid * 1024u;
    const int swz6 = lds_byte(fr, fq * 8), hof6 = fq * 128 + fr * 8;
    const int aoff6 = wr * 4096 + swz6, ahi6 = 8192 + wr * 2048 + hof6, boff6 = wc * 2048 + swz6, bhi6 = 8192 + wc * 1024 + hof6;
    const int aoff = lds_byte(wr * 64 + fr, fq * 8), boff = lds_byte(wc * 32 + fr, fq * 8);
    constexpr int KOFF = 1024;
    const unsigned one_scale = 0x7f7f7f7fu;
#define PG8_SA(b, h) (((b) * 2 + (h)) * HTB)
#define PG8_SB(b, h) ((4 + (b) * 2 + (h)) * HTB)
#define PG8_STAGE(bufoff, gbase, voff) do { if constexpr (FP6) { \
        if ((wid >> 2) != (((bufoff) / HTB) & 1)) { _Pragma("unroll") for (int _i = 0; _i < 2; ++_i) \
            __builtin_amdgcn_global_load_lds((const unsigned*)((const char*)(gbase) + voffA[_i]), (LAS unsigned*)(lds + (bufoff) + (wid & 3) * 1024 + _i * 4096), 16, 0, 0); } \
        else __builtin_amdgcn_global_load_lds((const unsigned*)((const char*)(gbase) + voffS), (LAS unsigned*)(lds + (bufoff) + 8192 + (wid & 3) * 1024), 16, 0, 0); \
    } else { _Pragma("unroll") for (int _i = 0; _i < 2; ++_i) \
        __builtin_amdgcn_global_load_lds((const unsigned*)((const char*)(gbase) + (voff)[_i]), (LAS unsigned*)(lds + (bufoff) + ldsw + _i * 8192), 16, 0, 0); } } while (0)
#define PG8_W64(p) ({ const s16x4 _v = *(const volatile LAS s16x4*)(p); __builtin_shufflevector(_v, _v, 0, 1, 2, 3, -1, -1, -1, -1); })
#define PG8_LDA(dst, b, h) do { if constexpr (FP6) { _Pragma("unroll") for (int m = 0; m < 4; ++m) { dst[m][0] = *(const LAS bf16x8*)(lds + PG8_SA(b, h) + aoff6 + m * 1024); dst[m][1] = PG8_W64(lds + PG8_SA(b, h) + ahi6 + m * 512); } } \
    else { _Pragma("unroll") for (int m = 0; m < 4; ++m) _Pragma("unroll") for (int k = 0; k < 2; ++k) dst[m][k] = *(const LAS bf16x8*)(lds + PG8_SA(b, h) + aoff + m * 2048 + k * KOFF); } } while (0)
#define PG8_LDB(dst, b, h) do { if constexpr (FP6) { _Pragma("unroll") for (int n = 0; n < 2; ++n) { dst[n][0] = *(const LAS bf16x8*)(lds + PG8_SB(b, h) + boff6 + n * 1024); dst[n][1] = PG8_W64(lds + PG8_SB(b, h) + bhi6 + n * 512); } } \
    else { _Pragma("unroll") for (int n = 0; n < 2; ++n) _Pragma("unroll") for (int k = 0; k < 2; ++k) dst[n][k] = *(const LAS bf16x8*)(lds + PG8_SB(b, h) + boff + n * 2048 + k * KOFF); } } while (0)
#define PG8_CAT6(x) __builtin_shufflevector(__builtin_bit_cast(v4i32, (x)[0]), __builtin_bit_cast(v4i32, (x)[1]), 0, 1, 2, 3, 4, 5)
#define PG8_CAT(x) __builtin_bit_cast(v8i32, __builtin_shufflevector((x)[0], (x)[1], 0, 1, 2, 3, 4, 5, 6, 7, 8, 9, 10, 11, 12, 13, 14, 15))
#define PG8_MMA(ai, bj, At, Bt) do { __builtin_amdgcn_s_setprio(1); _Pragma("unroll") for (int m = 0; m < 4; ++m) _Pragma("unroll") for (int n = 0; n < 2; ++n) { \
        if constexpr (F8 && NB == 1 && !F8ASM1) acc[ai][bj][m][n] = __builtin_amdgcn_mfma_scale_f32_16x16x128_f8f6f4(PG8_CAT(Bt[n]), PG8_CAT(At[m]), acc[ai][bj][m][n], 0, 0, 0, 0x7f7f7f7f, 0, 0x7f7f7f7f); \
        else if constexpr (F8 && F6 != 0) { asm volatile("s_nop 1\n\tv_mfma_scale_f32_16x16x128_f8f6f4 %0, %1, %2, %0, %3, %3 op_sel_hi:[0,0,0] cbsz:2 blgp:2" : "+v"(acc[ai][bj][m][n]) : "v"(PG8_CAT6(Bt[n])), "v"(PG8_CAT6(At[m])), "v"(one_scale)); } \
        else if constexpr (F8) { asm volatile("s_nop 1\n\tv_mfma_scale_f32_16x16x128_f8f6f4 %0, %1, %2, %0, %3, %3 op_sel_hi:[0,0,0]" : "+v"(acc[ai][bj][m][n]) : "v"(PG8_CAT(Bt[n])), "v"(PG8_CAT(At[m])), "v"(one_scale)); } \
        else { _Pragma("unroll") for (int k = 0; k < 2; ++k) acc[ai][bj][m][n] = __builtin_amdgcn_mfma_f32_16x16x32_bf16(Bt[n][k], At[m][k], acc[ai][bj][m][n], 0, 0, 0); } } \
        __builtin_amdgcn_s_setprio(0); } while (0)
#define PG8_WAIT_V(n) asm volatile("s_waitcnt vmcnt(" #n ")" ::: "memory")
#define PG8_WAIT_L(n) asm volatile("s_waitcnt lgkmcnt(" #n ")" ::: "memory")
#define PG8_BAR __builtin_amdgcn_s_barrier()
#define PG8_SCHED __builtin_amdgcn_sched_barrier(0)
#define PG8_WAIT_LA() do { if constexpr (FP6) PG8_WAIT_V(4); else PG8_WAIT_V(6); } while (0)
#define PG8_WAIT_LB() do { if constexpr (FP6) PG8_WAIT_V(1); else PG8_WAIT_V(2); } while (0)
#define PG8_WAIT_MAIN() do { if constexpr (FP6) PG8_WAIT_V(6); else PG8_WAIT_V(8); } while (0)
    Unit cur, nxt; int ui = 0;
    if (!S.next(0, cur)) return;
    f32x4 acc[2][NB][4][2];
    f32x4 yac[2][4][2];
#pragma unroll
    for (int a = 0; a < 2; ++a)
#pragma unroll
        for (int m = 0; m < 4; ++m)
#pragma unroll
            for (int n = 0; n < 2; ++n) { yac[a][m][n] = (f32x4){0.f, 0.f, 0.f, 0.f};
#pragma unroll
                for (int b = 0; b < NB; ++b) acc[a][b][m][n] = (f32x4){0.f, 0.f, 0.f, 0.f}; }
    bf16x8 At[4][2], B0[2][2], B1[2][2];
    const char* cA = S.abase(cur); const char* cB = S.bbase(cur);
    if constexpr (NB == 2) {
        PG8_STAGE(PG8_SB(0, 0), cB, voffB); PG8_STAGE(PG8_SB(0, 1), cB + hstep, voffB); PG8_STAGE(PG8_SA(0, 0), cA, voffA); PG8_STAGE(PG8_SA(0, 1), cA + hstep, voffA);
        if (wr == 1) PG8_BAR;
        if constexpr (FP6) PG8_WAIT_V(1); else PG8_WAIT_V(2);
        PG8_BAR;
        PG8_STAGE(PG8_SB(1, 0), cB + kstep, voffB); PG8_STAGE(PG8_SA(1, 0), cA + kstep, voffA); PG8_STAGE(PG8_SB(1, 1), cB + hstep + kstep, voffB);
        if constexpr (FP6) PG8_WAIT_V(4); else PG8_WAIT_V(6);
        PG8_BAR;
    } else {
        PG8_STAGE(PG8_SB(0, 0), cB, voffB); PG8_STAGE(PG8_SA(0, 0), cA, voffA); PG8_STAGE(PG8_SA(0, 1), cA + hstep, voffA);
        if (wr == 1) PG8_BAR;
        PG8_WAIT_V(2); PG8_BAR;
        PG8_STAGE(PG8_SB(1, 0), cB + kstep, voffB); PG8_STAGE(PG8_SA(1, 0), cA + kstep, voffA);
        PG8_WAIT_V(4); PG8_BAR;
    }
    for (;;) {
        const bool has_next = S.next(ui + 1, nxt);
        const char* nA = has_next ? S.abase(nxt) : cA; const char* nB = has_next ? S.bbase(nxt) : cB;
        for (int t = 0; t < nt; t += 2) {
            if constexpr (Epi::GATED) { if (t != 0 && (t & 15) == 0) { E.flush(acc, yac, cur, (t >> 4) - 1, wr, wc, fr, fq);
#pragma unroll
                for (int a = 0; a < 2; ++a)
#pragma unroll
                    for (int m = 0; m < 4; ++m)
#pragma unroll
                        for (int n = 0; n < 2; ++n) acc[a][0][m][n] = (f32x4){0.f, 0.f, 0.f, 0.f}; } }
            const bool last = (t == nt - 2);
            const char* a1 = cA + (size_t)(t + 1) * kstep;
            const char* a2 = last ? nA : cA + (size_t)(t + 2) * kstep; const char* b2 = last ? nB : cB + (size_t)(t + 2) * kstep;
            const char* a3 = a2 + kstep; const char* b3 = b2 + kstep;
            if constexpr (NB == 2 && STAGE_LATE != 0) {
            PG8_LDB(B0, 0, 0); PG8_LDB(B1, 0, 1); PG8_SCHED; PG8_LDA(At, 0, 0);
            PG8_WAIT_LA(); PG8_WAIT_L(0); PG8_BAR; PG8_MMA(0, 0, At, B0); PG8_MMA(0, 1, At, B1); PG8_STAGE(PG8_SA(1, 1), a1 + hstep, voffA); PG8_BAR; PG8_SCHED;
            PG8_LDA(At, 0, 1);
            PG8_WAIT_LB(); PG8_WAIT_L(0); PG8_BAR; PG8_MMA(1, 0, At, B0); PG8_MMA(1, 1, At, B1); PG8_STAGE(PG8_SB(0, 0), b2, voffB); PG8_STAGE(PG8_SB(0, 1), b2 + hstep, voffB); PG8_STAGE(PG8_SA(0, 0), a2, voffA); PG8_BAR; PG8_SCHED;
            PG8_LDB(B0, 1, 0); PG8_LDB(B1, 1, 1); PG8_SCHED; PG8_LDA(At, 1, 0);
            PG8_WAIT_LA(); PG8_WAIT_L(0); PG8_BAR; PG8_MMA(0, 0, At, B0); PG8_MMA(0, 1, At, B1); PG8_STAGE(PG8_SA(0, 1), a2 + hstep, voffA); PG8_BAR; PG8_SCHED;
            PG8_LDA(At, 1, 1);
            PG8_WAIT_LB(); PG8_WAIT_L(0); PG8_BAR; PG8_MMA(1, 0, At, B0); PG8_MMA(1, 1, At, B1); PG8_STAGE(PG8_SB(1, 0), b3, voffB); PG8_STAGE(PG8_SB(1, 1), b3 + hstep, voffB); PG8_STAGE(PG8_SA(1, 0), a3, voffA); PG8_BAR; PG8_SCHED;
            } else if constexpr (NB == 2) {
            PG8_LDB(B0, 0, 0); PG8_LDB(B1, 0, 1); PG8_SCHED; PG8_LDA(At, 0, 0); PG8_STAGE(PG8_SA(1, 1), a1 + hstep, voffA);
            PG8_WAIT_MAIN(); PG8_WAIT_L(0); PG8_BAR; PG8_MMA(0, 0, At, B0); PG8_MMA(0, 1, At, B1); PG8_BAR; PG8_SCHED;
            PG8_LDA(At, 0, 1); PG8_STAGE(PG8_SB(0, 0), b2, voffB); PG8_STAGE(PG8_SB(0, 1), b2 + hstep, voffB); PG8_STAGE(PG8_SA(0, 0), a2, voffA);
            PG8_WAIT_MAIN(); PG8_WAIT_L(0); PG8_BAR; PG8_MMA(1, 0, At, B0); PG8_MMA(1, 1, At, B1); PG8_BAR; PG8_SCHED;
            PG8_LDB(B0, 1, 0); PG8_LDB(B1, 1, 1); PG8_SCHED; PG8_LDA(At, 1, 0); PG8_STAGE(PG8_SA(0, 1), a2 + hstep, voffA);
            PG8_WAIT_MAIN(); PG8_WAIT_L(0); PG8_BAR; PG8_MMA(0, 0, At, B0); PG8_MMA(0, 1, At, B1); PG8_BAR; PG8_SCHED;
            PG8_LDA(At, 1, 1); PG8_STAGE(PG8_SB(1, 0), b3, voffB); PG8_STAGE(PG8_SB(1, 1), b3 + hstep, voffB); PG8_STAGE(PG8_SA(1, 0), a3, voffA);
            PG8_WAIT_MAIN(); PG8_WAIT_L(0); PG8_BAR; PG8_MMA(1, 0, At, B0); PG8_MMA(1, 1, At, B1); PG8_BAR; PG8_SCHED;
            } else {
            PG8_LDB(B0, 0, 0); PG8_SCHED; PG8_LDA(At, 0, 0); PG8_STAGE(PG8_SA(1, 1), a1 + hstep, voffA);
            PG8_WAIT_V(6); PG8_WAIT_L(0); PG8_BAR; PG8_MMA(0, 0, At, B0); PG8_BAR; PG8_SCHED;
            PG8_LDA(At, 0, 1); PG8_STAGE(PG8_SB(0, 0), b2, voffB); PG8_STAGE(PG8_SA(0, 0), a2, voffA);
            PG8_WAIT_V(6); PG8_WAIT_L(0); PG8_BAR; PG8_MMA(1, 0, At, B0); PG8_BAR; PG8_SCHED;
            PG8_LDB(B0, 1, 0); PG8_SCHED; PG8_LDA(At, 1, 0); PG8_STAGE(PG8_SA(0, 1), a2 + hstep, voffA);
            PG8_WAIT_V(6); PG8_WAIT_L(0); PG8_BAR; PG8_MMA(0, 0, At, B0); PG8_BAR; PG8_SCHED;
            PG8_LDA(At, 1, 1); PG8_STAGE(PG8_SB(1, 0), b3, voffB); PG8_STAGE(PG8_SA(1, 0), a3, voffA);
            PG8_WAIT_V(6); PG8_WAIT_L(0); PG8_BAR; PG8_MMA(1, 0, At, B0); PG8_BAR; PG8_SCHED;
            }
        }
        if constexpr (F8) {
            asm volatile("s_nop 15\n\ts_nop 15" ::: "memory");
#pragma unroll
            for (int a = 0; a < 2; ++a)
#pragma unroll
                for (int b = 0; b < NB; ++b)
#pragma unroll
                    for (int m = 0; m < 4; ++m)
#pragma unroll
                        for (int n = 0; n < 2; ++n) asm volatile("" : "+v"(acc[a][b][m][n]));
        }
        if constexpr (ALIGN_EPI) { if (wr == 0) PG8_BAR; }
        if constexpr (Epi::GATED) { E.finish(acc, yac, cur, wr, wc, fr, fq);
#pragma unroll
            for (int a = 0; a < 2; ++a)
#pragma unroll
                for (int m = 0; m < 4; ++m)
#pragma unroll
                    for (int n = 0; n < 2; ++n) yac[a][m][n] = (f32x4){0.f, 0.f, 0.f, 0.f};
        } else { E(acc, cur, wr, wc, fr, fq); }
        if (!has_next) break;
#pragma unroll
        for (int a = 0; a < 2; ++a)
#pragma unroll
            for (int b = 0; b < NB; ++b)
#pragma unroll
                for (int m = 0; m < 4; ++m)
#pragma unroll
                    for (int n = 0; n < 2; ++n) acc[a][b][m][n] = (f32x4){0.f, 0.f, 0.f, 0.f};
        cur = nxt; cA = nA; cB = nB; ++ui;
        if constexpr (ALIGN_EPI) { if (wr == 1) PG8_BAR; }
    }
    PG8_WAIT_V(0);
    if constexpr (!ALIGN_EPI) { if (wr == 0) PG8_BAR; }
    PG8_BAR;
#undef PG8_SA
#undef PG8_SB
#undef PG8_STAGE
#undef PG8_LDA
#undef PG8_LDB
#undef PG8_MMA
#undef PG8_CAT
#undef PG8_WAIT_V
#undef PG8_WAIT_L
#undef PG8_BAR
#undef PG8_SCHED
#undef PG8_WAIT_MAIN
}
}

#define XB_TMO      128
#define XB_XCNT(j)  (256  + 64 * (j))
#define XB_XSUB(j)  (1280 + 64 * (j))
#define XB_XGEN(j)  (2304 + 64 * (j))
#define XB_TOP      3328
#define XB_TOPGEN   3392
#define XCD_BAR_WORDS 3456
#define XB_SPIN_CAP (1u << 18)
DI unsigned xb_ld(unsigned* p)              { return __hip_atomic_load(p, __ATOMIC_RELAXED, __HIP_MEMORY_SCOPE_AGENT); }
DI unsigned xb_add(unsigned* p, unsigned v) { return __hip_atomic_fetch_add(p, v, __ATOMIC_RELAXED, __HIP_MEMORY_SCOPE_AGENT); }
DI unsigned xb_xcc_id() { return (unsigned)__builtin_amdgcn_s_getreg((3 << 11) | 20) & 0xFu; }
#define XB_SPIN(cond, bar) do { unsigned _sp = 0; while (cond) { __builtin_amdgcn_s_sleep(1); \
    if ((++_sp & 255u) == 0u) { if (xb_ld(&(bar)[XB_TMO])) break; if (_sp > XB_SPIN_CAP) { atomicAdd(&(bar)[XB_TMO], 1u); break; } } } } while (0)
struct XcdBarrier { unsigned* bar; unsigned x; volatile LAS unsigned* st; };
DI XcdBarrier xcd_barrier_post(unsigned* bar, volatile LAS unsigned* st) {
    XcdBarrier b; b.bar = bar; b.x = xb_xcc_id(); b.st = st;
    if (threadIdx.x == 0) (void)xb_add(&bar[XB_XCNT(b.x)], 1u);
    return b;
}
DI void xcd_barrier_complete(unsigned* bar, unsigned x, unsigned& nloc, unsigned& nx) {
    const unsigned G = gridDim.x * gridDim.y * gridDim.z;
    unsigned sum, cnt, mine, sp = 0u;
    for (;;) {
        sum = 0u; cnt = 0u; mine = 0u;
#pragma unroll
        for (unsigned j = 0; j < 16; ++j) { const unsigned c = xb_ld(&bar[XB_XCNT(j)]); sum += c; cnt += (c > 0u) ? 1u : 0u; mine = (j == x) ? c : mine; }
        if (sum == G) break;
        __builtin_amdgcn_s_sleep(1);
        if ((++sp & 255u) == 0u) { if (xb_ld(&bar[XB_TMO])) break; if (sp > XB_SPIN_CAP) { atomicAdd(&bar[XB_TMO], 1u); break; } }
    }
    nloc = mine > 0u ? mine : 1u; nx = cnt > 0u ? cnt : 1u;
}
DI void xcd_barrier(const XcdBarrier& b) {
    asm volatile("s_waitcnt vmcnt(0)" ::: "memory");
    __syncthreads();
    if (threadIdx.x == 0) {
        unsigned* bar = b.bar;
        __builtin_amdgcn_s_waitcnt(0);
        unsigned nloc = b.st[0], nx = b.st[1];
        if (nloc == 0u) { xcd_barrier_complete(bar, b.x, nloc, nx); b.st[0] = nloc; b.st[1] = nx; }
        const unsigned old = xb_add(&bar[XB_XSUB(b.x)], 1u);
        const unsigned gen = old / nloc;
        if (old + 1u == (gen + 1u) * nloc) {
            __builtin_amdgcn_fence(__ATOMIC_RELEASE, "agent");
            asm volatile("s_waitcnt vmcnt(0)" ::: "memory");
            const unsigned og = xb_add(&bar[XB_TOP], 1u);
            const unsigned tg = og / nx;
            if (og + 1u == (tg + 1u) * nx) xb_add(&bar[XB_TOPGEN], 1u);
            else XB_SPIN(xb_ld(&bar[XB_TOPGEN]) == tg, bar);
            __builtin_amdgcn_fence(__ATOMIC_ACQUIRE, "agent");
            xb_add(&bar[XB_XGEN(b.x)], 1u);
            asm volatile("s_waitcnt vmcnt(0)" ::: "memory");
        } else {
            XB_SPIN(xb_ld(&bar[XB_XGEN(b.x)]) == gen, bar);
            __builtin_amdgcn_fence(__ATOMIC_ACQUIRE, "agent");
            asm volatile("s_waitcnt vmcnt(0)" ::: "memory");
        }
    }
    __syncthreads();
}

struct Frame {
    LAS unsigned char* lds;
    int tid, lane, wave, G, wg;
    float* out; unsigned char* ws;
};
template <class T> DI T* wsp(const Frame& F, size_t off) { return (T*)(F.ws + off); }

struct EpiH {
    static constexpr bool PERM = true, GATED = false;
    bf16* H; bf16* MK; bf16* MVT;
    DI void operator()(const f32x4 (&acc)[2][2][4][2], const pg8::Unit& u, int wr, int wc, int fr, int fq) const {
        bf16* base = H; size_t ldc = NH; int act = 0;
        if (u.gi == 0) { const int pn = u.pn; act = ((pn >= 4 && pn < 8) || (pn >= 16 && pn < 20)) ? 1 : 0; }
        else { const int lx = (u.gi - 1) >> 1, w = (u.gi - 1) & 1; if (w == 0) { base = MK + (size_t)lx * 512 * 1024; ldc = 1024; } else { base = MVT + (size_t)lx * 1024 * 512; ldc = 512; } }
        const int row0 = u.pm * 256 + wr * 64 + fr, col0 = u.pn * 256 + wc * 32 + 8 * fq;
#pragma unroll
        for (int ai = 0; ai < 2; ++ai)
#pragma unroll
            for (int m = 0; m < 4; ++m) { bf16* rowp = base + (size_t)(row0 + ai * 128 + m * 16) * ldc + col0;
#pragma unroll
                for (int bj = 0; bj < 2; ++bj) { f32x4 v0 = acc[ai][bj][m][0], v1 = acc[ai][bj][m][1];
                    if (act != 0) {
#pragma unroll
                        for (int j = 0; j < 4; ++j) { const float s0 = fast_sigmoid(v0[j]), s1 = fast_sigmoid(v1[j]); v0[j] = (act == 1) ? v0[j] * s0 : s0; v1[j] = (act == 1) ? v1[j] * s1 : s1; } }
                    u32x4 w; w.x = cvt_pk_bf16(v0[0], v0[1]); w.y = cvt_pk_bf16(v0[2], v0[3]); w.z = cvt_pk_bf16(v1[0], v1[1]); w.w = cvt_pk_bf16(v1[2], v1[3]);
                    *(u32x4*)(rowp + bj * 128) = w; } }
    }
};
template <int NB> struct EpiMG {
    static constexpr bool PERM = true, GATED = false;
    bf16* H;
    DI void operator()(const f32x4 (&acc)[2][NB][4][2], const pg8::Unit& u, int wr, int wc, int fr, int fq) const {
        const int colu = C_F8 + u.pn * (128 * NB);
        const int act = (colu >= C_MG) ? 2 : (((colu >= C_SG && colu < C_XQ) || colu >= C_XG) ? 1 : 0);
        const int row0 = u.pm * 256 + wr * 64 + fr, col0 = colu + wc * 32 + 8 * fq;
#pragma unroll
        for (int ai = 0; ai < 2; ++ai)
#pragma unroll
            for (int m = 0; m < 4; ++m) { bf16* rowp = H + (size_t)(row0 + ai * 128 + m * 16) * NH + col0;
#pragma unroll
                for (int bj = 0; bj < NB; ++bj) { f32x4 v0 = acc[ai][bj][m][0], v1 = acc[ai][bj][m][1];
                    if (act == 2) {
#pragma unroll
                        for (int j = 0; j < 4; ++j) { v0[j] = __builtin_amdgcn_rcpf(1.0f + __builtin_amdgcn_exp2f(v0[j] * (-1.44269504089f * MG_DESCALE)));
                            v1[j] = __builtin_amdgcn_rcpf(1.0f + __builtin_amdgcn_exp2f(v1[j] * (-1.44269504089f * MG_DESCALE))); }
                    } else if (act == 1) {
#pragma unroll
                        for (int j = 0; j < 4; ++j) { const float a0 = v0[j] * MG_DESCALE, a1 = v1[j] * MG_DESCALE; v0[j] = a0 * fast_sigmoid(a0); v1[j] = a1 * fast_sigmoid(a1); }
                    } else {
#pragma unroll
                        for (int j = 0; j < 4; ++j) { v0[j] *= MG_DESCALE; v1[j] *= MG_DESCALE; } }
                    u32x4 w; w.x = cvt_pk_bf16(v0[0], v0[1]); w.y = cvt_pk_bf16(v0[2], v0[3]); w.z = cvt_pk_bf16(v1[0], v1[1]); w.w = cvt_pk_bf16(v1[2], v1[3]);
                    *(u32x4*)(rowp + bj * 128) = w; } }
    }
};
struct EpiRes {
    static constexpr bool PERM = true, GATED = false;
    const float* __restrict__ res; float* __restrict__ out;
    DI void operator()(const f32x4 (&acc)[2][2][4][2], const pg8::Unit& u, int wr, int wc, int fr, int fq) const {
        const int row0 = u.pm * 256 + wr * 64 + fr, col0 = u.pn * 256 + wc * 32 + 8 * fq;
#pragma unroll
        for (int ai = 0; ai < 2; ++ai)
#pragma unroll
            for (int m = 0; m < 4; ++m) { const size_t ro = (size_t)(row0 + ai * 128 + m * 16) * DM + col0;
#pragma unroll
                for (int bj = 0; bj < 2; ++bj)
#pragma unroll
                    for (int n = 0; n < 2; ++n) { const size_t o = ro + bj * 128 + n * 4; const f32x4 r = *(const f32x4*)(res + o); *(f32x4*)(out + o) = r * DN_ALPHA + acc[ai][bj][m][n]; } }
    }
};
struct EpiGate {
    static constexpr bool PERM = true, GATED = true;
    const bf16* H; bf16* Y;
    DI void flush(const f32x4 (&acc)[2][1][4][2], f32x4 (&y)[2][4][2], const pg8::Unit& u, int bi, int wr, int wc, int fr, int fq) const {
        const int row0 = u.pm * 256 + wr * 64 + fr, col0 = u.pn * 128 + wc * 32 + 8 * fq;
#pragma unroll
        for (int ai = 0; ai < 2; ++ai)
#pragma unroll
            for (int m = 0; m < 4; ++m) { const u32x4 gw = *(const u32x4*)(H + (size_t)(row0 + ai * 128 + m * 16) * NH + C_MG + bi * DM + col0);
                float g[8]; unpack8(gw, g);
#pragma unroll
                for (int j = 0; j < 4; ++j) { y[ai][m][0][j] += g[j] * acc[ai][0][m][0][j]; y[ai][m][1][j] += g[4 + j] * acc[ai][0][m][1][j]; }
                if (m == 1 || m == 3) __builtin_amdgcn_sched_barrier(0); }
    }
    DI void finish(const f32x4 (&acc)[2][1][4][2], f32x4 (&y)[2][4][2], const pg8::Unit& u, int wr, int wc, int fr, int fq) const {
        flush(acc, y, u, 3, wr, wc, fr, fq);
        const int row0 = u.pm * 256 + wr * 64 + fr, col0 = u.pn * 128 + wc * 32 + 8 * fq;
#pragma unroll
        for (int ai = 0; ai < 2; ++ai)
#pragma unroll
            for (int m = 0; m < 4; ++m) { const f32x4 v0 = y[ai][m][0], v1 = y[ai][m][1];
                u32x4 w; w.x = cvt_pk_bf16(v0[0], v0[1]); w.y = cvt_pk_bf16(v0[2], v0[3]); w.z = cvt_pk_bf16(v1[0], v1[1]); w.w = cvt_pk_bf16(v1[2], v1[3]);
                if (BLK_OUT) *(u32x4*)((char*)Y + pg8::blk_off<false>(row0 + ai * 128 + m * 16, col0, DM / 64)) = w; else *(u32x4*)(Y + (size_t)(row0 + ai * 128 + m * 16) * DM + col0) = w; }
    }
};
struct SchedInProj {
    static constexpr bool BLK = false;
    int G, c, n_extra; const char *XB, *WT, *MEMB, *WKV;
    static constexpr int NM = 32, NN = 21, NU = NM * NN;
    static constexpr size_t TSTEP = (size_t)256 * 4096 * 2;
    DI bool next(int i, pg8::Unit& u) const {
        const long L = (long)i * G + c;
        if (L < NU) { pg8::static_tile((int)L, NM, NN, u.pm, u.pn); if (u.pn == 20) u.pn = 101; u.gi = 0; return true; }
        const int e = (int)(L - NU); if (e >= n_extra) return false;
        const int lx = e >> 4, r = e & 15;
        if (r < 8) { u.pm = r >> 2; u.pn = r & 3; u.gi = 1 + 2 * lx; } else { u.pm = (r - 8) >> 1; u.pn = (r - 8) & 1; u.gi = 2 + 2 * lx; }
        return true;
    }
    DI const char* abase(const pg8::Unit& u) const {
        if (u.gi == 0) return XB + (size_t)u.pm * TSTEP;
        const int lx = (u.gi - 1) >> 1, w = (u.gi - 1) & 1;
        return w == 0 ? MEMB + (size_t)u.pm * TSTEP : WKV + (size_t)lx * 2048 * 4096 * 2 + (size_t)(1024 + u.pm * 256) * 4096 * 2;
    }
    DI const char* bbase(const pg8::Unit& u) const {
        if (u.gi == 0) return WT + (size_t)u.pn * TSTEP;
        const int lx = (u.gi - 1) >> 1, w = (u.gi - 1) & 1;
        return w == 0 ? WKV + (size_t)lx * 2048 * 4096 * 2 + (size_t)u.pn * TSTEP : MEMB + (size_t)u.pn * TSTEP;
    }
};

DI int win_src_col(int n) { return n < 5120 ? n : (n < C_LR ? n + 16 : (n < C_LR + 16 ? n - C_LR + 5120 : -1)); }
template <bool WIN, int LAY = 0> DI void transpose_item(const float* W, size_t ldw, bf16* WT, size_t ldt, int k0, int n0, int kd0, LAS float* scr, int lane) {
    const int kr = lane >> 3, nc = lane & 7; int sc = n0 + 4 * nc; if (WIN) sc = win_src_col(sc);
    const float* src = W + (size_t)(k0 + kr) * ldw + (sc < 0 ? 0 : sc);
    f32x4 v[8];
#pragma unroll
    for (int i = 0; i < 8; ++i) v[i] = *(const f32x4*)(src + (size_t)(8 * i) * ldw);
#pragma unroll
    for (int i = 0; i < 8; ++i) { LAS float* d = scr + (8 * i + kr) * 33 + 4 * nc; const f32x4 x = (sc < 0) ? (f32x4){0.f, 0.f, 0.f, 0.f} : v[i]; d[0] = x.x; d[1] = x.y; d[2] = x.z; d[3] = x.w; }
    LDS_WAIT();
    const int c = lane & 7;
#pragma unroll
    for (int j = 0; j < 4; ++j) { const int n = (lane >> 3) + 8 * j; const LAS float* s = scr + (8 * c) * 33 + n;
        u32x4 o; o.x = pk2(s[0 * 33], s[1 * 33]); o.y = pk2(s[2 * 33], s[3 * 33]); o.z = pk2(s[4 * 33], s[5 * 33]); o.w = pk2(s[6 * 33], s[7 * 33]);
        if constexpr (LAY == 0) *(u32x4*)(WT + (size_t)(n0 + n) * ldt + kd0 + 8 * c) = o; else *(u32x4*)((char*)WT + pg8::blk_off<LAY == 2>(n0 + n, kd0 + 8 * c, (int)(ldt / 64))) = o; }
    LDS_WAIT();
}
DI void transpose_item_f8(const float* W, size_t ldw, unsigned char* WT, size_t ldt, int k0, int n0, LAS float* scr, int lane) {
    const int kr = lane >> 3, nc = lane & 7; const int sc = win_src_col(n0 + 4 * nc);
    const float* src = W + (size_t)(k0 + kr) * ldw + sc;
#pragma unroll
    for (int h = 0; h < 2; ++h) {
        f32x4 v[8];
#pragma unroll
        for (int i = 0; i < 8; ++i) v[i] = *(const f32x4*)(src + (size_t)(64 * h + 8 * i) * ldw);
#pragma unroll
        for (int i = 0; i < 8; ++i) { LAS float* d = scr + (64 * h + 8 * i + kr) * 33 + 4 * nc; d[0] = v[i].x * W8_SCALE; d[1] = v[i].y * W8_SCALE; d[2] = v[i].z * W8_SCALE; d[3] = v[i].w * W8_SCALE; }
    }
    LDS_WAIT();
#if F6
    { const int q = lane >> 4;
#pragma unroll
      for (int j = 0; j < 2; ++j) { const int n = (lane & 15) + 16 * j; const LAS float* sp = scr + (32 * q) * 33 + n; float f[32];
#pragma unroll
          for (int e = 0; e < 32; ++e) f[e] = sp[e * 33];
          u32x4 lo, hi; pk32_fp6(f, lo, hi); const int R = n0 - C_F8 + n; size_t ol, oh; pg8::f6_off((R & ~31) + pg8::invperm32(R & 31), k0 >> 7, q, ol, oh);
          *(u32x4*)(WT + ol) = lo; u32x2 h2; h2.x = hi.x; h2.y = hi.y; *(u32x2*)(WT + oh) = h2; } }
#else
    const int c = lane & 7;
#pragma unroll
    for (int j = 0; j < 4; ++j) { const int n = (lane >> 3) + 8 * j; const LAS float* s = scr + (16 * c) * 33 + n;
        u32x4 o; o.x = pk4_fp8(s[0 * 33], s[1 * 33], s[2 * 33], s[3 * 33]); o.y = pk4_fp8(s[4 * 33], s[5 * 33], s[6 * 33], s[7 * 33]);
        o.z = pk4_fp8(s[8 * 33], s[9 * 33], s[10 * 33], s[11 * 33]); o.w = pk4_fp8(s[12 * 33], s[13 * 33], s[14 * 33], s[15 * 33]);
        *(u32x4*)(WT + (size_t)(n0 - C_F8 + n) * ldt + k0 + 16 * c) = o; }
#endif
    LDS_WAIT();
}
DI void prologue(const Frame& F, const float* x, const float* mem, const int* pos, const float* w_in, const float* w_pool, const float* w_mem_kv, const float* w_branch, const float* w_out) {
    LAS float* scr = (LAS float*)(F.lds + F.wave * 17408);
    const int gw = F.wg * NWAVES + F.wave, NGW = F.G * NWAVES, lane = F.lane;
    constexpr int I_B16 = 64 * ((NH - N_F8) / 32), I_F8 = 32 * (N_F8 / 32), I_KV = 64 * 64, I_BR = 16 * 128, I_OUT = 64 * 128, I_PL = 4 * 8;
    constexpr int NITEMS = 2 * I_B16 + 2 * I_F8 + 2 * I_KV + 8 * I_BR + 2 * I_OUT + 8 * I_PL;
    LAS unsigned* qc = (LAS unsigned*)(F.lds + MISC_OFF) + 16;
    (void)gw;
    int q = 0; if (lane == 0) q = (int)__hip_atomic_fetch_add(qc, 1u, __ATOMIC_RELAXED, __HIP_MEMORY_SCOPE_WORKGROUP); q = __builtin_amdgcn_readfirstlane(q);
    for (;;) {
        const int it = (q >> 3) * NGW + F.wg * NWAVES + (q & 7); if (it >= NITEMS) break;
        if (lane == 0) q = (int)__hip_atomic_fetch_add(qc, 1u, __ATOMIC_RELAXED, __HIP_MEMORY_SCOPE_WORKGROUP);
        q = __builtin_amdgcn_readfirstlane(q);
        int r = it;
        if (r < 2 * I_F8) { const int l = r / I_F8; r -= l * I_F8; const int nb = C_F8 / 32 + (PRO_NFAST ? r % (N_F8 / 32) : (r >> 5)), kb = PRO_NFAST ? r / (N_F8 / 32) : (r & 31);
            transpose_item_f8(w_in + (size_t)l * 4096 * D_IN, D_IN, wsp<unsigned char>(F, WS_W8) + (size_t)l * W8_LAYER, 4096, kb * 128, nb * 32, scr, lane); continue; }
        r -= 2 * I_F8;
        if (r < 2 * I_B16) { const int l = r / I_B16; r -= l * I_B16; int nb = r >> 6; const int kb = r & 63; if (nb >= C_F8 / 32) nb += N_F8 / 32;
            transpose_item<true>(w_in + (size_t)l * 4096 * D_IN, D_IN, wsp<bf16>(F, WS_WINT) + (size_t)l * NH * 4096, 4096, kb * 64, nb * 32, kb * 64, scr, lane); continue; }
        r -= 2 * I_B16;
        if (r < 2 * I_KV) { const int l = r / I_KV; r -= l * I_KV; const int nb = r >> 6, kb = r & 63;
            transpose_item<false>(w_mem_kv + (size_t)l * 4096 * 2048, 2048, wsp<bf16>(F, WS_WMKVT) + (size_t)l * 2048 * 4096, 4096, kb * 64, nb * 32, kb * 64, scr, lane); continue; }
        r -= 2 * I_KV;
        if (r < 8 * I_BR) { const int lb = r / I_BR; r -= lb * I_BR; const int l = lb >> 2, bi = lb & 3; const int nb = PRO_NFAST ? (r & 127) : (r >> 4), kb = PRO_NFAST ? (r >> 7) : (r & 15);
            transpose_item<false, BLK_GATE ? 2 : 0>(w_branch + (size_t)lb * 1024 * 4096, 4096, wsp<bf16>(F, WS_WBRT) + (size_t)l * 4096 * 4096, 4096, kb * 64, nb * 32, bi * 1024 + kb * 64, scr, lane); continue; }
        r -= 8 * I_BR;
        if (r < 2 * I_OUT) { const int l = r / I_OUT; r -= l * I_OUT; const int nb = PRO_NFAST ? (r & 127) : (r >> 6), kb = PRO_NFAST ? (r >> 7) : (r & 63);
            transpose_item<false, BLK_OUT ? 2 : 0>(w_out + (size_t)l * 4096 * 4096, 4096, wsp<bf16>(F, WS_WOUTT) + (size_t)l * 4096 * 4096, 4096, kb * 64, nb * 32, kb * 64, scr, lane); continue; }
        r -= 2 * I_OUT;
        { const int lg = r / I_PL; r -= lg * I_PL; const int nb = r >> 2, kb = r & 3;
            transpose_item<false>(w_pool + (size_t)lg * 256 * 256, 256, wsp<bf16>(F, WS_WPOOLT) + (size_t)lg * 256 * 256, 256, kb * 64, nb * 32, kb * 64, scr, lane); }
    }
    const size_t gt = (size_t)F.wg * NTHR + F.tid, GT = (size_t)F.G * NTHR;
    { const f32x4* xs = (const f32x4*)x; u32x4* xd = wsp<u32x4>(F, WS_XB);
      u32x2* x8 = wsp<u32x2>(F, WS_X8);
#if F6
      (void)x8; (void)xd;
      { LAS unsigned char* lw = (LAS unsigned char*)scr; u32x2* xb2 = wsp<u32x2>(F, WS_XB);
        for (size_t g0 = (size_t)gw * 64; g0 < (size_t)MTOK * DM / 32; g0 += (size_t)NGW * 64) {
            const f32x4* src = xs + g0 * 8;
            f32x4 v[8];
#pragma unroll
            for (int t = 0; t < 8; ++t) v[t] = src[64 * t + lane];
#pragma unroll
            for (int t = 0; t < 8; ++t) { u32x2 w; w.x = pk2(v[t].x, v[t].y); w.y = pk2(v[t].z, v[t].w); xb2[g0 * 8 + 64 * t + lane] = w;
                *(LAS f32x4*)(lw + ((lane >> 3) + 8 * t) * 144 + (lane & 7) * 16) = v[t] * X8_SCALE; }
            LDS_WAIT();
            float f[32];
#pragma unroll
            for (int t = 0; t < 8; ++t) { const f32x4 qv = *(const LAS f32x4*)(lw + lane * 144 + 16 * t); f[4 * t] = qv.x; f[4 * t + 1] = qv.y; f[4 * t + 2] = qv.z; f[4 * t + 3] = qv.w; }
            const size_t gi = g0 + lane; u32x4 lo, hi; pk32_fp6(f, lo, hi); size_t ol, oh; pg8::f6_off((int)(gi >> 7), (int)((gi >> 2) & 31), (int)(gi & 3), ol, oh);
            *(u32x4*)(wsp<unsigned char>(F, WS_X8) + ol) = lo; u32x2 h2; h2.x = hi.x; h2.y = hi.y; *(u32x2*)(wsp<unsigned char>(F, WS_X8) + oh) = h2;
            LDS_WAIT();
        } }
#else
      for (size_t i = gt; i < (size_t)MTOK * DM / 8; i += GT) { const f32x4 a = xs[2 * i], b = xs[2 * i + 1]; u32x4 o; o.x = pk2(a.x, a.y); o.y = pk2(a.z, a.w); o.z = pk2(b.x, b.y); o.w = pk2(b.z, b.w); xd[i] = o;
          u32x2 q; q.x = pk4_fp8(a.x * X8_SCALE, a.y * X8_SCALE, a.z * X8_SCALE, a.w * X8_SCALE); q.y = pk4_fp8(b.x * X8_SCALE, b.y * X8_SCALE, b.z * X8_SCALE, b.w * X8_SCALE); x8[i] = q; }
#endif
      const f32x4* ms = (const f32x4*)mem; u32x4* md = wsp<u32x4>(F, WS_MEMB);
      for (size_t i = gt; i < (size_t)BATCH * MEMLEN * DM / 8; i += GT) { const f32x4 a = ms[2 * i], b = ms[2 * i + 1]; u32x4 o; o.x = pk2(a.x, a.y); o.y = pk2(a.z, a.w); o.z = pk2(b.x, b.y); o.w = pk2(b.z, b.w); md[i] = o; } }
    { f32x2* rt = wsp<f32x2>(F, WS_ROPE);
      for (size_t i = gt; i < (size_t)MTOK * 8; i += GT) { const int t = (int)(i >> 3), fi = (int)(i & 7);
          const double invd = fi == 0 ? 1 : fi == 1 ? 0.19392274474868576 : fi == 2 ? 0.037606030930863933 : fi == 3 ? 0.0072926647372171093 : fi == 4 ? 0.001414213562373095 : fi == 5 ? 0.0002742481756762073 : fi == 6 ? 5.3182958969449883e-05 : 1.031338537721246e-05;
          const float inv = (float)invd; const float ang = (float)pos[t] * inv;
          rt[i] = (f32x2){cosf(ang), sinf(ang)}; } }
}

DI bf16* ob_at(bf16* OB, int t, int col) { return BLK_GATE ? (bf16*)((char*)OB + pg8::blk_off<false>(t, col, DM / 64)) : OB + (size_t)t * DM + col; }
DI float fexp(float x) { return __builtin_amdgcn_exp2f(x * 1.44269504089f); }
DI float logsigmoid_f(float z) { return fminf(z, 0.f) - 0.69314718056f * __builtin_amdgcn_logf(1.0f + fexp(-fabsf(z))); }

DI void gla_a_unit(const Frame& F, int l, int unit, const float* w_gla_up, const float* b_gla) {
    const int bh = unit >> 6, c = unit & 63, b = bh >> 2, h = bh & 3, t0 = b * SEQ + c * 64, tid = F.tid, lane = F.lane, wave = F.wave;
    const bf16* H = wsp<bf16>(F, WS_H);
    LAS float* lrs = (LAS float*)(F.lds);
    LAS float* bcs = (LAS float*)(F.lds + 4096);
    LAS float* seg = (LAS float*)(F.lds + 36864);
    LAS bf16* kds = (LAS bf16*)(F.lds + 40960);
    LAS bf16* vs = (LAS bf16*)(F.lds + 59392);
    constexpr int LDK = 136, LDV = 264;
    __syncthreads();
    if (tid < 128) { const int j = tid >> 1, hf = tid & 1; const u32x4 w = *(const u32x4*)(H + (size_t)(t0 + j) * NH + C_LR + 8 * hf); float f[8]; unpack8(w, f);
#pragma unroll
        for (int i = 0; i < 8; ++i) lrs[j * 16 + 8 * hf + i] = f[i]; }
    for (int p = tid; p < 64 * 32; p += NTHR) { const int j = p >> 5, ch = p & 31; *(LAS u32x4*)(vs + j * LDV + 8 * ch) = *(const u32x4*)(H + (size_t)(t0 + j) * NH + C_GV + h * 256 + 8 * ch); }
    __syncthreads();
    const int d = tid & 127, sg = tid >> 7;
    { float w[16];
#pragma unroll
      for (int r = 0; r < 16; ++r) w[r] = w_gla_up[(size_t)l * 16 * 512 + r * 512 + h * 128 + d];
      const float bg = b_gla[l * 512 + h * 128 + d]; float run = 0.f;
      for (int jj = 0; jj < 16; ++jj) { const int j = sg * 16 + jj; float z = bg;
#pragma unroll
          for (int r = 0; r < 16; ++r) z += lrs[j * 16 + r] * w[r];
          run += logsigmoid_f(z) * (1.0f / 16.0f); bcs[j * 128 + d] = run; }
      seg[sg * 128 + d] = run; }
    __syncthreads();
    { float pre = 0.f;
      for (int s = 0; s < sg; ++s) pre += seg[s * 128 + d];
      float* GB = wsp<float>(F, WS_GB);
      for (int jj = 0; jj < 16; ++jj) { const int j = sg * 16 + jj; const float v = bcs[j * 128 + d] + pre; bcs[j * 128 + d] = v; GB[(size_t)(t0 + j) * 512 + h * 128 + d] = v; }
      if (sg == 3) wsp<float>(F, WS_DEC)[(size_t)unit * 128 + d] = expf(bcs[63 * 128 + d]); }
    __syncthreads();
    for (int p = tid; p < 64 * 16; p += NTHR) { const int j = p >> 4, ch = p & 15; const u32x4 w = *(const u32x4*)(H + (size_t)(t0 + j) * NH + C_GK + h * 128 + 8 * ch); float f[8]; unpack8(w, f);
#pragma unroll
        for (int i = 0; i < 8; ++i) f[i] *= fexp(bcs[63 * 128 + 8 * ch + i] - bcs[j * 128 + 8 * ch + i]);
        *(LAS u32x4*)(kds + j * LDK + 8 * ch) = pack8(f); }
    __syncthreads();
    f32x4 acc[2][8];
#pragma unroll
    for (int a = 0; a < 2; ++a)
#pragma unroll
        for (int n = 0; n < 8; ++n) acc[a][n] = (f32x4){0.f, 0.f, 0.f, 0.f};
#pragma unroll
    for (int ks = 0; ks < 2; ++ks) {
        bf16x8 af[2];
#pragma unroll
        for (int a = 0; a < 2; ++a) af[a] = frag_tr(vs, LDV, 32 * ks, 32 * wave + 16 * a, lane);
#pragma unroll
        for (int n = 0; n < 8; ++n) { const bf16x8 bfr = frag_tr(kds, LDK, 32 * ks, 16 * n, lane);
#pragma unroll
            for (int a = 0; a < 2; ++a) acc[a][n] = mma16(bfr, af[a], acc[a][n]); }
    }
    float* U = wsp<float>(F, WS_GU) + (size_t)unit * 256 * 128;
#pragma unroll
    for (int a = 0; a < 2; ++a)
#pragma unroll
        for (int n = 0; n < 8; ++n) *(f32x4*)(U + (size_t)(32 * wave + 16 * a + (lane & 15)) * 128 + 16 * n + 4 * (lane >> 4)) = acc[a][n];
}

DI void gla_scan(const Frame& F) {
    const float* U = wsp<float>(F, WS_GU); const float* DEC = wsp<float>(F, WS_DEC); unsigned* S = wsp<unsigned>(F, WS_GS);
    const int gt = F.wg * NTHR + F.tid, GT = F.G * NTHR;
    for (int it = gt; it < 8 * 256 * 64; it += GT) {
        const int bh = it >> 14, r = it & 16383, e = r >> 6, dp = r & 63;
        float s0 = 0.f, s1 = 0.f;
#pragma unroll 8
        for (int c = 0; c < 64; ++c) { const size_t un = (size_t)bh * 64 + c; const size_t o = (un * 256 + e) * 128 + 2 * dp;
            const f32x2 u = *(const f32x2*)(U + o); const f32x2 dc = *(const f32x2*)(DEC + un * 128 + 2 * dp);
            S[o >> 1] = pk2(s0, s1); s0 = dc.x * s0 + u.x; s1 = dc.y * s1 + u.y; }
    }
}

#ifndef PROBE_T
#define PROBE_T 0
#endif
#if PROBE_T
#define PT_STAMP(k) do { if (F.wg == 0 && F.tid == 0) { const unsigned _now = (unsigned)wall_clock64(); volatile LAS unsigned* _pt = (volatile LAS unsigned*)(F.lds + MISC_OFF + 128); if ((k) > 0) _pt[k] += _now - _pt[0]; _pt[0] = _now; } } while (0)
#else
#define PT_STAMP(k) do {} while (0)
#endif
DI void gla_c_unit(const Frame& F, int l, int unit, const float* gla_norm) {
    const int bh = unit >> 6, c = unit & 63, b = bh >> 2, h = bh & 3, t0 = b * SEQ + c * 64, tid = F.tid, lane = F.lane, wave = F.wave;
    const bf16* H = wsp<bf16>(F, WS_H);
    LAS bf16* qs = (LAS bf16*)(F.lds);
    LAS bf16* ks = (LAS bf16*)(F.lds + 17408);
    LAS bf16* vs = (LAS bf16*)(F.lds + 34816);
    LAS bf16* ps = (LAS bf16*)(F.lds + 68608);
    LAS float* red = (LAS float*)(F.lds + 77824);
    constexpr int LDK = 136, LDV = 264, LDP = 72;
    __syncthreads();
    PT_STAMP(0);
    const float* GB = wsp<float>(F, WS_GB);
    u32x4 qw[2], kw[2], vw[4]; f32x4 b0[2], b1[2];
#pragma unroll
    for (int it = 0; it < 2; ++it) { const int p = tid + it * NTHR, j = p >> 4, ch = p & 15;
        qw[it] = *(const u32x4*)(H + (size_t)(t0 + j) * NH + C_GQ + h * 128 + 8 * ch); kw[it] = *(const u32x4*)(H + (size_t)(t0 + j) * NH + C_GK + h * 128 + 8 * ch);
        b0[it] = *(const f32x4*)(GB + (size_t)(t0 + j) * 512 + h * 128 + 8 * ch); b1[it] = *(const f32x4*)(GB + (size_t)(t0 + j) * 512 + h * 128 + 8 * ch + 4); }
#pragma unroll
    for (int it = 0; it < 4; ++it) { const int p = tid + it * NTHR, j = p >> 5, ch = p & 31; vw[it] = *(const u32x4*)(H + (size_t)(t0 + j) * NH + C_GV + h * 256 + 8 * ch); }
    const bf16* St = wsp<bf16>(F, WS_GS) + (size_t)unit * 256 * 128;
    bf16x8 sf[4][2];
#pragma unroll
    for (int kk = 0; kk < 4; ++kk)
#pragma unroll
        for (int a = 0; a < 2; ++a) sf[kk][a] = frag_glb(St, 128, 32 * wave + 16 * a, 32 * kk, lane);
    f32x4 gn[2]; u32x2 gw[4][2];
#pragma unroll
    for (int a = 0; a < 2; ++a) { const int e = 32 * wave + 16 * a + 4 * (lane >> 4); gn[a] = *(const f32x4*)(gla_norm + l * 1024 + h * 256 + e);
#pragma unroll
        for (int n = 0; n < 4; ++n) gw[n][a] = *(const u32x2*)(H + (size_t)(t0 + 16 * n + (lane & 15)) * NH + C_GG + h * 256 + e); }
#pragma unroll
    for (int it = 0; it < 2; ++it) { const int p = tid + it * NTHR, j = p >> 4, ch = p & 15;
        float q[8], k[8]; unpack8(qw[it], q); unpack8(kw[it], k); const float bb[8] = {b0[it].x, b0[it].y, b0[it].z, b0[it].w, b1[it].x, b1[it].y, b1[it].z, b1[it].w};
#pragma unroll
        for (int i = 0; i < 8; ++i) { const float eb = fexp(bb[i]); q[i] *= eb * 0.08838834764831845f; k[i] *= fexp(-bb[i]); }
        *(LAS u32x4*)(qs + j * LDK + 8 * ch) = pack8(q); *(LAS u32x4*)(ks + j * LDK + 8 * ch) = pack8(k); }
#pragma unroll
    for (int it = 0; it < 4; ++it) { const int p = tid + it * NTHR, j = p >> 5, ch = p & 31; *(LAS u32x4*)(vs + j * LDV + 8 * ch) = vw[it]; }
    __syncthreads();
    PT_STAMP(1);
    { const int it = wave >> 1; f32x4 sa[2] = {(f32x4){0.f, 0.f, 0.f, 0.f}, (f32x4){0.f, 0.f, 0.f, 0.f}};
#pragma unroll
      for (int kk = 0; kk < 4; ++kk) { const bf16x8 qa = frag_lds(qs, LDK, 16 * it, 32 * kk, lane);
#pragma unroll
          for (int jj = 0; jj < 2; ++jj) sa[jj] = mma16(qa, frag_lds(ks, LDK, 16 * (2 * (wave & 1) + jj), 32 * kk, lane), sa[jj]); }
#pragma unroll
      for (int jj = 0; jj < 2; ++jj)
#pragma unroll
          for (int r = 0; r < 4; ++r) { const int i = 16 * it + 4 * (lane >> 4) + r, j = 16 * (2 * (wave & 1) + jj) + (lane & 15);
              ps[i * LDP + j] = (bf16)f2bf(j <= i ? sa[jj][r] : 0.f); } }
    __syncthreads();
    PT_STAMP(2);
    f32x4 acc[2][4];
#pragma unroll
    for (int a = 0; a < 2; ++a)
#pragma unroll
        for (int n = 0; n < 4; ++n) acc[a][n] = (f32x4){0.f, 0.f, 0.f, 0.f};
#pragma unroll
    for (int kk = 0; kk < 4; ++kk) {
#pragma unroll
        for (int n = 0; n < 4; ++n) { const bf16x8 bq = frag_lds(qs, LDK, 16 * n, 32 * kk, lane);
#pragma unroll
            for (int a = 0; a < 2; ++a) acc[a][n] = mma16(sf[kk][a], bq, acc[a][n]); } }
#pragma unroll
    for (int kk = 0; kk < 2; ++kk) { bf16x8 af[2];
#pragma unroll
        for (int a = 0; a < 2; ++a) af[a] = frag_tr(vs, LDV, 32 * kk, 32 * wave + 16 * a, lane);
#pragma unroll
        for (int n = 0; n < 4; ++n) { const bf16x8 bp = frag_lds(ps, LDP, 16 * n, 32 * kk, lane);
#pragma unroll
            for (int a = 0; a < 2; ++a) acc[a][n] = mma16(af[a], bp, acc[a][n]); } }
#pragma unroll
    for (int n = 0; n < 4; ++n) { float s = 0.f;
#pragma unroll
        for (int a = 0; a < 2; ++a)
#pragma unroll
            for (int r = 0; r < 4; ++r) s += acc[a][n][r] * acc[a][n][r];
        s += __shfl_xor(s, 16); s += __shfl_xor(s, 32);
        if (lane < 16) red[wave * 64 + 16 * n + lane] = s; }
    __syncthreads();
    PT_STAMP(3);
    bf16* OB = wsp<bf16>(F, WS_OB);
#pragma unroll
    for (int n = 0; n < 4; ++n) { const int i = 16 * n + (lane & 15); float tot = 0.f;
#pragma unroll
        for (int w = 0; w < 8; ++w) tot += red[w * 64 + i];
        const float rs = 1.0f / sqrtf(tot * (1.0f / 256.0f) + LN_EPS);
#pragma unroll
        for (int a = 0; a < 2; ++a) { const int e = 32 * wave + 16 * a + 4 * (lane >> 4);
            const float g0 = bf2f(gw[n][a].x & 0xffffu), g1 = bf2f(gw[n][a].x >> 16), g2 = bf2f(gw[n][a].y & 0xffffu), g3 = bf2f(gw[n][a].y >> 16);
            u32x2 o; o.x = pk2(acc[a][n][0] * rs * gn[a].x * g0, acc[a][n][1] * rs * gn[a].y * g1); o.y = pk2(acc[a][n][2] * rs * gn[a].z * g2, acc[a][n][3] * rs * gn[a].w * g3);
            *(u32x2*)ob_at(OB, t0 + i, 1024 + h * 256 + e) = o; } }
    PT_STAMP(4);
}

DI void pool_unit(const Frame& F, int l, int unit, const float* pool_scale) {
    const int gi = unit & 3, tt = unit >> 2, t0 = tt * 128, tid = F.tid, lane = F.lane, wave = F.wave, w = 2 << gi;
    const bf16* H = wsp<bf16>(F, WS_H);
    LAS bf16* pl = (LAS bf16*)(F.lds);
    constexpr int LDP = 264;
    __syncthreads();
    LAS bf16* raw = (LAS bf16*)(F.lds + 67584);
    { const int seq0 = t0 & ~(SEQ - 1);
      for (int p = tid + (16 - w) * 32; p < 143 * 32; p += NTHR) { const int r = p >> 5, ch = p & 31, tok = t0 - 15 + r;
          u32x4 x = (u32x4){0u, 0u, 0u, 0u}; if (tok >= seq0) x = *(const u32x4*)(H + (size_t)tok * NH + C_PU + gi * 256 + 8 * ch);
          *(LAS u32x4*)(raw + r * 256 + 8 * ch) = x; } }
    __syncthreads();
    for (int p = tid; p < 128 * 32; p += NTHR) { const int j = p >> 5, ch = p & 31, ts = (t0 + j) & (SEQ - 1);
        const int cnt = (ts + 1 < w) ? ts + 1 : w; float a[8], u0[8];
        { unpack8(*(const LAS u32x4*)(raw + (j + 15) * 256 + 8 * ch), u0);
#pragma unroll
          for (int i = 0; i < 8; ++i) a[i] = u0[i]; }
#pragma unroll
        for (int s = 1; s < 16; ++s) if (s < w) { float f[8]; unpack8(*(const LAS u32x4*)(raw + (j + 15 - s) * 256 + 8 * ch), f);
#pragma unroll
            for (int i = 0; i < 8; ++i) a[i] += f[i]; }
        const float ic = 1.0f / (float)cnt;
#pragma unroll
        for (int i = 0; i < 8; ++i) a[i] = a[i] * ic - u0[i];
        *(LAS u32x4*)(pl + j * LDP + 8 * ch) = pack8(a); }
    __syncthreads();
    const bf16* WP = wsp<bf16>(F, WS_WPOOLT) + (size_t)(l * 4 + gi) * 256 * 256;
    f32x4 acc[2][8];
#pragma unroll
    for (int a = 0; a < 2; ++a)
#pragma unroll
        for (int n = 0; n < 8; ++n) acc[a][n] = (f32x4){0.f, 0.f, 0.f, 0.f};
#pragma unroll 2
    for (int kk = 0; kk < 8; ++kk) { bf16x8 af[2];
#pragma unroll
        for (int a = 0; a < 2; ++a) af[a] = frag_glb(WP, 256, 32 * wave + 16 * a, 32 * kk, lane);
#pragma unroll
        for (int n = 0; n < 8; ++n) { const bf16x8 bp = frag_lds(pl, LDP, 16 * n, 32 * kk, lane);
#pragma unroll
            for (int a = 0; a < 2; ++a) acc[a][n] = mma16(af[a], bp, acc[a][n]); } }
    bf16* OB = wsp<bf16>(F, WS_OB);
#pragma unroll
    for (int n = 0; n < 8; ++n) { const int t = t0 + 16 * n + (lane & 15);
#pragma unroll
        for (int a = 0; a < 2; ++a) { const int dd = gi * 256 + 32 * wave + 16 * a + 4 * (lane >> 4);
            const f32x4 sc = *(const f32x4*)(pool_scale + l * 1024 + dd);
            const u32x2 gw = *(const u32x2*)(H + (size_t)t * NH + C_PG + dd);
            const float g0 = bf2f(gw.x & 0xffffu), g1 = bf2f(gw.x >> 16), g2 = bf2f(gw.y & 0xffffu), g3 = bf2f(gw.y >> 16);
            u32x2 o; o.x = pk2(acc[a][n][0] * sc.x * g0, acc[a][n][1] * sc.y * g1); o.y = pk2(acc[a][n][2] * sc.z * g2, acc[a][n][3] * sc.w * g3);
            *(u32x2*)ob_at(OB, t, dd) = o; } }
}

DI void swa_unit(const Frame& F, int l, int unit, const float* sinks) {
    const int n = unit & 31, hq = (unit >> 5) & 15, b = unit >> 9, kvh = hq >> 3, tid = F.tid, lane = F.lane, wave = F.wave;
    const int tq0 = b * SEQ + n * 128, tk0 = tq0 - 128;
    const bf16* H = wsp<bf16>(F, WS_H); const f32x2* RT = wsp<f32x2>(F, WS_ROPE);
    constexpr int LD = 72, LDPW = 168;
    LAS bf16* qs = (LAS bf16*)(F.lds);
    LAS bf16* ks = (LAS bf16*)(F.lds + 18432);
    LAS bf16* vs = (LAS bf16*)(F.lds + 57600);
    LAS bf16* pw = (LAS bf16*)(F.lds + 96768) + wave * 16 * LDPW;
    __syncthreads();
    for (int p = tid; p < 128 * 4; p += NTHR) { const int i = p >> 2, ch = p & 3; const bf16* src = H + (size_t)(tq0 + i) * NH + C_SQ + hq * 64 + 16 * ch;
        float f[16]; { float a[8], c[8]; unpack8(*(const u32x4*)src, a); unpack8(*(const u32x4*)(src + 8), c);
#pragma unroll
            for (int j = 0; j < 8; ++j) { f[j] = a[j]; f[8 + j] = c[j]; } }
        if (ch == 0) {
#pragma unroll
            for (int j = 0; j < 8; ++j) { const f32x2 cs = RT[(size_t)(tq0 + i) * 8 + j]; const float x1 = f[j], x2 = f[8 + j]; f[j] = x1 * cs.x - x2 * cs.y; f[8 + j] = x2 * cs.x + x1 * cs.y; } }
        float o0[8], o1[8];
#pragma unroll
        for (int j = 0; j < 8; ++j) { o0[j] = f[j] * 0.125f; o1[j] = f[8 + j] * 0.125f; }
        *(LAS u32x4*)(qs + i * LD + 16 * ch) = pack8(o0); *(LAS u32x4*)(qs + i * LD + 16 * ch + 8) = pack8(o1); }
    for (int p = tid; p < 272 * 4; p += NTHR) { const int j = p >> 2, ch = p & 3; const bool ok = (j < 256) && (n > 0 || j >= 128);
        u32x4 k0 = (u32x4){0u, 0u, 0u, 0u}, k1 = k0, v0 = k0, v1 = k0;
        if (ok) { const bf16* ksrc = H + (size_t)(tk0 + j) * NH + C_SK + kvh * 64 + 16 * ch; const bf16* vsrc = H + (size_t)(tk0 + j) * NH + C_SV + kvh * 64 + 16 * ch;
            k0 = *(const u32x4*)ksrc; k1 = *(const u32x4*)(ksrc + 8); v0 = *(const u32x4*)vsrc; v1 = *(const u32x4*)(vsrc + 8);
            if (ch == 0) { float a[8], c[8]; unpack8(k0, a); unpack8(k1, c);
#pragma unroll
                for (int jj = 0; jj < 8; ++jj) { const f32x2 cs = RT[(size_t)(tk0 + j) * 8 + jj]; const float x1 = a[jj], x2 = c[jj]; a[jj] = x1 * cs.x - x2 * cs.y; c[jj] = x2 * cs.x + x1 * cs.y; }
                k0 = pack8(a); k1 = pack8(c); } }
        *(LAS u32x4*)(ks + j * LD + 16 * ch) = k0; *(LAS u32x4*)(ks + j * LD + 16 * ch + 8) = k1;
        *(LAS u32x4*)(vs + j * LD + 16 * ch) = v0; *(LAS u32x4*)(vs + j * LD + 16 * ch + 8) = v1; }
    __syncthreads();
    const int qi = 16 * wave + (lane & 15);
    bf16x8 qf[2];
#pragma unroll
    for (int s = 0; s < 2; ++s) qf[s] = frag_lds(qs, LD, 16 * wave, 32 * s, lane);
    f32x4 sc[10];
#pragma unroll
    for (int jt = 0; jt < 10; ++jt) { sc[jt] = (f32x4){0.f, 0.f, 0.f, 0.f};
#pragma unroll
        for (int s = 0; s < 2; ++s) sc[jt] = mma16(frag_lds(ks, LD, 16 * (wave + jt), 32 * s, lane), qf[s], sc[jt]); }
    const float sink = sinks[l * 16 + hq];
    float mx = sink;
#pragma unroll
    for (int jt = 0; jt < 10; ++jt)
#pragma unroll
        for (int r = 0; r < 4; ++r) { const int kj = 16 * (wave + jt) + 4 * (lane >> 4) + r; const bool ok = (kj > qi) && (kj <= qi + 128) && (n > 0 || kj >= 128);
            sc[jt][r] = ok ? sc[jt][r] : -INFINITY; mx = fmaxf(mx, sc[jt][r]); }
    mx = fmaxf(mx, __shfl_xor(mx, 16)); mx = fmaxf(mx, __shfl_xor(mx, 32));
    float sum = 0.f;
#pragma unroll
    for (int jt = 0; jt < 10; ++jt)
#pragma unroll
        for (int r = 0; r < 4; ++r) { const float p = fexp(sc[jt][r] - mx); sc[jt][r] = p; sum += p; }
    sum += __shfl_xor(sum, 16); sum += __shfl_xor(sum, 32);
    const float inv = 1.0f / (sum + fexp(sink - mx));
#pragma unroll
    for (int jt = 0; jt < 10; ++jt) { u32x2 o; o.x = pk2(sc[jt][0] * inv, sc[jt][1] * inv); o.y = pk2(sc[jt][2] * inv, sc[jt][3] * inv);
        *(LAS u32x2*)(pw + (lane & 15) * LDPW + 16 * jt + 4 * (lane >> 4)) = o; }
    LDS_WAIT();
    f32x4 oa[4];
#pragma unroll
    for (int dt = 0; dt < 4; ++dt) oa[dt] = (f32x4){0.f, 0.f, 0.f, 0.f};
#pragma unroll
    for (int s = 0; s < 5; ++s) { const bf16x8 pf = frag_lds(pw, LDPW, 0, 32 * s, lane);
#pragma unroll
        for (int dt = 0; dt < 4; ++dt) oa[dt] = mma16(frag_tr(vs, LD, 16 * wave + 32 * s, 16 * dt, lane), pf, oa[dt]); }
    bf16* OB = wsp<bf16>(F, WS_OB);
    { const int t = tq0 + qi;
#pragma unroll
      for (int dt = 0; dt < 4; ++dt) { const int dd = hq * 64 + 16 * dt + 4 * (lane >> 4);
          const u32x2 gw = *(const u32x2*)(H + (size_t)t * NH + C_SG + dd);
          const float g0 = bf2f(gw.x & 0xffffu), g1 = bf2f(gw.x >> 16), g2 = bf2f(gw.y & 0xffffu), g3 = bf2f(gw.y >> 16);
          u32x2 o; o.x = pk2(oa[dt][0] * g0, oa[dt][1] * g1); o.y = pk2(oa[dt][2] * g2, oa[dt][3] * g3);
          *(u32x2*)ob_at(OB, t, 2048 + dd) = o; } }
}

DI void mem_unit(const Frame& F, int l, int unit) {
    const int n = unit & 31, hx = (unit >> 5) & 3, b = unit >> 7, lane = F.lane, wave = F.wave, tid = F.tid;
    const int tq0 = b * SEQ + n * 128 + 16 * wave;
    const bf16* H = wsp<bf16>(F, WS_H);
    const bf16* MK = wsp<bf16>(F, WS_MK) + (size_t)l * 512 * 1024 + (size_t)b * 256 * 1024 + hx * 256;
    const bf16* MVT = wsp<bf16>(F, WS_MVT) + (size_t)l * 1024 * 512 + (size_t)hx * 256 * 512 + b * 256;
    constexpr int LDI = 264;
    LAS bf16* img = (LAS bf16*)(F.lds);
    __syncthreads();
#pragma unroll 4
    for (int p = tid; p < 256 * 32; p += NTHR) { const int r = p >> 5, ch = p & 31; *(LAS u32x4*)(img + r * LDI + 8 * ch) = *(const u32x4*)(MK + (size_t)r * 1024 + 8 * ch); }
    bf16x8 qf[8];
#pragma unroll
    for (int s = 0; s < 8; ++s) qf[s] = frag_glb(H + C_XQ + hx * 256, NH, tq0, 32 * s, lane);
    __syncthreads();
    f32x4 sc[16];
#pragma unroll
    for (int jt = 0; jt < 16; ++jt) { sc[jt] = (f32x4){0.f, 0.f, 0.f, 0.f};
#pragma unroll
        for (int s = 0; s < 8; ++s) sc[jt] = mma16(frag_lds(img, LDI, 16 * jt, 32 * s, lane), qf[s], sc[jt]);
        if (jt & 1) __builtin_amdgcn_sched_barrier(0); }
#pragma unroll
    for (int jt = 0; jt < 16; ++jt) asm volatile("" : "+v"(sc[jt]));
    __syncthreads();
#pragma unroll 4
    for (int p = tid; p < 256 * 32; p += NTHR) { const int r = p >> 5, ch = p & 31; *(LAS u32x4*)(img + r * LDI + 8 * ch) = *(const u32x4*)(MVT + (size_t)r * 512 + 8 * ch); }
    float mx = -INFINITY;
#pragma unroll
    for (int jt = 0; jt < 16; ++jt)
#pragma unroll
        for (int r = 0; r < 4; ++r) { sc[jt][r] *= 0.0625f; mx = fmaxf(mx, sc[jt][r]); }
    mx = fmaxf(mx, __shfl_xor(mx, 16)); mx = fmaxf(mx, __shfl_xor(mx, 32));
    float sum = 0.f;
#pragma unroll
    for (int jt = 0; jt < 16; ++jt)
#pragma unroll
        for (int r = 0; r < 4; ++r) { const float p = __builtin_amdgcn_exp2f((sc[jt][r] - mx) * 1.44269504089f); sc[jt][r] = p; sum += p; }
    sum += __shfl_xor(sum, 16); sum += __shfl_xor(sum, 32);
    const float inv = 1.0f / sum;
    bf16x8 pb[8];
#pragma unroll
    for (int s = 0; s < 8; ++s) { u32x4 w; w.x = pk2(sc[2 * s][0] * inv, sc[2 * s][1] * inv); w.y = pk2(sc[2 * s][2] * inv, sc[2 * s][3] * inv);
        w.z = pk2(sc[2 * s + 1][0] * inv, sc[2 * s + 1][1] * inv); w.w = pk2(sc[2 * s + 1][2] * inv, sc[2 * s + 1][3] * inv); pb[s] = __builtin_bit_cast(bf16x8, w); }
    __syncthreads();
    bf16* OB = wsp<bf16>(F, WS_OB); const int t = tq0 + (lane & 15);
    const LAS bf16* arow = img + (lane & 15) * LDI + 4 * (lane >> 4);
#pragma unroll 4
    for (int dt = 0; dt < 16; ++dt) { f32x4 oa = (f32x4){0.f, 0.f, 0.f, 0.f};
#pragma unroll
        for (int s = 0; s < 8; ++s) { const u32x2 lo = *(const LAS u32x2*)(arow + 16 * dt * LDI + 32 * s), hi = *(const LAS u32x2*)(arow + 16 * dt * LDI + 32 * s + 16);
            const u32x4 av = (u32x4){lo.x, lo.y, hi.x, hi.y};
            oa = mma16(__builtin_bit_cast(bf16x8, av), pb[s], oa); }
        __builtin_amdgcn_sched_barrier(0);
        const int dd = hx * 256 + 16 * dt + 4 * (lane >> 4);
        const u32x2 gw = *(const u32x2*)(H + (size_t)t * NH + C_XG + dd);
        const float g0 = bf2f(gw.x & 0xffffu), g1 = bf2f(gw.x >> 16), g2 = bf2f(gw.y & 0xffffu), g3 = bf2f(gw.y >> 16);
        u32x2 o; o.x = pk2(oa[0] * g0, oa[1] * g1); o.y = pk2(oa[2] * g2, oa[3] * g3);
        *(u32x2*)ob_at(OB, t, 3072 + dd) = o; }
}

#ifndef NAIVE_MASK
#define NAIVE_MASK 0
#endif
DI float Hf(const bf16* H, size_t row, int col) { return bf2f(H[row * NH + col]); }
DI void naive_mem(const Frame& F, int l) {
    const bf16* H = wsp<bf16>(F, WS_H); bf16* OB = wsp<bf16>(F, WS_OB);
    LAS float* qs = (LAS float*)(F.lds) + F.wave * 512; LAS float* ps = qs + 256;
    const int gw = F.wg * NWAVES + F.wave, NGW = F.G * NWAVES, lane = F.lane;
    for (int it = gw; it < MTOK * 4; it += NGW) {
        const int t = it >> 2, hx = it & 3, b = t / SEQ;
        const bf16* MK = wsp<bf16>(F, WS_MK) + (size_t)l * 512 * 1024 + (size_t)b * 256 * 1024 + hx * 256;
        const bf16* MVT = wsp<bf16>(F, WS_MVT) + (size_t)l * 1024 * 512 + (size_t)hx * 256 * 512 + b * 256;
        for (int i = 0; i < 4; ++i) qs[lane + 64 * i] = Hf(H, t, C_XQ + hx * 256 + lane + 64 * i);
        LDS_WAIT();
        float sc[4]; float mx = -INFINITY;
        for (int i = 0; i < 4; ++i) { const int j = lane + 64 * i; float a = 0.f; for (int d = 0; d < 256; ++d) a += qs[d] * bf2f(MK[(size_t)j * 1024 + d]); sc[i] = a * 0.0625f; mx = fmaxf(mx, sc[i]); }
        for (int o = 1; o < 64; o <<= 1) mx = fmaxf(mx, __shfl_xor(mx, o));
        float sum = 0.f; for (int i = 0; i < 4; ++i) { sc[i] = expf(sc[i] - mx); sum += sc[i]; }
        sum = wave_sum(sum);
        for (int i = 0; i < 4; ++i) ps[lane + 64 * i] = sc[i] / sum;
        LDS_WAIT();
        for (int i = 0; i < 4; ++i) { const int d = lane + 64 * i; float a = 0.f; for (int j = 0; j < 256; ++j) a += ps[j] * bf2f(MVT[(size_t)d * 512 + j]);
            *ob_at(OB, t, 3072 + hx * 256 + d) = (bf16)f2bf(a * Hf(H, t, C_XG + hx * 256 + d)); }
        LDS_WAIT();
    }
}
DI void naive_swa(const Frame& F, int l, const float* sinks) {
    const bf16* H = wsp<bf16>(F, WS_H); bf16* OB = wsp<bf16>(F, WS_OB); const f32x2* RT = wsp<f32x2>(F, WS_ROPE);
    LAS float* qs = (LAS float*)(F.lds) + F.wave * 256; LAS float* ps = qs + 64;
    const int gw = F.wg * NWAVES + F.wave, NGW = F.G * NWAVES, lane = F.lane;
    for (int it = gw; it < MTOK * 16; it += NGW) {
        const int t = it >> 4, hq = it & 15, kvh = hq >> 3, ts = t & (SEQ - 1);
        { float x = Hf(H, t, C_SQ + hq * 64 + lane);
          if (lane < 16) { const int i = lane & 7; const float x1 = Hf(H, t, C_SQ + hq * 64 + i), x2 = Hf(H, t, C_SQ + hq * 64 + 8 + i); const f32x2 cs = RT[(size_t)t * 8 + i];
              x = (lane < 8) ? x1 * cs.x - x2 * cs.y : x2 * cs.x + x1 * cs.y; }
          qs[lane] = x * 0.125f; }
        LDS_WAIT();
        float sc[2]; const float sink = sinks[l * 16 + hq]; float mx = sink;
        for (int i = 0; i < 2; ++i) { const int back = lane + 64 * i; sc[i] = -INFINITY;
            if (back <= ts) { const int tk = t - back; float a = 0.f;
                for (int d = 0; d < 64; ++d) { float kv = Hf(H, tk, C_SK + kvh * 64 + d);
                    if (d < 16) { const int ii = d & 7; const float x1 = Hf(H, tk, C_SK + kvh * 64 + ii), x2 = Hf(H, tk, C_SK + kvh * 64 + 8 + ii); const f32x2 cs = RT[(size_t)tk * 8 + ii];
                        kv = (d < 8) ? x1 * cs.x - x2 * cs.y : x2 * cs.x + x1 * cs.y; }
                    a += qs[d] * kv; }
                sc[i] = a; }
            mx = fmaxf(mx, sc[i]); }
        for (int o = 1; o < 64; o <<= 1) mx = fmaxf(mx, __shfl_xor(mx, o));
        float sum = 0.f; for (int i = 0; i < 2; ++i) { sc[i] = expf(sc[i] - mx); sum += sc[i]; }
        sum = wave_sum(sum) + expf(sink - mx);
        for (int i = 0; i < 2; ++i) ps[lane + 64 * i] = sc[i] / sum;
        LDS_WAIT();
        { float a = 0.f; const int nk = (ts + 1 < 128) ? ts + 1 : 128;
          for (int back = 0; back < nk; ++back) a += ps[back] * Hf(H, t - back, C_SV + kvh * 64 + lane);
          *ob_at(OB, t, 2048 + hq * 64 + lane) = (bf16)f2bf(a * Hf(H, t, C_SG + hq * 64 + lane)); }
        LDS_WAIT();
    }
}
DI void naive_pool(const Frame& F, int l, const float* w_pool, const float* pool_scale) {
    const bf16* H = wsp<bf16>(F, WS_H); bf16* OB = wsp<bf16>(F, WS_OB); LAS float* pl = (LAS float*)(F.lds);
    for (int unit = F.wg; unit < 512; unit += F.G) { const int gi = unit & 3, t0 = (unit >> 2) * 64, w = 2 << gi;
        __syncthreads();
        for (int p = F.tid; p < 64 * 256; p += NTHR) { const int j = p >> 8, c = p & 255, t = t0 + j, ts = t & (SEQ - 1); const int cnt = (ts + 1 < w) ? ts + 1 : w; float a = 0.f;
            for (int s2 = 0; s2 < cnt; ++s2) a += Hf(H, t - s2, C_PU + gi * 256 + c);
            pl[p] = a / (float)cnt - Hf(H, t, C_PU + gi * 256 + c); }
        __syncthreads();
        const float* W = w_pool + (size_t)(l * 4 + gi) * 256 * 256;
        for (int o = F.tid; o < 64 * 256; o += NTHR) { const int j = o >> 8, d = o & 255; float a = 0.f; for (int c = 0; c < 256; ++c) a += pl[j * 256 + c] * W[c * 256 + d];
            const int t = t0 + j; *ob_at(OB, t, gi * 256 + d) = (bf16)f2bf(a * pool_scale[l * 1024 + gi * 256 + d] * Hf(H, t, C_PG + gi * 256 + d)); } }
}
DI void naive_gla(const Frame& F, int l, const float* w_gla_up, const float* b_gla) {
    const bf16* H = wsp<bf16>(F, WS_H); float* RAW = wsp<float>(F, WS_GU); LAS float* red = (LAS float*)(F.lds);
    for (int unit = F.wg; unit < 64; unit += F.G) { const int bh = unit >> 3, es = unit & 7, b = bh >> 2, h = bh & 3, e = es * 32 + (F.tid & 31), dg = F.tid >> 5;
        float S[8], wu[8][16], bg[8];
        for (int i = 0; i < 8; ++i) { S[i] = 0.f; bg[i] = b_gla[l * 512 + h * 128 + 8 * dg + i]; for (int r = 0; r < 16; ++r) wu[i][r] = w_gla_up[(size_t)l * 16 * 512 + r * 512 + h * 128 + 8 * dg + i]; }
        for (int ts = 0; ts < SEQ; ++ts) { const size_t t = (size_t)b * SEQ + ts; float lr[16]; for (int r = 0; r < 16; ++r) lr[r] = Hf(H, t, C_LR + r);
            const float v = Hf(H, t, C_GV + h * 256 + e); float part = 0.f;
            for (int i = 0; i < 8; ++i) { float z = bg[i]; for (int r = 0; r < 16; ++r) z += lr[r] * wu[i][r];
                const float a = expf((fminf(z, 0.f) - log1pf(expf(-fabsf(z)))) * (1.0f / 16.0f));
                S[i] = a * S[i] + Hf(H, t, C_GK + h * 128 + 8 * dg + i) * v; part += Hf(H, t, C_GQ + h * 128 + 8 * dg + i) * 0.08838834764831845f * S[i]; }
            __syncthreads(); red[dg * 32 + (F.tid & 31)] = part; __syncthreads();
            if (dg == 0) { float o = 0.f; for (int g = 0; g < 16; ++g) o += red[g * 32 + (F.tid & 31)]; RAW[t * 1024 + h * 256 + e] = o; } } }
}
DI void naive_gla_norm(const Frame& F, int l, const float* gla_norm) {
    const bf16* H = wsp<bf16>(F, WS_H); bf16* OB = wsp<bf16>(F, WS_OB); const float* RAW = wsp<float>(F, WS_GU);
    const int gw = F.wg * NWAVES + F.wave, NGW = F.G * NWAVES, lane = F.lane;
    for (int it = gw; it < MTOK * 4; it += NGW) { const int t = it >> 2, h = it & 3; float o[4], ss = 0.f;
        for (int i = 0; i < 4; ++i) { o[i] = RAW[(size_t)t * 1024 + h * 256 + lane + 64 * i]; ss += o[i] * o[i]; }
        ss = wave_sum(ss); const float rs = 1.0f / sqrtf(ss * (1.0f / 256.0f) + LN_EPS);
        for (int i = 0; i < 4; ++i) { const int e = lane + 64 * i; *ob_at(OB, t, 1024 + h * 256 + e) = (bf16)f2bf(o[i] * rs * gla_norm[l * 1024 + h * 256 + e] * Hf(H, t, C_GG + h * 256 + e)); } }
}

DI void ln_phase(const Frame& F, int l, const float* ln_g, const float* ln_b) {
    const int gw = F.wg * NWAVES + F.wave, NGW = F.G * NWAVES, lane = F.lane;
    const float* g = ln_g + l * DM; const float* bb = ln_b + l * DM;
    for (int m = gw; m < MTOK; m += NGW) {
        f32x4* row = (f32x4*)(F.out + (size_t)m * DM) + lane; const f32x4* zrow = (const f32x4*)(wsp<float>(F, WS_Z) + (size_t)m * DM) + lane;
        f32x4 v[16]; float s = 0.f;
#pragma unroll
        for (int j = 0; j < 16; ++j) { v[j] = zrow[64 * j]; s += (v[j].x + v[j].y) + (v[j].z + v[j].w); }
        const float mean = wave_sum(s) * (1.f / DM); float s2 = 0.f;
#pragma unroll
        for (int j = 0; j < 16; ++j) { v[j] = v[j] - mean; s2 += (v[j].x * v[j].x + v[j].y * v[j].y) + (v[j].z * v[j].z + v[j].w * v[j].w); }
        const float rstd = 1.f / sqrtf(wave_sum(s2) * (1.f / DM) + LN_EPS);
        u32x2* xb = (u32x2*)(wsp<bf16>(F, WS_XB) + (size_t)m * DM) + lane; unsigned* x8 = (unsigned*)(wsp<unsigned char>(F, WS_X8) + (size_t)m * DM) + lane;
#pragma unroll
        for (int j = 0; j < 16; ++j) { const f32x4 gg = *((const f32x4*)g + lane + 64 * j), be = *((const f32x4*)bb + lane + 64 * j);
            const f32x4 o = v[j] * rstd * gg + be; row[64 * j] = o;
#if F6
            if (l + 1 < DEPTH) { u32x2 w; w.x = pk2(o.x, o.y); w.y = pk2(o.z, o.w); xb[64 * j] = w;
                LAS unsigned char* lw = F.lds + F.wave * 9216;
                *(LAS f32x4*)(lw + ((lane >> 3) + 8 * (j & 7)) * 144 + (lane & 7) * 16) = o * X8_SCALE;
                if ((j & 7) == 7) { LDS_WAIT(); float f[32];
#pragma unroll
                    for (int t = 0; t < 8; ++t) { const f32x4 q = *(const LAS f32x4*)(lw + lane * 144 + 16 * t); f[4 * t] = q.x; f[4 * t + 1] = q.y; f[4 * t + 2] = q.z; f[4 * t + 3] = q.w; }
                    u32x4 lo, hi; pk32_fp6(f, lo, hi); const int gi = 64 * (j >> 3) + lane; size_t ol, oh; pg8::f6_off(m, gi >> 2, gi & 3, ol, oh);
                    *(u32x4*)(wsp<unsigned char>(F, WS_X8) + ol) = lo; u32x2 h2; h2.x = hi.x; h2.y = hi.y; *(u32x2*)(wsp<unsigned char>(F, WS_X8) + oh) = h2; LDS_WAIT(); } } }
#else
            if (l + 1 < DEPTH) { u32x2 w; w.x = pk2(o.x, o.y); w.y = pk2(o.z, o.w); xb[64 * j] = w; x8[64 * j] = pk4_fp8(o.x * X8_SCALE, o.y * X8_SCALE, o.z * X8_SCALE, o.w * X8_SCALE); } }
#endif
    }
}

struct Args { const void* in[15]; float* out; unsigned char* ws; int ph_lo, ph_hi; };
constexpr int PH_PER_LAYER = 7, N_PHASES = 1 + PH_PER_LAYER * DEPTH;
#define IN(k) (lo <= (k) && (k) < hi)
#ifndef PH_MASK
#define PH_MASK 0xffff
#endif
#define PHM(b) ((PH_MASK >> (b)) & 1)
#ifndef REP_MASK
#define REP_MASK 0
#endif
#define REPS(b) (((REP_MASK >> (b)) & 1) ? 2 : 1)
#define SEAM(k) do { if (IN(k) && IN((k) + 1)) xcd_barrier(bar); } while (0)
#ifndef PROBE_CLK
#define PROBE_CLK 0
#endif
#ifndef PROBE_HOT
#define PROBE_HOT 0
#endif
struct SchedHot {
    static constexpr bool BLK = false;
    int G, c, mode; const char* A; const char* B;
    DI bool next(int i, pg8::Unit& u) const { if (i >= 4) return false; if (mode == 1) { u.pm = c & 7; u.pn = 0; } else if (mode == 4) { u.pm = c & 7; u.pn = c & 7; } else pg8::static_tile(i * G + c, 32, 32, u.pm, u.pn); u.gi = 0; return true; }
    DI const char* abase(const pg8::Unit& u) const { return A + (size_t)u.pm * 256 * 4096 * 2; }
    DI const char* bbase(const pg8::Unit& u) const { return B + (size_t)u.pn * 256 * 4096 * 2; }
};
struct SchedHot6 {
    static constexpr bool BLK = false;
    int G, c, mode; const char* A; const char* B;
    DI bool next(int i, pg8::Unit& u) const { if (i >= 4) return false; if (mode == 6) { u.pm = c & 7; u.pn = c & 7; } else pg8::static_tile(i * G + c, 32, 32, u.pm, u.pn); u.gi = 0; return true; }
    DI const char* abase(const pg8::Unit& u) const { return A + (size_t)u.pm * 786432; }
    DI const char* bbase(const pg8::Unit& u) const { return (mode == 6 ? A : B) + (size_t)u.pn * 786432; }
};
struct SchedHotBlk : SchedHot { static constexpr bool BLK = true; };
template <int l> DI void layer_body(const Frame& F, const Args& args, const int lo, const int hi, const XcdBarrier& bar) {
        const int p0 = 1 + PH_PER_LAYER * l;
        if (PHM(1) && IN(p0)) { {
            SchedInProj S; S.G = F.G; S.c = F.wg; S.n_extra = (l == 0) ? 32 : 0; S.XB = (const char*)(F.ws + WS_XB); S.WT = (const char*)(F.ws + WS_WINT) + (size_t)l * NH * 4096 * 2;
            S.MEMB = (const char*)(F.ws + WS_MEMB); S.WKV = (const char*)(F.ws + WS_WMKVT);
            EpiH E{wsp<bf16>(F, WS_H), wsp<bf16>(F, WS_MK), wsp<bf16>(F, WS_MVT)};
            pg8::SchedStatic S8; S8.nM = 32; S8.nN = N_F8 / (128 * F8NB); S8.G = F.G; S8.c = (F.wg + F8_ROT) % F.G; S8.A = (const char*)(F.ws + WS_X8); S8.B = (const char*)(F.ws + WS_W8) + (size_t)l * W8_LAYER;
            S8.astep = F6 ? (size_t)2 * 32 * 12288 : (size_t)256 * 4096; S8.bstep = F6 ? (size_t)F8NB * 32 * 12288 : (size_t)(128 * F8NB) * 4096;
            EpiMG<F8NB> E8{wsp<bf16>(F, WS_H)};
#if F6_FIRST
            pg8::gemm_phase<EpiMG<F8NB>, pg8::SchedStatic, F8NB, true, true>(F.lds, 2048, S8, E8);
            pg8::gemm_phase<EpiH, SchedInProj, 2, true>(F.lds, 4096, S, E);
#else
            pg8::gemm_phase<EpiH, SchedInProj, 2, true>(F.lds, 4096, S, E);
            pg8::gemm_phase<EpiMG<F8NB>, pg8::SchedStatic, F8NB, true, true>(F.lds, 2048, S8, E8);
#endif
        }
        if (PROBE_HOT >= 5 && l == 0) {
            SchedHot6 S6; S6.G = F.G; S6.c = F.wg; S6.mode = PROBE_HOT; S6.A = (const char*)(F.ws + WS_X8); S6.B = (const char*)(F.ws + WS_W8);
            EpiMG<F8NB> E6{(bf16*)(F.ws + (size_t)1700 * MiB)};
            pg8::gemm_phase<EpiMG<F8NB>, SchedHot6, F8NB, true, true>(F.lds, 2048, S6, E6);
        } else
        if (PROBE_HOT != 0 && l == 0) {
            SchedHot S; S.G = F.G; S.c = F.wg; S.mode = PROBE_HOT; S.A = (const char*)(F.ws + WS_XB); S.B = (PROBE_HOT == 4) ? (const char*)(F.ws + WS_XB) : (const char*)(F.ws + WS_WINT);
            EpiH E{(bf16*)(F.ws + (size_t)1700 * MiB), wsp<bf16>(F, WS_MK), wsp<bf16>(F, WS_MVT)};
            if (PROBE_HOT == 3) { SchedHotBlk S3; S3.G = S.G; S3.c = S.c; S3.mode = 2; S3.A = S.A; S3.B = S.B; pg8::gemm_phase<EpiH, SchedHotBlk, 2, true>(F.lds, 4096, S3, E); }
            else pg8::gemm_phase<EpiH, SchedHot, 2, true>(F.lds, 4096, S, E);
        }
        if (REPS(1) == 2) {
            SchedInProj S; S.G = F.G; S.c = F.wg; S.n_extra = (l == 0) ? 32 : 0; S.XB = (const char*)(F.ws + WS_XB); S.WT = (const char*)(F.ws + WS_WINT) + (size_t)l * NH * 4096 * 2;
            S.MEMB = (const char*)(F.ws + WS_MEMB); S.WKV = (const char*)(F.ws + WS_WMKVT);
            EpiH E{wsp<bf16>(F, WS_H), wsp<bf16>(F, WS_MK), wsp<bf16>(F, WS_MVT)};
            pg8::gemm_phase<EpiH, SchedInProj, 2, true>(F.lds, 4096, S, E);
            pg8::SchedStatic S8; S8.nM = 32; S8.nN = N_F8 / (128 * F8NB); S8.G = F.G; S8.c = (F.wg + F8_ROT) % F.G; S8.A = (const char*)(F.ws + WS_X8); S8.B = (const char*)(F.ws + WS_W8) + (size_t)l * W8_LAYER;
            S8.astep = F6 ? (size_t)2 * 32 * 12288 : (size_t)256 * 4096; S8.bstep = F6 ? (size_t)F8NB * 32 * 12288 : (size_t)(128 * F8NB) * 4096;
            EpiMG<F8NB> E8{wsp<bf16>(F, WS_H)};
            pg8::gemm_phase<EpiMG<F8NB>, pg8::SchedStatic, F8NB, true, true>(F.lds, 2048, S8, E8);
        } }
        SEAM(p0);
        if (PHM(2) && IN(p0 + 1)) for (int rep = 0; rep < REPS(2); ++rep) { if (NAIVE_MASK & 2) naive_gla(F, l, (const float*)args.in[6], (const float*)args.in[7]); else for (int u = F.wg; u < 512; u += F.G) gla_a_unit(F, l, u, (const float*)args.in[6], (const float*)args.in[7]); }
        SEAM(p0 + 1);
        if (PHM(3) && IN(p0 + 2)) for (int rep = 0; rep < REPS(3); ++rep) { if (!(NAIVE_MASK & 2)) gla_scan(F); }
        SEAM(p0 + 2);
        if (PHM(4) && IN(p0 + 3)) for (int rep = 0; rep < REPS(4); ++rep) {
            if (NAIVE_MASK & 2) naive_gla_norm(F, l, (const float*)args.in[8]); else
            for (int r2 = 0; r2 < REPS(8); ++r2) for (int u = F.wg; u < 512; u += F.G) gla_c_unit(F, l, u, (const float*)args.in[8]);
            if (NAIVE_MASK & 1) naive_pool(F, l, (const float*)args.in[4], (const float*)args.in[5]); else
            for (int r2 = 0; r2 < REPS(9); ++r2) for (int u = F.wg; u < 256; u += F.G) pool_unit(F, l, u, (const float*)args.in[5]);
            __syncthreads();
            if (NAIVE_MASK & 4) naive_swa(F, l, (const float*)args.in[9]); else
            for (int r2 = 0; r2 < REPS(10); ++r2) for (int u = F.wg; u < 1024; u += F.G) swa_unit(F, l, u, (const float*)args.in[9]);
            __syncthreads();
            if (NAIVE_MASK & 8) naive_mem(F, l); else
            for (int r2 = 0; r2 < REPS(11); ++r2) for (int u = F.wg; u < 256; u += F.G) mem_unit(F, l, u);
            __syncthreads();
        }
        SEAM(p0 + 3);
        if (PHM(5) && IN(p0 + 4)) { {
            pg8::SchedStatic S; S.nM = 32; S.nN = 32; S.G = F.G; S.c = F.wg; S.A = (const char*)(F.ws + WS_OB); S.B = (const char*)(F.ws + WS_WBRT) + (size_t)l * 4096 * 4096 * 2;
            S.astep = (size_t)256 * 4096 * 2; S.bstep = (size_t)128 * 4096 * 2;
            EpiGate E{wsp<bf16>(F, WS_H), wsp<bf16>(F, WS_YB)};
            if (BLK_GATE) { pg8::SchedStaticBlk SB; (pg8::SchedStatic&)SB = S; pg8::gemm_phase<EpiGate, pg8::SchedStaticBlk, 1, true>(F.lds, 4096, SB, E); } else
            pg8::gemm_phase<EpiGate, pg8::SchedStatic, 1, true>(F.lds, 4096, S, E);
        }
        if (REPS(5) == 2) {
            pg8::SchedStatic S; S.nM = 32; S.nN = 32; S.G = F.G; S.c = F.wg; S.A = (const char*)(F.ws + WS_OB); S.B = (const char*)(F.ws + WS_WBRT) + (size_t)l * 4096 * 4096 * 2;
            S.astep = (size_t)256 * 4096 * 2; S.bstep = (size_t)128 * 4096 * 2;
            EpiGate E{wsp<bf16>(F, WS_H), wsp<bf16>(F, WS_YB)};
            if (BLK_GATE) { pg8::SchedStaticBlk SB; (pg8::SchedStatic&)SB = S; pg8::gemm_phase<EpiGate, pg8::SchedStaticBlk, 1, true>(F.lds, 4096, SB, E); } else
            pg8::gemm_phase<EpiGate, pg8::SchedStatic, 1, true>(F.lds, 4096, S, E);
        } }
        SEAM(p0 + 4);
        if (PHM(6) && IN(p0 + 5)) { {
            pg8::SchedStatic S; S.nM = 32; S.nN = 16; S.G = F.G; S.c = F.wg; S.A = (const char*)(F.ws + WS_YB); S.B = (const char*)(F.ws + WS_WOUTT) + (size_t)l * 4096 * 4096 * 2;
            S.astep = (size_t)256 * 4096 * 2; S.bstep = (size_t)256 * 4096 * 2;
            EpiRes E{l == 0 ? (const float*)args.in[0] : (const float*)F.out, wsp<float>(F, WS_Z)};
            if (BLK_OUT) { pg8::SchedStaticBlk SB; (pg8::SchedStatic&)SB = S; pg8::gemm_phase<EpiRes, pg8::SchedStaticBlk, 2, true>(F.lds, 4096, SB, E); } else
            pg8::gemm_phase<EpiRes, pg8::SchedStatic, 2, true>(F.lds, 4096, S, E);
        }
        if (REPS(6) == 2) {
            pg8::SchedStatic S; S.nM = 32; S.nN = 16; S.G = F.G; S.c = F.wg; S.A = (const char*)(F.ws + WS_YB); S.B = (const char*)(F.ws + WS_WOUTT) + (size_t)l * 4096 * 4096 * 2;
            S.astep = (size_t)256 * 4096 * 2; S.bstep = (size_t)256 * 4096 * 2;
            EpiRes E{l == 0 ? (const float*)args.in[0] : (const float*)F.out, wsp<float>(F, WS_Z)};
            if (BLK_OUT) { pg8::SchedStaticBlk SB; (pg8::SchedStatic&)SB = S; pg8::gemm_phase<EpiRes, pg8::SchedStaticBlk, 2, true>(F.lds, 4096, SB, E); } else
            pg8::gemm_phase<EpiRes, pg8::SchedStatic, 2, true>(F.lds, 4096, S, E);
        } }
        SEAM(p0 + 5);
        if (PHM(7) && IN(p0 + 6)) for (int rep = 0; rep < REPS(7); ++rep) { ln_phase(F, l, (const float*)args.in[13], (const float*)args.in[14]); }
        SEAM(p0 + 6);
}


__global__ void __launch_bounds__(NTHR, 2) mk_fwd(Args args) {
    extern __shared__ __attribute__((aligned(16))) unsigned char lds_raw[];
    Frame F;
    F.lds = (LAS unsigned char*)lds_raw;
    F.tid = threadIdx.x; F.lane = F.tid & 63; F.wave = __builtin_amdgcn_readfirstlane(F.tid >> 6); F.G = gridDim.x; F.wg = blockIdx.x;
    F.out = args.out; F.ws = args.ws;
    volatile LAS unsigned* MISC = (volatile LAS unsigned*)(F.lds + MISC_OFF);
    for (int u = F.tid; u < (LDS_BYTES - LDSCTL_OFF) / 4; u += NTHR) ((LAS unsigned*)(F.lds + LDSCTL_OFF))[u] = 0u;
    __syncthreads();
    unsigned* barw = (unsigned*)(F.ws + WS_CTL) + CW_BAR;
    XcdBarrier bar; bar.bar = barw; bar.x = 0; bar.st = nullptr;
    const int lo = args.ph_lo, hi = args.ph_hi;
    if (hi - lo > 1) bar = xcd_barrier_post(barw, MISC + 8);

    if (PHM(0) && IN(0)) for (int rep = 0; rep < REPS(0); ++rep) { prologue(F, (const float*)args.in[0], (const float*)args.in[1], (const int*)args.in[2], (const float*)args.in[3], (const float*)args.in[4], (const float*)args.in[10], (const float*)args.in[11], (const float*)args.in[12]); }
    SEAM(0);
    layer_body<0>(F, args, lo, hi, bar);
#if PROBE_CLK
    const long long pc0 = clock64(), pw0 = wall_clock64();
#endif
    layer_body<1>(F, args, lo, hi, bar);
#if PROBE_CLK
    if (blockIdx.x == 0 && threadIdx.x == 0) {
        const long long dc = clock64() - pc0, dw = wall_clock64() - pw0; const long long fmhz = dw > 0 ? 100 * dc / dw : 0; const long long ticks = (fmhz - 1000) * 100;
        if (ticks > 0 && ticks < 300000) { const long long s0 = wall_clock64(); while (wall_clock64() - s0 < ticks) __builtin_amdgcn_s_sleep(8); }
    }
#endif
#if PROBE_T
    if (blockIdx.x == 0 && threadIdx.x == 0) {
        const unsigned acc_t = ((volatile LAS unsigned*)(F.lds + MISC_OFF + 128))[PROBE_T]; const long long ticks = 8ll * acc_t;
        if (ticks > 0 && ticks < 400000) { const long long s0 = wall_clock64(); while (wall_clock64() - s0 < ticks) __builtin_amdgcn_s_sleep(8); }
    }
#endif
#undef IN
#undef SEAM
}

extern "C" void kernel_launch(void* const* d_in, const int* in_sizes, int n_in, void* d_out, int out_size, void* d_ws, size_t ws_size, hipStream_t stream) {
    static int grid = 0;
    if (grid == 0) {
        if (n_in != 15 || out_size != MTOK * DM || ws_size < WS_END) { fprintf(stderr, "kernel_launch: unexpected sizes (n_in %d, out %d, ws %zu); nothing launched\n", n_in, out_size, ws_size); grid = -1; return; }
        int dev = 0, cus = 0, per_cu = 0;
        if (hipGetDevice(&dev) != hipSuccess || hipDeviceGetAttribute(&cus, hipDeviceAttributeMultiprocessorCount, dev) != hipSuccess) { grid = -1; return; }
        if (hipFuncSetAttribute((const void*)mk_fwd, hipFuncAttributeMaxDynamicSharedMemorySize, LDS_BYTES) != hipSuccess) { fprintf(stderr, "kernel_launch: hipFuncSetAttribute failed\n"); grid = -1; return; }
        if (hipOccupancyMaxActiveBlocksPerMultiprocessor(&per_cu, (const void*)mk_fwd, NTHR, LDS_BYTES) != hipSuccess || per_cu < 1) fprintf(stderr, "kernel_launch: occupancy query says %d\n", per_cu);
        (void)hipGetLastError();
        grid = cus;
    }
    if (grid < 0) return;
    (void)hipMemsetAsync((char*)d_ws + WS_CTL, 0, CTL_ZERO_BYTES, stream);
    Args a{};
    for (int i = 0; i < 15; ++i) a.in[i] = d_in[i];
    a.out = (float*)d_out; a.ws = (unsigned char*)d_ws;
#if MK_PER_PHASE
    for (int p = 0; p < N_PHASES; ++p) { a.ph_lo = p; a.ph_hi = p + 1; hipLaunchKernelGGL(mk_fwd, dim3(grid), dim3(NTHR), LDS_BYTES, stream, a); }
#else
    a.ph_lo = 0; a.ph_hi = N_PHASES;
    hipLaunchKernelGGL(mk_fwd, dim3(grid), dim3(NTHR), LDS_BYTES, stream, a);
#endif
}
```

```cpp
#include <hip/hip_runtime.h>
#include <cstdio>
#include <cstdint>

#ifndef F8ASM1
#define F8ASM1 0
#endif
#ifndef F8NB
#define F8NB 2
#endif
#ifndef MK_PER_PHASE
#define MK_PER_PHASE 0
#endif

#define DI __device__ __forceinline__
#define LAS __attribute__((address_space(3)))
#define GAS __attribute__((address_space(1)))
typedef unsigned short bf16;
typedef short bf16x8 __attribute__((ext_vector_type(8)));
typedef short s16x4 __attribute__((ext_vector_type(4)));
typedef short v4i16_t __attribute__((ext_vector_type(4)));
typedef float f32x4 __attribute__((ext_vector_type(4)));
typedef float f32x2 __attribute__((ext_vector_type(2)));
typedef unsigned u32x4 __attribute__((ext_vector_type(4)));
typedef unsigned u32x2 __attribute__((ext_vector_type(2)));

constexpr int BATCH = 2, SEQ = 4096, DM = 4096, MTOK = BATCH * SEQ, DEPTH = 2;
constexpr int D_IN = 25872, NH = 26112;
constexpr int BW = 1024;
constexpr int MEMLEN = 256;
constexpr int C_PU = 0, C_PG = 1024, C_GQ = 2048, C_GK = 2560, C_GV = 3072, C_GG = 4096, C_SQ = 5120, C_SK = 6144, C_SV = 6272, C_SG = 6400, C_XQ = 7424, C_XG = 8448, C_MG = 9472, C_LR = 25856;
constexpr float LN_EPS = 1e-5f;
constexpr float DN_ALPHA = 1.41421356237309515f;

constexpr size_t MiB = 1u << 20;
constexpr size_t WS_CTL = 0, CTL_ZERO_BYTES = 1 * MiB;
constexpr size_t WS_ROPE = 1 * MiB;
constexpr size_t WS_WPOOLT = 2 * MiB;
constexpr size_t WS_MEMB = 4 * MiB;
constexpr size_t WS_MK = 8 * MiB;
constexpr size_t WS_MVT = 10 * MiB;
constexpr size_t WS_DEC = 12 * MiB;
constexpr size_t WS_WMKVT = 16 * MiB;
constexpr size_t WS_WBRT = 48 * MiB;
constexpr size_t WS_WOUTT = 112 * MiB;
constexpr size_t WS_XB = 176 * MiB;
constexpr size_t WS_OB = 240 * MiB;
constexpr size_t WS_YB = 304 * MiB;
constexpr size_t WS_GU = 368 * MiB;
constexpr size_t WS_GS = 432 * MiB;
constexpr size_t WS_GB = 464 * MiB;
constexpr size_t WS_WINT = 512 * MiB;
constexpr size_t WS_H = 928 * MiB;
constexpr size_t WS_Z = 1336 * MiB;
constexpr size_t WS_X8 = 1464 * MiB;
constexpr size_t WS_W8 = 1496 * MiB;
constexpr size_t WS_END = 1660 * MiB;
constexpr int C_F8 = C_SQ, N_F8 = C_LR - C_F8;
#ifndef STAGE_LATE
#define STAGE_LATE 0
#endif
#ifndef PRO_NFAST
#define PRO_NFAST 1
#endif
#ifndef BLK_GATE
#define BLK_GATE 1
#endif
#ifndef BLK_OUT
#define BLK_OUT 1
#endif
#ifndef F6_FIRST
#define F6_FIRST 1
#endif
#ifndef F8_ROT
#define F8_ROT 64
#endif
#ifndef F6
#define F6 1
#endif
constexpr size_t W8_LAYER = F6 ? (size_t)(N_F8 / 128) * 32 * 12288 : (size_t)N_F8 * 4096;
constexpr float X8_SCALE = F6 ? 2.0f : 16.0f, W8_SCALE = F6 ? 128.0f : 2048.0f, MG_DESCALE = 1.0f / (X8_SCALE * W8_SCALE);
constexpr int CW_BAR = 4096;

constexpr int RING_BYTES = 131072;
constexpr int THIN_BYTES = 141312;
constexpr int LDSCTL_OFF = THIN_BYTES, MISC_OFF = LDSCTL_OFF + 320;
constexpr int LDS_BYTES = 147456;
constexpr int NWAVES = 8, NTHR = 512;

DI float bf2f(unsigned v) { return __builtin_bit_cast(float, v << 16); }
DI unsigned f2bf(float f) { unsigned u = __builtin_bit_cast(unsigned, f); return (u + 0x7fffu + ((u >> 16) & 1u)) >> 16; }
typedef float f32x2_t __attribute__((ext_vector_type(2))); typedef __bf16 bf16x2_t __attribute__((ext_vector_type(2)));
DI unsigned cvt_pk_bf16(float lo, float hi) { const f32x2_t v = {lo, hi}; const bf16x2_t b = __builtin_convertvector(v, bf16x2_t); return __builtin_bit_cast(unsigned, b); }
DI unsigned pk2(float lo, float hi) { return cvt_pk_bf16(lo, hi); }
DI float fast_sigmoid(float v) { return __builtin_amdgcn_rcpf(1.0f + __builtin_amdgcn_exp2f(-1.44269504089f * v)); }
DI void unpack8(const u32x4 w, float (&f)[8]) {
    f[0] = bf2f(w.x & 0xffffu); f[1] = bf2f(w.x >> 16); f[2] = bf2f(w.y & 0xffffu); f[3] = bf2f(w.y >> 16);
    f[4] = bf2f(w.z & 0xffffu); f[5] = bf2f(w.z >> 16); f[6] = bf2f(w.w & 0xffffu); f[7] = bf2f(w.w >> 16);
}
DI u32x4 pack8(const float (&f)[8]) { u32x4 w; w.x = pk2(f[0], f[1]); w.y = pk2(f[2], f[3]); w.z = pk2(f[4], f[5]); w.w = pk2(f[6], f[7]); return w; }
DI float clamp448(float v) { return fminf(fmaxf(v, -448.0f), 448.0f); }
DI unsigned pk4_fp8(float a, float b, float c, float d) {
    int w = 0; w = __builtin_amdgcn_cvt_pk_fp8_f32(clamp448(a), clamp448(b), w, false); w = __builtin_amdgcn_cvt_pk_fp8_f32(clamp448(c), clamp448(d), w, true); return (unsigned)w; }
typedef int v8i32 __attribute__((ext_vector_type(8)));
typedef int v6i32 __attribute__((ext_vector_type(6)));
typedef int v4i32 __attribute__((ext_vector_type(4)));
typedef unsigned u32x6 __attribute__((ext_vector_type(6)));
typedef float f32x16 __attribute__((ext_vector_type(16)));
DI void pk32_fp6(const float (&f)[32], u32x4& lo, u32x4& hi) {
    f32x16 a, b;
#pragma unroll
    for (int i = 0; i < 16; ++i) { a[i] = f[i]; b[i] = f[16 + i]; }
    const u32x6 r = __builtin_amdgcn_cvt_scalef32_2xpk16_fp6_f32(a, b, 1.0f);
    lo.x = r[0]; lo.y = r[1]; lo.z = r[2]; lo.w = r[3]; hi.x = r[4]; hi.y = r[5]; hi.z = 0u; hi.w = 0u;
}
DI f32x4 mma16(bf16x8 a, bf16x8 b, f32x4 c) { return __builtin_amdgcn_mfma_f32_16x16x32_bf16(a, b, c, 0, 0, 0); }
DI bf16x8 frag_lds(const LAS bf16* img, int ld, int idx0, int k0, int lane) { return *(const LAS bf16x8*)(img + (idx0 + (lane & 15)) * ld + k0 + 8 * (lane >> 4)); }
DI bf16x8 frag_glb(const bf16* img, size_t ld, int idx0, int k0, int lane) { return *(const bf16x8*)(img + (size_t)(idx0 + (lane & 15)) * ld + k0 + 8 * (lane >> 4)); }
DI s16x4 tr4(const LAS bf16* p) { return __builtin_bit_cast(s16x4, __builtin_amdgcn_ds_read_tr16_b64_v4i16((LAS v4i16_t*)p)); }
DI bf16x8 frag_tr(const LAS bf16* img, int ld, int k0, int idx0, int lane) {
    const int g = lane >> 4, q = (lane >> 2) & 3, p = lane & 3;
    const LAS bf16* a0 = img + (k0 + 8 * g + q) * ld + idx0 + 4 * p;
    const s16x4 lo = tr4(a0), hi = tr4(a0 + 4 * ld);
    return __builtin_shufflevector(lo, hi, 0, 1, 2, 3, 4, 5, 6, 7);
}
DI float wave_sum(float v) {
#pragma unroll
    for (int o = 1; o < 64; o <<= 1) v += __shfl_xor(v, o);
    return v;
}
#define LDS_WAIT() asm volatile("s_waitcnt lgkmcnt(0)" ::: "memory")
#define VM_WAIT() asm volatile("s_waitcnt vmcnt(0)" ::: "memory")

namespace pg8 {
constexpr int BM = 256, BK = 64, HALF = 128, HTB = HALF * BK * 2, STAGE_BYTES = 8 * HTB, NXCD = 8, WGM = 8;
__host__ __device__ __forceinline__ int lds_byte(int r, int c) { const int st = (r >> 4) * 2 + (c >> 5), rr = r & 15, cc = c & 31, ob = rr * 64 + cc * 2; return st * 1024 + (ob ^ (((ob >> 9) & 1) << 5)); }
__host__ __device__ __forceinline__ void stage_rc(int b, int& R, int& C) { const int st = b / 1024, sb = b % 1024, swz = sb ^ (((sb >> 9) & 1) << 5); R = (st >> 1) * 16 + swz / 64; C = (st & 1) * 32 + (swz % 64) / 2; }
__host__ __device__ __forceinline__ int perm32(int rho) { const int n = rho >> 4, i = rho & 15; return 8 * (i >> 2) + 4 * n + (i & 3); }
__host__ __device__ __forceinline__ int invperm32(int v) { return 16 * ((v >> 2) & 1) + 4 * (v >> 3) + (v & 3); }
template <bool PERM> __host__ __device__ __forceinline__ size_t blk_off(int row, int k, int NT) {
    const int r = PERM ? ((row & ~31) + invperm32(row & 31)) : row;
    return ((size_t)(r >> 7) * NT + (k >> 6)) * 16384 + lds_byte(r & 127, k & 63);
}
__host__ __device__ __forceinline__ void f6_off(int row, int step, int q, size_t& lo, size_t& hi) {
    const int ht = row >> 7, rb = (row >> 4) & 7, rr = row & 15;
    const size_t base = ((size_t)ht * 32 + step) * 12288;
    lo = base + rb * 1024 + lds_byte(rr, q * 8);
    hi = base + 8192 + rb * 512 + q * 128 + rr * 8;
}

struct Unit { int pm, pn, gi; };

DI void static_tile(int L, int nM, int nN, int& pm, int& pn) {
    const int nwg = nM * nN; int wgid = L;
    { const int q = nwg / NXCD, r = nwg % NXCD, xcd = wgid % NXCD, off = wgid / NXCD; wgid = (xcd < r ? xcd * (q + 1) : r * (q + 1) + (xcd - r) * q) + off; }
    const int nig = WGM * nN, gid = wgid / nig, fm = gid * WGM, gsz = (nM - fm) < WGM ? (nM - fm) : WGM;
    pm = fm + ((wgid % nig) % gsz); pn = (wgid % nig) / gsz;
}
struct SchedStatic {
    static constexpr bool BLK = false;
    int nM, nN, G, c; const char* A; const char* B; size_t astep, bstep;
    DI bool next(int i, Unit& u) const { const long L = (long)i * G + c; if (L >= (long)nM * nN) return false; static_tile((int)L, nM, nN, u.pm, u.pn); u.gi = 0; return true; }
    DI const char* abase(const Unit& u) const { return A + (size_t)u.pm * astep; }
    DI const char* bbase(const Unit& u) const { return B + (size_t)u.pn * bstep; }
};
struct SchedStaticBlk : SchedStatic { static constexpr bool BLK = true; };

template <class Epi, class Sched, int NB, bool ALIGN_EPI, bool F8 = false>
DI void gemm_phase(LAS unsigned char* lds, const int K, const Sched& S, const Epi& E) {
    const int tid = threadIdx.x, wid = __builtin_amdgcn_readfirstlane(tid >> 6), lane = tid & 63, wr = wid >> 2, wc = wid & 3, fr = lane & 15, fq = lane >> 4;
    const int nt = K / BK;
    constexpr bool FP6 = F8 && (F6 != 0);
    unsigned voffA[2], voffB[2];
#pragma unroll
    for (int i = 0; i < 2; ++i) { int R, C; stage_rc(tid * 16 + i * 8192, R, C); const int Rb = Epi::PERM ? ((R & ~31) + perm32(R & 31)) : R;
        voffA[i] = (unsigned)(R * K + C) * 2u; voffB[i] = (unsigned)(Rb * K + C) * 2u;
        if constexpr (FP6) { voffA[i] = (unsigned)(((wid & 3) + 4 * i) * 1024 + lane * 16); voffB[i] = voffA[i]; }
        if constexpr (Sched::BLK) { voffA[i] = (unsigned)((wid + 8 * i) * 1024 + lane * 16); voffB[i] = voffA[i]; } }
    const unsigned voffS = (unsigned)((8 + (wid & 3)) * 1024 + lane * 16);
    const size_t kstep = FP6 ? (size_t)12288 : (Sched::BLK ? (size_t)16384 : (size_t)(BK * 2));
    const size_t hstep = FP6 ? (size_t)nt * 12288 : (Sched::BLK ? (size_t)nt * 16384 : (size_t)HALF * K * 2);
    const unsigned ldsw = (unsigned)wid * 1024u;
    const int swz6 = lds_byte(fr, fq * 8), hof6 = fq * 128 + fr * 8;
    const int aoff6 = wr * 4096 + swz6, ahi6 = 8192 + wr * 2048 + hof6, boff6 = wc * 2048 + swz6, bhi6 = 8192 + wc * 1024 + hof6;
    const int aoff = lds_byte(wr * 64 + fr, fq * 8), boff = lds_byte(wc * 32 + fr, fq * 8);
    constexpr int KOFF = 1024;
    const unsigned one_scale = 0x7f7f7f7fu;
#define PG8_SA(b, h) (((b) * 2 + (h)) * HTB)
#define PG8_SB(b, h) ((4 + (b) * 2 + (h)) * HTB)
#define PG8_STAGE(bufoff, gbase, voff) do { if constexpr (FP6) { \
        if ((wid >> 2) != (((bufoff) / HTB) & 1)) { _Pragma("unroll") for (int _i = 0; _i < 2; ++_i) \
            __builtin_amdgcn_global_load_lds((const unsigned*)((const char*)(gbase) + voffA[_i]), (LAS unsigned*)(lds + (bufoff) + (wid & 3) * 1024 + _i * 4096), 16, 0, 0); } \
        else __builtin_amdgcn_global_load_lds((const unsigned*)((const char*)(gbase) + voffS), (LAS unsigned*)(lds + (bufoff) + 8192 + (wid & 3) * 1024), 16, 0, 0); \
    } else { _Pragma("unroll") for (int _i = 0; _i < 2; ++_i) \
        __builtin_amdgcn_global_load_lds((const unsigned*)((const char*)(gbase) + (voff)[_i]), (LAS unsigned*)(lds + (bufoff) + ldsw + _i * 8192), 16, 0, 0); } } while (0)
#define PG8_W64(p) ({ const s16x4 _v = *(const volatile LAS s16x4*)(p); __builtin_shufflevector(_v, _v, 0, 1, 2, 3, -1, -1, -1, -1); })
#define PG8_LDA(dst, b, h) do { if constexpr (FP6) { _Pragma("unroll") for (int m = 0; m < 4; ++m) { dst[m][0] = *(const LAS bf16x8*)(lds + PG8_SA(b, h) + aoff6 + m * 1024); dst[m][1] = PG8_W64(lds + PG8_SA(b, h) + ahi6 + m * 512); } } \
    else { _Pragma("unroll") for (int m = 0; m < 4; ++m) _Pragma("unroll") for (int k = 0; k < 2; ++k) dst[m][k] = *(const LAS bf16x8*)(lds + PG8_SA(b, h) + aoff + m * 2048 + k * KOFF); } } while (0)
#define PG8_LDB(dst, b, h) do { if constexpr (FP6) { _Pragma("unroll") for (int n = 0; n < 2; ++n) { dst[n][0] = *(const LAS bf16x8*)(lds + PG8_SB(b, h) + boff6 + n * 1024); dst[n][1] = PG8_W64(lds + PG8_SB(b, h) + bhi6 + n * 512); } } \
    else { _Pragma("unroll") for (int n = 0; n < 2; ++n) _Pragma("unroll") for (int k = 0; k < 2; ++k) dst[n][k] = *(const LAS bf16x8*)(lds + PG8_SB(b, h) + boff + n * 2048 + k * KOFF); } } while (0)
#define PG8_CAT6(x) __builtin_shufflevector(__builtin_bit_cast(v4i32, (x)[0]), __builtin_bit_cast(v4i32, (x)[1]), 0, 1, 2, 3, 4, 5)
#define PG8_CAT(x) __builtin_bit_cast(v8i32, __builtin_shufflevector((x)[0], (x)[1], 0, 1, 2, 3, 4, 5, 6, 7, 8, 9, 10, 11, 12, 13, 14, 15))
#define PG8_MMA(ai, bj, At, Bt) do { __builtin_amdgcn_s_setprio(1); _Pragma("unroll") for (int m = 0; m < 4; ++m) _Pragma("unroll") for (int n = 0; n < 2; ++n) { \
        if constexpr (F8 && NB == 1 && !F8ASM1) acc[ai][bj][m][n] = __builtin_amdgcn_mfma_scale_f32_16x16x128_f8f6f4(PG8_CAT(Bt[n]), PG8_CAT(At[m]), acc[ai][bj][m][n], 0, 0, 0, 0x7f7f7f7f, 0, 0x7f7f7f7f); \
        else if constexpr (F8 && F6 != 0) { asm volatile("s_nop 1\n\tv_mfma_scale_f32_16x16x128_f8f6f4 %0, %1, %2, %0, %3, %3 op_sel_hi:[0,0,0] cbsz:2 blgp:2" : "+v"(acc[ai][bj][m][n]) : "v"(PG8_CAT6(Bt[n])), "v"(PG8_CAT6(At[m])), "v"(one_scale)); } \
        else if constexpr (F8) { asm volatile("s_nop 1\n\tv_mfma_scale_f32_16x16x128_f8f6f4 %0, %1, %2, %0, %3, %3 op_sel_hi:[0,0,0]" : "+v"(acc[ai][bj][m][n]) : "v"(PG8_CAT(Bt[n])), "v"(PG8_CAT(At[m])), "v"(one_scale)); } \
        else { _Pragma("unroll") for (int k = 0; k < 2; ++k) acc[ai][bj][m][n] = __builtin_amdgcn_mfma_f32_16x16x32_bf16(Bt[n][k], At[m][k], acc[ai][bj][m][n], 0, 0, 0); } } \
        __builtin_amdgcn_s_setprio(0); } while (0)
#define PG8_WAIT_V(n) asm volatile("s_waitcnt vmcnt(" #n ")" ::: "memory")
#define PG8_WAIT_L(n) asm volatile("s_waitcnt lgkmcnt(" #n ")" ::: "memory")
#define PG8_BAR __builtin_amdgcn_s_barrier()
#define PG8_SCHED __builtin_amdgcn_sched_barrier(0)
#define PG8_WAIT_LA() do { if constexpr (FP6) PG8_WAIT_V(4); else PG8_WAIT_V(6); } while (0)
#define PG8_WAIT_LB() do { if constexpr (FP6) PG8_WAIT_V(1); else PG8_WAIT_V(2); } while (0)
#define PG8_WAIT_MAIN() do { if constexpr (FP6) PG8_WAIT_V(6); else PG8_WAIT_V(8); } while (0)
    Unit cur, nxt; int ui = 0;
    if (!S.next(0, cur)) return;
    f32x4 acc[2][NB][4][2];
    f32x4 yac[2][4][2];
    u32x4 gpre[2][4];
#pragma unroll
    for (int a = 0; a < 2; ++a)
#pragma unroll
        for (int m = 0; m < 4; ++m)
#pragma unroll
            for (int n = 0; n < 2; ++n) { yac[a][m][n] = (f32x4){0.f, 0.f, 0.f, 0.f};
#pragma unroll
                for (int b = 0; b < NB; ++b) acc[a][b][m][n] = (f32x4){0.f, 0.f, 0.f, 0.f}; }
    bf16x8 At[4][2], B0[2][2], B1[2][2];
    const char* cA = S.abase(cur); const char* cB = S.bbase(cur);
    if constexpr (NB == 2) {
        PG8_STAGE(PG8_SB(0, 0), cB, voffB); PG8_STAGE(PG8_SB(0, 1), cB + hstep, voffB); PG8_STAGE(PG8_SA(0, 0), cA, voffA); PG8_STAGE(PG8_SA(0, 1), cA + hstep, voffA);
        if (wr == 1) PG8_BAR;
        if constexpr (FP6) PG8_WAIT_V(1); else PG8_WAIT_V(2);
        PG8_BAR;
        PG8_STAGE(PG8_SB(1, 0), cB + kstep, voffB); PG8_STAGE(PG8_SA(1, 0), cA + kstep, voffA); PG8_STAGE(PG8_SB(1, 1), cB + hstep + kstep, voffB);
        if constexpr (FP6) PG8_WAIT_V(4); else PG8_WAIT_V(6);
        PG8_BAR;
    } else {
        PG8_STAGE(PG8_SB(0, 0), cB, voffB); PG8_STAGE(PG8_SA(0, 0), cA, voffA); PG8_STAGE(PG8_SA(0, 1), cA + hstep, voffA);
        if (wr == 1) PG8_BAR;
        PG8_WAIT_V(2); PG8_BAR;
        PG8_STAGE(PG8_SB(1, 0), cB + kstep, voffB); PG8_STAGE(PG8_SA(1, 0), cA + kstep, voffA);
        PG8_WAIT_V(4); PG8_BAR;
    }
    for (;;) {
        const bool has_next = S.next(ui + 1, nxt);
        const char* nA = has_next ? S.abase(nxt) : cA; const char* nB = has_next ? S.bbase(nxt) : cB;
        for (int t = 0; t < nt; t += 2) {
            if constexpr (Epi::GATED) { if ((t & 15) == 14) E.prefetch(gpre, cur, t >> 4, wr, wc, fr, fq); }
            if constexpr (Epi::GATED) { if (t != 0 && (t & 15) == 0) { E.flush(acc, yac, gpre);
#pragma unroll
                for (int a = 0; a < 2; ++a)
#pragma unroll
                    for (int m = 0; m < 4; ++m)
#pragma unroll
                        for (int n = 0; n < 2; ++n) acc[a][0][m][n] = (f32x4){0.f, 0.f, 0.f, 0.f}; } }
            const bool last = (t == nt - 2);
            const char* a1 = cA + (size_t)(t + 1) * kstep;
            const char* a2 = last ? nA : cA + (size_t)(t + 2) * kstep; const char* b2 = last ? nB : cB + (size_t)(t + 2) * kstep;
            const char* a3 = a2 + kstep; const char* b3 = b2 + kstep;
            if constexpr (NB == 2 && STAGE_LATE != 0) {
            PG8_LDB(B0, 0, 0); PG8_LDB(B1, 0, 1); PG8_SCHED; PG8_LDA(At, 0, 0);
            PG8_WAIT_LA(); PG8_WAIT_L(0); PG8_BAR; PG8_MMA(0, 0, At, B0); PG8_MMA(0, 1, At, B1); PG8_STAGE(PG8_SA(1, 1), a1 + hstep, voffA); PG8_BAR; PG8_SCHED;
            PG8_LDA(At, 0, 1);
            PG8_WAIT_LB(); PG8_WAIT_L(0); PG8_BAR; PG8_MMA(1, 0, At, B0); PG8_MMA(1, 1, At, B1); PG8_STAGE(PG8_SB(0, 0), b2, voffB); PG8_STAGE(PG8_SB(0, 1), b2 + hstep, voffB); PG8_STAGE(PG8_SA(0, 0), a2, voffA); PG8_BAR; PG8_SCHED;
            PG8_LDB(B0, 1, 0); PG8_LDB(B1, 1, 1); PG8_SCHED; PG8_LDA(At, 1, 0);
            PG8_WAIT_LA(); PG8_WAIT_L(0); PG8_BAR; PG8_MMA(0, 0, At, B0); PG8_MMA(0, 1, At, B1); PG8_STAGE(PG8_SA(0, 1), a2 + hstep, voffA); PG8_BAR; PG8_SCHED;
            PG8_LDA(At, 1, 1);
            PG8_WAIT_LB(); PG8_WAIT_L(0); PG8_BAR; PG8_MMA(1, 0, At, B0); PG8_MMA(1, 1, At, B1); PG8_STAGE(PG8_SB(1, 0), b3, voffB); PG8_STAGE(PG8_SB(1, 1), b3 + hstep, voffB); PG8_STAGE(PG8_SA(1, 0), a3, voffA); PG8_BAR; PG8_SCHED;
            } else if constexpr (NB == 2) {
            PG8_LDB(B0, 0, 0); PG8_LDB(B1, 0, 1); PG8_SCHED; PG8_LDA(At, 0, 0); PG8_STAGE(PG8_SA(1, 1), a1 + hstep, voffA);
            PG8_WAIT_MAIN(); PG8_WAIT_L(0); PG8_BAR; PG8_MMA(0, 0, At, B0); PG8_MMA(0, 1, At, B1); PG8_BAR; PG8_SCHED;
            PG8_LDA(At, 0, 1); PG8_STAGE(PG8_SB(0, 0), b2, voffB); PG8_STAGE(PG8_SB(0, 1), b2 + hstep, voffB); PG8_STAGE(PG8_SA(0, 0), a2, voffA);
            PG8_WAIT_MAIN(); PG8_WAIT_L(0); PG8_BAR; PG8_MMA(1, 0, At, B0); PG8_MMA(1, 1, At, B1); PG8_BAR; PG8_SCHED;
            PG8_LDB(B0, 1, 0); PG8_LDB(B1, 1, 1); PG8_SCHED; PG8_LDA(At, 1, 0); PG8_STAGE(PG8_SA(0, 1), a2 + hstep, voffA);
            PG8_WAIT_MAIN(); PG8_WAIT_L(0); PG8_BAR; PG8_MMA(0, 0, At, B0); PG8_MMA(0, 1, At, B1); PG8_BAR; PG8_SCHED;
            PG8_LDA(At, 1, 1); PG8_STAGE(PG8_SB(1, 0), b3, voffB); PG8_STAGE(PG8_SB(1, 1), b3 + hstep, voffB); PG8_STAGE(PG8_SA(1, 0), a3, voffA);
            PG8_WAIT_MAIN(); PG8_WAIT_L(0); PG8_BAR; PG8_MMA(1, 0, At, B0); PG8_MMA(1, 1, At, B1); PG8_BAR; PG8_SCHED;
            } else {
            PG8_LDB(B0, 0, 0); PG8_SCHED; PG8_LDA(At, 0, 0); PG8_STAGE(PG8_SA(1, 1), a1 + hstep, voffA);
            PG8_WAIT_V(6); PG8_WAIT_L(0); PG8_BAR; PG8_MMA(0, 0, At, B0); PG8_BAR; PG8_SCHED;
            PG8_LDA(At, 0, 1); PG8_STAGE(PG8_SB(0, 0), b2, voffB); PG8_STAGE(PG8_SA(0, 0), a2, voffA);
            PG8_WAIT_V(6); PG8_WAIT_L(0); PG8_BAR; PG8_MMA(1, 0, At, B0); PG8_BAR; PG8_SCHED;
            PG8_LDB(B0, 1, 0); PG8_SCHED; PG8_LDA(At, 1, 0); PG8_STAGE(PG8_SA(0, 1), a2 + hstep, voffA);
            PG8_WAIT_V(6); PG8_WAIT_L(0); PG8_BAR; PG8_MMA(0, 0, At, B0); PG8_BAR; PG8_SCHED;
            PG8_LDA(At, 1, 1); PG8_STAGE(PG8_SB(1, 0), b3, voffB); PG8_STAGE(PG8_SA(1, 0), a3, voffA);
            PG8_WAIT_V(6); PG8_WAIT_L(0); PG8_BAR; PG8_MMA(1, 0, At, B0); PG8_BAR; PG8_SCHED;
            }
        }
        if constexpr (F8) {
            asm volatile("s_nop 15\n\ts_nop 15" ::: "memory");
#pragma unroll
            for (int a = 0; a < 2; ++a)
#pragma unroll
                for (int b = 0; b < NB; ++b)
#pragma unroll
                    for (int m = 0; m < 4; ++m)
#pragma unroll
                        for (int n = 0; n < 2; ++n) asm volatile("" : "+v"(acc[a][b][m][n]));
        }
        if constexpr (ALIGN_EPI) { if (wr == 0) PG8_BAR; }
        if constexpr (Epi::GATED) { E.finish(acc, yac, gpre, cur, wr, wc, fr, fq);
#pragma unroll
            for (int a = 0; a < 2; ++a)
#pragma unroll
                for (int m = 0; m < 4; ++m)
#pragma unroll
                    for (int n = 0; n < 2; ++n) yac[a][m][n] = (f32x4){0.f, 0.f, 0.f, 0.f};
        } else { E(acc, cur, wr, wc, fr, fq); }
        if (!has_next) break;
#pragma unroll
        for (int a = 0; a < 2; ++a)
#pragma unroll
            for (int b = 0; b < NB; ++b)
#pragma unroll
                for (int m = 0; m < 4; ++m)
#pragma unroll
                    for (int n = 0; n < 2; ++n) acc[a][b][m][n] = (f32x4){0.f, 0.f, 0.f, 0.f};
        cur = nxt; cA = nA; cB = nB; ++ui;
        if constexpr (ALIGN_EPI) { if (wr == 1) PG8_BAR; }
    }
    PG8_WAIT_V(0);
    if constexpr (!ALIGN_EPI) { if (wr == 0) PG8_BAR; }
    PG8_BAR;
#undef PG8_SA
#undef PG8_SB
#undef PG8_STAGE
#undef PG8_LDA
#undef PG8_LDB
#undef PG8_MMA
#undef PG8_CAT
#undef PG8_WAIT_V
#undef PG8_WAIT_L
#undef PG8_BAR
#undef PG8_SCHED
#undef PG8_WAIT_MAIN
}
}

#define XB_TMO      128
#define XB_XCNT(j)  (256  + 64 * (j))
#define XB_XSUB(j)  (1280 + 64 * (j))
#define XB_XGEN(j)  (2304 + 64 * (j))
#define XB_TOP      3328
#define XB_TOPGEN   3392
#define XCD_BAR_WORDS 3456
#define XB_SPIN_CAP (1u << 18)
DI unsigned xb_ld(unsigned* p)              { return __hip_atomic_load(p, __ATOMIC_RELAXED, __HIP_MEMORY_SCOPE_AGENT); }
DI unsigned xb_add(unsigned* p, unsigned v) { return __hip_atomic_fetch_add(p, v, __ATOMIC_RELAXED, __HIP_MEMORY_SCOPE_AGENT); }
DI unsigned xb_xcc_id() { return (unsigned)__builtin_amdgcn_s_getreg((3 << 11) | 20) & 0xFu; }
#define XB_SPIN(cond, bar) do { unsigned _sp = 0; while (cond) { __builtin_amdgcn_s_sleep(1); \
    if ((++_sp & 255u) == 0u) { if (xb_ld(&(bar)[XB_TMO])) break; if (_sp > XB_SPIN_CAP) { atomicAdd(&(bar)[XB_TMO], 1u); break; } } } } while (0)
struct XcdBarrier { unsigned* bar; unsigned x; volatile LAS unsigned* st; };
DI XcdBarrier xcd_barrier_post(unsigned* bar, volatile LAS unsigned* st) {
    XcdBarrier b; b.bar = bar; b.x = xb_xcc_id(); b.st = st;
    if (threadIdx.x == 0) (void)xb_add(&bar[XB_XCNT(b.x)], 1u);
    return b;
}
DI void xcd_barrier_complete(unsigned* bar, unsigned x, unsigned& nloc, unsigned& nx) {
    const unsigned G = gridDim.x * gridDim.y * gridDim.z;
    unsigned sum, cnt, mine, sp = 0u;
    for (;;) {
        sum = 0u; cnt = 0u; mine = 0u;
#pragma unroll
        for (unsigned j = 0; j < 16; ++j) { const unsigned c = xb_ld(&bar[XB_XCNT(j)]); sum += c; cnt += (c > 0u) ? 1u : 0u; mine = (j == x) ? c : mine; }
        if (sum == G) break;
        __builtin_amdgcn_s_sleep(1);
        if ((++sp & 255u) == 0u) { if (xb_ld(&bar[XB_TMO])) break; if (sp > XB_SPIN_CAP) { atomicAdd(&bar[XB_TMO], 1u); break; } }
    }
    nloc = mine > 0u ? mine : 1u; nx = cnt > 0u ? cnt : 1u;
}
DI void xcd_barrier(const XcdBarrier& b) {
    asm volatile("s_waitcnt vmcnt(0)" ::: "memory");
    __syncthreads();
    if (threadIdx.x == 0) {
        unsigned* bar = b.bar;
        __builtin_amdgcn_s_waitcnt(0);
        unsigned nloc = b.st[0], nx = b.st[1];
        if (nloc == 0u) { xcd_barrier_complete(bar, b.x, nloc, nx); b.st[0] = nloc; b.st[1] = nx; }
        const unsigned old = xb_add(&bar[XB_XSUB(b.x)], 1u);
        const unsigned gen = old / nloc;
        if (old + 1u == (gen + 1u) * nloc) {
            __builtin_amdgcn_fence(__ATOMIC_RELEASE, "agent");
            asm volatile("s_waitcnt vmcnt(0)" ::: "memory");
            const unsigned og = xb_add(&bar[XB_TOP], 1u);
            const unsigned tg = og / nx;
            if (og + 1u == (tg + 1u) * nx) xb_add(&bar[XB_TOPGEN], 1u);
            else XB_SPIN(xb_ld(&bar[XB_TOPGEN]) == tg, bar);
            __builtin_amdgcn_fence(__ATOMIC_ACQUIRE, "agent");
            xb_add(&bar[XB_XGEN(b.x)], 1u);
            asm volatile("s_waitcnt vmcnt(0)" ::: "memory");
        } else {
            XB_SPIN(xb_ld(&bar[XB_XGEN(b.x)]) == gen, bar);
            __builtin_amdgcn_fence(__ATOMIC_ACQUIRE, "agent");
            asm volatile("s_waitcnt vmcnt(0)" ::: "memory");
        }
    }
    __syncthreads();
}

struct Frame {
    LAS unsigned char* lds;
    int tid, lane, wave, G, wg;
    float* out; unsigned char* ws;
};
template <class T> DI T* wsp(const Frame& F, size_t off) { return (T*)(F.ws + off); }

struct EpiH {
    static constexpr bool PERM = true, GATED = false;
    bf16* H; bf16* MK; bf16* MVT;
    DI void operator()(const f32x4 (&acc)[2][2][4][2], const pg8::Unit& u, int wr, int wc, int fr, int fq) const {
        bf16* base = H; size_t ldc = NH; int act = 0;
        if (u.gi == 0) { const int pn = u.pn; act = ((pn >= 4 && pn < 8) || (pn >= 16 && pn < 20)) ? 1 : 0; }
        else { const int lx = (u.gi - 1) >> 1, w = (u.gi - 1) & 1; if (w == 0) { base = MK + (size_t)lx * 512 * 1024; ldc = 1024; } else { base = MVT + (size_t)lx * 1024 * 512; ldc = 512; } }
        const int row0 = u.pm * 256 + wr * 64 + fr, col0 = u.pn * 256 + wc * 32 + 8 * fq;
#pragma unroll
        for (int ai = 0; ai < 2; ++ai)
#pragma unroll
            for (int m = 0; m < 4; ++m) { bf16* rowp = base + (size_t)(row0 + ai * 128 + m * 16) * ldc + col0;
#pragma unroll
                for (int bj = 0; bj < 2; ++bj) { f32x4 v0 = acc[ai][bj][m][0], v1 = acc[ai][bj][m][1];
                    if (act != 0) {
#pragma unroll
                        for (int j = 0; j < 4; ++j) { const float s0 = fast_sigmoid(v0[j]), s1 = fast_sigmoid(v1[j]); v0[j] = (act == 1) ? v0[j] * s0 : s0; v1[j] = (act == 1) ? v1[j] * s1 : s1; } }
                    u32x4 w; w.x = cvt_pk_bf16(v0[0], v0[1]); w.y = cvt_pk_bf16(v0[2], v0[3]); w.z = cvt_pk_bf16(v1[0], v1[1]); w.w = cvt_pk_bf16(v1[2], v1[3]);
                    *(u32x4*)(rowp + bj * 128) = w; } }
    }
};
template <int NB> struct EpiMG {
    static constexpr bool PERM = true, GATED = false;
    bf16* H;
    DI void operator()(const f32x4 (&acc)[2][NB][4][2], const pg8::Unit& u, int wr, int wc, int fr, int fq) const {
        const int colu = C_F8 + u.pn * (128 * NB);
        const int act = (colu >= C_MG) ? 2 : (((colu >= C_SG && colu < C_XQ) || colu >= C_XG) ? 1 : 0);
        const int row0 = u.pm * 256 + wr * 64 + fr, col0 = colu + wc * 32 + 8 * fq;
#pragma unroll
        for (int ai = 0; ai < 2; ++ai)
#pragma unroll
            for (int m = 0; m < 4; ++m) { bf16* rowp = H + (size_t)(row0 + ai * 128 + m * 16) * NH + col0;
#pragma unroll
                for (int bj = 0; bj < NB; ++bj) { f32x4 v0 = acc[ai][bj][m][0], v1 = acc[ai][bj][m][1];
                    if (act == 2) {
#pragma unroll
                        for (int j = 0; j < 4; ++j) { v0[j] = __builtin_amdgcn_rcpf(1.0f + __builtin_amdgcn_exp2f(v0[j] * (-1.44269504089f * MG_DESCALE)));
                            v1[j] = __builtin_amdgcn_rcpf(1.0f + __builtin_amdgcn_exp2f(v1[j] * (-1.44269504089f * MG_DESCALE))); }
                    } else if (act == 1) {
#pragma unroll
                        for (int j = 0; j < 4; ++j) { const float a0 = v0[j] * MG_DESCALE, a1 = v1[j] * MG_DESCALE; v0[j] = a0 * fast_sigmoid(a0); v1[j] = a1 * fast_sigmoid(a1); }
                    } else {
#pragma unroll
                        for (int j = 0; j < 4; ++j) { v0[j] *= MG_DESCALE; v1[j] *= MG_DESCALE; } }
                    u32x4 w; w.x = cvt_pk_bf16(v0[0], v0[1]); w.y = cvt_pk_bf16(v0[2], v0[3]); w.z = cvt_pk_bf16(v1[0], v1[1]); w.w = cvt_pk_bf16(v1[2], v1[3]);
                    *(u32x4*)(rowp + bj * 128) = w; } }
    }
};
struct EpiRes {
    static constexpr bool PERM = true, GATED = false;
    const float* __restrict__ res; float* __restrict__ out;
    DI void operator()(const f32x4 (&acc)[2][2][4][2], const pg8::Unit& u, int wr, int wc, int fr, int fq) const {
        const int row0 = u.pm * 256 + wr * 64 + fr, col0 = u.pn * 256 + wc * 32 + 8 * fq;
#pragma unroll
        for (int ai = 0; ai < 2; ++ai) { f32x4 r[4][2][2];
#pragma unroll
            for (int m = 0; m < 4; ++m)
#pragma unroll
                for (int bj = 0; bj < 2; ++bj)
#pragma unroll
                    for (int n = 0; n < 2; ++n) r[m][bj][n] = *(const f32x4*)(res + (size_t)(row0 + ai * 128 + m * 16) * DM + col0 + bj * 128 + n * 4);
#pragma unroll
            for (int m = 0; m < 4; ++m)
#pragma unroll
                for (int bj = 0; bj < 2; ++bj)
#pragma unroll
                    for (int n = 0; n < 2; ++n) asm volatile("" : "+v"(r[m][bj][n]));
#pragma unroll
            for (int m = 0; m < 4; ++m)
#pragma unroll
                for (int bj = 0; bj < 2; ++bj)
#pragma unroll
                    for (int n = 0; n < 2; ++n) *(f32x4*)(out + (size_t)(row0 + ai * 128 + m * 16) * DM + col0 + bj * 128 + n * 4) = r[m][bj][n] * DN_ALPHA + acc[ai][bj][m][n]; }
    }
};
struct EpiGate {
    static constexpr bool PERM = true, GATED = true;
    const bf16* H; bf16* Y;
    DI void prefetch(u32x4 (&gp)[2][4], const pg8::Unit& u, int bi, int wr, int wc, int fr, int fq) const {
        const char* ub = (const char*)(H + (size_t)(u.pm * 256 + wr * 64) * NH + C_MG + bi * DM + u.pn * 128 + wc * 32);
        const unsigned vo = (unsigned)(fr * NH + 8 * fq) * 2u;
#pragma unroll
        for (int ai = 0; ai < 2; ++ai)
#pragma unroll
            for (int m = 0; m < 4; ++m) { const char* sb = ub + (size_t)(ai * 128 + m * 16) * NH * 2;
                asm volatile("global_load_dwordx4 %0, %1, %2" : "=&v"(gp[ai][m]) : "v"(vo), "s"(sb) : "memory"); }
    }
    DI void flush(const f32x4 (&acc)[2][1][4][2], f32x4 (&y)[2][4][2], u32x4 (&gp)[2][4]) const {
#pragma unroll
        for (int ai = 0; ai < 2; ++ai)
#pragma unroll
            for (int m = 0; m < 4; ++m) { asm volatile("" : "+v"(gp[ai][m])); float g[8]; unpack8(gp[ai][m], g);
#pragma unroll
                for (int j = 0; j < 4; ++j) { y[ai][m][0][j] += g[j] * acc[ai][0][m][0][j]; y[ai][m][1][j] += g[4 + j] * acc[ai][0][m][1][j]; } }
    }
    DI void finish(const f32x4 (&acc)[2][1][4][2], f32x4 (&y)[2][4][2], u32x4 (&gp)[2][4], const pg8::Unit& u, int wr, int wc, int fr, int fq) const {
        flush(acc, y, gp);
        const int row0 = u.pm * 256 + wr * 64 + fr, col0 = u.pn * 128 + wc * 32 + 8 * fq;
#pragma unroll
        for (int ai = 0; ai < 2; ++ai)
#pragma unroll
            for (int m = 0; m < 4; ++m) { const f32x4 v0 = y[ai][m][0], v1 = y[ai][m][1];
                u32x4 w; w.x = cvt_pk_bf16(v0[0], v0[1]); w.y = cvt_pk_bf16(v0[2], v0[3]); w.z = cvt_pk_bf16(v1[0], v1[1]); w.w = cvt_pk_bf16(v1[2], v1[3]);
                if (BLK_OUT) *(u32x4*)((char*)Y + pg8::blk_off<false>(row0 + ai * 128 + m * 16, col0, DM / 64)) = w; else *(u32x4*)(Y + (size_t)(row0 + ai * 128 + m * 16) * DM + col0) = w; }
    }
};
struct SchedInProj {
    static constexpr bool BLK = false;
    int G, c, n_extra; const char *XB, *WT, *MEMB, *WKV;
    static constexpr int NM = 32, NN = 21, NU = NM * NN;
    static constexpr size_t TSTEP = (size_t)256 * 4096 * 2;
    DI bool next(int i, pg8::Unit& u) const {
        const long L = (long)i * G + c;
        if (L < NU) { pg8::static_tile((int)L, NM, NN, u.pm, u.pn); if (u.pn == 20) u.pn = 101; u.gi = 0; return true; }
        const int e = (int)(L - NU); if (e >= n_extra) return false;
        const int lx = e >> 4, r = e & 15;
        if (r < 8) { u.pm = r >> 2; u.pn = r & 3; u.gi = 1 + 2 * lx; } else { u.pm = (r - 8) >> 1; u.pn = (r - 8) & 1; u.gi = 2 + 2 * lx; }
        return true;
    }
    DI const char* abase(const pg8::Unit& u) const {
        if (u.gi == 0) return XB + (size_t)u.pm * TSTEP;
        const int lx = (u.gi - 1) >> 1, w = (u.gi - 1) & 1;
        return w == 0 ? MEMB + (size_t)u.pm * TSTEP : WKV + (size_t)lx * 2048 * 4096 * 2 + (size_t)(1024 + u.pm * 256) * 4096 * 2;
    }
    DI const char* bbase(const pg8::Unit& u) const {
        if (u.gi == 0) return WT + (size_t)u.pn * TSTEP;
        const int lx = (u.gi - 1) >> 1, w = (u.gi - 1) & 1;
        return w == 0 ? WKV + (size_t)lx * 2048 * 4096 * 2 + (size_t)u.pn * TSTEP : MEMB + (size_t)u.pn * TSTEP;
    }
};

DI int win_src_col(int n) { return n < 5120 ? n : (n < C_LR ? n + 16 : (n < C_LR + 16 ? n - C_LR + 5120 : -1)); }
template <bool WIN, int LAY = 0> DI void transpose_item(const float* W, size_t ldw, bf16* WT, size_t ldt, int k0, int n0, int kd0, LAS float* scr, int lane) {
    const int kr = lane >> 3, nc = lane & 7; int sc = n0 + 4 * nc; if (WIN) sc = win_src_col(sc);
    const float* src = W + (size_t)(k0 + kr) * ldw + (sc < 0 ? 0 : sc);
    f32x4 v[8];
#pragma unroll
    for (int i = 0; i < 8; ++i) v[i] = *(const f32x4*)(src + (size_t)(8 * i) * ldw);
#pragma unroll
    for (int i = 0; i < 8; ++i) { LAS float* d = scr + (8 * i + kr) * 33 + 4 * nc; const f32x4 x = (sc < 0) ? (f32x4){0.f, 0.f, 0.f, 0.f} : v[i]; d[0] = x.x; d[1] = x.y; d[2] = x.z; d[3] = x.w; }
    LDS_WAIT();
    const int c = lane & 7;
#pragma unroll
    for (int j = 0; j < 4; ++j) { const int n = (lane >> 3) + 8 * j; const LAS float* s = scr + (8 * c) * 33 + n;
        u32x4 o; o.x = pk2(s[0 * 33], s[1 * 33]); o.y = pk2(s[2 * 33], s[3 * 33]); o.z = pk2(s[4 * 33], s[5 * 33]); o.w = pk2(s[6 * 33], s[7 * 33]);
        if constexpr (LAY == 0) *(u32x4*)(WT + (size_t)(n0 + n) * ldt + kd0 + 8 * c) = o; else *(u32x4*)((char*)WT + pg8::blk_off<LAY == 2>(n0 + n, kd0 + 8 * c, (int)(ldt / 64))) = o; }
    LDS_WAIT();
}
DI void transpose_item_f8(const float* W, size_t ldw, unsigned char* WT, size_t ldt, int k0, int n0, LAS float* scr, int lane) {
    const int kr = lane >> 3, nc = lane & 7; const int sc = win_src_col(n0 + 4 * nc);
    const float* src = W + (size_t)(k0 + kr) * ldw + sc;
#pragma unroll
    for (int h = 0; h < 2; ++h) {
        f32x4 v[8];
#pragma unroll
        for (int i = 0; i < 8; ++i) v[i] = *(const f32x4*)(src + (size_t)(64 * h + 8 * i) * ldw);
#pragma unroll
        for (int i = 0; i < 8; ++i) { LAS float* d = scr + (64 * h + 8 * i + kr) * 33 + 4 * nc; d[0] = v[i].x * W8_SCALE; d[1] = v[i].y * W8_SCALE; d[2] = v[i].z * W8_SCALE; d[3] = v[i].w * W8_SCALE; }
    }
    LDS_WAIT();
#if F6
    { const int q = lane >> 4;
#pragma unroll
      for (int j = 0; j < 2; ++j) { const int n = (lane & 15) + 16 * j; const LAS float* sp = scr + (32 * q) * 33 + n; float f[32];
#pragma unroll
          for (int e = 0; e < 32; ++e) f[e] = sp[e * 33];
          u32x4 lo, hi; pk32_fp6(f, lo, hi); const int R = n0 - C_F8 + n; size_t ol, oh; pg8::f6_off((R & ~31) + pg8::invperm32(R & 31), k0 >> 7, q, ol, oh);
          *(u32x4*)(WT + ol) = lo; u32x2 h2; h2.x = hi.x; h2.y = hi.y; *(u32x2*)(WT + oh) = h2; } }
#else
    const int c = lane & 7;
#pragma unroll
    for (int j = 0; j < 4; ++j) { const int n = (lane >> 3) + 8 * j; const LAS float* s = scr + (16 * c) * 33 + n;
        u32x4 o; o.x = pk4_fp8(s[0 * 33], s[1 * 33], s[2 * 33], s[3 * 33]); o.y = pk4_fp8(s[4 * 33], s[5 * 33], s[6 * 33], s[7 * 33]);
        o.z = pk4_fp8(s[8 * 33], s[9 * 33], s[10 * 33], s[11 * 33]); o.w = pk4_fp8(s[12 * 33], s[13 * 33], s[14 * 33], s[15 * 33]);
        *(u32x4*)(WT + (size_t)(n0 - C_F8 + n) * ldt + k0 + 16 * c) = o; }
#endif
    LDS_WAIT();
}
DI void prologue(const Frame& F, const float* x, const float* mem, const int* pos, const float* w_in, const float* w_pool, const float* w_mem_kv, const float* w_branch, const float* w_out) {
    LAS float* scr = (LAS float*)(F.lds + F.wave * 17408);
    const int gw = F.wg * NWAVES + F.wave, NGW = F.G * NWAVES, lane = F.lane;
    constexpr int I_B16 = 64 * ((NH - N_F8) / 32), I_F8 = 32 * (N_F8 / 32), I_KV = 64 * 64, I_BR = 16 * 128, I_OUT = 64 * 128, I_PL = 4 * 8;
    constexpr int NITEMS = 2 * I_B16 + 2 * I_F8 + 2 * I_KV + 8 * I_BR + 2 * I_OUT + 8 * I_PL;
    LAS unsigned* qc = (LAS unsigned*)(F.lds + MISC_OFF) + 16;
    (void)gw;
    int q = 0; if (lane == 0) q = (int)__hip_atomic_fetch_add(qc, 1u, __ATOMIC_RELAXED, __HIP_MEMORY_SCOPE_WORKGROUP); q = __builtin_amdgcn_readfirstlane(q);
    for (;;) {
        const int it = (q >> 3) * NGW + F.wg * NWAVES + (q & 7); if (it >= NITEMS) break;
        if (lane == 0) q = (int)__hip_atomic_fetch_add(qc, 1u, __ATOMIC_RELAXED, __HIP_MEMORY_SCOPE_WORKGROUP);
        q = __builtin_amdgcn_readfirstlane(q);
        int r = it;
        if (r < 2 * I_F8) { const int l = r / I_F8; r -= l * I_F8; const int nb = C_F8 / 32 + (PRO_NFAST ? r % (N_F8 / 32) : (r >> 5)), kb = PRO_NFAST ? r / (N_F8 / 32) : (r & 31);
            transpose_item_f8(w_in + (size_t)l * 4096 * D_IN, D_IN, wsp<unsigned char>(F, WS_W8) + (size_t)l * W8_LAYER, 4096, kb * 128, nb * 32, scr, lane); continue; }
        r -= 2 * I_F8;
        if (r < 2 * I_B16) { const int l = r / I_B16; r -= l * I_B16; int nb = r >> 6; const int kb = r & 63; if (nb >= C_F8 / 32) nb += N_F8 / 32;
            transpose_item<true>(w_in + (size_t)l * 4096 * D_IN, D_IN, wsp<bf16>(F, WS_WINT) + (size_t)l * NH * 4096, 4096, kb * 64, nb * 32, kb * 64, scr, lane); continue; }
        r -= 2 * I_B16;
        if (r < 2 * I_KV) { const int l = r / I_KV; r -= l * I_KV; const int nb = r >> 6, kb = r & 63;
            transpose_item<false>(w_mem_kv + (size_t)l * 4096 * 2048, 2048, wsp<bf16>(F, WS_WMKVT) + (size_t)l * 2048 * 4096, 4096, kb * 64, nb * 32, kb * 64, scr, lane); continue; }
        r -= 2 * I_KV;
        if (r < 8 * I_BR) { const int lb = r / I_BR; r -= lb * I_BR; const int l = lb >> 2, bi = lb & 3; const int nb = PRO_NFAST ? (r & 127) : (r >> 4), kb = PRO_NFAST ? (r >> 7) : (r & 15);
            transpose_item<false, BLK_GATE ? 2 : 0>(w_branch + (size_t)lb * 1024 * 4096, 4096, wsp<bf16>(F, WS_WBRT) + (size_t)l * 4096 * 4096, 4096, kb * 64, nb * 32, bi * 1024 + kb * 64, scr, lane); continue; }
        r -= 8 * I_BR;
        if (r < 2 * I_OUT) { const int l = r / I_OUT; r -= l * I_OUT; const int nb = PRO_NFAST ? (r & 127) : (r >> 6), kb = PRO_NFAST ? (r >> 7) : (r & 63);
            transpose_item<false, BLK_OUT ? 2 : 0>(w_out + (size_t)l * 4096 * 4096, 4096, wsp<bf16>(F, WS_WOUTT) + (size_t)l * 4096 * 4096, 4096, kb * 64, nb * 32, kb * 64, scr, lane); continue; }
        r -= 2 * I_OUT;
        { const int lg = r / I_PL; r -= lg * I_PL; const int nb = r >> 2, kb = r & 3;
            transpose_item<false>(w_pool + (size_t)lg * 256 * 256, 256, wsp<bf16>(F, WS_WPOOLT) + (size_t)lg * 256 * 256, 256, kb * 64, nb * 32, kb * 64, scr, lane); }
    }
    const size_t gt = (size_t)F.wg * NTHR + F.tid, GT = (size_t)F.G * NTHR;
    { const f32x4* xs = (const f32x4*)x; u32x4* xd = wsp<u32x4>(F, WS_XB);
      u32x2* x8 = wsp<u32x2>(F, WS_X8);
#if F6
      (void)x8; (void)xd;
      { LAS unsigned char* lw = (LAS unsigned char*)scr; u32x2* xb2 = wsp<u32x2>(F, WS_XB);
        for (size_t g0 = (size_t)gw * 64; g0 < (size_t)MTOK * DM / 32; g0 += (size_t)NGW * 64) {
            const f32x4* src = xs + g0 * 8;
            f32x4 v[8];
#pragma unroll
            for (int t = 0; t < 8; ++t) v[t] = src[64 * t + lane];
#pragma unroll
            for (int t = 0; t < 8; ++t) { u32x2 w; w.x = pk2(v[t].x, v[t].y); w.y = pk2(v[t].z, v[t].w); xb2[g0 * 8 + 64 * t + lane] = w;
                *(LAS f32x4*)(lw + ((lane >> 3) + 8 * t) * 144 + (lane & 7) * 16) = v[t] * X8_SCALE; }
            LDS_WAIT();
            float f[32];
#pragma unroll
            for (int t = 0; t < 8; ++t) { const f32x4 qv = *(const LAS f32x4*)(lw + lane * 144 + 16 * t); f[4 * t] = qv.x; f[4 * t + 1] = qv.y; f[4 * t + 2] = qv.z; f[4 * t + 3] = qv.w; }
            const size_t gi = g0 + lane; u32x4 lo, hi; pk32_fp6(f, lo, hi); size_t ol, oh; pg8::f6_off((int)(gi >> 7), (int)((gi >> 2) & 31), (int)(gi & 3), ol, oh);
            *(u32x4*)(wsp<unsigned char>(F, WS_X8) + ol) = lo; u32x2 h2; h2.x = hi.x; h2.y = hi.y; *(u32x2*)(wsp<unsigned char>(F, WS_X8) + oh) = h2;
            LDS_WAIT();
        } }
#else
      for (size_t i = gt; i < (size_t)MTOK * DM / 8; i += GT) { const f32x4 a = xs[2 * i], b = xs[2 * i + 1]; u32x4 o; o.x = pk2(a.x, a.y); o.y = pk2(a.z, a.w); o.z = pk2(b.x, b.y); o.w = pk2(b.z, b.w); xd[i] = o;
          u32x2 q; q.x = pk4_fp8(a.x * X8_SCALE, a.y * X8_SCALE, a.z * X8_SCALE, a.w * X8_SCALE); q.y = pk4_fp8(b.x * X8_SCALE, b.y * X8_SCALE, b.z * X8_SCALE, b.w * X8_SCALE); x8[i] = q; }
#endif
      const f32x4* ms = (const f32x4*)mem; u32x4* md = wsp<u32x4>(F, WS_MEMB);
      for (size_t i = gt; i < (size_t)BATCH * MEMLEN * DM / 8; i += GT) { const f32x4 a = ms[2 * i], b = ms[2 * i + 1]; u32x4 o; o.x = pk2(a.x, a.y); o.y = pk2(a.z, a.w); o.z = pk2(b.x, b.y); o.w = pk2(b.z, b.w); md[i] = o; } }
    { f32x2* rt = wsp<f32x2>(F, WS_ROPE);
      for (size_t i = gt; i < (size_t)MTOK * 8; i += GT) { const int t = (int)(i >> 3), fi = (int)(i & 7);
          const double invd = fi == 0 ? 1 : fi == 1 ? 0.19392274474868576 : fi == 2 ? 0.037606030930863933 : fi == 3 ? 0.0072926647372171093 : fi == 4 ? 0.001414213562373095 : fi == 5 ? 0.0002742481756762073 : fi == 6 ? 5.3182958969449883e-05 : 1.031338537721246e-05;
          const float inv = (float)invd; const float ang = (float)pos[t] * inv;
          rt[i] = (f32x2){cosf(ang), sinf(ang)}; } }
}

DI bf16* ob_at(bf16* OB, int t, int col) { return BLK_GATE ? (bf16*)((char*)OB + pg8::blk_off<false>(t, col, DM / 64)) : OB + (size_t)t * DM + col; }
DI float fexp(float x) { return __builtin_amdgcn_exp2f(x * 1.44269504089f); }
DI float logsigmoid_f(float z) { return fminf(z, 0.f) - 0.69314718056f * __builtin_amdgcn_logf(1.0f + fexp(-fabsf(z))); }

DI void gla_a_unit(const Frame& F, int l, int unit, const float* w_gla_up, const float* b_gla) {
    const int bh = unit >> 6, c = unit & 63, b = bh >> 2, h = bh & 3, t0 = b * SEQ + c * 64, tid = F.tid, lane = F.lane, wave = F.wave;
    const bf16* H = wsp<bf16>(F, WS_H);
    LAS float* lrs = (LAS float*)(F.lds);
    LAS float* bcs = (LAS float*)(F.lds + 4096);
    LAS float* seg = (LAS float*)(F.lds + 36864);
    LAS bf16* kds = (LAS bf16*)(F.lds + 40960);
    LAS bf16* vs = (LAS bf16*)(F.lds + 59392);
    constexpr int LDK = 136, LDV = 264;
    __syncthreads();
    if (tid < 128) { const int j = tid >> 1, hf = tid & 1; const u32x4 w = *(const u32x4*)(H + (size_t)(t0 + j) * NH + C_LR + 8 * hf); float f[8]; unpack8(w, f);
#pragma unroll
        for (int i = 0; i < 8; ++i) lrs[j * 16 + 8 * hf + i] = f[i]; }
    u32x4 kw[2];
#pragma unroll
    for (int it = 0; it < 2; ++it) { const int p = tid + it * NTHR, j = p >> 4, ch = p & 15; kw[it] = *(const u32x4*)(H + (size_t)(t0 + j) * NH + C_GK + h * 128 + 8 * ch); }
    for (int p = tid; p < 64 * 32; p += NTHR) { const int j = p >> 5, ch = p & 31; *(LAS u32x4*)(vs + j * LDV + 8 * ch) = *(const u32x4*)(H + (size_t)(t0 + j) * NH + C_GV + h * 256 + 8 * ch); }
    __syncthreads();
    const int d = tid & 127, sg = tid >> 7;
    { float w[16];
#pragma unroll
      for (int r = 0; r < 16; ++r) w[r] = w_gla_up[(size_t)l * 16 * 512 + r * 512 + h * 128 + d];
      const float bg = b_gla[l * 512 + h * 128 + d]; float run = 0.f;
      for (int jj = 0; jj < 16; ++jj) { const int j = sg * 16 + jj; float z = bg;
#pragma unroll
          for (int r = 0; r < 16; ++r) z += lrs[j * 16 + r] * w[r];
          run += logsigmoid_f(z) * (1.0f / 16.0f); bcs[j * 128 + d] = run; }
      seg[sg * 128 + d] = run; }
    __syncthreads();
    { float pre = 0.f;
      for (int s = 0; s < sg; ++s) pre += seg[s * 128 + d];
      float* GB = wsp<float>(F, WS_GB);
      for (int jj = 0; jj < 16; ++jj) { const int j = sg * 16 + jj; const float v = bcs[j * 128 + d] + pre; bcs[j * 128 + d] = v; GB[(size_t)(t0 + j) * 512 + h * 128 + d] = v; }
      if (sg == 3) wsp<float>(F, WS_DEC)[(size_t)unit * 128 + d] = expf(bcs[63 * 128 + d]); }
    __syncthreads();
#pragma unroll
    for (int it = 0; it < 2; ++it) { const int p = tid + it * NTHR, j = p >> 4, ch = p & 15; float f[8]; unpack8(kw[it], f);
#pragma unroll
        for (int i = 0; i < 8; ++i) f[i] *= fexp(bcs[63 * 128 + 8 * ch + i] - bcs[j * 128 + 8 * ch + i]);
        *(LAS u32x4*)(kds + j * LDK + 8 * ch) = pack8(f); }
    __syncthreads();
    f32x4 acc[2][8];
#pragma unroll
    for (int a = 0; a < 2; ++a)
#pragma unroll
        for (int n = 0; n < 8; ++n) acc[a][n] = (f32x4){0.f, 0.f, 0.f, 0.f};
#pragma unroll
    for (int ks = 0; ks < 2; ++ks) {
        bf16x8 af[2];
#pragma unroll
        for (int a = 0; a < 2; ++a) af[a] = frag_tr(vs, LDV, 32 * ks, 32 * wave + 16 * a, lane);
#pragma unroll
        for (int n = 0; n < 8; ++n) { const bf16x8 bfr = frag_tr(kds, LDK, 32 * ks, 16 * n, lane);
#pragma unroll
            for (int a = 0; a < 2; ++a) acc[a][n] = mma16(bfr, af[a], acc[a][n]); }
    }
    float* U = wsp<float>(F, WS_GU) + (size_t)unit * 256 * 128;
#pragma unroll
    for (int a = 0; a < 2; ++a)
#pragma unroll
        for (int n = 0; n < 8; ++n) *(f32x4*)(U + (size_t)(32 * wave + 16 * a + (lane & 15)) * 128 + 16 * n + 4 * (lane >> 4)) = acc[a][n];
}

DI void gla_scan(const Frame& F) {
    const float* U = wsp<float>(F, WS_GU); const float* DEC = wsp<float>(F, WS_DEC); unsigned* S = wsp<unsigned>(F, WS_GS);
    const int gt = F.wg * NTHR + F.tid, GT = F.G * NTHR;
    for (int it = gt; it < 8 * 256 * 64; it += GT) {
        const int bh = it >> 14, r = it & 16383, e = r >> 6, dp = r & 63;
        float s0 = 0.f, s1 = 0.f;
#pragma unroll 8
        for (int c = 0; c < 64; ++c) { const size_t un = (size_t)bh * 64 + c; const size_t o = (un * 256 + e) * 128 + 2 * dp;
            const f32x2 u = *(const f32x2*)(U + o); const f32x2 dc = *(const f32x2*)(DEC + un * 128 + 2 * dp);
            S[o >> 1] = pk2(s0, s1); s0 = dc.x * s0 + u.x; s1 = dc.y * s1 + u.y; }
    }
}

#ifndef PROBE_T
#define PROBE_T 0
#endif
#if PROBE_T
#define PT_STAMP(k) do { if (F.wg == 0 && F.tid == 0) { const unsigned _now = (unsigned)wall_clock64(); volatile LAS unsigned* _pt = (volatile LAS unsigned*)(F.lds + MISC_OFF + 128); if ((k) > 0) _pt[k] += _now - _pt[0]; _pt[0] = _now; } } while (0)
#else
#define PT_STAMP(k) do {} while (0)
#endif
DI void gla_c_unit(const Frame& F, int l, int unit, const float* gla_norm) {
    const int bh = unit >> 6, c = unit & 63, b = bh >> 2, h = bh & 3, t0 = b * SEQ + c * 64, tid = F.tid, lane = F.lane, wave = F.wave;
    const bf16* H = wsp<bf16>(F, WS_H);
    LAS bf16* qs = (LAS bf16*)(F.lds);
    LAS bf16* ks = (LAS bf16*)(F.lds + 17408);
    LAS bf16* vs = (LAS bf16*)(F.lds + 34816);
    LAS bf16* ps = (LAS bf16*)(F.lds + 68608);
    LAS float* red = (LAS float*)(F.lds + 77824);
    constexpr int LDK = 136, LDV = 264, LDP = 72;
    __syncthreads();
    PT_STAMP(0);
    const float* GB = wsp<float>(F, WS_GB);
    u32x4 qw[2], kw[2], vw[4]; f32x4 b0[2], b1[2];
#pragma unroll
    for (int it = 0; it < 2; ++it) { const int p = tid + it * NTHR, j = p >> 4, ch = p & 15;
        qw[it] = *(const u32x4*)(H + (size_t)(t0 + j) * NH + C_GQ + h * 128 + 8 * ch); kw[it] = *(const u32x4*)(H + (size_t)(t0 + j) * NH + C_GK + h * 128 + 8 * ch);
        b0[it] = *(const f32x4*)(GB + (size_t)(t0 + j) * 512 + h * 128 + 8 * ch); b1[it] = *(const f32x4*)(GB + (size_t)(t0 + j) * 512 + h * 128 + 8 * ch + 4); }
#pragma unroll
    for (int it = 0; it < 4; ++it) { const int p = tid + it * NTHR, j = p >> 5, ch = p & 31; vw[it] = *(const u32x4*)(H + (size_t)(t0 + j) * NH + C_GV + h * 256 + 8 * ch); }
    const bf16* St = wsp<bf16>(F, WS_GS) + (size_t)unit * 256 * 128;
    bf16x8 sf[4][2];
#pragma unroll
    for (int kk = 0; kk < 4; ++kk)
#pragma unroll
        for (int a = 0; a < 2; ++a) sf[kk][a] = frag_glb(St, 128, 32 * wave + 16 * a, 32 * kk, lane);
    f32x4 gn[2]; u32x2 gw[4][2];
#pragma unroll
    for (int a = 0; a < 2; ++a) { const int e = 32 * wave + 16 * a + 4 * (lane >> 4); gn[a] = *(const f32x4*)(gla_norm + l * 1024 + h * 256 + e);
#pragma unroll
        for (int n = 0; n < 4; ++n) gw[n][a] = *(const u32x2*)(H + (size_t)(t0 + 16 * n + (lane & 15)) * NH + C_GG + h * 256 + e); }
#pragma unroll
    for (int it = 0; it < 2; ++it) { const int p = tid + it * NTHR, j = p >> 4, ch = p & 15;
        float q[8], k[8]; unpack8(qw[it], q); unpack8(kw[it], k); const float bb[8] = {b0[it].x, b0[it].y, b0[it].z, b0[it].w, b1[it].x, b1[it].y, b1[it].z, b1[it].w};
#pragma unroll
        for (int i = 0; i < 8; ++i) { const float eb = fexp(bb[i]); q[i] *= eb * 0.08838834764831845f; k[i] *= fexp(-bb[i]); }
        *(LAS u32x4*)(qs + j * LDK + 8 * ch) = pack8(q); *(LAS u32x4*)(ks + j * LDK + 8 * ch) = pack8(k); }
#pragma unroll
    for (int it = 0; it < 4; ++it) { const int p = tid + it * NTHR, j = p >> 5, ch = p & 31; *(LAS u32x4*)(vs + j * LDV + 8 * ch) = vw[it]; }
    LDS_WAIT(); __builtin_amdgcn_s_barrier(); asm volatile("" ::: "memory");
    PT_STAMP(1);
    { const int it = wave >> 1; f32x4 sa[2] = {(f32x4){0.f, 0.f, 0.f, 0.f}, (f32x4){0.f, 0.f, 0.f, 0.f}};
#pragma unroll
      for (int kk = 0; kk < 4; ++kk) { const bf16x8 qa = frag_lds(qs, LDK, 16 * it, 32 * kk, lane);
#pragma unroll
          for (int jj = 0; jj < 2; ++jj) sa[jj] = mma16(qa, frag_lds(ks, LDK, 16 * (2 * (wave & 1) + jj), 32 * kk, lane), sa[jj]); }
#pragma unroll
      for (int jj = 0; jj < 2; ++jj)
#pragma unroll
          for (int r = 0; r < 4; ++r) { const int i = 16 * it + 4 * (lane >> 4) + r, j = 16 * (2 * (wave & 1) + jj) + (lane & 15);
              ps[i * LDP + j] = (bf16)f2bf(j <= i ? sa[jj][r] : 0.f); } }
    LDS_WAIT(); __builtin_amdgcn_s_barrier(); asm volatile("" ::: "memory");
    PT_STAMP(2);
    f32x4 acc[2][4];
#pragma unroll
    for (int a = 0; a < 2; ++a)
#pragma unroll
        for (int n = 0; n < 4; ++n) acc[a][n] = (f32x4){0.f, 0.f, 0.f, 0.f};
#pragma unroll
    for (int kk = 0; kk < 4; ++kk) {
#pragma unroll
        for (int n = 0; n < 4; ++n) { const bf16x8 bq = frag_lds(qs, LDK, 16 * n, 32 * kk, lane);
#pragma unroll
            for (int a = 0; a < 2; ++a) acc[a][n] = mma16(sf[kk][a], bq, acc[a][n]); } }
#pragma unroll
    for (int kk = 0; kk < 2; ++kk) { bf16x8 af[2];
#pragma unroll
        for (int a = 0; a < 2; ++a) af[a] = frag_tr(vs, LDV, 32 * kk, 32 * wave + 16 * a, lane);
#pragma unroll
        for (int n = 0; n < 4; ++n) { const bf16x8 bp = frag_lds(ps, LDP, 16 * n, 32 * kk, lane);
#pragma unroll
            for (int a = 0; a < 2; ++a) acc[a][n] = mma16(af[a], bp, acc[a][n]); } }
#pragma unroll
    for (int n = 0; n < 4; ++n) { float s = 0.f;
#pragma unroll
        for (int a = 0; a < 2; ++a)
#pragma unroll
            for (int r = 0; r < 4; ++r) s += acc[a][n][r] * acc[a][n][r];
        s += __shfl_xor(s, 16); s += __shfl_xor(s, 32);
        if (lane < 16) red[wave * 64 + 16 * n + lane] = s; }
    __syncthreads();
    PT_STAMP(3);
    bf16* OB = wsp<bf16>(F, WS_OB);
#pragma unroll
    for (int n = 0; n < 4; ++n) { const int i = 16 * n + (lane & 15); float tot = 0.f;
#pragma unroll
        for (int w = 0; w < 8; ++w) tot += red[w * 64 + i];
        const float rs = 1.0f / sqrtf(tot * (1.0f / 256.0f) + LN_EPS);
#pragma unroll
        for (int a = 0; a < 2; ++a) { const int e = 32 * wave + 16 * a + 4 * (lane >> 4);
            const float g0 = bf2f(gw[n][a].x & 0xffffu), g1 = bf2f(gw[n][a].x >> 16), g2 = bf2f(gw[n][a].y & 0xffffu), g3 = bf2f(gw[n][a].y >> 16);
            u32x2 o; o.x = pk2(acc[a][n][0] * rs * gn[a].x * g0, acc[a][n][1] * rs * gn[a].y * g1); o.y = pk2(acc[a][n][2] * rs * gn[a].z * g2, acc[a][n][3] * rs * gn[a].w * g3);
            *(u32x2*)ob_at(OB, t0 + i, 1024 + h * 256 + e) = o; } }
    PT_STAMP(4);
}

DI void pool_unit(const Frame& F, int l, int unit, const float* pool_scale) {
    const int gi = unit & 3, tt = unit >> 2, t0 = tt * 128, tid = F.tid, lane = F.lane, wave = F.wave, w = 2 << gi;
    const bf16* H = wsp<bf16>(F, WS_H);
    LAS bf16* pl = (LAS bf16*)(F.lds);
    constexpr int LDP = 264;
    __syncthreads();
    LAS bf16* raw = (LAS bf16*)(F.lds + 67584);
    { const int seq0 = t0 & ~(SEQ - 1);
      for (int p = tid + (16 - w) * 32; p < 143 * 32; p += NTHR) { const int r = p >> 5, ch = p & 31, tok = t0 - 15 + r;
          u32x4 x = (u32x4){0u, 0u, 0u, 0u}; if (tok >= seq0) x = *(const u32x4*)(H + (size_t)tok * NH + C_PU + gi * 256 + 8 * ch);
          *(LAS u32x4*)(raw + r * 256 + 8 * ch) = x; } }
    __syncthreads();
    for (int p = tid; p < 128 * 32; p += NTHR) { const int j = p >> 5, ch = p & 31, ts = (t0 + j) & (SEQ - 1);
        const int cnt = (ts + 1 < w) ? ts + 1 : w; float a[8], u0[8];
        { unpack8(*(const LAS u32x4*)(raw + (j + 15) * 256 + 8 * ch), u0);
#pragma unroll
          for (int i = 0; i < 8; ++i) a[i] = u0[i]; }
#pragma unroll
        for (int s = 1; s < 16; ++s) if (s < w) { float f[8]; unpack8(*(const LAS u32x4*)(raw + (j + 15 - s) * 256 + 8 * ch), f);
#pragma unroll
            for (int i = 0; i < 8; ++i) a[i] += f[i]; }
        const float ic = 1.0f / (float)cnt;
#pragma unroll
        for (int i = 0; i < 8; ++i) a[i] = a[i] * ic - u0[i];
        *(LAS u32x4*)(pl + j * LDP + 8 * ch) = pack8(a); }
    __syncthreads();
    const bf16* WP = wsp<bf16>(F, WS_WPOOLT) + (size_t)(l * 4 + gi) * 256 * 256;
    f32x4 acc[2][8];
#pragma unroll
    for (int a = 0; a < 2; ++a)
#pragma unroll
        for (int n = 0; n < 8; ++n) acc[a][n] = (f32x4){0.f, 0.f, 0.f, 0.f};
#pragma unroll 2
    for (int kk = 0; kk < 8; ++kk) { bf16x8 af[2];
#pragma unroll
        for (int a = 0; a < 2; ++a) af[a] = frag_glb(WP, 256, 32 * wave + 16 * a, 32 * kk, lane);
#pragma unroll
        for (int n = 0; n < 8; ++n) { const bf16x8 bp = frag_lds(pl, LDP, 16 * n, 32 * kk, lane);
#pragma unroll
            for (int a = 0; a < 2; ++a) acc[a][n] = mma16(af[a], bp, acc[a][n]); } }
    bf16* OB = wsp<bf16>(F, WS_OB);
    u32x2 gwa[8][2]; f32x4 sca[2];
#pragma unroll
    for (int a = 0; a < 2; ++a) { const int dd = gi * 256 + 32 * wave + 16 * a + 4 * (lane >> 4); sca[a] = *(const f32x4*)(pool_scale + l * 1024 + dd);
#pragma unroll
        for (int n = 0; n < 8; ++n) gwa[n][a] = *(const u32x2*)(H + (size_t)(t0 + 16 * n + (lane & 15)) * NH + C_PG + dd); }
#pragma unroll
    for (int a = 0; a < 2; ++a)
#pragma unroll
        for (int n = 0; n < 8; ++n) asm volatile("" : "+v"(gwa[n][a]));
#pragma unroll
    for (int n = 0; n < 8; ++n) { const int t = t0 + 16 * n + (lane & 15);
#pragma unroll
        for (int a = 0; a < 2; ++a) { const int dd = gi * 256 + 32 * wave + 16 * a + 4 * (lane >> 4);
            const f32x4 sc = sca[a];
            const u32x2 gw = gwa[n][a];
            const float g0 = bf2f(gw.x & 0xffffu), g1 = bf2f(gw.x >> 16), g2 = bf2f(gw.y & 0xffffu), g3 = bf2f(gw.y >> 16);
            u32x2 o; o.x = pk2(acc[a][n][0] * sc.x * g0, acc[a][n][1] * sc.y * g1); o.y = pk2(acc[a][n][2] * sc.z * g2, acc[a][n][3] * sc.w * g3);
            *(u32x2*)ob_at(OB, t, dd) = o; } }
}

DI void swa_unit(const Frame& F, int l, int unit, const float* sinks, const bool restage = true) {
    const int n = unit & 31, hq = (unit >> 5) & 15, b = unit >> 9, kvh = hq >> 3, tid = F.tid, lane = F.lane, wave = F.wave;
    const int tq0 = b * SEQ + n * 128, tk0 = tq0 - 128;
    const bf16* H = wsp<bf16>(F, WS_H); const f32x2* RT = wsp<f32x2>(F, WS_ROPE);
    constexpr int LD = 72, LDPW = 168;
    LAS bf16* qs = (LAS bf16*)(F.lds);
    LAS bf16* ks = (LAS bf16*)(F.lds + 18432);
    LAS bf16* vs = (LAS bf16*)(F.lds + 57600);
    LAS bf16* pw = (LAS bf16*)(F.lds + 96768) + wave * 16 * LDPW;
    __syncthreads();
    for (int p = tid; p < 128 * 4; p += NTHR) { const int i = p >> 2, ch = p & 3; const bf16* src = H + (size_t)(tq0 + i) * NH + C_SQ + hq * 64 + 16 * ch;
        float f[16]; { float a[8], c[8]; unpack8(*(const u32x4*)src, a); unpack8(*(const u32x4*)(src + 8), c);
#pragma unroll
            for (int j = 0; j < 8; ++j) { f[j] = a[j]; f[8 + j] = c[j]; } }
        if (ch == 0) {
#pragma unroll
            for (int j = 0; j < 8; ++j) { const f32x2 cs = RT[(size_t)(tq0 + i) * 8 + j]; const float x1 = f[j], x2 = f[8 + j]; f[j] = x1 * cs.x - x2 * cs.y; f[8 + j] = x2 * cs.x + x1 * cs.y; } }
        float o0[8], o1[8];
#pragma unroll
        for (int j = 0; j < 8; ++j) { o0[j] = f[j] * 0.125f; o1[j] = f[8 + j] * 0.125f; }
        *(LAS u32x4*)(qs + i * LD + 16 * ch) = pack8(o0); *(LAS u32x4*)(qs + i * LD + 16 * ch + 8) = pack8(o1); }
    if (restage)
    for (int p = tid; p < 272 * 4; p += NTHR) { const int j = p >> 2, ch = p & 3; const bool ok = (j < 256) && (n > 0 || j >= 128);
        u32x4 k0 = (u32x4){0u, 0u, 0u, 0u}, k1 = k0, v0 = k0, v1 = k0;
        if (ok) { const bf16* ksrc = H + (size_t)(tk0 + j) * NH + C_SK + kvh * 64 + 16 * ch; const bf16* vsrc = H + (size_t)(tk0 + j) * NH + C_SV + kvh * 64 + 16 * ch;
            k0 = *(const u32x4*)ksrc; k1 = *(const u32x4*)(ksrc + 8); v0 = *(const u32x4*)vsrc; v1 = *(const u32x4*)(vsrc + 8);
            if (ch == 0) { float a[8], c[8]; unpack8(k0, a); unpack8(k1, c);
#pragma unroll
                for (int jj = 0; jj < 8; ++jj) { const f32x2 cs = RT[(size_t)(tk0 + j) * 8 + jj]; const float x1 = a[jj], x2 = c[jj]; a[jj] = x1 * cs.x - x2 * cs.y; c[jj] = x2 * cs.x + x1 * cs.y; }
                k0 = pack8(a); k1 = pack8(c); } }
        *(LAS u32x4*)(ks + j * LD + 16 * ch) = k0; *(LAS u32x4*)(ks + j * LD + 16 * ch + 8) = k1;
        *(LAS u32x4*)(vs + j * LD + 16 * ch) = v0; *(LAS u32x4*)(vs + j * LD + 16 * ch + 8) = v1; }
    __syncthreads();
    const int qi = 16 * wave + (lane & 15);
    bf16x8 qf[2];
#pragma unroll
    for (int s = 0; s < 2; ++s) qf[s] = frag_lds(qs, LD, 16 * wave, 32 * s, lane);
    f32x4 sc[10];
#pragma unroll
    for (int jt = 0; jt < 10; ++jt) { sc[jt] = (f32x4){0.f, 0.f, 0.f, 0.f};
#pragma unroll
        for (int s = 0; s < 2; ++s) sc[jt] = mma16(frag_lds(ks, LD, 16 * (wave + jt), 32 * s, lane), qf[s], sc[jt]); }
    const float sink = sinks[l * 16 + hq];
    float mx = sink;
#pragma unroll
    for (int jt = 0; jt < 10; ++jt)
#pragma unroll
        for (int r = 0; r < 4; ++r) { const int kj = 16 * (wave + jt) + 4 * (lane >> 4) + r; const bool ok = (kj > qi) && (kj <= qi + 128) && (n > 0 || kj >= 128);
            sc[jt][r] = ok ? sc[jt][r] : -INFINITY; mx = fmaxf(mx, sc[jt][r]); }
    mx = fmaxf(mx, __shfl_xor(mx, 16)); mx = fmaxf(mx, __shfl_xor(mx, 32));
    float sum = 0.f;
#pragma unroll
    for (int jt = 0; jt < 10; ++jt)
#pragma unroll
        for (int r = 0; r < 4; ++r) { const float p = fexp(sc[jt][r] - mx); sc[jt][r] = p; sum += p; }
    sum += __shfl_xor(sum, 16); sum += __shfl_xor(sum, 32);
    const float inv = 1.0f / (sum + fexp(sink - mx));
#pragma unroll
    for (int jt = 0; jt < 10; ++jt) { u32x2 o; o.x = pk2(sc[jt][0] * inv, sc[jt][1] * inv); o.y = pk2(sc[jt][2] * inv, sc[jt][3] * inv);
        *(LAS u32x2*)(pw + (lane & 15) * LDPW + 16 * jt + 4 * (lane >> 4)) = o; }
    LDS_WAIT();
    f32x4 oa[4];
#pragma unroll
    for (int dt = 0; dt < 4; ++dt) oa[dt] = (f32x4){0.f, 0.f, 0.f, 0.f};
#pragma unroll
    for (int s = 0; s < 5; ++s) { const bf16x8 pf = frag_lds(pw, LDPW, 0, 32 * s, lane);
#pragma unroll
        for (int dt = 0; dt < 4; ++dt) oa[dt] = mma16(frag_tr(vs, LD, 16 * wave + 32 * s, 16 * dt, lane), pf, oa[dt]); }
    bf16* OB = wsp<bf16>(F, WS_OB);
    { const int t = tq0 + qi; u32x2 gwa[4];
#pragma unroll
      for (int dt = 0; dt < 4; ++dt) gwa[dt] = *(const u32x2*)(H + (size_t)t * NH + C_SG + hq * 64 + 16 * dt + 4 * (lane >> 4));
#pragma unroll
      for (int dt = 0; dt < 4; ++dt) asm volatile("" : "+v"(gwa[dt]));
#pragma unroll
      for (int dt = 0; dt < 4; ++dt) { const int dd = hq * 64 + 16 * dt + 4 * (lane >> 4);
          const u32x2 gw = gwa[dt];
          const float g0 = bf2f(gw.x & 0xffffu), g1 = bf2f(gw.x >> 16), g2 = bf2f(gw.y & 0xffffu), g3 = bf2f(gw.y >> 16);
          u32x2 o; o.x = pk2(oa[dt][0] * g0, oa[dt][1] * g1); o.y = pk2(oa[dt][2] * g2, oa[dt][3] * g3);
          *(u32x2*)ob_at(OB, t, 2048 + dd) = o; } }
}

DI void mem_unit(const Frame& F, int l, int unit) {
    const int n = unit & 31, hx = (unit >> 5) & 3, b = unit >> 7, lane = F.lane, wave = F.wave, tid = F.tid;
    const int tq0 = b * SEQ + n * 128 + 16 * wave;
    const bf16* H = wsp<bf16>(F, WS_H);
    const bf16* MK = wsp<bf16>(F, WS_MK) + (size_t)l * 512 * 1024 + (size_t)b * 256 * 1024 + hx * 256;
    const bf16* MVT = wsp<bf16>(F, WS_MVT) + (size_t)l * 1024 * 512 + (size_t)hx * 256 * 512 + b * 256;
    constexpr int LDI = 264;
    LAS bf16* img = (LAS bf16*)(F.lds);
    __syncthreads();
#pragma unroll 4
    for (int p = tid; p < 256 * 32; p += NTHR) { const int r = p >> 5, ch = p & 31; *(LAS u32x4*)(img + r * LDI + 8 * ch) = *(const u32x4*)(MK + (size_t)r * 1024 + 8 * ch); }
    bf16x8 qf[8];
#pragma unroll
    for (int s = 0; s < 8; ++s) qf[s] = frag_glb(H + C_XQ + hx * 256, NH, tq0, 32 * s, lane);
    __syncthreads();
    f32x4 sc[16];
#pragma unroll
    for (int jt = 0; jt < 16; ++jt) { sc[jt] = (f32x4){0.f, 0.f, 0.f, 0.f};
#pragma unroll
        for (int s = 0; s < 8; ++s) sc[jt] = mma16(frag_lds(img, LDI, 16 * jt, 32 * s, lane), qf[s], sc[jt]);
        if (jt & 1) __builtin_amdgcn_sched_barrier(0); }
#pragma unroll
    for (int jt = 0; jt < 16; ++jt) asm volatile("" : "+v"(sc[jt]));
    __syncthreads();
#pragma unroll 4
    for (int p = tid; p < 256 * 32; p += NTHR) { const int r = p >> 5, ch = p & 31; *(LAS u32x4*)(img + r * LDI + 8 * ch) = *(const u32x4*)(MVT + (size_t)r * 512 + 8 * ch); }
    float mx = -INFINITY;
#pragma unroll
    for (int jt = 0; jt < 16; ++jt)
#pragma unroll
        for (int r = 0; r < 4; ++r) { sc[jt][r] *= 0.0625f; mx = fmaxf(mx, sc[jt][r]); }
    mx = fmaxf(mx, __shfl_xor(mx, 16)); mx = fmaxf(mx, __shfl_xor(mx, 32));
    float sum = 0.f;
#pragma unroll
    for (int jt = 0; jt < 16; ++jt)
#pragma unroll
        for (int r = 0; r < 4; ++r) { const float p = __builtin_amdgcn_exp2f((sc[jt][r] - mx) * 1.44269504089f); sc[jt][r] = p; sum += p; }
    sum += __shfl_xor(sum, 16); sum += __shfl_xor(sum, 32);
    const float inv = 1.0f / sum;
    bf16x8 pb[8];
#pragma unroll
    for (int s = 0; s < 8; ++s) { u32x4 w; w.x = pk2(sc[2 * s][0] * inv, sc[2 * s][1] * inv); w.y = pk2(sc[2 * s][2] * inv, sc[2 * s][3] * inv);
        w.z = pk2(sc[2 * s + 1][0] * inv, sc[2 * s + 1][1] * inv); w.w = pk2(sc[2 * s + 1][2] * inv, sc[2 * s + 1][3] * inv); pb[s] = __builtin_bit_cast(bf16x8, w); }
    __syncthreads();
    bf16* OB = wsp<bf16>(F, WS_OB); const int t = tq0 + (lane & 15);
    const LAS bf16* arow = img + (lane & 15) * LDI + 4 * (lane >> 4);
#pragma unroll 4
    for (int dt = 0; dt < 16; ++dt) { f32x4 oa = (f32x4){0.f, 0.f, 0.f, 0.f};
#pragma unroll
        for (int s = 0; s < 8; ++s) { const u32x2 lo = *(const LAS u32x2*)(arow + 16 * dt * LDI + 32 * s), hi = *(const LAS u32x2*)(arow + 16 * dt * LDI + 32 * s + 16);
            const u32x4 av = (u32x4){lo.x, lo.y, hi.x, hi.y};
            oa = mma16(__builtin_bit_cast(bf16x8, av), pb[s], oa); }
        __builtin_amdgcn_sched_barrier(0);
        const int dd = hx * 256 + 16 * dt + 4 * (lane >> 4);
        const u32x2 gw = *(const u32x2*)(H + (size_t)t * NH + C_XG + dd);
        const float g0 = bf2f(gw.x & 0xffffu), g1 = bf2f(gw.x >> 16), g2 = bf2f(gw.y & 0xffffu), g3 = bf2f(gw.y >> 16);
        u32x2 o; o.x = pk2(oa[0] * g0, oa[1] * g1); o.y = pk2(oa[2] * g2, oa[3] * g3);
        *(u32x2*)ob_at(OB, t, 3072 + dd) = o; }
}

#ifndef NAIVE_MASK
#define NAIVE_MASK 0
#endif
DI float Hf(const bf16* H, size_t row, int col) { return bf2f(H[row * NH + col]); }
DI void naive_mem(const Frame& F, int l) {
    const bf16* H = wsp<bf16>(F, WS_H); bf16* OB = wsp<bf16>(F, WS_OB);
    LAS float* qs = (LAS float*)(F.lds) + F.wave * 512; LAS float* ps = qs + 256;
    const int gw = F.wg * NWAVES + F.wave, NGW = F.G * NWAVES, lane = F.lane;
    for (int it = gw; it < MTOK * 4; it += NGW) {
        const int t = it >> 2, hx = it & 3, b = t / SEQ;
        const bf16* MK = wsp<bf16>(F, WS_MK) + (size_t)l * 512 * 1024 + (size_t)b * 256 * 1024 + hx * 256;
        const bf16* MVT = wsp<bf16>(F, WS_MVT) + (size_t)l * 1024 * 512 + (size_t)hx * 256 * 512 + b * 256;
        for (int i = 0; i < 4; ++i) qs[lane + 64 * i] = Hf(H, t, C_XQ + hx * 256 + lane + 64 * i);
        LDS_WAIT();
        float sc[4]; float mx = -INFINITY;
        for (int i = 0; i < 4; ++i) { const int j = lane + 64 * i; float a = 0.f; for (int d = 0; d < 256; ++d) a += qs[d] * bf2f(MK[(size_t)j * 1024 + d]); sc[i] = a * 0.0625f; mx = fmaxf(mx, sc[i]); }
        for (int o = 1; o < 64; o <<= 1) mx = fmaxf(mx, __shfl_xor(mx, o));
        float sum = 0.f; for (int i = 0; i < 4; ++i) { sc[i] = expf(sc[i] - mx); sum += sc[i]; }
        sum = wave_sum(sum);
        for (int i = 0; i < 4; ++i) ps[lane + 64 * i] = sc[i] / sum;
        LDS_WAIT();
        for (int i = 0; i < 4; ++i) { const int d = lane + 64 * i; float a = 0.f; for (int j = 0; j < 256; ++j) a += ps[j] * bf2f(MVT[(size_t)d * 512 + j]);
            *ob_at(OB, t, 3072 + hx * 256 + d) = (bf16)f2bf(a * Hf(H, t, C_XG + hx * 256 + d)); }
        LDS_WAIT();
    }
}
DI void naive_swa(const Frame& F, int l, const float* sinks) {
    const bf16* H = wsp<bf16>(F, WS_H); bf16* OB = wsp<bf16>(F, WS_OB); const f32x2* RT = wsp<f32x2>(F, WS_ROPE);
    LAS float* qs = (LAS float*)(F.lds) + F.wave * 256; LAS float* ps = qs + 64;
    const int gw = F.wg * NWAVES + F.wave, NGW = F.G * NWAVES, lane = F.lane;
    for (int it = gw; it < MTOK * 16; it += NGW) {
        const int t = it >> 4, hq = it & 15, kvh = hq >> 3, ts = t & (SEQ - 1);
        { float x = Hf(H, t, C_SQ + hq * 64 + lane);
          if (lane < 16) { const int i = lane & 7; const float x1 = Hf(H, t, C_SQ + hq * 64 + i), x2 = Hf(H, t, C_SQ + hq * 64 + 8 + i); const f32x2 cs = RT[(size_t)t * 8 + i];
              x = (lane < 8) ? x1 * cs.x - x2 * cs.y : x2 * cs.x + x1 * cs.y; }
          qs[lane] = x * 0.125f; }
        LDS_WAIT();
        float sc[2]; const float sink = sinks[l * 16 + hq]; float mx = sink;
        for (int i = 0; i < 2; ++i) { const int back = lane + 64 * i; sc[i] = -INFINITY;
            if (back <= ts) { const int tk = t - back; float a = 0.f;
                for (int d = 0; d < 64; ++d) { float kv = Hf(H, tk, C_SK + kvh * 64 + d);
                    if (d < 16) { const int ii = d & 7; const float x1 = Hf(H, tk, C_SK + kvh * 64 + ii), x2 = Hf(H, tk, C_SK + kvh * 64 + 8 + ii); const f32x2 cs = RT[(size_t)tk * 8 + ii];
                        kv = (d < 8) ? x1 * cs.x - x2 * cs.y : x2 * cs.x + x1 * cs.y; }
                    a += qs[d] * kv; }
                sc[i] = a; }
            mx = fmaxf(mx, sc[i]); }
        for (int o = 1; o < 64; o <<= 1) mx = fmaxf(mx, __shfl_xor(mx, o));
        float sum = 0.f; for (int i = 0; i < 2; ++i) { sc[i] = expf(sc[i] - mx); sum += sc[i]; }
        sum = wave_sum(sum) + expf(sink - mx);
        for (int i = 0; i < 2; ++i) ps[lane + 64 * i] = sc[i] / sum;
        LDS_WAIT();
        { float a = 0.f; const int nk = (ts + 1 < 128) ? ts + 1 : 128;
          for (int back = 0; back < nk; ++back) a += ps[back] * Hf(H, t - back, C_SV + kvh * 64 + lane);
          *ob_at(OB, t, 2048 + hq * 64 + lane) = (bf16)f2bf(a * Hf(H, t, C_SG + hq * 64 + lane)); }
        LDS_WAIT();
    }
}
DI void naive_pool(const Frame& F, int l, const float* w_pool, const float* pool_scale) {
    const bf16* H = wsp<bf16>(F, WS_H); bf16* OB = wsp<bf16>(F, WS_OB); LAS float* pl = (LAS float*)(F.lds);
    for (int unit = F.wg; unit < 512; unit += F.G) { const int gi = unit & 3, t0 = (unit >> 2) * 64, w = 2 << gi;
        __syncthreads();
        for (int p = F.tid; p < 64 * 256; p += NTHR) { const int j = p >> 8, c = p & 255, t = t0 + j, ts = t & (SEQ - 1); const int cnt = (ts + 1 < w) ? ts + 1 : w; float a = 0.f;
            for (int s2 = 0; s2 < cnt; ++s2) a += Hf(H, t - s2, C_PU + gi * 256 + c);
            pl[p] = a / (float)cnt - Hf(H, t, C_PU + gi * 256 + c); }
        __syncthreads();
        const float* W = w_pool + (size_t)(l * 4 + gi) * 256 * 256;
        for (int o = F.tid; o < 64 * 256; o += NTHR) { const int j = o >> 8, d = o & 255; float a = 0.f; for (int c = 0; c < 256; ++c) a += pl[j * 256 + c] * W[c * 256 + d];
            const int t = t0 + j; *ob_at(OB, t, gi * 256 + d) = (bf16)f2bf(a * pool_scale[l * 1024 + gi * 256 + d] * Hf(H, t, C_PG + gi * 256 + d)); } }
}
DI void naive_gla(const Frame& F, int l, const float* w_gla_up, const float* b_gla) {
    const bf16* H = wsp<bf16>(F, WS_H); float* RAW = wsp<float>(F, WS_GU); LAS float* red = (LAS float*)(F.lds);
    for (int unit = F.wg; unit < 64; unit += F.G) { const int bh = unit >> 3, es = unit & 7, b = bh >> 2, h = bh & 3, e = es * 32 + (F.tid & 31), dg = F.tid >> 5;
        float S[8], wu[8][16], bg[8];
        for (int i = 0; i < 8; ++i) { S[i] = 0.f; bg[i] = b_gla[l * 512 + h * 128 + 8 * dg + i]; for (int r = 0; r < 16; ++r) wu[i][r] = w_gla_up[(size_t)l * 16 * 512 + r * 512 + h * 128 + 8 * dg + i]; }
        for (int ts = 0; ts < SEQ; ++ts) { const size_t t = (size_t)b * SEQ + ts; float lr[16]; for (int r = 0; r < 16; ++r) lr[r] = Hf(H, t, C_LR + r);
            const float v = Hf(H, t, C_GV + h * 256 + e); float part = 0.f;
            for (int i = 0; i < 8; ++i) { float z = bg[i]; for (int r = 0; r < 16; ++r) z += lr[r] * wu[i][r];
                const float a = expf((fminf(z, 0.f) - log1pf(expf(-fabsf(z)))) * (1.0f / 16.0f));
                S[i] = a * S[i] + Hf(H, t, C_GK + h * 128 + 8 * dg + i) * v; part += Hf(H, t, C_GQ + h * 128 + 8 * dg + i) * 0.08838834764831845f * S[i]; }
            __syncthreads(); red[dg * 32 + (F.tid & 31)] = part; __syncthreads();
            if (dg == 0) { float o = 0.f; for (int g = 0; g < 16; ++g) o += red[g * 32 + (F.tid & 31)]; RAW[t * 1024 + h * 256 + e] = o; } } }
}
DI void naive_gla_norm(const Frame& F, int l, const float* gla_norm) {
    const bf16* H = wsp<bf16>(F, WS_H); bf16* OB = wsp<bf16>(F, WS_OB); const float* RAW = wsp<float>(F, WS_GU);
    const int gw = F.wg * NWAVES + F.wave, NGW = F.G * NWAVES, lane = F.lane;
    for (int it = gw; it < MTOK * 4; it += NGW) { const int t = it >> 2, h = it & 3; float o[4], ss = 0.f;
        for (int i = 0; i < 4; ++i) { o[i] = RAW[(size_t)t * 1024 + h * 256 + lane + 64 * i]; ss += o[i] * o[i]; }
        ss = wave_sum(ss); const float rs = 1.0f / sqrtf(ss * (1.0f / 256.0f) + LN_EPS);
        for (int i = 0; i < 4; ++i) { const int e = lane + 64 * i; *ob_at(OB, t, 1024 + h * 256 + e) = (bf16)f2bf(o[i] * rs * gla_norm[l * 1024 + h * 256 + e] * Hf(H, t, C_GG + h * 256 + e)); } }
}

DI void ln_phase(const Frame& F, int l, const float* ln_g, const float* ln_b) {
    const int gw = F.wg * NWAVES + F.wave, NGW = F.G * NWAVES, lane = F.lane;
    const float* g = ln_g + l * DM; const float* bb = ln_b + l * DM;
    for (int m = gw; m < MTOK; m += NGW) {
        f32x4* row = (f32x4*)(F.out + (size_t)m * DM) + lane; const f32x4* zrow = (const f32x4*)(wsp<float>(F, WS_Z) + (size_t)m * DM) + lane;
        f32x4 v[16]; float s = 0.f;
#pragma unroll
        for (int j = 0; j < 16; ++j) { v[j] = zrow[64 * j]; s += (v[j].x + v[j].y) + (v[j].z + v[j].w); }
        const float mean = wave_sum(s) * (1.f / DM); float s2 = 0.f;
#pragma unroll
        for (int j = 0; j < 16; ++j) { v[j] = v[j] - mean; s2 += (v[j].x * v[j].x + v[j].y * v[j].y) + (v[j].z * v[j].z + v[j].w * v[j].w); }
        const float rstd = 1.f / sqrtf(wave_sum(s2) * (1.f / DM) + LN_EPS);
        u32x2* xb = (u32x2*)(wsp<bf16>(F, WS_XB) + (size_t)m * DM) + lane; unsigned* x8 = (unsigned*)(wsp<unsigned char>(F, WS_X8) + (size_t)m * DM) + lane;
#pragma unroll
        for (int j = 0; j < 16; ++j) { const f32x4 gg = *((const f32x4*)g + lane + 64 * j), be = *((const f32x4*)bb + lane + 64 * j);
            const f32x4 o = v[j] * rstd * gg + be; row[64 * j] = o;
#if F6
            if (l + 1 < DEPTH) { u32x2 w; w.x = pk2(o.x, o.y); w.y = pk2(o.z, o.w); xb[64 * j] = w;
                LAS unsigned char* lw = F.lds + F.wave * 9216;
                *(LAS f32x4*)(lw + ((lane >> 3) + 8 * (j & 7)) * 144 + (lane & 7) * 16) = o * X8_SCALE;
                if ((j & 7) == 7) { LDS_WAIT(); float f[32];
#pragma unroll
                    for (int t = 0; t < 8; ++t) { const f32x4 q = *(const LAS f32x4*)(lw + lane * 144 + 16 * t); f[4 * t] = q.x; f[4 * t + 1] = q.y; f[4 * t + 2] = q.z; f[4 * t + 3] = q.w; }
                    u32x4 lo, hi; pk32_fp6(f, lo, hi); const int gi = 64 * (j >> 3) + lane; size_t ol, oh; pg8::f6_off(m, gi >> 2, gi & 3, ol, oh);
                    *(u32x4*)(wsp<unsigned char>(F, WS_X8) + ol) = lo; u32x2 h2; h2.x = hi.x; h2.y = hi.y; *(u32x2*)(wsp<unsigned char>(F, WS_X8) + oh) = h2; LDS_WAIT(); } } }
#else
            if (l + 1 < DEPTH) { u32x2 w; w.x = pk2(o.x, o.y); w.y = pk2(o.z, o.w); xb[64 * j] = w; x8[64 * j] = pk4_fp8(o.x * X8_SCALE, o.y * X8_SCALE, o.z * X8_SCALE, o.w * X8_SCALE); } }
#endif
    }
}

struct Args { const void* in[15]; float* out; unsigned char* ws; int ph_lo, ph_hi; };
constexpr int PH_PER_LAYER = 7, N_PHASES = 1 + PH_PER_LAYER * DEPTH;
#define IN(k) (lo <= (k) && (k) < hi)
#ifndef PH_MASK
#define PH_MASK 0xffff
#endif
#define PHM(b) ((PH_MASK >> (b)) & 1)
#ifndef REP_MASK
#define REP_MASK 0
#endif
#define REPS(b) (((REP_MASK >> (b)) & 1) ? 2 : 1)
#define SEAM(k) do { if (IN(k) && IN((k) + 1)) xcd_barrier(bar); } while (0)
#ifndef PROBE_CLK
#define PROBE_CLK 0
#endif
#ifndef PROBE_HOT
#define PROBE_HOT 0
#endif
struct SchedHot {
    static constexpr bool BLK = false;
    int G, c, mode; const char* A; const char* B;
    DI bool next(int i, pg8::Unit& u) const { if (i >= 4) return false; if (mode == 1) { u.pm = c & 7; u.pn = 0; } else if (mode == 4) { u.pm = c & 7; u.pn = c & 7; } else pg8::static_tile(i * G + c, 32, 32, u.pm, u.pn); u.gi = 0; return true; }
    DI const char* abase(const pg8::Unit& u) const { return A + (size_t)u.pm * 256 * 4096 * 2; }
    DI const char* bbase(const pg8::Unit& u) const { return B + (size_t)u.pn * 256 * 4096 * 2; }
};
struct SchedHot6 {
    static constexpr bool BLK = false;
    int G, c, mode; const char* A; const char* B;
    DI bool next(int i, pg8::Unit& u) const { if (i >= 4) return false; if (mode == 6) { u.pm = c & 7; u.pn = c & 7; } else pg8::static_tile(i * G + c, 32, 32, u.pm, u.pn); u.gi = 0; return true; }
    DI const char* abase(const pg8::Unit& u) const { return A + (size_t)u.pm * 786432; }
    DI const char* bbase(const pg8::Unit& u) const { return (mode == 6 ? A : B) + (size_t)u.pn * 786432; }
};
struct SchedHotBlk : SchedHot { static constexpr bool BLK = true; };
template <int l> DI void layer_body(const Frame& F, const Args& args, const int lo, const int hi, const XcdBarrier& bar) {
        const int p0 = 1 + PH_PER_LAYER * l;
        if (PHM(1) && IN(p0)) { {
            SchedInProj S; S.G = F.G; S.c = F.wg; S.n_extra = (l == 0) ? 32 : 0; S.XB = (const char*)(F.ws + WS_XB); S.WT = (const char*)(F.ws + WS_WINT) + (size_t)l * NH * 4096 * 2;
            S.MEMB = (const char*)(F.ws + WS_MEMB); S.WKV = (const char*)(F.ws + WS_WMKVT);
            EpiH E{wsp<bf16>(F, WS_H), wsp<bf16>(F, WS_MK), wsp<bf16>(F, WS_MVT)};
            pg8::SchedStatic S8; S8.nM = 32; S8.nN = N_F8 / (128 * F8NB); S8.G = F.G; S8.c = (F.wg + F8_ROT) % F.G; S8.A = (const char*)(F.ws + WS_X8); S8.B = (const char*)(F.ws + WS_W8) + (size_t)l * W8_LAYER;
            S8.astep = F6 ? (size_t)2 * 32 * 12288 : (size_t)256 * 4096; S8.bstep = F6 ? (size_t)F8NB * 32 * 12288 : (size_t)(128 * F8NB) * 4096;
            EpiMG<F8NB> E8{wsp<bf16>(F, WS_H)};
#if F6_FIRST
            pg8::gemm_phase<EpiMG<F8NB>, pg8::SchedStatic, F8NB, true, true>(F.lds, 2048, S8, E8);
            pg8::gemm_phase<EpiH, SchedInProj, 2, true>(F.lds, 4096, S, E);
#else
            pg8::gemm_phase<EpiH, SchedInProj, 2, true>(F.lds, 4096, S, E);
            pg8::gemm_phase<EpiMG<F8NB>, pg8::SchedStatic, F8NB, true, true>(F.lds, 2048, S8, E8);
#endif
        }
        if (PROBE_HOT >= 5 && l == 0) {
            SchedHot6 S6; S6.G = F.G; S6.c = F.wg; S6.mode = PROBE_HOT; S6.A = (const char*)(F.ws + WS_X8); S6.B = (const char*)(F.ws + WS_W8);
            EpiMG<F8NB> E6{(bf16*)(F.ws + (size_t)1700 * MiB)};
            pg8::gemm_phase<EpiMG<F8NB>, SchedHot6, F8NB, true, true>(F.lds, 2048, S6, E6);
        } else
        if (PROBE_HOT != 0 && l == 0) {
            SchedHot S; S.G = F.G; S.c = F.wg; S.mode = PROBE_HOT; S.A = (const char*)(F.ws + WS_XB); S.B = (PROBE_HOT == 4) ? (const char*)(F.ws + WS_XB) : (const char*)(F.ws + WS_WINT);
            EpiH E{(bf16*)(F.ws + (size_t)1700 * MiB), wsp<bf16>(F, WS_MK), wsp<bf16>(F, WS_MVT)};
            if (PROBE_HOT == 3) { SchedHotBlk S3; S3.G = S.G; S3.c = S.c; S3.mode = 2; S3.A = S.A; S3.B = S.B; pg8::gemm_phase<EpiH, SchedHotBlk, 2, true>(F.lds, 4096, S3, E); }
            else pg8::gemm_phase<EpiH, SchedHot, 2, true>(F.lds, 4096, S, E);
        }
        if (REPS(1) == 2) {
            SchedInProj S; S.G = F.G; S.c = F.wg; S.n_extra = (l == 0) ? 32 : 0; S.XB = (const char*)(F.ws + WS_XB); S.WT = (const char*)(F.ws + WS_WINT) + (size_t)l * NH * 4096 * 2;
            S.MEMB = (const char*)(F.ws + WS_MEMB); S.WKV = (const char*)(F.ws + WS_WMKVT);
            EpiH E{wsp<bf16>(F, WS_H), wsp<bf16>(F, WS_MK), wsp<bf16>(F, WS_MVT)};
            pg8::gemm_phase<EpiH, SchedInProj, 2, true>(F.lds, 4096, S, E);
            pg8::SchedStatic S8; S8.nM = 32; S8.nN = N_F8 / (128 * F8NB); S8.G = F.G; S8.c = (F.wg + F8_ROT) % F.G; S8.A = (const char*)(F.ws + WS_X8); S8.B = (const char*)(F.ws + WS_W8) + (size_t)l * W8_LAYER;
            S8.astep = F6 ? (size_t)2 * 32 * 12288 : (size_t)256 * 4096; S8.bstep = F6 ? (size_t)F8NB * 32 * 12288 : (size_t)(128 * F8NB) * 4096;
            EpiMG<F8NB> E8{wsp<bf16>(F, WS_H)};
            pg8::gemm_phase<EpiMG<F8NB>, pg8::SchedStatic, F8NB, true, true>(F.lds, 2048, S8, E8);
        } }
        SEAM(p0);
        if (PHM(2) && IN(p0 + 1)) for (int rep = 0; rep < REPS(2); ++rep) { if (NAIVE_MASK & 2) naive_gla(F, l, (const float*)args.in[6], (const float*)args.in[7]); else for (int u = F.wg; u < 512; u += F.G) gla_a_unit(F, l, u, (const float*)args.in[6], (const float*)args.in[7]); }
        SEAM(p0 + 1);
        if (PHM(3) && IN(p0 + 2)) for (int rep = 0; rep < REPS(3); ++rep) { if (!(NAIVE_MASK & 2)) gla_scan(F); }
        SEAM(p0 + 2);
        if (PHM(4) && IN(p0 + 3)) for (int rep = 0; rep < REPS(4); ++rep) {
            if (NAIVE_MASK & 2) naive_gla_norm(F, l, (const float*)args.in[8]); else
            for (int r2 = 0; r2 < REPS(8); ++r2) for (int u = F.wg; u < 512; u += F.G) gla_c_unit(F, l, u, (const float*)args.in[8]);
            if (NAIVE_MASK & 1) naive_pool(F, l, (const float*)args.in[4], (const float*)args.in[5]); else
            for (int r2 = 0; r2 < REPS(9); ++r2) for (int u = F.wg; u < 256; u += F.G) pool_unit(F, l, u, (const float*)args.in[5]);
            __syncthreads();
            if (NAIVE_MASK & 4) naive_swa(F, l, (const float*)args.in[9]); else
            for (int r2 = 0; r2 < REPS(10); ++r2) {
                if (F.G == 256 && REPS(10) == 1) {
                    const int g = F.wg >> 1, n = g & 31, kvh = (g >> 5) & 1, b = g >> 6;
                    for (int i = 0; i < 4; ++i) swa_unit(F, l, n | ((kvh * 8 + (F.wg & 1) * 4 + i) << 5) | (b << 9), (const float*)args.in[9], i == 0);
                } else for (int u = F.wg; u < 1024; u += F.G) swa_unit(F, l, u, (const float*)args.in[9]); }
            __syncthreads();
            if (NAIVE_MASK & 8) naive_mem(F, l); else
            for (int r2 = 0; r2 < REPS(11); ++r2) for (int u = F.wg; u < 256; u += F.G) mem_unit(F, l, u);
            __syncthreads();
        }
        SEAM(p0 + 3);
        if (PHM(5) && IN(p0 + 4)) { {
            pg8::SchedStatic S; S.nM = 32; S.nN = 32; S.G = F.G; S.c = F.wg; S.A = (const char*)(F.ws + WS_OB); S.B = (const char*)(F.ws + WS_WBRT) + (size_t)l * 4096 * 4096 * 2;
            S.astep = (size_t)256 * 4096 * 2; S.bstep = (size_t)128 * 4096 * 2;
            EpiGate E{wsp<bf16>(F, WS_H), wsp<bf16>(F, WS_YB)};
            if (BLK_GATE) { pg8::SchedStaticBlk SB; (pg8::SchedStatic&)SB = S; pg8::gemm_phase<EpiGate, pg8::SchedStaticBlk, 1, true>(F.lds, 4096, SB, E); } else
            pg8::gemm_phase<EpiGate, pg8::SchedStatic, 1, true>(F.lds, 4096, S, E);
        }
        if (REPS(5) == 2) {
            pg8::SchedStatic S; S.nM = 32; S.nN = 32; S.G = F.G; S.c = F.wg; S.A = (const char*)(F.ws + WS_OB); S.B = (const char*)(F.ws + WS_WBRT) + (size_t)l * 4096 * 4096 * 2;
            S.astep = (size_t)256 * 4096 * 2; S.bstep = (size_t)128 * 4096 * 2;
            EpiGate E{wsp<bf16>(F, WS_H), wsp<bf16>(F, WS_YB)};
            if (BLK_GATE) { pg8::SchedStaticBlk SB; (pg8::SchedStatic&)SB = S; pg8::gemm_phase<EpiGate, pg8::SchedStaticBlk, 1, true>(F.lds, 4096, SB, E); } else
            pg8::gemm_phase<EpiGate, pg8::SchedStatic, 1, true>(F.lds, 4096, S, E);
        } }
        SEAM(p0 + 4);
        if (PHM(6) && IN(p0 + 5)) { {
            pg8::SchedStatic S; S.nM = 32; S.nN = 16; S.G = F.G; S.c = F.wg; S.A = (const char*)(F.ws + WS_YB); S.B = (const char*)(F.ws + WS_WOUTT) + (size_t)l * 4096 * 4096 * 2;
            S.astep = (size_t)256 * 4096 * 2; S.bstep = (size_t)256 * 4096 * 2;
            EpiRes E{l == 0 ? (const float*)args.in[0] : (const float*)F.out, wsp<float>(F, WS_Z)};
            if (BLK_OUT) { pg8::SchedStaticBlk SB; (pg8::SchedStatic&)SB = S; pg8::gemm_phase<EpiRes, pg8::SchedStaticBlk, 2, true>(F.lds, 4096, SB, E); } else
            pg8::gemm_phase<EpiRes, pg8::SchedStatic, 2, true>(F.lds, 4096, S, E);
        }
        if (REPS(6) == 2) {
            pg8::SchedStatic S; S.nM = 32; S.nN = 16; S.G = F.G; S.c = F.wg; S.A = (const char*)(F.ws + WS_YB); S.B = (const char*)(F.ws + WS_WOUTT) + (size_t)l * 4096 * 4096 * 2;
            S.astep = (size_t)256 * 4096 * 2; S.bstep = (size_t)256 * 4096 * 2;
            EpiRes E{l == 0 ? (const float*)args.in[0] : (const float*)F.out, wsp<float>(F, WS_Z)};
            if (BLK_OUT) { pg8::SchedStaticBlk SB; (pg8::SchedStatic&)SB = S; pg8::gemm_phase<EpiRes, pg8::SchedStaticBlk, 2, true>(F.lds, 4096, SB, E); } else
            pg8::gemm_phase<EpiRes, pg8::SchedStatic, 2, true>(F.lds, 4096, S, E);
        } }
        SEAM(p0 + 5);
        if (PHM(7) && IN(p0 + 6)) for (int rep = 0; rep < REPS(7); ++rep) { ln_phase(F, l, (const float*)args.in[13], (const float*)args.in[14]); }
        SEAM(p0 + 6);
}


__global__ void __launch_bounds__(NTHR, 2) mk_fwd(Args args) {
    extern __shared__ __attribute__((aligned(16))) unsigned char lds_raw[];
    Frame F;
    F.lds = (LAS unsigned char*)lds_raw;
    F.tid = threadIdx.x; F.lane = F.tid & 63; F.wave = __builtin_amdgcn_readfirstlane(F.tid >> 6); F.G = gridDim.x; F.wg = blockIdx.x;
    F.out = args.out; F.ws = args.ws;
    volatile LAS unsigned* MISC = (volatile LAS unsigned*)(F.lds + MISC_OFF);
    for (int u = F.tid; u < (LDS_BYTES - LDSCTL_OFF) / 4; u += NTHR) ((LAS unsigned*)(F.lds + LDSCTL_OFF))[u] = 0u;
    __syncthreads();
    unsigned* barw = (unsigned*)(F.ws + WS_CTL) + CW_BAR;
    XcdBarrier bar; bar.bar = barw; bar.x = 0; bar.st = nullptr;
    const int lo = args.ph_lo, hi = args.ph_hi;
    if (hi - lo > 1) bar = xcd_barrier_post(barw, MISC + 8);

    if (PHM(0) && IN(0)) for (int rep = 0; rep < REPS(0); ++rep) { prologue(F, (const float*)args.in[0], (const float*)args.in[1], (const int*)args.in[2], (const float*)args.in[3], (const float*)args.in[4], (const float*)args.in[10], (const float*)args.in[11], (const float*)args.in[12]); }
    SEAM(0);
    layer_body<0>(F, args, lo, hi, bar);
#if PROBE_CLK
    const long long pc0 = clock64(), pw0 = wall_clock64();
#endif
    layer_body<1>(F, args, lo, hi, bar);
#if PROBE_CLK
    if (blockIdx.x == 0 && threadIdx.x == 0) {
        const long long dc = clock64() - pc0, dw = wall_clock64() - pw0; const long long fmhz = dw > 0 ? 100 * dc / dw : 0; const long long ticks = (fmhz - 1000) * 100;
        if (ticks > 0 && ticks < 300000) { const long long s0 = wall_clock64(); while (wall_clock64() - s0 < ticks) __builtin_amdgcn_s_sleep(8); }
    }
#endif
#if PROBE_T
    if (blockIdx.x == 0 && threadIdx.x == 0) {
        const unsigned acc_t = ((volatile LAS unsigned*)(F.lds + MISC_OFF + 128))[PROBE_T]; const long long ticks = 8ll * acc_t;
        if (ticks > 0 && ticks < 400000) { const long long s0 = wall_clock64(); while (wall_clock64() - s0 < ticks) __builtin_amdgcn_s_sleep(8); }
    }
#endif
#undef IN
#undef SEAM
}

extern "C" void kernel_launch(void* const* d_in, const int* in_sizes, int n_in, void* d_out, int out_size, void* d_ws, size_t ws_size, hipStream_t stream) {
    static int grid = 0;
    if (grid == 0) {
        if (n_in != 15 || out_size != MTOK * DM || ws_size < WS_END) { fprintf(stderr, "kernel_launch: unexpected sizes (n_in %d, out %d, ws %zu); nothing launched\n", n_in, out_size, ws_size); grid = -1; return; }
        int dev = 0, cus = 0, per_cu = 0;
        if (hipGetDevice(&dev) != hipSuccess || hipDeviceGetAttribute(&cus, hipDeviceAttributeMultiprocessorCount, dev) != hipSuccess) { grid = -1; return; }
        if (hipFuncSetAttribute((const void*)mk_fwd, hipFuncAttributeMaxDynamicSharedMemorySize, LDS_BYTES) != hipSuccess) { fprintf(stderr, "kernel_launch: hipFuncSetAttribute failed\n"); grid = -1; return; }
        if (hipOccupancyMaxActiveBlocksPerMultiprocessor(&per_cu, (const void*)mk_fwd, NTHR, LDS_BYTES) != hipSuccess || per_cu < 1) fprintf(stderr, "kernel_launch: occupancy query says %d\n", per_cu);
        (void)hipGetLastError();
        grid = cus;
    }
    if (grid < 0) return;
    (void)hipMemsetAsync((char*)d_ws + WS_CTL, 0, CTL_ZERO_BYTES, stream);
    Args a{};
    for (int i = 0; i < 15; ++i) a.in[i] = d_in[i];
    a.out = (float*)d_out; a.ws = (unsigned char*)d_ws;
#if MK_PER_PHASE
    for (int p = 0; p < N_PHASES; ++p) { a.ph_lo = p; a.ph_hi = p + 1; hipLaunchKernelGGL(mk_fwd, dim3(grid), dim3(NTHR), LDS_BYTES, stream, a); }
#else
    a.ph_lo = 0; a.ph_hi = N_PHASES;
    hipLaunchKernelGGL(mk_fwd, dim3(grid), dim3(NTHR), LDS_BYTES, stream, a);
#endif
}
```
